# Optimizing an MI355X kernel written in HIP

```python
import jax, jax.numpy as jnp
from jax import lax
import numpy as np

D_MODEL = 2048
BATCH = 2
SEQ = 8192
DEPTH = 4

CTX_LEN = 256
GRID_W = 64

MIX_WIDTH = D_MODEL
CONV_WIDTH = MIX_WIDTH // 4
CONV_K = 3
GLA_HEADS = 4
GLA_DV = MIX_WIDTH // 4 // GLA_HEADS
GLA_DK = GLA_DV // 2
GLA_LOWRANK = 16
GLA_TAU = 16.0
GLA_CHUNK = 64
SWA_HEADS = 8
SWA_KV_HEADS = 2
SWA_GROUP = SWA_HEADS // SWA_KV_HEADS
SWA_HEAD_DIM = MIX_WIDTH // 2 // SWA_HEADS
SWA_WINDOW = 128
SWA_BLOCK = 128
ROPE_THETA = 10000.0
NEG_INF = -1e30
PEER_HEADS = 8
PEER_NKEYS = 128
PEER_EXPERTS = PEER_NKEYS * PEER_NKEYS
PEER_DKEY = 256
PEER_TOPK = 16
PEER_TOKEN_BLOCK = 128
DEEPNORM_ALPHA = (2.0 * DEPTH) ** 0.25
DEEPNORM_BETA = (8.0 * DEPTH) ** -0.25
LN_EPS = 1e-6

IN_SPLITS = (
    CONV_WIDTH, CONV_WIDTH, CONV_WIDTH,
    GLA_HEADS * GLA_DK, GLA_HEADS * GLA_DK,
    GLA_HEADS * GLA_DV, GLA_HEADS * GLA_DV,
    GLA_LOWRANK, GLA_LOWRANK,
    SWA_HEADS * SWA_HEAD_DIM,
    SWA_KV_HEADS * SWA_HEAD_DIM, SWA_KV_HEADS * SWA_HEAD_DIM,
)
IN_WIDTH = sum(IN_SPLITS)

kernel_name = "hymba_conv_gla_swa_peer_deepnorm_dit"


def layer_norm(x, g, b):
    xf = x.astype(jnp.float32)
    mu = jnp.mean(xf, axis=-1, keepdims=True)
    var = jnp.mean(jnp.square(xf - mu), axis=-1, keepdims=True)
    return ((xf - mu) * lax.rsqrt(var + LN_EPS) * g + b).astype(x.dtype)


def split_cols(z):
    points, acc = [], 0
    for width in IN_SPLITS[:-1]:
        acc += width
        points.append(acc)
    return jnp.split(z, points, axis=-1)


def axial_rope_tables(n_tokens, dtype):
    rows = n_tokens // GRID_W
    r, col = jnp.meshgrid(jnp.arange(rows, dtype=jnp.float32), jnp.arange(GRID_W, dtype=jnp.float32), indexing='ij')
    axis_dim = SWA_HEAD_DIM // 2
    inv_freq = ROPE_THETA ** (-jnp.arange(0, axis_dim, 2, dtype=jnp.float32) / axis_dim)
    ang_r = r.reshape(-1, 1) * inv_freq
    ang_c = col.reshape(-1, 1) * inv_freq
    cos_r = jnp.cos(ang_r).astype(dtype)[None, :, None, :]
    sin_r = jnp.sin(ang_r).astype(dtype)[None, :, None, :]
    cos_c = jnp.cos(ang_c).astype(dtype)[None, :, None, :]
    sin_c = jnp.sin(ang_c).astype(dtype)[None, :, None, :]
    return (cos_r, sin_r, cos_c, sin_c)


def rotate_half(x, cos, sin):
    x1, x2 = jnp.split(x, 2, axis=-1)
    return jnp.concatenate([x1 * cos - x2 * sin, x2 * cos + x1 * sin], axis=-1)


def apply_axial_rope(x, tables):
    cos_r, sin_r, cos_c, sin_c = tables
    x_row, x_col = jnp.split(x, 2, axis=-1)
    return jnp.concatenate([rotate_half(x_row, cos_r, sin_r), rotate_half(x_col, cos_c, sin_c)], axis=-1)


def short_conv(z, w):
    return lax.conv_general_dilated(z, w[:, None, :], window_strides=(1,), padding=((CONV_K // 2, CONV_K // 2),),
                                    dimension_numbers=('NWC', 'WIO', 'NWC'), feature_group_count=z.shape[-1])


def conv_mixer(x_in, gate_b, gate_c, w):
    return gate_b * short_conv(gate_c * x_in, w)


def gla_heads(parts, w2, b2):
    _, _, _, q, k, v, g, lr_f, lr_b, _, _, _ = parts
    bsz, n = q.shape[:2]
    q = q.reshape(bsz, n, GLA_HEADS, GLA_DK) * GLA_DK ** -0.5
    k = k.reshape(bsz, n, GLA_HEADS, GLA_DK)
    v = v.reshape(bsz, n, GLA_HEADS, GLA_DV)
    lg_f = gla_log_decay(lr_f, w2[0], b2[0])
    lg_b = gla_log_decay(lr_b, w2[1], b2[1])
    return q, k, v, lg_f, lg_b, g


def gla_log_decay(lr, w2, b2):
    z = (lr @ w2 + b2).astype(jnp.float32)
    return (jax.nn.log_sigmoid(z) / GLA_TAU).reshape(lr.shape[0], lr.shape[1], GLA_HEADS, GLA_DK)


def gla_chunk_states(k, v, lg, s0):
    bsz, n_tok, h, dk = k.shape
    dv = v.shape[-1]
    n = n_tok // GLA_CHUNK
    kc = k.reshape(bsz, n, GLA_CHUNK, h, dk)
    vc = v.reshape(bsz, n, GLA_CHUNK, h, dv)
    b = jnp.cumsum(lg.reshape(bsz, n, GLA_CHUNK, h, dk), axis=2)
    b_last = b[:, :, -1]
    k_end = kc * jnp.exp(b_last[:, :, None] - b).astype(k.dtype)
    delta = jnp.einsum('bnchk,bnchv->nbhkv', k_end, vc)
    decay = jnp.exp(b_last).astype(k.dtype).transpose(1, 0, 2, 3)

    def step(s, inp):
        dec, dlt = inp
        return dec[..., None] * s + dlt, s

    s_final, s_starts = lax.scan(step, s0, (decay, delta))
    return s_starts, s_final, b


def gla_chunk_outputs(q, k, v, b, s_starts):
    bsz, n_tok, h, dk = q.shape
    dv = v.shape[-1]
    n = n_tok // GLA_CHUNK
    qe = q.reshape(bsz, n, GLA_CHUNK, h, dk) * jnp.exp(b).astype(q.dtype)
    ke = k.reshape(bsz, n, GLA_CHUNK, h, dk) * jnp.exp(-b).astype(k.dtype)
    vc = v.reshape(bsz, n, GLA_CHUNK, h, dv)
    att = jnp.einsum('bnihk,bnjhk->bnhij', qe, ke)
    lower_tri = jnp.tril(jnp.ones((GLA_CHUNK, GLA_CHUNK), dtype=bool))
    att = jnp.where(lower_tri, att, jnp.zeros_like(att))
    o = jnp.einsum('bnhij,bnjhv->bnihv', att, vc) + jnp.einsum('bnihk,nbhkv->bnihv', qe, s_starts)
    return o.reshape(bsz, n_tok, h, dv)


def gla_bidir(q, k, v, lg_f, lg_b, s0_f, s0_b):
    st_f, fin_f, b_f = gla_chunk_states(k, v, lg_f, s0_f)
    o_f = gla_chunk_outputs(q, k, v, b_f, st_f)
    qr, kr, vr = jnp.flip(q, axis=1), jnp.flip(k, axis=1), jnp.flip(v, axis=1)
    st_b, fin_b, b_b = gla_chunk_states(kr, vr, jnp.flip(lg_b, axis=1), s0_b)
    o_b = jnp.flip(gla_chunk_outputs(qr, kr, vr, b_b, st_b), axis=1)
    return o_f + o_b, fin_f, fin_b


def gla_final_states(k, v, lg_f, lg_b, s0):
    _, fin_f, _ = gla_chunk_states(k, v, lg_f, s0)
    _, fin_b, _ = gla_chunk_states(jnp.flip(k, axis=1), jnp.flip(v, axis=1), jnp.flip(lg_b, axis=1), s0)
    return fin_f, fin_b


def gla_finish(o, g, norm_w):
    of = o.astype(jnp.float32)
    of = of * lax.rsqrt(jnp.mean(of * of, axis=-1, keepdims=True) + LN_EPS) * norm_w
    bsz, n = o.shape[:2]
    return of.astype(o.dtype).reshape(bsz, n, GLA_HEADS * GLA_DV) * jax.nn.silu(g)


def swa_heads(parts):
    sq, sk, sv = parts[9], parts[10], parts[11]
    bsz, n = sq.shape[:2]
    return (sq.reshape(bsz, n, SWA_HEADS, SWA_HEAD_DIM),
            sk.reshape(bsz, n, SWA_KV_HEADS, SWA_HEAD_DIM),
            sv.reshape(bsz, n, SWA_KV_HEADS, SWA_HEAD_DIM))


def sink_column(sink, lead_shape):
    col = sink.astype(jnp.float32).reshape(SWA_KV_HEADS, SWA_GROUP)[:, :, None, None]
    return jnp.broadcast_to(col, lead_shape + (1,))


def swa_latent(q, k, v, k_ctx, v_ctx, sink):
    bsz, n = q.shape[:2]
    nb = n // SWA_BLOCK
    band = 3 * SWA_BLOCK
    qb = q.reshape(bsz, nb, SWA_BLOCK, SWA_KV_HEADS, SWA_GROUP, SWA_HEAD_DIM) * SWA_HEAD_DIM ** -0.5
    pad = ((0, 0), (SWA_BLOCK, SWA_BLOCK), (0, 0), (0, 0))
    band_idx = jnp.arange(nb)[:, None] * SWA_BLOCK + jnp.arange(band)[None, :]
    kb = jnp.pad(k, pad)[:, band_idx]
    vb = jnp.pad(v, pad)[:, band_idx]
    q_pos = jnp.arange(nb)[:, None] * SWA_BLOCK + jnp.arange(SWA_BLOCK)[None, :]
    k_pos = band_idx - SWA_BLOCK
    valid = ((jnp.abs(q_pos[:, :, None] - k_pos[:, None, :]) <= SWA_WINDOW)
             & (k_pos[:, None, :] >= 0) & (k_pos[:, None, :] < n))
    s_loc = jnp.einsum('bnqhgd,bnkhd->bnhgqk', qb, kb).astype(jnp.float32)
    s_loc = jnp.where(valid[None, :, None, None], s_loc, NEG_INF)
    s_ctx = jnp.einsum('bnqhgd,bchd->bnhgqc', qb, k_ctx).astype(jnp.float32)
    logits = jnp.concatenate([s_loc, s_ctx, sink_column(sink, s_loc.shape[:-1])], axis=-1)
    p = jax.nn.softmax(logits, axis=-1).astype(v.dtype)
    n_ctx = k_ctx.shape[1]
    o = (jnp.einsum('bnhgqk,bnkhd->bnqhgd', p[..., :band], vb)
         + jnp.einsum('bnhgqc,bchd->bnqhgd', p[..., band:band + n_ctx], v_ctx))
    return o.reshape(bsz, n, SWA_HEADS * SWA_HEAD_DIM)


def swa_context(q, k, v, sink):
    bsz, n = q.shape[:2]
    qg = q.reshape(bsz, n, SWA_KV_HEADS, SWA_GROUP, SWA_HEAD_DIM) * SWA_HEAD_DIM ** -0.5
    s = jnp.einsum('bqhgd,bkhd->bhgqk', qg, k).astype(jnp.float32)
    logits = jnp.concatenate([s, sink_column(sink, s.shape[:-1])], axis=-1)
    p = jax.nn.softmax(logits, axis=-1)[..., :n].astype(v.dtype)
    return jnp.einsum('bhgqk,bkhd->bqhgd', p, v).reshape(bsz, n, SWA_HEADS * SWA_HEAD_DIM)


def token_mixer(hl, hc, rope, w_in, conv_w, gla_w2, gla_b2, gla_norm, swa_sink, w_out, with_ctx_out):
    pl = split_cols(hl @ w_in)
    pc = split_cols(hc @ w_in)
    q_c, k_c, v_c, lgf_c, lgb_c, g_c = gla_heads(pc, gla_w2, gla_b2)
    sq_c, sk_c, sv_c = swa_heads(pc)
    s0 = jnp.zeros((hc.shape[0], GLA_HEADS, GLA_DK, GLA_DV), hc.dtype)
    if with_ctx_out:
        o_c, s_ctx_f, s_ctx_b = gla_bidir(q_c, k_c, v_c, lgf_c, lgb_c, s0, s0)
    else:
        s_ctx_f, s_ctx_b = gla_final_states(k_c, v_c, lgf_c, lgb_c, s0)
    q_l, k_l, v_l, lgf_l, lgb_l, g_l = gla_heads(pl, gla_w2, gla_b2)
    o_l, _, _ = gla_bidir(q_l, k_l, v_l, lgf_l, lgb_l, s_ctx_f, s_ctx_b)
    sq_l, sk_l, sv_l = swa_heads(pl)
    swa_l = swa_latent(apply_axial_rope(sq_l, rope), apply_axial_rope(sk_l, rope), sv_l, sk_c, sv_c, swa_sink)
    y_l = jnp.concatenate([conv_mixer(pl[0], pl[1], pl[2], conv_w), gla_finish(o_l, g_l, gla_norm), swa_l],
                          axis=-1) @ w_out
    if with_ctx_out:
        y_c = jnp.concatenate([conv_mixer(pc[0], pc[1], pc[2], conv_w), gla_finish(o_c, g_c, gla_norm),
                               swa_context(sq_c, sk_c, sv_c, swa_sink)], axis=-1) @ w_out
        return y_l, y_c
    return y_l, None


def peer_ffn(h, wq, subkeys, u_tab, v_tab):
    n_tok, d = h.shape
    q = (h @ wq).reshape(n_tok, PEER_HEADS, 2, PEER_DKEY // 2)
    s = jnp.einsum('thpd,pnd->thpn', q, subkeys).astype(jnp.float32)
    s_top, i_top = lax.top_k(s, PEER_TOPK)
    cand = (s_top[:, :, 0, :, None] + s_top[:, :, 1, None, :]).reshape(n_tok, PEER_HEADS, PEER_TOPK * PEER_TOPK)
    best, flat = lax.top_k(cand, PEER_TOPK)
    i1 = jnp.take_along_axis(i_top[:, :, 0], flat // PEER_TOPK, axis=-1)
    i2 = jnp.take_along_axis(i_top[:, :, 1], flat % PEER_TOPK, axis=-1)
    experts = i1 * PEER_NKEYS + i2
    gates = jax.nn.softmax(best, axis=-1).astype(h.dtype)
    nblk = n_tok // PEER_TOKEN_BLOCK

    def block(args):
        hb, eb, gb = args
        act = jax.nn.gelu(jnp.einsum('thkd,td->thk', u_tab[eb], hb), approximate=False)
        return jnp.einsum('thk,thkd->td', act * gb, v_tab[eb])

    y = lax.map(block, (h.reshape(nblk, PEER_TOKEN_BLOCK, d),
                        experts.reshape(nblk, PEER_TOKEN_BLOCK, PEER_HEADS, PEER_TOPK),
                        gates.reshape(nblk, PEER_TOKEN_BLOCK, PEER_HEADS, PEER_TOPK)))
    return y.reshape(n_tok, d)


def setup_inputs(seed: int = 0) -> dict:
    key = jax.random.key(seed)
    ks = jax.random.split(key, 19)
    f32 = jnp.float32

    def nrm(k, shape, scale):
        return jax.random.normal(k, shape, f32) * scale

    return {
        "x": nrm(ks[0], (BATCH, SEQ, D_MODEL), 1.0),
        "c": nrm(ks[1], (BATCH, D_MODEL), 1.0),
        "ctx": nrm(ks[2], (BATCH, CTX_LEN, D_MODEL), 1.0),
        "c_ctx": nrm(ks[3], (D_MODEL,), 1.0),
        "w_ada": nrm(ks[4], (DEPTH, D_MODEL, 6 * D_MODEL), D_MODEL ** -0.5),
        "b_ada": nrm(ks[5], (DEPTH, 6 * D_MODEL), 0.02),
        "w_in": nrm(ks[6], (DEPTH, D_MODEL, IN_WIDTH), D_MODEL ** -0.5),
        "conv_w": nrm(ks[7], (DEPTH, CONV_K, CONV_WIDTH), CONV_K ** -0.5),
        "gla_w2": nrm(ks[8], (DEPTH, 2, GLA_LOWRANK, GLA_HEADS * GLA_DK), GLA_LOWRANK ** -0.5),
        "gla_b2": nrm(ks[9], (DEPTH, 2, GLA_HEADS * GLA_DK), 0.1),
        "gla_norm": 1.0 + nrm(ks[10], (DEPTH, GLA_DV), 0.1),
        "swa_sink": nrm(ks[11], (DEPTH, SWA_HEADS), 0.5),
        "w_out": nrm(ks[12], (DEPTH, MIX_WIDTH, D_MODEL), MIX_WIDTH ** -0.5 * DEEPNORM_BETA),
        "ln_g": 1.0 + nrm(ks[13], (DEPTH, 2, D_MODEL), 0.1),
        "ln_b": nrm(ks[14], (DEPTH, 2, D_MODEL), 0.02),
        "peer_wq": nrm(ks[15], (DEPTH, D_MODEL, PEER_HEADS * PEER_DKEY), D_MODEL ** -0.5),
        "peer_subkeys": nrm(ks[16], (DEPTH, 2, PEER_NKEYS, PEER_DKEY // 2), (PEER_DKEY // 2) ** -0.5),
        "peer_u": nrm(ks[17], (DEPTH, PEER_EXPERTS, D_MODEL), D_MODEL ** -0.5),
        "peer_v": nrm(ks[18], (DEPTH, PEER_EXPERTS, D_MODEL), PEER_HEADS ** -0.5 * DEEPNORM_BETA),
    }


def reference(x, c, ctx, c_ctx, w_ada, b_ada, w_in, conv_w, gla_w2, gla_b2, gla_norm, swa_sink, w_out,
              ln_g, ln_b, peer_wq, peer_subkeys, peer_u, peer_v):
    xl, xc = x, ctx
    rope = axial_rope_tables(x.shape[1], x.dtype)
    for layer in range(DEPTH):
        last = layer == DEPTH - 1
        sh1, sc1, g1, sh2, sc2, g2 = jnp.split((jax.nn.silu(c) @ w_ada[layer] + b_ada[layer])[:, None, :], 6, axis=-1)
        csh1, csc1, cg1, csh2, csc2, cg2 = jnp.split(jax.nn.silu(c_ctx) @ w_ada[layer] + b_ada[layer], 6, axis=-1)
        ml, mc = token_mixer(xl * (1 + sc1) + sh1, xc * (1 + csc1) + csh1, rope, w_in[layer], conv_w[layer],
                             gla_w2[layer], gla_b2[layer], gla_norm[layer], swa_sink[layer], w_out[layer],
                             not last)
        xl = layer_norm(DEEPNORM_ALPHA * xl + g1 * ml, ln_g[layer, 0], ln_b[layer, 0])
        hl = (xl * (1 + sc2) + sh2).reshape(-1, xl.shape[-1])
        fl = peer_ffn(hl, peer_wq[layer], peer_subkeys[layer], peer_u[layer], peer_v[layer]).reshape(xl.shape)
        xl = layer_norm(DEEPNORM_ALPHA * xl + g2 * fl, ln_g[layer, 1], ln_b[layer, 1])
        if not last:
            xc = layer_norm(DEEPNORM_ALPHA * xc + cg1 * mc, ln_g[layer, 0], ln_b[layer, 0])
            hc = (xc * (1 + csc2) + csh2).reshape(-1, xc.shape[-1])
            fc = peer_ffn(hc, peer_wq[layer], peer_subkeys[layer], peer_u[layer], peer_v[layer]).reshape(xc.shape)
            xc = layer_norm(DEEPNORM_ALPHA * xc + cg2 * fc, ln_g[layer, 1], ln_b[layer, 1])
    return xl
```

```cpp
#include <hip/hip_runtime.h>
#include <cstdio>
#include <cstdint>

#define LAS __attribute__((address_space(3)))
typedef unsigned short bf16_t;
typedef short bf16x8 __attribute__((ext_vector_type(8)));
typedef float f32x4 __attribute__((ext_vector_type(4)));
typedef unsigned u32x4 __attribute__((ext_vector_type(4)));
typedef unsigned u32x2 __attribute__((ext_vector_type(2)));

constexpr int DM = 2048, NBATCH = 2, SEQ = 8192, DEPTH = 4, CTXL = 256;
constexpr int TL = NBATCH * SEQ, TC = NBATCH * CTXL, TA = TL + TC;
constexpr int INW = 4640, INWP = 4864;
constexpr int C_CX = 0, C_CB = 512, C_CC = 1024, C_GQ = 1536, C_GK = 1792, C_GV = 2048, C_GG = 2560, C_LRF = 3072, C_LRB = 3088,
              C_SQ = 3104, C_SK = 4128, C_SV = 4384;
constexpr int NEXP = 16384;
constexpr float DN_ALPHA = 1.6817928305074290f;
constexpr float LN_EPS = 1e-6f;
constexpr int NWAVES = 8, NTHREADS = 512;

constexpr size_t MiB = 1u << 20;
constexpr size_t WS_CTL = 0, CTL_ZERO_BYTES = 2 * MiB;
constexpr size_t WS_MOD = 2 * MiB;
constexpr size_t WS_WIN = 4 * MiB;
constexpr size_t WS_WOUT = 80 * MiB;
constexpr size_t WS_WQ = 112 * MiB;
constexpr size_t WS_XL = 144 * MiB;
constexpr size_t WS_HB = 276 * MiB;
constexpr size_t WS_P = 342 * MiB;
constexpr size_t WS_QR = 656 * MiB;
constexpr size_t WS_KR = 720 * MiB;
constexpr size_t WS_ALF = 736 * MiB;
constexpr size_t WS_ALB = 753 * MiB;
constexpr size_t WS_OF = 770 * MiB;
constexpr size_t WS_OB = 803 * MiB;
constexpr size_t WS_MIX = 836 * MiB;
constexpr size_t WS_Y = 902 * MiB;
constexpr size_t WS_QP = 1034 * MiB;
constexpr size_t WS_END = 1166 * MiB;
static_assert(WS_WIN + (size_t)4 * INWP * DM * 2 <= WS_WOUT, "map");
static_assert(WS_P + (size_t)TA * INWP * 4 <= WS_QR, "map");
static_assert(WS_XL + (size_t)TA * DM * 4 <= WS_HB, "map");
constexpr int CW_BAR = 4096;
constexpr int LDS_BYTES = 147456;
constexpr int MISC_OFF = 131072 + 320;

#define XB_TMO      128
#define XB_XCNT(j)  (256  + 64 * (j))
#define XB_XSUB(j)  (1280 + 64 * (j))
#define XB_XGEN(j)  (2304 + 64 * (j))
#define XB_TOP      3328
#define XB_TOPGEN   3392
#define XCD_BAR_WORDS 3456
#define XB_SPIN_CAP (1u << 18)
__device__ __forceinline__ unsigned xb_ld(unsigned* p)              { return __hip_atomic_load(p, __ATOMIC_RELAXED, __HIP_MEMORY_SCOPE_AGENT); }
__device__ __forceinline__ unsigned xb_add(unsigned* p, unsigned v) { return __hip_atomic_fetch_add(p, v, __ATOMIC_RELAXED, __HIP_MEMORY_SCOPE_AGENT); }
__device__ __forceinline__ unsigned xb_xcc_id() { return (unsigned)__builtin_amdgcn_s_getreg((3 << 11) | 20) & 0xFu; }
#define XB_SPIN(cond, bar) do { unsigned _sp = 0; while (cond) { __builtin_amdgcn_s_sleep(1); \
    if ((++_sp & 255u) == 0u) { if (xb_ld(&(bar)[XB_TMO])) break; if (_sp > XB_SPIN_CAP) { atomicAdd(&(bar)[XB_TMO], 1u); break; } } } } while (0)
struct XcdBarrier { unsigned* bar; unsigned x; volatile LAS unsigned* st; };
__device__ __forceinline__ XcdBarrier xcd_barrier_post(unsigned* bar, volatile LAS unsigned* st) {
    XcdBarrier b; b.bar = bar; b.x = xb_xcc_id(); b.st = st;
    if (threadIdx.x == 0) (void)xb_add(&bar[XB_XCNT(b.x)], 1u);
    return b;
}
__device__ __forceinline__ void xcd_barrier_complete(unsigned* bar, unsigned x, unsigned& nloc, unsigned& nx) {
    const unsigned G = gridDim.x * gridDim.y * gridDim.z;
    unsigned sum, cnt, mine, sp = 0u;
    for (;;) {
        sum = 0u; cnt = 0u; mine = 0u;
#pragma unroll
        for (unsigned j = 0; j < 16; ++j) { const unsigned c = xb_ld(&bar[XB_XCNT(j)]); sum += c; cnt += (c > 0u) ? 1u : 0u; mine = (j == x) ? c : mine; }
        if (sum == G) break;
        __builtin_amdgcn_s_sleep(1);
        if ((++sp & 255u) == 0u) { if (xb_ld(&bar[XB_TMO])) break; if (sp > XB_SPIN_CAP) { atomicAdd(&bar[XB_TMO], 1u); break; } }
    }
    nloc = mine > 0u ? mine : 1u; nx = cnt > 0u ? cnt : 1u;
}
__device__ __forceinline__ void xcd_barrier(const XcdBarrier& b) {
    asm volatile("s_waitcnt vmcnt(0)" ::: "memory");
    __syncthreads();
    if (threadIdx.x == 0) {
        unsigned* bar = b.bar;
        __builtin_amdgcn_s_waitcnt(0);
        unsigned nloc = b.st[0], nx = b.st[1];
        if (nloc == 0u) { xcd_barrier_complete(bar, b.x, nloc, nx); b.st[0] = nloc; b.st[1] = nx; }
        const unsigned old = xb_add(&bar[XB_XSUB(b.x)], 1u);
        const unsigned gen = old / nloc;
        if (old + 1u == (gen + 1u) * nloc) {
            __builtin_amdgcn_fence(__ATOMIC_RELEASE, "agent");
            asm volatile("s_waitcnt vmcnt(0)" ::: "memory");
            const unsigned og = xb_add(&bar[XB_TOP], 1u);
            const unsigned tg = og / nx;
            if (og + 1u == (tg + 1u) * nx) xb_add(&bar[XB_TOPGEN], 1u);
            else XB_SPIN(xb_ld(&bar[XB_TOPGEN]) == tg, bar);
            __builtin_amdgcn_fence(__ATOMIC_ACQUIRE, "agent");
            xb_add(&bar[XB_XGEN(b.x)], 1u);
            asm volatile("s_waitcnt vmcnt(0)" ::: "memory");
        } else {
            XB_SPIN(xb_ld(&bar[XB_XGEN(b.x)]) == gen, bar);
            __builtin_amdgcn_fence(__ATOMIC_ACQUIRE, "agent");
            asm volatile("s_waitcnt vmcnt(0)" ::: "memory");
        }
    }
    __syncthreads();
}

#define LDS_FENCE() asm volatile("s_waitcnt lgkmcnt(0)" ::: "memory")
__device__ __forceinline__ unsigned f2bf(float f) { unsigned u = __builtin_bit_cast(unsigned, f); return (u + 0x7fffu + ((u >> 16) & 1u)) >> 16; }
__device__ __forceinline__ unsigned pk2(float lo, float hi) { return f2bf(lo) | (f2bf(hi) << 16); }
__device__ __forceinline__ float wave_sum(float v) {
#pragma unroll
    for (int o = 1; o < 64; o <<= 1) v += __shfl_xor(v, o);
    return v;
}
__device__ __forceinline__ float wave_max(float v) {
#pragma unroll
    for (int o = 1; o < 64; o <<= 1) v = fmaxf(v, __shfl_xor(v, o));
    return v;
}
__device__ __forceinline__ float silu_f(float x) { return x / (1.0f + expf(-x)); }
__device__ __forceinline__ float gelu_f(float x) { return 0.5f * x * (1.0f + erff(x * 0.70710678118654752f)); }
__device__ __forceinline__ float log_sigmoid_f(float z) { return fminf(z, 0.0f) - log1pf(expf(-fabsf(z))); }

struct Params {
    const float* in[19];
    float* out;
    unsigned char* ws;
    int ph_lo, ph_hi;
};
enum { I_X = 0, I_C, I_CTX, I_CCTX, I_WADA, I_BADA, I_WIN, I_CONVW, I_GW2, I_GB2, I_GNORM, I_SINK, I_WOUT, I_LNG, I_LNB, I_PWQ, I_PSUB, I_PU, I_PV };

__device__ __forceinline__ int row_stream(int r) { return r < TL ? r / SEQ : 2; }

__device__ __forceinline__ void transpose_item(const float* W, int K, int N, bf16_t* WT, LAS float* scr, int item, int lane) {
    const int nblk = N / 32, kb = item / nblk, nb = item % nblk, k0 = 64 * kb, n0 = 32 * nb;
#pragma unroll 8
    for (int i = 0; i < 32; ++i) { const int kk = 2 * i + (lane >> 5); scr[kk * 33 + (lane & 31)] = W[(size_t)(k0 + kk) * N + n0 + (lane & 31)]; }
    LDS_FENCE();
    const int c = lane & 7;
#pragma unroll
    for (int j = 0; j < 4; ++j) { const int n = (lane >> 3) + 8 * j; const LAS float* s = scr + (8 * c) * 33 + n;
        u32x4 o; o.x = pk2(s[0 * 33], s[1 * 33]); o.y = pk2(s[2 * 33], s[3 * 33]); o.z = pk2(s[4 * 33], s[5 * 33]); o.w = pk2(s[6 * 33], s[7 * 33]);
        *(u32x4*)(WT + (size_t)(n0 + n) * K + k0 + 8 * c) = o; }
    LDS_FENCE();
}

__device__ __forceinline__ void phase_prologue(const Params& p, LAS unsigned char* lds, int tid, int lane, int wave, int bid, int G) {
    const int gw = bid * NWAVES + wave, NGW = G * NWAVES;
    LAS float* scr = (LAS float*)(lds + wave * 16384);
    bf16_t* WIN = (bf16_t*)(p.ws + WS_WIN); bf16_t* WOUT = (bf16_t*)(p.ws + WS_WOUT); bf16_t* WQ = (bf16_t*)(p.ws + WS_WQ);
    constexpr int IT_IN = (DM / 64) * (INW / 32), IT_SQ = (DM / 64) * (DM / 32), IT_L = IT_IN + 2 * IT_SQ;
    for (int it = gw; it < DEPTH * IT_L; it += NGW) {
        const int l = it / IT_L; int r = it % IT_L;
        if (r < IT_IN) { transpose_item(p.in[I_WIN] + (size_t)l * DM * INW, DM, INW, WIN + (size_t)l * INWP * DM, scr, r, lane); continue; } r -= IT_IN;
        if (r < IT_SQ) { transpose_item(p.in[I_WOUT] + (size_t)l * DM * DM, DM, DM, WOUT + (size_t)l * DM * DM, scr, r, lane); continue; } r -= IT_SQ;
        transpose_item(p.in[I_PWQ] + (size_t)l * DM * DM, DM, DM, WQ + (size_t)l * DM * DM, scr, r, lane);
    }
    {
        constexpr int PADV = (INWP - INW) * DM / 8;
        const int gt = bid * NTHREADS + tid, NGT = G * NTHREADS;
        for (int i = gt; i < DEPTH * PADV; i += NGT) { const int l = i / PADV, o = i % PADV;
            *(u32x4*)(WIN + (size_t)l * INWP * DM + (size_t)INW * DM + (size_t)o * 8) = (u32x4){0u, 0u, 0u, 0u}; }
    }
    __syncthreads();
    LAS float* sc = (LAS float*)lds;
    LAS float* red = (LAS float*)(lds + 32768);
    for (int i = tid; i < 3 * DM; i += NTHREADS) { const int s = i / DM, k = i % DM; const float v = s < 2 ? p.in[I_C][s * DM + k] : p.in[I_CCTX][k]; sc[i] = silu_f(v); }
    __syncthreads();
    float* MOD = (float*)(p.ws + WS_MOD);
    constexpr int NCH = 6 * DM / 64;
    for (int it = bid; it < DEPTH * NCH; it += G) {
        const int l = it / NCH, n = (it % NCH) * 64 + lane;
        const float* wp = p.in[I_WADA] + (size_t)l * DM * 6 * DM + n;
        float a0 = 0.f, a1 = 0.f, a2 = 0.f;
        const int kb = wave * (DM / NWAVES);
#pragma unroll 8
        for (int k = kb; k < kb + DM / NWAVES; ++k) { const float w = wp[(size_t)k * 6 * DM]; a0 += sc[k] * w; a1 += sc[DM + k] * w; a2 += sc[2 * DM + k] * w; }
        red[(wave * 3 + 0) * 64 + lane] = a0; red[(wave * 3 + 1) * 64 + lane] = a1; red[(wave * 3 + 2) * 64 + lane] = a2;
        __syncthreads();
        if (tid < 192) { const int s = tid / 64, ln = tid % 64; float v = 0.f;
#pragma unroll
            for (int w = 0; w < NWAVES; ++w) v += red[(w * 3 + s) * 64 + ln];
            const int nn = (it % NCH) * 64 + ln;
            MOD[((size_t)l * 3 + s) * 6 * DM + nn] = v + p.in[I_BADA][(size_t)l * 6 * DM + nn]; }
        __syncthreads();
    }
}

__device__ __forceinline__ const float* xsrc(const Params& p, int l, int r) {
    if (l > 0) return (const float*)(p.ws + WS_XL) + (size_t)r * DM;
    return r < TL ? p.in[I_X] + (size_t)r * DM : p.in[I_CTX] + (size_t)(r - TL) * DM;
}

__device__ __forceinline__ void modulate_row(const float* xr, const float* mod, int sh_off, int sc_off, bf16_t* hb, int lane) {
#pragma unroll
    for (int j = 0; j < 8; ++j) { const int c = lane * 4 + 256 * j;
        const f32x4 x = *(const f32x4*)(xr + c), sh = *(const f32x4*)(mod + sh_off + c), s = *(const f32x4*)(mod + sc_off + c);
        u32x2 o; o.x = pk2(x.x * (1.f + s.x) + sh.x, x.y * (1.f + s.y) + sh.y); o.y = pk2(x.z * (1.f + s.z) + sh.z, x.w * (1.f + s.w) + sh.w);
        *(u32x2*)(hb + c) = o; }
}
__device__ __forceinline__ void phase_modulate0(const Params& p, int lane, int wave, int bid, int G) {
    const int gw = bid * NWAVES + wave, NGW = G * NWAVES;
    const float* MOD = (const float*)(p.ws + WS_MOD); bf16_t* HB = (bf16_t*)(p.ws + WS_HB);
    for (int r = gw; r < TA; r += NGW) modulate_row(xsrc(p, 0, r), MOD + (size_t)(0 * 3 + row_stream(r)) * 6 * DM, 0, DM, HB + (size_t)r * DM, lane);
}

__device__ __forceinline__ void gemm_direct(const bf16_t* A, const bf16_t* Bt, float* C, int M, int N, int K, int ldc, int gw, int NGW, int lane) {
    const int nTn = N / 64, nItems = (M / 32) * nTn;
    const int fr = lane & 15, fq = lane >> 4;
    for (int it = gw; it < nItems; it += NGW) {
        const int mt = it / nTn, nt = it % nTn;
        const bf16_t* a0 = A + (size_t)(mt * 32 + fr) * K + fq * 8;
        const bf16_t* b0 = Bt + (size_t)(nt * 64 + fr) * K + fq * 8;
        f32x4 acc[2][4];
#pragma unroll
        for (int i = 0; i < 2; ++i)
#pragma unroll
            for (int j = 0; j < 4; ++j) acc[i][j] = (f32x4){0.f, 0.f, 0.f, 0.f};
#pragma unroll 2
        for (int k0 = 0; k0 < K; k0 += 32) {
            bf16x8 af[2], bfr[4];
#pragma unroll
            for (int i = 0; i < 2; ++i) af[i] = *(const bf16x8*)(a0 + (size_t)i * 16 * K + k0);
#pragma unroll
            for (int j = 0; j < 4; ++j) bfr[j] = *(const bf16x8*)(b0 + (size_t)j * 16 * K + k0);
#pragma unroll
            for (int i = 0; i < 2; ++i)
#pragma unroll
                for (int j = 0; j < 4; ++j) acc[i][j] = __builtin_amdgcn_mfma_f32_16x16x32_bf16(af[i], bfr[j], acc[i][j], 0, 0, 0);
        }
#pragma unroll
        for (int i = 0; i < 2; ++i)
#pragma unroll
            for (int j = 0; j < 4; ++j)
#pragma unroll
                for (int g = 0; g < 4; ++g) C[(size_t)(mt * 32 + i * 16 + fq * 4 + g) * ldc + nt * 64 + j * 16 + fr] = acc[i][j][g];
    }
}

__device__ __forceinline__ void phase_post_in(const Params& p, int l, int lane, int wave, int bid, int G) {
    const int gw = bid * NWAVES + wave, NGW = G * NWAVES;
    const float* P = (const float*)(p.ws + WS_P);
    float* QR = (float*)(p.ws + WS_QR); float* KR = (float*)(p.ws + WS_KR);
    float* ALF = (float*)(p.ws + WS_ALF); float* ALB = (float*)(p.ws + WS_ALB);
    bf16_t* MIX = (bf16_t*)(p.ws + WS_MIX);
    const float* cw = p.in[I_CONVW] + (size_t)l * 3 * 512;
    const float* w2 = p.in[I_GW2] + (size_t)l * 2 * 16 * 256;
    const float* b2 = p.in[I_GB2] + (size_t)l * 2 * 256;
    for (int r = gw; r < TA; r += NGW) {
        const float* pr = P + (size_t)r * INWP;
        int pos, len;
        if (r < TL) { pos = r % SEQ; len = SEQ; } else { pos = (r - TL) % CTXL; len = CTXL; }
#pragma unroll 1
        for (int j = 0; j < 8; ++j) { const int c = lane + 64 * j;
            float a = cw[512 + c] * pr[C_CC + c] * pr[C_CX + c];
            if (pos > 0) a += cw[c] * pr[C_CC + c - INWP] * pr[C_CX + c - INWP];
            if (pos < len - 1) a += cw[1024 + c] * pr[C_CC + c + INWP] * pr[C_CX + c + INWP];
            MIX[(size_t)r * DM + c] = (bf16_t)f2bf(pr[C_CB + c] * a); }
#pragma unroll 1
        for (int d = 0; d < 2; ++d) {
            const float* lr = pr + (d ? C_LRB : C_LRF);
#pragma unroll 1
            for (int j = 0; j < 4; ++j) { const int c = lane + 64 * j; float z = b2[d * 256 + c];
#pragma unroll
                for (int q = 0; q < 16; ++q) z += lr[q] * w2[(d * 16 + q) * 256 + c];
                (d ? ALB : ALF)[(size_t)r * 256 + c] = expf(log_sigmoid_f(z) * (1.0f / 16.0f)); }
        }
        if (r < TL) {
            const int half = lane >> 5, i = lane & 31;
            const float invf = powf(10000.0f, -(float)i / 32.0f);
            const float ang = (float)(half ? (pos % 64) : (pos / 64)) * invf;
            float sn, cs; sincosf(ang, &sn, &cs);
#pragma unroll 2
            for (int h = 0; h < 8; ++h) { const float* q = pr + C_SQ + h * 128 + half * 64; const float x1 = q[i], x2 = q[32 + i];
                float* o = QR + (size_t)r * 1024 + h * 128 + half * 64;
                o[i] = (x1 * cs - x2 * sn) * 0.08838834764831845f; o[32 + i] = (x2 * cs + x1 * sn) * 0.08838834764831845f; }
#pragma unroll
            for (int h = 0; h < 2; ++h) { const float* k = pr + C_SK + h * 128 + half * 64; const float x1 = k[i], x2 = k[32 + i];
                float* o = KR + (size_t)r * 256 + h * 128 + half * 64;
                o[i] = x1 * cs - x2 * sn; o[32 + i] = x2 * cs + x1 * sn; }
        }
    }
}

__device__ __forceinline__ void gla_scan(const Params& p, int s, int t, int lane, LAS float* sh) {
    const int dir = s >> 3, b = (s >> 2) & 1, h = s & 3;
    const float* P = (const float*)(p.ws + WS_P);
    const float* AL = (const float*)(p.ws + (dir ? WS_ALB : WS_ALF));
    float* O = (float*)(p.ws + (dir ? WS_OB : WS_OF));
    float S[64];
#pragma unroll
    for (int k = 0; k < 64; ++k) S[k] = 0.f;
    constexpr int NST = CTXL + SEQ;
#define GLA_ROW(i) ((i) < CTXL ? TL + b * CTXL + (dir ? CTXL - 1 - (i) : (i)) : b * SEQ + (dir ? SEQ - 1 - ((i) - CTXL) : ((i) - CTXL)))
    int row = GLA_ROW(0);
    float nq = P[(size_t)row * INWP + C_GQ + h * 64 + lane], nk = P[(size_t)row * INWP + C_GK + h * 64 + lane],
          na = AL[(size_t)row * 256 + h * 64 + lane], nv = P[(size_t)row * INWP + C_GV + h * 128 + t];
    for (int i = 0; i < NST; ++i) {
        const float cq = nq * 0.125f, ck = nk, ca = na, cv = nv; const int crow = row;
        if (i + 1 < NST) { row = GLA_ROW(i + 1);
            nq = P[(size_t)row * INWP + C_GQ + h * 64 + lane]; nk = P[(size_t)row * INWP + C_GK + h * 64 + lane];
            na = AL[(size_t)row * 256 + h * 64 + lane]; nv = P[(size_t)row * INWP + C_GV + h * 128 + t]; }
        sh[lane] = cq; sh[64 + lane] = ck; sh[128 + lane] = ca;
        LDS_FENCE();
        float o = 0.f;
#pragma unroll
        for (int k = 0; k < 64; k += 4) {
            const f32x4 q4 = *(const LAS f32x4*)(sh + k), k4 = *(const LAS f32x4*)(sh + 64 + k), a4 = *(const LAS f32x4*)(sh + 128 + k);
            S[k + 0] = a4.x * S[k + 0] + k4.x * cv; o += q4.x * S[k + 0];
            S[k + 1] = a4.y * S[k + 1] + k4.y * cv; o += q4.y * S[k + 1];
            S[k + 2] = a4.z * S[k + 2] + k4.z * cv; o += q4.z * S[k + 2];
            S[k + 3] = a4.w * S[k + 3] + k4.w * cv; o += q4.w * S[k + 3];
        }
        O[(size_t)crow * 512 + h * 128 + t] = o;
        LDS_FENCE();
    }
#undef GLA_ROW
}

__device__ __forceinline__ void swa_item(LAS float* qs, LAS float* ps, const float* kA, size_t ksA, const float* vA, size_t vsA, int nA,
                                         const float* kB, size_t ksB, const float* vB, size_t vsB, int nB, float sink, bf16_t* out, int lane) {
    const int ntot = nA + nB;
    float mx = sink;
    for (int j = lane; j < ntot; j += 64) {
        const float* kr = j < nA ? kA + (size_t)j * ksA : kB + (size_t)(j - nA) * ksB;
        float s = 0.f;
#pragma unroll 8
        for (int d = 0; d < 128; d += 4) { const f32x4 kv = *(const f32x4*)(kr + d); const f32x4 qv = *(const LAS f32x4*)(qs + d); s += kv.x * qv.x + kv.y * qv.y + kv.z * qv.z + kv.w * qv.w; }
        ps[j] = s; mx = fmaxf(mx, s);
    }
    mx = wave_max(mx);
    float sum = 0.f;
    for (int j = lane; j < ntot; j += 64) { const float e = expf(ps[j] - mx); ps[j] = e; sum += e; }
    sum = wave_sum(sum) + expf(sink - mx);
    LDS_FENCE();
    const float inv = 1.0f / sum;
    float o0 = 0.f, o1 = 0.f;
#pragma unroll 4
    for (int j = 0; j < ntot; ++j) { const float* vr = j < nA ? vA + (size_t)j * vsA : vB + (size_t)(j - nA) * vsB; const float pj = ps[j]; o0 += pj * vr[lane]; o1 += pj * vr[lane + 64]; }
    out[lane] = (bf16_t)f2bf(o0 * inv); out[lane + 64] = (bf16_t)f2bf(o1 * inv);
    LDS_FENCE();
}

__device__ __forceinline__ void phase_mixers(const Params& p, int l, LAS unsigned char* lds, int tid, int lane, int wave, int bid, int G) {
    LAS float* wl = (LAS float*)(lds + wave * 16384);
    if (wave < 2) {
        for (int s = bid; s < 16; s += G) gla_scan(p, s, tid, lane, wl);
        return;
    }
    const int gw = bid * 6 + (wave - 2), NGW = G * 6;
    const float* P = (const float*)(p.ws + WS_P);
    const float* QR = (const float*)(p.ws + WS_QR); const float* KR = (const float*)(p.ws + WS_KR);
    bf16_t* MIX = (bf16_t*)(p.ws + WS_MIX);
    const float* sinkp = p.in[I_SINK] + l * 8;
    LAS float* qs = wl; LAS float* ps = wl + 128;
    const bool with_ctx = (l < DEPTH - 1);
    const int nItems = (with_ctx ? TA : TL) * 8;
    for (int it = gw; it < nItems; it += NGW) {
        const int r = it >> 3, hq = it & 7, hk = hq >> 2;
        bf16_t* out = MIX + (size_t)r * DM + 1024 + hq * 128;
        if (r < TL) {
            const int b = r / SEQ, n = r % SEQ;
            qs[lane] = QR[(size_t)r * 1024 + hq * 128 + lane]; qs[lane + 64] = QR[(size_t)r * 1024 + hq * 128 + lane + 64];
            LDS_FENCE();
            const int lo = n - 128 < 0 ? 0 : n - 128, hi = n + 128 > SEQ - 1 ? SEQ - 1 : n + 128;
            const size_t r0 = (size_t)b * SEQ + lo, c0 = (size_t)TL + (size_t)b * CTXL;
            swa_item(qs, ps, KR + r0 * 256 + hk * 128, 256, P + r0 * INWP + C_SV + hk * 128, INWP, hi - lo + 1,
                     P + c0 * INWP + C_SK + hk * 128, INWP, P + c0 * INWP + C_SV + hk * 128, INWP, CTXL, sinkp[hq], out, lane);
        } else {
            const int b = (r - TL) / CTXL;
            const float* q = P + (size_t)r * INWP + C_SQ + hq * 128;
            qs[lane] = q[lane] * 0.08838834764831845f; qs[lane + 64] = q[lane + 64] * 0.08838834764831845f;
            LDS_FENCE();
            const size_t c0 = (size_t)TL + (size_t)b * CTXL;
            swa_item(qs, ps, P, 0, P, 0, 0, P + c0 * INWP + C_SK + hk * 128, INWP, P + c0 * INWP + C_SV + hk * 128, INWP, CTXL, sinkp[hq], out, lane);
        }
    }
}

__device__ __forceinline__ void phase_gla_finish(const Params& p, int l, int lane, int wave, int bid, int G) {
    const int gw = bid * NWAVES + wave, NGW = G * NWAVES;
    const float* P = (const float*)(p.ws + WS_P);
    const float* OF = (const float*)(p.ws + WS_OF); const float* OB = (const float*)(p.ws + WS_OB);
    bf16_t* MIX = (bf16_t*)(p.ws + WS_MIX);
    const float* nw = p.in[I_GNORM] + l * 128;
    for (int r = gw; r < TA; r += NGW) {
#pragma unroll
        for (int h = 0; h < 4; ++h) {
            const size_t o = (size_t)r * 512 + h * 128;
            const float a0 = OF[o + lane] + OB[o + lane], a1 = OF[o + lane + 64] + OB[o + lane + 64];
            const float ms = wave_sum(a0 * a0 + a1 * a1) * (1.0f / 128.0f);
            const float rs = 1.0f / sqrtf(ms + LN_EPS);
            const float g0 = P[(size_t)r * INWP + C_GG + h * 128 + lane], g1 = P[(size_t)r * INWP + C_GG + h * 128 + lane + 64];
            MIX[(size_t)r * DM + 512 + h * 128 + lane] = (bf16_t)f2bf(a0 * rs * nw[lane] * silu_f(g0));
            MIX[(size_t)r * DM + 512 + h * 128 + lane + 64] = (bf16_t)f2bf(a1 * rs * nw[lane + 64] * silu_f(g1));
        }
    }
}

__device__ __forceinline__ void ln_row(f32x4 (&v)[8], const float* lg, const float* lb, int lane) {
    float s = 0.f;
#pragma unroll
    for (int j = 0; j < 8; ++j) s += (v[j].x + v[j].y) + (v[j].z + v[j].w);
    const float mean = wave_sum(s) * (1.0f / DM);
    float s2 = 0.f;
#pragma unroll
    for (int j = 0; j < 8; ++j) { v[j] = v[j] - mean; s2 += (v[j].x * v[j].x + v[j].y * v[j].y) + (v[j].z * v[j].z + v[j].w * v[j].w); }
    const float rstd = 1.0f / sqrtf(wave_sum(s2) * (1.0f / DM) + LN_EPS);
#pragma unroll
    for (int j = 0; j < 8; ++j) { const int c = lane * 4 + 256 * j; const f32x4 g = *(const f32x4*)(lg + c), b = *(const f32x4*)(lb + c); v[j] = v[j] * rstd * g + b; }
}

__device__ __forceinline__ void phase_ln1(const Params& p, int l, int lane, int wave, int bid, int G) {
    const int gw = bid * NWAVES + wave, NGW = G * NWAVES;
    const float* MOD = (const float*)(p.ws + WS_MOD); const float* Y = (const float*)(p.ws + WS_Y);
    float* XL = (float*)(p.ws + WS_XL); bf16_t* HB = (bf16_t*)(p.ws + WS_HB);
    const float* lg = p.in[I_LNG] + (size_t)(l * 2 + 0) * DM; const float* lb = p.in[I_LNB] + (size_t)(l * 2 + 0) * DM;
    for (int r = gw; r < TA; r += NGW) {
        const float* mod = MOD + (size_t)(l * 3 + row_stream(r)) * 6 * DM;
        const float* xr = xsrc(p, l, r);
        f32x4 v[8];
#pragma unroll
        for (int j = 0; j < 8; ++j) { const int c = lane * 4 + 256 * j; const f32x4 x = *(const f32x4*)(xr + c), y = *(const f32x4*)(Y + (size_t)r * DM + c), g = *(const f32x4*)(mod + 2 * DM + c); v[j] = x * DN_ALPHA + g * y; }
        ln_row(v, lg, lb, lane);
#pragma unroll
        for (int j = 0; j < 8; ++j) { const int c = lane * 4 + 256 * j; *(f32x4*)(XL + (size_t)r * DM + c) = v[j];
            const f32x4 sh = *(const f32x4*)(mod + 3 * DM + c), s = *(const f32x4*)(mod + 4 * DM + c);
            u32x2 o; o.x = pk2(v[j].x * (1.f + s.x) + sh.x, v[j].y * (1.f + s.y) + sh.y); o.y = pk2(v[j].z * (1.f + s.z) + sh.z, v[j].w * (1.f + s.w) + sh.w);
            *(u32x2*)(HB + (size_t)r * DM + c) = o; }
    }
}

__device__ __forceinline__ void wave_argmax(float& v, int& idx) {
#pragma unroll
    for (int o = 1; o < 64; o <<= 1) { const float ov = __shfl_xor(v, o); const int oi = __shfl_xor(idx, o); if (ov > v || (ov == v && oi < idx)) { v = ov; idx = oi; } }
}
__device__ __forceinline__ void phase_peer(const Params& p, int l, LAS unsigned char* lds, int lane, int wave, int bid, int G) {
    const int gw = bid * NWAVES + wave, NGW = G * NWAVES;
    const float* MOD = (const float*)(p.ws + WS_MOD); const float* QP = (const float*)(p.ws + WS_QP);
    float* XL = (float*)(p.ws + WS_XL); bf16_t* HB = (bf16_t*)(p.ws + WS_HB);
    const float* lg = p.in[I_LNG] + (size_t)(l * 2 + 1) * DM; const float* lb = p.in[I_LNB] + (size_t)(l * 2 + 1) * DM;
    const float* sub = p.in[I_PSUB] + (size_t)l * 2 * 128 * 128;
    const float* U = p.in[I_PU] + (size_t)l * NEXP * DM; const float* V = p.in[I_PV] + (size_t)l * NEXP * DM;
    LAS float* qs = (LAS float*)(lds + wave * 16384);
    LAS int* eidx = (LAS int*)(qs + 256);
    LAS float* egate = (LAS float*)(eidx + 128);
    const bool last = (l == DEPTH - 1);
    const int nrows = last ? TL : TA;
    for (int r = gw; r < nrows; r += NGW) {
        const float* mod = MOD + (size_t)(l * 3 + row_stream(r)) * 6 * DM;
        for (int h = 0; h < 8; ++h) {
            const float* q = QP + (size_t)r * DM + h * 256;
            qs[lane] = q[lane]; qs[lane + 64] = q[lane + 64]; qs[lane + 128] = q[lane + 128]; qs[lane + 192] = q[lane + 192];
            LDS_FENCE();
            float tv[2]; int ti[2];
#pragma unroll
            for (int pp = 0; pp < 2; ++pp) {
                const float* k0 = sub + (size_t)(pp * 128 + lane) * 128; const float* k1 = k0 + 64 * 128;
                float s0 = 0.f, s1 = 0.f;
#pragma unroll 8
                for (int d = 0; d < 128; d += 4) { const f32x4 qv = *(const LAS f32x4*)(qs + pp * 128 + d); const f32x4 a = *(const f32x4*)(k0 + d), b = *(const f32x4*)(k1 + d);
                    s0 += a.x * qv.x + a.y * qv.y + a.z * qv.z + a.w * qv.w; s1 += b.x * qv.x + b.y * qv.y + b.z * qv.z + b.w * qv.w; }
                float mv = 0.f; int mi = 0;
                for (int it = 0; it < 16; ++it) {
                    float v = s0 >= s1 ? s0 : s1; int idx = s0 >= s1 ? lane : lane + 64;
                    wave_argmax(v, idx);
                    if (lane == it) { mv = v; mi = idx; }
                    if (idx == lane) s0 = -INFINITY; if (idx == lane + 64) s1 = -INFINITY;
                }
                tv[pp] = mv; ti[pp] = mi;
            }
            float cv[4];
            const float ai = __shfl(tv[0], lane >> 2);
#pragma unroll
            for (int m = 0; m < 4; ++m) cv[m] = ai + __shfl(tv[1], (lane & 3) * 4 + m);
            float bv = 0.f; int bc = 0;
            for (int it = 0; it < 16; ++it) {
                float v = cv[0]; int idx = lane * 4;
#pragma unroll
                for (int m = 1; m < 4; ++m) if (cv[m] > v) { v = cv[m]; idx = lane * 4 + m; }
                wave_argmax(v, idx);
                if (lane == it) { bv = v; bc = idx; }
#pragma unroll
                for (int m = 0; m < 4; ++m) if (idx == lane * 4 + m) cv[m] = -INFINITY;
            }
            const int i1 = __shfl(ti[0], bc >> 4), i2 = __shfl(ti[1], bc & 15);
            const float bmax = __shfl(bv, 0);
            float e = lane < 16 ? expf(bv - bmax) : 0.f;
            const float esum = wave_sum(e);
            if (lane < 16) { eidx[h * 16 + lane] = i1 * 128 + i2; egate[h * 16 + lane] = e / esum; }
            LDS_FENCE();
        }
        const float* xr = XL + (size_t)r * DM;
        f32x4 xv[8], hv[8], yv[8];
#pragma unroll
        for (int j = 0; j < 8; ++j) { const int c = lane * 4 + 256 * j; xv[j] = *(const f32x4*)(xr + c);
            const f32x4 sh = *(const f32x4*)(mod + 3 * DM + c), s = *(const f32x4*)(mod + 4 * DM + c); hv[j] = xv[j] * (1.f + s) + sh; yv[j] = (f32x4){0.f, 0.f, 0.f, 0.f}; }
        for (int j = 0; j < 128; ++j) {
            const int e = eidx[j]; const float gt = egate[j];
            const float* ur = U + (size_t)e * DM; const float* vr = V + (size_t)e * DM;
            float d = 0.f;
#pragma unroll
            for (int q = 0; q < 8; ++q) { const f32x4 u = *(const f32x4*)(ur + lane * 4 + 256 * q); d += (u.x * hv[q].x + u.y * hv[q].y) + (u.z * hv[q].z + u.w * hv[q].w); }
            d = wave_sum(d);
            const float w = gelu_f(d) * gt;
#pragma unroll
            for (int q = 0; q < 8; ++q) { const f32x4 vv = *(const f32x4*)(vr + lane * 4 + 256 * q); yv[q] += vv * w; }
        }
#pragma unroll
        for (int j = 0; j < 8; ++j) { const int c = lane * 4 + 256 * j; const f32x4 g = *(const f32x4*)(mod + 5 * DM + c); xv[j] = xv[j] * DN_ALPHA + g * yv[j]; }
        ln_row(xv, lg, lb, lane);
        float* dst = (last ? p.out : XL) + (size_t)r * DM;
#pragma unroll
        for (int j = 0; j < 8; ++j) { const int c = lane * 4 + 256 * j; *(f32x4*)(dst + c) = xv[j]; }
        if (!last) {
            const float* modn = MOD + (size_t)((l + 1) * 3 + row_stream(r)) * 6 * DM;
#pragma unroll
            for (int j = 0; j < 8; ++j) { const int c = lane * 4 + 256 * j; const f32x4 sh = *(const f32x4*)(modn + c), s = *(const f32x4*)(modn + DM + c);
                u32x2 o; o.x = pk2(xv[j].x * (1.f + s.x) + sh.x, xv[j].y * (1.f + s.y) + sh.y); o.y = pk2(xv[j].z * (1.f + s.z) + sh.z, xv[j].w * (1.f + s.w) + sh.w);
                *(u32x2*)(HB + (size_t)r * DM + c) = o; }
        }
        LDS_FENCE();
    }
}

enum { K_PRO = 0, K_MOD0, K_GIN, K_POST, K_MIX, K_GFIN, K_GOUT, K_LN1, K_GQ, K_PEER };
template <int KIND>
__global__ void __launch_bounds__(NTHREADS, 2) phase_kernel(Params p, int l) {
    extern __shared__ __attribute__((aligned(16))) unsigned char lds_raw[];
    LAS unsigned char* lds = (LAS unsigned char*)lds_raw;
    const int tid = threadIdx.x, lane = tid & 63, wave = __builtin_amdgcn_readfirstlane(tid >> 6), bid = blockIdx.x, G = gridDim.x;
    const int gw = bid * NWAVES + wave, NGW = G * NWAVES;
    if (KIND == K_PRO) phase_prologue(p, lds, tid, lane, wave, bid, G);
    if (KIND == K_MOD0) phase_modulate0(p, lane, wave, bid, G);
    if (KIND == K_GIN) gemm_direct((const bf16_t*)(p.ws + WS_HB), (const bf16_t*)(p.ws + WS_WIN) + (size_t)l * INWP * DM, (float*)(p.ws + WS_P), TA, INWP, DM, INWP, gw, NGW, lane);
    if (KIND == K_POST) phase_post_in(p, l, lane, wave, bid, G);
    if (KIND == K_MIX) phase_mixers(p, l, lds, tid, lane, wave, bid, G);
    if (KIND == K_GFIN) phase_gla_finish(p, l, lane, wave, bid, G);
    if (KIND == K_GOUT) gemm_direct((const bf16_t*)(p.ws + WS_MIX), (const bf16_t*)(p.ws + WS_WOUT) + (size_t)l * DM * DM, (float*)(p.ws + WS_Y), TA, DM, DM, DM, gw, NGW, lane);
    if (KIND == K_LN1) phase_ln1(p, l, lane, wave, bid, G);
    if (KIND == K_GQ) gemm_direct((const bf16_t*)(p.ws + WS_HB), (const bf16_t*)(p.ws + WS_WQ) + (size_t)l * DM * DM, (float*)(p.ws + WS_QP), TA, DM, DM, DM, gw, NGW, lane);
    if (KIND == K_PEER) phase_peer(p, l, lds, lane, wave, bid, G);
}

template <int KIND> static void launch_phase(const Params& p, int l, int grid, hipStream_t stream) {
    static bool attr = false;
    if (!attr) { (void)hipFuncSetAttribute((const void*)phase_kernel<KIND>, hipFuncAttributeMaxDynamicSharedMemorySize, LDS_BYTES); attr = true; }
    hipLaunchKernelGGL(phase_kernel<KIND>, dim3(grid), dim3(NTHREADS), LDS_BYTES, stream, p, l);
}
extern "C" void kernel_launch(void* const* d_in, const int* in_sizes, int n_in, void* d_out, int out_size, void* d_ws, size_t ws_size, hipStream_t stream) {
    static int grid = 0;
    if (grid == 0) {
        if (n_in != 19 || out_size != TL * DM || ws_size < WS_END) { fprintf(stderr, "kernel_launch: unexpected shapes (n_in %d out %d ws %zu)\n", n_in, out_size, ws_size); grid = -1; return; }
        int dev = 0, cus = 0;
        if (hipGetDevice(&dev) != hipSuccess || hipDeviceGetAttribute(&cus, hipDeviceAttributeMultiprocessorCount, dev) != hipSuccess) { grid = -1; return; }
        grid = cus;
    }
    if (grid < 0) return;
    Params p{};
    for (int i = 0; i < 19; ++i) p.in[i] = (const float*)d_in[i];
    p.out = (float*)d_out; p.ws = (unsigned char*)d_ws;
    launch_phase<K_PRO>(p, 0, grid, stream);
    launch_phase<K_MOD0>(p, 0, grid, stream);
    for (int l = 0; l < DEPTH; ++l) {
        launch_phase<K_GIN>(p, l, grid, stream);
        launch_phase<K_POST>(p, l, grid, stream);
        launch_phase<K_MIX>(p, l, grid, stream);
        launch_phase<K_GFIN>(p, l, grid, stream);
        launch_phase<K_GOUT>(p, l, grid, stream);
        launch_phase<K_LN1>(p, l, grid, stream);
        launch_phase<K_GQ>(p, l, grid, stream);
        launch_phase<K_PEER>(p, l, grid, stream);
    }
}
```

```cpp
#include <hip/hip_runtime.h>
#include <cstdio>
#include <cstdint>

#define LAS __attribute__((address_space(3)))
typedef unsigned short bf16_t;
typedef short bf16x8 __attribute__((ext_vector_type(8)));
typedef float f32x4 __attribute__((ext_vector_type(4)));
typedef unsigned u32x4 __attribute__((ext_vector_type(4)));
typedef unsigned u32x2 __attribute__((ext_vector_type(2)));

constexpr int DM = 2048, NBATCH = 2, SEQ = 8192, DEPTH = 4, CTXL = 256;
constexpr int TL = NBATCH * SEQ, TC = NBATCH * CTXL, TA = TL + TC;
constexpr int INW = 4640, INWP = 4864;
constexpr int C_CX = 0, C_CB = 512, C_CC = 1024, C_GQ = 1536, C_GK = 1792, C_GV = 2048, C_GG = 2560, C_LRF = 3072, C_LRB = 3088,
              C_SQ = 3104, C_SK = 4128, C_SV = 4384;
constexpr int NEXP = 16384;
constexpr float DN_ALPHA = 1.6817928305074290f;
constexpr float LN_EPS = 1e-6f;
constexpr int NWAVES = 8, NTHREADS = 512;

constexpr size_t MiB = 1u << 20;
constexpr size_t WS_CTL = 0, CTL_ZERO_BYTES = 2 * MiB;
constexpr size_t WS_MOD = 2 * MiB;
constexpr size_t WS_WIN = 4 * MiB;
constexpr size_t WS_WOUT = 80 * MiB;
constexpr size_t WS_WQ = 112 * MiB;
constexpr size_t WS_XL = 144 * MiB;
constexpr size_t WS_HB = 276 * MiB;
constexpr size_t WS_P = 342 * MiB;
constexpr size_t WS_QR = 656 * MiB;
constexpr size_t WS_KR = 720 * MiB;
constexpr size_t WS_ALF = 736 * MiB;
constexpr size_t WS_ALB = 753 * MiB;
constexpr size_t WS_OF = 770 * MiB;
constexpr size_t WS_OB = 803 * MiB;
constexpr size_t WS_MIX = 836 * MiB;
constexpr size_t WS_Y = 902 * MiB;
constexpr size_t WS_QP = 1034 * MiB;
constexpr size_t WS_END = 1166 * MiB;
static_assert(WS_WIN + (size_t)4 * INWP * DM * 2 <= WS_WOUT, "map");
static_assert(WS_P + (size_t)TA * INWP * 4 <= WS_QR, "map");
static_assert(WS_XL + (size_t)TA * DM * 4 <= WS_HB, "map");
constexpr int CW_BAR = 4096;
constexpr int LDS_BYTES = 147456;
constexpr int MISC_OFF = 131072 + 320;

#define XB_TMO      128
#define XB_XCNT(j)  (256  + 64 * (j))
#define XB_XSUB(j)  (1280 + 64 * (j))
#define XB_XGEN(j)  (2304 + 64 * (j))
#define XB_TOP      3328
#define XB_TOPGEN   3392
#define XCD_BAR_WORDS 3456
#define XB_SPIN_CAP (1u << 18)
__device__ __forceinline__ unsigned xb_ld(unsigned* p)              { return __hip_atomic_load(p, __ATOMIC_RELAXED, __HIP_MEMORY_SCOPE_AGENT); }
__device__ __forceinline__ unsigned xb_add(unsigned* p, unsigned v) { return __hip_atomic_fetch_add(p, v, __ATOMIC_RELAXED, __HIP_MEMORY_SCOPE_AGENT); }
__device__ __forceinline__ unsigned xb_xcc_id() { return (unsigned)__builtin_amdgcn_s_getreg((3 << 11) | 20) & 0xFu; }
#define XB_SPIN(cond, bar) do { unsigned _sp = 0; while (cond) { __builtin_amdgcn_s_sleep(1); \
    if ((++_sp & 255u) == 0u) { if (xb_ld(&(bar)[XB_TMO])) break; if (_sp > XB_SPIN_CAP) { atomicAdd(&(bar)[XB_TMO], 1u); break; } } } } while (0)
struct XcdBarrier { unsigned* bar; unsigned x; volatile LAS unsigned* st; };
__device__ __forceinline__ XcdBarrier xcd_barrier_post(unsigned* bar, volatile LAS unsigned* st) {
    XcdBarrier b; b.bar = bar; b.x = xb_xcc_id(); b.st = st;
    if (threadIdx.x == 0) (void)xb_add(&bar[XB_XCNT(b.x)], 1u);
    return b;
}
__device__ __forceinline__ void xcd_barrier_complete(unsigned* bar, unsigned x, unsigned& nloc, unsigned& nx) {
    const unsigned G = gridDim.x * gridDim.y * gridDim.z;
    unsigned sum, cnt, mine, sp = 0u;
    for (;;) {
        sum = 0u; cnt = 0u; mine = 0u;
#pragma unroll
        for (unsigned j = 0; j < 16; ++j) { const unsigned c = xb_ld(&bar[XB_XCNT(j)]); sum += c; cnt += (c > 0u) ? 1u : 0u; mine = (j == x) ? c : mine; }
        if (sum == G) break;
        __builtin_amdgcn_s_sleep(1);
        if ((++sp & 255u) == 0u) { if (xb_ld(&bar[XB_TMO])) break; if (sp > XB_SPIN_CAP) { atomicAdd(&bar[XB_TMO], 1u); break; } }
    }
    nloc = mine > 0u ? mine : 1u; nx = cnt > 0u ? cnt : 1u;
}
__device__ __forceinline__ void xcd_barrier(const XcdBarrier& b) {
    asm volatile("s_waitcnt vmcnt(0)" ::: "memory");
    __syncthreads();
    if (threadIdx.x == 0) {
        unsigned* bar = b.bar;
        __builtin_amdgcn_s_waitcnt(0);
        unsigned nloc = b.st[0], nx = b.st[1];
        if (nloc == 0u) { xcd_barrier_complete(bar, b.x, nloc, nx); b.st[0] = nloc; b.st[1] = nx; }
        const unsigned old = xb_add(&bar[XB_XSUB(b.x)], 1u);
        const unsigned gen = old / nloc;
        if (old + 1u == (gen + 1u) * nloc) {
            __builtin_amdgcn_fence(__ATOMIC_RELEASE, "agent");
            asm volatile("s_waitcnt vmcnt(0)" ::: "memory");
            const unsigned og = xb_add(&bar[XB_TOP], 1u);
            const unsigned tg = og / nx;
            if (og + 1u == (tg + 1u) * nx) xb_add(&bar[XB_TOPGEN], 1u);
            else XB_SPIN(xb_ld(&bar[XB_TOPGEN]) == tg, bar);
            __builtin_amdgcn_fence(__ATOMIC_ACQUIRE, "agent");
            xb_add(&bar[XB_XGEN(b.x)], 1u);
            asm volatile("s_waitcnt vmcnt(0)" ::: "memory");
        } else {
            XB_SPIN(xb_ld(&bar[XB_XGEN(b.x)]) == gen, bar);
            __builtin_amdgcn_fence(__ATOMIC_ACQUIRE, "agent");
            asm volatile("s_waitcnt vmcnt(0)" ::: "memory");
        }
    }
    __syncthreads();
}

namespace pg8 {
#define PG8_LAS __attribute__((address_space(3)))
typedef unsigned short bf16_t;
typedef short bf16x8 __attribute__((ext_vector_type(8)));
typedef float f32x4 __attribute__((ext_vector_type(4)));
typedef unsigned u32x4 __attribute__((ext_vector_type(4)));
constexpr int BM = 256, BK = 64, HALF = 128, HTB = HALF * BK * 2  , STAGE_BYTES = 8 * HTB, NXCD = 8, WGM = 8;

__host__ __device__ __forceinline__ int lds_byte(int r, int c) { const int st = (r >> 4) * 2 + (c >> 5), rr = r & 15, cc = c & 31, ob = rr * 64 + cc * 2; return st * 1024 + (ob ^ (((ob >> 9) & 1) << 5)); }
__host__ __device__ __forceinline__ void stage_rc(int b, int& R, int& C) { const int st = b / 1024, sb = b % 1024, swz = sb ^ (((sb >> 9) & 1) << 5); R = (st >> 1) * 16 + swz / 64; C = (st & 1) * 32 + (swz % 64) / 2; }
__host__ __device__ __forceinline__ int perm32(int rho) { const int n = rho >> 4, i = rho & 15; return 8 * (i >> 2) + 4 * n + (i & 3); }

struct Unit { int pm, pn; };
struct Gemm { const bf16_t* A; const bf16_t* Bt; int M, N, K; };

struct StaticOrder {
    int nM, nN, nwg, G, c;
    __host__ __device__ void init(int M, int N, int G_, int c_) { nM = M / BM; nN = N / BM; nwg = nM * nN; G = G_; c = c_; }
    __host__ __device__ bool next(int i, Unit& u) const {
        const long L = (long)i * G + c; if (L >= nwg) return false;
        int wgid = (int)L; { const int q = nwg / NXCD, r = nwg % NXCD, xcd = wgid % NXCD, off = wgid / NXCD; wgid = (xcd < r ? xcd * (q + 1) : r * (q + 1) + (xcd - r) * q) + off; }
        const int nig = WGM * nN, gid = wgid / nig, fm = gid * WGM, gsz = (nM - fm) < WGM ? (nM - fm) : WGM;
        u.pm = fm + ((wgid % nig) % gsz); u.pn = (wgid % nig) / gsz; return true;
    }
    __device__ __forceinline__ void a_ready(const Unit&) const {}
    __device__ __forceinline__ void done(const Unit&) const {}
};

__device__ __forceinline__ unsigned cvt_pk_bf16(float lo, float hi) { unsigned r; asm volatile("v_cvt_pk_bf16_f32 %0, %1, %2" : "=v"(r) : "v"(lo), "v"(hi)); return r; }
typedef float f32x2 __attribute__((ext_vector_type(2)));
__device__ __forceinline__ f32x2 gelu_pk(f32x2 v) {
    const f32x2 av = __builtin_elementwise_abs(v), d = av * 0.2316418882f + 1.0f;
    f32x2 t; t.x = __builtin_amdgcn_rcpf(d.x); t.y = __builtin_amdgcn_rcpf(d.y);
    f32x2 q = t * 0.5307027145f + (-0.7265760135f); q = q * t + 0.7107068705f; q = q * t + (-0.142248368f); q = q * t + 0.127414796f; q = q * t;
    const f32x2 s = (v * v) * (-0.72134752044f);
    f32x2 e; e.x = __builtin_amdgcn_exp2f(s.x); e.y = __builtin_amdgcn_exp2f(s.y);
    const f32x2 m = v * (q * e), r = v - m;
    f32x2 o; o.x = v.x < 0.f ? m.x : r.x; o.y = v.y < 0.f ? m.y : r.y; return o;
}

template <int ACT  > struct EpiBf16 {
    static constexpr bool PERM = true, AFTER_DRAIN = false; static_assert(ACT == 0 || ACT == 1, "EpiBf16: ACT is 0 (none) or 1 (gelu_pk)");
    bf16_t* O; int ldc; const float* bias; int split_cols; size_t split_stride; float scale0;
    __device__ __forceinline__ void operator()(const f32x4 (&acc)[2][2][4][2], const Unit& u, int wr, int wc, int fr, int fq) const {
        const int row0 = u.pm * BM + wr * 64 + fr; int colt = u.pn * BM; bf16_t* base = O;
        float sc = 1.f; if (split_cols) { const int t = colt / split_cols; base += (size_t)t * split_stride; colt -= t * split_cols; if (t == 0) sc = scale0; }
        const int col0 = colt + wc * 32 + 8 * fq, bcol0 = u.pn * BM + wc * 32 + 8 * fq;
        f32x4 bv[2][2];
#pragma unroll
        for (int bj = 0; bj < 2; ++bj)
#pragma unroll
            for (int n = 0; n < 2; ++n) bv[bj][n] = bias ? *(const f32x4*)(bias + bcol0 + bj * HALF + 4 * n) : (f32x4){0.f, 0.f, 0.f, 0.f};
#pragma unroll
        for (int ai = 0; ai < 2; ++ai)
#pragma unroll
            for (int m = 0; m < 4; ++m) { bf16_t* rowp = base + (size_t)(row0 + ai * HALF + m * 16) * ldc + col0;
#pragma unroll
                for (int bj = 0; bj < 2; ++bj) { f32x4 v0 = acc[ai][bj][m][0] + bv[bj][0], v1 = acc[ai][bj][m][1] + bv[bj][1];
                    if (ACT == 1) { f32x2 a = gelu_pk((f32x2){v0[0], v0[1]}), b = gelu_pk((f32x2){v0[2], v0[3]}), c = gelu_pk((f32x2){v1[0], v1[1]}), d = gelu_pk((f32x2){v1[2], v1[3]});
                        v0 = (f32x4){a.x, a.y, b.x, b.y}; v1 = (f32x4){c.x, c.y, d.x, d.y}; }
                    v0 = v0 * sc; v1 = v1 * sc; u32x4 w; w.x = cvt_pk_bf16(v0[0], v0[1]); w.y = cvt_pk_bf16(v0[2], v0[3]); w.z = cvt_pk_bf16(v1[0], v1[1]); w.w = cvt_pk_bf16(v1[2], v1[3]);
                    *(u32x4*)(rowp + bj * HALF) = w; } }
    }
};


struct EpiF32 {
    static constexpr bool PERM = false, AFTER_DRAIN = false;
    float* C; int ldc; const float* bias;
    __device__ __forceinline__ void operator()(const f32x4 (&acc)[2][2][4][2], const Unit& u, int wr, int wc, int fr, int fq) const {
        const int row0 = u.pm * BM + wr * 64 + fr, col0 = u.pn * BM + wc * 32 + 4 * fq;
        f32x4 bv[2][2];
#pragma unroll
        for (int bj = 0; bj < 2; ++bj)
#pragma unroll
            for (int n = 0; n < 2; ++n) bv[bj][n] = bias ? *(const f32x4*)(bias + col0 + bj * HALF + n * 16) : (f32x4){0.f, 0.f, 0.f, 0.f};
#pragma unroll
        for (int ai = 0; ai < 2; ++ai)
#pragma unroll
            for (int m = 0; m < 4; ++m) { float* rowp = C + (size_t)(row0 + ai * HALF + m * 16) * ldc + col0;
#pragma unroll
                for (int bj = 0; bj < 2; ++bj)
#pragma unroll
                    for (int n = 0; n < 2; ++n) *(f32x4*)(rowp + bj * HALF + n * 16) = acc[ai][bj][m][n] + bv[bj][n]; }
    }
};

template <class Epi, class Sched, bool ALIGN_EPI = false, bool SP2 = false>
__device__ __forceinline__ void gemm_phase(PG8_LAS unsigned char* lds, const Gemm g, const Sched& S, const Epi& E) {
    const int tid = threadIdx.x, wid = __builtin_amdgcn_readfirstlane(tid >> 6), lane = tid & 63, wr = wid >> 2, wc = wid & 3, fr = lane & 15, fq = lane >> 4;
    const int K = g.K, nt = K / BK;
    unsigned voffA[2], voffB[2];
#pragma unroll
    for (int i = 0; i < 2; ++i) { int R, C; stage_rc(tid * 16 + i * 8192, R, C); const int Rb = Epi::PERM ? ((R & ~31) + perm32(R & 31)) : R;
        voffA[i] = (unsigned)(R * K + C) * 2u; voffB[i] = (unsigned)(Rb * K + C) * 2u; }
    const size_t kstep = (size_t)(BK * 2);
    const size_t hstep = (size_t)HALF * K * 2;
    const size_t tstep = 2 * hstep;
    const unsigned ldsw = (unsigned)wid * 1024u;
    const int aoff = lds_byte(wr * 64 + fr, fq * 8), boff = lds_byte(wc * 32 + fr, fq * 8);
#define PG8_SA(b, h) (((b) * 2 + (h)) * HTB)
#define PG8_SB(b, h) ((4 + (b) * 2 + (h)) * HTB)
#define PG8_STAGE(bufoff, gbase, voff) do { _Pragma("unroll") for (int _i = 0; _i < 2; ++_i) \
        __builtin_amdgcn_global_load_lds((const unsigned*)((const char*)(gbase) + (voff)[_i]), (PG8_LAS unsigned*)(lds + (bufoff) + ldsw + _i * 8192), 16, 0, 0); } while (0)
#define PG8_LDA(dst, b, h) do { _Pragma("unroll") for (int m = 0; m < 4; ++m) _Pragma("unroll") for (int k = 0; k < 2; ++k) dst[m][k] = *(const PG8_LAS bf16x8*)(lds + PG8_SA(b, h) + aoff + m * 2048 + k * 1024); } while (0)
#define PG8_LDB(dst, b, h) do { _Pragma("unroll") for (int n = 0; n < 2; ++n) _Pragma("unroll") for (int k = 0; k < 2; ++k) dst[n][k] = *(const PG8_LAS bf16x8*)(lds + PG8_SB(b, h) + boff + n * 2048 + k * 1024); } while (0)
#define PG8_MMA(ai, bj, At, Bt) do { __builtin_amdgcn_s_setprio(1); _Pragma("unroll") for (int m = 0; m < 4; ++m) _Pragma("unroll") for (int n = 0; n < 2; ++n) _Pragma("unroll") for (int k = 0; k < 2; ++k) \
        acc[ai][bj][m][n] = __builtin_amdgcn_mfma_f32_16x16x32_bf16(Bt[n][k], At[m][k], acc[ai][bj][m][n], 0, 0, 0); __builtin_amdgcn_s_setprio(0); } while (0)
#define PG8_WAIT_V(n) asm volatile("s_waitcnt vmcnt(" #n ")" ::: "memory")
#define PG8_WAIT_L(n) asm volatile("s_waitcnt lgkmcnt(" #n ")" ::: "memory")
#define PG8_BAR __builtin_amdgcn_s_barrier()
#define PG8_SCHED __builtin_amdgcn_sched_barrier(0)
    Unit cur, nxt; int ui = 0;
    if (!S.next(0, cur)) return;
    f32x4 acc[2][2][4][2];
#pragma unroll
    for (int a = 0; a < 2; ++a)
#pragma unroll
        for (int b = 0; b < 2; ++b)
#pragma unroll
            for (int m = 0; m < 4; ++m)
#pragma unroll
                for (int n = 0; n < 2; ++n) acc[a][b][m][n] = (f32x4){0.f, 0.f, 0.f, 0.f};
    bf16x8 At[4][2], B0[2][2], B1[2][2];
    const char* cA = (const char*)g.A + (size_t)cur.pm * tstep; const char* cB = (const char*)g.Bt + (size_t)cur.pn * tstep;
    S.a_ready(cur);
    if constexpr (SP2) {
        PG8_STAGE(PG8_SB(0, 0), cB, voffB); PG8_STAGE(PG8_SB(0, 1), cB + hstep, voffB); PG8_STAGE(PG8_SA(0, 0), cA, voffA); PG8_STAGE(PG8_SA(0, 1), cA + hstep, voffA);
        if (wr == 1) PG8_BAR;
        PG8_WAIT_V(2); PG8_BAR;
        PG8_STAGE(PG8_SB(1, 0), cB + kstep, voffB); PG8_STAGE(PG8_SA(1, 0), cA + kstep, voffA); PG8_STAGE(PG8_SB(1, 1), cB + hstep + kstep, voffB);
        PG8_WAIT_V(6); PG8_BAR;
    } else {
        PG8_STAGE(PG8_SB(0, 0), cB, voffB); PG8_STAGE(PG8_SA(0, 0), cA, voffA); PG8_STAGE(PG8_SB(0, 1), cB + hstep, voffB); PG8_STAGE(PG8_SA(0, 1), cA + hstep, voffA);
        if (wr == 1) PG8_BAR;
        PG8_WAIT_V(4); PG8_BAR;
        PG8_STAGE(PG8_SB(1, 0), cB + kstep, voffB); PG8_STAGE(PG8_SA(1, 0), cA + kstep, voffA); PG8_STAGE(PG8_SB(1, 1), cB + hstep + kstep, voffB);
        PG8_WAIT_V(6); PG8_BAR;
    }
    for (;;) {
        const bool has_next = S.next(ui + 1, nxt);
        const char* nA = has_next ? (const char*)g.A + (size_t)nxt.pm * tstep : cA; const char* nB = has_next ? (const char*)g.Bt + (size_t)nxt.pn * tstep : cB;
        for (int t = 0; t < nt; t += 2) {
            const bool last = (t == nt - 2);
            const char* a1 = cA + (size_t)(t + 1) * kstep;
            const char* a2 = last ? nA : cA + (size_t)(t + 2) * kstep; const char* b2 = last ? nB : cB + (size_t)(t + 2) * kstep;
            const char* a3 = a2 + kstep; const char* b3 = b2 + kstep;
            if (last && has_next) S.a_ready(nxt);
            if constexpr (SP2) {
            PG8_LDB(B0, 0, 0); PG8_LDB(B1, 0, 1); PG8_SCHED; PG8_LDA(At, 0, 0); PG8_STAGE(PG8_SA(1, 1), a1 + hstep, voffA);
            PG8_WAIT_V(8); PG8_WAIT_L(0); PG8_BAR; PG8_MMA(0, 0, At, B0); PG8_MMA(0, 1, At, B1); PG8_BAR; PG8_SCHED;
            PG8_LDA(At, 0, 1); PG8_STAGE(PG8_SB(0, 0), b2, voffB); PG8_STAGE(PG8_SB(0, 1), b2 + hstep, voffB); PG8_STAGE(PG8_SA(0, 0), a2, voffA);
            PG8_WAIT_V(8); PG8_WAIT_L(0); PG8_BAR; PG8_MMA(1, 0, At, B0); PG8_MMA(1, 1, At, B1); PG8_BAR; PG8_SCHED;
            PG8_LDB(B0, 1, 0); PG8_LDB(B1, 1, 1); PG8_SCHED; PG8_LDA(At, 1, 0); PG8_STAGE(PG8_SA(0, 1), a2 + hstep, voffA);
            PG8_WAIT_V(8); PG8_WAIT_L(0); PG8_BAR; PG8_MMA(0, 0, At, B0); PG8_MMA(0, 1, At, B1); PG8_BAR; PG8_SCHED;
            PG8_LDA(At, 1, 1); PG8_STAGE(PG8_SB(1, 0), b3, voffB); PG8_STAGE(PG8_SB(1, 1), b3 + hstep, voffB); PG8_STAGE(PG8_SA(1, 0), a3, voffA);
            PG8_WAIT_V(8); PG8_WAIT_L(0); PG8_BAR; PG8_MMA(1, 0, At, B0); PG8_MMA(1, 1, At, B1); PG8_BAR; PG8_SCHED;
            } else {
            PG8_LDB(B0, 0, 0); PG8_SCHED; PG8_LDA(At, 0, 0); PG8_STAGE(PG8_SA(1, 1), a1 + hstep, voffA);
            PG8_WAIT_L(8); PG8_BAR; PG8_WAIT_L(0); PG8_MMA(0, 0, At, B0); PG8_BAR; PG8_SCHED;
            PG8_LDB(B1, 0, 1); PG8_STAGE(PG8_SB(0, 0), b2, voffB);
            PG8_BAR; PG8_WAIT_L(0); PG8_MMA(0, 1, At, B1); PG8_BAR;
            PG8_LDA(At, 0, 1); PG8_STAGE(PG8_SA(0, 0), a2, voffA);
            PG8_BAR; PG8_WAIT_L(0); PG8_MMA(1, 0, At, B0); PG8_BAR; PG8_SCHED;
            PG8_STAGE(PG8_SB(0, 1), b2 + hstep, voffB);
            PG8_WAIT_V(6); PG8_BAR; PG8_MMA(1, 1, At, B1); PG8_BAR;
            PG8_LDB(B0, 1, 0); PG8_SCHED; PG8_LDA(At, 1, 0); PG8_STAGE(PG8_SA(0, 1), a2 + hstep, voffA);
            PG8_WAIT_L(8); PG8_BAR; PG8_WAIT_L(0); PG8_MMA(0, 0, At, B0); PG8_BAR; PG8_SCHED;
            PG8_LDB(B1, 1, 1); PG8_STAGE(PG8_SB(1, 0), b3, voffB);
            PG8_BAR; PG8_WAIT_L(0); PG8_MMA(0, 1, At, B1); PG8_BAR;
            PG8_LDA(At, 1, 1); PG8_STAGE(PG8_SA(1, 0), a3, voffA);
            PG8_BAR; PG8_WAIT_L(0); PG8_MMA(1, 0, At, B0); PG8_BAR; PG8_SCHED;
            PG8_STAGE(PG8_SB(1, 1), b3 + hstep, voffB);
            PG8_WAIT_V(6); PG8_BAR; PG8_MMA(1, 1, At, B1); PG8_BAR;
            }
        }
        if constexpr (ALIGN_EPI) { if (wr == 0) PG8_BAR; }
        if constexpr (!Epi::AFTER_DRAIN) { E(acc, cur, wr, wc, fr, fq); S.done(cur); }
        if (!has_next) break;
#pragma unroll
        for (int a = 0; a < 2; ++a)
#pragma unroll
            for (int b = 0; b < 2; ++b)
#pragma unroll
                for (int m = 0; m < 4; ++m)
#pragma unroll
                    for (int n = 0; n < 2; ++n) acc[a][b][m][n] = (f32x4){0.f, 0.f, 0.f, 0.f};
        cur = nxt; cA = nA; cB = nB; ++ui;
        if constexpr (ALIGN_EPI) { if (wr == 1) PG8_BAR; }
    }
    PG8_WAIT_V(0);
    if constexpr (!ALIGN_EPI) { if (wr == 0) PG8_BAR; }
    PG8_BAR;
    if constexpr (Epi::AFTER_DRAIN) { E.fused(acc, cur, wr, wc, fr, fq, lds, wid, lane); S.done(cur); }
#undef PG8_SA
#undef PG8_SB
#undef PG8_STAGE
#undef PG8_LDA
#undef PG8_LDB
#undef PG8_MMA
#undef PG8_WAIT_V
#undef PG8_WAIT_L
#undef PG8_BAR
#undef PG8_SCHED
}
}
#define PG8_SP2 true
#define PG8_ALIGN true

#define LDS_FENCE() asm volatile("s_waitcnt lgkmcnt(0)" ::: "memory")
__device__ __forceinline__ unsigned f2bf(float f) { unsigned u = __builtin_bit_cast(unsigned, f); return (u + 0x7fffu + ((u >> 16) & 1u)) >> 16; }
__device__ __forceinline__ unsigned pk2(float lo, float hi) { return f2bf(lo) | (f2bf(hi) << 16); }
__device__ __forceinline__ float wave_sum(float v) {
#pragma unroll
    for (int o = 1; o < 64; o <<= 1) v += __shfl_xor(v, o);
    return v;
}
__device__ __forceinline__ float wave_max(float v) {
#pragma unroll
    for (int o = 1; o < 64; o <<= 1) v = fmaxf(v, __shfl_xor(v, o));
    return v;
}
__device__ __forceinline__ float silu_f(float x) { return x / (1.0f + expf(-x)); }
__device__ __forceinline__ float gelu_f(float x) { return 0.5f * x * (1.0f + erff(x * 0.70710678118654752f)); }
__device__ __forceinline__ float log_sigmoid_f(float z) { return fminf(z, 0.0f) - log1pf(expf(-fabsf(z))); }

struct Params {
    const float* in[19];
    float* out;
    unsigned char* ws;
    int ph_lo, ph_hi;
};
enum { I_X = 0, I_C, I_CTX, I_CCTX, I_WADA, I_BADA, I_WIN, I_CONVW, I_GW2, I_GB2, I_GNORM, I_SINK, I_WOUT, I_LNG, I_LNB, I_PWQ, I_PSUB, I_PU, I_PV };

__device__ __forceinline__ int row_stream(int r) { return r < TL ? r / SEQ : 2; }

__device__ __forceinline__ void transpose_item(const float* W, int K, int N, bf16_t* WT, LAS float* scr, int item, int lane) {
    const int nblk = N / 32, kb = item / nblk, nb = item % nblk, k0 = 64 * kb, n0 = 32 * nb;
#pragma unroll 8
    for (int i = 0; i < 32; ++i) { const int kk = 2 * i + (lane >> 5); scr[kk * 33 + (lane & 31)] = W[(size_t)(k0 + kk) * N + n0 + (lane & 31)]; }
    LDS_FENCE();
    const int c = lane & 7;
#pragma unroll
    for (int j = 0; j < 4; ++j) { const int n = (lane >> 3) + 8 * j; const LAS float* s = scr + (8 * c) * 33 + n;
        u32x4 o; o.x = pk2(s[0 * 33], s[1 * 33]); o.y = pk2(s[2 * 33], s[3 * 33]); o.z = pk2(s[4 * 33], s[5 * 33]); o.w = pk2(s[6 * 33], s[7 * 33]);
        *(u32x4*)(WT + (size_t)(n0 + n) * K + k0 + 8 * c) = o; }
    LDS_FENCE();
}

__device__ __forceinline__ void phase_prologue(const Params& p, LAS unsigned char* lds, int tid, int lane, int wave, int bid, int G) {
    const int gw = bid * NWAVES + wave, NGW = G * NWAVES;
    LAS float* scr = (LAS float*)(lds + wave * 16384);
    bf16_t* WIN = (bf16_t*)(p.ws + WS_WIN); bf16_t* WOUT = (bf16_t*)(p.ws + WS_WOUT); bf16_t* WQ = (bf16_t*)(p.ws + WS_WQ);
    constexpr int IT_IN = (DM / 64) * (INW / 32), IT_SQ = (DM / 64) * (DM / 32), IT_L = IT_IN + 2 * IT_SQ;
    for (int it = gw; it < DEPTH * IT_L; it += NGW) {
        const int l = it / IT_L; int r = it % IT_L;
        if (r < IT_IN) { transpose_item(p.in[I_WIN] + (size_t)l * DM * INW, DM, INW, WIN + (size_t)l * INWP * DM, scr, r, lane); continue; } r -= IT_IN;
        if (r < IT_SQ) { transpose_item(p.in[I_WOUT] + (size_t)l * DM * DM, DM, DM, WOUT + (size_t)l * DM * DM, scr, r, lane); continue; } r -= IT_SQ;
        transpose_item(p.in[I_PWQ] + (size_t)l * DM * DM, DM, DM, WQ + (size_t)l * DM * DM, scr, r, lane);
    }
    {
        constexpr int PADV = (INWP - INW) * DM / 8;
        const int gt = bid * NTHREADS + tid, NGT = G * NTHREADS;
        for (int i = gt; i < DEPTH * PADV; i += NGT) { const int l = i / PADV, o = i % PADV;
            *(u32x4*)(WIN + (size_t)l * INWP * DM + (size_t)INW * DM + (size_t)o * 8) = (u32x4){0u, 0u, 0u, 0u}; }
    }
    __syncthreads();
    LAS float* sc = (LAS float*)lds;
    LAS float* red = (LAS float*)(lds + 32768);
    for (int i = tid; i < 3 * DM; i += NTHREADS) { const int s = i / DM, k = i % DM; const float v = s < 2 ? p.in[I_C][s * DM + k] : p.in[I_CCTX][k]; sc[i] = silu_f(v); }
    __syncthreads();
    float* MOD = (float*)(p.ws + WS_MOD);
    constexpr int NCH = 6 * DM / 64;
    for (int it = bid; it < DEPTH * NCH; it += G) {
        const int l = it / NCH, n = (it % NCH) * 64 + lane;
        const float* wp = p.in[I_WADA] + (size_t)l * DM * 6 * DM + n;
        float a0 = 0.f, a1 = 0.f, a2 = 0.f;
        const int kb = wave * (DM / NWAVES);
#pragma unroll 8
        for (int k = kb; k < kb + DM / NWAVES; ++k) { const float w = wp[(size_t)k * 6 * DM]; a0 += sc[k] * w; a1 += sc[DM + k] * w; a2 += sc[2 * DM + k] * w; }
        red[(wave * 3 + 0) * 64 + lane] = a0; red[(wave * 3 + 1) * 64 + lane] = a1; red[(wave * 3 + 2) * 64 + lane] = a2;
        __syncthreads();
        if (tid < 192) { const int s = tid / 64, ln = tid % 64; float v = 0.f;
#pragma unroll
            for (int w = 0; w < NWAVES; ++w) v += red[(w * 3 + s) * 64 + ln];
            const int nn = (it % NCH) * 64 + ln;
            MOD[((size_t)l * 3 + s) * 6 * DM + nn] = v + p.in[I_BADA][(size_t)l * 6 * DM + nn]; }
        __syncthreads();
    }
}

__device__ __forceinline__ const float* xsrc(const Params& p, int l, int r) {
    if (l > 0) return (const float*)(p.ws + WS_XL) + (size_t)r * DM;
    return r < TL ? p.in[I_X] + (size_t)r * DM : p.in[I_CTX] + (size_t)(r - TL) * DM;
}

__device__ __forceinline__ void modulate_row(const float* xr, const float* mod, int sh_off, int sc_off, bf16_t* hb, int lane) {
#pragma unroll
    for (int j = 0; j < 8; ++j) { const int c = lane * 4 + 256 * j;
        const f32x4 x = *(const f32x4*)(xr + c), sh = *(const f32x4*)(mod + sh_off + c), s = *(const f32x4*)(mod + sc_off + c);
        u32x2 o; o.x = pk2(x.x * (1.f + s.x) + sh.x, x.y * (1.f + s.y) + sh.y); o.y = pk2(x.z * (1.f + s.z) + sh.z, x.w * (1.f + s.w) + sh.w);
        *(u32x2*)(hb + c) = o; }
}
__device__ __forceinline__ void phase_modulate0(const Params& p, int lane, int wave, int bid, int G) {
    const int gw = bid * NWAVES + wave, NGW = G * NWAVES;
    const float* MOD = (const float*)(p.ws + WS_MOD); bf16_t* HB = (bf16_t*)(p.ws + WS_HB);
    for (int r = gw; r < TA; r += NGW) modulate_row(xsrc(p, 0, r), MOD + (size_t)(0 * 3 + row_stream(r)) * 6 * DM, 0, DM, HB + (size_t)r * DM, lane);
}

__device__ __forceinline__ void gemm_direct(const bf16_t* A, const bf16_t* Bt, float* C, int M, int N, int K, int ldc, int gw, int NGW, int lane) {
    const int nTn = N / 64, nItems = (M / 32) * nTn;
    const int fr = lane & 15, fq = lane >> 4;
    for (int it = gw; it < nItems; it += NGW) {
        const int mt = it / nTn, nt = it % nTn;
        const bf16_t* a0 = A + (size_t)(mt * 32 + fr) * K + fq * 8;
        const bf16_t* b0 = Bt + (size_t)(nt * 64 + fr) * K + fq * 8;
        f32x4 acc[2][4];
#pragma unroll
        for (int i = 0; i < 2; ++i)
#pragma unroll
            for (int j = 0; j < 4; ++j) acc[i][j] = (f32x4){0.f, 0.f, 0.f, 0.f};
#pragma unroll 2
        for (int k0 = 0; k0 < K; k0 += 32) {
            bf16x8 af[2], bfr[4];
#pragma unroll
            for (int i = 0; i < 2; ++i) af[i] = *(const bf16x8*)(a0 + (size_t)i * 16 * K + k0);
#pragma unroll
            for (int j = 0; j < 4; ++j) bfr[j] = *(const bf16x8*)(b0 + (size_t)j * 16 * K + k0);
#pragma unroll
            for (int i = 0; i < 2; ++i)
#pragma unroll
                for (int j = 0; j < 4; ++j) acc[i][j] = __builtin_amdgcn_mfma_f32_16x16x32_bf16(af[i], bfr[j], acc[i][j], 0, 0, 0);
        }
#pragma unroll
        for (int i = 0; i < 2; ++i)
#pragma unroll
            for (int j = 0; j < 4; ++j)
#pragma unroll
                for (int g = 0; g < 4; ++g) C[(size_t)(mt * 32 + i * 16 + fq * 4 + g) * ldc + nt * 64 + j * 16 + fr] = acc[i][j][g];
    }
}

__device__ __forceinline__ void phase_post_in(const Params& p, int l, int lane, int wave, int bid, int G) {
    const int gw = bid * NWAVES + wave, NGW = G * NWAVES;
    const float* P = (const float*)(p.ws + WS_P);
    float* QR = (float*)(p.ws + WS_QR); float* KR = (float*)(p.ws + WS_KR);
    float* ALF = (float*)(p.ws + WS_ALF); float* ALB = (float*)(p.ws + WS_ALB);
    bf16_t* MIX = (bf16_t*)(p.ws + WS_MIX);
    const float* cw = p.in[I_CONVW] + (size_t)l * 3 * 512;
    const float* w2 = p.in[I_GW2] + (size_t)l * 2 * 16 * 256;
    const float* b2 = p.in[I_GB2] + (size_t)l * 2 * 256;
    for (int r = gw; r < TA; r += NGW) {
        const float* pr = P + (size_t)r * INWP;
        int pos, len;
        if (r < TL) { pos = r % SEQ; len = SEQ; } else { pos = (r - TL) % CTXL; len = CTXL; }
#pragma unroll 1
        for (int j = 0; j < 8; ++j) { const int c = lane + 64 * j;
            float a = cw[512 + c] * pr[C_CC + c] * pr[C_CX + c];
            if (pos > 0) a += cw[c] * pr[C_CC + c - INWP] * pr[C_CX + c - INWP];
            if (pos < len - 1) a += cw[1024 + c] * pr[C_CC + c + INWP] * pr[C_CX + c + INWP];
            MIX[(size_t)r * DM + c] = (bf16_t)f2bf(pr[C_CB + c] * a); }
#pragma unroll 1
        for (int d = 0; d < 2; ++d) {
            const float* lr = pr + (d ? C_LRB : C_LRF);
#pragma unroll 1
            for (int j = 0; j < 4; ++j) { const int c = lane + 64 * j; float z = b2[d * 256 + c];
#pragma unroll
                for (int q = 0; q < 16; ++q) z += lr[q] * w2[(d * 16 + q) * 256 + c];
                (d ? ALB : ALF)[(size_t)r * 256 + c] = expf(log_sigmoid_f(z) * (1.0f / 16.0f)); }
        }
        if (r < TL) {
            const int half = lane >> 5, i = lane & 31;
            const float invf = powf(10000.0f, -(float)i / 32.0f);
            const float ang = (float)(half ? (pos % 64) : (pos / 64)) * invf;
            float sn, cs; sincosf(ang, &sn, &cs);
#pragma unroll 2
            for (int h = 0; h < 8; ++h) { const float* q = pr + C_SQ + h * 128 + half * 64; const float x1 = q[i], x2 = q[32 + i];
                float* o = QR + (size_t)r * 1024 + h * 128 + half * 64;
                o[i] = (x1 * cs - x2 * sn) * 0.08838834764831845f; o[32 + i] = (x2 * cs + x1 * sn) * 0.08838834764831845f; }
#pragma unroll
            for (int h = 0; h < 2; ++h) { const float* k = pr + C_SK + h * 128 + half * 64; const float x1 = k[i], x2 = k[32 + i];
                float* o = KR + (size_t)r * 256 + h * 128 + half * 64;
                o[i] = x1 * cs - x2 * sn; o[32 + i] = x2 * cs + x1 * sn; }
        }
    }
}

__device__ __forceinline__ void gla_scan(const Params& p, int s, int t, int lane, LAS float* sh) {
    const int dir = s >> 3, b = (s >> 2) & 1, h = s & 3;
    const float* P = (const float*)(p.ws + WS_P);
    const float* AL = (const float*)(p.ws + (dir ? WS_ALB : WS_ALF));
    float* O = (float*)(p.ws + (dir ? WS_OB : WS_OF));
    float S[64];
#pragma unroll
    for (int k = 0; k < 64; ++k) S[k] = 0.f;
    constexpr int NST = CTXL + SEQ;
#define GLA_ROW(i) ((i) < CTXL ? TL + b * CTXL + (dir ? CTXL - 1 - (i) : (i)) : b * SEQ + (dir ? SEQ - 1 - ((i) - CTXL) : ((i) - CTXL)))
    int row = GLA_ROW(0);
    float nq = P[(size_t)row * INWP + C_GQ + h * 64 + lane], nk = P[(size_t)row * INWP + C_GK + h * 64 + lane],
          na = AL[(size_t)row * 256 + h * 64 + lane], nv = P[(size_t)row * INWP + C_GV + h * 128 + t];
    for (int i = 0; i < NST; ++i) {
        const float cq = nq * 0.125f, ck = nk, ca = na, cv = nv; const int crow = row;
        if (i + 1 < NST) { row = GLA_ROW(i + 1);
            nq = P[(size_t)row * INWP + C_GQ + h * 64 + lane]; nk = P[(size_t)row * INWP + C_GK + h * 64 + lane];
            na = AL[(size_t)row * 256 + h * 64 + lane]; nv = P[(size_t)row * INWP + C_GV + h * 128 + t]; }
        sh[lane] = cq; sh[64 + lane] = ck; sh[128 + lane] = ca;
        LDS_FENCE();
        float o = 0.f;
#pragma unroll
        for (int k = 0; k < 64; k += 4) {
            const f32x4 q4 = *(const LAS f32x4*)(sh + k), k4 = *(const LAS f32x4*)(sh + 64 + k), a4 = *(const LAS f32x4*)(sh + 128 + k);
            S[k + 0] = a4.x * S[k + 0] + k4.x * cv; o += q4.x * S[k + 0];
            S[k + 1] = a4.y * S[k + 1] + k4.y * cv; o += q4.y * S[k + 1];
            S[k + 2] = a4.z * S[k + 2] + k4.z * cv; o += q4.z * S[k + 2];
            S[k + 3] = a4.w * S[k + 3] + k4.w * cv; o += q4.w * S[k + 3];
        }
        O[(size_t)crow * 512 + h * 128 + t] = o;
        LDS_FENCE();
    }
#undef GLA_ROW
}

__device__ __forceinline__ void swa_item(LAS float* qs, LAS float* ps, const float* kA, size_t ksA, const float* vA, size_t vsA, int nA,
                                         const float* kB, size_t ksB, const float* vB, size_t vsB, int nB, float sink, bf16_t* out, int lane) {
    const int ntot = nA + nB;
    float mx = sink;
    for (int j = lane; j < ntot; j += 64) {
        const float* kr = j < nA ? kA + (size_t)j * ksA : kB + (size_t)(j - nA) * ksB;
        float s = 0.f;
#pragma unroll 8
        for (int d = 0; d < 128; d += 4) { const f32x4 kv = *(const f32x4*)(kr + d); const f32x4 qv = *(const LAS f32x4*)(qs + d); s += kv.x * qv.x + kv.y * qv.y + kv.z * qv.z + kv.w * qv.w; }
        ps[j] = s; mx = fmaxf(mx, s);
    }
    mx = wave_max(mx);
    float sum = 0.f;
    for (int j = lane; j < ntot; j += 64) { const float e = expf(ps[j] - mx); ps[j] = e; sum += e; }
    sum = wave_sum(sum) + expf(sink - mx);
    LDS_FENCE();
    const float inv = 1.0f / sum;
    float o0 = 0.f, o1 = 0.f;
#pragma unroll 4
    for (int j = 0; j < ntot; ++j) { const float* vr = j < nA ? vA + (size_t)j * vsA : vB + (size_t)(j - nA) * vsB; const float pj = ps[j]; o0 += pj * vr[lane]; o1 += pj * vr[lane + 64]; }
    out[lane] = (bf16_t)f2bf(o0 * inv); out[lane + 64] = (bf16_t)f2bf(o1 * inv);
    LDS_FENCE();
}

__device__ __forceinline__ void phase_mixers(const Params& p, int l, LAS unsigned char* lds, int tid, int lane, int wave, int bid, int G) {
    LAS float* wl = (LAS float*)(lds + wave * 16384);
    if (wave < 2) {
        for (int s = bid; s < 16; s += G) gla_scan(p, s, tid, lane, wl);
        return;
    }
    const int gw = bid * 6 + (wave - 2), NGW = G * 6;
    const float* P = (const float*)(p.ws + WS_P);
    const float* QR = (const float*)(p.ws + WS_QR); const float* KR = (const float*)(p.ws + WS_KR);
    bf16_t* MIX = (bf16_t*)(p.ws + WS_MIX);
    const float* sinkp = p.in[I_SINK] + l * 8;
    LAS float* qs = wl; LAS float* ps = wl + 128;
    const bool with_ctx = (l < DEPTH - 1);
    const int nItems = (with_ctx ? TA : TL) * 8;
    for (int it = gw; it < nItems; it += NGW) {
        const int r = it >> 3, hq = it & 7, hk = hq >> 2;
        bf16_t* out = MIX + (size_t)r * DM + 1024 + hq * 128;
        if (r < TL) {
            const int b = r / SEQ, n = r % SEQ;
            qs[lane] = QR[(size_t)r * 1024 + hq * 128 + lane]; qs[lane + 64] = QR[(size_t)r * 1024 + hq * 128 + lane + 64];
            LDS_FENCE();
            const int lo = n - 128 < 0 ? 0 : n - 128, hi = n + 128 > SEQ - 1 ? SEQ - 1 : n + 128;
            const size_t r0 = (size_t)b * SEQ + lo, c0 = (size_t)TL + (size_t)b * CTXL;
            swa_item(qs, ps, KR + r0 * 256 + hk * 128, 256, P + r0 * INWP + C_SV + hk * 128, INWP, hi - lo + 1,
                     P + c0 * INWP + C_SK + hk * 128, INWP, P + c0 * INWP + C_SV + hk * 128, INWP, CTXL, sinkp[hq], out, lane);
        } else {
            const int b = (r - TL) / CTXL;
            const float* q = P + (size_t)r * INWP + C_SQ + hq * 128;
            qs[lane] = q[lane] * 0.08838834764831845f; qs[lane + 64] = q[lane + 64] * 0.08838834764831845f;
            LDS_FENCE();
            const size_t c0 = (size_t)TL + (size_t)b * CTXL;
            swa_item(qs, ps, P, 0, P, 0, 0, P + c0 * INWP + C_SK + hk * 128, INWP, P + c0 * INWP + C_SV + hk * 128, INWP, CTXL, sinkp[hq], out, lane);
        }
    }
}

__device__ __forceinline__ void phase_gla_finish(const Params& p, int l, int lane, int wave, int bid, int G) {
    const int gw = bid * NWAVES + wave, NGW = G * NWAVES;
    const float* P = (const float*)(p.ws + WS_P);
    const float* OF = (const float*)(p.ws + WS_OF); const float* OB = (const float*)(p.ws + WS_OB);
    bf16_t* MIX = (bf16_t*)(p.ws + WS_MIX);
    const float* nw = p.in[I_GNORM] + l * 128;
    for (int r = gw; r < TA; r += NGW) {
#pragma unroll
        for (int h = 0; h < 4; ++h) {
            const size_t o = (size_t)r * 512 + h * 128;
            const float a0 = OF[o + lane] + OB[o + lane], a1 = OF[o + lane + 64] + OB[o + lane + 64];
            const float ms = wave_sum(a0 * a0 + a1 * a1) * (1.0f / 128.0f);
            const float rs = 1.0f / sqrtf(ms + LN_EPS);
            const float g0 = P[(size_t)r * INWP + C_GG + h * 128 + lane], g1 = P[(size_t)r * INWP + C_GG + h * 128 + lane + 64];
            MIX[(size_t)r * DM + 512 + h * 128 + lane] = (bf16_t)f2bf(a0 * rs * nw[lane] * silu_f(g0));
            MIX[(size_t)r * DM + 512 + h * 128 + lane + 64] = (bf16_t)f2bf(a1 * rs * nw[lane + 64] * silu_f(g1));
        }
    }
}

__device__ __forceinline__ void ln_row(f32x4 (&v)[8], const float* lg, const float* lb, int lane) {
    float s = 0.f;
#pragma unroll
    for (int j = 0; j < 8; ++j) s += (v[j].x + v[j].y) + (v[j].z + v[j].w);
    const float mean = wave_sum(s) * (1.0f / DM);
    float s2 = 0.f;
#pragma unroll
    for (int j = 0; j < 8; ++j) { v[j] = v[j] - mean; s2 += (v[j].x * v[j].x + v[j].y * v[j].y) + (v[j].z * v[j].z + v[j].w * v[j].w); }
    const float rstd = 1.0f / sqrtf(wave_sum(s2) * (1.0f / DM) + LN_EPS);
#pragma unroll
    for (int j = 0; j < 8; ++j) { const int c = lane * 4 + 256 * j; const f32x4 g = *(const f32x4*)(lg + c), b = *(const f32x4*)(lb + c); v[j] = v[j] * rstd * g + b; }
}

__device__ __forceinline__ void phase_ln1(const Params& p, int l, int lane, int wave, int bid, int G) {
    const int gw = bid * NWAVES + wave, NGW = G * NWAVES;
    const float* MOD = (const float*)(p.ws + WS_MOD); const float* Y = (const float*)(p.ws + WS_Y);
    float* XL = (float*)(p.ws + WS_XL); bf16_t* HB = (bf16_t*)(p.ws + WS_HB);
    const float* lg = p.in[I_LNG] + (size_t)(l * 2 + 0) * DM; const float* lb = p.in[I_LNB] + (size_t)(l * 2 + 0) * DM;
    for (int r = gw; r < TA; r += NGW) {
        const float* mod = MOD + (size_t)(l * 3 + row_stream(r)) * 6 * DM;
        const float* xr = xsrc(p, l, r);
        f32x4 v[8];
#pragma unroll
        for (int j = 0; j < 8; ++j) { const int c = lane * 4 + 256 * j; const f32x4 x = *(const f32x4*)(xr + c), y = *(const f32x4*)(Y + (size_t)r * DM + c), g = *(const f32x4*)(mod + 2 * DM + c); v[j] = x * DN_ALPHA + g * y; }
        ln_row(v, lg, lb, lane);
#pragma unroll
        for (int j = 0; j < 8; ++j) { const int c = lane * 4 + 256 * j; *(f32x4*)(XL + (size_t)r * DM + c) = v[j];
            const f32x4 sh = *(const f32x4*)(mod + 3 * DM + c), s = *(const f32x4*)(mod + 4 * DM + c);
            u32x2 o; o.x = pk2(v[j].x * (1.f + s.x) + sh.x, v[j].y * (1.f + s.y) + sh.y); o.y = pk2(v[j].z * (1.f + s.z) + sh.z, v[j].w * (1.f + s.w) + sh.w);
            *(u32x2*)(HB + (size_t)r * DM + c) = o; }
    }
}

__device__ __forceinline__ void wave_argmax(float& v, int& idx) {
#pragma unroll
    for (int o = 1; o < 64; o <<= 1) { const float ov = __shfl_xor(v, o); const int oi = __shfl_xor(idx, o); if (ov > v || (ov == v && oi < idx)) { v = ov; idx = oi; } }
}
__device__ __forceinline__ void phase_peer(const Params& p, int l, LAS unsigned char* lds, int lane, int wave, int bid, int G) {
    const int gw = bid * NWAVES + wave, NGW = G * NWAVES;
    const float* MOD = (const float*)(p.ws + WS_MOD); const float* QP = (const float*)(p.ws + WS_QP);
    float* XL = (float*)(p.ws + WS_XL); bf16_t* HB = (bf16_t*)(p.ws + WS_HB);
    const float* lg = p.in[I_LNG] + (size_t)(l * 2 + 1) * DM; const float* lb = p.in[I_LNB] + (size_t)(l * 2 + 1) * DM;
    const float* sub = p.in[I_PSUB] + (size_t)l * 2 * 128 * 128;
    const float* U = p.in[I_PU] + (size_t)l * NEXP * DM; const float* V = p.in[I_PV] + (size_t)l * NEXP * DM;
    LAS float* qs = (LAS float*)(lds + wave * 16384);
    LAS int* eidx = (LAS int*)(qs + 256);
    LAS float* egate = (LAS float*)(eidx + 128);
    const bool last = (l == DEPTH - 1);
    const int nrows = last ? TL : TA;
    for (int r = gw; r < nrows; r += NGW) {
        const float* mod = MOD + (size_t)(l * 3 + row_stream(r)) * 6 * DM;
        for (int h = 0; h < 8; ++h) {
            const float* q = QP + (size_t)r * DM + h * 256;
            qs[lane] = q[lane]; qs[lane + 64] = q[lane + 64]; qs[lane + 128] = q[lane + 128]; qs[lane + 192] = q[lane + 192];
            LDS_FENCE();
            float tv[2]; int ti[2];
#pragma unroll
            for (int pp = 0; pp < 2; ++pp) {
                const float* k0 = sub + (size_t)(pp * 128 + lane) * 128; const float* k1 = k0 + 64 * 128;
                float s0 = 0.f, s1 = 0.f;
#pragma unroll 8
                for (int d = 0; d < 128; d += 4) { const f32x4 qv = *(const LAS f32x4*)(qs + pp * 128 + d); const f32x4 a = *(const f32x4*)(k0 + d), b = *(const f32x4*)(k1 + d);
                    s0 += a.x * qv.x + a.y * qv.y + a.z * qv.z + a.w * qv.w; s1 += b.x * qv.x + b.y * qv.y + b.z * qv.z + b.w * qv.w; }
                float mv = 0.f; int mi = 0;
                for (int it = 0; it < 16; ++it) {
                    float v = s0 >= s1 ? s0 : s1; int idx = s0 >= s1 ? lane : lane + 64;
                    wave_argmax(v, idx);
                    if (lane == it) { mv = v; mi = idx; }
                    if (idx == lane) s0 = -INFINITY; if (idx == lane + 64) s1 = -INFINITY;
                }
                tv[pp] = mv; ti[pp] = mi;
            }
            float cv[4];
            const float ai = __shfl(tv[0], lane >> 2);
#pragma unroll
            for (int m = 0; m < 4; ++m) cv[m] = ai + __shfl(tv[1], (lane & 3) * 4 + m);
            float bv = 0.f; int bc = 0;
            for (int it = 0; it < 16; ++it) {
                float v = cv[0]; int idx = lane * 4;
#pragma unroll
                for (int m = 1; m < 4; ++m) if (cv[m] > v) { v = cv[m]; idx = lane * 4 + m; }
                wave_argmax(v, idx);
                if (lane == it) { bv = v; bc = idx; }
#pragma unroll
                for (int m = 0; m < 4; ++m) if (idx == lane * 4 + m) cv[m] = -INFINITY;
            }
            const int i1 = __shfl(ti[0], bc >> 4), i2 = __shfl(ti[1], bc & 15);
            const float bmax = __shfl(bv, 0);
            float e = lane < 16 ? expf(bv - bmax) : 0.f;
            const float esum = wave_sum(e);
            if (lane < 16) { eidx[h * 16 + lane] = i1 * 128 + i2; egate[h * 16 + lane] = e / esum; }
            LDS_FENCE();
        }
        const float* xr = XL + (size_t)r * DM;
        f32x4 xv[8], hv[8], yv[8];
#pragma unroll
        for (int j = 0; j < 8; ++j) { const int c = lane * 4 + 256 * j; const f32x4 x0 = *(const f32x4*)(xr + c);
            const f32x4 sh = *(const f32x4*)(mod + 3 * DM + c), s = *(const f32x4*)(mod + 4 * DM + c); hv[j] = x0 * (1.f + s) + sh; yv[j] = (f32x4){0.f, 0.f, 0.f, 0.f}; }
        for (int j = 0; j < 128; ++j) {
            const int e = eidx[j]; const float gt = egate[j];
            const float* ur = U + (size_t)e * DM; const float* vr = V + (size_t)e * DM;
            float d = 0.f;
#pragma unroll
            for (int q = 0; q < 8; ++q) { const f32x4 u = *(const f32x4*)(ur + lane * 4 + 256 * q); d += (u.x * hv[q].x + u.y * hv[q].y) + (u.z * hv[q].z + u.w * hv[q].w); }
            d = wave_sum(d);
            const float w = gelu_f(d) * gt;
#pragma unroll
            for (int q = 0; q < 8; ++q) { const f32x4 vv = *(const f32x4*)(vr + lane * 4 + 256 * q); yv[q] += vv * w; }
        }
#pragma unroll
        for (int j = 0; j < 8; ++j) { const int c = lane * 4 + 256 * j; const f32x4 g = *(const f32x4*)(mod + 5 * DM + c); xv[j] = *(const f32x4*)(xr + c) * DN_ALPHA + g * yv[j]; }
        ln_row(xv, lg, lb, lane);
        float* dst = (last ? p.out : XL) + (size_t)r * DM;
#pragma unroll
        for (int j = 0; j < 8; ++j) { const int c = lane * 4 + 256 * j; *(f32x4*)(dst + c) = xv[j]; }
        if (!last) {
            const float* modn = MOD + (size_t)((l + 1) * 3 + row_stream(r)) * 6 * DM;
#pragma unroll
            for (int j = 0; j < 8; ++j) { const int c = lane * 4 + 256 * j; const f32x4 sh = *(const f32x4*)(modn + c), s = *(const f32x4*)(modn + DM + c);
                u32x2 o; o.x = pk2(xv[j].x * (1.f + s.x) + sh.x, xv[j].y * (1.f + s.y) + sh.y); o.y = pk2(xv[j].z * (1.f + s.z) + sh.z, xv[j].w * (1.f + s.w) + sh.w);
                *(u32x2*)(HB + (size_t)r * DM + c) = o; }
        }
        LDS_FENCE();
    }
}

__device__ __forceinline__ void gemm_rows(LAS unsigned char* lds, const bf16_t* A, const bf16_t* Bt, float* C, bool with_ctx, int G, int bid) {
    { pg8::Gemm g{A, Bt, TL, DM, DM}; pg8::StaticOrder S; S.init(TL, DM, G, bid); pg8::EpiF32 E{C, DM, nullptr};
      pg8::gemm_phase<pg8::EpiF32, pg8::StaticOrder, PG8_ALIGN, PG8_SP2>(lds, g, S, E); }
    if (with_ctx) { pg8::Gemm g{A + (size_t)TL * DM, Bt, TC, DM, DM}; pg8::StaticOrder S; S.init(TC, DM, G, bid); pg8::EpiF32 E{C + (size_t)TL * DM, DM, nullptr};
      pg8::gemm_phase<pg8::EpiF32, pg8::StaticOrder, PG8_ALIGN, PG8_SP2>(lds, g, S, E); }
}

constexpr int PH_PER_LAYER = 8, N_PHASES = 2 + DEPTH * PH_PER_LAYER;
__global__ void __launch_bounds__(NTHREADS, 2) fwd_kernel(Params p) {
    extern __shared__ __attribute__((aligned(16))) unsigned char lds_raw[];
    LAS unsigned char* lds = (LAS unsigned char*)lds_raw;
    const int tid = threadIdx.x, lane = tid & 63, wave = __builtin_amdgcn_readfirstlane(tid >> 6), bid = blockIdx.x, G = gridDim.x;
    volatile LAS unsigned* MISC = (volatile LAS unsigned*)(lds + MISC_OFF);
    if (tid < 32) MISC[tid] = 0u;
    __syncthreads();
    const int lo = p.ph_lo, hi = p.ph_hi;
    unsigned* ctl = (unsigned*)(p.ws + WS_CTL);
    XcdBarrier bar; bar.bar = ctl + CW_BAR; bar.x = 0; bar.st = MISC + 8;
    if (hi - lo > 1) bar = xcd_barrier_post(ctl + CW_BAR, MISC + 8);
#define IN(k) (lo <= (k) && (k) < hi)
#define SEAM(k) do { if (IN(k) && IN((k) + 1)) xcd_barrier(bar); } while (0)
    const int NGW = G * NWAVES;
#define FRESH() int tid_ = tid, lane_ = lane, wave_ = wave, bid_ = bid; asm volatile("" : "+v"(tid_), "+v"(lane_), "+s"(wave_), "+s"(bid_)); const int gw_ = bid_ * NWAVES + wave_; (void)tid_; (void)gw_
    if (IN(0)) { FRESH(); phase_prologue(p, lds, tid_, lane_, wave_, bid_, G); }
    SEAM(0);
    if (IN(1)) { FRESH(); phase_modulate0(p, lane_, wave_, bid_, G); }
    SEAM(1);
    for (int l = 0; l < DEPTH; ++l) {
        const int b0 = 2 + l * PH_PER_LAYER;
        if (IN(b0 + 0)) { FRESH();
            pg8::Gemm g{(const bf16_t*)(p.ws + WS_HB), (const bf16_t*)(p.ws + WS_WIN) + (size_t)l * INWP * DM, TA, INWP, DM}; pg8::StaticOrder S; S.init(TA, INWP, G, bid_);
            pg8::EpiF32 E{(float*)(p.ws + WS_P), INWP, nullptr};
            pg8::gemm_phase<pg8::EpiF32, pg8::StaticOrder, PG8_ALIGN, PG8_SP2>(lds, g, S, E); }
        SEAM(b0 + 0);
        if (IN(b0 + 1)) { FRESH(); phase_post_in(p, l, lane_, wave_, bid_, G); }
        SEAM(b0 + 1);
        if (IN(b0 + 2)) { FRESH(); phase_mixers(p, l, lds, tid_, lane_, wave_, bid_, G); }
        SEAM(b0 + 2);
        if (IN(b0 + 3)) { FRESH(); phase_gla_finish(p, l, lane_, wave_, bid_, G); }
        SEAM(b0 + 3);
        if (IN(b0 + 4)) { FRESH();
            gemm_rows(lds, (const bf16_t*)(p.ws + WS_MIX), (const bf16_t*)(p.ws + WS_WOUT) + (size_t)l * DM * DM, (float*)(p.ws + WS_Y), l < DEPTH - 1, G, bid_); }
        SEAM(b0 + 4);
        if (IN(b0 + 5)) { FRESH(); phase_ln1(p, l, lane_, wave_, bid_, G); }
        SEAM(b0 + 5);
        if (IN(b0 + 6)) { FRESH();
            gemm_rows(lds, (const bf16_t*)(p.ws + WS_HB), (const bf16_t*)(p.ws + WS_WQ) + (size_t)l * DM * DM, (float*)(p.ws + WS_QP), l < DEPTH - 1, G, bid_); }
        SEAM(b0 + 6);
        if (IN(b0 + 7)) { FRESH(); phase_peer(p, l, lds, lane_, wave_, bid_, G); }
        SEAM(b0 + 7);
    }
#undef FRESH
#undef IN
#undef SEAM
}

#ifndef MK_PER_PHASE
#define MK_PER_PHASE 0
#endif
extern "C" void kernel_launch(void* const* d_in, const int* in_sizes, int n_in, void* d_out, int out_size, void* d_ws, size_t ws_size, hipStream_t stream) {
    static int grid = 0;
    if (grid == 0) {
        if (n_in != 19 || out_size != TL * DM || ws_size < WS_END) { fprintf(stderr, "kernel_launch: unexpected shapes (n_in %d out %d ws %zu)\n", n_in, out_size, ws_size); grid = -1; return; }
        int dev = 0, cus = 0;
        if (hipGetDevice(&dev) != hipSuccess || hipDeviceGetAttribute(&cus, hipDeviceAttributeMultiprocessorCount, dev) != hipSuccess) { grid = -1; return; }
        if (hipFuncSetAttribute((const void*)fwd_kernel, hipFuncAttributeMaxDynamicSharedMemorySize, LDS_BYTES) != hipSuccess) { fprintf(stderr, "kernel_launch: hipFuncSetAttribute failed\n"); grid = -1; return; }
        int per_cu = 0;
        (void)hipOccupancyMaxActiveBlocksPerMultiprocessor(&per_cu, (const void*)fwd_kernel, NTHREADS, LDS_BYTES);
        (void)hipGetLastError();
        if (per_cu < 1) fprintf(stderr, "kernel_launch: occupancy query reports %d blocks per CU\n", per_cu);
        grid = cus;
    }
    if (grid < 0) return;
    (void)hipMemsetAsync((char*)d_ws + WS_CTL, 0, CTL_ZERO_BYTES, stream);
    Params p{};
    for (int i = 0; i < 19; ++i) p.in[i] = (const float*)d_in[i];
    p.out = (float*)d_out; p.ws = (unsigned char*)d_ws;
#if MK_PER_PHASE
    for (int ph = 0; ph < N_PHASES; ++ph) { p.ph_lo = ph; p.ph_hi = ph + 1; hipLaunchKernelGGL(fwd_kernel, dim3(grid), dim3(NTHREADS), LDS_BYTES, stream, p); }
#else
    p.ph_lo = 0; p.ph_hi = N_PHASES;
    hipLaunchKernelGGL(fwd_kernel, dim3(grid), dim3(NTHREADS), LDS_BYTES, stream, p);
#endif
}
```

```cpp
#include <hip/hip_runtime.h>
#include <cstdio>
#include <cstdint>

#define LAS __attribute__((address_space(3)))
typedef unsigned short bf16_t;
typedef short bf16x8 __attribute__((ext_vector_type(8)));
typedef float f32x4 __attribute__((ext_vector_type(4)));
typedef unsigned u32x4 __attribute__((ext_vector_type(4)));
typedef unsigned u32x2 __attribute__((ext_vector_type(2)));

constexpr int DM = 2048, NBATCH = 2, SEQ = 8192, DEPTH = 4, CTXL = 256;
constexpr int TL = NBATCH * SEQ, TC = NBATCH * CTXL, TA = TL + TC;
constexpr int INW = 4640, INWP = 4864;
constexpr int C_CX = 0, C_CB = 512, C_CC = 1024, C_GQ = 1536, C_GK = 1792, C_GV = 2048, C_GG = 2560, C_LRF = 3072, C_LRB = 3088,
              C_SQ = 3104, C_SK = 4128, C_SV = 4384;
constexpr int NEXP = 16384;
constexpr float DN_ALPHA = 1.6817928305074290f;
constexpr float LN_EPS = 1e-6f;
constexpr int NWAVES = 8, NTHREADS = 512;

constexpr size_t MiB = 1u << 20;
constexpr size_t WS_CTL = 0, CTL_ZERO_BYTES = 2 * MiB;
constexpr size_t WS_MOD = 2 * MiB;
constexpr size_t WS_WIN = 4 * MiB;
constexpr size_t WS_WOUT = 80 * MiB;
constexpr size_t WS_WQ = 112 * MiB;
constexpr size_t WS_XL = 144 * MiB;
constexpr size_t WS_HB = 276 * MiB;
constexpr size_t WS_P = 342 * MiB;
constexpr size_t WS_QR = 656 * MiB;
constexpr size_t WS_KR = 720 * MiB;
constexpr size_t WS_ALF = 736 * MiB;
constexpr size_t WS_ALB = 753 * MiB;
constexpr size_t WS_OF = 770 * MiB;
constexpr size_t WS_OB = 803 * MiB;
constexpr size_t WS_MIX = 836 * MiB;
constexpr size_t WS_Y = 902 * MiB;
constexpr size_t WS_QP = 1034 * MiB;
constexpr size_t WS_DELTA = 1166 * MiB;
constexpr size_t WS_DEC = 1233 * MiB;
constexpr size_t WS_SST = 1234 * MiB;
constexpr size_t WS_END = 1268 * MiB;
constexpr int GLA_ITEMS = (TA / 64) * 4;
static_assert(WS_DELTA + (size_t)GLA_ITEMS * 2 * 8192 * 4 <= WS_DEC && WS_DEC + (size_t)GLA_ITEMS * 2 * 64 * 4 <= WS_SST && WS_SST + (size_t)GLA_ITEMS * 2 * 8192 * 2 <= WS_END, "map");
static_assert(WS_WIN + (size_t)4 * INWP * DM * 2 <= WS_WOUT, "map");
static_assert(WS_P + (size_t)TA * INWP * 4 <= WS_QR, "map");
static_assert(WS_XL + (size_t)TA * DM * 4 <= WS_HB, "map");
constexpr int CW_BAR = 4096;
constexpr int LDS_BYTES = 147456;
constexpr int MISC_OFF = 131072 + 320;

#define XB_TMO      128
#define XB_XCNT(j)  (256  + 64 * (j))
#define XB_XSUB(j)  (1280 + 64 * (j))
#define XB_XGEN(j)  (2304 + 64 * (j))
#define XB_TOP      3328
#define XB_TOPGEN   3392
#define XCD_BAR_WORDS 3456
#define XB_SPIN_CAP (1u << 18)
__device__ __forceinline__ unsigned xb_ld(unsigned* p)              { return __hip_atomic_load(p, __ATOMIC_RELAXED, __HIP_MEMORY_SCOPE_AGENT); }
__device__ __forceinline__ unsigned xb_add(unsigned* p, unsigned v) { return __hip_atomic_fetch_add(p, v, __ATOMIC_RELAXED, __HIP_MEMORY_SCOPE_AGENT); }
__device__ __forceinline__ unsigned xb_xcc_id() { return (unsigned)__builtin_amdgcn_s_getreg((3 << 11) | 20) & 0xFu; }
#define XB_SPIN(cond, bar) do { unsigned _sp = 0; while (cond) { __builtin_amdgcn_s_sleep(1); \
    if ((++_sp & 255u) == 0u) { if (xb_ld(&(bar)[XB_TMO])) break; if (_sp > XB_SPIN_CAP) { atomicAdd(&(bar)[XB_TMO], 1u); break; } } } } while (0)
struct XcdBarrier { unsigned* bar; unsigned x; volatile LAS unsigned* st; };
__device__ __forceinline__ XcdBarrier xcd_barrier_post(unsigned* bar, volatile LAS unsigned* st) {
    XcdBarrier b; b.bar = bar; b.x = xb_xcc_id(); b.st = st;
    if (threadIdx.x == 0) (void)xb_add(&bar[XB_XCNT(b.x)], 1u);
    return b;
}
__device__ __forceinline__ void xcd_barrier_complete(unsigned* bar, unsigned x, unsigned& nloc, unsigned& nx) {
    const unsigned G = gridDim.x * gridDim.y * gridDim.z;
    unsigned sum, cnt, mine, sp = 0u;
    for (;;) {
        sum = 0u; cnt = 0u; mine = 0u;
#pragma unroll
        for (unsigned j = 0; j < 16; ++j) { const unsigned c = xb_ld(&bar[XB_XCNT(j)]); sum += c; cnt += (c > 0u) ? 1u : 0u; mine = (j == x) ? c : mine; }
        if (sum == G) break;
        __builtin_amdgcn_s_sleep(1);
        if ((++sp & 255u) == 0u) { if (xb_ld(&bar[XB_TMO])) break; if (sp > XB_SPIN_CAP) { atomicAdd(&bar[XB_TMO], 1u); break; } }
    }
    nloc = mine > 0u ? mine : 1u; nx = cnt > 0u ? cnt : 1u;
}
__device__ __forceinline__ void xcd_barrier(const XcdBarrier& b) {
    asm volatile("s_waitcnt vmcnt(0)" ::: "memory");
    __syncthreads();
    if (threadIdx.x == 0) {
        unsigned* bar = b.bar;
        __builtin_amdgcn_s_waitcnt(0);
        unsigned nloc = b.st[0], nx = b.st[1];
        if (nloc == 0u) { xcd_barrier_complete(bar, b.x, nloc, nx); b.st[0] = nloc; b.st[1] = nx; }
        const unsigned old = xb_add(&bar[XB_XSUB(b.x)], 1u);
        const unsigned gen = old / nloc;
        if (old + 1u == (gen + 1u) * nloc) {
            __builtin_amdgcn_fence(__ATOMIC_RELEASE, "agent");
            asm volatile("s_waitcnt vmcnt(0)" ::: "memory");
            const unsigned og = xb_add(&bar[XB_TOP], 1u);
            const unsigned tg = og / nx;
            if (og + 1u == (tg + 1u) * nx) xb_add(&bar[XB_TOPGEN], 1u);
            else XB_SPIN(xb_ld(&bar[XB_TOPGEN]) == tg, bar);
            __builtin_amdgcn_fence(__ATOMIC_ACQUIRE, "agent");
            xb_add(&bar[XB_XGEN(b.x)], 1u);
            asm volatile("s_waitcnt vmcnt(0)" ::: "memory");
        } else {
            XB_SPIN(xb_ld(&bar[XB_XGEN(b.x)]) == gen, bar);
            __builtin_amdgcn_fence(__ATOMIC_ACQUIRE, "agent");
            asm volatile("s_waitcnt vmcnt(0)" ::: "memory");
        }
    }
    __syncthreads();
}

namespace pg8 {
#define PG8_LAS __attribute__((address_space(3)))
typedef unsigned short bf16_t;
typedef short bf16x8 __attribute__((ext_vector_type(8)));
typedef float f32x4 __attribute__((ext_vector_type(4)));
typedef unsigned u32x4 __attribute__((ext_vector_type(4)));
constexpr int BM = 256, BK = 64, HALF = 128, HTB = HALF * BK * 2  , STAGE_BYTES = 8 * HTB, NXCD = 8, WGM = 8;

__host__ __device__ __forceinline__ int lds_byte(int r, int c) { const int st = (r >> 4) * 2 + (c >> 5), rr = r & 15, cc = c & 31, ob = rr * 64 + cc * 2; return st * 1024 + (ob ^ (((ob >> 9) & 1) << 5)); }
__host__ __device__ __forceinline__ void stage_rc(int b, int& R, int& C) { const int st = b / 1024, sb = b % 1024, swz = sb ^ (((sb >> 9) & 1) << 5); R = (st >> 1) * 16 + swz / 64; C = (st & 1) * 32 + (swz % 64) / 2; }
__host__ __device__ __forceinline__ int perm32(int rho) { const int n = rho >> 4, i = rho & 15; return 8 * (i >> 2) + 4 * n + (i & 3); }

struct Unit { int pm, pn; };
struct Gemm { const bf16_t* A; const bf16_t* Bt; int M, N, K; };

struct StaticOrder {
    int nM, nN, nwg, G, c;
    __host__ __device__ void init(int M, int N, int G_, int c_) { nM = M / BM; nN = N / BM; nwg = nM * nN; G = G_; c = c_; }
    __host__ __device__ bool next(int i, Unit& u) const {
        const long L = (long)i * G + c; if (L >= nwg) return false;
        int wgid = (int)L; { const int q = nwg / NXCD, r = nwg % NXCD, xcd = wgid % NXCD, off = wgid / NXCD; wgid = (xcd < r ? xcd * (q + 1) : r * (q + 1) + (xcd - r) * q) + off; }
        const int nig = WGM * nN, gid = wgid / nig, fm = gid * WGM, gsz = (nM - fm) < WGM ? (nM - fm) : WGM;
        u.pm = fm + ((wgid % nig) % gsz); u.pn = (wgid % nig) / gsz; return true;
    }
    __device__ __forceinline__ void a_ready(const Unit&) const {}
    __device__ __forceinline__ void done(const Unit&) const {}
};

__device__ __forceinline__ unsigned cvt_pk_bf16(float lo, float hi) { unsigned r; asm volatile("v_cvt_pk_bf16_f32 %0, %1, %2" : "=v"(r) : "v"(lo), "v"(hi)); return r; }
typedef float f32x2 __attribute__((ext_vector_type(2)));
__device__ __forceinline__ f32x2 gelu_pk(f32x2 v) {
    const f32x2 av = __builtin_elementwise_abs(v), d = av * 0.2316418882f + 1.0f;
    f32x2 t; t.x = __builtin_amdgcn_rcpf(d.x); t.y = __builtin_amdgcn_rcpf(d.y);
    f32x2 q = t * 0.5307027145f + (-0.7265760135f); q = q * t + 0.7107068705f; q = q * t + (-0.142248368f); q = q * t + 0.127414796f; q = q * t;
    const f32x2 s = (v * v) * (-0.72134752044f);
    f32x2 e; e.x = __builtin_amdgcn_exp2f(s.x); e.y = __builtin_amdgcn_exp2f(s.y);
    const f32x2 m = v * (q * e), r = v - m;
    f32x2 o; o.x = v.x < 0.f ? m.x : r.x; o.y = v.y < 0.f ? m.y : r.y; return o;
}

template <int ACT  > struct EpiBf16 {
    static constexpr bool PERM = true, AFTER_DRAIN = false; static_assert(ACT == 0 || ACT == 1, "EpiBf16: ACT is 0 (none) or 1 (gelu_pk)");
    bf16_t* O; int ldc; const float* bias; int split_cols; size_t split_stride; float scale0;
    __device__ __forceinline__ void operator()(const f32x4 (&acc)[2][2][4][2], const Unit& u, int wr, int wc, int fr, int fq) const {
        const int row0 = u.pm * BM + wr * 64 + fr; int colt = u.pn * BM; bf16_t* base = O;
        float sc = 1.f; if (split_cols) { const int t = colt / split_cols; base += (size_t)t * split_stride; colt -= t * split_cols; if (t == 0) sc = scale0; }
        const int col0 = colt + wc * 32 + 8 * fq, bcol0 = u.pn * BM + wc * 32 + 8 * fq;
        f32x4 bv[2][2];
#pragma unroll
        for (int bj = 0; bj < 2; ++bj)
#pragma unroll
            for (int n = 0; n < 2; ++n) bv[bj][n] = bias ? *(const f32x4*)(bias + bcol0 + bj * HALF + 4 * n) : (f32x4){0.f, 0.f, 0.f, 0.f};
#pragma unroll
        for (int ai = 0; ai < 2; ++ai)
#pragma unroll
            for (int m = 0; m < 4; ++m) { bf16_t* rowp = base + (size_t)(row0 + ai * HALF + m * 16) * ldc + col0;
#pragma unroll
                for (int bj = 0; bj < 2; ++bj) { f32x4 v0 = acc[ai][bj][m][0] + bv[bj][0], v1 = acc[ai][bj][m][1] + bv[bj][1];
                    if (ACT == 1) { f32x2 a = gelu_pk((f32x2){v0[0], v0[1]}), b = gelu_pk((f32x2){v0[2], v0[3]}), c = gelu_pk((f32x2){v1[0], v1[1]}), d = gelu_pk((f32x2){v1[2], v1[3]});
                        v0 = (f32x4){a.x, a.y, b.x, b.y}; v1 = (f32x4){c.x, c.y, d.x, d.y}; }
                    v0 = v0 * sc; v1 = v1 * sc; u32x4 w; w.x = cvt_pk_bf16(v0[0], v0[1]); w.y = cvt_pk_bf16(v0[2], v0[3]); w.z = cvt_pk_bf16(v1[0], v1[1]); w.w = cvt_pk_bf16(v1[2], v1[3]);
                    *(u32x4*)(rowp + bj * HALF) = w; } }
    }
};


struct EpiF32 {
    static constexpr bool PERM = false, AFTER_DRAIN = false;
    float* C; int ldc; const float* bias;
    __device__ __forceinline__ void operator()(const f32x4 (&acc)[2][2][4][2], const Unit& u, int wr, int wc, int fr, int fq) const {
        const int row0 = u.pm * BM + wr * 64 + fr, col0 = u.pn * BM + wc * 32 + 4 * fq;
        f32x4 bv[2][2];
#pragma unroll
        for (int bj = 0; bj < 2; ++bj)
#pragma unroll
            for (int n = 0; n < 2; ++n) bv[bj][n] = bias ? *(const f32x4*)(bias + col0 + bj * HALF + n * 16) : (f32x4){0.f, 0.f, 0.f, 0.f};
#pragma unroll
        for (int ai = 0; ai < 2; ++ai)
#pragma unroll
            for (int m = 0; m < 4; ++m) { float* rowp = C + (size_t)(row0 + ai * HALF + m * 16) * ldc + col0;
#pragma unroll
                for (int bj = 0; bj < 2; ++bj)
#pragma unroll
                    for (int n = 0; n < 2; ++n) *(f32x4*)(rowp + bj * HALF + n * 16) = acc[ai][bj][m][n] + bv[bj][n]; }
    }
};

template <class Epi, class Sched, bool ALIGN_EPI = false, bool SP2 = false>
__device__ __forceinline__ void gemm_phase(PG8_LAS unsigned char* lds, const Gemm g, const Sched& S, const Epi& E) {
    const int tid = threadIdx.x, wid = __builtin_amdgcn_readfirstlane(tid >> 6), lane = tid & 63, wr = wid >> 2, wc = wid & 3, fr = lane & 15, fq = lane >> 4;
    const int K = g.K, nt = K / BK;
    unsigned voffA[2], voffB[2];
#pragma unroll
    for (int i = 0; i < 2; ++i) { int R, C; stage_rc(tid * 16 + i * 8192, R, C); const int Rb = Epi::PERM ? ((R & ~31) + perm32(R & 31)) : R;
        voffA[i] = (unsigned)(R * K + C) * 2u; voffB[i] = (unsigned)(Rb * K + C) * 2u; }
    const size_t kstep = (size_t)(BK * 2);
    const size_t hstep = (size_t)HALF * K * 2;
    const size_t tstep = 2 * hstep;
    const unsigned ldsw = (unsigned)wid * 1024u;
    const int aoff = lds_byte(wr * 64 + fr, fq * 8), boff = lds_byte(wc * 32 + fr, fq * 8);
#define PG8_SA(b, h) (((b) * 2 + (h)) * HTB)
#define PG8_SB(b, h) ((4 + (b) * 2 + (h)) * HTB)
#define PG8_STAGE(bufoff, gbase, voff) do { _Pragma("unroll") for (int _i = 0; _i < 2; ++_i) \
        __builtin_amdgcn_global_load_lds((const unsigned*)((const char*)(gbase) + (voff)[_i]), (PG8_LAS unsigned*)(lds + (bufoff) + ldsw + _i * 8192), 16, 0, 0); } while (0)
#define PG8_LDA(dst, b, h) do { _Pragma("unroll") for (int m = 0; m < 4; ++m) _Pragma("unroll") for (int k = 0; k < 2; ++k) dst[m][k] = *(const PG8_LAS bf16x8*)(lds + PG8_SA(b, h) + aoff + m * 2048 + k * 1024); } while (0)
#define PG8_LDB(dst, b, h) do { _Pragma("unroll") for (int n = 0; n < 2; ++n) _Pragma("unroll") for (int k = 0; k < 2; ++k) dst[n][k] = *(const PG8_LAS bf16x8*)(lds + PG8_SB(b, h) + boff + n * 2048 + k * 1024); } while (0)
#define PG8_MMA(ai, bj, At, Bt) do { __builtin_amdgcn_s_setprio(1); _Pragma("unroll") for (int m = 0; m < 4; ++m) _Pragma("unroll") for (int n = 0; n < 2; ++n) _Pragma("unroll") for (int k = 0; k < 2; ++k) \
        acc[ai][bj][m][n] = __builtin_amdgcn_mfma_f32_16x16x32_bf16(Bt[n][k], At[m][k], acc[ai][bj][m][n], 0, 0, 0); __builtin_amdgcn_s_setprio(0); } while (0)
#define PG8_WAIT_V(n) asm volatile("s_waitcnt vmcnt(" #n ")" ::: "memory")
#define PG8_WAIT_L(n) asm volatile("s_waitcnt lgkmcnt(" #n ")" ::: "memory")
#define PG8_BAR __builtin_amdgcn_s_barrier()
#define PG8_SCHED __builtin_amdgcn_sched_barrier(0)
    Unit cur, nxt; int ui = 0;
    if (!S.next(0, cur)) return;
    f32x4 acc[2][2][4][2];
#pragma unroll
    for (int a = 0; a < 2; ++a)
#pragma unroll
        for (int b = 0; b < 2; ++b)
#pragma unroll
            for (int m = 0; m < 4; ++m)
#pragma unroll
                for (int n = 0; n < 2; ++n) acc[a][b][m][n] = (f32x4){0.f, 0.f, 0.f, 0.f};
    bf16x8 At[4][2], B0[2][2], B1[2][2];
    const char* cA = (const char*)g.A + (size_t)cur.pm * tstep; const char* cB = (const char*)g.Bt + (size_t)cur.pn * tstep;
    S.a_ready(cur);
    if constexpr (SP2) {
        PG8_STAGE(PG8_SB(0, 0), cB, voffB); PG8_STAGE(PG8_SB(0, 1), cB + hstep, voffB); PG8_STAGE(PG8_SA(0, 0), cA, voffA); PG8_STAGE(PG8_SA(0, 1), cA + hstep, voffA);
        if (wr == 1) PG8_BAR;
        PG8_WAIT_V(2); PG8_BAR;
        PG8_STAGE(PG8_SB(1, 0), cB + kstep, voffB); PG8_STAGE(PG8_SA(1, 0), cA + kstep, voffA); PG8_STAGE(PG8_SB(1, 1), cB + hstep + kstep, voffB);
        PG8_WAIT_V(6); PG8_BAR;
    } else {
        PG8_STAGE(PG8_SB(0, 0), cB, voffB); PG8_STAGE(PG8_SA(0, 0), cA, voffA); PG8_STAGE(PG8_SB(0, 1), cB + hstep, voffB); PG8_STAGE(PG8_SA(0, 1), cA + hstep, voffA);
        if (wr == 1) PG8_BAR;
        PG8_WAIT_V(4); PG8_BAR;
        PG8_STAGE(PG8_SB(1, 0), cB + kstep, voffB); PG8_STAGE(PG8_SA(1, 0), cA + kstep, voffA); PG8_STAGE(PG8_SB(1, 1), cB + hstep + kstep, voffB);
        PG8_WAIT_V(6); PG8_BAR;
    }
    for (;;) {
        const bool has_next = S.next(ui + 1, nxt);
        const char* nA = has_next ? (const char*)g.A + (size_t)nxt.pm * tstep : cA; const char* nB = has_next ? (const char*)g.Bt + (size_t)nxt.pn * tstep : cB;
        for (int t = 0; t < nt; t += 2) {
            const bool last = (t == nt - 2);
            const char* a1 = cA + (size_t)(t + 1) * kstep;
            const char* a2 = last ? nA : cA + (size_t)(t + 2) * kstep; const char* b2 = last ? nB : cB + (size_t)(t + 2) * kstep;
            const char* a3 = a2 + kstep; const char* b3 = b2 + kstep;
            if (last && has_next) S.a_ready(nxt);
            if constexpr (SP2) {
            PG8_LDB(B0, 0, 0); PG8_LDB(B1, 0, 1); PG8_SCHED; PG8_LDA(At, 0, 0); PG8_STAGE(PG8_SA(1, 1), a1 + hstep, voffA);
            PG8_WAIT_V(8); PG8_WAIT_L(0); PG8_BAR; PG8_MMA(0, 0, At, B0); PG8_MMA(0, 1, At, B1); PG8_BAR; PG8_SCHED;
            PG8_LDA(At, 0, 1); PG8_STAGE(PG8_SB(0, 0), b2, voffB); PG8_STAGE(PG8_SB(0, 1), b2 + hstep, voffB); PG8_STAGE(PG8_SA(0, 0), a2, voffA);
            PG8_WAIT_V(8); PG8_WAIT_L(0); PG8_BAR; PG8_MMA(1, 0, At, B0); PG8_MMA(1, 1, At, B1); PG8_BAR; PG8_SCHED;
            PG8_LDB(B0, 1, 0); PG8_LDB(B1, 1, 1); PG8_SCHED; PG8_LDA(At, 1, 0); PG8_STAGE(PG8_SA(0, 1), a2 + hstep, voffA);
            PG8_WAIT_V(8); PG8_WAIT_L(0); PG8_BAR; PG8_MMA(0, 0, At, B0); PG8_MMA(0, 1, At, B1); PG8_BAR; PG8_SCHED;
            PG8_LDA(At, 1, 1); PG8_STAGE(PG8_SB(1, 0), b3, voffB); PG8_STAGE(PG8_SB(1, 1), b3 + hstep, voffB); PG8_STAGE(PG8_SA(1, 0), a3, voffA);
            PG8_WAIT_V(8); PG8_WAIT_L(0); PG8_BAR; PG8_MMA(1, 0, At, B0); PG8_MMA(1, 1, At, B1); PG8_BAR; PG8_SCHED;
            } else {
            PG8_LDB(B0, 0, 0); PG8_SCHED; PG8_LDA(At, 0, 0); PG8_STAGE(PG8_SA(1, 1), a1 + hstep, voffA);
            PG8_WAIT_L(8); PG8_BAR; PG8_WAIT_L(0); PG8_MMA(0, 0, At, B0); PG8_BAR; PG8_SCHED;
            PG8_LDB(B1, 0, 1); PG8_STAGE(PG8_SB(0, 0), b2, voffB);
            PG8_BAR; PG8_WAIT_L(0); PG8_MMA(0, 1, At, B1); PG8_BAR;
            PG8_LDA(At, 0, 1); PG8_STAGE(PG8_SA(0, 0), a2, voffA);
            PG8_BAR; PG8_WAIT_L(0); PG8_MMA(1, 0, At, B0); PG8_BAR; PG8_SCHED;
            PG8_STAGE(PG8_SB(0, 1), b2 + hstep, voffB);
            PG8_WAIT_V(6); PG8_BAR; PG8_MMA(1, 1, At, B1); PG8_BAR;
            PG8_LDB(B0, 1, 0); PG8_SCHED; PG8_LDA(At, 1, 0); PG8_STAGE(PG8_SA(0, 1), a2 + hstep, voffA);
            PG8_WAIT_L(8); PG8_BAR; PG8_WAIT_L(0); PG8_MMA(0, 0, At, B0); PG8_BAR; PG8_SCHED;
            PG8_LDB(B1, 1, 1); PG8_STAGE(PG8_SB(1, 0), b3, voffB);
            PG8_BAR; PG8_WAIT_L(0); PG8_MMA(0, 1, At, B1); PG8_BAR;
            PG8_LDA(At, 1, 1); PG8_STAGE(PG8_SA(1, 0), a3, voffA);
            PG8_BAR; PG8_WAIT_L(0); PG8_MMA(1, 0, At, B0); PG8_BAR; PG8_SCHED;
            PG8_STAGE(PG8_SB(1, 1), b3 + hstep, voffB);
            PG8_WAIT_V(6); PG8_BAR; PG8_MMA(1, 1, At, B1); PG8_BAR;
            }
        }
        if constexpr (ALIGN_EPI) { if (wr == 0) PG8_BAR; }
        if constexpr (!Epi::AFTER_DRAIN) { E(acc, cur, wr, wc, fr, fq); S.done(cur); }
        if (!has_next) break;
#pragma unroll
        for (int a = 0; a < 2; ++a)
#pragma unroll
            for (int b = 0; b < 2; ++b)
#pragma unroll
                for (int m = 0; m < 4; ++m)
#pragma unroll
                    for (int n = 0; n < 2; ++n) acc[a][b][m][n] = (f32x4){0.f, 0.f, 0.f, 0.f};
        cur = nxt; cA = nA; cB = nB; ++ui;
        if constexpr (ALIGN_EPI) { if (wr == 1) PG8_BAR; }
    }
    PG8_WAIT_V(0);
    if constexpr (!ALIGN_EPI) { if (wr == 0) PG8_BAR; }
    PG8_BAR;
    if constexpr (Epi::AFTER_DRAIN) { E.fused(acc, cur, wr, wc, fr, fq, lds, wid, lane); S.done(cur); }
#undef PG8_SA
#undef PG8_SB
#undef PG8_STAGE
#undef PG8_LDA
#undef PG8_LDB
#undef PG8_MMA
#undef PG8_WAIT_V
#undef PG8_WAIT_L
#undef PG8_BAR
#undef PG8_SCHED
}
}
#define PG8_SP2 true
#define PG8_ALIGN true

#define LDS_FENCE() asm volatile("s_waitcnt lgkmcnt(0)" ::: "memory")
__device__ __forceinline__ unsigned f2bf(float f) { unsigned u = __builtin_bit_cast(unsigned, f); return (u + 0x7fffu + ((u >> 16) & 1u)) >> 16; }
__device__ __forceinline__ unsigned pk2(float lo, float hi) { return f2bf(lo) | (f2bf(hi) << 16); }
__device__ __forceinline__ float wave_sum(float v) {
#pragma unroll
    for (int o = 1; o < 64; o <<= 1) v += __shfl_xor(v, o);
    return v;
}
__device__ __forceinline__ float wave_max(float v) {
#pragma unroll
    for (int o = 1; o < 64; o <<= 1) v = fmaxf(v, __shfl_xor(v, o));
    return v;
}
__device__ __forceinline__ float silu_f(float x) { return x / (1.0f + expf(-x)); }
__device__ __forceinline__ float gelu_f(float x) { return 0.5f * x * (1.0f + erff(x * 0.70710678118654752f)); }
__device__ __forceinline__ float log_sigmoid_f(float z) { return fminf(z, 0.0f) - log1pf(expf(-fabsf(z))); }

struct Params {
    const float* in[19];
    float* out;
    unsigned char* ws;
    int ph_lo, ph_hi;
};
enum { I_X = 0, I_C, I_CTX, I_CCTX, I_WADA, I_BADA, I_WIN, I_CONVW, I_GW2, I_GB2, I_GNORM, I_SINK, I_WOUT, I_LNG, I_LNB, I_PWQ, I_PSUB, I_PU, I_PV };

__device__ __forceinline__ int row_stream(int r) { return r < TL ? r / SEQ : 2; }

__device__ __forceinline__ void transpose_item(const float* W, int K, int N, bf16_t* WT, LAS float* scr, int item, int lane) {
    const int nblk = N / 32, kb = item / nblk, nb = item % nblk, k0 = 64 * kb, n0 = 32 * nb;
#pragma unroll 8
    for (int i = 0; i < 32; ++i) { const int kk = 2 * i + (lane >> 5); scr[kk * 33 + (lane & 31)] = W[(size_t)(k0 + kk) * N + n0 + (lane & 31)]; }
    LDS_FENCE();
    const int c = lane & 7;
#pragma unroll
    for (int j = 0; j < 4; ++j) { const int n = (lane >> 3) + 8 * j; const LAS float* s = scr + (8 * c) * 33 + n;
        u32x4 o; o.x = pk2(s[0 * 33], s[1 * 33]); o.y = pk2(s[2 * 33], s[3 * 33]); o.z = pk2(s[4 * 33], s[5 * 33]); o.w = pk2(s[6 * 33], s[7 * 33]);
        *(u32x4*)(WT + (size_t)(n0 + n) * K + k0 + 8 * c) = o; }
    LDS_FENCE();
}

__device__ __forceinline__ void phase_prologue(const Params& p, LAS unsigned char* lds, int tid, int lane, int wave, int bid, int G) {
    const int gw = bid * NWAVES + wave, NGW = G * NWAVES;
    LAS float* scr = (LAS float*)(lds + wave * 16384);
    bf16_t* WIN = (bf16_t*)(p.ws + WS_WIN); bf16_t* WOUT = (bf16_t*)(p.ws + WS_WOUT); bf16_t* WQ = (bf16_t*)(p.ws + WS_WQ);
    constexpr int IT_IN = (DM / 64) * (INW / 32), IT_SQ = (DM / 64) * (DM / 32), IT_L = IT_IN + 2 * IT_SQ;
    for (int it = gw; it < DEPTH * IT_L; it += NGW) {
        const int l = it / IT_L; int r = it % IT_L;
        if (r < IT_IN) { transpose_item(p.in[I_WIN] + (size_t)l * DM * INW, DM, INW, WIN + (size_t)l * INWP * DM, scr, r, lane); continue; } r -= IT_IN;
        if (r < IT_SQ) { transpose_item(p.in[I_WOUT] + (size_t)l * DM * DM, DM, DM, WOUT + (size_t)l * DM * DM, scr, r, lane); continue; } r -= IT_SQ;
        transpose_item(p.in[I_PWQ] + (size_t)l * DM * DM, DM, DM, WQ + (size_t)l * DM * DM, scr, r, lane);
    }
    {
        constexpr int PADV = (INWP - INW) * DM / 8;
        const int gt = bid * NTHREADS + tid, NGT = G * NTHREADS;
        for (int i = gt; i < DEPTH * PADV; i += NGT) { const int l = i / PADV, o = i % PADV;
            *(u32x4*)(WIN + (size_t)l * INWP * DM + (size_t)INW * DM + (size_t)o * 8) = (u32x4){0u, 0u, 0u, 0u}; }
    }
    __syncthreads();
    LAS float* sc = (LAS float*)lds;
    LAS float* red = (LAS float*)(lds + 32768);
    for (int i = tid; i < 3 * DM; i += NTHREADS) { const int s = i / DM, k = i % DM; const float v = s < 2 ? p.in[I_C][s * DM + k] : p.in[I_CCTX][k]; sc[i] = silu_f(v); }
    __syncthreads();
    float* MOD = (float*)(p.ws + WS_MOD);
    constexpr int NCH = 6 * DM / 64;
    for (int it = bid; it < DEPTH * NCH; it += G) {
        const int l = it / NCH, n = (it % NCH) * 64 + lane;
        const float* wp = p.in[I_WADA] + (size_t)l * DM * 6 * DM + n;
        float a0 = 0.f, a1 = 0.f, a2 = 0.f;
        const int kb = wave * (DM / NWAVES);
#pragma unroll 8
        for (int k = kb; k < kb + DM / NWAVES; ++k) { const float w = wp[(size_t)k * 6 * DM]; a0 += sc[k] * w; a1 += sc[DM + k] * w; a2 += sc[2 * DM + k] * w; }
        red[(wave * 3 + 0) * 64 + lane] = a0; red[(wave * 3 + 1) * 64 + lane] = a1; red[(wave * 3 + 2) * 64 + lane] = a2;
        __syncthreads();
        if (tid < 192) { const int s = tid / 64, ln = tid % 64; float v = 0.f;
#pragma unroll
            for (int w = 0; w < NWAVES; ++w) v += red[(w * 3 + s) * 64 + ln];
            const int nn = (it % NCH) * 64 + ln;
            MOD[((size_t)l * 3 + s) * 6 * DM + nn] = v + p.in[I_BADA][(size_t)l * 6 * DM + nn]; }
        __syncthreads();
    }
}

__device__ __forceinline__ const float* xsrc(const Params& p, int l, int r) {
    if (l > 0) return (const float*)(p.ws + WS_XL) + (size_t)r * DM;
    return r < TL ? p.in[I_X] + (size_t)r * DM : p.in[I_CTX] + (size_t)(r - TL) * DM;
}

__device__ __forceinline__ void modulate_row(const float* xr, const float* mod, int sh_off, int sc_off, bf16_t* hb, int lane) {
#pragma unroll
    for (int j = 0; j < 8; ++j) { const int c = lane * 4 + 256 * j;
        const f32x4 x = *(const f32x4*)(xr + c), sh = *(const f32x4*)(mod + sh_off + c), s = *(const f32x4*)(mod + sc_off + c);
        u32x2 o; o.x = pk2(x.x * (1.f + s.x) + sh.x, x.y * (1.f + s.y) + sh.y); o.y = pk2(x.z * (1.f + s.z) + sh.z, x.w * (1.f + s.w) + sh.w);
        *(u32x2*)(hb + c) = o; }
}
__device__ __forceinline__ void phase_modulate0(const Params& p, int lane, int wave, int bid, int G) {
    const int gw = bid * NWAVES + wave, NGW = G * NWAVES;
    const float* MOD = (const float*)(p.ws + WS_MOD); bf16_t* HB = (bf16_t*)(p.ws + WS_HB);
    for (int r = gw; r < TA; r += NGW) modulate_row(xsrc(p, 0, r), MOD + (size_t)(0 * 3 + row_stream(r)) * 6 * DM, 0, DM, HB + (size_t)r * DM, lane);
}

__device__ __forceinline__ void gemm_direct(const bf16_t* A, const bf16_t* Bt, float* C, int M, int N, int K, int ldc, int gw, int NGW, int lane) {
    const int nTn = N / 64, nItems = (M / 32) * nTn;
    const int fr = lane & 15, fq = lane >> 4;
    for (int it = gw; it < nItems; it += NGW) {
        const int mt = it / nTn, nt = it % nTn;
        const bf16_t* a0 = A + (size_t)(mt * 32 + fr) * K + fq * 8;
        const bf16_t* b0 = Bt + (size_t)(nt * 64 + fr) * K + fq * 8;
        f32x4 acc[2][4];
#pragma unroll
        for (int i = 0; i < 2; ++i)
#pragma unroll
            for (int j = 0; j < 4; ++j) acc[i][j] = (f32x4){0.f, 0.f, 0.f, 0.f};
#pragma unroll 2
        for (int k0 = 0; k0 < K; k0 += 32) {
            bf16x8 af[2], bfr[4];
#pragma unroll
            for (int i = 0; i < 2; ++i) af[i] = *(const bf16x8*)(a0 + (size_t)i * 16 * K + k0);
#pragma unroll
            for (int j = 0; j < 4; ++j) bfr[j] = *(const bf16x8*)(b0 + (size_t)j * 16 * K + k0);
#pragma unroll
            for (int i = 0; i < 2; ++i)
#pragma unroll
                for (int j = 0; j < 4; ++j) acc[i][j] = __builtin_amdgcn_mfma_f32_16x16x32_bf16(af[i], bfr[j], acc[i][j], 0, 0, 0);
        }
#pragma unroll
        for (int i = 0; i < 2; ++i)
#pragma unroll
            for (int j = 0; j < 4; ++j)
#pragma unroll
                for (int g = 0; g < 4; ++g) C[(size_t)(mt * 32 + i * 16 + fq * 4 + g) * ldc + nt * 64 + j * 16 + fr] = acc[i][j][g];
    }
}

__device__ __forceinline__ void phase_post_in(const Params& p, int l, int lane, int wave, int bid, int G) {
    const int gw = bid * NWAVES + wave, NGW = G * NWAVES;
    const float* P = (const float*)(p.ws + WS_P);
    float* QR = (float*)(p.ws + WS_QR); float* KR = (float*)(p.ws + WS_KR);
    bf16_t* MIX = (bf16_t*)(p.ws + WS_MIX);
    const float* cw = p.in[I_CONVW] + (size_t)l * 3 * 512;
    for (int r = gw; r < TA; r += NGW) {
        const float* pr = P + (size_t)r * INWP;
        int pos, len;
        if (r < TL) { pos = r % SEQ; len = SEQ; } else { pos = (r - TL) % CTXL; len = CTXL; }
#pragma unroll 1
        for (int j = 0; j < 8; ++j) { const int c = lane + 64 * j;
            float a = cw[512 + c] * pr[C_CC + c] * pr[C_CX + c];
            if (pos > 0) a += cw[c] * pr[C_CC + c - INWP] * pr[C_CX + c - INWP];
            if (pos < len - 1) a += cw[1024 + c] * pr[C_CC + c + INWP] * pr[C_CX + c + INWP];
            MIX[(size_t)r * DM + c] = (bf16_t)f2bf(pr[C_CB + c] * a); }
        if (r < TL) {
            const int half = lane >> 5, i = lane & 31;
            const float invf = powf(10000.0f, -(float)i / 32.0f);
            const float ang = (float)(half ? (pos % 64) : (pos / 64)) * invf;
            float sn, cs; sincosf(ang, &sn, &cs);
#pragma unroll 2
            for (int h = 0; h < 8; ++h) { const float* q = pr + C_SQ + h * 128 + half * 64; const float x1 = q[i], x2 = q[32 + i];
                float* o = QR + (size_t)r * 1024 + h * 128 + half * 64;
                o[i] = (x1 * cs - x2 * sn) * 0.08838834764831845f; o[32 + i] = (x2 * cs + x1 * sn) * 0.08838834764831845f; }
#pragma unroll
            for (int h = 0; h < 2; ++h) { const float* k = pr + C_SK + h * 128 + half * 64; const float x1 = k[i], x2 = k[32 + i];
                float* o = KR + (size_t)r * 256 + h * 128 + half * 64;
                o[i] = x1 * cs - x2 * sn; o[32 + i] = x2 * cs + x1 * sn; }
        }
    }
}

__device__ __forceinline__ void swa_item(LAS float* qs, LAS float* ps, const float* kA, size_t ksA, const float* vA, size_t vsA, int nA,
                                         const float* kB, size_t ksB, const float* vB, size_t vsB, int nB, float sink, bf16_t* out, int lane) {
    const int ntot = nA + nB;
    float mx = sink;
    for (int j = lane; j < ntot; j += 64) {
        const float* kr = j < nA ? kA + (size_t)j * ksA : kB + (size_t)(j - nA) * ksB;
        float s = 0.f;
#pragma unroll 8
        for (int d = 0; d < 128; d += 4) { const f32x4 kv = *(const f32x4*)(kr + d); const f32x4 qv = *(const LAS f32x4*)(qs + d); s += kv.x * qv.x + kv.y * qv.y + kv.z * qv.z + kv.w * qv.w; }
        ps[j] = s; mx = fmaxf(mx, s);
    }
    mx = wave_max(mx);
    float sum = 0.f;
    for (int j = lane; j < ntot; j += 64) { const float e = expf(ps[j] - mx); ps[j] = e; sum += e; }
    sum = wave_sum(sum) + expf(sink - mx);
    LDS_FENCE();
    const float inv = 1.0f / sum;
    float o0 = 0.f, o1 = 0.f;
#pragma unroll 4
    for (int j = 0; j < ntot; ++j) { const float* vr = j < nA ? vA + (size_t)j * vsA : vB + (size_t)(j - nA) * vsB; const float pj = ps[j]; o0 += pj * vr[lane]; o1 += pj * vr[lane + 64]; }
    out[lane] = (bf16_t)f2bf(o0 * inv); out[lane + 64] = (bf16_t)f2bf(o1 * inv);
    LDS_FENCE();
}

__device__ __forceinline__ void phase_mixers(const Params& p, int l, LAS unsigned char* lds, int tid, int lane, int wave, int bid, int G) {
    LAS float* wl = (LAS float*)(lds + wave * 16384);
    const int gw = bid * NWAVES + wave, NGW = G * NWAVES;
    const float* P = (const float*)(p.ws + WS_P);
    const float* QR = (const float*)(p.ws + WS_QR); const float* KR = (const float*)(p.ws + WS_KR);
    bf16_t* MIX = (bf16_t*)(p.ws + WS_MIX);
    const float* sinkp = p.in[I_SINK] + l * 8;
    LAS float* qs = wl; LAS float* ps = wl + 128;
    const bool with_ctx = (l < DEPTH - 1);
    const int nItems = (with_ctx ? TA : TL) * 8;
    for (int it = gw; it < nItems; it += NGW) {
        const int r = it >> 3, hq = it & 7, hk = hq >> 2;
        bf16_t* out = MIX + (size_t)r * DM + 1024 + hq * 128;
        if (r < TL) {
            const int b = r / SEQ, n = r % SEQ;
            qs[lane] = QR[(size_t)r * 1024 + hq * 128 + lane]; qs[lane + 64] = QR[(size_t)r * 1024 + hq * 128 + lane + 64];
            LDS_FENCE();
            const int lo = n - 128 < 0 ? 0 : n - 128, hi = n + 128 > SEQ - 1 ? SEQ - 1 : n + 128;
            const size_t r0 = (size_t)b * SEQ + lo, c0 = (size_t)TL + (size_t)b * CTXL;
            swa_item(qs, ps, KR + r0 * 256 + hk * 128, 256, P + r0 * INWP + C_SV + hk * 128, INWP, hi - lo + 1,
                     P + c0 * INWP + C_SK + hk * 128, INWP, P + c0 * INWP + C_SV + hk * 128, INWP, CTXL, sinkp[hq], out, lane);
        } else {
            const int b = (r - TL) / CTXL;
            const float* q = P + (size_t)r * INWP + C_SQ + hq * 128;
            qs[lane] = q[lane] * 0.08838834764831845f; qs[lane + 64] = q[lane + 64] * 0.08838834764831845f;
            LDS_FENCE();
            const size_t c0 = (size_t)TL + (size_t)b * CTXL;
            swa_item(qs, ps, P, 0, P, 0, 0, P + c0 * INWP + C_SK + hk * 128, INWP, P + c0 * INWP + C_SV + hk * 128, INWP, CTXL, sinkp[hq], out, lane);
        }
    }
}

__device__ __forceinline__ int chunk_row0(int cid) { return cid < 256 ? (cid >> 7) * SEQ + (cid & 127) * 64 : TL + ((cid - 256) >> 2) * CTXL + ((cid - 256) & 3) * 64; }
constexpr int GP = 72;

__device__ __forceinline__ void gla_g1(const Params& p, int l, LAS unsigned char* lds, int tid, int lane, int wave, int bid, int G) {
    LAS float* Bf = (LAS float*)lds; LAS float* Bb = Bf + 4096;
    LAS bf16_t* KTf = (LAS bf16_t*)(lds + 32768); LAS bf16_t* KTb = KTf + 64 * GP;
    LAS bf16_t* VT = KTb + 64 * GP;
    const float* P = (const float*)(p.ws + WS_P);
    float* BF = (float*)(p.ws + WS_OF); float* BB = (float*)(p.ws + WS_OB);
    float* DELTA = (float*)(p.ws + WS_DELTA); float* DEC = (float*)(p.ws + WS_DEC);
    const float* w2 = p.in[I_GW2] + (size_t)l * 2 * 16 * 256; const float* b2 = p.in[I_GB2] + (size_t)l * 2 * 256;
    const int fr = lane & 15, fq = lane >> 4;
    for (int item = bid; item < GLA_ITEMS; item += G) {
        const int cid = item >> 2, h = item & 3, row0 = chunk_row0(cid);
#pragma unroll 1
        for (int j = 0; j < 16; ++j) { const int e = tid + NTHREADS * j, dir = e >> 12, i = (e >> 6) & 63, k = e & 63;
            const float* lr = P + (size_t)(row0 + i) * INWP + (dir ? C_LRB : C_LRF);
            float z = b2[dir * 256 + h * 64 + k];
#pragma unroll
            for (int q = 0; q < 16; ++q) z += lr[q] * w2[(dir * 16 + q) * 256 + h * 64 + k];
            (dir ? Bb : Bf)[i * 64 + k] = log_sigmoid_f(z) * (1.0f / 16.0f); }
        __syncthreads();
        if (tid < 128) { const int dir = tid >> 6, k = tid & 63; LAS float* Bl = dir ? Bb : Bf; float* BG = (dir ? BB : BF) + (size_t)row0 * 256 + h * 64 + k; float a = 0.f;
            if (dir == 0) { for (int i = 0; i < 64; ++i) { a += Bl[i * 64 + k]; Bl[i * 64 + k] = a; BG[(size_t)i * 256] = a; } }
            else { for (int i = 63; i >= 0; --i) { a += Bl[i * 64 + k]; Bl[i * 64 + k] = a; BG[(size_t)i * 256] = a; } } }
        __syncthreads();
#pragma unroll 1
        for (int j = 0; j < 8; ++j) { const int e = tid + NTHREADS * j, i = e >> 6, k = e & 63;
            const float kv = P[(size_t)(row0 + i) * INWP + C_GK + h * 64 + k];
            KTf[k * GP + i] = (bf16_t)f2bf(kv * expf(Bf[63 * 64 + k] - Bf[i * 64 + k]));
            KTb[k * GP + i] = (bf16_t)f2bf(kv * expf(Bb[k] - Bb[i * 64 + k])); }
#pragma unroll 1
        for (int j = 0; j < 16; ++j) { const int e = tid + NTHREADS * j, i = e >> 7, v = e & 127;
            VT[v * GP + i] = (bf16_t)f2bf(P[(size_t)(row0 + i) * INWP + C_GV + h * 128 + v]); }
        if (tid < 128) { const int dir = tid >> 6, k = tid & 63; DEC[((size_t)item * 2 + dir) * 64 + k] = expf(dir ? Bb[k] : Bf[63 * 64 + k]); }
        __syncthreads();
        { const int dir = wave >> 2, vq = wave & 3; const LAS bf16_t* KT = dir ? KTb : KTf;
            f32x4 acc[2][4];
#pragma unroll
            for (int a = 0; a < 2; ++a)
#pragma unroll
                for (int b = 0; b < 4; ++b) acc[a][b] = (f32x4){0.f, 0.f, 0.f, 0.f};
#pragma unroll
            for (int ks = 0; ks < 2; ++ks) { bf16x8 af[2], bfr[4];
#pragma unroll
                for (int a = 0; a < 2; ++a) af[a] = *(const LAS bf16x8*)(VT + ((vq * 2 + a) * 16 + fr) * GP + ks * 32 + fq * 8);
#pragma unroll
                for (int b = 0; b < 4; ++b) bfr[b] = *(const LAS bf16x8*)(KT + (b * 16 + fr) * GP + ks * 32 + fq * 8);
#pragma unroll
                for (int a = 0; a < 2; ++a)
#pragma unroll
                    for (int b = 0; b < 4; ++b) acc[a][b] = __builtin_amdgcn_mfma_f32_16x16x32_bf16(af[a], bfr[b], acc[a][b], 0, 0, 0); }
            float* dst = DELTA + ((size_t)item * 2 + dir) * 8192;
#pragma unroll
            for (int a = 0; a < 2; ++a)
#pragma unroll
                for (int b = 0; b < 4; ++b)
#pragma unroll
                    for (int g = 0; g < 4; ++g) dst[((vq * 2 + a) * 16 + fq * 4 + g) * 64 + b * 16 + fr] = acc[a][b][g]; }
        __syncthreads();
    }
}

__device__ __forceinline__ void gla_g2(const Params& p, int tid, int bid, int G) {
    const float* DELTA = (const float*)(p.ws + WS_DELTA); const float* DEC = (const float*)(p.ws + WS_DEC); bf16_t* SST = (bf16_t*)(p.ws + WS_SST);
    for (int u = bid; u < 64; u += G) {
        const int s = u >> 2, dir = s >> 3, b = (s >> 2) & 1, h = s & 3, off = ((u & 3) * NTHREADS + tid) * 4, k0 = off & 63;
        f32x4 S = (f32x4){0.f, 0.f, 0.f, 0.f};
#pragma unroll 1
        for (int st = 0; st < 132; st += 4) {
            f32x4 d[4], dc[4]; size_t base[4];
#pragma unroll
            for (int q = 0; q < 4; ++q) { const int t = st + q;
                const int cid = t < 4 ? 256 + b * 4 + (dir ? 3 - t : t) : b * 128 + (dir ? 127 - (t - 4) : (t - 4));
                const size_t it2 = (size_t)(cid * 4 + h) * 2 + dir; base[q] = it2 * 8192 + off;
                d[q] = *(const f32x4*)(DELTA + base[q]); dc[q] = *(const f32x4*)(DEC + it2 * 64 + k0); }
#pragma unroll
            for (int q = 0; q < 4; ++q) { u32x2 o; o.x = pk2(S.x, S.y); o.y = pk2(S.z, S.w); *(u32x2*)(SST + base[q]) = o; S = dc[q] * S + d[q]; }
        }
    }
}

__device__ __forceinline__ void gla_g3(const Params& p, int l, LAS unsigned char* lds, int tid, int lane, int wave, int bid, int G) {
    LAS bf16_t* QEf = (LAS bf16_t*)lds; LAS bf16_t* QEb = QEf + 64 * GP; LAS bf16_t* KEf = QEb + 64 * GP; LAS bf16_t* KEb = KEf + 64 * GP;
    LAS bf16_t* VT = KEb + 64 * GP;
    LAS bf16_t* ATT = VT + 128 * GP + wave * (16 * GP);
    LAS float* RS = (LAS float*)(lds + 2 * (4 * 64 * GP + 128 * GP + 8 * 16 * GP));
    const float* P = (const float*)(p.ws + WS_P);
    const float* BF = (const float*)(p.ws + WS_OF); const float* BB = (const float*)(p.ws + WS_OB);
    const bf16_t* SST = (const bf16_t*)(p.ws + WS_SST); bf16_t* MIX = (bf16_t*)(p.ws + WS_MIX);
    const float* nw = p.in[I_GNORM] + l * 128;
    const int fr = lane & 15, fq = lane >> 4, it = wave >> 1, vh = wave & 1;
    for (int item = bid; item < GLA_ITEMS; item += G) {
        const int cid = item >> 2, h = item & 3, row0 = chunk_row0(cid);
#pragma unroll 1
        for (int j = 0; j < 8; ++j) { const int e = tid + NTHREADS * j, i = e >> 6, k = e & 63;
            const size_t r = (size_t)(row0 + i);
            const float bf = BF[r * 256 + h * 64 + k], bb = BB[r * 256 + h * 64 + k];
            const float q = P[r * INWP + C_GQ + h * 64 + k] * 0.125f, kk = P[r * INWP + C_GK + h * 64 + k];
            QEf[i * GP + k] = (bf16_t)f2bf(q * expf(bf)); KEf[i * GP + k] = (bf16_t)f2bf(kk * expf(-bf));
            QEb[i * GP + k] = (bf16_t)f2bf(q * expf(bb)); KEb[i * GP + k] = (bf16_t)f2bf(kk * expf(-bb)); }
#pragma unroll 1
        for (int j = 0; j < 16; ++j) { const int e = tid + NTHREADS * j, i = e >> 7, v = e & 127;
            VT[v * GP + i] = (bf16_t)f2bf(P[(size_t)(row0 + i) * INWP + C_GV + h * 128 + v]); }
        __syncthreads();
        f32x4 acc[4];
#pragma unroll
        for (int vt = 0; vt < 4; ++vt) acc[vt] = (f32x4){0.f, 0.f, 0.f, 0.f};
#pragma unroll
        for (int dir = 0; dir < 2; ++dir) {
            const LAS bf16_t* QE = dir ? QEb : QEf; const LAS bf16_t* KE = dir ? KEb : KEf;
            bf16x8 qa[2];
#pragma unroll
            for (int ks = 0; ks < 2; ++ks) qa[ks] = *(const LAS bf16x8*)(QE + (it * 16 + fr) * GP + ks * 32 + fq * 8);
#pragma unroll
            for (int jt = 0; jt < 4; ++jt) { f32x4 a = (f32x4){0.f, 0.f, 0.f, 0.f};
#pragma unroll
                for (int ks = 0; ks < 2; ++ks) { const bf16x8 kb = *(const LAS bf16x8*)(KE + (jt * 16 + fr) * GP + ks * 32 + fq * 8); a = __builtin_amdgcn_mfma_f32_16x16x32_bf16(qa[ks], kb, a, 0, 0, 0); }
#pragma unroll
                for (int g = 0; g < 4; ++g) { const int ii = it * 16 + fq * 4 + g, jj = jt * 16 + fr; const bool keep = dir ? (jj >= ii) : (jj <= ii);
                    ATT[(fq * 4 + g) * GP + jt * 16 + fr] = (bf16_t)f2bf(keep ? a[g] : 0.f); } }
            LDS_FENCE();
            const bf16_t* Sg = SST + ((size_t)item * 2 + dir) * 8192;
#pragma unroll
            for (int ks = 0; ks < 2; ++ks) { const bf16x8 aa = *(const LAS bf16x8*)(ATT + fr * GP + ks * 32 + fq * 8);
#pragma unroll
                for (int vt = 0; vt < 4; ++vt) { const int v = (vh * 4 + vt) * 16 + fr;
                    const bf16x8 vb = *(const LAS bf16x8*)(VT + v * GP + ks * 32 + fq * 8);
                    acc[vt] = __builtin_amdgcn_mfma_f32_16x16x32_bf16(aa, vb, acc[vt], 0, 0, 0);
                    const bf16x8 sb = *(const bf16x8*)(Sg + v * 64 + ks * 32 + fq * 8);
                    acc[vt] = __builtin_amdgcn_mfma_f32_16x16x32_bf16(qa[ks], sb, acc[vt], 0, 0, 0); } }
            LDS_FENCE();
        }
        float ss[4];
#pragma unroll
        for (int g = 0; g < 4; ++g) { float t = 0.f;
#pragma unroll
            for (int vt = 0; vt < 4; ++vt) t += acc[vt][g] * acc[vt][g];
            t += __shfl_xor(t, 1); t += __shfl_xor(t, 2); t += __shfl_xor(t, 4); t += __shfl_xor(t, 8); ss[g] = t; }
        if (fr == 0) {
#pragma unroll
            for (int g = 0; g < 4; ++g) RS[(it * 16 + fq * 4 + g) * 2 + vh] = ss[g]; }
        __syncthreads();
#pragma unroll
        for (int g = 0; g < 4; ++g) { const int i = it * 16 + fq * 4 + g; const float tot = RS[i * 2] + RS[i * 2 + 1];
            const float rs = 1.0f / sqrtf(tot * (1.0f / 128.0f) + LN_EPS); const size_t r = (size_t)(row0 + i);
#pragma unroll
            for (int vt = 0; vt < 4; ++vt) { const int v = (vh * 4 + vt) * 16 + fr; const float gt = P[r * INWP + C_GG + h * 128 + v];
                MIX[r * DM + 512 + h * 128 + v] = (bf16_t)f2bf(acc[vt][g] * rs * nw[v] * silu_f(gt)); } }
        __syncthreads();
    }
}

__device__ __forceinline__ void ln_row(f32x4 (&v)[8], const float* lg, const float* lb, int lane) {
    float s = 0.f;
#pragma unroll
    for (int j = 0; j < 8; ++j) s += (v[j].x + v[j].y) + (v[j].z + v[j].w);
    const float mean = wave_sum(s) * (1.0f / DM);
    float s2 = 0.f;
#pragma unroll
    for (int j = 0; j < 8; ++j) { v[j] = v[j] - mean; s2 += (v[j].x * v[j].x + v[j].y * v[j].y) + (v[j].z * v[j].z + v[j].w * v[j].w); }
    const float rstd = 1.0f / sqrtf(wave_sum(s2) * (1.0f / DM) + LN_EPS);
#pragma unroll
    for (int j = 0; j < 8; ++j) { const int c = lane * 4 + 256 * j; const f32x4 g = *(const f32x4*)(lg + c), b = *(const f32x4*)(lb + c); v[j] = v[j] * rstd * g + b; }
}

__device__ __forceinline__ void phase_ln1(const Params& p, int l, int lane, int wave, int bid, int G) {
    const int gw = bid * NWAVES + wave, NGW = G * NWAVES;
    const float* MOD = (const float*)(p.ws + WS_MOD); const float* Y = (const float*)(p.ws + WS_Y);
    float* XL = (float*)(p.ws + WS_XL); bf16_t* HB = (bf16_t*)(p.ws + WS_HB);
    const float* lg = p.in[I_LNG] + (size_t)(l * 2 + 0) * DM; const float* lb = p.in[I_LNB] + (size_t)(l * 2 + 0) * DM;
    for (int r = gw; r < TA; r += NGW) {
        const float* mod = MOD + (size_t)(l * 3 + row_stream(r)) * 6 * DM;
        const float* xr = xsrc(p, l, r);
        f32x4 v[8];
#pragma unroll
        for (int j = 0; j < 8; ++j) { const int c = lane * 4 + 256 * j; const f32x4 x = *(const f32x4*)(xr + c), y = *(const f32x4*)(Y + (size_t)r * DM + c), g = *(const f32x4*)(mod + 2 * DM + c); v[j] = x * DN_ALPHA + g * y; }
        ln_row(v, lg, lb, lane);
#pragma unroll
        for (int j = 0; j < 8; ++j) { const int c = lane * 4 + 256 * j; *(f32x4*)(XL + (size_t)r * DM + c) = v[j];
            const f32x4 sh = *(const f32x4*)(mod + 3 * DM + c), s = *(const f32x4*)(mod + 4 * DM + c);
            u32x2 o; o.x = pk2(v[j].x * (1.f + s.x) + sh.x, v[j].y * (1.f + s.y) + sh.y); o.y = pk2(v[j].z * (1.f + s.z) + sh.z, v[j].w * (1.f + s.w) + sh.w);
            *(u32x2*)(HB + (size_t)r * DM + c) = o; }
    }
}

__device__ __forceinline__ void wave_argmax(float& v, int& idx) {
#pragma unroll
    for (int o = 1; o < 64; o <<= 1) { const float ov = __shfl_xor(v, o); const int oi = __shfl_xor(idx, o); if (ov > v || (ov == v && oi < idx)) { v = ov; idx = oi; } }
}
__device__ __forceinline__ void phase_peer(const Params& p, int l, LAS unsigned char* lds, int lane, int wave, int bid, int G) {
    const int gw = bid * NWAVES + wave, NGW = G * NWAVES;
    const float* MOD = (const float*)(p.ws + WS_MOD); const float* QP = (const float*)(p.ws + WS_QP);
    float* XL = (float*)(p.ws + WS_XL); bf16_t* HB = (bf16_t*)(p.ws + WS_HB);
    const float* lg = p.in[I_LNG] + (size_t)(l * 2 + 1) * DM; const float* lb = p.in[I_LNB] + (size_t)(l * 2 + 1) * DM;
    const float* sub = p.in[I_PSUB] + (size_t)l * 2 * 128 * 128;
    const float* U = p.in[I_PU] + (size_t)l * NEXP * DM; const float* V = p.in[I_PV] + (size_t)l * NEXP * DM;
    LAS float* qs = (LAS float*)(lds + wave * 16384);
    LAS int* eidx = (LAS int*)(qs + 256);
    LAS float* egate = (LAS float*)(eidx + 128);
    const bool last = (l == DEPTH - 1);
    const int nrows = last ? TL : TA;
    for (int r = gw; r < nrows; r += NGW) {
        const float* mod = MOD + (size_t)(l * 3 + row_stream(r)) * 6 * DM;
        for (int h = 0; h < 8; ++h) {
            const float* q = QP + (size_t)r * DM + h * 256;
            qs[lane] = q[lane]; qs[lane + 64] = q[lane + 64]; qs[lane + 128] = q[lane + 128]; qs[lane + 192] = q[lane + 192];
            LDS_FENCE();
            float tv[2]; int ti[2];
#pragma unroll
            for (int pp = 0; pp < 2; ++pp) {
                const float* k0 = sub + (size_t)(pp * 128 + lane) * 128; const float* k1 = k0 + 64 * 128;
                float s0 = 0.f, s1 = 0.f;
#pragma unroll 8
                for (int d = 0; d < 128; d += 4) { const f32x4 qv = *(const LAS f32x4*)(qs + pp * 128 + d); const f32x4 a = *(const f32x4*)(k0 + d), b = *(const f32x4*)(k1 + d);
                    s0 += a.x * qv.x + a.y * qv.y + a.z * qv.z + a.w * qv.w; s1 += b.x * qv.x + b.y * qv.y + b.z * qv.z + b.w * qv.w; }
                float mv = 0.f; int mi = 0;
                for (int it = 0; it < 16; ++it) {
                    float v = s0 >= s1 ? s0 : s1; int idx = s0 >= s1 ? lane : lane + 64;
                    wave_argmax(v, idx);
                    if (lane == it) { mv = v; mi = idx; }
                    if (idx == lane) s0 = -INFINITY; if (idx == lane + 64) s1 = -INFINITY;
                }
                tv[pp] = mv; ti[pp] = mi;
            }
            float cv[4];
            const float ai = __shfl(tv[0], lane >> 2);
#pragma unroll
            for (int m = 0; m < 4; ++m) cv[m] = ai + __shfl(tv[1], (lane & 3) * 4 + m);
            float bv = 0.f; int bc = 0;
            for (int it = 0; it < 16; ++it) {
                float v = cv[0]; int idx = lane * 4;
#pragma unroll
                for (int m = 1; m < 4; ++m) if (cv[m] > v) { v = cv[m]; idx = lane * 4 + m; }
                wave_argmax(v, idx);
                if (lane == it) { bv = v; bc = idx; }
#pragma unroll
                for (int m = 0; m < 4; ++m) if (idx == lane * 4 + m) cv[m] = -INFINITY;
            }
            const int i1 = __shfl(ti[0], bc >> 4), i2 = __shfl(ti[1], bc & 15);
            const float bmax = __shfl(bv, 0);
            float e = lane < 16 ? expf(bv - bmax) : 0.f;
            const float esum = wave_sum(e);
            if (lane < 16) { eidx[h * 16 + lane] = i1 * 128 + i2; egate[h * 16 + lane] = e / esum; }
            LDS_FENCE();
        }
        const float* xr = XL + (size_t)r * DM;
        f32x4 xv[8], hv[8], yv[8];
#pragma unroll
        for (int j = 0; j < 8; ++j) { const int c = lane * 4 + 256 * j; const f32x4 x0 = *(const f32x4*)(xr + c);
            const f32x4 sh = *(const f32x4*)(mod + 3 * DM + c), s = *(const f32x4*)(mod + 4 * DM + c); hv[j] = x0 * (1.f + s) + sh; yv[j] = (f32x4){0.f, 0.f, 0.f, 0.f}; }
        for (int j = 0; j < 128; ++j) {
            const int e = eidx[j]; const float gt = egate[j];
            const float* ur = U + (size_t)e * DM; const float* vr = V + (size_t)e * DM;
            float d = 0.f;
#pragma unroll
            for (int q = 0; q < 8; ++q) { const f32x4 u = *(const f32x4*)(ur + lane * 4 + 256 * q); d += (u.x * hv[q].x + u.y * hv[q].y) + (u.z * hv[q].z + u.w * hv[q].w); }
            d = wave_sum(d);
            const float w = gelu_f(d) * gt;
#pragma unroll
            for (int q = 0; q < 8; ++q) { const f32x4 vv = *(const f32x4*)(vr + lane * 4 + 256 * q); yv[q] += vv * w; }
        }
#pragma unroll
        for (int j = 0; j < 8; ++j) { const int c = lane * 4 + 256 * j; const f32x4 g = *(const f32x4*)(mod + 5 * DM + c); xv[j] = *(const f32x4*)(xr + c) * DN_ALPHA + g * yv[j]; }
        ln_row(xv, lg, lb, lane);
        float* dst = (last ? p.out : XL) + (size_t)r * DM;
#pragma unroll
        for (int j = 0; j < 8; ++j) { const int c = lane * 4 + 256 * j; *(f32x4*)(dst + c) = xv[j]; }
        if (!last) {
            const float* modn = MOD + (size_t)((l + 1) * 3 + row_stream(r)) * 6 * DM;
#pragma unroll
            for (int j = 0; j < 8; ++j) { const int c = lane * 4 + 256 * j; const f32x4 sh = *(const f32x4*)(modn + c), s = *(const f32x4*)(modn + DM + c);
                u32x2 o; o.x = pk2(xv[j].x * (1.f + s.x) + sh.x, xv[j].y * (1.f + s.y) + sh.y); o.y = pk2(xv[j].z * (1.f + s.z) + sh.z, xv[j].w * (1.f + s.w) + sh.w);
                *(u32x2*)(HB + (size_t)r * DM + c) = o; }
        }
        LDS_FENCE();
    }
}

__device__ __forceinline__ void gemm_rows(LAS unsigned char* lds, const bf16_t* A, const bf16_t* Bt, float* C, bool with_ctx, int G, int bid) {
    { pg8::Gemm g{A, Bt, TL, DM, DM}; pg8::StaticOrder S; S.init(TL, DM, G, bid); pg8::EpiF32 E{C, DM, nullptr};
      pg8::gemm_phase<pg8::EpiF32, pg8::StaticOrder, PG8_ALIGN, PG8_SP2>(lds, g, S, E); }
    if (with_ctx) { pg8::Gemm g{A + (size_t)TL * DM, Bt, TC, DM, DM}; pg8::StaticOrder S; S.init(TC, DM, G, bid); pg8::EpiF32 E{C + (size_t)TL * DM, DM, nullptr};
      pg8::gemm_phase<pg8::EpiF32, pg8::StaticOrder, PG8_ALIGN, PG8_SP2>(lds, g, S, E); }
}

constexpr int PH_PER_LAYER = 8, N_PHASES = 2 + DEPTH * PH_PER_LAYER;
__global__ void __launch_bounds__(NTHREADS, 2) fwd_kernel(Params p) {
    extern __shared__ __attribute__((aligned(16))) unsigned char lds_raw[];
    LAS unsigned char* lds = (LAS unsigned char*)lds_raw;
    const int tid = threadIdx.x, lane = tid & 63, wave = __builtin_amdgcn_readfirstlane(tid >> 6), bid = blockIdx.x, G = gridDim.x;
    volatile LAS unsigned* MISC = (volatile LAS unsigned*)(lds + MISC_OFF);
    if (tid < 32) MISC[tid] = 0u;
    __syncthreads();
    const int lo = p.ph_lo, hi = p.ph_hi;
    unsigned* ctl = (unsigned*)(p.ws + WS_CTL);
    XcdBarrier bar; bar.bar = ctl + CW_BAR; bar.x = 0; bar.st = MISC + 8;
    if (hi - lo > 1) bar = xcd_barrier_post(ctl + CW_BAR, MISC + 8);
#define IN(k) (lo <= (k) && (k) < hi)
#define SEAM(k) do { if (IN(k) && IN((k) + 1)) xcd_barrier(bar); } while (0)
    const int NGW = G * NWAVES;
#define FRESH() int tid_ = tid, lane_ = lane, wave_ = wave, bid_ = bid; asm volatile("" : "+v"(tid_), "+v"(lane_), "+s"(wave_), "+s"(bid_)); const int gw_ = bid_ * NWAVES + wave_; (void)tid_; (void)gw_
    if (IN(0)) { FRESH(); phase_prologue(p, lds, tid_, lane_, wave_, bid_, G); }
    SEAM(0);
    if (IN(1)) { FRESH(); phase_modulate0(p, lane_, wave_, bid_, G); }
    SEAM(1);
    for (int l = 0; l < DEPTH; ++l) {
        const int b0 = 2 + l * PH_PER_LAYER;
        if (IN(b0 + 0)) { FRESH();
            pg8::Gemm g{(const bf16_t*)(p.ws + WS_HB), (const bf16_t*)(p.ws + WS_WIN) + (size_t)l * INWP * DM, TA, INWP, DM}; pg8::StaticOrder S; S.init(TA, INWP, G, bid_);
            pg8::EpiF32 E{(float*)(p.ws + WS_P), INWP, nullptr};
            pg8::gemm_phase<pg8::EpiF32, pg8::StaticOrder, PG8_ALIGN, PG8_SP2>(lds, g, S, E); }
        SEAM(b0 + 0);
        if (IN(b0 + 1)) { { FRESH(); gla_g1(p, l, lds, tid_, lane_, wave_, bid_, G); } { FRESH(); phase_post_in(p, l, lane_, wave_, bid_, G); } }
        SEAM(b0 + 1);
        if (IN(b0 + 2)) { { FRESH(); gla_g2(p, tid_, bid_, G); } { FRESH(); phase_mixers(p, l, lds, tid_, lane_, wave_, bid_, G); } }
        SEAM(b0 + 2);
        if (IN(b0 + 3)) { FRESH(); gla_g3(p, l, lds, tid_, lane_, wave_, bid_, G); }
        SEAM(b0 + 3);
        if (IN(b0 + 4)) { FRESH();
            gemm_rows(lds, (const bf16_t*)(p.ws + WS_MIX), (const bf16_t*)(p.ws + WS_WOUT) + (size_t)l * DM * DM, (float*)(p.ws + WS_Y), l < DEPTH - 1, G, bid_); }
        SEAM(b0 + 4);
        if (IN(b0 + 5)) { FRESH(); phase_ln1(p, l, lane_, wave_, bid_, G); }
        SEAM(b0 + 5);
        if (IN(b0 + 6)) { FRESH();
            gemm_rows(lds, (const bf16_t*)(p.ws + WS_HB), (const bf16_t*)(p.ws + WS_WQ) + (size_t)l * DM * DM, (float*)(p.ws + WS_QP), l < DEPTH - 1, G, bid_); }
        SEAM(b0 + 6);
        if (IN(b0 + 7)) { FRESH(); phase_peer(p, l, lds, lane_, wave_, bid_, G); }
        SEAM(b0 + 7);
    }
#undef FRESH
#undef IN
#undef SEAM
}

#ifndef MK_PER_PHASE
#define MK_PER_PHASE 0
#endif
extern "C" void kernel_launch(void* const* d_in, const int* in_sizes, int n_in, void* d_out, int out_size, void* d_ws, size_t ws_size, hipStream_t stream) {
    static int grid = 0;
    if (grid == 0) {
        if (n_in != 19 || out_size != TL * DM || ws_size < WS_END) { fprintf(stderr, "kernel_launch: unexpected shapes (n_in %d out %d ws %zu)\n", n_in, out_size, ws_size); grid = -1; return; }
        int dev = 0, cus = 0;
        if (hipGetDevice(&dev) != hipSuccess || hipDeviceGetAttribute(&cus, hipDeviceAttributeMultiprocessorCount, dev) != hipSuccess) { grid = -1; return; }
        if (hipFuncSetAttribute((const void*)fwd_kernel, hipFuncAttributeMaxDynamicSharedMemorySize, LDS_BYTES) != hipSuccess) { fprintf(stderr, "kernel_launch: hipFuncSetAttribute failed\n"); grid = -1; return; }
        int per_cu = 0;
        (void)hipOccupancyMaxActiveBlocksPerMultiprocessor(&per_cu, (const void*)fwd_kernel, NTHREADS, LDS_BYTES);
        (void)hipGetLastError();
        if (per_cu < 1) fprintf(stderr, "kernel_launch: occupancy query reports %d blocks per CU\n", per_cu);
        grid = cus;
    }
    if (grid < 0) return;
    (void)hipMemsetAsync((char*)d_ws + WS_CTL, 0, CTL_ZERO_BYTES, stream);
    Params p{};
    for (int i = 0; i < 19; ++i) p.in[i] = (const float*)d_in[i];
    p.out = (float*)d_out; p.ws = (unsigned char*)d_ws;
#if MK_PER_PHASE
    for (int ph = 0; ph < N_PHASES; ++ph) { p.ph_lo = ph; p.ph_hi = ph + 1; hipLaunchKernelGGL(fwd_kernel, dim3(grid), dim3(NTHREADS), LDS_BYTES, stream, p); }
#else
    p.ph_lo = 0; p.ph_hi = N_PHASES;
    hipLaunchKernelGGL(fwd_kernel, dim3(grid), dim3(NTHREADS), LDS_BYTES, stream, p);
#endif
}
```

```cpp
#include <hip/hip_runtime.h>
#include <cstdio>
#include <cstdint>

#define LAS __attribute__((address_space(3)))
typedef unsigned short bf16_t;
typedef short bf16x8 __attribute__((ext_vector_type(8)));
typedef float f32x4 __attribute__((ext_vector_type(4)));
typedef unsigned u32x4 __attribute__((ext_vector_type(4)));
typedef unsigned u32x2 __attribute__((ext_vector_type(2)));

constexpr int DM = 2048, NBATCH = 2, SEQ = 8192, DEPTH = 4, CTXL = 256;
constexpr int TL = NBATCH * SEQ, TC = NBATCH * CTXL, TA = TL + TC;
constexpr int INW = 4640, INWP = 4864;
constexpr int C_CX = 0, C_CB = 512, C_CC = 1024, C_GQ = 1536, C_GK = 1792, C_GV = 2048, C_GG = 2560, C_LRF = 3072, C_LRB = 3088,
              C_SQ = 3104, C_SK = 4128, C_SV = 4384;
constexpr int NEXP = 16384;
constexpr float DN_ALPHA = 1.6817928305074290f;
constexpr float LN_EPS = 1e-6f;
constexpr int NWAVES = 8, NTHREADS = 512;

constexpr size_t MiB = 1u << 20;
constexpr size_t WS_CTL = 0, CTL_ZERO_BYTES = 2 * MiB;
constexpr size_t WS_MOD = 2 * MiB;
constexpr size_t WS_WIN = 4 * MiB;
constexpr size_t WS_WOUT = 80 * MiB;
constexpr size_t WS_WQ = 112 * MiB;
constexpr size_t WS_XL = 144 * MiB;
constexpr size_t WS_HB = 276 * MiB;
constexpr size_t WS_P = 342 * MiB;
constexpr size_t WS_QR = 656 * MiB;
constexpr size_t WS_KR = 720 * MiB;
constexpr size_t WS_ALF = 736 * MiB;
constexpr size_t WS_ALB = 753 * MiB;
constexpr size_t WS_OF = 770 * MiB;
constexpr size_t WS_OB = 803 * MiB;
constexpr size_t WS_MIX = 836 * MiB;
constexpr size_t WS_Y = 902 * MiB;
constexpr size_t WS_QP = 1034 * MiB;
constexpr size_t WS_DELTA = 1166 * MiB;
constexpr size_t WS_DEC = 1233 * MiB;
constexpr size_t WS_SST = 1234 * MiB;
constexpr size_t WS_UB = 1268 * MiB;
constexpr size_t WS_VB = 1524 * MiB;
constexpr size_t WS_EIDX = 1780 * MiB;
constexpr size_t WS_EGATE = 1789 * MiB;
constexpr size_t WS_SUBB = 1798 * MiB;
constexpr size_t WS_END = 1799 * MiB;
constexpr int GLA_ITEMS = (TA / 64) * 4;
static_assert(WS_DELTA + (size_t)GLA_ITEMS * 2 * 8192 * 4 <= WS_DEC && WS_DEC + (size_t)GLA_ITEMS * 2 * 64 * 4 <= WS_SST && WS_SST + (size_t)GLA_ITEMS * 2 * 8192 * 2 <= WS_END, "map");
static_assert(WS_WIN + (size_t)4 * INWP * DM * 2 <= WS_WOUT, "map");
static_assert(WS_P + (size_t)TA * INWP * 4 <= WS_QR, "map");
static_assert(WS_XL + (size_t)TA * DM * 4 <= WS_HB, "map");
constexpr int CW_BAR = 4096;
constexpr int LDS_BYTES = 147456;
constexpr int MISC_OFF = 131072 + 320;

#define XB_TMO      128
#define XB_XCNT(j)  (256  + 64 * (j))
#define XB_XSUB(j)  (1280 + 64 * (j))
#define XB_XGEN(j)  (2304 + 64 * (j))
#define XB_TOP      3328
#define XB_TOPGEN   3392
#define XCD_BAR_WORDS 3456
#define XB_SPIN_CAP (1u << 18)
__device__ __forceinline__ unsigned xb_ld(unsigned* p)              { return __hip_atomic_load(p, __ATOMIC_RELAXED, __HIP_MEMORY_SCOPE_AGENT); }
__device__ __forceinline__ unsigned xb_add(unsigned* p, unsigned v) { return __hip_atomic_fetch_add(p, v, __ATOMIC_RELAXED, __HIP_MEMORY_SCOPE_AGENT); }
__device__ __forceinline__ unsigned xb_xcc_id() { return (unsigned)__builtin_amdgcn_s_getreg((3 << 11) | 20) & 0xFu; }
#define XB_SPIN(cond, bar) do { unsigned _sp = 0; while (cond) { __builtin_amdgcn_s_sleep(1); \
    if ((++_sp & 255u) == 0u) { if (xb_ld(&(bar)[XB_TMO])) break; if (_sp > XB_SPIN_CAP) { atomicAdd(&(bar)[XB_TMO], 1u); break; } } } } while (0)
struct XcdBarrier { unsigned* bar; unsigned x; volatile LAS unsigned* st; };
__device__ __forceinline__ XcdBarrier xcd_barrier_post(unsigned* bar, volatile LAS unsigned* st) {
    XcdBarrier b; b.bar = bar; b.x = xb_xcc_id(); b.st = st;
    if (threadIdx.x == 0) (void)xb_add(&bar[XB_XCNT(b.x)], 1u);
    return b;
}
__device__ __forceinline__ void xcd_barrier_complete(unsigned* bar, unsigned x, unsigned& nloc, unsigned& nx) {
    const unsigned G = gridDim.x * gridDim.y * gridDim.z;
    unsigned sum, cnt, mine, sp = 0u;
    for (;;) {
        sum = 0u; cnt = 0u; mine = 0u;
#pragma unroll
        for (unsigned j = 0; j < 16; ++j) { const unsigned c = xb_ld(&bar[XB_XCNT(j)]); sum += c; cnt += (c > 0u) ? 1u : 0u; mine = (j == x) ? c : mine; }
        if (sum == G) break;
        __builtin_amdgcn_s_sleep(1);
        if ((++sp & 255u) == 0u) { if (xb_ld(&bar[XB_TMO])) break; if (sp > XB_SPIN_CAP) { atomicAdd(&bar[XB_TMO], 1u); break; } }
    }
    nloc = mine > 0u ? mine : 1u; nx = cnt > 0u ? cnt : 1u;
}
__device__ __forceinline__ void xcd_barrier(const XcdBarrier& b) {
    asm volatile("s_waitcnt vmcnt(0)" ::: "memory");
    __syncthreads();
    if (threadIdx.x == 0) {
        unsigned* bar = b.bar;
        __builtin_amdgcn_s_waitcnt(0);
        unsigned nloc = b.st[0], nx = b.st[1];
        if (nloc == 0u) { xcd_barrier_complete(bar, b.x, nloc, nx); b.st[0] = nloc; b.st[1] = nx; }
        const unsigned old = xb_add(&bar[XB_XSUB(b.x)], 1u);
        const unsigned gen = old / nloc;
        if (old + 1u == (gen + 1u) * nloc) {
            __builtin_amdgcn_fence(__ATOMIC_RELEASE, "agent");
            asm volatile("s_waitcnt vmcnt(0)" ::: "memory");
            const unsigned og = xb_add(&bar[XB_TOP], 1u);
            const unsigned tg = og / nx;
            if (og + 1u == (tg + 1u) * nx) xb_add(&bar[XB_TOPGEN], 1u);
            else XB_SPIN(xb_ld(&bar[XB_TOPGEN]) == tg, bar);
            __builtin_amdgcn_fence(__ATOMIC_ACQUIRE, "agent");
            xb_add(&bar[XB_XGEN(b.x)], 1u);
            asm volatile("s_waitcnt vmcnt(0)" ::: "memory");
        } else {
            XB_SPIN(xb_ld(&bar[XB_XGEN(b.x)]) == gen, bar);
            __builtin_amdgcn_fence(__ATOMIC_ACQUIRE, "agent");
            asm volatile("s_waitcnt vmcnt(0)" ::: "memory");
        }
    }
    __syncthreads();
}

namespace pg8 {
#define PG8_LAS __attribute__((address_space(3)))
typedef unsigned short bf16_t;
typedef short bf16x8 __attribute__((ext_vector_type(8)));
typedef float f32x4 __attribute__((ext_vector_type(4)));
typedef unsigned u32x4 __attribute__((ext_vector_type(4)));
constexpr int BM = 256, BK = 64, HALF = 128, HTB = HALF * BK * 2  , STAGE_BYTES = 8 * HTB, NXCD = 8, WGM = 8;

__host__ __device__ __forceinline__ int lds_byte(int r, int c) { const int st = (r >> 4) * 2 + (c >> 5), rr = r & 15, cc = c & 31, ob = rr * 64 + cc * 2; return st * 1024 + (ob ^ (((ob >> 9) & 1) << 5)); }
__host__ __device__ __forceinline__ void stage_rc(int b, int& R, int& C) { const int st = b / 1024, sb = b % 1024, swz = sb ^ (((sb >> 9) & 1) << 5); R = (st >> 1) * 16 + swz / 64; C = (st & 1) * 32 + (swz % 64) / 2; }
__host__ __device__ __forceinline__ int perm32(int rho) { const int n = rho >> 4, i = rho & 15; return 8 * (i >> 2) + 4 * n + (i & 3); }

struct Unit { int pm, pn; };
struct Gemm { const bf16_t* A; const bf16_t* Bt; int M, N, K; };

struct StaticOrder {
    int nM, nN, nwg, G, c;
    __host__ __device__ void init(int M, int N, int G_, int c_) { nM = M / BM; nN = N / BM; nwg = nM * nN; G = G_; c = c_; }
    __host__ __device__ bool next(int i, Unit& u) const {
        const long L = (long)i * G + c; if (L >= nwg) return false;
        int wgid = (int)L; { const int q = nwg / NXCD, r = nwg % NXCD, xcd = wgid % NXCD, off = wgid / NXCD; wgid = (xcd < r ? xcd * (q + 1) : r * (q + 1) + (xcd - r) * q) + off; }
        const int nig = WGM * nN, gid = wgid / nig, fm = gid * WGM, gsz = (nM - fm) < WGM ? (nM - fm) : WGM;
        u.pm = fm + ((wgid % nig) % gsz); u.pn = (wgid % nig) / gsz; return true;
    }
    __device__ __forceinline__ void a_ready(const Unit&) const {}
    __device__ __forceinline__ void done(const Unit&) const {}
};

__device__ __forceinline__ unsigned cvt_pk_bf16(float lo, float hi) { unsigned r; asm volatile("v_cvt_pk_bf16_f32 %0, %1, %2" : "=v"(r) : "v"(lo), "v"(hi)); return r; }
typedef float f32x2 __attribute__((ext_vector_type(2)));
__device__ __forceinline__ f32x2 gelu_pk(f32x2 v) {
    const f32x2 av = __builtin_elementwise_abs(v), d = av * 0.2316418882f + 1.0f;
    f32x2 t; t.x = __builtin_amdgcn_rcpf(d.x); t.y = __builtin_amdgcn_rcpf(d.y);
    f32x2 q = t * 0.5307027145f + (-0.7265760135f); q = q * t + 0.7107068705f; q = q * t + (-0.142248368f); q = q * t + 0.127414796f; q = q * t;
    const f32x2 s = (v * v) * (-0.72134752044f);
    f32x2 e; e.x = __builtin_amdgcn_exp2f(s.x); e.y = __builtin_amdgcn_exp2f(s.y);
    const f32x2 m = v * (q * e), r = v - m;
    f32x2 o; o.x = v.x < 0.f ? m.x : r.x; o.y = v.y < 0.f ? m.y : r.y; return o;
}

template <int ACT  > struct EpiBf16 {
    static constexpr bool PERM = true, AFTER_DRAIN = false; static_assert(ACT == 0 || ACT == 1, "EpiBf16: ACT is 0 (none) or 1 (gelu_pk)");
    bf16_t* O; int ldc; const float* bias; int split_cols; size_t split_stride; float scale0;
    __device__ __forceinline__ void operator()(const f32x4 (&acc)[2][2][4][2], const Unit& u, int wr, int wc, int fr, int fq) const {
        const int row0 = u.pm * BM + wr * 64 + fr; int colt = u.pn * BM; bf16_t* base = O;
        float sc = 1.f; if (split_cols) { const int t = colt / split_cols; base += (size_t)t * split_stride; colt -= t * split_cols; if (t == 0) sc = scale0; }
        const int col0 = colt + wc * 32 + 8 * fq, bcol0 = u.pn * BM + wc * 32 + 8 * fq;
        f32x4 bv[2][2];
#pragma unroll
        for (int bj = 0; bj < 2; ++bj)
#pragma unroll
            for (int n = 0; n < 2; ++n) bv[bj][n] = bias ? *(const f32x4*)(bias + bcol0 + bj * HALF + 4 * n) : (f32x4){0.f, 0.f, 0.f, 0.f};
#pragma unroll
        for (int ai = 0; ai < 2; ++ai)
#pragma unroll
            for (int m = 0; m < 4; ++m) { bf16_t* rowp = base + (size_t)(row0 + ai * HALF + m * 16) * ldc + col0;
#pragma unroll
                for (int bj = 0; bj < 2; ++bj) { f32x4 v0 = acc[ai][bj][m][0] + bv[bj][0], v1 = acc[ai][bj][m][1] + bv[bj][1];
                    if (ACT == 1) { f32x2 a = gelu_pk((f32x2){v0[0], v0[1]}), b = gelu_pk((f32x2){v0[2], v0[3]}), c = gelu_pk((f32x2){v1[0], v1[1]}), d = gelu_pk((f32x2){v1[2], v1[3]});
                        v0 = (f32x4){a.x, a.y, b.x, b.y}; v1 = (f32x4){c.x, c.y, d.x, d.y}; }
                    v0 = v0 * sc; v1 = v1 * sc; u32x4 w; w.x = cvt_pk_bf16(v0[0], v0[1]); w.y = cvt_pk_bf16(v0[2], v0[3]); w.z = cvt_pk_bf16(v1[0], v1[1]); w.w = cvt_pk_bf16(v1[2], v1[3]);
                    *(u32x4*)(rowp + bj * HALF) = w; } }
    }
};


struct EpiF32 {
    static constexpr bool PERM = false, AFTER_DRAIN = false;
    float* C; int ldc; const float* bias;
    __device__ __forceinline__ void operator()(const f32x4 (&acc)[2][2][4][2], const Unit& u, int wr, int wc, int fr, int fq) const {
        const int row0 = u.pm * BM + wr * 64 + fr, col0 = u.pn * BM + wc * 32 + 4 * fq;
        f32x4 bv[2][2];
#pragma unroll
        for (int bj = 0; bj < 2; ++bj)
#pragma unroll
            for (int n = 0; n < 2; ++n) bv[bj][n] = bias ? *(const f32x4*)(bias + col0 + bj * HALF + n * 16) : (f32x4){0.f, 0.f, 0.f, 0.f};
#pragma unroll
        for (int ai = 0; ai < 2; ++ai)
#pragma unroll
            for (int m = 0; m < 4; ++m) { float* rowp = C + (size_t)(row0 + ai * HALF + m * 16) * ldc + col0;
#pragma unroll
                for (int bj = 0; bj < 2; ++bj)
#pragma unroll
                    for (int n = 0; n < 2; ++n) *(f32x4*)(rowp + bj * HALF + n * 16) = acc[ai][bj][m][n] + bv[bj][n]; }
    }
};

template <class Epi, class Sched, bool ALIGN_EPI = false, bool SP2 = false>
__device__ __forceinline__ void gemm_phase(PG8_LAS unsigned char* lds, const Gemm g, const Sched& S, const Epi& E) {
    const int tid = threadIdx.x, wid = __builtin_amdgcn_readfirstlane(tid >> 6), lane = tid & 63, wr = wid >> 2, wc = wid & 3, fr = lane & 15, fq = lane >> 4;
    const int K = g.K, nt = K / BK;
    unsigned voffA[2], voffB[2];
#pragma unroll
    for (int i = 0; i < 2; ++i) { int R, C; stage_rc(tid * 16 + i * 8192, R, C); const int Rb = Epi::PERM ? ((R & ~31) + perm32(R & 31)) : R;
        voffA[i] = (unsigned)(R * K + C) * 2u; voffB[i] = (unsigned)(Rb * K + C) * 2u; }
    const size_t kstep = (size_t)(BK * 2);
    const size_t hstep = (size_t)HALF * K * 2;
    const size_t tstep = 2 * hstep;
    const unsigned ldsw = (unsigned)wid * 1024u;
    const int aoff = lds_byte(wr * 64 + fr, fq * 8), boff = lds_byte(wc * 32 + fr, fq * 8);
#define PG8_SA(b, h) (((b) * 2 + (h)) * HTB)
#define PG8_SB(b, h) ((4 + (b) * 2 + (h)) * HTB)
#define PG8_STAGE(bufoff, gbase, voff) do { _Pragma("unroll") for (int _i = 0; _i < 2; ++_i) \
        __builtin_amdgcn_global_load_lds((const unsigned*)((const char*)(gbase) + (voff)[_i]), (PG8_LAS unsigned*)(lds + (bufoff) + ldsw + _i * 8192), 16, 0, 0); } while (0)
#define PG8_LDA(dst, b, h) do { _Pragma("unroll") for (int m = 0; m < 4; ++m) _Pragma("unroll") for (int k = 0; k < 2; ++k) dst[m][k] = *(const PG8_LAS bf16x8*)(lds + PG8_SA(b, h) + aoff + m * 2048 + k * 1024); } while (0)
#define PG8_LDB(dst, b, h) do { _Pragma("unroll") for (int n = 0; n < 2; ++n) _Pragma("unroll") for (int k = 0; k < 2; ++k) dst[n][k] = *(const PG8_LAS bf16x8*)(lds + PG8_SB(b, h) + boff + n * 2048 + k * 1024); } while (0)
#define PG8_MMA(ai, bj, At, Bt) do { __builtin_amdgcn_s_setprio(1); _Pragma("unroll") for (int m = 0; m < 4; ++m) _Pragma("unroll") for (int n = 0; n < 2; ++n) _Pragma("unroll") for (int k = 0; k < 2; ++k) \
        acc[ai][bj][m][n] = __builtin_amdgcn_mfma_f32_16x16x32_bf16(Bt[n][k], At[m][k], acc[ai][bj][m][n], 0, 0, 0); __builtin_amdgcn_s_setprio(0); } while (0)
#define PG8_WAIT_V(n) asm volatile("s_waitcnt vmcnt(" #n ")" ::: "memory")
#define PG8_WAIT_L(n) asm volatile("s_waitcnt lgkmcnt(" #n ")" ::: "memory")
#define PG8_BAR __builtin_amdgcn_s_barrier()
#define PG8_SCHED __builtin_amdgcn_sched_barrier(0)
    Unit cur, nxt; int ui = 0;
    if (!S.next(0, cur)) return;
    f32x4 acc[2][2][4][2];
#pragma unroll
    for (int a = 0; a < 2; ++a)
#pragma unroll
        for (int b = 0; b < 2; ++b)
#pragma unroll
            for (int m = 0; m < 4; ++m)
#pragma unroll
                for (int n = 0; n < 2; ++n) acc[a][b][m][n] = (f32x4){0.f, 0.f, 0.f, 0.f};
    bf16x8 At[4][2], B0[2][2], B1[2][2];
    const char* cA = (const char*)g.A + (size_t)cur.pm * tstep; const char* cB = (const char*)g.Bt + (size_t)cur.pn * tstep;
    S.a_ready(cur);
    if constexpr (SP2) {
        PG8_STAGE(PG8_SB(0, 0), cB, voffB); PG8_STAGE(PG8_SB(0, 1), cB + hstep, voffB); PG8_STAGE(PG8_SA(0, 0), cA, voffA); PG8_STAGE(PG8_SA(0, 1), cA + hstep, voffA);
        if (wr == 1) PG8_BAR;
        PG8_WAIT_V(2); PG8_BAR;
        PG8_STAGE(PG8_SB(1, 0), cB + kstep, voffB); PG8_STAGE(PG8_SA(1, 0), cA + kstep, voffA); PG8_STAGE(PG8_SB(1, 1), cB + hstep + kstep, voffB);
        PG8_WAIT_V(6); PG8_BAR;
    } else {
        PG8_STAGE(PG8_SB(0, 0), cB, voffB); PG8_STAGE(PG8_SA(0, 0), cA, voffA); PG8_STAGE(PG8_SB(0, 1), cB + hstep, voffB); PG8_STAGE(PG8_SA(0, 1), cA + hstep, voffA);
        if (wr == 1) PG8_BAR;
        PG8_WAIT_V(4); PG8_BAR;
        PG8_STAGE(PG8_SB(1, 0), cB + kstep, voffB); PG8_STAGE(PG8_SA(1, 0), cA + kstep, voffA); PG8_STAGE(PG8_SB(1, 1), cB + hstep + kstep, voffB);
        PG8_WAIT_V(6); PG8_BAR;
    }
    for (;;) {
        const bool has_next = S.next(ui + 1, nxt);
        const char* nA = has_next ? (const char*)g.A + (size_t)nxt.pm * tstep : cA; const char* nB = has_next ? (const char*)g.Bt + (size_t)nxt.pn * tstep : cB;
        for (int t = 0; t < nt; t += 2) {
            const bool last = (t == nt - 2);
            const char* a1 = cA + (size_t)(t + 1) * kstep;
            const char* a2 = last ? nA : cA + (size_t)(t + 2) * kstep; const char* b2 = last ? nB : cB + (size_t)(t + 2) * kstep;
            const char* a3 = a2 + kstep; const char* b3 = b2 + kstep;
            if (last && has_next) S.a_ready(nxt);
            if constexpr (SP2) {
            PG8_LDB(B0, 0, 0); PG8_LDB(B1, 0, 1); PG8_SCHED; PG8_LDA(At, 0, 0); PG8_STAGE(PG8_SA(1, 1), a1 + hstep, voffA);
            PG8_WAIT_V(8); PG8_WAIT_L(0); PG8_BAR; PG8_MMA(0, 0, At, B0); PG8_MMA(0, 1, At, B1); PG8_BAR; PG8_SCHED;
            PG8_LDA(At, 0, 1); PG8_STAGE(PG8_SB(0, 0), b2, voffB); PG8_STAGE(PG8_SB(0, 1), b2 + hstep, voffB); PG8_STAGE(PG8_SA(0, 0), a2, voffA);
            PG8_WAIT_V(8); PG8_WAIT_L(0); PG8_BAR; PG8_MMA(1, 0, At, B0); PG8_MMA(1, 1, At, B1); PG8_BAR; PG8_SCHED;
            PG8_LDB(B0, 1, 0); PG8_LDB(B1, 1, 1); PG8_SCHED; PG8_LDA(At, 1, 0); PG8_STAGE(PG8_SA(0, 1), a2 + hstep, voffA);
            PG8_WAIT_V(8); PG8_WAIT_L(0); PG8_BAR; PG8_MMA(0, 0, At, B0); PG8_MMA(0, 1, At, B1); PG8_BAR; PG8_SCHED;
            PG8_LDA(At, 1, 1); PG8_STAGE(PG8_SB(1, 0), b3, voffB); PG8_STAGE(PG8_SB(1, 1), b3 + hstep, voffB); PG8_STAGE(PG8_SA(1, 0), a3, voffA);
            PG8_WAIT_V(8); PG8_WAIT_L(0); PG8_BAR; PG8_MMA(1, 0, At, B0); PG8_MMA(1, 1, At, B1); PG8_BAR; PG8_SCHED;
            } else {
            PG8_LDB(B0, 0, 0); PG8_SCHED; PG8_LDA(At, 0, 0); PG8_STAGE(PG8_SA(1, 1), a1 + hstep, voffA);
            PG8_WAIT_L(8); PG8_BAR; PG8_WAIT_L(0); PG8_MMA(0, 0, At, B0); PG8_BAR; PG8_SCHED;
            PG8_LDB(B1, 0, 1); PG8_STAGE(PG8_SB(0, 0), b2, voffB);
            PG8_BAR; PG8_WAIT_L(0); PG8_MMA(0, 1, At, B1); PG8_BAR;
            PG8_LDA(At, 0, 1); PG8_STAGE(PG8_SA(0, 0), a2, voffA);
            PG8_BAR; PG8_WAIT_L(0); PG8_MMA(1, 0, At, B0); PG8_BAR; PG8_SCHED;
            PG8_STAGE(PG8_SB(0, 1), b2 + hstep, voffB);
            PG8_WAIT_V(6); PG8_BAR; PG8_MMA(1, 1, At, B1); PG8_BAR;
            PG8_LDB(B0, 1, 0); PG8_SCHED; PG8_LDA(At, 1, 0); PG8_STAGE(PG8_SA(0, 1), a2 + hstep, voffA);
            PG8_WAIT_L(8); PG8_BAR; PG8_WAIT_L(0); PG8_MMA(0, 0, At, B0); PG8_BAR; PG8_SCHED;
            PG8_LDB(B1, 1, 1); PG8_STAGE(PG8_SB(1, 0), b3, voffB);
            PG8_BAR; PG8_WAIT_L(0); PG8_MMA(0, 1, At, B1); PG8_BAR;
            PG8_LDA(At, 1, 1); PG8_STAGE(PG8_SA(1, 0), a3, voffA);
            PG8_BAR; PG8_WAIT_L(0); PG8_MMA(1, 0, At, B0); PG8_BAR; PG8_SCHED;
            PG8_STAGE(PG8_SB(1, 1), b3 + hstep, voffB);
            PG8_WAIT_V(6); PG8_BAR; PG8_MMA(1, 1, At, B1); PG8_BAR;
            }
        }
        if constexpr (ALIGN_EPI) { if (wr == 0) PG8_BAR; }
        if constexpr (!Epi::AFTER_DRAIN) { E(acc, cur, wr, wc, fr, fq); S.done(cur); }
        if (!has_next) break;
#pragma unroll
        for (int a = 0; a < 2; ++a)
#pragma unroll
            for (int b = 0; b < 2; ++b)
#pragma unroll
                for (int m = 0; m < 4; ++m)
#pragma unroll
                    for (int n = 0; n < 2; ++n) acc[a][b][m][n] = (f32x4){0.f, 0.f, 0.f, 0.f};
        cur = nxt; cA = nA; cB = nB; ++ui;
        if constexpr (ALIGN_EPI) { if (wr == 1) PG8_BAR; }
    }
    PG8_WAIT_V(0);
    if constexpr (!ALIGN_EPI) { if (wr == 0) PG8_BAR; }
    PG8_BAR;
    if constexpr (Epi::AFTER_DRAIN) { E.fused(acc, cur, wr, wc, fr, fq, lds, wid, lane); S.done(cur); }
#undef PG8_SA
#undef PG8_SB
#undef PG8_STAGE
#undef PG8_LDA
#undef PG8_LDB
#undef PG8_MMA
#undef PG8_WAIT_V
#undef PG8_WAIT_L
#undef PG8_BAR
#undef PG8_SCHED
}
}
#define PG8_SP2 true
#define PG8_ALIGN true

#define LDS_FENCE() asm volatile("s_waitcnt lgkmcnt(0)" ::: "memory")
__device__ __forceinline__ unsigned f2bf(float f) { unsigned u = __builtin_bit_cast(unsigned, f); return (u + 0x7fffu + ((u >> 16) & 1u)) >> 16; }
__device__ __forceinline__ unsigned pk2(float lo, float hi) { return f2bf(lo) | (f2bf(hi) << 16); }
__device__ __forceinline__ float wave_sum(float v) {
#pragma unroll
    for (int o = 1; o < 64; o <<= 1) v += __shfl_xor(v, o);
    return v;
}
__device__ __forceinline__ float wave_max(float v) {
#pragma unroll
    for (int o = 1; o < 64; o <<= 1) v = fmaxf(v, __shfl_xor(v, o));
    return v;
}
__device__ __forceinline__ float silu_f(float x) { return x / (1.0f + expf(-x)); }
__device__ __forceinline__ float gelu_f(float x) { return 0.5f * x * (1.0f + erff(x * 0.70710678118654752f)); }
__device__ __forceinline__ float log_sigmoid_f(float z) { return fminf(z, 0.0f) - log1pf(expf(-fabsf(z))); }

struct Params {
    const float* in[19];
    float* out;
    unsigned char* ws;
    int ph_lo, ph_hi;
};
enum { I_X = 0, I_C, I_CTX, I_CCTX, I_WADA, I_BADA, I_WIN, I_CONVW, I_GW2, I_GB2, I_GNORM, I_SINK, I_WOUT, I_LNG, I_LNB, I_PWQ, I_PSUB, I_PU, I_PV };

__device__ __forceinline__ int row_stream(int r) { return r < TL ? r / SEQ : 2; }

__device__ __forceinline__ void transpose_item(const float* W, int K, int N, bf16_t* WT, LAS float* scr, int item, int lane) {
    const int nblk = N / 32, kb = item / nblk, nb = item % nblk, k0 = 64 * kb, n0 = 32 * nb;
#pragma unroll 8
    for (int i = 0; i < 32; ++i) { const int kk = 2 * i + (lane >> 5); scr[kk * 33 + (lane & 31)] = W[(size_t)(k0 + kk) * N + n0 + (lane & 31)]; }
    LDS_FENCE();
    const int c = lane & 7;
#pragma unroll
    for (int j = 0; j < 4; ++j) { const int n = (lane >> 3) + 8 * j; const LAS float* s = scr + (8 * c) * 33 + n;
        u32x4 o; o.x = pk2(s[0 * 33], s[1 * 33]); o.y = pk2(s[2 * 33], s[3 * 33]); o.z = pk2(s[4 * 33], s[5 * 33]); o.w = pk2(s[6 * 33], s[7 * 33]);
        *(u32x4*)(WT + (size_t)(n0 + n) * K + k0 + 8 * c) = o; }
    LDS_FENCE();
}

__device__ __forceinline__ void phase_prologue(const Params& p, LAS unsigned char* lds, int tid, int lane, int wave, int bid, int G) {
    const int gw = bid * NWAVES + wave, NGW = G * NWAVES;
    LAS float* scr = (LAS float*)(lds + wave * 16384);
    bf16_t* WIN = (bf16_t*)(p.ws + WS_WIN); bf16_t* WOUT = (bf16_t*)(p.ws + WS_WOUT); bf16_t* WQ = (bf16_t*)(p.ws + WS_WQ);
    constexpr int IT_IN = (DM / 64) * (INW / 32), IT_SQ = (DM / 64) * (DM / 32), IT_L = IT_IN + 2 * IT_SQ;
    for (int it = gw; it < DEPTH * IT_L; it += NGW) {
        const int l = it / IT_L; int r = it % IT_L;
        if (r < IT_IN) { transpose_item(p.in[I_WIN] + (size_t)l * DM * INW, DM, INW, WIN + (size_t)l * INWP * DM, scr, r, lane); continue; } r -= IT_IN;
        if (r < IT_SQ) { transpose_item(p.in[I_WOUT] + (size_t)l * DM * DM, DM, DM, WOUT + (size_t)l * DM * DM, scr, r, lane); continue; } r -= IT_SQ;
        transpose_item(p.in[I_PWQ] + (size_t)l * DM * DM, DM, DM, WQ + (size_t)l * DM * DM, scr, r, lane);
    }
    {
        constexpr int PADV = (INWP - INW) * DM / 8;
        const int gt = bid * NTHREADS + tid, NGT = G * NTHREADS;
        for (int i = gt; i < DEPTH * PADV; i += NGT) { const int l = i / PADV, o = i % PADV;
            *(u32x4*)(WIN + (size_t)l * INWP * DM + (size_t)INW * DM + (size_t)o * 8) = (u32x4){0u, 0u, 0u, 0u}; }
    }
    {
        const size_t gt = (size_t)bid * NTHREADS + tid, NGT = (size_t)G * NTHREADS;
        const size_t NV = (size_t)DEPTH * NEXP * DM / 8;
        const float* U = p.in[I_PU]; const float* V = p.in[I_PV]; bf16_t* UB = (bf16_t*)(p.ws + WS_UB); bf16_t* VB = (bf16_t*)(p.ws + WS_VB);
        for (size_t i = gt; i < NV; i += NGT) {
            const f32x4 a0 = *(const f32x4*)(U + i * 8), a1 = *(const f32x4*)(U + i * 8 + 4), b0 = *(const f32x4*)(V + i * 8), b1 = *(const f32x4*)(V + i * 8 + 4);
            u32x4 o; o.x = pk2(a0.x, a0.y); o.y = pk2(a0.z, a0.w); o.z = pk2(a1.x, a1.y); o.w = pk2(a1.z, a1.w); *(u32x4*)(UB + i * 8) = o;
            u32x4 q; q.x = pk2(b0.x, b0.y); q.y = pk2(b0.z, b0.w); q.z = pk2(b1.x, b1.y); q.w = pk2(b1.z, b1.w); *(u32x4*)(VB + i * 8) = q; }
        const float* SUB = p.in[I_PSUB]; bf16_t* SUBB = (bf16_t*)(p.ws + WS_SUBB);
        for (size_t i = gt; i < (size_t)DEPTH * 2 * 128 * 128 / 2; i += NGT) ((unsigned*)SUBB)[i] = pk2(SUB[2 * i], SUB[2 * i + 1]);
    }
    __syncthreads();
    LAS float* sc = (LAS float*)lds;
    LAS float* red = (LAS float*)(lds + 32768);
    for (int i = tid; i < 3 * DM; i += NTHREADS) { const int s = i / DM, k = i % DM; const float v = s < 2 ? p.in[I_C][s * DM + k] : p.in[I_CCTX][k]; sc[i] = silu_f(v); }
    __syncthreads();
    float* MOD = (float*)(p.ws + WS_MOD);
    constexpr int NCH = 6 * DM / 64;
    for (int it = bid; it < DEPTH * NCH; it += G) {
        const int l = it / NCH, n = (it % NCH) * 64 + lane;
        const float* wp = p.in[I_WADA] + (size_t)l * DM * 6 * DM + n;
        float a0 = 0.f, a1 = 0.f, a2 = 0.f;
        const int kb = wave * (DM / NWAVES);
#pragma unroll 8
        for (int k = kb; k < kb + DM / NWAVES; ++k) { const float w = wp[(size_t)k * 6 * DM]; a0 += sc[k] * w; a1 += sc[DM + k] * w; a2 += sc[2 * DM + k] * w; }
        red[(wave * 3 + 0) * 64 + lane] = a0; red[(wave * 3 + 1) * 64 + lane] = a1; red[(wave * 3 + 2) * 64 + lane] = a2;
        __syncthreads();
        if (tid < 192) { const int s = tid / 64, ln = tid % 64; float v = 0.f;
#pragma unroll
            for (int w = 0; w < NWAVES; ++w) v += red[(w * 3 + s) * 64 + ln];
            const int nn = (it % NCH) * 64 + ln;
            MOD[((size_t)l * 3 + s) * 6 * DM + nn] = v + p.in[I_BADA][(size_t)l * 6 * DM + nn]; }
        __syncthreads();
    }
}

__device__ __forceinline__ const float* xsrc(const Params& p, int l, int r) {
    if (l > 0) return (const float*)(p.ws + WS_XL) + (size_t)r * DM;
    return r < TL ? p.in[I_X] + (size_t)r * DM : p.in[I_CTX] + (size_t)(r - TL) * DM;
}

__device__ __forceinline__ void modulate_row(const float* xr, const float* mod, int sh_off, int sc_off, bf16_t* hb, int lane) {
#pragma unroll
    for (int j = 0; j < 8; ++j) { const int c = lane * 4 + 256 * j;
        const f32x4 x = *(const f32x4*)(xr + c), sh = *(const f32x4*)(mod + sh_off + c), s = *(const f32x4*)(mod + sc_off + c);
        u32x2 o; o.x = pk2(x.x * (1.f + s.x) + sh.x, x.y * (1.f + s.y) + sh.y); o.y = pk2(x.z * (1.f + s.z) + sh.z, x.w * (1.f + s.w) + sh.w);
        *(u32x2*)(hb + c) = o; }
}
__device__ __forceinline__ void phase_modulate0(const Params& p, int lane, int wave, int bid, int G) {
    const int gw = bid * NWAVES + wave, NGW = G * NWAVES;
    const float* MOD = (const float*)(p.ws + WS_MOD); bf16_t* HB = (bf16_t*)(p.ws + WS_HB);
    for (int r = gw; r < TA; r += NGW) modulate_row(xsrc(p, 0, r), MOD + (size_t)(0 * 3 + row_stream(r)) * 6 * DM, 0, DM, HB + (size_t)r * DM, lane);
}

__device__ __forceinline__ void gemm_direct(const bf16_t* A, const bf16_t* Bt, float* C, int M, int N, int K, int ldc, int gw, int NGW, int lane) {
    const int nTn = N / 64, nItems = (M / 32) * nTn;
    const int fr = lane & 15, fq = lane >> 4;
    for (int it = gw; it < nItems; it += NGW) {
        const int mt = it / nTn, nt = it % nTn;
        const bf16_t* a0 = A + (size_t)(mt * 32 + fr) * K + fq * 8;
        const bf16_t* b0 = Bt + (size_t)(nt * 64 + fr) * K + fq * 8;
        f32x4 acc[2][4];
#pragma unroll
        for (int i = 0; i < 2; ++i)
#pragma unroll
            for (int j = 0; j < 4; ++j) acc[i][j] = (f32x4){0.f, 0.f, 0.f, 0.f};
#pragma unroll 2
        for (int k0 = 0; k0 < K; k0 += 32) {
            bf16x8 af[2], bfr[4];
#pragma unroll
            for (int i = 0; i < 2; ++i) af[i] = *(const bf16x8*)(a0 + (size_t)i * 16 * K + k0);
#pragma unroll
            for (int j = 0; j < 4; ++j) bfr[j] = *(const bf16x8*)(b0 + (size_t)j * 16 * K + k0);
#pragma unroll
            for (int i = 0; i < 2; ++i)
#pragma unroll
                for (int j = 0; j < 4; ++j) acc[i][j] = __builtin_amdgcn_mfma_f32_16x16x32_bf16(af[i], bfr[j], acc[i][j], 0, 0, 0);
        }
#pragma unroll
        for (int i = 0; i < 2; ++i)
#pragma unroll
            for (int j = 0; j < 4; ++j)
#pragma unroll
                for (int g = 0; g < 4; ++g) C[(size_t)(mt * 32 + i * 16 + fq * 4 + g) * ldc + nt * 64 + j * 16 + fr] = acc[i][j][g];
    }
}

__device__ __forceinline__ void phase_post_in(const Params& p, int l, int lane, int wave, int bid, int G) {
    const int gw = bid * NWAVES + wave, NGW = G * NWAVES;
    const float* P = (const float*)(p.ws + WS_P);
    float* QR = (float*)(p.ws + WS_QR); float* KR = (float*)(p.ws + WS_KR);
    bf16_t* MIX = (bf16_t*)(p.ws + WS_MIX);
    const float* cw = p.in[I_CONVW] + (size_t)l * 3 * 512;
    for (int r = gw; r < TA; r += NGW) {
        const float* pr = P + (size_t)r * INWP;
        int pos, len;
        if (r < TL) { pos = r % SEQ; len = SEQ; } else { pos = (r - TL) % CTXL; len = CTXL; }
#pragma unroll 1
        for (int j = 0; j < 8; ++j) { const int c = lane + 64 * j;
            float a = cw[512 + c] * pr[C_CC + c] * pr[C_CX + c];
            if (pos > 0) a += cw[c] * pr[C_CC + c - INWP] * pr[C_CX + c - INWP];
            if (pos < len - 1) a += cw[1024 + c] * pr[C_CC + c + INWP] * pr[C_CX + c + INWP];
            MIX[(size_t)r * DM + c] = (bf16_t)f2bf(pr[C_CB + c] * a); }
        if (r < TL) {
            const int half = lane >> 5, i = lane & 31;
            const float invf = powf(10000.0f, -(float)i / 32.0f);
            const float ang = (float)(half ? (pos % 64) : (pos / 64)) * invf;
            float sn, cs; sincosf(ang, &sn, &cs);
#pragma unroll 2
            for (int h = 0; h < 8; ++h) { const float* q = pr + C_SQ + h * 128 + half * 64; const float x1 = q[i], x2 = q[32 + i];
                float* o = QR + (size_t)r * 1024 + h * 128 + half * 64;
                o[i] = (x1 * cs - x2 * sn) * 0.08838834764831845f; o[32 + i] = (x2 * cs + x1 * sn) * 0.08838834764831845f; }
#pragma unroll
            for (int h = 0; h < 2; ++h) { const float* k = pr + C_SK + h * 128 + half * 64; const float x1 = k[i], x2 = k[32 + i];
                float* o = KR + (size_t)r * 256 + h * 128 + half * 64;
                o[i] = x1 * cs - x2 * sn; o[32 + i] = x2 * cs + x1 * sn; }
        }
    }
}

__device__ __forceinline__ void swa_item(LAS float* qs, LAS float* ps, const float* kA, size_t ksA, const float* vA, size_t vsA, int nA,
                                         const float* kB, size_t ksB, const float* vB, size_t vsB, int nB, float sink, bf16_t* out, int lane) {
    const int ntot = nA + nB;
    float mx = sink;
    for (int j = lane; j < ntot; j += 64) {
        const float* kr = j < nA ? kA + (size_t)j * ksA : kB + (size_t)(j - nA) * ksB;
        float s = 0.f;
#pragma unroll 8
        for (int d = 0; d < 128; d += 4) { const f32x4 kv = *(const f32x4*)(kr + d); const f32x4 qv = *(const LAS f32x4*)(qs + d); s += kv.x * qv.x + kv.y * qv.y + kv.z * qv.z + kv.w * qv.w; }
        ps[j] = s; mx = fmaxf(mx, s);
    }
    mx = wave_max(mx);
    float sum = 0.f;
    for (int j = lane; j < ntot; j += 64) { const float e = expf(ps[j] - mx); ps[j] = e; sum += e; }
    sum = wave_sum(sum) + expf(sink - mx);
    LDS_FENCE();
    const float inv = 1.0f / sum;
    float o0 = 0.f, o1 = 0.f;
#pragma unroll 4
    for (int j = 0; j < ntot; ++j) { const float* vr = j < nA ? vA + (size_t)j * vsA : vB + (size_t)(j - nA) * vsB; const float pj = ps[j]; o0 += pj * vr[lane]; o1 += pj * vr[lane + 64]; }
    out[lane] = (bf16_t)f2bf(o0 * inv); out[lane + 64] = (bf16_t)f2bf(o1 * inv);
    LDS_FENCE();
}

__device__ __forceinline__ void phase_mixers(const Params& p, int l, LAS unsigned char* lds, int tid, int lane, int wave, int bid, int G) {
    LAS float* wl = (LAS float*)(lds + wave * 16384);
    const int gw = bid * NWAVES + wave, NGW = G * NWAVES;
    const float* P = (const float*)(p.ws + WS_P);
    const float* QR = (const float*)(p.ws + WS_QR); const float* KR = (const float*)(p.ws + WS_KR);
    bf16_t* MIX = (bf16_t*)(p.ws + WS_MIX);
    const float* sinkp = p.in[I_SINK] + l * 8;
    LAS float* qs = wl; LAS float* ps = wl + 128;
    const bool with_ctx = (l < DEPTH - 1);
    const int nItems = (with_ctx ? TA : TL) * 8;
    for (int it = gw; it < nItems; it += NGW) {
        const int r = it >> 3, hq = it & 7, hk = hq >> 2;
        bf16_t* out = MIX + (size_t)r * DM + 1024 + hq * 128;
        if (r < TL) {
            const int b = r / SEQ, n = r % SEQ;
            qs[lane] = QR[(size_t)r * 1024 + hq * 128 + lane]; qs[lane + 64] = QR[(size_t)r * 1024 + hq * 128 + lane + 64];
            LDS_FENCE();
            const int lo = n - 128 < 0 ? 0 : n - 128, hi = n + 128 > SEQ - 1 ? SEQ - 1 : n + 128;
            const size_t r0 = (size_t)b * SEQ + lo, c0 = (size_t)TL + (size_t)b * CTXL;
            swa_item(qs, ps, KR + r0 * 256 + hk * 128, 256, P + r0 * INWP + C_SV + hk * 128, INWP, hi - lo + 1,
                     P + c0 * INWP + C_SK + hk * 128, INWP, P + c0 * INWP + C_SV + hk * 128, INWP, CTXL, sinkp[hq], out, lane);
        } else {
            const int b = (r - TL) / CTXL;
            const float* q = P + (size_t)r * INWP + C_SQ + hq * 128;
            qs[lane] = q[lane] * 0.08838834764831845f; qs[lane + 64] = q[lane + 64] * 0.08838834764831845f;
            LDS_FENCE();
            const size_t c0 = (size_t)TL + (size_t)b * CTXL;
            swa_item(qs, ps, P, 0, P, 0, 0, P + c0 * INWP + C_SK + hk * 128, INWP, P + c0 * INWP + C_SV + hk * 128, INWP, CTXL, sinkp[hq], out, lane);
        }
    }
}

__device__ __forceinline__ int chunk_row0(int cid) { return cid < 256 ? (cid >> 7) * SEQ + (cid & 127) * 64 : TL + ((cid - 256) >> 2) * CTXL + ((cid - 256) & 3) * 64; }
constexpr int GP = 72;

__device__ __forceinline__ void gla_g1(const Params& p, int l, LAS unsigned char* lds, int tid, int lane, int wave, int bid, int G) {
    LAS float* Bf = (LAS float*)lds; LAS float* Bb = Bf + 4096;
    LAS bf16_t* KTf = (LAS bf16_t*)(lds + 32768); LAS bf16_t* KTb = KTf + 64 * GP;
    LAS bf16_t* VT = KTb + 64 * GP;
    const float* P = (const float*)(p.ws + WS_P);
    float* BF = (float*)(p.ws + WS_OF); float* BB = (float*)(p.ws + WS_OB);
    float* DELTA = (float*)(p.ws + WS_DELTA); float* DEC = (float*)(p.ws + WS_DEC);
    const float* w2 = p.in[I_GW2] + (size_t)l * 2 * 16 * 256; const float* b2 = p.in[I_GB2] + (size_t)l * 2 * 256;
    const int fr = lane & 15, fq = lane >> 4;
    for (int item = bid; item < GLA_ITEMS; item += G) {
        const int cid = item >> 2, h = item & 3, row0 = chunk_row0(cid);
#pragma unroll 1
        for (int j = 0; j < 16; ++j) { const int e = tid + NTHREADS * j, dir = e >> 12, i = (e >> 6) & 63, k = e & 63;
            const float* lr = P + (size_t)(row0 + i) * INWP + (dir ? C_LRB : C_LRF);
            float z = b2[dir * 256 + h * 64 + k];
#pragma unroll
            for (int q = 0; q < 16; ++q) z += lr[q] * w2[(dir * 16 + q) * 256 + h * 64 + k];
            (dir ? Bb : Bf)[i * 64 + k] = log_sigmoid_f(z) * (1.0f / 16.0f); }
        __syncthreads();
        if (tid < 128) { const int dir = tid >> 6, k = tid & 63; LAS float* Bl = dir ? Bb : Bf; float* BG = (dir ? BB : BF) + (size_t)row0 * 256 + h * 64 + k; float a = 0.f;
            if (dir == 0) { for (int i = 0; i < 64; ++i) { a += Bl[i * 64 + k]; Bl[i * 64 + k] = a; BG[(size_t)i * 256] = a; } }
            else { for (int i = 63; i >= 0; --i) { a += Bl[i * 64 + k]; Bl[i * 64 + k] = a; BG[(size_t)i * 256] = a; } } }
        __syncthreads();
#pragma unroll 1
        for (int j = 0; j < 8; ++j) { const int e = tid + NTHREADS * j, i = e >> 6, k = e & 63;
            const float kv = P[(size_t)(row0 + i) * INWP + C_GK + h * 64 + k];
            KTf[k * GP + i] = (bf16_t)f2bf(kv * expf(Bf[63 * 64 + k] - Bf[i * 64 + k]));
            KTb[k * GP + i] = (bf16_t)f2bf(kv * expf(Bb[k] - Bb[i * 64 + k])); }
#pragma unroll 1
        for (int j = 0; j < 16; ++j) { const int e = tid + NTHREADS * j, i = e >> 7, v = e & 127;
            VT[v * GP + i] = (bf16_t)f2bf(P[(size_t)(row0 + i) * INWP + C_GV + h * 128 + v]); }
        if (tid < 128) { const int dir = tid >> 6, k = tid & 63; DEC[((size_t)item * 2 + dir) * 64 + k] = expf(dir ? Bb[k] : Bf[63 * 64 + k]); }
        __syncthreads();
        { const int dir = wave >> 2, vq = wave & 3; const LAS bf16_t* KT = dir ? KTb : KTf;
            f32x4 acc[2][4];
#pragma unroll
            for (int a = 0; a < 2; ++a)
#pragma unroll
                for (int b = 0; b < 4; ++b) acc[a][b] = (f32x4){0.f, 0.f, 0.f, 0.f};
#pragma unroll
            for (int ks = 0; ks < 2; ++ks) { bf16x8 af[2], bfr[4];
#pragma unroll
                for (int a = 0; a < 2; ++a) af[a] = *(const LAS bf16x8*)(VT + ((vq * 2 + a) * 16 + fr) * GP + ks * 32 + fq * 8);
#pragma unroll
                for (int b = 0; b < 4; ++b) bfr[b] = *(const LAS bf16x8*)(KT + (b * 16 + fr) * GP + ks * 32 + fq * 8);
#pragma unroll
                for (int a = 0; a < 2; ++a)
#pragma unroll
                    for (int b = 0; b < 4; ++b) acc[a][b] = __builtin_amdgcn_mfma_f32_16x16x32_bf16(af[a], bfr[b], acc[a][b], 0, 0, 0); }
            float* dst = DELTA + ((size_t)item * 2 + dir) * 8192;
#pragma unroll
            for (int a = 0; a < 2; ++a)
#pragma unroll
                for (int b = 0; b < 4; ++b)
#pragma unroll
                    for (int g = 0; g < 4; ++g) dst[((vq * 2 + a) * 16 + fq * 4 + g) * 64 + b * 16 + fr] = acc[a][b][g]; }
        __syncthreads();
    }
}

__device__ __forceinline__ void gla_g2(const Params& p, int tid, int bid, int G) {
    const float* DELTA = (const float*)(p.ws + WS_DELTA); const float* DEC = (const float*)(p.ws + WS_DEC); bf16_t* SST = (bf16_t*)(p.ws + WS_SST);
    for (int u = bid; u < 64; u += G) {
        const int s = u >> 2, dir = s >> 3, b = (s >> 2) & 1, h = s & 3, off = ((u & 3) * NTHREADS + tid) * 4, k0 = off & 63;
        f32x4 S = (f32x4){0.f, 0.f, 0.f, 0.f};
#pragma unroll 1
        for (int st = 0; st < 132; st += 4) {
            f32x4 d[4], dc[4]; size_t base[4];
#pragma unroll
            for (int q = 0; q < 4; ++q) { const int t = st + q;
                const int cid = t < 4 ? 256 + b * 4 + (dir ? 3 - t : t) : b * 128 + (dir ? 127 - (t - 4) : (t - 4));
                const size_t it2 = (size_t)(cid * 4 + h) * 2 + dir; base[q] = it2 * 8192 + off;
                d[q] = *(const f32x4*)(DELTA + base[q]); dc[q] = *(const f32x4*)(DEC + it2 * 64 + k0); }
#pragma unroll
            for (int q = 0; q < 4; ++q) { u32x2 o; o.x = pk2(S.x, S.y); o.y = pk2(S.z, S.w); *(u32x2*)(SST + base[q]) = o; S = dc[q] * S + d[q]; }
        }
    }
}

__device__ __forceinline__ void gla_g3(const Params& p, int l, LAS unsigned char* lds, int tid, int lane, int wave, int bid, int G) {
    LAS bf16_t* QEf = (LAS bf16_t*)lds; LAS bf16_t* QEb = QEf + 64 * GP; LAS bf16_t* KEf = QEb + 64 * GP; LAS bf16_t* KEb = KEf + 64 * GP;
    LAS bf16_t* VT = KEb + 64 * GP;
    LAS bf16_t* ATT = VT + 128 * GP + wave * (16 * GP);
    LAS float* RS = (LAS float*)(lds + 2 * (4 * 64 * GP + 128 * GP + 8 * 16 * GP));
    const float* P = (const float*)(p.ws + WS_P);
    const float* BF = (const float*)(p.ws + WS_OF); const float* BB = (const float*)(p.ws + WS_OB);
    const bf16_t* SST = (const bf16_t*)(p.ws + WS_SST); bf16_t* MIX = (bf16_t*)(p.ws + WS_MIX);
    const float* nw = p.in[I_GNORM] + l * 128;
    const int fr = lane & 15, fq = lane >> 4, it = wave >> 1, vh = wave & 1;
    for (int item = bid; item < GLA_ITEMS; item += G) {
        const int cid = item >> 2, h = item & 3, row0 = chunk_row0(cid);
#pragma unroll 1
        for (int j = 0; j < 8; ++j) { const int e = tid + NTHREADS * j, i = e >> 6, k = e & 63;
            const size_t r = (size_t)(row0 + i);
            const float bf = BF[r * 256 + h * 64 + k], bb = BB[r * 256 + h * 64 + k];
            const float q = P[r * INWP + C_GQ + h * 64 + k] * 0.125f, kk = P[r * INWP + C_GK + h * 64 + k];
            QEf[i * GP + k] = (bf16_t)f2bf(q * expf(bf)); KEf[i * GP + k] = (bf16_t)f2bf(kk * expf(-bf));
            QEb[i * GP + k] = (bf16_t)f2bf(q * expf(bb)); KEb[i * GP + k] = (bf16_t)f2bf(kk * expf(-bb)); }
#pragma unroll 1
        for (int j = 0; j < 16; ++j) { const int e = tid + NTHREADS * j, i = e >> 7, v = e & 127;
            VT[v * GP + i] = (bf16_t)f2bf(P[(size_t)(row0 + i) * INWP + C_GV + h * 128 + v]); }
        __syncthreads();
        f32x4 acc[4];
#pragma unroll
        for (int vt = 0; vt < 4; ++vt) acc[vt] = (f32x4){0.f, 0.f, 0.f, 0.f};
#pragma unroll
        for (int dir = 0; dir < 2; ++dir) {
            const LAS bf16_t* QE = dir ? QEb : QEf; const LAS bf16_t* KE = dir ? KEb : KEf;
            bf16x8 qa[2];
#pragma unroll
            for (int ks = 0; ks < 2; ++ks) qa[ks] = *(const LAS bf16x8*)(QE + (it * 16 + fr) * GP + ks * 32 + fq * 8);
#pragma unroll
            for (int jt = 0; jt < 4; ++jt) { f32x4 a = (f32x4){0.f, 0.f, 0.f, 0.f};
#pragma unroll
                for (int ks = 0; ks < 2; ++ks) { const bf16x8 kb = *(const LAS bf16x8*)(KE + (jt * 16 + fr) * GP + ks * 32 + fq * 8); a = __builtin_amdgcn_mfma_f32_16x16x32_bf16(qa[ks], kb, a, 0, 0, 0); }
#pragma unroll
                for (int g = 0; g < 4; ++g) { const int ii = it * 16 + fq * 4 + g, jj = jt * 16 + fr; const bool keep = dir ? (jj >= ii) : (jj <= ii);
                    ATT[(fq * 4 + g) * GP + jt * 16 + fr] = (bf16_t)f2bf(keep ? a[g] : 0.f); } }
            LDS_FENCE();
            const bf16_t* Sg = SST + ((size_t)item * 2 + dir) * 8192;
#pragma unroll
            for (int ks = 0; ks < 2; ++ks) { const bf16x8 aa = *(const LAS bf16x8*)(ATT + fr * GP + ks * 32 + fq * 8);
#pragma unroll
                for (int vt = 0; vt < 4; ++vt) { const int v = (vh * 4 + vt) * 16 + fr;
                    const bf16x8 vb = *(const LAS bf16x8*)(VT + v * GP + ks * 32 + fq * 8);
                    acc[vt] = __builtin_amdgcn_mfma_f32_16x16x32_bf16(aa, vb, acc[vt], 0, 0, 0);
                    const bf16x8 sb = *(const bf16x8*)(Sg + v * 64 + ks * 32 + fq * 8);
                    acc[vt] = __builtin_amdgcn_mfma_f32_16x16x32_bf16(qa[ks], sb, acc[vt], 0, 0, 0); } }
            LDS_FENCE();
        }
        float ss[4];
#pragma unroll
        for (int g = 0; g < 4; ++g) { float t = 0.f;
#pragma unroll
            for (int vt = 0; vt < 4; ++vt) t += acc[vt][g] * acc[vt][g];
            t += __shfl_xor(t, 1); t += __shfl_xor(t, 2); t += __shfl_xor(t, 4); t += __shfl_xor(t, 8); ss[g] = t; }
        if (fr == 0) {
#pragma unroll
            for (int g = 0; g < 4; ++g) RS[(it * 16 + fq * 4 + g) * 2 + vh] = ss[g]; }
        __syncthreads();
#pragma unroll
        for (int g = 0; g < 4; ++g) { const int i = it * 16 + fq * 4 + g; const float tot = RS[i * 2] + RS[i * 2 + 1];
            const float rs = 1.0f / sqrtf(tot * (1.0f / 128.0f) + LN_EPS); const size_t r = (size_t)(row0 + i);
#pragma unroll
            for (int vt = 0; vt < 4; ++vt) { const int v = (vh * 4 + vt) * 16 + fr; const float gt = P[r * INWP + C_GG + h * 128 + v];
                MIX[r * DM + 512 + h * 128 + v] = (bf16_t)f2bf(acc[vt][g] * rs * nw[v] * silu_f(gt)); } }
        __syncthreads();
    }
}

__device__ __forceinline__ void ln_row(f32x4 (&v)[8], const float* lg, const float* lb, int lane) {
    float s = 0.f;
#pragma unroll
    for (int j = 0; j < 8; ++j) s += (v[j].x + v[j].y) + (v[j].z + v[j].w);
    const float mean = wave_sum(s) * (1.0f / DM);
    float s2 = 0.f;
#pragma unroll
    for (int j = 0; j < 8; ++j) { v[j] = v[j] - mean; s2 += (v[j].x * v[j].x + v[j].y * v[j].y) + (v[j].z * v[j].z + v[j].w * v[j].w); }
    const float rstd = 1.0f / sqrtf(wave_sum(s2) * (1.0f / DM) + LN_EPS);
#pragma unroll
    for (int j = 0; j < 8; ++j) { const int c = lane * 4 + 256 * j; const f32x4 g = *(const f32x4*)(lg + c), b = *(const f32x4*)(lb + c); v[j] = v[j] * rstd * g + b; }
}

__device__ __forceinline__ void phase_ln1(const Params& p, int l, int lane, int wave, int bid, int G) {
    const int gw = bid * NWAVES + wave, NGW = G * NWAVES;
    const float* MOD = (const float*)(p.ws + WS_MOD); const float* Y = (const float*)(p.ws + WS_Y);
    float* XL = (float*)(p.ws + WS_XL); bf16_t* HB = (bf16_t*)(p.ws + WS_HB);
    const float* lg = p.in[I_LNG] + (size_t)(l * 2 + 0) * DM; const float* lb = p.in[I_LNB] + (size_t)(l * 2 + 0) * DM;
    for (int r = gw; r < TA; r += NGW) {
        const float* mod = MOD + (size_t)(l * 3 + row_stream(r)) * 6 * DM;
        const float* xr = xsrc(p, l, r);
        f32x4 v[8];
#pragma unroll
        for (int j = 0; j < 8; ++j) { const int c = lane * 4 + 256 * j; const f32x4 x = *(const f32x4*)(xr + c), y = *(const f32x4*)(Y + (size_t)r * DM + c), g = *(const f32x4*)(mod + 2 * DM + c); v[j] = x * DN_ALPHA + g * y; }
        ln_row(v, lg, lb, lane);
#pragma unroll
        for (int j = 0; j < 8; ++j) { const int c = lane * 4 + 256 * j; *(f32x4*)(XL + (size_t)r * DM + c) = v[j];
            const f32x4 sh = *(const f32x4*)(mod + 3 * DM + c), s = *(const f32x4*)(mod + 4 * DM + c);
            u32x2 o; o.x = pk2(v[j].x * (1.f + s.x) + sh.x, v[j].y * (1.f + s.y) + sh.y); o.y = pk2(v[j].z * (1.f + s.z) + sh.z, v[j].w * (1.f + s.w) + sh.w);
            *(u32x2*)(HB + (size_t)r * DM + c) = o; }
    }
}

constexpr int SKP = 136;
__device__ __forceinline__ void group16_argmax(float& m, int& idx) {
#pragma unroll
    for (int o = 1; o < 16; o <<= 1) { const float om = __shfl_xor(m, o); const int oi = __shfl_xor(idx, o); if (om > m || (om == m && oi < idx)) { m = om; idx = oi; } }
}
__device__ __forceinline__ void peer_retrieve(const Params& p, int l, LAS unsigned char* lds, int tid, int lane, int wave, int bid, int G, int ntok) {
    LAS bf16_t* SK = (LAS bf16_t*)lds;
    const bf16_t* SUBB = (const bf16_t*)(p.ws + WS_SUBB) + (size_t)l * 2 * 128 * 128;
#pragma unroll 1
    for (int j = 0; j < 8; ++j) { const int vv = tid + NTHREADS * j, row = vv >> 4, c = vv & 15; *(LAS u32x4*)(SK + row * SKP + c * 8) = *(const u32x4*)(SUBB + row * 128 + c * 8); }
    __syncthreads();
    const bf16_t* QP = (const bf16_t*)(p.ws + WS_QP);
    int* EIDX = (int*)(p.ws + WS_EIDX); float* EGATE = (float*)(p.ws + WS_EGATE);
    const int gw = bid * NWAVES + wave, NGW = G * NWAVES, fr = lane & 15, fq = lane >> 4, gbase = lane & 48;
    const int nitems = (ntok / 16) * 8;
    for (int item = gw; item < nitems; item += NGW) {
        const int tile = item >> 3, h = item & 7;
        float tvp[2][4]; int tip[2][4];
#pragma unroll
        for (int pp = 0; pp < 2; ++pp) {
            asm volatile("" ::: "memory"); __builtin_amdgcn_sched_barrier(0);
            f32x4 acc[8];
#pragma unroll
            for (int kt = 0; kt < 8; ++kt) acc[kt] = (f32x4){0.f, 0.f, 0.f, 0.f};
#pragma unroll
            for (int ks = 0; ks < 4; ++ks) { const bf16x8 a = *(const bf16x8*)(QP + (size_t)(tile * 16 + fr) * DM + h * 256 + pp * 128 + ks * 32 + fq * 8);
#pragma unroll
                for (int kt = 0; kt < 8; ++kt) { const bf16x8 bb = *(const LAS bf16x8*)(SK + (pp * 128 + kt * 16 + fr) * SKP + ks * 32 + fq * 8); acc[kt] = __builtin_amdgcn_mfma_f32_16x16x32_bf16(a, bb, acc[kt], 0, 0, 0); } }
#pragma unroll
            for (int g = 0; g < 4; ++g) {
                float v[8];
#pragma unroll
                for (int kt = 0; kt < 8; ++kt) v[kt] = acc[kt][g];
                float tv = 0.f; int ti = 0;
#pragma unroll 1
                for (int it = 0; it < 16; ++it) {
                    float m = v[0]; int mi = 0;
#pragma unroll
                    for (int kt = 1; kt < 8; ++kt) if (v[kt] > m) { m = v[kt]; mi = kt; }
                    int idx = mi * 16 + fr;
                    group16_argmax(m, idx);
                    if (fr == it) { tv = m; ti = idx; }
                    const int wk = (idx & 15) == fr ? (idx >> 4) : -1;
#pragma unroll
                    for (int kt = 0; kt < 8; ++kt) if (kt == wk) v[kt] = -INFINITY;
                }
                tvp[pp][g] = tv; tip[pp][g] = ti;
            }
        }
#pragma unroll
        for (int g = 0; g < 4; ++g) {
            const float a = tvp[0][g], b = tvp[1][g];
            int ptr = 0; float bv = 0.f; int bc = 0;
#pragma unroll 1
            for (int it = 0; it < 16; ++it) {
                const float bj = __shfl(b, gbase + (ptr & 15));
                float m = ptr < 16 ? a + bj : -INFINITY; int idx = fr * 16 + (ptr & 15);
                group16_argmax(m, idx);
                if (fr == it) { bv = m; bc = idx; }
                if ((idx >> 4) == fr) ++ptr;
            }
            const int i1 = __shfl(tip[0][g], gbase + (bc >> 4)), i2 = __shfl(tip[1][g], gbase + (bc & 15));
            const float mx = __shfl(bv, gbase);
            const float ex = expf(bv - mx);
            float sm = ex;
#pragma unroll
            for (int o = 1; o < 16; o <<= 1) sm += __shfl_xor(sm, o);
            const size_t tok = (size_t)tile * 16 + fq * 4 + g;
            EIDX[tok * 128 + h * 16 + fr] = i1 * 128 + i2; EGATE[tok * 128 + h * 16 + fr] = ex / sm;
        }
    }
}

__device__ __forceinline__ float bflo(unsigned w) { return __builtin_bit_cast(float, w << 16); }
__device__ __forceinline__ float bfhi(unsigned w) { return __builtin_bit_cast(float, w & 0xffff0000u); }
__device__ __forceinline__ void phase_peer(const Params& p, int l, int lane, int wave, int bid, int G) {
    const int gw = bid * NWAVES + wave, NGW = G * NWAVES;
    const float* MOD = (const float*)(p.ws + WS_MOD);
    float* XL = (float*)(p.ws + WS_XL); bf16_t* HB = (bf16_t*)(p.ws + WS_HB);
    const float* lg = p.in[I_LNG] + (size_t)(l * 2 + 1) * DM; const float* lb = p.in[I_LNB] + (size_t)(l * 2 + 1) * DM;
    const bf16_t* UB = (const bf16_t*)(p.ws + WS_UB) + (size_t)l * NEXP * DM; const bf16_t* VB = (const bf16_t*)(p.ws + WS_VB) + (size_t)l * NEXP * DM;
    const int* EIDX = (const int*)(p.ws + WS_EIDX); const float* EGATE = (const float*)(p.ws + WS_EGATE);
    const bool last = (l == DEPTH - 1);
    const int nrows = last ? TL : TA;
    for (int r = gw; r < nrows; r += NGW) {
        const float* mod = MOD + (size_t)(l * 3 + row_stream(r)) * 6 * DM;
        float hf[4][8];
#pragma unroll
        for (int q = 0; q < 4; ++q) { const u32x4 w = *(const u32x4*)(HB + (size_t)r * DM + q * 512 + lane * 8);
            hf[q][0] = bflo(w.x); hf[q][1] = bfhi(w.x); hf[q][2] = bflo(w.y); hf[q][3] = bfhi(w.y); hf[q][4] = bflo(w.z); hf[q][5] = bfhi(w.z); hf[q][6] = bflo(w.w); hf[q][7] = bfhi(w.w); }
        const int e0 = EIDX[(size_t)r * 128 + lane], e1 = EIDX[(size_t)r * 128 + 64 + lane];
        const float g0 = EGATE[(size_t)r * 128 + lane], g1 = EGATE[(size_t)r * 128 + 64 + lane];
        float w0 = 0.f, w1 = 0.f;
#pragma unroll 1
        for (int j0 = 0; j0 < 128; j0 += 4) {
            u32x4 ur[4][4];
#pragma unroll
            for (int c = 0; c < 4; ++c) { const int j = j0 + c; const int e = j < 64 ? __builtin_amdgcn_readlane(e0, j) : __builtin_amdgcn_readlane(e1, j - 64);
                const bf16_t* up = UB + (size_t)e * DM + lane * 8;
#pragma unroll
                for (int q = 0; q < 4; ++q) ur[c][q] = *(const u32x4*)(up + q * 512); }
            float d[4];
#pragma unroll
            for (int c = 0; c < 4; ++c) { float a = 0.f;
#pragma unroll
                for (int q = 0; q < 4; ++q) { const u32x4 w = ur[c][q];
                    a += bflo(w.x) * hf[q][0]; a += bfhi(w.x) * hf[q][1]; a += bflo(w.y) * hf[q][2]; a += bfhi(w.y) * hf[q][3];
                    a += bflo(w.z) * hf[q][4]; a += bfhi(w.z) * hf[q][5]; a += bflo(w.w) * hf[q][6]; a += bfhi(w.w) * hf[q][7]; }
                d[c] = a; }
#pragma unroll
            for (int o = 1; o < 64; o <<= 1) {
#pragma unroll
                for (int c = 0; c < 4; ++c) d[c] += __shfl_xor(d[c], o); }
#pragma unroll
            for (int c = 0; c < 4; ++c) { const int j = j0 + c; const float act = gelu_f(d[c]);
                if (j < 64) { if (lane == j) w0 = act * g0; } else { if (lane == j - 64) w1 = act * g1; } }
        }
        float yv[4][8];
#pragma unroll
        for (int q = 0; q < 4; ++q)
#pragma unroll
            for (int i = 0; i < 8; ++i) yv[q][i] = 0.f;
#pragma unroll 1
        for (int j0 = 0; j0 < 128; j0 += 4) {
            u32x4 vr[4][4]; float wj[4];
#pragma unroll
            for (int c = 0; c < 4; ++c) { const int j = j0 + c; const int e = j < 64 ? __builtin_amdgcn_readlane(e0, j) : __builtin_amdgcn_readlane(e1, j - 64);
                wj[c] = __builtin_bit_cast(float, j < 64 ? __builtin_amdgcn_readlane(__builtin_bit_cast(int, w0), j) : __builtin_amdgcn_readlane(__builtin_bit_cast(int, w1), j - 64));
                const bf16_t* vp = VB + (size_t)e * DM + lane * 8;
#pragma unroll
                for (int q = 0; q < 4; ++q) vr[c][q] = *(const u32x4*)(vp + q * 512); }
#pragma unroll
            for (int c = 0; c < 4; ++c)
#pragma unroll
                for (int q = 0; q < 4; ++q) { const u32x4 w = vr[c][q];
                    yv[q][0] += wj[c] * bflo(w.x); yv[q][1] += wj[c] * bfhi(w.x); yv[q][2] += wj[c] * bflo(w.y); yv[q][3] += wj[c] * bfhi(w.y);
                    yv[q][4] += wj[c] * bflo(w.z); yv[q][5] += wj[c] * bfhi(w.z); yv[q][6] += wj[c] * bflo(w.w); yv[q][7] += wj[c] * bfhi(w.w); }
        }
        const float* xr = XL + (size_t)r * DM;
        float s = 0.f;
#pragma unroll
        for (int q = 0; q < 4; ++q) { const int c = q * 512 + lane * 8;
            const f32x4 x0 = *(const f32x4*)(xr + c), x1 = *(const f32x4*)(xr + c + 4), ga = *(const f32x4*)(mod + 5 * DM + c), gb = *(const f32x4*)(mod + 5 * DM + c + 4);
            yv[q][0] = x0.x * DN_ALPHA + ga.x * yv[q][0]; yv[q][1] = x0.y * DN_ALPHA + ga.y * yv[q][1]; yv[q][2] = x0.z * DN_ALPHA + ga.z * yv[q][2]; yv[q][3] = x0.w * DN_ALPHA + ga.w * yv[q][3];
            yv[q][4] = x1.x * DN_ALPHA + gb.x * yv[q][4]; yv[q][5] = x1.y * DN_ALPHA + gb.y * yv[q][5]; yv[q][6] = x1.z * DN_ALPHA + gb.z * yv[q][6]; yv[q][7] = x1.w * DN_ALPHA + gb.w * yv[q][7];
#pragma unroll
            for (int i = 0; i < 8; ++i) s += yv[q][i]; }
        const float mean = wave_sum(s) * (1.0f / DM);
        float s2 = 0.f;
#pragma unroll
        for (int q = 0; q < 4; ++q)
#pragma unroll
            for (int i = 0; i < 8; ++i) { yv[q][i] -= mean; s2 += yv[q][i] * yv[q][i]; }
        const float rstd = 1.0f / sqrtf(wave_sum(s2) * (1.0f / DM) + LN_EPS);
        float* dst = (last ? p.out : XL) + (size_t)r * DM;
        const float* modn = MOD + (size_t)((last ? l : l + 1) * 3 + row_stream(r)) * 6 * DM;
#pragma unroll
        for (int q = 0; q < 4; ++q) { const int c = q * 512 + lane * 8;
            const f32x4 ga = *(const f32x4*)(lg + c), gb = *(const f32x4*)(lg + c + 4), ba = *(const f32x4*)(lb + c), bb = *(const f32x4*)(lb + c + 4);
            f32x4 o0, o1;
            o0.x = yv[q][0] * rstd * ga.x + ba.x; o0.y = yv[q][1] * rstd * ga.y + ba.y; o0.z = yv[q][2] * rstd * ga.z + ba.z; o0.w = yv[q][3] * rstd * ga.w + ba.w;
            o1.x = yv[q][4] * rstd * gb.x + bb.x; o1.y = yv[q][5] * rstd * gb.y + bb.y; o1.z = yv[q][6] * rstd * gb.z + bb.z; o1.w = yv[q][7] * rstd * gb.w + bb.w;
            *(f32x4*)(dst + c) = o0; *(f32x4*)(dst + c + 4) = o1;
            if (!last) {
                const f32x4 sa = *(const f32x4*)(modn + c), sb = *(const f32x4*)(modn + c + 4), ca = *(const f32x4*)(modn + DM + c), cb = *(const f32x4*)(modn + DM + c + 4);
                u32x4 o; o.x = pk2(o0.x * (1.f + ca.x) + sa.x, o0.y * (1.f + ca.y) + sa.y); o.y = pk2(o0.z * (1.f + ca.z) + sa.z, o0.w * (1.f + ca.w) + sa.w);
                o.z = pk2(o1.x * (1.f + cb.x) + sb.x, o1.y * (1.f + cb.y) + sb.y); o.w = pk2(o1.z * (1.f + cb.z) + sb.z, o1.w * (1.f + cb.w) + sb.w);
                *(u32x4*)(HB + (size_t)r * DM + c) = o; }
        }
    }
}

__device__ __forceinline__ void gemm_rows(LAS unsigned char* lds, const bf16_t* A, const bf16_t* Bt, float* C, bool with_ctx, int G, int bid) {
    { pg8::Gemm g{A, Bt, TL, DM, DM}; pg8::StaticOrder S; S.init(TL, DM, G, bid); pg8::EpiF32 E{C, DM, nullptr};
      pg8::gemm_phase<pg8::EpiF32, pg8::StaticOrder, PG8_ALIGN, PG8_SP2>(lds, g, S, E); }
    if (with_ctx) { pg8::Gemm g{A + (size_t)TL * DM, Bt, TC, DM, DM}; pg8::StaticOrder S; S.init(TC, DM, G, bid); pg8::EpiF32 E{C + (size_t)TL * DM, DM, nullptr};
      pg8::gemm_phase<pg8::EpiF32, pg8::StaticOrder, PG8_ALIGN, PG8_SP2>(lds, g, S, E); }
}
__device__ __forceinline__ void gemm_rows_bf16(LAS unsigned char* lds, const bf16_t* A, const bf16_t* Bt, bf16_t* C, bool with_ctx, int G, int bid) {
    { pg8::Gemm g{A, Bt, TL, DM, DM}; pg8::StaticOrder S; S.init(TL, DM, G, bid); pg8::EpiBf16<0> E{C, DM, nullptr, 0, 0, 1.f};
      pg8::gemm_phase<pg8::EpiBf16<0>, pg8::StaticOrder, PG8_ALIGN, PG8_SP2>(lds, g, S, E); }
    if (with_ctx) { pg8::Gemm g{A + (size_t)TL * DM, Bt, TC, DM, DM}; pg8::StaticOrder S; S.init(TC, DM, G, bid); pg8::EpiBf16<0> E{C + (size_t)TL * DM, DM, nullptr, 0, 0, 1.f};
      pg8::gemm_phase<pg8::EpiBf16<0>, pg8::StaticOrder, PG8_ALIGN, PG8_SP2>(lds, g, S, E); }
}

constexpr int PH_PER_LAYER = 9, N_PHASES = 2 + DEPTH * PH_PER_LAYER;
__global__ void __launch_bounds__(NTHREADS, 2) fwd_kernel(Params p) {
    extern __shared__ __attribute__((aligned(16))) unsigned char lds_raw[];
    LAS unsigned char* lds = (LAS unsigned char*)lds_raw;
    const int tid = threadIdx.x, lane = tid & 63, wave = __builtin_amdgcn_readfirstlane(tid >> 6), bid = blockIdx.x, G = gridDim.x;
    volatile LAS unsigned* MISC = (volatile LAS unsigned*)(lds + MISC_OFF);
    if (tid < 32) MISC[tid] = 0u;
    __syncthreads();
    const int lo = p.ph_lo, hi = p.ph_hi;
    unsigned* ctl = (unsigned*)(p.ws + WS_CTL);
    XcdBarrier bar; bar.bar = ctl + CW_BAR; bar.x = 0; bar.st = MISC + 8;
    if (hi - lo > 1) bar = xcd_barrier_post(ctl + CW_BAR, MISC + 8);
#define IN(k) (lo <= (k) && (k) < hi)
#define SEAM(k) do { if (IN(k) && IN((k) + 1)) xcd_barrier(bar); } while (0)
    const int NGW = G * NWAVES;
#define FRESH() int tid_ = tid, lane_ = lane, wave_ = wave, bid_ = bid; asm volatile("" : "+v"(tid_), "+v"(lane_), "+s"(wave_), "+s"(bid_)); const int gw_ = bid_ * NWAVES + wave_; (void)tid_; (void)gw_
    if (IN(0)) { FRESH(); phase_prologue(p, lds, tid_, lane_, wave_, bid_, G); }
    SEAM(0);
    if (IN(1)) { FRESH(); phase_modulate0(p, lane_, wave_, bid_, G); }
    SEAM(1);
    for (int l = 0; l < DEPTH; ++l) {
        const int b0 = 2 + l * PH_PER_LAYER;
        if (IN(b0 + 0)) { FRESH();
            pg8::Gemm g{(const bf16_t*)(p.ws + WS_HB), (const bf16_t*)(p.ws + WS_WIN) + (size_t)l * INWP * DM, TA, INWP, DM}; pg8::StaticOrder S; S.init(TA, INWP, G, bid_);
            pg8::EpiF32 E{(float*)(p.ws + WS_P), INWP, nullptr};
            pg8::gemm_phase<pg8::EpiF32, pg8::StaticOrder, PG8_ALIGN, PG8_SP2>(lds, g, S, E); }
        SEAM(b0 + 0);
        if (IN(b0 + 1)) { { FRESH(); gla_g1(p, l, lds, tid_, lane_, wave_, bid_, G); } { FRESH(); phase_post_in(p, l, lane_, wave_, bid_, G); } }
        SEAM(b0 + 1);
        if (IN(b0 + 2)) { { FRESH(); gla_g2(p, tid_, bid_, G); } { FRESH(); phase_mixers(p, l, lds, tid_, lane_, wave_, bid_, G); } }
        SEAM(b0 + 2);
        if (IN(b0 + 3)) { FRESH(); gla_g3(p, l, lds, tid_, lane_, wave_, bid_, G); }
        SEAM(b0 + 3);
        if (IN(b0 + 4)) { FRESH();
            gemm_rows(lds, (const bf16_t*)(p.ws + WS_MIX), (const bf16_t*)(p.ws + WS_WOUT) + (size_t)l * DM * DM, (float*)(p.ws + WS_Y), l < DEPTH - 1, G, bid_); }
        SEAM(b0 + 4);
        if (IN(b0 + 5)) { FRESH(); phase_ln1(p, l, lane_, wave_, bid_, G); }
        SEAM(b0 + 5);
        if (IN(b0 + 6)) { FRESH();
            gemm_rows_bf16(lds, (const bf16_t*)(p.ws + WS_HB), (const bf16_t*)(p.ws + WS_WQ) + (size_t)l * DM * DM, (bf16_t*)(p.ws + WS_QP), l < DEPTH - 1, G, bid_); }
        SEAM(b0 + 6);
        if (IN(b0 + 7)) { FRESH(); peer_retrieve(p, l, lds, tid_, lane_, wave_, bid_, G, l < DEPTH - 1 ? TA : TL); }
        SEAM(b0 + 7);
        if (IN(b0 + 8)) { FRESH(); phase_peer(p, l, lane_, wave_, bid_, G); }
        SEAM(b0 + 8);
    }
#undef FRESH
#undef IN
#undef SEAM
}

#ifndef MK_PER_PHASE
#define MK_PER_PHASE 0
#endif
extern "C" void kernel_launch(void* const* d_in, const int* in_sizes, int n_in, void* d_out, int out_size, void* d_ws, size_t ws_size, hipStream_t stream) {
    static int grid = 0;
    if (grid == 0) {
        if (n_in != 19 || out_size != TL * DM || ws_size < WS_END) { fprintf(stderr, "kernel_launch: unexpected shapes (n_in %d out %d ws %zu)\n", n_in, out_size, ws_size); grid = -1; return; }
        int dev = 0, cus = 0;
        if (hipGetDevice(&dev) != hipSuccess || hipDeviceGetAttribute(&cus, hipDeviceAttributeMultiprocessorCount, dev) != hipSuccess) { grid = -1; return; }
        if (hipFuncSetAttribute((const void*)fwd_kernel, hipFuncAttributeMaxDynamicSharedMemorySize, LDS_BYTES) != hipSuccess) { fprintf(stderr, "kernel_launch: hipFuncSetAttribute failed\n"); grid = -1; return; }
        int per_cu = 0;
        (void)hipOccupancyMaxActiveBlocksPerMultiprocessor(&per_cu, (const void*)fwd_kernel, NTHREADS, LDS_BYTES);
        (void)hipGetLastError();
        if (per_cu < 1) fprintf(stderr, "kernel_launch: occupancy query reports %d blocks per CU\n", per_cu);
        grid = cus;
    }
    if (grid < 0) return;
    (void)hipMemsetAsync((char*)d_ws + WS_CTL, 0, CTL_ZERO_BYTES, stream);
    Params p{};
    for (int i = 0; i < 19; ++i) p.in[i] = (const float*)d_in[i];
    p.out = (float*)d_out; p.ws = (unsigned char*)d_ws;
#if MK_PER_PHASE
    for (int ph = 0; ph < N_PHASES; ++ph) { p.ph_lo = ph; p.ph_hi = ph + 1; hipLaunchKernelGGL(fwd_kernel, dim3(grid), dim3(NTHREADS), LDS_BYTES, stream, p); }
#else
    p.ph_lo = 0; p.ph_hi = N_PHASES;
    hipLaunchKernelGGL(fwd_kernel, dim3(grid), dim3(NTHREADS), LDS_BYTES, stream, p);
#endif
}
```

```cpp
#include <hip/hip_runtime.h>
#include <cstdio>
#include <cstdint>

#define LAS __attribute__((address_space(3)))
typedef unsigned short bf16_t;
typedef short bf16x8 __attribute__((ext_vector_type(8)));
typedef float f32x4 __attribute__((ext_vector_type(4)));
typedef unsigned u32x4 __attribute__((ext_vector_type(4)));
typedef unsigned u32x2 __attribute__((ext_vector_type(2)));

constexpr int DM = 2048, NBATCH = 2, SEQ = 8192, DEPTH = 4, CTXL = 256;
constexpr int TL = NBATCH * SEQ, TC = NBATCH * CTXL, TA = TL + TC;
constexpr int INW = 4640, INWP = 4864;
constexpr int C_CX = 0, C_CB = 512, C_CC = 1024, C_GQ = 1536, C_GK = 1792, C_GV = 2048, C_GG = 2560, C_LRF = 3072, C_LRB = 3088,
              C_SQ = 3104, C_SK = 4128, C_SV = 4384;
constexpr int NEXP = 16384;
constexpr float DN_ALPHA = 1.6817928305074290f;
constexpr float LN_EPS = 1e-6f;
constexpr int NWAVES = 8, NTHREADS = 512;

constexpr size_t MiB = 1u << 20;
constexpr size_t WS_CTL = 0, CTL_ZERO_BYTES = 2 * MiB;
constexpr size_t WS_MOD = 2 * MiB;
constexpr size_t WS_WIN = 4 * MiB;
constexpr size_t WS_WOUT = 80 * MiB;
constexpr size_t WS_WQ = 112 * MiB;
constexpr size_t WS_XL = 144 * MiB;
constexpr size_t WS_HB = 276 * MiB;
constexpr size_t WS_P = 342 * MiB;
constexpr size_t WS_QR = 656 * MiB;
constexpr size_t WS_KR = 720 * MiB;
constexpr size_t WS_ALF = 736 * MiB;
constexpr size_t WS_ALB = 753 * MiB;
constexpr size_t WS_OF = 770 * MiB;
constexpr size_t WS_OB = 803 * MiB;
constexpr size_t WS_MIX = 836 * MiB;
constexpr size_t WS_Y = 902 * MiB;
constexpr size_t WS_QP = 1034 * MiB;
constexpr size_t WS_DELTA = 1166 * MiB;
constexpr size_t WS_DEC = 1233 * MiB;
constexpr size_t WS_SST = 1234 * MiB;
constexpr size_t WS_UB = 1268 * MiB;
constexpr size_t WS_VB = 1524 * MiB;
constexpr size_t WS_EIDX = 1780 * MiB;
constexpr size_t WS_EGATE = 1789 * MiB;
constexpr size_t WS_SUBB = 1798 * MiB;
constexpr size_t WS_END = 1799 * MiB;
constexpr int GLA_ITEMS = (TA / 64) * 4;
static_assert(WS_DELTA + (size_t)GLA_ITEMS * 2 * 8192 * 4 <= WS_DEC && WS_DEC + (size_t)GLA_ITEMS * 2 * 64 * 4 <= WS_SST && WS_SST + (size_t)GLA_ITEMS * 2 * 8192 * 2 <= WS_END, "map");
static_assert(WS_WIN + (size_t)4 * INWP * DM * 2 <= WS_WOUT, "map");
static_assert(WS_P + (size_t)TA * INWP * 4 <= WS_QR, "map");
static_assert(WS_XL + (size_t)TA * DM * 4 <= WS_HB, "map");
constexpr int CW_BAR = 4096;
constexpr int LDS_BYTES = 147456;
constexpr int MISC_OFF = 131072 + 320;

#define XB_TMO      128
#define XB_XCNT(j)  (256  + 64 * (j))
#define XB_XSUB(j)  (1280 + 64 * (j))
#define XB_XGEN(j)  (2304 + 64 * (j))
#define XB_TOP      3328
#define XB_TOPGEN   3392
#define XCD_BAR_WORDS 3456
#define XB_SPIN_CAP (1u << 18)
__device__ __forceinline__ unsigned xb_ld(unsigned* p)              { return __hip_atomic_load(p, __ATOMIC_RELAXED, __HIP_MEMORY_SCOPE_AGENT); }
__device__ __forceinline__ unsigned xb_add(unsigned* p, unsigned v) { return __hip_atomic_fetch_add(p, v, __ATOMIC_RELAXED, __HIP_MEMORY_SCOPE_AGENT); }
__device__ __forceinline__ unsigned xb_xcc_id() { return (unsigned)__builtin_amdgcn_s_getreg((3 << 11) | 20) & 0xFu; }
#define XB_SPIN(cond, bar) do { unsigned _sp = 0; while (cond) { __builtin_amdgcn_s_sleep(1); \
    if ((++_sp & 255u) == 0u) { if (xb_ld(&(bar)[XB_TMO])) break; if (_sp > XB_SPIN_CAP) { atomicAdd(&(bar)[XB_TMO], 1u); break; } } } } while (0)
struct XcdBarrier { unsigned* bar; unsigned x; volatile LAS unsigned* st; };
__device__ __forceinline__ XcdBarrier xcd_barrier_post(unsigned* bar, volatile LAS unsigned* st) {
    XcdBarrier b; b.bar = bar; b.x = xb_xcc_id(); b.st = st;
    if (threadIdx.x == 0) (void)xb_add(&bar[XB_XCNT(b.x)], 1u);
    return b;
}
__device__ __forceinline__ void xcd_barrier_complete(unsigned* bar, unsigned x, unsigned& nloc, unsigned& nx) {
    const unsigned G = gridDim.x * gridDim.y * gridDim.z;
    unsigned sum, cnt, mine, sp = 0u;
    for (;;) {
        sum = 0u; cnt = 0u; mine = 0u;
#pragma unroll
        for (unsigned j = 0; j < 16; ++j) { const unsigned c = xb_ld(&bar[XB_XCNT(j)]); sum += c; cnt += (c > 0u) ? 1u : 0u; mine = (j == x) ? c : mine; }
        if (sum == G) break;
        __builtin_amdgcn_s_sleep(1);
        if ((++sp & 255u) == 0u) { if (xb_ld(&bar[XB_TMO])) break; if (sp > XB_SPIN_CAP) { atomicAdd(&bar[XB_TMO], 1u); break; } }
    }
    nloc = mine > 0u ? mine : 1u; nx = cnt > 0u ? cnt : 1u;
}
__device__ __forceinline__ void xcd_barrier(const XcdBarrier& b) {
    asm volatile("s_waitcnt vmcnt(0)" ::: "memory");
    __syncthreads();
    if (threadIdx.x == 0) {
        unsigned* bar = b.bar;
        __builtin_amdgcn_s_waitcnt(0);
        unsigned nloc = b.st[0], nx = b.st[1];
        if (nloc == 0u) { xcd_barrier_complete(bar, b.x, nloc, nx); b.st[0] = nloc; b.st[1] = nx; }
        const unsigned old = xb_add(&bar[XB_XSUB(b.x)], 1u);
        const unsigned gen = old / nloc;
        if (old + 1u == (gen + 1u) * nloc) {
            __builtin_amdgcn_fence(__ATOMIC_RELEASE, "agent");
            asm volatile("s_waitcnt vmcnt(0)" ::: "memory");
            const unsigned og = xb_add(&bar[XB_TOP], 1u);
            const unsigned tg = og / nx;
            if (og + 1u == (tg + 1u) * nx) xb_add(&bar[XB_TOPGEN], 1u);
            else XB_SPIN(xb_ld(&bar[XB_TOPGEN]) == tg, bar);
            __builtin_amdgcn_fence(__ATOMIC_ACQUIRE, "agent");
            xb_add(&bar[XB_XGEN(b.x)], 1u);
            asm volatile("s_waitcnt vmcnt(0)" ::: "memory");
        } else {
            XB_SPIN(xb_ld(&bar[XB_XGEN(b.x)]) == gen, bar);
            __builtin_amdgcn_fence(__ATOMIC_ACQUIRE, "agent");
            asm volatile("s_waitcnt vmcnt(0)" ::: "memory");
        }
    }
    __syncthreads();
}

namespace pg8 {
#define PG8_LAS __attribute__((address_space(3)))
typedef unsigned short bf16_t;
typedef short bf16x8 __attribute__((ext_vector_type(8)));
typedef float f32x4 __attribute__((ext_vector_type(4)));
typedef unsigned u32x4 __attribute__((ext_vector_type(4)));
constexpr int BM = 256, BK = 64, HALF = 128, HTB = HALF * BK * 2  , STAGE_BYTES = 8 * HTB, NXCD = 8, WGM = 8;

__host__ __device__ __forceinline__ int lds_byte(int r, int c) { const int st = (r >> 4) * 2 + (c >> 5), rr = r & 15, cc = c & 31, ob = rr * 64 + cc * 2; return st * 1024 + (ob ^ (((ob >> 9) & 1) << 5)); }
__host__ __device__ __forceinline__ void stage_rc(int b, int& R, int& C) { const int st = b / 1024, sb = b % 1024, swz = sb ^ (((sb >> 9) & 1) << 5); R = (st >> 1) * 16 + swz / 64; C = (st & 1) * 32 + (swz % 64) / 2; }
__host__ __device__ __forceinline__ int perm32(int rho) { const int n = rho >> 4, i = rho & 15; return 8 * (i >> 2) + 4 * n + (i & 3); }

struct Unit { int pm, pn; };
struct Gemm { const bf16_t* A; const bf16_t* Bt; int M, N, K; };

struct StaticOrder {
    int nM, nN, nwg, G, c;
    __host__ __device__ void init(int M, int N, int G_, int c_) { nM = M / BM; nN = N / BM; nwg = nM * nN; G = G_; c = c_; }
    __host__ __device__ bool next(int i, Unit& u) const {
        const long L = (long)i * G + c; if (L >= nwg) return false;
        int wgid = (int)L; { const int q = nwg / NXCD, r = nwg % NXCD, xcd = wgid % NXCD, off = wgid / NXCD; wgid = (xcd < r ? xcd * (q + 1) : r * (q + 1) + (xcd - r) * q) + off; }
        const int nig = WGM * nN, gid = wgid / nig, fm = gid * WGM, gsz = (nM - fm) < WGM ? (nM - fm) : WGM;
        u.pm = fm + ((wgid % nig) % gsz); u.pn = (wgid % nig) / gsz; return true;
    }
    __device__ __forceinline__ void a_ready(const Unit&) const {}
    __device__ __forceinline__ void done(const Unit&) const {}
};

__device__ __forceinline__ unsigned cvt_pk_bf16(float lo, float hi) { unsigned r; asm volatile("v_cvt_pk_bf16_f32 %0, %1, %2" : "=v"(r) : "v"(lo), "v"(hi)); return r; }
typedef float f32x2 __attribute__((ext_vector_type(2)));
__device__ __forceinline__ f32x2 gelu_pk(f32x2 v) {
    const f32x2 av = __builtin_elementwise_abs(v), d = av * 0.2316418882f + 1.0f;
    f32x2 t; t.x = __builtin_amdgcn_rcpf(d.x); t.y = __builtin_amdgcn_rcpf(d.y);
    f32x2 q = t * 0.5307027145f + (-0.7265760135f); q = q * t + 0.7107068705f; q = q * t + (-0.142248368f); q = q * t + 0.127414796f; q = q * t;
    const f32x2 s = (v * v) * (-0.72134752044f);
    f32x2 e; e.x = __builtin_amdgcn_exp2f(s.x); e.y = __builtin_amdgcn_exp2f(s.y);
    const f32x2 m = v * (q * e), r = v - m;
    f32x2 o; o.x = v.x < 0.f ? m.x : r.x; o.y = v.y < 0.f ? m.y : r.y; return o;
}

template <int ACT  > struct EpiBf16 {
    static constexpr bool PERM = true, AFTER_DRAIN = false; static_assert(ACT == 0 || ACT == 1, "EpiBf16: ACT is 0 (none) or 1 (gelu_pk)");
    bf16_t* O; int ldc; const float* bias; int split_cols; size_t split_stride; float scale0;
    __device__ __forceinline__ void operator()(const f32x4 (&acc)[2][2][4][2], const Unit& u, int wr, int wc, int fr, int fq) const {
        const int row0 = u.pm * BM + wr * 64 + fr; int colt = u.pn * BM; bf16_t* base = O;
        float sc = 1.f; if (split_cols) { const int t = colt / split_cols; base += (size_t)t * split_stride; colt -= t * split_cols; if (t == 0) sc = scale0; }
        const int col0 = colt + wc * 32 + 8 * fq, bcol0 = u.pn * BM + wc * 32 + 8 * fq;
        f32x4 bv[2][2];
#pragma unroll
        for (int bj = 0; bj < 2; ++bj)
#pragma unroll
            for (int n = 0; n < 2; ++n) bv[bj][n] = bias ? *(const f32x4*)(bias + bcol0 + bj * HALF + 4 * n) : (f32x4){0.f, 0.f, 0.f, 0.f};
#pragma unroll
        for (int ai = 0; ai < 2; ++ai)
#pragma unroll
            for (int m = 0; m < 4; ++m) { bf16_t* rowp = base + (size_t)(row0 + ai * HALF + m * 16) * ldc + col0;
#pragma unroll
                for (int bj = 0; bj < 2; ++bj) { f32x4 v0 = acc[ai][bj][m][0] + bv[bj][0], v1 = acc[ai][bj][m][1] + bv[bj][1];
                    if (ACT == 1) { f32x2 a = gelu_pk((f32x2){v0[0], v0[1]}), b = gelu_pk((f32x2){v0[2], v0[3]}), c = gelu_pk((f32x2){v1[0], v1[1]}), d = gelu_pk((f32x2){v1[2], v1[3]});
                        v0 = (f32x4){a.x, a.y, b.x, b.y}; v1 = (f32x4){c.x, c.y, d.x, d.y}; }
                    v0 = v0 * sc; v1 = v1 * sc; u32x4 w; w.x = cvt_pk_bf16(v0[0], v0[1]); w.y = cvt_pk_bf16(v0[2], v0[3]); w.z = cvt_pk_bf16(v1[0], v1[1]); w.w = cvt_pk_bf16(v1[2], v1[3]);
                    *(u32x4*)(rowp + bj * HALF) = w; } }
    }
};


struct EpiF32 {
    static constexpr bool PERM = false, AFTER_DRAIN = false;
    float* C; int ldc; const float* bias;
    __device__ __forceinline__ void operator()(const f32x4 (&acc)[2][2][4][2], const Unit& u, int wr, int wc, int fr, int fq) const {
        const int row0 = u.pm * BM + wr * 64 + fr, col0 = u.pn * BM + wc * 32 + 4 * fq;
        f32x4 bv[2][2];
#pragma unroll
        for (int bj = 0; bj < 2; ++bj)
#pragma unroll
            for (int n = 0; n < 2; ++n) bv[bj][n] = bias ? *(const f32x4*)(bias + col0 + bj * HALF + n * 16) : (f32x4){0.f, 0.f, 0.f, 0.f};
#pragma unroll
        for (int ai = 0; ai < 2; ++ai)
#pragma unroll
            for (int m = 0; m < 4; ++m) { float* rowp = C + (size_t)(row0 + ai * HALF + m * 16) * ldc + col0;
#pragma unroll
                for (int bj = 0; bj < 2; ++bj)
#pragma unroll
                    for (int n = 0; n < 2; ++n) *(f32x4*)(rowp + bj * HALF + n * 16) = acc[ai][bj][m][n] + bv[bj][n]; }
    }
};

template <class Epi, class Sched, bool ALIGN_EPI = false, bool SP2 = false>
__device__ __forceinline__ void gemm_phase(PG8_LAS unsigned char* lds, const Gemm g, const Sched& S, const Epi& E) {
    const int tid = threadIdx.x, wid = __builtin_amdgcn_readfirstlane(tid >> 6), lane = tid & 63, wr = wid >> 2, wc = wid & 3, fr = lane & 15, fq = lane >> 4;
    const int K = g.K, nt = K / BK;
    unsigned voffA[2], voffB[2];
#pragma unroll
    for (int i = 0; i < 2; ++i) { int R, C; stage_rc(tid * 16 + i * 8192, R, C); const int Rb = Epi::PERM ? ((R & ~31) + perm32(R & 31)) : R;
        voffA[i] = (unsigned)(R * K + C) * 2u; voffB[i] = (unsigned)(Rb * K + C) * 2u; }
    const size_t kstep = (size_t)(BK * 2);
    const size_t hstep = (size_t)HALF * K * 2;
    const size_t tstep = 2 * hstep;
    const unsigned ldsw = (unsigned)wid * 1024u;
    const int aoff = lds_byte(wr * 64 + fr, fq * 8), boff = lds_byte(wc * 32 + fr, fq * 8);
#define PG8_SA(b, h) (((b) * 2 + (h)) * HTB)
#define PG8_SB(b, h) ((4 + (b) * 2 + (h)) * HTB)
#define PG8_STAGE(bufoff, gbase, voff) do { _Pragma("unroll") for (int _i = 0; _i < 2; ++_i) \
        __builtin_amdgcn_global_load_lds((const unsigned*)((const char*)(gbase) + (voff)[_i]), (PG8_LAS unsigned*)(lds + (bufoff) + ldsw + _i * 8192), 16, 0, 0); } while (0)
#define PG8_LDA(dst, b, h) do { _Pragma("unroll") for (int m = 0; m < 4; ++m) _Pragma("unroll") for (int k = 0; k < 2; ++k) dst[m][k] = *(const PG8_LAS bf16x8*)(lds + PG8_SA(b, h) + aoff + m * 2048 + k * 1024); } while (0)
#define PG8_LDB(dst, b, h) do { _Pragma("unroll") for (int n = 0; n < 2; ++n) _Pragma("unroll") for (int k = 0; k < 2; ++k) dst[n][k] = *(const PG8_LAS bf16x8*)(lds + PG8_SB(b, h) + boff + n * 2048 + k * 1024); } while (0)
#define PG8_MMA(ai, bj, At, Bt) do { __builtin_amdgcn_s_setprio(1); _Pragma("unroll") for (int m = 0; m < 4; ++m) _Pragma("unroll") for (int n = 0; n < 2; ++n) _Pragma("unroll") for (int k = 0; k < 2; ++k) \
        acc[ai][bj][m][n] = __builtin_amdgcn_mfma_f32_16x16x32_bf16(Bt[n][k], At[m][k], acc[ai][bj][m][n], 0, 0, 0); __builtin_amdgcn_s_setprio(0); } while (0)
#define PG8_WAIT_V(n) asm volatile("s_waitcnt vmcnt(" #n ")" ::: "memory")
#define PG8_WAIT_L(n) asm volatile("s_waitcnt lgkmcnt(" #n ")" ::: "memory")
#define PG8_BAR __builtin_amdgcn_s_barrier()
#define PG8_SCHED __builtin_amdgcn_sched_barrier(0)
    Unit cur, nxt; int ui = 0;
    if (!S.next(0, cur)) return;
    f32x4 acc[2][2][4][2];
#pragma unroll
    for (int a = 0; a < 2; ++a)
#pragma unroll
        for (int b = 0; b < 2; ++b)
#pragma unroll
            for (int m = 0; m < 4; ++m)
#pragma unroll
                for (int n = 0; n < 2; ++n) acc[a][b][m][n] = (f32x4){0.f, 0.f, 0.f, 0.f};
    bf16x8 At[4][2], B0[2][2], B1[2][2];
    const char* cA = (const char*)g.A + (size_t)cur.pm * tstep; const char* cB = (const char*)g.Bt + (size_t)cur.pn * tstep;
    S.a_ready(cur);
    if constexpr (SP2) {
        PG8_STAGE(PG8_SB(0, 0), cB, voffB); PG8_STAGE(PG8_SB(0, 1), cB + hstep, voffB); PG8_STAGE(PG8_SA(0, 0), cA, voffA); PG8_STAGE(PG8_SA(0, 1), cA + hstep, voffA);
        if (wr == 1) PG8_BAR;
        PG8_WAIT_V(2); PG8_BAR;
        PG8_STAGE(PG8_SB(1, 0), cB + kstep, voffB); PG8_STAGE(PG8_SA(1, 0), cA + kstep, voffA); PG8_STAGE(PG8_SB(1, 1), cB + hstep + kstep, voffB);
        PG8_WAIT_V(6); PG8_BAR;
    } else {
        PG8_STAGE(PG8_SB(0, 0), cB, voffB); PG8_STAGE(PG8_SA(0, 0), cA, voffA); PG8_STAGE(PG8_SB(0, 1), cB + hstep, voffB); PG8_STAGE(PG8_SA(0, 1), cA + hstep, voffA);
        if (wr == 1) PG8_BAR;
        PG8_WAIT_V(4); PG8_BAR;
        PG8_STAGE(PG8_SB(1, 0), cB + kstep, voffB); PG8_STAGE(PG8_SA(1, 0), cA + kstep, voffA); PG8_STAGE(PG8_SB(1, 1), cB + hstep + kstep, voffB);
        PG8_WAIT_V(6); PG8_BAR;
    }
    for (;;) {
        const bool has_next = S.next(ui + 1, nxt);
        const char* nA = has_next ? (const char*)g.A + (size_t)nxt.pm * tstep : cA; const char* nB = has_next ? (const char*)g.Bt + (size_t)nxt.pn * tstep : cB;
        for (int t = 0; t < nt; t += 2) {
            const bool last = (t == nt - 2);
            const char* a1 = cA + (size_t)(t + 1) * kstep;
            const char* a2 = last ? nA : cA + (size_t)(t + 2) * kstep; const char* b2 = last ? nB : cB + (size_t)(t + 2) * kstep;
            const char* a3 = a2 + kstep; const char* b3 = b2 + kstep;
            if (last && has_next) S.a_ready(nxt);
            if constexpr (SP2) {
            PG8_LDB(B0, 0, 0); PG8_LDB(B1, 0, 1); PG8_SCHED; PG8_LDA(At, 0, 0); PG8_STAGE(PG8_SA(1, 1), a1 + hstep, voffA);
            PG8_WAIT_V(8); PG8_WAIT_L(0); PG8_BAR; PG8_MMA(0, 0, At, B0); PG8_MMA(0, 1, At, B1); PG8_BAR; PG8_SCHED;
            PG8_LDA(At, 0, 1); PG8_STAGE(PG8_SB(0, 0), b2, voffB); PG8_STAGE(PG8_SB(0, 1), b2 + hstep, voffB); PG8_STAGE(PG8_SA(0, 0), a2, voffA);
            PG8_WAIT_V(8); PG8_WAIT_L(0); PG8_BAR; PG8_MMA(1, 0, At, B0); PG8_MMA(1, 1, At, B1); PG8_BAR; PG8_SCHED;
            PG8_LDB(B0, 1, 0); PG8_LDB(B1, 1, 1); PG8_SCHED; PG8_LDA(At, 1, 0); PG8_STAGE(PG8_SA(0, 1), a2 + hstep, voffA);
            PG8_WAIT_V(8); PG8_WAIT_L(0); PG8_BAR; PG8_MMA(0, 0, At, B0); PG8_MMA(0, 1, At, B1); PG8_BAR; PG8_SCHED;
            PG8_LDA(At, 1, 1); PG8_STAGE(PG8_SB(1, 0), b3, voffB); PG8_STAGE(PG8_SB(1, 1), b3 + hstep, voffB); PG8_STAGE(PG8_SA(1, 0), a3, voffA);
            PG8_WAIT_V(8); PG8_WAIT_L(0); PG8_BAR; PG8_MMA(1, 0, At, B0); PG8_MMA(1, 1, At, B1); PG8_BAR; PG8_SCHED;
            } else {
            PG8_LDB(B0, 0, 0); PG8_SCHED; PG8_LDA(At, 0, 0); PG8_STAGE(PG8_SA(1, 1), a1 + hstep, voffA);
            PG8_WAIT_L(8); PG8_BAR; PG8_WAIT_L(0); PG8_MMA(0, 0, At, B0); PG8_BAR; PG8_SCHED;
            PG8_LDB(B1, 0, 1); PG8_STAGE(PG8_SB(0, 0), b2, voffB);
            PG8_BAR; PG8_WAIT_L(0); PG8_MMA(0, 1, At, B1); PG8_BAR;
            PG8_LDA(At, 0, 1); PG8_STAGE(PG8_SA(0, 0), a2, voffA);
            PG8_BAR; PG8_WAIT_L(0); PG8_MMA(1, 0, At, B0); PG8_BAR; PG8_SCHED;
            PG8_STAGE(PG8_SB(0, 1), b2 + hstep, voffB);
            PG8_WAIT_V(6); PG8_BAR; PG8_MMA(1, 1, At, B1); PG8_BAR;
            PG8_LDB(B0, 1, 0); PG8_SCHED; PG8_LDA(At, 1, 0); PG8_STAGE(PG8_SA(0, 1), a2 + hstep, voffA);
            PG8_WAIT_L(8); PG8_BAR; PG8_WAIT_L(0); PG8_MMA(0, 0, At, B0); PG8_BAR; PG8_SCHED;
            PG8_LDB(B1, 1, 1); PG8_STAGE(PG8_SB(1, 0), b3, voffB);
            PG8_BAR; PG8_WAIT_L(0); PG8_MMA(0, 1, At, B1); PG8_BAR;
            PG8_LDA(At, 1, 1); PG8_STAGE(PG8_SA(1, 0), a3, voffA);
            PG8_BAR; PG8_WAIT_L(0); PG8_MMA(1, 0, At, B0); PG8_BAR; PG8_SCHED;
            PG8_STAGE(PG8_SB(1, 1), b3 + hstep, voffB);
            PG8_WAIT_V(6); PG8_BAR; PG8_MMA(1, 1, At, B1); PG8_BAR;
            }
        }
        if constexpr (ALIGN_EPI) { if (wr == 0) PG8_BAR; }
        if constexpr (!Epi::AFTER_DRAIN) { E(acc, cur, wr, wc, fr, fq); S.done(cur); }
        if (!has_next) break;
#pragma unroll
        for (int a = 0; a < 2; ++a)
#pragma unroll
            for (int b = 0; b < 2; ++b)
#pragma unroll
                for (int m = 0; m < 4; ++m)
#pragma unroll
                    for (int n = 0; n < 2; ++n) acc[a][b][m][n] = (f32x4){0.f, 0.f, 0.f, 0.f};
        cur = nxt; cA = nA; cB = nB; ++ui;
        if constexpr (ALIGN_EPI) { if (wr == 1) PG8_BAR; }
    }
    PG8_WAIT_V(0);
    if constexpr (!ALIGN_EPI) { if (wr == 0) PG8_BAR; }
    PG8_BAR;
    if constexpr (Epi::AFTER_DRAIN) { E.fused(acc, cur, wr, wc, fr, fq, lds, wid, lane); S.done(cur); }
#undef PG8_SA
#undef PG8_SB
#undef PG8_STAGE
#undef PG8_LDA
#undef PG8_LDB
#undef PG8_MMA
#undef PG8_WAIT_V
#undef PG8_WAIT_L
#undef PG8_BAR
#undef PG8_SCHED
}
}
#define PG8_SP2 true
#define PG8_ALIGN true

#define LDS_FENCE() asm volatile("s_waitcnt lgkmcnt(0)" ::: "memory")
__device__ __forceinline__ unsigned f2bf(float f) { unsigned u = __builtin_bit_cast(unsigned, f); return (u + 0x7fffu + ((u >> 16) & 1u)) >> 16; }
__device__ __forceinline__ unsigned pk2(float lo, float hi) { return f2bf(lo) | (f2bf(hi) << 16); }
__device__ __forceinline__ float wave_sum(float v) {
#pragma unroll
    for (int o = 1; o < 64; o <<= 1) v += __shfl_xor(v, o);
    return v;
}
__device__ __forceinline__ float wave_max(float v) {
#pragma unroll
    for (int o = 1; o < 64; o <<= 1) v = fmaxf(v, __shfl_xor(v, o));
    return v;
}
__device__ __forceinline__ float silu_f(float x) { return x / (1.0f + expf(-x)); }
__device__ __forceinline__ float gelu_f(float x) { return 0.5f * x * (1.0f + erff(x * 0.70710678118654752f)); }
__device__ __forceinline__ float log_sigmoid_f(float z) { return fminf(z, 0.0f) - log1pf(expf(-fabsf(z))); }

struct Params {
    const float* in[19];
    float* out;
    unsigned char* ws;
    int ph_lo, ph_hi;
};
enum { I_X = 0, I_C, I_CTX, I_CCTX, I_WADA, I_BADA, I_WIN, I_CONVW, I_GW2, I_GB2, I_GNORM, I_SINK, I_WOUT, I_LNG, I_LNB, I_PWQ, I_PSUB, I_PU, I_PV };

__device__ __forceinline__ int row_stream(int r) { return r < TL ? r / SEQ : 2; }

__device__ __forceinline__ void transpose_item(const float* W, int K, int N, bf16_t* WT, LAS float* scr, int item, int lane) {
    const int nblk = N / 32, kb = item / nblk, nb = item % nblk, k0 = 64 * kb, n0 = 32 * nb;
#pragma unroll 8
    for (int i = 0; i < 32; ++i) { const int kk = 2 * i + (lane >> 5); scr[kk * 33 + (lane & 31)] = W[(size_t)(k0 + kk) * N + n0 + (lane & 31)]; }
    LDS_FENCE();
    const int c = lane & 7;
#pragma unroll
    for (int j = 0; j < 4; ++j) { const int n = (lane >> 3) + 8 * j; const LAS float* s = scr + (8 * c) * 33 + n;
        u32x4 o; o.x = pk2(s[0 * 33], s[1 * 33]); o.y = pk2(s[2 * 33], s[3 * 33]); o.z = pk2(s[4 * 33], s[5 * 33]); o.w = pk2(s[6 * 33], s[7 * 33]);
        *(u32x4*)(WT + (size_t)(n0 + n) * K + k0 + 8 * c) = o; }
    LDS_FENCE();
}

__device__ __forceinline__ void phase_prologue(const Params& p, LAS unsigned char* lds, int tid, int lane, int wave, int bid, int G) {
    const int gw = bid * NWAVES + wave, NGW = G * NWAVES;
    LAS float* scr = (LAS float*)(lds + wave * 16384);
    bf16_t* WIN = (bf16_t*)(p.ws + WS_WIN); bf16_t* WOUT = (bf16_t*)(p.ws + WS_WOUT); bf16_t* WQ = (bf16_t*)(p.ws + WS_WQ);
    constexpr int IT_IN = (DM / 64) * (INW / 32), IT_SQ = (DM / 64) * (DM / 32), IT_L = IT_IN + 2 * IT_SQ;
    for (int it = gw; it < DEPTH * IT_L; it += NGW) {
        const int l = it / IT_L; int r = it % IT_L;
        if (r < IT_IN) { transpose_item(p.in[I_WIN] + (size_t)l * DM * INW, DM, INW, WIN + (size_t)l * INWP * DM, scr, r, lane); continue; } r -= IT_IN;
        if (r < IT_SQ) { transpose_item(p.in[I_WOUT] + (size_t)l * DM * DM, DM, DM, WOUT + (size_t)l * DM * DM, scr, r, lane); continue; } r -= IT_SQ;
        transpose_item(p.in[I_PWQ] + (size_t)l * DM * DM, DM, DM, WQ + (size_t)l * DM * DM, scr, r, lane);
    }
    {
        constexpr int PADV = (INWP - INW) * DM / 8;
        const int gt = bid * NTHREADS + tid, NGT = G * NTHREADS;
        for (int i = gt; i < DEPTH * PADV; i += NGT) { const int l = i / PADV, o = i % PADV;
            *(u32x4*)(WIN + (size_t)l * INWP * DM + (size_t)INW * DM + (size_t)o * 8) = (u32x4){0u, 0u, 0u, 0u}; }
    }
    {
        const size_t gt = (size_t)bid * NTHREADS + tid, NGT = (size_t)G * NTHREADS;
        const size_t NV = (size_t)DEPTH * NEXP * DM / 8;
        const float* U = p.in[I_PU]; const float* V = p.in[I_PV]; bf16_t* UB = (bf16_t*)(p.ws + WS_UB); bf16_t* VB = (bf16_t*)(p.ws + WS_VB);
        for (size_t i = gt; i < NV; i += NGT) {
            const f32x4 a0 = *(const f32x4*)(U + i * 8), a1 = *(const f32x4*)(U + i * 8 + 4), b0 = *(const f32x4*)(V + i * 8), b1 = *(const f32x4*)(V + i * 8 + 4);
            u32x4 o; o.x = pk2(a0.x, a0.y); o.y = pk2(a0.z, a0.w); o.z = pk2(a1.x, a1.y); o.w = pk2(a1.z, a1.w); *(u32x4*)(UB + i * 8) = o;
            u32x4 q; q.x = pk2(b0.x, b0.y); q.y = pk2(b0.z, b0.w); q.z = pk2(b1.x, b1.y); q.w = pk2(b1.z, b1.w); *(u32x4*)(VB + i * 8) = q; }
        const float* SUB = p.in[I_PSUB]; bf16_t* SUBB = (bf16_t*)(p.ws + WS_SUBB);
        for (size_t i = gt; i < (size_t)DEPTH * 2 * 128 * 128 / 2; i += NGT) ((unsigned*)SUBB)[i] = pk2(SUB[2 * i], SUB[2 * i + 1]);
    }
    __syncthreads();
    LAS float* sc = (LAS float*)lds;
    LAS float* red = (LAS float*)(lds + 32768);
    for (int i = tid; i < 3 * DM; i += NTHREADS) { const int s = i / DM, k = i % DM; const float v = s < 2 ? p.in[I_C][s * DM + k] : p.in[I_CCTX][k]; sc[i] = silu_f(v); }
    __syncthreads();
    float* MOD = (float*)(p.ws + WS_MOD);
    constexpr int NCH = 6 * DM / 64;
    for (int it = bid; it < DEPTH * NCH; it += G) {
        const int l = it / NCH, n = (it % NCH) * 64 + lane;
        const float* wp = p.in[I_WADA] + (size_t)l * DM * 6 * DM + n;
        float a0 = 0.f, a1 = 0.f, a2 = 0.f;
        const int kb = wave * (DM / NWAVES);
#pragma unroll 8
        for (int k = kb; k < kb + DM / NWAVES; ++k) { const float w = wp[(size_t)k * 6 * DM]; a0 += sc[k] * w; a1 += sc[DM + k] * w; a2 += sc[2 * DM + k] * w; }
        red[(wave * 3 + 0) * 64 + lane] = a0; red[(wave * 3 + 1) * 64 + lane] = a1; red[(wave * 3 + 2) * 64 + lane] = a2;
        __syncthreads();
        if (tid < 192) { const int s = tid / 64, ln = tid % 64; float v = 0.f;
#pragma unroll
            for (int w = 0; w < NWAVES; ++w) v += red[(w * 3 + s) * 64 + ln];
            const int nn = (it % NCH) * 64 + ln;
            MOD[((size_t)l * 3 + s) * 6 * DM + nn] = v + p.in[I_BADA][(size_t)l * 6 * DM + nn]; }
        __syncthreads();
    }
}

__device__ __forceinline__ const float* xsrc(const Params& p, int l, int r) {
    if (l > 0) return (const float*)(p.ws + WS_XL) + (size_t)r * DM;
    return r < TL ? p.in[I_X] + (size_t)r * DM : p.in[I_CTX] + (size_t)(r - TL) * DM;
}

__device__ __forceinline__ void modulate_row(const float* xr, const float* mod, int sh_off, int sc_off, bf16_t* hb, int lane) {
#pragma unroll
    for (int j = 0; j < 8; ++j) { const int c = lane * 4 + 256 * j;
        const f32x4 x = *(const f32x4*)(xr + c), sh = *(const f32x4*)(mod + sh_off + c), s = *(const f32x4*)(mod + sc_off + c);
        u32x2 o; o.x = pk2(x.x * (1.f + s.x) + sh.x, x.y * (1.f + s.y) + sh.y); o.y = pk2(x.z * (1.f + s.z) + sh.z, x.w * (1.f + s.w) + sh.w);
        *(u32x2*)(hb + c) = o; }
}
__device__ __forceinline__ void phase_modulate0(const Params& p, int lane, int wave, int bid, int G) {
    const int gw = bid * NWAVES + wave, NGW = G * NWAVES;
    const float* MOD = (const float*)(p.ws + WS_MOD); bf16_t* HB = (bf16_t*)(p.ws + WS_HB);
    for (int r = gw; r < TA; r += NGW) modulate_row(xsrc(p, 0, r), MOD + (size_t)(0 * 3 + row_stream(r)) * 6 * DM, 0, DM, HB + (size_t)r * DM, lane);
}

__device__ __forceinline__ void gemm_direct(const bf16_t* A, const bf16_t* Bt, float* C, int M, int N, int K, int ldc, int gw, int NGW, int lane) {
    const int nTn = N / 64, nItems = (M / 32) * nTn;
    const int fr = lane & 15, fq = lane >> 4;
    for (int it = gw; it < nItems; it += NGW) {
        const int mt = it / nTn, nt = it % nTn;
        const bf16_t* a0 = A + (size_t)(mt * 32 + fr) * K + fq * 8;
        const bf16_t* b0 = Bt + (size_t)(nt * 64 + fr) * K + fq * 8;
        f32x4 acc[2][4];
#pragma unroll
        for (int i = 0; i < 2; ++i)
#pragma unroll
            for (int j = 0; j < 4; ++j) acc[i][j] = (f32x4){0.f, 0.f, 0.f, 0.f};
#pragma unroll 2
        for (int k0 = 0; k0 < K; k0 += 32) {
            bf16x8 af[2], bfr[4];
#pragma unroll
            for (int i = 0; i < 2; ++i) af[i] = *(const bf16x8*)(a0 + (size_t)i * 16 * K + k0);
#pragma unroll
            for (int j = 0; j < 4; ++j) bfr[j] = *(const bf16x8*)(b0 + (size_t)j * 16 * K + k0);
#pragma unroll
            for (int i = 0; i < 2; ++i)
#pragma unroll
                for (int j = 0; j < 4; ++j) acc[i][j] = __builtin_amdgcn_mfma_f32_16x16x32_bf16(af[i], bfr[j], acc[i][j], 0, 0, 0);
        }
#pragma unroll
        for (int i = 0; i < 2; ++i)
#pragma unroll
            for (int j = 0; j < 4; ++j)
#pragma unroll
                for (int g = 0; g < 4; ++g) C[(size_t)(mt * 32 + i * 16 + fq * 4 + g) * ldc + nt * 64 + j * 16 + fr] = acc[i][j][g];
    }
}

__device__ __forceinline__ void phase_post_in(const Params& p, int l, int lane, int wave, int bid, int G) {
    const int gw = bid * NWAVES + wave, NGW = G * NWAVES;
    const float* P = (const float*)(p.ws + WS_P);
    bf16_t* QR = (bf16_t*)(p.ws + WS_QR); bf16_t* KR = (bf16_t*)(p.ws + WS_KR); bf16_t* VR = (bf16_t*)(p.ws + WS_ALF);
    bf16_t* MIX = (bf16_t*)(p.ws + WS_MIX);
    const float* cw = p.in[I_CONVW] + (size_t)l * 3 * 512;
    for (int r = gw; r < TA; r += NGW) {
        const float* pr = P + (size_t)r * INWP;
        int pos, len;
        if (r < TL) { pos = r % SEQ; len = SEQ; } else { pos = (r - TL) % CTXL; len = CTXL; }
#pragma unroll 1
        for (int j = 0; j < 8; ++j) { const int c = lane + 64 * j;
            float a = cw[512 + c] * pr[C_CC + c] * pr[C_CX + c];
            if (pos > 0) a += cw[c] * pr[C_CC + c - INWP] * pr[C_CX + c - INWP];
            if (pos < len - 1) a += cw[1024 + c] * pr[C_CC + c + INWP] * pr[C_CX + c + INWP];
            MIX[(size_t)r * DM + c] = (bf16_t)f2bf(pr[C_CB + c] * a); }
        {
            const int half = lane >> 5, i = lane & 31;
            float sn = 0.f, cs = 1.f;
            if (r < TL) { const float invf = powf(10000.0f, -(float)i / 32.0f); const float ang = (float)(half ? (pos % 64) : (pos / 64)) * invf; sincosf(ang, &sn, &cs); }
#pragma unroll 2
            for (int h = 0; h < 8; ++h) { const float* q = pr + C_SQ + h * 128 + half * 64; const float x1 = q[i], x2 = q[32 + i];
                bf16_t* o = QR + (size_t)r * 1024 + h * 128 + half * 64;
                o[i] = (bf16_t)f2bf((x1 * cs - x2 * sn) * 0.08838834764831845f); o[32 + i] = (bf16_t)f2bf((x2 * cs + x1 * sn) * 0.08838834764831845f); }
#pragma unroll
            for (int h = 0; h < 2; ++h) { const float* k = pr + C_SK + h * 128 + half * 64; const float x1 = k[i], x2 = k[32 + i];
                bf16_t* o = KR + (size_t)r * 256 + h * 128 + half * 64;
                o[i] = (bf16_t)f2bf(x1 * cs - x2 * sn); o[32 + i] = (bf16_t)f2bf(x2 * cs + x1 * sn); }
#pragma unroll
            for (int j = 0; j < 4; ++j) VR[(size_t)r * 256 + lane + 64 * j] = (bf16_t)f2bf(pr[C_SV + lane + 64 * j]);
        }
    }
}

constexpr int KP = 136, VP = 72;
constexpr int SWA_BUF = 64 * KP * 2 + 128 * VP * 2;
typedef short bf16x4 __attribute__((ext_vector_type(4)));
__device__ __forceinline__ void phase_mixers(const Params& p, int l, LAS unsigned char* lds, int tid, int lane, int wave, int bid, int G) {
    const bf16_t* QR = (const bf16_t*)(p.ws + WS_QR); const bf16_t* KR = (const bf16_t*)(p.ws + WS_KR); const bf16_t* VR = (const bf16_t*)(p.ws + WS_ALF);
    bf16_t* MIX = (bf16_t*)(p.ws + WS_MIX);
    const float* sinkp = p.in[I_SINK] + l * 8;
    const int fr = lane & 15, fq = lane >> 4, g = wave & 3, qh = wave >> 2;
    const int nItems = 512 + ((l < DEPTH - 1) ? 16 : 0);
    for (int it = bid; it < nItems; it += G) {
        int b, tile, hk, s0; size_t qrow0;
        if (it < 512) { b = it >> 8; tile = (it >> 1) & 127; hk = it & 1; s0 = 0; qrow0 = (size_t)b * SEQ + tile * 64; }
        else { const int c = it - 512; b = c >> 3; tile = (c >> 1) & 3; hk = c & 1; s0 = 5; qrow0 = (size_t)TL + b * CTXL + tile * 64; }
        const int n0 = tile * 64, hq = hk * 4 + g;
        bf16x8 qf[2][4];
#pragma unroll
        for (int qt = 0; qt < 2; ++qt)
#pragma unroll
            for (int ks = 0; ks < 4; ++ks) qf[qt][ks] = *(const bf16x8*)(QR + (qrow0 + qh * 32 + qt * 16 + fr) * 1024 + hq * 128 + ks * 32 + fq * 8);
        f32x4 O[2][8];
#pragma unroll
        for (int qt = 0; qt < 2; ++qt)
#pragma unroll
            for (int dt = 0; dt < 8; ++dt) O[qt][dt] = (f32x4){0.f, 0.f, 0.f, 0.f};
        float m[2], lsum[2];
        m[0] = m[1] = sinkp[hq]; lsum[0] = lsum[1] = (fq == 0) ? 1.f : 0.f;
        u32x4 kreg[2], vreg[2];
#define SWA_ROW(s, kk) ((s) < 5 ? (size_t)b * SEQ + (size_t)min(max(n0 - 128 + (s) * 64 + (kk), 0), SEQ - 1) : (size_t)TL + (size_t)b * CTXL + ((s) - 5) * 64 + (kk))
#define SWA_LOAD(s) do { _Pragma("unroll") for (int j = 0; j < 2; ++j) { const int v = tid + NTHREADS * j; \
            kreg[j] = *(const u32x4*)(KR + SWA_ROW(s, v >> 4) * 256 + hk * 128 + (v & 15) * 8); \
            vreg[j] = *(const u32x4*)(VR + SWA_ROW(s, tid & 63) * 256 + hk * 128 + ((tid >> 6) + 8 * j) * 8); } } while (0)
#define SWA_WRITE(buf) do { LAS bf16_t* Kd = (LAS bf16_t*)(lds + (buf) * SWA_BUF); LAS bf16_t* Vd = Kd + 64 * KP; \
            _Pragma("unroll") for (int j = 0; j < 2; ++j) { const int v = tid + NTHREADS * j; *(LAS u32x4*)(Kd + (v >> 4) * KP + (v & 15) * 8) = kreg[j]; \
                const int d0 = ((tid >> 6) + 8 * j) * 8, key = tid & 63; const u32x4 w = vreg[j]; \
                Vd[(d0 + 0) * VP + key] = (bf16_t)(w.x & 0xffffu); Vd[(d0 + 1) * VP + key] = (bf16_t)(w.x >> 16); Vd[(d0 + 2) * VP + key] = (bf16_t)(w.y & 0xffffu); Vd[(d0 + 3) * VP + key] = (bf16_t)(w.y >> 16); \
                Vd[(d0 + 4) * VP + key] = (bf16_t)(w.z & 0xffffu); Vd[(d0 + 5) * VP + key] = (bf16_t)(w.z >> 16); Vd[(d0 + 6) * VP + key] = (bf16_t)(w.w & 0xffffu); Vd[(d0 + 7) * VP + key] = (bf16_t)(w.w >> 16); } } while (0)
        SWA_LOAD(s0); SWA_WRITE(0);
        __syncthreads();
#pragma unroll 1
        for (int s = s0; s < 9; ++s) {
            const int buf = (s - s0) & 1;
            if (s + 1 < 9) SWA_LOAD(s + 1);
            const LAS bf16_t* Ks = (const LAS bf16_t*)(lds + buf * SWA_BUF); const LAS bf16_t* Vs = Ks + 64 * KP;
#pragma unroll 1
            for (int sc = 0; sc < 2; ++sc) {
                f32x4 sT[2][2];
#pragma unroll
                for (int qt = 0; qt < 2; ++qt) { sT[qt][0] = (f32x4){0.f, 0.f, 0.f, 0.f}; sT[qt][1] = (f32x4){0.f, 0.f, 0.f, 0.f}; }
#pragma unroll
                for (int ks = 0; ks < 4; ++ks)
#pragma unroll
                    for (int kt = 0; kt < 2; ++kt) { const bf16x8 ka = *(const LAS bf16x8*)(Ks + (sc * 32 + kt * 16 + fr) * KP + ks * 32 + fq * 8);
#pragma unroll
                        for (int qt = 0; qt < 2; ++qt) sT[qt][kt] = __builtin_amdgcn_mfma_f32_16x16x32_bf16(ka, qf[qt][ks], sT[qt][kt], 0, 0, 0); }
                bf16x8 pb[2];
#pragma unroll
                for (int qt = 0; qt < 2; ++qt) {
                    if (s < 5) {
                        const int qpos = n0 + qh * 32 + qt * 16 + fr;
#pragma unroll
                        for (int kt = 0; kt < 2; ++kt)
#pragma unroll
                            for (int e = 0; e < 4; ++e) { const int kpos = n0 - 128 + s * 64 + sc * 32 + kt * 16 + fq * 4 + e; const int dlt = qpos - kpos;
                                const bool ok = kpos >= 0 && kpos < SEQ && dlt <= 128 && dlt >= -128; sT[qt][kt][e] = ok ? sT[qt][kt][e] : -1e30f; } }
                    float cm = fmaxf(fmaxf(fmaxf(sT[qt][0][0], sT[qt][0][1]), fmaxf(sT[qt][0][2], sT[qt][0][3])), fmaxf(fmaxf(sT[qt][1][0], sT[qt][1][1]), fmaxf(sT[qt][1][2], sT[qt][1][3])));
                    cm = fmaxf(cm, __shfl_xor(cm, 16)); cm = fmaxf(cm, __shfl_xor(cm, 32));
                    const float mn = fmaxf(m[qt], cm), scl = __expf(m[qt] - mn); m[qt] = mn;
                    float pe[8]; float ps = 0.f;
#pragma unroll
                    for (int kt = 0; kt < 2; ++kt)
#pragma unroll
                        for (int e = 0; e < 4; ++e) { pe[kt * 4 + e] = __expf(sT[qt][kt][e] - mn); ps += pe[kt * 4 + e]; }
                    lsum[qt] = lsum[qt] * scl + ps;
#pragma unroll
                    for (int dt = 0; dt < 8; ++dt) O[qt][dt] = O[qt][dt] * scl;
                    u32x4 pw; pw.x = pk2(pe[0], pe[1]); pw.y = pk2(pe[2], pe[3]); pw.z = pk2(pe[4], pe[5]); pw.w = pk2(pe[6], pe[7]);
                    pb[qt] = __builtin_bit_cast(bf16x8, pw);
                }
#pragma unroll
                for (int dt = 0; dt < 8; ++dt) {
                    const bf16x4 v0 = *(const LAS bf16x4*)(Vs + (dt * 16 + fr) * VP + sc * 32 + 4 * fq), v1 = *(const LAS bf16x4*)(Vs + (dt * 16 + fr) * VP + sc * 32 + 16 + 4 * fq);
                    const bf16x8 va = __builtin_shufflevector(v0, v1, 0, 1, 2, 3, 4, 5, 6, 7);
#pragma unroll
                    for (int qt = 0; qt < 2; ++qt) O[qt][dt] = __builtin_amdgcn_mfma_f32_16x16x32_bf16(va, pb[qt], O[qt][dt], 0, 0, 0);
                }
            }
            if (s + 1 < 9) SWA_WRITE(buf ^ 1);
            __syncthreads();
        }
#undef SWA_ROW
#undef SWA_LOAD
#undef SWA_WRITE
#pragma unroll
        for (int qt = 0; qt < 2; ++qt) {
            float lt = lsum[qt]; lt += __shfl_xor(lt, 16); lt += __shfl_xor(lt, 32);
            const float inv = 1.0f / lt;
            bf16_t* o = MIX + (qrow0 + qh * 32 + qt * 16 + fr) * DM + 1024 + hq * 128 + fq * 4;
#pragma unroll
            for (int dt = 0; dt < 8; ++dt) { u32x2 w; w.x = pk2(O[qt][dt][0] * inv, O[qt][dt][1] * inv); w.y = pk2(O[qt][dt][2] * inv, O[qt][dt][3] * inv); *(u32x2*)(o + dt * 16) = w; }
        }
    }
}

__device__ __forceinline__ int chunk_row0(int cid) { return cid < 256 ? (cid >> 7) * SEQ + (cid & 127) * 64 : TL + ((cid - 256) >> 2) * CTXL + ((cid - 256) & 3) * 64; }
constexpr int GP = 72;

__device__ __forceinline__ void gla_g1(const Params& p, int l, LAS unsigned char* lds, int tid, int lane, int wave, int bid, int G) {
    LAS float* Bf = (LAS float*)lds; LAS float* Bb = Bf + 4096;
    LAS bf16_t* KTf = (LAS bf16_t*)(lds + 32768); LAS bf16_t* KTb = KTf + 64 * GP;
    LAS bf16_t* VT = KTb + 64 * GP;
    const float* P = (const float*)(p.ws + WS_P);
    float* BF = (float*)(p.ws + WS_OF); float* BB = (float*)(p.ws + WS_OB);
    float* DELTA = (float*)(p.ws + WS_DELTA); float* DEC = (float*)(p.ws + WS_DEC);
    const float* w2 = p.in[I_GW2] + (size_t)l * 2 * 16 * 256; const float* b2 = p.in[I_GB2] + (size_t)l * 2 * 256;
    const int fr = lane & 15, fq = lane >> 4;
    for (int item = bid; item < GLA_ITEMS; item += G) {
        const int cid = item >> 2, h = item & 3, row0 = chunk_row0(cid);
#pragma unroll 1
        for (int j = 0; j < 16; ++j) { const int e = tid + NTHREADS * j, dir = e >> 12, i = (e >> 6) & 63, k = e & 63;
            const float* lr = P + (size_t)(row0 + i) * INWP + (dir ? C_LRB : C_LRF);
            float z = b2[dir * 256 + h * 64 + k];
#pragma unroll
            for (int q = 0; q < 16; ++q) z += lr[q] * w2[(dir * 16 + q) * 256 + h * 64 + k];
            (dir ? Bb : Bf)[i * 64 + k] = log_sigmoid_f(z) * (1.0f / 16.0f); }
        __syncthreads();
        if (tid < 128) { const int dir = tid >> 6, k = tid & 63; LAS float* Bl = dir ? Bb : Bf; float* BG = (dir ? BB : BF) + (size_t)row0 * 256 + h * 64 + k; float a = 0.f;
            if (dir == 0) { for (int i = 0; i < 64; ++i) { a += Bl[i * 64 + k]; Bl[i * 64 + k] = a; BG[(size_t)i * 256] = a; } }
            else { for (int i = 63; i >= 0; --i) { a += Bl[i * 64 + k]; Bl[i * 64 + k] = a; BG[(size_t)i * 256] = a; } } }
        __syncthreads();
#pragma unroll 1
        for (int j = 0; j < 8; ++j) { const int e = tid + NTHREADS * j, i = e >> 6, k = e & 63;
            const float kv = P[(size_t)(row0 + i) * INWP + C_GK + h * 64 + k];
            KTf[k * GP + i] = (bf16_t)f2bf(kv * expf(Bf[63 * 64 + k] - Bf[i * 64 + k]));
            KTb[k * GP + i] = (bf16_t)f2bf(kv * expf(Bb[k] - Bb[i * 64 + k])); }
#pragma unroll 1
        for (int j = 0; j < 16; ++j) { const int e = tid + NTHREADS * j, i = e >> 7, v = e & 127;
            VT[v * GP + i] = (bf16_t)f2bf(P[(size_t)(row0 + i) * INWP + C_GV + h * 128 + v]); }
        if (tid < 128) { const int dir = tid >> 6, k = tid & 63; DEC[((size_t)item * 2 + dir) * 64 + k] = expf(dir ? Bb[k] : Bf[63 * 64 + k]); }
        __syncthreads();
        { const int dir = wave >> 2, vq = wave & 3; const LAS bf16_t* KT = dir ? KTb : KTf;
            f32x4 acc[2][4];
#pragma unroll
            for (int a = 0; a < 2; ++a)
#pragma unroll
                for (int b = 0; b < 4; ++b) acc[a][b] = (f32x4){0.f, 0.f, 0.f, 0.f};
#pragma unroll
            for (int ks = 0; ks < 2; ++ks) { bf16x8 af[2], bfr[4];
#pragma unroll
                for (int a = 0; a < 2; ++a) af[a] = *(const LAS bf16x8*)(VT + ((vq * 2 + a) * 16 + fr) * GP + ks * 32 + fq * 8);
#pragma unroll
                for (int b = 0; b < 4; ++b) bfr[b] = *(const LAS bf16x8*)(KT + (b * 16 + fr) * GP + ks * 32 + fq * 8);
#pragma unroll
                for (int a = 0; a < 2; ++a)
#pragma unroll
                    for (int b = 0; b < 4; ++b) acc[a][b] = __builtin_amdgcn_mfma_f32_16x16x32_bf16(af[a], bfr[b], acc[a][b], 0, 0, 0); }
            float* dst = DELTA + ((size_t)item * 2 + dir) * 8192;
#pragma unroll
            for (int a = 0; a < 2; ++a)
#pragma unroll
                for (int b = 0; b < 4; ++b)
#pragma unroll
                    for (int g = 0; g < 4; ++g) dst[((vq * 2 + a) * 16 + fq * 4 + g) * 64 + b * 16 + fr] = acc[a][b][g]; }
        __syncthreads();
    }
}

__device__ __forceinline__ void gla_g2(const Params& p, int tid, int bid, int G) {
    const float* DELTA = (const float*)(p.ws + WS_DELTA); const float* DEC = (const float*)(p.ws + WS_DEC); bf16_t* SST = (bf16_t*)(p.ws + WS_SST);
    for (int u = bid; u < 64; u += G) {
        const int s = u >> 2, dir = s >> 3, b = (s >> 2) & 1, h = s & 3, off = ((u & 3) * NTHREADS + tid) * 4, k0 = off & 63;
        f32x4 S = (f32x4){0.f, 0.f, 0.f, 0.f};
#pragma unroll 1
        for (int st = 0; st < 132; st += 4) {
            f32x4 d[4], dc[4]; size_t base[4];
#pragma unroll
            for (int q = 0; q < 4; ++q) { const int t = st + q;
                const int cid = t < 4 ? 256 + b * 4 + (dir ? 3 - t : t) : b * 128 + (dir ? 127 - (t - 4) : (t - 4));
                const size_t it2 = (size_t)(cid * 4 + h) * 2 + dir; base[q] = it2 * 8192 + off;
                d[q] = *(const f32x4*)(DELTA + base[q]); dc[q] = *(const f32x4*)(DEC + it2 * 64 + k0); }
#pragma unroll
            for (int q = 0; q < 4; ++q) { u32x2 o; o.x = pk2(S.x, S.y); o.y = pk2(S.z, S.w); *(u32x2*)(SST + base[q]) = o; S = dc[q] * S + d[q]; }
        }
    }
}

__device__ __forceinline__ void gla_g3(const Params& p, int l, LAS unsigned char* lds, int tid, int lane, int wave, int bid, int G) {
    LAS bf16_t* QEf = (LAS bf16_t*)lds; LAS bf16_t* QEb = QEf + 64 * GP; LAS bf16_t* KEf = QEb + 64 * GP; LAS bf16_t* KEb = KEf + 64 * GP;
    LAS bf16_t* VT = KEb + 64 * GP;
    LAS bf16_t* ATT = VT + 128 * GP + wave * (16 * GP);
    LAS float* RS = (LAS float*)(lds + 2 * (4 * 64 * GP + 128 * GP + 8 * 16 * GP));
    const float* P = (const float*)(p.ws + WS_P);
    const float* BF = (const float*)(p.ws + WS_OF); const float* BB = (const float*)(p.ws + WS_OB);
    const bf16_t* SST = (const bf16_t*)(p.ws + WS_SST); bf16_t* MIX = (bf16_t*)(p.ws + WS_MIX);
    const float* nw = p.in[I_GNORM] + l * 128;
    const int fr = lane & 15, fq = lane >> 4, it = wave >> 1, vh = wave & 1;
    for (int item = bid; item < GLA_ITEMS; item += G) {
        const int cid = item >> 2, h = item & 3, row0 = chunk_row0(cid);
#pragma unroll 1
        for (int j = 0; j < 8; ++j) { const int e = tid + NTHREADS * j, i = e >> 6, k = e & 63;
            const size_t r = (size_t)(row0 + i);
            const float bf = BF[r * 256 + h * 64 + k], bb = BB[r * 256 + h * 64 + k];
            const float q = P[r * INWP + C_GQ + h * 64 + k] * 0.125f, kk = P[r * INWP + C_GK + h * 64 + k];
            QEf[i * GP + k] = (bf16_t)f2bf(q * expf(bf)); KEf[i * GP + k] = (bf16_t)f2bf(kk * expf(-bf));
            QEb[i * GP + k] = (bf16_t)f2bf(q * expf(bb)); KEb[i * GP + k] = (bf16_t)f2bf(kk * expf(-bb)); }
#pragma unroll 1
        for (int j = 0; j < 16; ++j) { const int e = tid + NTHREADS * j, i = e >> 7, v = e & 127;
            VT[v * GP + i] = (bf16_t)f2bf(P[(size_t)(row0 + i) * INWP + C_GV + h * 128 + v]); }
        __syncthreads();
        f32x4 acc[4];
#pragma unroll
        for (int vt = 0; vt < 4; ++vt) acc[vt] = (f32x4){0.f, 0.f, 0.f, 0.f};
#pragma unroll
        for (int dir = 0; dir < 2; ++dir) {
            const LAS bf16_t* QE = dir ? QEb : QEf; const LAS bf16_t* KE = dir ? KEb : KEf;
            bf16x8 qa[2];
#pragma unroll
            for (int ks = 0; ks < 2; ++ks) qa[ks] = *(const LAS bf16x8*)(QE + (it * 16 + fr) * GP + ks * 32 + fq * 8);
#pragma unroll
            for (int jt = 0; jt < 4; ++jt) { f32x4 a = (f32x4){0.f, 0.f, 0.f, 0.f};
#pragma unroll
                for (int ks = 0; ks < 2; ++ks) { const bf16x8 kb = *(const LAS bf16x8*)(KE + (jt * 16 + fr) * GP + ks * 32 + fq * 8); a = __builtin_amdgcn_mfma_f32_16x16x32_bf16(qa[ks], kb, a, 0, 0, 0); }
#pragma unroll
                for (int g = 0; g < 4; ++g) { const int ii = it * 16 + fq * 4 + g, jj = jt * 16 + fr; const bool keep = dir ? (jj >= ii) : (jj <= ii);
                    ATT[(fq * 4 + g) * GP + jt * 16 + fr] = (bf16_t)f2bf(keep ? a[g] : 0.f); } }
            LDS_FENCE();
            const bf16_t* Sg = SST + ((size_t)item * 2 + dir) * 8192;
#pragma unroll
            for (int ks = 0; ks < 2; ++ks) { const bf16x8 aa = *(const LAS bf16x8*)(ATT + fr * GP + ks * 32 + fq * 8);
#pragma unroll
                for (int vt = 0; vt < 4; ++vt) { const int v = (vh * 4 + vt) * 16 + fr;
                    const bf16x8 vb = *(const LAS bf16x8*)(VT + v * GP + ks * 32 + fq * 8);
                    acc[vt] = __builtin_amdgcn_mfma_f32_16x16x32_bf16(aa, vb, acc[vt], 0, 0, 0);
                    const bf16x8 sb = *(const bf16x8*)(Sg + v * 64 + ks * 32 + fq * 8);
                    acc[vt] = __builtin_amdgcn_mfma_f32_16x16x32_bf16(qa[ks], sb, acc[vt], 0, 0, 0); } }
            LDS_FENCE();
        }
        float ss[4];
#pragma unroll
        for (int g = 0; g < 4; ++g) { float t = 0.f;
#pragma unroll
            for (int vt = 0; vt < 4; ++vt) t += acc[vt][g] * acc[vt][g];
            t += __shfl_xor(t, 1); t += __shfl_xor(t, 2); t += __shfl_xor(t, 4); t += __shfl_xor(t, 8); ss[g] = t; }
        if (fr == 0) {
#pragma unroll
            for (int g = 0; g < 4; ++g) RS[(it * 16 + fq * 4 + g) * 2 + vh] = ss[g]; }
        __syncthreads();
#pragma unroll
        for (int g = 0; g < 4; ++g) { const int i = it * 16 + fq * 4 + g; const float tot = RS[i * 2] + RS[i * 2 + 1];
            const float rs = 1.0f / sqrtf(tot * (1.0f / 128.0f) + LN_EPS); const size_t r = (size_t)(row0 + i);
#pragma unroll
            for (int vt = 0; vt < 4; ++vt) { const int v = (vh * 4 + vt) * 16 + fr; const float gt = P[r * INWP + C_GG + h * 128 + v];
                MIX[r * DM + 512 + h * 128 + v] = (bf16_t)f2bf(acc[vt][g] * rs * nw[v] * silu_f(gt)); } }
        __syncthreads();
    }
}

__device__ __forceinline__ void ln_row(f32x4 (&v)[8], const float* lg, const float* lb, int lane) {
    float s = 0.f;
#pragma unroll
    for (int j = 0; j < 8; ++j) s += (v[j].x + v[j].y) + (v[j].z + v[j].w);
    const float mean = wave_sum(s) * (1.0f / DM);
    float s2 = 0.f;
#pragma unroll
    for (int j = 0; j < 8; ++j) { v[j] = v[j] - mean; s2 += (v[j].x * v[j].x + v[j].y * v[j].y) + (v[j].z * v[j].z + v[j].w * v[j].w); }
    const float rstd = 1.0f / sqrtf(wave_sum(s2) * (1.0f / DM) + LN_EPS);
#pragma unroll
    for (int j = 0; j < 8; ++j) { const int c = lane * 4 + 256 * j; const f32x4 g = *(const f32x4*)(lg + c), b = *(const f32x4*)(lb + c); v[j] = v[j] * rstd * g + b; }
}

__device__ __forceinline__ void phase_ln1(const Params& p, int l, int lane, int wave, int bid, int G) {
    const int gw = bid * NWAVES + wave, NGW = G * NWAVES;
    const float* MOD = (const float*)(p.ws + WS_MOD); const float* Y = (const float*)(p.ws + WS_Y);
    float* XL = (float*)(p.ws + WS_XL); bf16_t* HB = (bf16_t*)(p.ws + WS_HB);
    const float* lg = p.in[I_LNG] + (size_t)(l * 2 + 0) * DM; const float* lb = p.in[I_LNB] + (size_t)(l * 2 + 0) * DM;
    for (int r = gw; r < TA; r += NGW) {
        const float* mod = MOD + (size_t)(l * 3 + row_stream(r)) * 6 * DM;
        const float* xr = xsrc(p, l, r);
        f32x4 v[8];
#pragma unroll
        for (int j = 0; j < 8; ++j) { const int c = lane * 4 + 256 * j; const f32x4 x = *(const f32x4*)(xr + c), y = *(const f32x4*)(Y + (size_t)r * DM + c), g = *(const f32x4*)(mod + 2 * DM + c); v[j] = x * DN_ALPHA + g * y; }
        ln_row(v, lg, lb, lane);
#pragma unroll
        for (int j = 0; j < 8; ++j) { const int c = lane * 4 + 256 * j; *(f32x4*)(XL + (size_t)r * DM + c) = v[j];
            const f32x4 sh = *(const f32x4*)(mod + 3 * DM + c), s = *(const f32x4*)(mod + 4 * DM + c);
            u32x2 o; o.x = pk2(v[j].x * (1.f + s.x) + sh.x, v[j].y * (1.f + s.y) + sh.y); o.y = pk2(v[j].z * (1.f + s.z) + sh.z, v[j].w * (1.f + s.w) + sh.w);
            *(u32x2*)(HB + (size_t)r * DM + c) = o; }
    }
}

constexpr int SKP = 136;
__device__ __forceinline__ void group16_argmax(float& m, int& idx) {
#pragma unroll
    for (int o = 1; o < 16; o <<= 1) { const float om = __shfl_xor(m, o); const int oi = __shfl_xor(idx, o); if (om > m || (om == m && oi < idx)) { m = om; idx = oi; } }
}
__device__ __forceinline__ void peer_retrieve(const Params& p, int l, LAS unsigned char* lds, int tid, int lane, int wave, int bid, int G, int ntok) {
    LAS bf16_t* SK = (LAS bf16_t*)lds;
    const bf16_t* SUBB = (const bf16_t*)(p.ws + WS_SUBB) + (size_t)l * 2 * 128 * 128;
#pragma unroll 1
    for (int j = 0; j < 8; ++j) { const int vv = tid + NTHREADS * j, row = vv >> 4, c = vv & 15; *(LAS u32x4*)(SK + row * SKP + c * 8) = *(const u32x4*)(SUBB + row * 128 + c * 8); }
    __syncthreads();
    const bf16_t* QP = (const bf16_t*)(p.ws + WS_QP);
    int* EIDX = (int*)(p.ws + WS_EIDX); float* EGATE = (float*)(p.ws + WS_EGATE);
    const int gw = bid * NWAVES + wave, NGW = G * NWAVES, fr = lane & 15, fq = lane >> 4, gbase = lane & 48;
    const int nitems = (ntok / 16) * 8;
    for (int item = gw; item < nitems; item += NGW) {
        const int tile = item >> 3, h = item & 7;
        float tvp[2][4]; int tip[2][4];
#pragma unroll
        for (int pp = 0; pp < 2; ++pp) {
            asm volatile("" ::: "memory"); __builtin_amdgcn_sched_barrier(0);
            f32x4 acc[8];
#pragma unroll
            for (int kt = 0; kt < 8; ++kt) acc[kt] = (f32x4){0.f, 0.f, 0.f, 0.f};
#pragma unroll
            for (int ks = 0; ks < 4; ++ks) { const bf16x8 a = *(const bf16x8*)(QP + (size_t)(tile * 16 + fr) * DM + h * 256 + pp * 128 + ks * 32 + fq * 8);
#pragma unroll
                for (int kt = 0; kt < 8; ++kt) { const bf16x8 bb = *(const LAS bf16x8*)(SK + (pp * 128 + kt * 16 + fr) * SKP + ks * 32 + fq * 8); acc[kt] = __builtin_amdgcn_mfma_f32_16x16x32_bf16(a, bb, acc[kt], 0, 0, 0); } }
#pragma unroll
            for (int g = 0; g < 4; ++g) {
                float v[8];
#pragma unroll
                for (int kt = 0; kt < 8; ++kt) v[kt] = acc[kt][g];
                float tv = 0.f; int ti = 0;
#pragma unroll 1
                for (int it = 0; it < 16; ++it) {
                    float m = v[0]; int mi = 0;
#pragma unroll
                    for (int kt = 1; kt < 8; ++kt) if (v[kt] > m) { m = v[kt]; mi = kt; }
                    int idx = mi * 16 + fr;
                    group16_argmax(m, idx);
                    if (fr == it) { tv = m; ti = idx; }
                    const int wk = (idx & 15) == fr ? (idx >> 4) : -1;
#pragma unroll
                    for (int kt = 0; kt < 8; ++kt) if (kt == wk) v[kt] = -INFINITY;
                }
                tvp[pp][g] = tv; tip[pp][g] = ti;
            }
        }
#pragma unroll
        for (int g = 0; g < 4; ++g) {
            const float a = tvp[0][g], b = tvp[1][g];
            int ptr = 0; float bv = 0.f; int bc = 0;
#pragma unroll 1
            for (int it = 0; it < 16; ++it) {
                const float bj = __shfl(b, gbase + (ptr & 15));
                float m = ptr < 16 ? a + bj : -INFINITY; int idx = fr * 16 + (ptr & 15);
                group16_argmax(m, idx);
                if (fr == it) { bv = m; bc = idx; }
                if ((idx >> 4) == fr) ++ptr;
            }
            const int i1 = __shfl(tip[0][g], gbase + (bc >> 4)), i2 = __shfl(tip[1][g], gbase + (bc & 15));
            const float mx = __shfl(bv, gbase);
            const float ex = expf(bv - mx);
            float sm = ex;
#pragma unroll
            for (int o = 1; o < 16; o <<= 1) sm += __shfl_xor(sm, o);
            const size_t tok = (size_t)tile * 16 + fq * 4 + g;
            EIDX[tok * 128 + h * 16 + fr] = i1 * 128 + i2; EGATE[tok * 128 + h * 16 + fr] = ex / sm;
        }
    }
}

__device__ __forceinline__ float bflo(unsigned w) { return __builtin_bit_cast(float, w << 16); }
__device__ __forceinline__ float bfhi(unsigned w) { return __builtin_bit_cast(float, w & 0xffff0000u); }
__device__ __forceinline__ void phase_peer(const Params& p, int l, int lane, int wave, int bid, int G) {
    const int gw = bid * NWAVES + wave, NGW = G * NWAVES;
    const float* MOD = (const float*)(p.ws + WS_MOD);
    float* XL = (float*)(p.ws + WS_XL); bf16_t* HB = (bf16_t*)(p.ws + WS_HB);
    const float* lg = p.in[I_LNG] + (size_t)(l * 2 + 1) * DM; const float* lb = p.in[I_LNB] + (size_t)(l * 2 + 1) * DM;
    const bf16_t* UB = (const bf16_t*)(p.ws + WS_UB) + (size_t)l * NEXP * DM; const bf16_t* VB = (const bf16_t*)(p.ws + WS_VB) + (size_t)l * NEXP * DM;
    const int* EIDX = (const int*)(p.ws + WS_EIDX); const float* EGATE = (const float*)(p.ws + WS_EGATE);
    const bool last = (l == DEPTH - 1);
    const int nrows = last ? TL : TA;
    for (int r = gw; r < nrows; r += NGW) {
        const float* mod = MOD + (size_t)(l * 3 + row_stream(r)) * 6 * DM;
        float hf[4][8];
#pragma unroll
        for (int q = 0; q < 4; ++q) { const u32x4 w = *(const u32x4*)(HB + (size_t)r * DM + q * 512 + lane * 8);
            hf[q][0] = bflo(w.x); hf[q][1] = bfhi(w.x); hf[q][2] = bflo(w.y); hf[q][3] = bfhi(w.y); hf[q][4] = bflo(w.z); hf[q][5] = bfhi(w.z); hf[q][6] = bflo(w.w); hf[q][7] = bfhi(w.w); }
        const int e0 = EIDX[(size_t)r * 128 + lane], e1 = EIDX[(size_t)r * 128 + 64 + lane];
        const float g0 = EGATE[(size_t)r * 128 + lane], g1 = EGATE[(size_t)r * 128 + 64 + lane];
        float w0 = 0.f, w1 = 0.f;
#pragma unroll 1
        for (int j0 = 0; j0 < 128; j0 += 4) {
            u32x4 ur[4][4];
#pragma unroll
            for (int c = 0; c < 4; ++c) { const int j = j0 + c; const int e = j < 64 ? __builtin_amdgcn_readlane(e0, j) : __builtin_amdgcn_readlane(e1, j - 64);
                const bf16_t* up = UB + (size_t)e * DM + lane * 8;
#pragma unroll
                for (int q = 0; q < 4; ++q) ur[c][q] = *(const u32x4*)(up + q * 512); }
            float d[4];
#pragma unroll
            for (int c = 0; c < 4; ++c) { float a = 0.f;
#pragma unroll
                for (int q = 0; q < 4; ++q) { const u32x4 w = ur[c][q];
                    a += bflo(w.x) * hf[q][0]; a += bfhi(w.x) * hf[q][1]; a += bflo(w.y) * hf[q][2]; a += bfhi(w.y) * hf[q][3];
                    a += bflo(w.z) * hf[q][4]; a += bfhi(w.z) * hf[q][5]; a += bflo(w.w) * hf[q][6]; a += bfhi(w.w) * hf[q][7]; }
                d[c] = a; }
#pragma unroll
            for (int o = 1; o < 64; o <<= 1) {
#pragma unroll
                for (int c = 0; c < 4; ++c) d[c] += __shfl_xor(d[c], o); }
#pragma unroll
            for (int c = 0; c < 4; ++c) { const int j = j0 + c; const float act = gelu_f(d[c]);
                if (j < 64) { if (lane == j) w0 = act * g0; } else { if (lane == j - 64) w1 = act * g1; } }
        }
        float yv[4][8];
#pragma unroll
        for (int q = 0; q < 4; ++q)
#pragma unroll
            for (int i = 0; i < 8; ++i) yv[q][i] = 0.f;
#pragma unroll 1
        for (int j0 = 0; j0 < 128; j0 += 4) {
            u32x4 vr[4][4]; float wj[4];
#pragma unroll
            for (int c = 0; c < 4; ++c) { const int j = j0 + c; const int e = j < 64 ? __builtin_amdgcn_readlane(e0, j) : __builtin_amdgcn_readlane(e1, j - 64);
                wj[c] = __builtin_bit_cast(float, j < 64 ? __builtin_amdgcn_readlane(__builtin_bit_cast(int, w0), j) : __builtin_amdgcn_readlane(__builtin_bit_cast(int, w1), j - 64));
                const bf16_t* vp = VB + (size_t)e * DM + lane * 8;
#pragma unroll
                for (int q = 0; q < 4; ++q) vr[c][q] = *(const u32x4*)(vp + q * 512); }
#pragma unroll
            for (int c = 0; c < 4; ++c)
#pragma unroll
                for (int q = 0; q < 4; ++q) { const u32x4 w = vr[c][q];
                    yv[q][0] += wj[c] * bflo(w.x); yv[q][1] += wj[c] * bfhi(w.x); yv[q][2] += wj[c] * bflo(w.y); yv[q][3] += wj[c] * bfhi(w.y);
                    yv[q][4] += wj[c] * bflo(w.z); yv[q][5] += wj[c] * bfhi(w.z); yv[q][6] += wj[c] * bflo(w.w); yv[q][7] += wj[c] * bfhi(w.w); }
        }
        const float* xr = XL + (size_t)r * DM;
        float s = 0.f;
#pragma unroll
        for (int q = 0; q < 4; ++q) { const int c = q * 512 + lane * 8;
            const f32x4 x0 = *(const f32x4*)(xr + c), x1 = *(const f32x4*)(xr + c + 4), ga = *(const f32x4*)(mod + 5 * DM + c), gb = *(const f32x4*)(mod + 5 * DM + c + 4);
            yv[q][0] = x0.x * DN_ALPHA + ga.x * yv[q][0]; yv[q][1] = x0.y * DN_ALPHA + ga.y * yv[q][1]; yv[q][2] = x0.z * DN_ALPHA + ga.z * yv[q][2]; yv[q][3] = x0.w * DN_ALPHA + ga.w * yv[q][3];
            yv[q][4] = x1.x * DN_ALPHA + gb.x * yv[q][4]; yv[q][5] = x1.y * DN_ALPHA + gb.y * yv[q][5]; yv[q][6] = x1.z * DN_ALPHA + gb.z * yv[q][6]; yv[q][7] = x1.w * DN_ALPHA + gb.w * yv[q][7];
#pragma unroll
            for (int i = 0; i < 8; ++i) s += yv[q][i]; }
        const float mean = wave_sum(s) * (1.0f / DM);
        float s2 = 0.f;
#pragma unroll
        for (int q = 0; q < 4; ++q)
#pragma unroll
            for (int i = 0; i < 8; ++i) { yv[q][i] -= mean; s2 += yv[q][i] * yv[q][i]; }
        const float rstd = 1.0f / sqrtf(wave_sum(s2) * (1.0f / DM) + LN_EPS);
        float* dst = (last ? p.out : XL) + (size_t)r * DM;
        const float* modn = MOD + (size_t)((last ? l : l + 1) * 3 + row_stream(r)) * 6 * DM;
#pragma unroll
        for (int q = 0; q < 4; ++q) { const int c = q * 512 + lane * 8;
            const f32x4 ga = *(const f32x4*)(lg + c), gb = *(const f32x4*)(lg + c + 4), ba = *(const f32x4*)(lb + c), bb = *(const f32x4*)(lb + c + 4);
            f32x4 o0, o1;
            o0.x = yv[q][0] * rstd * ga.x + ba.x; o0.y = yv[q][1] * rstd * ga.y + ba.y; o0.z = yv[q][2] * rstd * ga.z + ba.z; o0.w = yv[q][3] * rstd * ga.w + ba.w;
            o1.x = yv[q][4] * rstd * gb.x + bb.x; o1.y = yv[q][5] * rstd * gb.y + bb.y; o1.z = yv[q][6] * rstd * gb.z + bb.z; o1.w = yv[q][7] * rstd * gb.w + bb.w;
            *(f32x4*)(dst + c) = o0; *(f32x4*)(dst + c + 4) = o1;
            if (!last) {
                const f32x4 sa = *(const f32x4*)(modn + c), sb = *(const f32x4*)(modn + c + 4), ca = *(const f32x4*)(modn + DM + c), cb = *(const f32x4*)(modn + DM + c + 4);
                u32x4 o; o.x = pk2(o0.x * (1.f + ca.x) + sa.x, o0.y * (1.f + ca.y) + sa.y); o.y = pk2(o0.z * (1.f + ca.z) + sa.z, o0.w * (1.f + ca.w) + sa.w);
                o.z = pk2(o1.x * (1.f + cb.x) + sb.x, o1.y * (1.f + cb.y) + sb.y); o.w = pk2(o1.z * (1.f + cb.z) + sb.z, o1.w * (1.f + cb.w) + sb.w);
                *(u32x4*)(HB + (size_t)r * DM + c) = o; }
        }
    }
}

__device__ __forceinline__ void gemm_rows(LAS unsigned char* lds, const bf16_t* A, const bf16_t* Bt, float* C, bool with_ctx, int G, int bid) {
    { pg8::Gemm g{A, Bt, TL, DM, DM}; pg8::StaticOrder S; S.init(TL, DM, G, bid); pg8::EpiF32 E{C, DM, nullptr};
      pg8::gemm_phase<pg8::EpiF32, pg8::StaticOrder, PG8_ALIGN, PG8_SP2>(lds, g, S, E); }
    if (with_ctx) { pg8::Gemm g{A + (size_t)TL * DM, Bt, TC, DM, DM}; pg8::StaticOrder S; S.init(TC, DM, G, bid); pg8::EpiF32 E{C + (size_t)TL * DM, DM, nullptr};
      pg8::gemm_phase<pg8::EpiF32, pg8::StaticOrder, PG8_ALIGN, PG8_SP2>(lds, g, S, E); }
}
__device__ __forceinline__ void gemm_rows_bf16(LAS unsigned char* lds, const bf16_t* A, const bf16_t* Bt, bf16_t* C, bool with_ctx, int G, int bid) {
    { pg8::Gemm g{A, Bt, TL, DM, DM}; pg8::StaticOrder S; S.init(TL, DM, G, bid); pg8::EpiBf16<0> E{C, DM, nullptr, 0, 0, 1.f};
      pg8::gemm_phase<pg8::EpiBf16<0>, pg8::StaticOrder, PG8_ALIGN, PG8_SP2>(lds, g, S, E); }
    if (with_ctx) { pg8::Gemm g{A + (size_t)TL * DM, Bt, TC, DM, DM}; pg8::StaticOrder S; S.init(TC, DM, G, bid); pg8::EpiBf16<0> E{C + (size_t)TL * DM, DM, nullptr, 0, 0, 1.f};
      pg8::gemm_phase<pg8::EpiBf16<0>, pg8::StaticOrder, PG8_ALIGN, PG8_SP2>(lds, g, S, E); }
}

constexpr int PH_PER_LAYER = 9, N_PHASES = 2 + DEPTH * PH_PER_LAYER;
__global__ void __launch_bounds__(NTHREADS, 2) fwd_kernel(Params p) {
    extern __shared__ __attribute__((aligned(16))) unsigned char lds_raw[];
    LAS unsigned char* lds = (LAS unsigned char*)lds_raw;
    const int tid = threadIdx.x, lane = tid & 63, wave = __builtin_amdgcn_readfirstlane(tid >> 6), bid = blockIdx.x, G = gridDim.x;
    volatile LAS unsigned* MISC = (volatile LAS unsigned*)(lds + MISC_OFF);
    if (tid < 32) MISC[tid] = 0u;
    __syncthreads();
    const int lo = p.ph_lo, hi = p.ph_hi;
    unsigned* ctl = (unsigned*)(p.ws + WS_CTL);
    XcdBarrier bar; bar.bar = ctl + CW_BAR; bar.x = 0; bar.st = MISC + 8;
    if (hi - lo > 1) bar = xcd_barrier_post(ctl + CW_BAR, MISC + 8);
#define IN(k) (lo <= (k) && (k) < hi)
#define SEAM(k) do { if (IN(k) && IN((k) + 1)) xcd_barrier(bar); } while (0)
    const int NGW = G * NWAVES;
#define FRESH() int tid_ = tid, lane_ = lane, wave_ = wave, bid_ = bid; asm volatile("" : "+v"(tid_), "+v"(lane_), "+s"(wave_), "+s"(bid_)); const int gw_ = bid_ * NWAVES + wave_; (void)tid_; (void)gw_
    if (IN(0)) { FRESH(); phase_prologue(p, lds, tid_, lane_, wave_, bid_, G); }
    SEAM(0);
    if (IN(1)) { FRESH(); phase_modulate0(p, lane_, wave_, bid_, G); }
    SEAM(1);
    for (int l = 0; l < DEPTH; ++l) {
        const int b0 = 2 + l * PH_PER_LAYER;
        if (IN(b0 + 0)) { FRESH();
            pg8::Gemm g{(const bf16_t*)(p.ws + WS_HB), (const bf16_t*)(p.ws + WS_WIN) + (size_t)l * INWP * DM, TA, INWP, DM}; pg8::StaticOrder S; S.init(TA, INWP, G, bid_);
            pg8::EpiF32 E{(float*)(p.ws + WS_P), INWP, nullptr};
            pg8::gemm_phase<pg8::EpiF32, pg8::StaticOrder, PG8_ALIGN, PG8_SP2>(lds, g, S, E); }
        SEAM(b0 + 0);
        if (IN(b0 + 1)) { { FRESH(); gla_g1(p, l, lds, tid_, lane_, wave_, bid_, G); } { FRESH(); phase_post_in(p, l, lane_, wave_, bid_, G); } }
        SEAM(b0 + 1);
        if (IN(b0 + 2)) { { FRESH(); gla_g2(p, tid_, bid_, G); } { FRESH(); phase_mixers(p, l, lds, tid_, lane_, wave_, bid_, G); } }
        SEAM(b0 + 2);
        if (IN(b0 + 3)) { FRESH(); gla_g3(p, l, lds, tid_, lane_, wave_, bid_, G); }
        SEAM(b0 + 3);
        if (IN(b0 + 4)) { FRESH();
            gemm_rows(lds, (const bf16_t*)(p.ws + WS_MIX), (const bf16_t*)(p.ws + WS_WOUT) + (size_t)l * DM * DM, (float*)(p.ws + WS_Y), l < DEPTH - 1, G, bid_); }
        SEAM(b0 + 4);
        if (IN(b0 + 5)) { FRESH(); phase_ln1(p, l, lane_, wave_, bid_, G); }
        SEAM(b0 + 5);
        if (IN(b0 + 6)) { FRESH();
            gemm_rows_bf16(lds, (const bf16_t*)(p.ws + WS_HB), (const bf16_t*)(p.ws + WS_WQ) + (size_t)l * DM * DM, (bf16_t*)(p.ws + WS_QP), l < DEPTH - 1, G, bid_); }
        SEAM(b0 + 6);
        if (IN(b0 + 7)) { FRESH(); peer_retrieve(p, l, lds, tid_, lane_, wave_, bid_, G, l < DEPTH - 1 ? TA : TL); }
        SEAM(b0 + 7);
        if (IN(b0 + 8)) { FRESH(); phase_peer(p, l, lane_, wave_, bid_, G); }
        SEAM(b0 + 8);
    }
#undef FRESH
#undef IN
#undef SEAM
}

#ifndef MK_PER_PHASE
#define MK_PER_PHASE 0
#endif
extern "C" void kernel_launch(void* const* d_in, const int* in_sizes, int n_in, void* d_out, int out_size, void* d_ws, size_t ws_size, hipStream_t stream) {
    static int grid = 0;
    if (grid == 0) {
        if (n_in != 19 || out_size != TL * DM || ws_size < WS_END) { fprintf(stderr, "kernel_launch: unexpected shapes (n_in %d out %d ws %zu)\n", n_in, out_size, ws_size); grid = -1; return; }
        int dev = 0, cus = 0;
        if (hipGetDevice(&dev) != hipSuccess || hipDeviceGetAttribute(&cus, hipDeviceAttributeMultiprocessorCount, dev) != hipSuccess) { grid = -1; return; }
        if (hipFuncSetAttribute((const void*)fwd_kernel, hipFuncAttributeMaxDynamicSharedMemorySize, LDS_BYTES) != hipSuccess) { fprintf(stderr, "kernel_launch: hipFuncSetAttribute failed\n"); grid = -1; return; }
        int per_cu = 0;
        (void)hipOccupancyMaxActiveBlocksPerMultiprocessor(&per_cu, (const void*)fwd_kernel, NTHREADS, LDS_BYTES);
        (void)hipGetLastError();
        if (per_cu < 1) fprintf(stderr, "kernel_launch: occupancy query reports %d blocks per CU\n", per_cu);
        grid = cus;
    }
    if (grid < 0) return;
    (void)hipMemsetAsync((char*)d_ws + WS_CTL, 0, CTL_ZERO_BYTES, stream);
    Params p{};
    for (int i = 0; i < 19; ++i) p.in[i] = (const float*)d_in[i];
    p.out = (float*)d_out; p.ws = (unsigned char*)d_ws;
#if MK_PER_PHASE
    for (int ph = 0; ph < N_PHASES; ++ph) { p.ph_lo = ph; p.ph_hi = ph + 1; hipLaunchKernelGGL(fwd_kernel, dim3(grid), dim3(NTHREADS), LDS_BYTES, stream, p); }
#else
    p.ph_lo = 0; p.ph_hi = N_PHASES;
    hipLaunchKernelGGL(fwd_kernel, dim3(grid), dim3(NTHREADS), LDS_BYTES, stream, p);
#endif
}
```

```cpp
#include <hip/hip_runtime.h>
#include <cstdio>
#include <cstdint>

#define LAS __attribute__((address_space(3)))
typedef unsigned short bf16_t;
typedef short bf16x8 __attribute__((ext_vector_type(8)));
typedef float f32x4 __attribute__((ext_vector_type(4)));
typedef unsigned u32x4 __attribute__((ext_vector_type(4)));
typedef unsigned u32x2 __attribute__((ext_vector_type(2)));

constexpr int DM = 2048, NBATCH = 2, SEQ = 8192, DEPTH = 4, CTXL = 256;
constexpr int TL = NBATCH * SEQ, TC = NBATCH * CTXL, TA = TL + TC;
constexpr int INW = 4640, INWP = 4864;
constexpr int C_CX = 0, C_CB = 512, C_CC = 1024, C_GQ = 1536, C_GK = 1792, C_GV = 2048, C_GG = 2560, C_LRF = 3072, C_LRB = 3088,
              C_SQ = 3104, C_SK = 4128, C_SV = 4384;
constexpr int NEXP = 16384;
constexpr float DN_ALPHA = 1.6817928305074290f;
constexpr float LN_EPS = 1e-6f;
constexpr int NWAVES = 8, NTHREADS = 512;

constexpr size_t MiB = 1u << 20;
constexpr size_t WS_CTL = 0, CTL_ZERO_BYTES = 2 * MiB;
constexpr size_t WS_MOD = 2 * MiB;
constexpr size_t WS_WIN = 4 * MiB;
constexpr size_t WS_WOUT = 80 * MiB;
constexpr size_t WS_WQ = 112 * MiB;
constexpr size_t WS_XL = 144 * MiB;
constexpr size_t WS_HB = 276 * MiB;
constexpr size_t WS_P = 342 * MiB;
constexpr size_t WS_QR = 656 * MiB;
constexpr size_t WS_KR = 720 * MiB;
constexpr size_t WS_ALF = 736 * MiB;
constexpr size_t WS_ALB = 753 * MiB;
constexpr size_t WS_OF = 770 * MiB;
constexpr size_t WS_OB = 803 * MiB;
constexpr size_t WS_MIX = 836 * MiB;
constexpr size_t WS_Y = 902 * MiB;
constexpr size_t WS_QP = 1034 * MiB;
constexpr size_t WS_DELTA = 1166 * MiB;
constexpr size_t WS_DEC = 1233 * MiB;
constexpr size_t WS_SST = 1234 * MiB;
constexpr size_t WS_UB = 1268 * MiB;
constexpr size_t WS_VB = 1524 * MiB;
constexpr size_t WS_EIDX = 1780 * MiB;
constexpr size_t WS_EGATE = 1789 * MiB;
constexpr size_t WS_SUBB = 1798 * MiB;
constexpr size_t WS_USC = 1799 * MiB;
constexpr size_t WS_VSC = 1799 * MiB + 512 * 1024;
constexpr size_t WS_END = 1800 * MiB;
constexpr int GLA_ITEMS = (TA / 64) * 4;
static_assert(WS_DELTA + (size_t)GLA_ITEMS * 2 * 8192 * 4 <= WS_DEC && WS_DEC + (size_t)GLA_ITEMS * 2 * 64 * 4 <= WS_SST && WS_SST + (size_t)GLA_ITEMS * 2 * 8192 * 2 <= WS_END, "map");
static_assert(WS_WIN + (size_t)4 * INWP * DM * 2 <= WS_WOUT, "map");
static_assert(WS_P + (size_t)TA * INWP * 4 <= WS_QR, "map");
static_assert(WS_XL + (size_t)TA * DM * 4 <= WS_HB, "map");
constexpr int CW_BAR = 4096;
constexpr int LDS_BYTES = 147456;
constexpr int MISC_OFF = 131072 + 320;

#define XB_TMO      128
#define XB_XCNT(j)  (256  + 64 * (j))
#define XB_XSUB(j)  (1280 + 64 * (j))
#define XB_XGEN(j)  (2304 + 64 * (j))
#define XB_TOP      3328
#define XB_TOPGEN   3392
#define XCD_BAR_WORDS 3456
#define XB_SPIN_CAP (1u << 18)
__device__ __forceinline__ unsigned xb_ld(unsigned* p)              { return __hip_atomic_load(p, __ATOMIC_RELAXED, __HIP_MEMORY_SCOPE_AGENT); }
__device__ __forceinline__ unsigned xb_add(unsigned* p, unsigned v) { return __hip_atomic_fetch_add(p, v, __ATOMIC_RELAXED, __HIP_MEMORY_SCOPE_AGENT); }
__device__ __forceinline__ unsigned xb_xcc_id() { return (unsigned)__builtin_amdgcn_s_getreg((3 << 11) | 20) & 0xFu; }
#define XB_SPIN(cond, bar) do { unsigned _sp = 0; while (cond) { __builtin_amdgcn_s_sleep(1); \
    if ((++_sp & 255u) == 0u) { if (xb_ld(&(bar)[XB_TMO])) break; if (_sp > XB_SPIN_CAP) { atomicAdd(&(bar)[XB_TMO], 1u); break; } } } } while (0)
struct XcdBarrier { unsigned* bar; unsigned x; volatile LAS unsigned* st; };
__device__ __forceinline__ XcdBarrier xcd_barrier_post(unsigned* bar, volatile LAS unsigned* st) {
    XcdBarrier b; b.bar = bar; b.x = xb_xcc_id(); b.st = st;
    if (threadIdx.x == 0) (void)xb_add(&bar[XB_XCNT(b.x)], 1u);
    return b;
}
__device__ __forceinline__ void xcd_barrier_complete(unsigned* bar, unsigned x, unsigned& nloc, unsigned& nx) {
    const unsigned G = gridDim.x * gridDim.y * gridDim.z;
    unsigned sum, cnt, mine, sp = 0u;
    for (;;) {
        sum = 0u; cnt = 0u; mine = 0u;
#pragma unroll
        for (unsigned j = 0; j < 16; ++j) { const unsigned c = xb_ld(&bar[XB_XCNT(j)]); sum += c; cnt += (c > 0u) ? 1u : 0u; mine = (j == x) ? c : mine; }
        if (sum == G) break;
        __builtin_amdgcn_s_sleep(1);
        if ((++sp & 255u) == 0u) { if (xb_ld(&bar[XB_TMO])) break; if (sp > XB_SPIN_CAP) { atomicAdd(&bar[XB_TMO], 1u); break; } }
    }
    nloc = mine > 0u ? mine : 1u; nx = cnt > 0u ? cnt : 1u;
}
__device__ __forceinline__ void xcd_barrier(const XcdBarrier& b) {
    asm volatile("s_waitcnt vmcnt(0)" ::: "memory");
    __syncthreads();
    if (threadIdx.x == 0) {
        unsigned* bar = b.bar;
        __builtin_amdgcn_s_waitcnt(0);
        unsigned nloc = b.st[0], nx = b.st[1];
        if (nloc == 0u) { xcd_barrier_complete(bar, b.x, nloc, nx); b.st[0] = nloc; b.st[1] = nx; }
        const unsigned old = xb_add(&bar[XB_XSUB(b.x)], 1u);
        const unsigned gen = old / nloc;
        if (old + 1u == (gen + 1u) * nloc) {
            __builtin_amdgcn_fence(__ATOMIC_RELEASE, "agent");
            asm volatile("s_waitcnt vmcnt(0)" ::: "memory");
            const unsigned og = xb_add(&bar[XB_TOP], 1u);
            const unsigned tg = og / nx;
            if (og + 1u == (tg + 1u) * nx) xb_add(&bar[XB_TOPGEN], 1u);
            else XB_SPIN(xb_ld(&bar[XB_TOPGEN]) == tg, bar);
            __builtin_amdgcn_fence(__ATOMIC_ACQUIRE, "agent");
            xb_add(&bar[XB_XGEN(b.x)], 1u);
            asm volatile("s_waitcnt vmcnt(0)" ::: "memory");
        } else {
            XB_SPIN(xb_ld(&bar[XB_XGEN(b.x)]) == gen, bar);
            __builtin_amdgcn_fence(__ATOMIC_ACQUIRE, "agent");
            asm volatile("s_waitcnt vmcnt(0)" ::: "memory");
        }
    }
    __syncthreads();
}

namespace pg8 {
#define PG8_LAS __attribute__((address_space(3)))
typedef unsigned short bf16_t;
typedef short bf16x8 __attribute__((ext_vector_type(8)));
typedef float f32x4 __attribute__((ext_vector_type(4)));
typedef unsigned u32x4 __attribute__((ext_vector_type(4)));
constexpr int BM = 256, BK = 64, HALF = 128, HTB = HALF * BK * 2  , STAGE_BYTES = 8 * HTB, NXCD = 8, WGM = 8;

__host__ __device__ __forceinline__ int lds_byte(int r, int c) { const int st = (r >> 4) * 2 + (c >> 5), rr = r & 15, cc = c & 31, ob = rr * 64 + cc * 2; return st * 1024 + (ob ^ (((ob >> 9) & 1) << 5)); }
__host__ __device__ __forceinline__ void stage_rc(int b, int& R, int& C) { const int st = b / 1024, sb = b % 1024, swz = sb ^ (((sb >> 9) & 1) << 5); R = (st >> 1) * 16 + swz / 64; C = (st & 1) * 32 + (swz % 64) / 2; }
__host__ __device__ __forceinline__ int perm32(int rho) { const int n = rho >> 4, i = rho & 15; return 8 * (i >> 2) + 4 * n + (i & 3); }

struct Unit { int pm, pn; };
struct Gemm { const bf16_t* A; const bf16_t* Bt; int M, N, K; };

struct StaticOrder {
    int nM, nN, nwg, G, c;
    __host__ __device__ void init(int M, int N, int G_, int c_) { nM = M / BM; nN = N / BM; nwg = nM * nN; G = G_; c = c_; }
    __host__ __device__ bool next(int i, Unit& u) const {
        const long L = (long)i * G + c; if (L >= nwg) return false;
        int wgid = (int)L; { const int q = nwg / NXCD, r = nwg % NXCD, xcd = wgid % NXCD, off = wgid / NXCD; wgid = (xcd < r ? xcd * (q + 1) : r * (q + 1) + (xcd - r) * q) + off; }
        const int nig = WGM * nN, gid = wgid / nig, fm = gid * WGM, gsz = (nM - fm) < WGM ? (nM - fm) : WGM;
        u.pm = fm + ((wgid % nig) % gsz); u.pn = (wgid % nig) / gsz; return true;
    }
    __device__ __forceinline__ void a_ready(const Unit&) const {}
    __device__ __forceinline__ void done(const Unit&) const {}
};

__device__ __forceinline__ unsigned cvt_pk_bf16(float lo, float hi) { unsigned r; asm volatile("v_cvt_pk_bf16_f32 %0, %1, %2" : "=v"(r) : "v"(lo), "v"(hi)); return r; }
typedef float f32x2 __attribute__((ext_vector_type(2)));
__device__ __forceinline__ f32x2 gelu_pk(f32x2 v) {
    const f32x2 av = __builtin_elementwise_abs(v), d = av * 0.2316418882f + 1.0f;
    f32x2 t; t.x = __builtin_amdgcn_rcpf(d.x); t.y = __builtin_amdgcn_rcpf(d.y);
    f32x2 q = t * 0.5307027145f + (-0.7265760135f); q = q * t + 0.7107068705f; q = q * t + (-0.142248368f); q = q * t + 0.127414796f; q = q * t;
    const f32x2 s = (v * v) * (-0.72134752044f);
    f32x2 e; e.x = __builtin_amdgcn_exp2f(s.x); e.y = __builtin_amdgcn_exp2f(s.y);
    const f32x2 m = v * (q * e), r = v - m;
    f32x2 o; o.x = v.x < 0.f ? m.x : r.x; o.y = v.y < 0.f ? m.y : r.y; return o;
}

template <int ACT  > struct EpiBf16 {
    static constexpr bool PERM = true, AFTER_DRAIN = false; static_assert(ACT == 0 || ACT == 1, "EpiBf16: ACT is 0 (none) or 1 (gelu_pk)");
    bf16_t* O; int ldc; const float* bias; int split_cols; size_t split_stride; float scale0;
    __device__ __forceinline__ void operator()(const f32x4 (&acc)[2][2][4][2], const Unit& u, int wr, int wc, int fr, int fq) const {
        const int row0 = u.pm * BM + wr * 64 + fr; int colt = u.pn * BM; bf16_t* base = O;
        float sc = 1.f; if (split_cols) { const int t = colt / split_cols; base += (size_t)t * split_stride; colt -= t * split_cols; if (t == 0) sc = scale0; }
        const int col0 = colt + wc * 32 + 8 * fq, bcol0 = u.pn * BM + wc * 32 + 8 * fq;
        f32x4 bv[2][2];
#pragma unroll
        for (int bj = 0; bj < 2; ++bj)
#pragma unroll
            for (int n = 0; n < 2; ++n) bv[bj][n] = bias ? *(const f32x4*)(bias + bcol0 + bj * HALF + 4 * n) : (f32x4){0.f, 0.f, 0.f, 0.f};
#pragma unroll
        for (int ai = 0; ai < 2; ++ai)
#pragma unroll
            for (int m = 0; m < 4; ++m) { bf16_t* rowp = base + (size_t)(row0 + ai * HALF + m * 16) * ldc + col0;
#pragma unroll
                for (int bj = 0; bj < 2; ++bj) { f32x4 v0 = acc[ai][bj][m][0] + bv[bj][0], v1 = acc[ai][bj][m][1] + bv[bj][1];
                    if (ACT == 1) { f32x2 a = gelu_pk((f32x2){v0[0], v0[1]}), b = gelu_pk((f32x2){v0[2], v0[3]}), c = gelu_pk((f32x2){v1[0], v1[1]}), d = gelu_pk((f32x2){v1[2], v1[3]});
                        v0 = (f32x4){a.x, a.y, b.x, b.y}; v1 = (f32x4){c.x, c.y, d.x, d.y}; }
                    v0 = v0 * sc; v1 = v1 * sc; u32x4 w; w.x = cvt_pk_bf16(v0[0], v0[1]); w.y = cvt_pk_bf16(v0[2], v0[3]); w.z = cvt_pk_bf16(v1[0], v1[1]); w.w = cvt_pk_bf16(v1[2], v1[3]);
                    *(u32x4*)(rowp + bj * HALF) = w; } }
    }
};


struct EpiF32 {
    static constexpr bool PERM = false, AFTER_DRAIN = false;
    float* C; int ldc; const float* bias;
    __device__ __forceinline__ void operator()(const f32x4 (&acc)[2][2][4][2], const Unit& u, int wr, int wc, int fr, int fq) const {
        const int row0 = u.pm * BM + wr * 64 + fr, col0 = u.pn * BM + wc * 32 + 4 * fq;
        f32x4 bv[2][2];
#pragma unroll
        for (int bj = 0; bj < 2; ++bj)
#pragma unroll
            for (int n = 0; n < 2; ++n) bv[bj][n] = bias ? *(const f32x4*)(bias + col0 + bj * HALF + n * 16) : (f32x4){0.f, 0.f, 0.f, 0.f};
#pragma unroll
        for (int ai = 0; ai < 2; ++ai)
#pragma unroll
            for (int m = 0; m < 4; ++m) { float* rowp = C + (size_t)(row0 + ai * HALF + m * 16) * ldc + col0;
#pragma unroll
                for (int bj = 0; bj < 2; ++bj)
#pragma unroll
                    for (int n = 0; n < 2; ++n) *(f32x4*)(rowp + bj * HALF + n * 16) = acc[ai][bj][m][n] + bv[bj][n]; }
    }
};

template <class Epi, class Sched, bool ALIGN_EPI = false, bool SP2 = false>
__device__ __forceinline__ void gemm_phase(PG8_LAS unsigned char* lds, const Gemm g, const Sched& S, const Epi& E) {
    const int tid = threadIdx.x, wid = __builtin_amdgcn_readfirstlane(tid >> 6), lane = tid & 63, wr = wid >> 2, wc = wid & 3, fr = lane & 15, fq = lane >> 4;
    const int K = g.K, nt = K / BK;
    unsigned voffA[2], voffB[2];
#pragma unroll
    for (int i = 0; i < 2; ++i) { int R, C; stage_rc(tid * 16 + i * 8192, R, C); const int Rb = Epi::PERM ? ((R & ~31) + perm32(R & 31)) : R;
        voffA[i] = (unsigned)(R * K + C) * 2u; voffB[i] = (unsigned)(Rb * K + C) * 2u; }
    const size_t kstep = (size_t)(BK * 2);
    const size_t hstep = (size_t)HALF * K * 2;
    const size_t tstep = 2 * hstep;
    const unsigned ldsw = (unsigned)wid * 1024u;
    const int aoff = lds_byte(wr * 64 + fr, fq * 8), boff = lds_byte(wc * 32 + fr, fq * 8);
#define PG8_SA(b, h) (((b) * 2 + (h)) * HTB)
#define PG8_SB(b, h) ((4 + (b) * 2 + (h)) * HTB)
#define PG8_STAGE(bufoff, gbase, voff) do { _Pragma("unroll") for (int _i = 0; _i < 2; ++_i) \
        __builtin_amdgcn_global_load_lds((const unsigned*)((const char*)(gbase) + (voff)[_i]), (PG8_LAS unsigned*)(lds + (bufoff) + ldsw + _i * 8192), 16, 0, 0); } while (0)
#define PG8_LDA(dst, b, h) do { _Pragma("unroll") for (int m = 0; m < 4; ++m) _Pragma("unroll") for (int k = 0; k < 2; ++k) dst[m][k] = *(const PG8_LAS bf16x8*)(lds + PG8_SA(b, h) + aoff + m * 2048 + k * 1024); } while (0)
#define PG8_LDB(dst, b, h) do { _Pragma("unroll") for (int n = 0; n < 2; ++n) _Pragma("unroll") for (int k = 0; k < 2; ++k) dst[n][k] = *(const PG8_LAS bf16x8*)(lds + PG8_SB(b, h) + boff + n * 2048 + k * 1024); } while (0)
#define PG8_MMA(ai, bj, At, Bt) do { __builtin_amdgcn_s_setprio(1); _Pragma("unroll") for (int m = 0; m < 4; ++m) _Pragma("unroll") for (int n = 0; n < 2; ++n) _Pragma("unroll") for (int k = 0; k < 2; ++k) \
        acc[ai][bj][m][n] = __builtin_amdgcn_mfma_f32_16x16x32_bf16(Bt[n][k], At[m][k], acc[ai][bj][m][n], 0, 0, 0); __builtin_amdgcn_s_setprio(0); } while (0)
#define PG8_WAIT_V(n) asm volatile("s_waitcnt vmcnt(" #n ")" ::: "memory")
#define PG8_WAIT_L(n) asm volatile("s_waitcnt lgkmcnt(" #n ")" ::: "memory")
#define PG8_BAR __builtin_amdgcn_s_barrier()
#define PG8_SCHED __builtin_amdgcn_sched_barrier(0)
    Unit cur, nxt; int ui = 0;
    if (!S.next(0, cur)) return;
    f32x4 acc[2][2][4][2];
#pragma unroll
    for (int a = 0; a < 2; ++a)
#pragma unroll
        for (int b = 0; b < 2; ++b)
#pragma unroll
            for (int m = 0; m < 4; ++m)
#pragma unroll
                for (int n = 0; n < 2; ++n) acc[a][b][m][n] = (f32x4){0.f, 0.f, 0.f, 0.f};
    bf16x8 At[4][2], B0[2][2], B1[2][2];
    const char* cA = (const char*)g.A + (size_t)cur.pm * tstep; const char* cB = (const char*)g.Bt + (size_t)cur.pn * tstep;
    S.a_ready(cur);
    if constexpr (SP2) {
        PG8_STAGE(PG8_SB(0, 0), cB, voffB); PG8_STAGE(PG8_SB(0, 1), cB + hstep, voffB); PG8_STAGE(PG8_SA(0, 0), cA, voffA); PG8_STAGE(PG8_SA(0, 1), cA + hstep, voffA);
        if (wr == 1) PG8_BAR;
        PG8_WAIT_V(2); PG8_BAR;
        PG8_STAGE(PG8_SB(1, 0), cB + kstep, voffB); PG8_STAGE(PG8_SA(1, 0), cA + kstep, voffA); PG8_STAGE(PG8_SB(1, 1), cB + hstep + kstep, voffB);
        PG8_WAIT_V(6); PG8_BAR;
    } else {
        PG8_STAGE(PG8_SB(0, 0), cB, voffB); PG8_STAGE(PG8_SA(0, 0), cA, voffA); PG8_STAGE(PG8_SB(0, 1), cB + hstep, voffB); PG8_STAGE(PG8_SA(0, 1), cA + hstep, voffA);
        if (wr == 1) PG8_BAR;
        PG8_WAIT_V(4); PG8_BAR;
        PG8_STAGE(PG8_SB(1, 0), cB + kstep, voffB); PG8_STAGE(PG8_SA(1, 0), cA + kstep, voffA); PG8_STAGE(PG8_SB(1, 1), cB + hstep + kstep, voffB);
        PG8_WAIT_V(6); PG8_BAR;
    }
    for (;;) {
        const bool has_next = S.next(ui + 1, nxt);
        const char* nA = has_next ? (const char*)g.A + (size_t)nxt.pm * tstep : cA; const char* nB = has_next ? (const char*)g.Bt + (size_t)nxt.pn * tstep : cB;
        for (int t = 0; t < nt; t += 2) {
            const bool last = (t == nt - 2);
            const char* a1 = cA + (size_t)(t + 1) * kstep;
            const char* a2 = last ? nA : cA + (size_t)(t + 2) * kstep; const char* b2 = last ? nB : cB + (size_t)(t + 2) * kstep;
            const char* a3 = a2 + kstep; const char* b3 = b2 + kstep;
            if (last && has_next) S.a_ready(nxt);
            if constexpr (SP2) {
            PG8_LDB(B0, 0, 0); PG8_LDB(B1, 0, 1); PG8_SCHED; PG8_LDA(At, 0, 0); PG8_STAGE(PG8_SA(1, 1), a1 + hstep, voffA);
            PG8_WAIT_V(8); PG8_WAIT_L(0); PG8_BAR; PG8_MMA(0, 0, At, B0); PG8_MMA(0, 1, At, B1); PG8_BAR; PG8_SCHED;
            PG8_LDA(At, 0, 1); PG8_STAGE(PG8_SB(0, 0), b2, voffB); PG8_STAGE(PG8_SB(0, 1), b2 + hstep, voffB); PG8_STAGE(PG8_SA(0, 0), a2, voffA);
            PG8_WAIT_V(8); PG8_WAIT_L(0); PG8_BAR; PG8_MMA(1, 0, At, B0); PG8_MMA(1, 1, At, B1); PG8_BAR; PG8_SCHED;
            PG8_LDB(B0, 1, 0); PG8_LDB(B1, 1, 1); PG8_SCHED; PG8_LDA(At, 1, 0); PG8_STAGE(PG8_SA(0, 1), a2 + hstep, voffA);
            PG8_WAIT_V(8); PG8_WAIT_L(0); PG8_BAR; PG8_MMA(0, 0, At, B0); PG8_MMA(0, 1, At, B1); PG8_BAR; PG8_SCHED;
            PG8_LDA(At, 1, 1); PG8_STAGE(PG8_SB(1, 0), b3, voffB); PG8_STAGE(PG8_SB(1, 1), b3 + hstep, voffB); PG8_STAGE(PG8_SA(1, 0), a3, voffA);
            PG8_WAIT_V(8); PG8_WAIT_L(0); PG8_BAR; PG8_MMA(1, 0, At, B0); PG8_MMA(1, 1, At, B1); PG8_BAR; PG8_SCHED;
            } else {
            PG8_LDB(B0, 0, 0); PG8_SCHED; PG8_LDA(At, 0, 0); PG8_STAGE(PG8_SA(1, 1), a1 + hstep, voffA);
            PG8_WAIT_L(8); PG8_BAR; PG8_WAIT_L(0); PG8_MMA(0, 0, At, B0); PG8_BAR; PG8_SCHED;
            PG8_LDB(B1, 0, 1); PG8_STAGE(PG8_SB(0, 0), b2, voffB);
            PG8_BAR; PG8_WAIT_L(0); PG8_MMA(0, 1, At, B1); PG8_BAR;
            PG8_LDA(At, 0, 1); PG8_STAGE(PG8_SA(0, 0), a2, voffA);
            PG8_BAR; PG8_WAIT_L(0); PG8_MMA(1, 0, At, B0); PG8_BAR; PG8_SCHED;
            PG8_STAGE(PG8_SB(0, 1), b2 + hstep, voffB);
            PG8_WAIT_V(6); PG8_BAR; PG8_MMA(1, 1, At, B1); PG8_BAR;
            PG8_LDB(B0, 1, 0); PG8_SCHED; PG8_LDA(At, 1, 0); PG8_STAGE(PG8_SA(0, 1), a2 + hstep, voffA);
            PG8_WAIT_L(8); PG8_BAR; PG8_WAIT_L(0); PG8_MMA(0, 0, At, B0); PG8_BAR; PG8_SCHED;
            PG8_LDB(B1, 1, 1); PG8_STAGE(PG8_SB(1, 0), b3, voffB);
            PG8_BAR; PG8_WAIT_L(0); PG8_MMA(0, 1, At, B1); PG8_BAR;
            PG8_LDA(At, 1, 1); PG8_STAGE(PG8_SA(1, 0), a3, voffA);
            PG8_BAR; PG8_WAIT_L(0); PG8_MMA(1, 0, At, B0); PG8_BAR; PG8_SCHED;
            PG8_STAGE(PG8_SB(1, 1), b3 + hstep, voffB);
            PG8_WAIT_V(6); PG8_BAR; PG8_MMA(1, 1, At, B1); PG8_BAR;
            }
        }
        if constexpr (ALIGN_EPI) { if (wr == 0) PG8_BAR; }
        if constexpr (!Epi::AFTER_DRAIN) { E(acc, cur, wr, wc, fr, fq); S.done(cur); }
        if (!has_next) break;
#pragma unroll
        for (int a = 0; a < 2; ++a)
#pragma unroll
            for (int b = 0; b < 2; ++b)
#pragma unroll
                for (int m = 0; m < 4; ++m)
#pragma unroll
                    for (int n = 0; n < 2; ++n) acc[a][b][m][n] = (f32x4){0.f, 0.f, 0.f, 0.f};
        cur = nxt; cA = nA; cB = nB; ++ui;
        if constexpr (ALIGN_EPI) { if (wr == 1) PG8_BAR; }
    }
    PG8_WAIT_V(0);
    if constexpr (!ALIGN_EPI) { if (wr == 0) PG8_BAR; }
    PG8_BAR;
    if constexpr (Epi::AFTER_DRAIN) { E.fused(acc, cur, wr, wc, fr, fq, lds, wid, lane); S.done(cur); }
#undef PG8_SA
#undef PG8_SB
#undef PG8_STAGE
#undef PG8_LDA
#undef PG8_LDB
#undef PG8_MMA
#undef PG8_WAIT_V
#undef PG8_WAIT_L
#undef PG8_BAR
#undef PG8_SCHED
}
}
#define PG8_SP2 true
#define PG8_ALIGN true

#define LDS_FENCE() asm volatile("s_waitcnt lgkmcnt(0)" ::: "memory")
__device__ __forceinline__ unsigned f2bf(float f) { unsigned u = __builtin_bit_cast(unsigned, f); return (u + 0x7fffu + ((u >> 16) & 1u)) >> 16; }
__device__ __forceinline__ unsigned pk2(float lo, float hi) { return f2bf(lo) | (f2bf(hi) << 16); }
__device__ __forceinline__ float wave_sum(float v) {
#pragma unroll
    for (int o = 1; o < 64; o <<= 1) v += __shfl_xor(v, o);
    return v;
}
__device__ __forceinline__ float wave_max(float v) {
#pragma unroll
    for (int o = 1; o < 64; o <<= 1) v = fmaxf(v, __shfl_xor(v, o));
    return v;
}
__device__ __forceinline__ float silu_f(float x) { return x / (1.0f + expf(-x)); }
__device__ __forceinline__ float gelu_f(float x) { return 0.5f * x * (1.0f + erff(x * 0.70710678118654752f)); }
__device__ __forceinline__ float log_sigmoid_f(float z) { return fminf(z, 0.0f) - log1pf(expf(-fabsf(z))); }

struct Params {
    const float* in[19];
    float* out;
    unsigned char* ws;
    int ph_lo, ph_hi;
};
enum { I_X = 0, I_C, I_CTX, I_CCTX, I_WADA, I_BADA, I_WIN, I_CONVW, I_GW2, I_GB2, I_GNORM, I_SINK, I_WOUT, I_LNG, I_LNB, I_PWQ, I_PSUB, I_PU, I_PV };

__device__ __forceinline__ int row_stream(int r) { return r < TL ? r / SEQ : 2; }

__device__ __forceinline__ void transpose_item(const float* W, int K, int N, bf16_t* WT, LAS float* scr, int item, int lane) {
    const int nblk = N / 32, kb = item / nblk, nb = item % nblk, k0 = 64 * kb, n0 = 32 * nb;
#pragma unroll 8
    for (int i = 0; i < 32; ++i) { const int kk = 2 * i + (lane >> 5); scr[kk * 33 + (lane & 31)] = W[(size_t)(k0 + kk) * N + n0 + (lane & 31)]; }
    LDS_FENCE();
    const int c = lane & 7;
#pragma unroll
    for (int j = 0; j < 4; ++j) { const int n = (lane >> 3) + 8 * j; const LAS float* s = scr + (8 * c) * 33 + n;
        u32x4 o; o.x = pk2(s[0 * 33], s[1 * 33]); o.y = pk2(s[2 * 33], s[3 * 33]); o.z = pk2(s[4 * 33], s[5 * 33]); o.w = pk2(s[6 * 33], s[7 * 33]);
        *(u32x4*)(WT + (size_t)(n0 + n) * K + k0 + 8 * c) = o; }
    LDS_FENCE();
}

__device__ __forceinline__ void phase_prologue(const Params& p, LAS unsigned char* lds, int tid, int lane, int wave, int bid, int G) {
    const int gw = bid * NWAVES + wave, NGW = G * NWAVES;
    LAS float* scr = (LAS float*)(lds + wave * 16384);
    bf16_t* WIN = (bf16_t*)(p.ws + WS_WIN); bf16_t* WOUT = (bf16_t*)(p.ws + WS_WOUT); bf16_t* WQ = (bf16_t*)(p.ws + WS_WQ);
    constexpr int IT_IN = (DM / 64) * (INW / 32), IT_SQ = (DM / 64) * (DM / 32), IT_L = IT_IN + 2 * IT_SQ;
    for (int it = gw; it < DEPTH * IT_L; it += NGW) {
        const int l = it / IT_L; int r = it % IT_L;
        if (r < IT_IN) { transpose_item(p.in[I_WIN] + (size_t)l * DM * INW, DM, INW, WIN + (size_t)l * INWP * DM, scr, r, lane); continue; } r -= IT_IN;
        if (r < IT_SQ) { transpose_item(p.in[I_WOUT] + (size_t)l * DM * DM, DM, DM, WOUT + (size_t)l * DM * DM, scr, r, lane); continue; } r -= IT_SQ;
        transpose_item(p.in[I_PWQ] + (size_t)l * DM * DM, DM, DM, WQ + (size_t)l * DM * DM, scr, r, lane);
    }
    {
        constexpr int PADV = (INWP - INW) * DM / 8;
        const int gt = bid * NTHREADS + tid, NGT = G * NTHREADS;
        for (int i = gt; i < DEPTH * PADV; i += NGT) { const int l = i / PADV, o = i % PADV;
            *(u32x4*)(WIN + (size_t)l * INWP * DM + (size_t)INW * DM + (size_t)o * 8) = (u32x4){0u, 0u, 0u, 0u}; }
    }
    {
        const float* U = p.in[I_PU]; const float* V = p.in[I_PV];
        unsigned char* UB = p.ws + WS_UB; unsigned char* VB = p.ws + WS_VB; float* USC = (float*)(p.ws + WS_USC); float* VSC = (float*)(p.ws + WS_VSC);
        for (size_t row = gw; row < (size_t)DEPTH * NEXP; row += NGW) {
#pragma unroll 1
            for (int tb = 0; tb < 2; ++tb) {
                const float* src = (tb ? V : U) + row * DM; unsigned* dst = (unsigned*)((tb ? VB : UB) + row * DM);
                f32x4 x[8]; float am = 0.f;
#pragma unroll
                for (int j = 0; j < 8; ++j) { x[j] = *(const f32x4*)(src + lane * 4 + 256 * j); am = fmaxf(am, fmaxf(fmaxf(fabsf(x[j].x), fabsf(x[j].y)), fmaxf(fabsf(x[j].z), fabsf(x[j].w)))); }
                am = wave_max(am);
                const float inv = am > 0.f ? 440.0f / am : 0.f;
#pragma unroll
                for (int j = 0; j < 8; ++j) { int w = 0; w = __builtin_amdgcn_cvt_pk_fp8_f32(x[j].x * inv, x[j].y * inv, w, false); w = __builtin_amdgcn_cvt_pk_fp8_f32(x[j].z * inv, x[j].w * inv, w, true); dst[lane + 64 * j] = (unsigned)w; }
                if (lane == 0) (tb ? VSC : USC)[row] = am * (1.0f / 440.0f);
            }
        }
        const size_t gt = (size_t)bid * NTHREADS + tid, NGT = (size_t)G * NTHREADS;
        const float* SUB = p.in[I_PSUB]; bf16_t* SUBB = (bf16_t*)(p.ws + WS_SUBB);
        for (size_t i = gt; i < (size_t)DEPTH * 2 * 128 * 128 / 2; i += NGT) ((unsigned*)SUBB)[i] = pk2(SUB[2 * i], SUB[2 * i + 1]);
    }
    __syncthreads();
    LAS float* sc = (LAS float*)lds;
    LAS float* red = (LAS float*)(lds + 32768);
    for (int i = tid; i < 3 * DM; i += NTHREADS) { const int s = i / DM, k = i % DM; const float v = s < 2 ? p.in[I_C][s * DM + k] : p.in[I_CCTX][k]; sc[i] = silu_f(v); }
    __syncthreads();
    float* MOD = (float*)(p.ws + WS_MOD);
    constexpr int NCH = 6 * DM / 64;
    for (int it = bid; it < DEPTH * NCH; it += G) {
        const int l = it / NCH, n = (it % NCH) * 64 + lane;
        const float* wp = p.in[I_WADA] + (size_t)l * DM * 6 * DM + n;
        float a0 = 0.f, a1 = 0.f, a2 = 0.f;
        const int kb = wave * (DM / NWAVES);
#pragma unroll 8
        for (int k = kb; k < kb + DM / NWAVES; ++k) { const float w = wp[(size_t)k * 6 * DM]; a0 += sc[k] * w; a1 += sc[DM + k] * w; a2 += sc[2 * DM + k] * w; }
        red[(wave * 3 + 0) * 64 + lane] = a0; red[(wave * 3 + 1) * 64 + lane] = a1; red[(wave * 3 + 2) * 64 + lane] = a2;
        __syncthreads();
        if (tid < 192) { const int s = tid / 64, ln = tid % 64; float v = 0.f;
#pragma unroll
            for (int w = 0; w < NWAVES; ++w) v += red[(w * 3 + s) * 64 + ln];
            const int nn = (it % NCH) * 64 + ln;
            MOD[((size_t)l * 3 + s) * 6 * DM + nn] = v + p.in[I_BADA][(size_t)l * 6 * DM + nn]; }
        __syncthreads();
    }
}

__device__ __forceinline__ const float* xsrc(const Params& p, int l, int r) {
    if (l > 0) return (const float*)(p.ws + WS_XL) + (size_t)r * DM;
    return r < TL ? p.in[I_X] + (size_t)r * DM : p.in[I_CTX] + (size_t)(r - TL) * DM;
}

__device__ __forceinline__ void modulate_row(const float* xr, const float* mod, int sh_off, int sc_off, bf16_t* hb, int lane) {
#pragma unroll
    for (int j = 0; j < 8; ++j) { const int c = lane * 4 + 256 * j;
        const f32x4 x = *(const f32x4*)(xr + c), sh = *(const f32x4*)(mod + sh_off + c), s = *(const f32x4*)(mod + sc_off + c);
        u32x2 o; o.x = pk2(x.x * (1.f + s.x) + sh.x, x.y * (1.f + s.y) + sh.y); o.y = pk2(x.z * (1.f + s.z) + sh.z, x.w * (1.f + s.w) + sh.w);
        *(u32x2*)(hb + c) = o; }
}
__device__ __forceinline__ void phase_modulate0(const Params& p, int lane, int wave, int bid, int G) {
    const int gw = bid * NWAVES + wave, NGW = G * NWAVES;
    const float* MOD = (const float*)(p.ws + WS_MOD); bf16_t* HB = (bf16_t*)(p.ws + WS_HB);
    for (int r = gw; r < TA; r += NGW) modulate_row(xsrc(p, 0, r), MOD + (size_t)(0 * 3 + row_stream(r)) * 6 * DM, 0, DM, HB + (size_t)r * DM, lane);
}

__device__ __forceinline__ void gemm_direct(const bf16_t* A, const bf16_t* Bt, float* C, int M, int N, int K, int ldc, int gw, int NGW, int lane) {
    const int nTn = N / 64, nItems = (M / 32) * nTn;
    const int fr = lane & 15, fq = lane >> 4;
    for (int it = gw; it < nItems; it += NGW) {
        const int mt = it / nTn, nt = it % nTn;
        const bf16_t* a0 = A + (size_t)(mt * 32 + fr) * K + fq * 8;
        const bf16_t* b0 = Bt + (size_t)(nt * 64 + fr) * K + fq * 8;
        f32x4 acc[2][4];
#pragma unroll
        for (int i = 0; i < 2; ++i)
#pragma unroll
            for (int j = 0; j < 4; ++j) acc[i][j] = (f32x4){0.f, 0.f, 0.f, 0.f};
#pragma unroll 2
        for (int k0 = 0; k0 < K; k0 += 32) {
            bf16x8 af[2], bfr[4];
#pragma unroll
            for (int i = 0; i < 2; ++i) af[i] = *(const bf16x8*)(a0 + (size_t)i * 16 * K + k0);
#pragma unroll
            for (int j = 0; j < 4; ++j) bfr[j] = *(const bf16x8*)(b0 + (size_t)j * 16 * K + k0);
#pragma unroll
            for (int i = 0; i < 2; ++i)
#pragma unroll
                for (int j = 0; j < 4; ++j) acc[i][j] = __builtin_amdgcn_mfma_f32_16x16x32_bf16(af[i], bfr[j], acc[i][j], 0, 0, 0);
        }
#pragma unroll
        for (int i = 0; i < 2; ++i)
#pragma unroll
            for (int j = 0; j < 4; ++j)
#pragma unroll
                for (int g = 0; g < 4; ++g) C[(size_t)(mt * 32 + i * 16 + fq * 4 + g) * ldc + nt * 64 + j * 16 + fr] = acc[i][j][g];
    }
}

__device__ __forceinline__ void phase_post_in(const Params& p, int l, int lane, int wave, int bid, int G) {
    const int gw = bid * NWAVES + wave, NGW = G * NWAVES;
    const float* P = (const float*)(p.ws + WS_P);
    bf16_t* QR = (bf16_t*)(p.ws + WS_QR); bf16_t* KR = (bf16_t*)(p.ws + WS_KR); bf16_t* VR = (bf16_t*)(p.ws + WS_ALF);
    bf16_t* MIX = (bf16_t*)(p.ws + WS_MIX);
    const float* cw = p.in[I_CONVW] + (size_t)l * 3 * 512;
    for (int r = gw; r < TA; r += NGW) {
        const float* pr = P + (size_t)r * INWP;
        int pos, len;
        if (r < TL) { pos = r % SEQ; len = SEQ; } else { pos = (r - TL) % CTXL; len = CTXL; }
#pragma unroll 1
        for (int j = 0; j < 8; ++j) { const int c = lane + 64 * j;
            float a = cw[512 + c] * pr[C_CC + c] * pr[C_CX + c];
            if (pos > 0) a += cw[c] * pr[C_CC + c - INWP] * pr[C_CX + c - INWP];
            if (pos < len - 1) a += cw[1024 + c] * pr[C_CC + c + INWP] * pr[C_CX + c + INWP];
            MIX[(size_t)r * DM + c] = (bf16_t)f2bf(pr[C_CB + c] * a); }
        {
            const int half = lane >> 5, i = lane & 31;
            float sn = 0.f, cs = 1.f;
            if (r < TL) { const float invf = powf(10000.0f, -(float)i / 32.0f); const float ang = (float)(half ? (pos % 64) : (pos / 64)) * invf; sincosf(ang, &sn, &cs); }
#pragma unroll 2
            for (int h = 0; h < 8; ++h) { const float* q = pr + C_SQ + h * 128 + half * 64; const float x1 = q[i], x2 = q[32 + i];
                bf16_t* o = QR + (size_t)r * 1024 + h * 128 + half * 64;
                o[i] = (bf16_t)f2bf((x1 * cs - x2 * sn) * 0.08838834764831845f); o[32 + i] = (bf16_t)f2bf((x2 * cs + x1 * sn) * 0.08838834764831845f); }
#pragma unroll
            for (int h = 0; h < 2; ++h) { const float* k = pr + C_SK + h * 128 + half * 64; const float x1 = k[i], x2 = k[32 + i];
                bf16_t* o = KR + (size_t)r * 256 + h * 128 + half * 64;
                o[i] = (bf16_t)f2bf(x1 * cs - x2 * sn); o[32 + i] = (bf16_t)f2bf(x2 * cs + x1 * sn); }
#pragma unroll
            for (int j = 0; j < 4; ++j) VR[(size_t)r * 256 + lane + 64 * j] = (bf16_t)f2bf(pr[C_SV + lane + 64 * j]);
        }
    }
}

constexpr int KP = 136, VP = 72;
constexpr int SWA_BUF = 64 * KP * 2 + 128 * VP * 2;
typedef short bf16x4 __attribute__((ext_vector_type(4)));
__device__ __forceinline__ void phase_mixers(const Params& p, int l, LAS unsigned char* lds, int tid, int lane, int wave, int bid, int G) {
    const bf16_t* QR = (const bf16_t*)(p.ws + WS_QR); const bf16_t* KR = (const bf16_t*)(p.ws + WS_KR); const bf16_t* VR = (const bf16_t*)(p.ws + WS_ALF);
    bf16_t* MIX = (bf16_t*)(p.ws + WS_MIX);
    const float* sinkp = p.in[I_SINK] + l * 8;
    const int fr = lane & 15, fq = lane >> 4, g = wave & 3, qh = wave >> 2;
    const int nItems = 512 + ((l < DEPTH - 1) ? 16 : 0);
    for (int it = bid; it < nItems; it += G) {
        int b, tile, hk, s0; size_t qrow0;
        if (it < 512) { b = it >> 8; tile = (it >> 1) & 127; hk = it & 1; s0 = 0; qrow0 = (size_t)b * SEQ + tile * 64; }
        else { const int c = it - 512; b = c >> 3; tile = (c >> 1) & 3; hk = c & 1; s0 = 5; qrow0 = (size_t)TL + b * CTXL + tile * 64; }
        const int n0 = tile * 64, hq = hk * 4 + g;
        bf16x8 qf[2][4];
#pragma unroll
        for (int qt = 0; qt < 2; ++qt)
#pragma unroll
            for (int ks = 0; ks < 4; ++ks) qf[qt][ks] = *(const bf16x8*)(QR + (qrow0 + qh * 32 + qt * 16 + fr) * 1024 + hq * 128 + ks * 32 + fq * 8);
        f32x4 O[2][8];
#pragma unroll
        for (int qt = 0; qt < 2; ++qt)
#pragma unroll
            for (int dt = 0; dt < 8; ++dt) O[qt][dt] = (f32x4){0.f, 0.f, 0.f, 0.f};
        float m[2], lsum[2];
        m[0] = m[1] = sinkp[hq]; lsum[0] = lsum[1] = (fq == 0) ? 1.f : 0.f;
        u32x4 kreg[2], vreg[2];
#define SWA_ROW(s, kk) ((s) < 5 ? (size_t)b * SEQ + (size_t)min(max(n0 - 128 + (s) * 64 + (kk), 0), SEQ - 1) : (size_t)TL + (size_t)b * CTXL + ((s) - 5) * 64 + (kk))
#define SWA_LOAD(s) do { _Pragma("unroll") for (int j = 0; j < 2; ++j) { const int v = tid + NTHREADS * j; \
            kreg[j] = *(const u32x4*)(KR + SWA_ROW(s, v >> 4) * 256 + hk * 128 + (v & 15) * 8); \
            vreg[j] = *(const u32x4*)(VR + SWA_ROW(s, tid & 63) * 256 + hk * 128 + ((tid >> 6) + 8 * j) * 8); } } while (0)
#define SWA_WRITE(buf) do { LAS bf16_t* Kd = (LAS bf16_t*)(lds + (buf) * SWA_BUF); LAS bf16_t* Vd = Kd + 64 * KP; \
            _Pragma("unroll") for (int j = 0; j < 2; ++j) { const int v = tid + NTHREADS * j; *(LAS u32x4*)(Kd + (v >> 4) * KP + (v & 15) * 8) = kreg[j]; \
                const int d0 = ((tid >> 6) + 8 * j) * 8, key = tid & 63; const u32x4 w = vreg[j]; \
                Vd[(d0 + 0) * VP + key] = (bf16_t)(w.x & 0xffffu); Vd[(d0 + 1) * VP + key] = (bf16_t)(w.x >> 16); Vd[(d0 + 2) * VP + key] = (bf16_t)(w.y & 0xffffu); Vd[(d0 + 3) * VP + key] = (bf16_t)(w.y >> 16); \
                Vd[(d0 + 4) * VP + key] = (bf16_t)(w.z & 0xffffu); Vd[(d0 + 5) * VP + key] = (bf16_t)(w.z >> 16); Vd[(d0 + 6) * VP + key] = (bf16_t)(w.w & 0xffffu); Vd[(d0 + 7) * VP + key] = (bf16_t)(w.w >> 16); } } while (0)
        SWA_LOAD(s0); SWA_WRITE(0);
        __syncthreads();
#pragma unroll 1
        for (int s = s0; s < 9; ++s) {
            const int buf = (s - s0) & 1;
            if (s + 1 < 9) SWA_LOAD(s + 1);
            const LAS bf16_t* Ks = (const LAS bf16_t*)(lds + buf * SWA_BUF); const LAS bf16_t* Vs = Ks + 64 * KP;
#pragma unroll 1
            for (int sc = 0; sc < 2; ++sc) {
                f32x4 sT[2][2];
#pragma unroll
                for (int qt = 0; qt < 2; ++qt) { sT[qt][0] = (f32x4){0.f, 0.f, 0.f, 0.f}; sT[qt][1] = (f32x4){0.f, 0.f, 0.f, 0.f}; }
#pragma unroll
                for (int ks = 0; ks < 4; ++ks)
#pragma unroll
                    for (int kt = 0; kt < 2; ++kt) { const bf16x8 ka = *(const LAS bf16x8*)(Ks + (sc * 32 + kt * 16 + fr) * KP + ks * 32 + fq * 8);
#pragma unroll
                        for (int qt = 0; qt < 2; ++qt) sT[qt][kt] = __builtin_amdgcn_mfma_f32_16x16x32_bf16(ka, qf[qt][ks], sT[qt][kt], 0, 0, 0); }
                bf16x8 pb[2];
#pragma unroll
                for (int qt = 0; qt < 2; ++qt) {
                    if (s < 5) {
                        const int qpos = n0 + qh * 32 + qt * 16 + fr;
#pragma unroll
                        for (int kt = 0; kt < 2; ++kt)
#pragma unroll
                            for (int e = 0; e < 4; ++e) { const int kpos = n0 - 128 + s * 64 + sc * 32 + kt * 16 + fq * 4 + e; const int dlt = qpos - kpos;
                                const bool ok = kpos >= 0 && kpos < SEQ && dlt <= 128 && dlt >= -128; sT[qt][kt][e] = ok ? sT[qt][kt][e] : -1e30f; } }
                    float cm = fmaxf(fmaxf(fmaxf(sT[qt][0][0], sT[qt][0][1]), fmaxf(sT[qt][0][2], sT[qt][0][3])), fmaxf(fmaxf(sT[qt][1][0], sT[qt][1][1]), fmaxf(sT[qt][1][2], sT[qt][1][3])));
                    cm = fmaxf(cm, __shfl_xor(cm, 16)); cm = fmaxf(cm, __shfl_xor(cm, 32));
                    const float mn = fmaxf(m[qt], cm), scl = __expf(m[qt] - mn); m[qt] = mn;
                    float pe[8]; float ps = 0.f;
#pragma unroll
                    for (int kt = 0; kt < 2; ++kt)
#pragma unroll
                        for (int e = 0; e < 4; ++e) { pe[kt * 4 + e] = __expf(sT[qt][kt][e] - mn); ps += pe[kt * 4 + e]; }
                    lsum[qt] = lsum[qt] * scl + ps;
#pragma unroll
                    for (int dt = 0; dt < 8; ++dt) O[qt][dt] = O[qt][dt] * scl;
                    u32x4 pw; pw.x = pk2(pe[0], pe[1]); pw.y = pk2(pe[2], pe[3]); pw.z = pk2(pe[4], pe[5]); pw.w = pk2(pe[6], pe[7]);
                    pb[qt] = __builtin_bit_cast(bf16x8, pw);
                }
#pragma unroll
                for (int dt = 0; dt < 8; ++dt) {
                    const bf16x4 v0 = *(const LAS bf16x4*)(Vs + (dt * 16 + fr) * VP + sc * 32 + 4 * fq), v1 = *(const LAS bf16x4*)(Vs + (dt * 16 + fr) * VP + sc * 32 + 16 + 4 * fq);
                    const bf16x8 va = __builtin_shufflevector(v0, v1, 0, 1, 2, 3, 4, 5, 6, 7);
#pragma unroll
                    for (int qt = 0; qt < 2; ++qt) O[qt][dt] = __builtin_amdgcn_mfma_f32_16x16x32_bf16(va, pb[qt], O[qt][dt], 0, 0, 0);
                }
            }
            if (s + 1 < 9) SWA_WRITE(buf ^ 1);
            __syncthreads();
        }
#undef SWA_ROW
#undef SWA_LOAD
#undef SWA_WRITE
#pragma unroll
        for (int qt = 0; qt < 2; ++qt) {
            float lt = lsum[qt]; lt += __shfl_xor(lt, 16); lt += __shfl_xor(lt, 32);
            const float inv = 1.0f / lt;
            bf16_t* o = MIX + (qrow0 + qh * 32 + qt * 16 + fr) * DM + 1024 + hq * 128 + fq * 4;
#pragma unroll
            for (int dt = 0; dt < 8; ++dt) { u32x2 w; w.x = pk2(O[qt][dt][0] * inv, O[qt][dt][1] * inv); w.y = pk2(O[qt][dt][2] * inv, O[qt][dt][3] * inv); *(u32x2*)(o + dt * 16) = w; }
        }
    }
}

__device__ __forceinline__ int chunk_row0(int cid) { return cid < 256 ? (cid >> 7) * SEQ + (cid & 127) * 64 : TL + ((cid - 256) >> 2) * CTXL + ((cid - 256) & 3) * 64; }
constexpr int GP = 72;

__device__ __forceinline__ void gla_g1(const Params& p, int l, LAS unsigned char* lds, int tid, int lane, int wave, int bid, int G) {
    LAS float* Bf = (LAS float*)lds; LAS float* Bb = Bf + 4096;
    LAS bf16_t* KTf = (LAS bf16_t*)(lds + 32768); LAS bf16_t* KTb = KTf + 64 * GP;
    LAS bf16_t* VT = KTb + 64 * GP;
    const float* P = (const float*)(p.ws + WS_P);
    float* BF = (float*)(p.ws + WS_OF); float* BB = (float*)(p.ws + WS_OB);
    float* DELTA = (float*)(p.ws + WS_DELTA); float* DEC = (float*)(p.ws + WS_DEC);
    const float* w2 = p.in[I_GW2] + (size_t)l * 2 * 16 * 256; const float* b2 = p.in[I_GB2] + (size_t)l * 2 * 256;
    const int fr = lane & 15, fq = lane >> 4;
    for (int item = bid; item < GLA_ITEMS; item += G) {
        const int cid = item >> 2, h = item & 3, row0 = chunk_row0(cid);
#pragma unroll 1
        for (int j = 0; j < 16; ++j) { const int e = tid + NTHREADS * j, dir = e >> 12, i = (e >> 6) & 63, k = e & 63;
            const float* lr = P + (size_t)(row0 + i) * INWP + (dir ? C_LRB : C_LRF);
            float z = b2[dir * 256 + h * 64 + k];
#pragma unroll
            for (int q = 0; q < 16; ++q) z += lr[q] * w2[(dir * 16 + q) * 256 + h * 64 + k];
            (dir ? Bb : Bf)[i * 64 + k] = log_sigmoid_f(z) * (1.0f / 16.0f); }
        __syncthreads();
        if (tid < 128) { const int dir = tid >> 6, k = tid & 63; LAS float* Bl = dir ? Bb : Bf; float* BG = (dir ? BB : BF) + (size_t)row0 * 256 + h * 64 + k; float a = 0.f;
            if (dir == 0) { for (int i = 0; i < 64; ++i) { a += Bl[i * 64 + k]; Bl[i * 64 + k] = a; BG[(size_t)i * 256] = a; } }
            else { for (int i = 63; i >= 0; --i) { a += Bl[i * 64 + k]; Bl[i * 64 + k] = a; BG[(size_t)i * 256] = a; } } }
        __syncthreads();
#pragma unroll 1
        for (int j = 0; j < 8; ++j) { const int e = tid + NTHREADS * j, i = e >> 6, k = e & 63;
            const float kv = P[(size_t)(row0 + i) * INWP + C_GK + h * 64 + k];
            KTf[k * GP + i] = (bf16_t)f2bf(kv * expf(Bf[63 * 64 + k] - Bf[i * 64 + k]));
            KTb[k * GP + i] = (bf16_t)f2bf(kv * expf(Bb[k] - Bb[i * 64 + k])); }
#pragma unroll 1
        for (int j = 0; j < 16; ++j) { const int e = tid + NTHREADS * j, i = e >> 7, v = e & 127;
            VT[v * GP + i] = (bf16_t)f2bf(P[(size_t)(row0 + i) * INWP + C_GV + h * 128 + v]); }
        if (tid < 128) { const int dir = tid >> 6, k = tid & 63; DEC[((size_t)item * 2 + dir) * 64 + k] = expf(dir ? Bb[k] : Bf[63 * 64 + k]); }
        __syncthreads();
        { const int dir = wave >> 2, vq = wave & 3; const LAS bf16_t* KT = dir ? KTb : KTf;
            f32x4 acc[2][4];
#pragma unroll
            for (int a = 0; a < 2; ++a)
#pragma unroll
                for (int b = 0; b < 4; ++b) acc[a][b] = (f32x4){0.f, 0.f, 0.f, 0.f};
#pragma unroll
            for (int ks = 0; ks < 2; ++ks) { bf16x8 af[2], bfr[4];
#pragma unroll
                for (int a = 0; a < 2; ++a) af[a] = *(const LAS bf16x8*)(VT + ((vq * 2 + a) * 16 + fr) * GP + ks * 32 + fq * 8);
#pragma unroll
                for (int b = 0; b < 4; ++b) bfr[b] = *(const LAS bf16x8*)(KT + (b * 16 + fr) * GP + ks * 32 + fq * 8);
#pragma unroll
                for (int a = 0; a < 2; ++a)
#pragma unroll
                    for (int b = 0; b < 4; ++b) acc[a][b] = __builtin_amdgcn_mfma_f32_16x16x32_bf16(af[a], bfr[b], acc[a][b], 0, 0, 0); }
            float* dst = DELTA + ((size_t)item * 2 + dir) * 8192;
#pragma unroll
            for (int a = 0; a < 2; ++a)
#pragma unroll
                for (int b = 0; b < 4; ++b)
#pragma unroll
                    for (int g = 0; g < 4; ++g) dst[((vq * 2 + a) * 16 + fq * 4 + g) * 64 + b * 16 + fr] = acc[a][b][g]; }
        __syncthreads();
    }
}

__device__ __forceinline__ void gla_g2(const Params& p, int tid, int bid, int G) {
    const float* DELTA = (const float*)(p.ws + WS_DELTA); const float* DEC = (const float*)(p.ws + WS_DEC); bf16_t* SST = (bf16_t*)(p.ws + WS_SST);
    for (int u = bid; u < 64; u += G) {
        const int s = u >> 2, dir = s >> 3, b = (s >> 2) & 1, h = s & 3, off = ((u & 3) * NTHREADS + tid) * 4, k0 = off & 63;
        f32x4 S = (f32x4){0.f, 0.f, 0.f, 0.f};
#pragma unroll 1
        for (int st = 0; st < 132; st += 4) {
            f32x4 d[4], dc[4]; size_t base[4];
#pragma unroll
            for (int q = 0; q < 4; ++q) { const int t = st + q;
                const int cid = t < 4 ? 256 + b * 4 + (dir ? 3 - t : t) : b * 128 + (dir ? 127 - (t - 4) : (t - 4));
                const size_t it2 = (size_t)(cid * 4 + h) * 2 + dir; base[q] = it2 * 8192 + off;
                d[q] = *(const f32x4*)(DELTA + base[q]); dc[q] = *(const f32x4*)(DEC + it2 * 64 + k0); }
#pragma unroll
            for (int q = 0; q < 4; ++q) { u32x2 o; o.x = pk2(S.x, S.y); o.y = pk2(S.z, S.w); *(u32x2*)(SST + base[q]) = o; S = dc[q] * S + d[q]; }
        }
    }
}

__device__ __forceinline__ void gla_g3(const Params& p, int l, LAS unsigned char* lds, int tid, int lane, int wave, int bid, int G) {
    LAS bf16_t* QEf = (LAS bf16_t*)lds; LAS bf16_t* QEb = QEf + 64 * GP; LAS bf16_t* KEf = QEb + 64 * GP; LAS bf16_t* KEb = KEf + 64 * GP;
    LAS bf16_t* VT = KEb + 64 * GP;
    LAS bf16_t* ATT = VT + 128 * GP + wave * (16 * GP);
    LAS float* RS = (LAS float*)(lds + 2 * (4 * 64 * GP + 128 * GP + 8 * 16 * GP));
    const float* P = (const float*)(p.ws + WS_P);
    const float* BF = (const float*)(p.ws + WS_OF); const float* BB = (const float*)(p.ws + WS_OB);
    const bf16_t* SST = (const bf16_t*)(p.ws + WS_SST); bf16_t* MIX = (bf16_t*)(p.ws + WS_MIX);
    const float* nw = p.in[I_GNORM] + l * 128;
    const int fr = lane & 15, fq = lane >> 4, it = wave >> 1, vh = wave & 1;
    for (int item = bid; item < GLA_ITEMS; item += G) {
        const int cid = item >> 2, h = item & 3, row0 = chunk_row0(cid);
#pragma unroll 1
        for (int j = 0; j < 8; ++j) { const int e = tid + NTHREADS * j, i = e >> 6, k = e & 63;
            const size_t r = (size_t)(row0 + i);
            const float bf = BF[r * 256 + h * 64 + k], bb = BB[r * 256 + h * 64 + k];
            const float q = P[r * INWP + C_GQ + h * 64 + k] * 0.125f, kk = P[r * INWP + C_GK + h * 64 + k];
            QEf[i * GP + k] = (bf16_t)f2bf(q * expf(bf)); KEf[i * GP + k] = (bf16_t)f2bf(kk * expf(-bf));
            QEb[i * GP + k] = (bf16_t)f2bf(q * expf(bb)); KEb[i * GP + k] = (bf16_t)f2bf(kk * expf(-bb)); }
#pragma unroll 1
        for (int j = 0; j < 16; ++j) { const int e = tid + NTHREADS * j, i = e >> 7, v = e & 127;
            VT[v * GP + i] = (bf16_t)f2bf(P[(size_t)(row0 + i) * INWP + C_GV + h * 128 + v]); }
        __syncthreads();
        f32x4 acc[4];
#pragma unroll
        for (int vt = 0; vt < 4; ++vt) acc[vt] = (f32x4){0.f, 0.f, 0.f, 0.f};
#pragma unroll
        for (int dir = 0; dir < 2; ++dir) {
            const LAS bf16_t* QE = dir ? QEb : QEf; const LAS bf16_t* KE = dir ? KEb : KEf;
            bf16x8 qa[2];
#pragma unroll
            for (int ks = 0; ks < 2; ++ks) qa[ks] = *(const LAS bf16x8*)(QE + (it * 16 + fr) * GP + ks * 32 + fq * 8);
#pragma unroll
            for (int jt = 0; jt < 4; ++jt) { f32x4 a = (f32x4){0.f, 0.f, 0.f, 0.f};
#pragma unroll
                for (int ks = 0; ks < 2; ++ks) { const bf16x8 kb = *(const LAS bf16x8*)(KE + (jt * 16 + fr) * GP + ks * 32 + fq * 8); a = __builtin_amdgcn_mfma_f32_16x16x32_bf16(qa[ks], kb, a, 0, 0, 0); }
#pragma unroll
                for (int g = 0; g < 4; ++g) { const int ii = it * 16 + fq * 4 + g, jj = jt * 16 + fr; const bool keep = dir ? (jj >= ii) : (jj <= ii);
                    ATT[(fq * 4 + g) * GP + jt * 16 + fr] = (bf16_t)f2bf(keep ? a[g] : 0.f); } }
            LDS_FENCE();
            const bf16_t* Sg = SST + ((size_t)item * 2 + dir) * 8192;
#pragma unroll
            for (int ks = 0; ks < 2; ++ks) { const bf16x8 aa = *(const LAS bf16x8*)(ATT + fr * GP + ks * 32 + fq * 8);
#pragma unroll
                for (int vt = 0; vt < 4; ++vt) { const int v = (vh * 4 + vt) * 16 + fr;
                    const bf16x8 vb = *(const LAS bf16x8*)(VT + v * GP + ks * 32 + fq * 8);
                    acc[vt] = __builtin_amdgcn_mfma_f32_16x16x32_bf16(aa, vb, acc[vt], 0, 0, 0);
                    const bf16x8 sb = *(const bf16x8*)(Sg + v * 64 + ks * 32 + fq * 8);
                    acc[vt] = __builtin_amdgcn_mfma_f32_16x16x32_bf16(qa[ks], sb, acc[vt], 0, 0, 0); } }
            LDS_FENCE();
        }
        float ss[4];
#pragma unroll
        for (int g = 0; g < 4; ++g) { float t = 0.f;
#pragma unroll
            for (int vt = 0; vt < 4; ++vt) t += acc[vt][g] * acc[vt][g];
            t += __shfl_xor(t, 1); t += __shfl_xor(t, 2); t += __shfl_xor(t, 4); t += __shfl_xor(t, 8); ss[g] = t; }
        if (fr == 0) {
#pragma unroll
            for (int g = 0; g < 4; ++g) RS[(it * 16 + fq * 4 + g) * 2 + vh] = ss[g]; }
        __syncthreads();
#pragma unroll
        for (int g = 0; g < 4; ++g) { const int i = it * 16 + fq * 4 + g; const float tot = RS[i * 2] + RS[i * 2 + 1];
            const float rs = 1.0f / sqrtf(tot * (1.0f / 128.0f) + LN_EPS); const size_t r = (size_t)(row0 + i);
#pragma unroll
            for (int vt = 0; vt < 4; ++vt) { const int v = (vh * 4 + vt) * 16 + fr; const float gt = P[r * INWP + C_GG + h * 128 + v];
                MIX[r * DM + 512 + h * 128 + v] = (bf16_t)f2bf(acc[vt][g] * rs * nw[v] * silu_f(gt)); } }
        __syncthreads();
    }
}

__device__ __forceinline__ void ln_row(f32x4 (&v)[8], const float* lg, const float* lb, int lane) {
    float s = 0.f;
#pragma unroll
    for (int j = 0; j < 8; ++j) s += (v[j].x + v[j].y) + (v[j].z + v[j].w);
    const float mean = wave_sum(s) * (1.0f / DM);
    float s2 = 0.f;
#pragma unroll
    for (int j = 0; j < 8; ++j) { v[j] = v[j] - mean; s2 += (v[j].x * v[j].x + v[j].y * v[j].y) + (v[j].z * v[j].z + v[j].w * v[j].w); }
    const float rstd = 1.0f / sqrtf(wave_sum(s2) * (1.0f / DM) + LN_EPS);
#pragma unroll
    for (int j = 0; j < 8; ++j) { const int c = lane * 4 + 256 * j; const f32x4 g = *(const f32x4*)(lg + c), b = *(const f32x4*)(lb + c); v[j] = v[j] * rstd * g + b; }
}

__device__ __forceinline__ void phase_ln1(const Params& p, int l, int lane, int wave, int bid, int G) {
    const int gw = bid * NWAVES + wave, NGW = G * NWAVES;
    const float* MOD = (const float*)(p.ws + WS_MOD); const float* Y = (const float*)(p.ws + WS_Y);
    float* XL = (float*)(p.ws + WS_XL); bf16_t* HB = (bf16_t*)(p.ws + WS_HB);
    const float* lg = p.in[I_LNG] + (size_t)(l * 2 + 0) * DM; const float* lb = p.in[I_LNB] + (size_t)(l * 2 + 0) * DM;
    for (int r = gw; r < TA; r += NGW) {
        const float* mod = MOD + (size_t)(l * 3 + row_stream(r)) * 6 * DM;
        const float* xr = xsrc(p, l, r);
        f32x4 v[8];
#pragma unroll
        for (int j = 0; j < 8; ++j) { const int c = lane * 4 + 256 * j; const f32x4 x = *(const f32x4*)(xr + c), y = *(const f32x4*)(Y + (size_t)r * DM + c), g = *(const f32x4*)(mod + 2 * DM + c); v[j] = x * DN_ALPHA + g * y; }
        ln_row(v, lg, lb, lane);
#pragma unroll
        for (int j = 0; j < 8; ++j) { const int c = lane * 4 + 256 * j; *(f32x4*)(XL + (size_t)r * DM + c) = v[j];
            const f32x4 sh = *(const f32x4*)(mod + 3 * DM + c), s = *(const f32x4*)(mod + 4 * DM + c);
            u32x2 o; o.x = pk2(v[j].x * (1.f + s.x) + sh.x, v[j].y * (1.f + s.y) + sh.y); o.y = pk2(v[j].z * (1.f + s.z) + sh.z, v[j].w * (1.f + s.w) + sh.w);
            *(u32x2*)(HB + (size_t)r * DM + c) = o; }
    }
}

constexpr int SKP = 136;
__device__ __forceinline__ void group16_argmax(float& m, int& idx) {
#pragma unroll
    for (int o = 1; o < 16; o <<= 1) { const float om = __shfl_xor(m, o); const int oi = __shfl_xor(idx, o); if (om > m || (om == m && oi < idx)) { m = om; idx = oi; } }
}
__device__ __forceinline__ void peer_retrieve(const Params& p, int l, LAS unsigned char* lds, int tid, int lane, int wave, int bid, int G, int ntok) {
    LAS bf16_t* SK = (LAS bf16_t*)lds;
    const bf16_t* SUBB = (const bf16_t*)(p.ws + WS_SUBB) + (size_t)l * 2 * 128 * 128;
#pragma unroll 1
    for (int j = 0; j < 8; ++j) { const int vv = tid + NTHREADS * j, row = vv >> 4, c = vv & 15; *(LAS u32x4*)(SK + row * SKP + c * 8) = *(const u32x4*)(SUBB + row * 128 + c * 8); }
    __syncthreads();
    const bf16_t* QP = (const bf16_t*)(p.ws + WS_QP);
    int* EIDX = (int*)(p.ws + WS_EIDX); float* EGATE = (float*)(p.ws + WS_EGATE);
    const int gw = bid * NWAVES + wave, NGW = G * NWAVES, fr = lane & 15, fq = lane >> 4, gbase = lane & 48;
    const int nitems = (ntok / 16) * 8;
    for (int item = gw; item < nitems; item += NGW) {
        const int tile = item >> 3, h = item & 7;
        float tvp[2][4]; int tip[2][4];
#pragma unroll
        for (int pp = 0; pp < 2; ++pp) {
            asm volatile("" ::: "memory"); __builtin_amdgcn_sched_barrier(0);
            f32x4 acc[8];
#pragma unroll
            for (int kt = 0; kt < 8; ++kt) acc[kt] = (f32x4){0.f, 0.f, 0.f, 0.f};
#pragma unroll
            for (int ks = 0; ks < 4; ++ks) { const bf16x8 a = *(const bf16x8*)(QP + (size_t)(tile * 16 + fr) * DM + h * 256 + pp * 128 + ks * 32 + fq * 8);
#pragma unroll
                for (int kt = 0; kt < 8; ++kt) { const bf16x8 bb = *(const LAS bf16x8*)(SK + (pp * 128 + kt * 16 + fr) * SKP + ks * 32 + fq * 8); acc[kt] = __builtin_amdgcn_mfma_f32_16x16x32_bf16(a, bb, acc[kt], 0, 0, 0); } }
#pragma unroll
            for (int g = 0; g < 4; ++g) {
                float v[8];
#pragma unroll
                for (int kt = 0; kt < 8; ++kt) v[kt] = acc[kt][g];
                float tv = 0.f; int ti = 0;
#pragma unroll 1
                for (int it = 0; it < 16; ++it) {
                    float m = v[0]; int mi = 0;
#pragma unroll
                    for (int kt = 1; kt < 8; ++kt) if (v[kt] > m) { m = v[kt]; mi = kt; }
                    int idx = mi * 16 + fr;
                    group16_argmax(m, idx);
                    if (fr == it) { tv = m; ti = idx; }
                    const int wk = (idx & 15) == fr ? (idx >> 4) : -1;
#pragma unroll
                    for (int kt = 0; kt < 8; ++kt) if (kt == wk) v[kt] = -INFINITY;
                }
                tvp[pp][g] = tv; tip[pp][g] = ti;
            }
        }
#pragma unroll
        for (int g = 0; g < 4; ++g) {
            const float a = tvp[0][g], b = tvp[1][g];
            int ptr = 0; float bv = 0.f; int bc = 0;
#pragma unroll 1
            for (int it = 0; it < 16; ++it) {
                const float bj = __shfl(b, gbase + (ptr & 15));
                float m = ptr < 16 ? a + bj : -INFINITY; int idx = fr * 16 + (ptr & 15);
                group16_argmax(m, idx);
                if (fr == it) { bv = m; bc = idx; }
                if ((idx >> 4) == fr) ++ptr;
            }
            const int i1 = __shfl(tip[0][g], gbase + (bc >> 4)), i2 = __shfl(tip[1][g], gbase + (bc & 15));
            const float mx = __shfl(bv, gbase);
            const float ex = expf(bv - mx);
            float sm = ex;
#pragma unroll
            for (int o = 1; o < 16; o <<= 1) sm += __shfl_xor(sm, o);
            const size_t tok = (size_t)tile * 16 + fq * 4 + g;
            EIDX[tok * 128 + h * 16 + fr] = i1 * 128 + i2; EGATE[tok * 128 + h * 16 + fr] = ex / sm;
        }
    }
}

__device__ __forceinline__ float bflo(unsigned w) { return __builtin_bit_cast(float, w << 16); }
__device__ __forceinline__ float bfhi(unsigned w) { return __builtin_bit_cast(float, w & 0xffff0000u); }
typedef float f32x2v __attribute__((ext_vector_type(2)));
constexpr int PG = 4;
__device__ __forceinline__ void phase_peer(const Params& p, int l, int lane, int wave, int bid, int G) {
    const int gw = bid * NWAVES + wave, NGW = G * NWAVES;
    const float* MOD = (const float*)(p.ws + WS_MOD);
    float* XL = (float*)(p.ws + WS_XL); bf16_t* HB = (bf16_t*)(p.ws + WS_HB);
    const float* lg = p.in[I_LNG] + (size_t)(l * 2 + 1) * DM; const float* lb = p.in[I_LNB] + (size_t)(l * 2 + 1) * DM;
    const unsigned char* UB = p.ws + WS_UB + (size_t)l * NEXP * DM; const unsigned char* VB = p.ws + WS_VB + (size_t)l * NEXP * DM;
    const float* USC = (const float*)(p.ws + WS_USC) + (size_t)l * NEXP; const float* VSC = (const float*)(p.ws + WS_VSC) + (size_t)l * NEXP;
    const int* EIDX = (const int*)(p.ws + WS_EIDX); const float* EGATE = (const float*)(p.ws + WS_EGATE);
    const bool last = (l == DEPTH - 1);
    const int nrows = last ? TL : TA;
    for (int r = gw; r < nrows; r += NGW) {
        const float* mod = MOD + (size_t)(l * 3 + row_stream(r)) * 6 * DM;
        float hf[2][16];
#pragma unroll
        for (int q = 0; q < 2; ++q)
#pragma unroll
            for (int hh = 0; hh < 2; ++hh) { const u32x4 w = *(const u32x4*)(HB + (size_t)r * DM + q * 1024 + lane * 16 + hh * 8);
                hf[q][hh * 8 + 0] = bflo(w.x); hf[q][hh * 8 + 1] = bfhi(w.x); hf[q][hh * 8 + 2] = bflo(w.y); hf[q][hh * 8 + 3] = bfhi(w.y);
                hf[q][hh * 8 + 4] = bflo(w.z); hf[q][hh * 8 + 5] = bfhi(w.z); hf[q][hh * 8 + 6] = bflo(w.w); hf[q][hh * 8 + 7] = bfhi(w.w); }
        const int e0 = EIDX[(size_t)r * 128 + lane], e1 = EIDX[(size_t)r * 128 + 64 + lane];
        const float g0 = EGATE[(size_t)r * 128 + lane], g1 = EGATE[(size_t)r * 128 + 64 + lane];
        const float su0 = USC[e0], su1 = USC[e1], sv0 = VSC[e0], sv1 = VSC[e1];
        float w0 = 0.f, w1 = 0.f;
#pragma unroll 1
        for (int j0 = 0; j0 < 128; j0 += PG) {
            u32x4 ur[PG][2];
#pragma unroll
            for (int c = 0; c < PG; ++c) { const int j = j0 + c; const int e = j < 64 ? __builtin_amdgcn_readlane(e0, j) : __builtin_amdgcn_readlane(e1, j - 64);
                const unsigned char* up = UB + (size_t)e * DM + lane * 16;
                ur[c][0] = *(const u32x4*)(up); ur[c][1] = *(const u32x4*)(up + 1024); }
            float d[PG];
#pragma unroll
            for (int c = 0; c < PG; ++c) { float a = 0.f;
#pragma unroll
                for (int q = 0; q < 2; ++q) { const u32x4 w = ur[c][q]; const unsigned ww[4] = {w.x, w.y, w.z, w.w};
#pragma unroll
                    for (int t = 0; t < 4; ++t) { const f32x2v lo = __builtin_amdgcn_cvt_pk_f32_fp8((int)ww[t], false), hi = __builtin_amdgcn_cvt_pk_f32_fp8((int)ww[t], true);
                        a += lo.x * hf[q][t * 4 + 0]; a += lo.y * hf[q][t * 4 + 1]; a += hi.x * hf[q][t * 4 + 2]; a += hi.y * hf[q][t * 4 + 3]; } }
                d[c] = a; }
#pragma unroll
            for (int o = 1; o < 64; o <<= 1) {
#pragma unroll
                for (int c = 0; c < PG; ++c) d[c] += __shfl_xor(d[c], o); }
#pragma unroll
            for (int c = 0; c < PG; ++c) { const int j = j0 + c;
                if (j < 64) { if (lane == j) w0 = gelu_f(d[c] * su0) * g0 * sv0; } else { if (lane == j - 64) w1 = gelu_f(d[c] * su1) * g1 * sv1; } }
        }
        float yv[2][16];
#pragma unroll
        for (int q = 0; q < 2; ++q)
#pragma unroll
            for (int i = 0; i < 16; ++i) yv[q][i] = 0.f;
#pragma unroll 1
        for (int j0 = 0; j0 < 128; j0 += PG) {
            u32x4 vr[PG][2]; float wj[PG];
#pragma unroll
            for (int c = 0; c < PG; ++c) { const int j = j0 + c; const int e = j < 64 ? __builtin_amdgcn_readlane(e0, j) : __builtin_amdgcn_readlane(e1, j - 64);
                wj[c] = __builtin_bit_cast(float, j < 64 ? __builtin_amdgcn_readlane(__builtin_bit_cast(int, w0), j) : __builtin_amdgcn_readlane(__builtin_bit_cast(int, w1), j - 64));
                const unsigned char* vp = VB + (size_t)e * DM + lane * 16;
                vr[c][0] = *(const u32x4*)(vp); vr[c][1] = *(const u32x4*)(vp + 1024); }
#pragma unroll
            for (int c = 0; c < PG; ++c)
#pragma unroll
                for (int q = 0; q < 2; ++q) { const u32x4 w = vr[c][q]; const unsigned ww[4] = {w.x, w.y, w.z, w.w};
#pragma unroll
                    for (int t = 0; t < 4; ++t) { const f32x2v lo = __builtin_amdgcn_cvt_pk_f32_fp8((int)ww[t], false), hi = __builtin_amdgcn_cvt_pk_f32_fp8((int)ww[t], true);
                        yv[q][t * 4 + 0] += wj[c] * lo.x; yv[q][t * 4 + 1] += wj[c] * lo.y; yv[q][t * 4 + 2] += wj[c] * hi.x; yv[q][t * 4 + 3] += wj[c] * hi.y; } }
        }
        const float* xr = XL + (size_t)r * DM;
        float s = 0.f;
#pragma unroll
        for (int q = 0; q < 2; ++q)
#pragma unroll
            for (int t = 0; t < 4; ++t) { const int c = q * 1024 + lane * 16 + t * 4;
                const f32x4 x0 = *(const f32x4*)(xr + c), ga = *(const f32x4*)(mod + 5 * DM + c);
                yv[q][t * 4 + 0] = x0.x * DN_ALPHA + ga.x * yv[q][t * 4 + 0]; yv[q][t * 4 + 1] = x0.y * DN_ALPHA + ga.y * yv[q][t * 4 + 1];
                yv[q][t * 4 + 2] = x0.z * DN_ALPHA + ga.z * yv[q][t * 4 + 2]; yv[q][t * 4 + 3] = x0.w * DN_ALPHA + ga.w * yv[q][t * 4 + 3];
                s += (yv[q][t * 4 + 0] + yv[q][t * 4 + 1]) + (yv[q][t * 4 + 2] + yv[q][t * 4 + 3]); }
        const float mean = wave_sum(s) * (1.0f / DM);
        float s2 = 0.f;
#pragma unroll
        for (int q = 0; q < 2; ++q)
#pragma unroll
            for (int i = 0; i < 16; ++i) { yv[q][i] -= mean; s2 += yv[q][i] * yv[q][i]; }
        const float rstd = 1.0f / sqrtf(wave_sum(s2) * (1.0f / DM) + LN_EPS);
        float* dst = (last ? p.out : XL) + (size_t)r * DM;
        const float* modn = MOD + (size_t)((last ? l : l + 1) * 3 + row_stream(r)) * 6 * DM;
#pragma unroll
        for (int q = 0; q < 2; ++q)
#pragma unroll
            for (int t = 0; t < 4; t += 2) { const int c = q * 1024 + lane * 16 + t * 4;
                const f32x4 ga = *(const f32x4*)(lg + c), gb = *(const f32x4*)(lg + c + 4), ba = *(const f32x4*)(lb + c), bb = *(const f32x4*)(lb + c + 4);
                f32x4 o0, o1;
                o0.x = yv[q][t * 4 + 0] * rstd * ga.x + ba.x; o0.y = yv[q][t * 4 + 1] * rstd * ga.y + ba.y; o0.z = yv[q][t * 4 + 2] * rstd * ga.z + ba.z; o0.w = yv[q][t * 4 + 3] * rstd * ga.w + ba.w;
                o1.x = yv[q][t * 4 + 4] * rstd * gb.x + bb.x; o1.y = yv[q][t * 4 + 5] * rstd * gb.y + bb.y; o1.z = yv[q][t * 4 + 6] * rstd * gb.z + bb.z; o1.w = yv[q][t * 4 + 7] * rstd * gb.w + bb.w;
                *(f32x4*)(dst + c) = o0; *(f32x4*)(dst + c + 4) = o1;
                if (!last) {
                    const f32x4 sa = *(const f32x4*)(modn + c), sb = *(const f32x4*)(modn + c + 4), ca = *(const f32x4*)(modn + DM + c), cb = *(const f32x4*)(modn + DM + c + 4);
                    u32x4 o; o.x = pk2(o0.x * (1.f + ca.x) + sa.x, o0.y * (1.f + ca.y) + sa.y); o.y = pk2(o0.z * (1.f + ca.z) + sa.z, o0.w * (1.f + ca.w) + sa.w);
                    o.z = pk2(o1.x * (1.f + cb.x) + sb.x, o1.y * (1.f + cb.y) + sb.y); o.w = pk2(o1.z * (1.f + cb.z) + sb.z, o1.w * (1.f + cb.w) + sb.w);
                    *(u32x4*)(HB + (size_t)r * DM + c) = o; }
            }
    }
}

__device__ __forceinline__ void gemm_rows(LAS unsigned char* lds, const bf16_t* A, const bf16_t* Bt, float* C, bool with_ctx, int G, int bid) {
    { pg8::Gemm g{A, Bt, TL, DM, DM}; pg8::StaticOrder S; S.init(TL, DM, G, bid); pg8::EpiF32 E{C, DM, nullptr};
      pg8::gemm_phase<pg8::EpiF32, pg8::StaticOrder, PG8_ALIGN, PG8_SP2>(lds, g, S, E); }
    if (with_ctx) { pg8::Gemm g{A + (size_t)TL * DM, Bt, TC, DM, DM}; pg8::StaticOrder S; S.init(TC, DM, G, bid); pg8::EpiF32 E{C + (size_t)TL * DM, DM, nullptr};
      pg8::gemm_phase<pg8::EpiF32, pg8::StaticOrder, PG8_ALIGN, PG8_SP2>(lds, g, S, E); }
}
__device__ __forceinline__ void gemm_rows_bf16(LAS unsigned char* lds, const bf16_t* A, const bf16_t* Bt, bf16_t* C, bool with_ctx, int G, int bid) {
    { pg8::Gemm g{A, Bt, TL, DM, DM}; pg8::StaticOrder S; S.init(TL, DM, G, bid); pg8::EpiBf16<0> E{C, DM, nullptr, 0, 0, 1.f};
      pg8::gemm_phase<pg8::EpiBf16<0>, pg8::StaticOrder, PG8_ALIGN, PG8_SP2>(lds, g, S, E); }
    if (with_ctx) { pg8::Gemm g{A + (size_t)TL * DM, Bt, TC, DM, DM}; pg8::StaticOrder S; S.init(TC, DM, G, bid); pg8::EpiBf16<0> E{C + (size_t)TL * DM, DM, nullptr, 0, 0, 1.f};
      pg8::gemm_phase<pg8::EpiBf16<0>, pg8::StaticOrder, PG8_ALIGN, PG8_SP2>(lds, g, S, E); }
}

constexpr int PH_PER_LAYER = 9, N_PHASES = 2 + DEPTH * PH_PER_LAYER;
__global__ void __launch_bounds__(NTHREADS, 2) fwd_kernel(Params p) {
    extern __shared__ __attribute__((aligned(16))) unsigned char lds_raw[];
    LAS unsigned char* lds = (LAS unsigned char*)lds_raw;
    const int tid = threadIdx.x, lane = tid & 63, wave = __builtin_amdgcn_readfirstlane(tid >> 6), bid = blockIdx.x, G = gridDim.x;
    volatile LAS unsigned* MISC = (volatile LAS unsigned*)(lds + MISC_OFF);
    if (tid < 32) MISC[tid] = 0u;
    __syncthreads();
    const int lo = p.ph_lo, hi = p.ph_hi;
    unsigned* ctl = (unsigned*)(p.ws + WS_CTL);
    XcdBarrier bar; bar.bar = ctl + CW_BAR; bar.x = 0; bar.st = MISC + 8;
    if (hi - lo > 1) bar = xcd_barrier_post(ctl + CW_BAR, MISC + 8);
#define IN(k) (lo <= (k) && (k) < hi)
#define SEAM(k) do { if (IN(k) && IN((k) + 1)) xcd_barrier(bar); } while (0)
    const int NGW = G * NWAVES;
#define FRESH() int tid_ = tid, lane_ = lane, wave_ = wave, bid_ = bid; asm volatile("" : "+v"(tid_), "+v"(lane_), "+s"(wave_), "+s"(bid_)); const int gw_ = bid_ * NWAVES + wave_; (void)tid_; (void)gw_
    if (IN(0)) { FRESH(); phase_prologue(p, lds, tid_, lane_, wave_, bid_, G); }
    SEAM(0);
    if (IN(1)) { FRESH(); phase_modulate0(p, lane_, wave_, bid_, G); }
    SEAM(1);
    for (int l = 0; l < DEPTH; ++l) {
        const int b0 = 2 + l * PH_PER_LAYER;
        if (IN(b0 + 0)) { FRESH();
            pg8::Gemm g{(const bf16_t*)(p.ws + WS_HB), (const bf16_t*)(p.ws + WS_WIN) + (size_t)l * INWP * DM, TA, INWP, DM}; pg8::StaticOrder S; S.init(TA, INWP, G, bid_);
            pg8::EpiF32 E{(float*)(p.ws + WS_P), INWP, nullptr};
            pg8::gemm_phase<pg8::EpiF32, pg8::StaticOrder, PG8_ALIGN, PG8_SP2>(lds, g, S, E); }
        SEAM(b0 + 0);
        if (IN(b0 + 1)) { { FRESH(); gla_g1(p, l, lds, tid_, lane_, wave_, bid_, G); } { FRESH(); phase_post_in(p, l, lane_, wave_, bid_, G); } }
        SEAM(b0 + 1);
        if (IN(b0 + 2)) { { FRESH(); gla_g2(p, tid_, bid_, G); } { FRESH(); phase_mixers(p, l, lds, tid_, lane_, wave_, bid_, G); } }
        SEAM(b0 + 2);
        if (IN(b0 + 3)) { FRESH(); gla_g3(p, l, lds, tid_, lane_, wave_, bid_, G); }
        SEAM(b0 + 3);
        if (IN(b0 + 4)) { FRESH();
            gemm_rows(lds, (const bf16_t*)(p.ws + WS_MIX), (const bf16_t*)(p.ws + WS_WOUT) + (size_t)l * DM * DM, (float*)(p.ws + WS_Y), l < DEPTH - 1, G, bid_); }
        SEAM(b0 + 4);
        if (IN(b0 + 5)) { FRESH(); phase_ln1(p, l, lane_, wave_, bid_, G); }
        SEAM(b0 + 5);
        if (IN(b0 + 6)) { FRESH();
            gemm_rows_bf16(lds, (const bf16_t*)(p.ws + WS_HB), (const bf16_t*)(p.ws + WS_WQ) + (size_t)l * DM * DM, (bf16_t*)(p.ws + WS_QP), l < DEPTH - 1, G, bid_); }
        SEAM(b0 + 6);
        if (IN(b0 + 7)) { FRESH(); peer_retrieve(p, l, lds, tid_, lane_, wave_, bid_, G, l < DEPTH - 1 ? TA : TL); }
        SEAM(b0 + 7);
        if (IN(b0 + 8)) { FRESH(); phase_peer(p, l, lane_, wave_, bid_, G); }
        SEAM(b0 + 8);
    }
#undef FRESH
#undef IN
#undef SEAM
}

#ifndef MK_PER_PHASE
#define MK_PER_PHASE 0
#endif
extern "C" void kernel_launch(void* const* d_in, const int* in_sizes, int n_in, void* d_out, int out_size, void* d_ws, size_t ws_size, hipStream_t stream) {
    static int grid = 0;
    if (grid == 0) {
        if (n_in != 19 || out_size != TL * DM || ws_size < WS_END) { fprintf(stderr, "kernel_launch: unexpected shapes (n_in %d out %d ws %zu)\n", n_in, out_size, ws_size); grid = -1; return; }
        int dev = 0, cus = 0;
        if (hipGetDevice(&dev) != hipSuccess || hipDeviceGetAttribute(&cus, hipDeviceAttributeMultiprocessorCount, dev) != hipSuccess) { grid = -1; return; }
        if (hipFuncSetAttribute((const void*)fwd_kernel, hipFuncAttributeMaxDynamicSharedMemorySize, LDS_BYTES) != hipSuccess) { fprintf(stderr, "kernel_launch: hipFuncSetAttribute failed\n"); grid = -1; return; }
        int per_cu = 0;
        (void)hipOccupancyMaxActiveBlocksPerMultiprocessor(&per_cu, (const void*)fwd_kernel, NTHREADS, LDS_BYTES);
        (void)hipGetLastError();
        if (per_cu < 1) fprintf(stderr, "kernel_launch: occupancy query reports %d blocks per CU\n", per_cu);
        grid = cus;
    }
    if (grid < 0) return;
    (void)hipMemsetAsync((char*)d_ws + WS_CTL, 0, CTL_ZERO_BYTES, stream);
    Params p{};
    for (int i = 0; i < 19; ++i) p.in[i] = (const float*)d_in[i];
    p.out = (float*)d_out; p.ws = (unsigned char*)d_ws;
#if MK_PER_PHASE
    for (int ph = 0; ph < N_PHASES; ++ph) { p.ph_lo = ph; p.ph_hi = ph + 1; hipLaunchKernelGGL(fwd_kernel, dim3(grid), dim3(NTHREADS), LDS_BYTES, stream, p); }
#else
    p.ph_lo = 0; p.ph_hi = N_PHASES;
    hipLaunchKernelGGL(fwd_kernel, dim3(grid), dim3(NTHREADS), LDS_BYTES, stream, p);
#endif
}
```

```cpp
#include <hip/hip_runtime.h>
#include <cstdio>
#include <cstdint>

#define LAS __attribute__((address_space(3)))
typedef unsigned short bf16_t;
typedef short bf16x8 __attribute__((ext_vector_type(8)));
typedef float f32x4 __attribute__((ext_vector_type(4)));
typedef unsigned u32x4 __attribute__((ext_vector_type(4)));
typedef unsigned u32x2 __attribute__((ext_vector_type(2)));
typedef unsigned u32x6 __attribute__((ext_vector_type(6)));
typedef float f32x2v __attribute__((ext_vector_type(2)));
typedef float f32x16 __attribute__((ext_vector_type(16)));
typedef float f32x32 __attribute__((ext_vector_type(32)));

constexpr int DM = 2048, NBATCH = 2, SEQ = 8192, DEPTH = 4, CTXL = 256;
constexpr int TL = NBATCH * SEQ, TC = NBATCH * CTXL, TA = TL + TC;
constexpr int INW = 4640, INWP = 4864;
constexpr int C_CX = 0, C_CB = 512, C_CC = 1024, C_GQ = 1536, C_GK = 1792, C_GV = 2048, C_GG = 2560, C_LRF = 3072, C_LRB = 3088,
              C_SQ = 3104, C_SK = 4128, C_SV = 4384;
constexpr int NEXP = 16384;
constexpr int ROWB = 1536;
constexpr int ROWB4 = 1088;
#ifndef TBL_U_FP4
#define TBL_U_FP4 1
#endif
#ifndef TBL_U_I4
#define TBL_U_I4 (TBL_U_FP4)
#endif
constexpr unsigned I4_BASE = 103u << 23;
#ifndef U_ROWSCALE
#define U_ROWSCALE (TBL_U_I4)
#endif
#ifndef V_ROWSCALE
#define V_ROWSCALE 1
#endif
constexpr int ROWB_U = U_ROWSCALE ? 1024 : (TBL_U_FP4 ? ROWB4 : ROWB), ROWB_V = V_ROWSCALE ? 1024 : ROWB4;
constexpr float DN_ALPHA = 1.6817928305074290f;
constexpr float LN_EPS = 1e-6f;
constexpr int NWAVES = 8, NTHREADS = 512;

constexpr size_t MiB = 1u << 20;
constexpr size_t WS_CTL = 0, CTL_ZERO_BYTES = 256 * 1024;
constexpr size_t WS_MOD = 2 * MiB;
constexpr size_t WS_WIN = 4 * MiB;
constexpr size_t WS_WOUT = 80 * MiB;
constexpr size_t WS_WQ = 112 * MiB;
constexpr size_t WS_XL = 144 * MiB;
constexpr size_t WS_HB = 276 * MiB;
constexpr size_t WS_P = 342 * MiB;
constexpr size_t WS_QR = 656 * MiB;
constexpr size_t WS_KR = 720 * MiB;
constexpr size_t WS_ALF = 736 * MiB;
constexpr size_t WS_ALB = 753 * MiB;
constexpr size_t WS_OF = 770 * MiB;
constexpr size_t WS_OB = 803 * MiB;
constexpr size_t WS_MIX = 836 * MiB;
constexpr size_t WS_Y = 902 * MiB;
constexpr size_t WS_QP = 1034 * MiB;
constexpr size_t WS_DELTA = 1166 * MiB;
constexpr size_t WS_DEC = 1233 * MiB;
constexpr size_t WS_SST = 1234 * MiB;
constexpr size_t WS_UB = 1268 * MiB;
constexpr size_t WS_VB = 1524 * MiB;
constexpr size_t WS_EIDX = 1780 * MiB;
constexpr size_t WS_EGATE = 1789 * MiB;
constexpr size_t WS_SUBB = 1798 * MiB;
constexpr size_t WS_USC = 1799 * MiB;
constexpr size_t WS_VSC = 1799 * MiB + 512 * 1024;
constexpr size_t WS_YPART = 1800 * MiB;
constexpr size_t WS_QPART = 1832 * MiB;
constexpr size_t WS_XM = 1864 * MiB;
constexpr size_t WS_END = 1996 * MiB;
constexpr int GLA_ITEMS = (TA / 64) * 4;
static_assert(WS_DELTA + (size_t)GLA_ITEMS * 2 * 8192 * 4 <= WS_DEC && WS_DEC + (size_t)GLA_ITEMS * 2 * 64 * 4 <= WS_SST && WS_SST + (size_t)GLA_ITEMS * 2 * 8192 * 2 <= WS_END, "map");
static_assert(WS_WIN + (size_t)4 * INWP * DM * 2 <= WS_WOUT, "map");
static_assert(WS_P + (size_t)TA * INWP * 2 <= WS_QR, "map");
static_assert(WS_XL + (size_t)TA * DM * 4 <= WS_HB, "map");
constexpr int CW_BAR = 4096;
constexpr int CW_QUEUE = 8192;
constexpr int LDS_BYTES = 163840;
constexpr int MISC_OFF = 163840 - 512;

#define XB_TMO      128
#define XB_XCNT(j)  (256  + 64 * (j))
#define XB_XSUB(j)  (1280 + 64 * (j))
#define XB_XGEN(j)  (2304 + 64 * (j))
#define XB_TOP      3328
#define XB_TOPGEN   3392
#define XCD_BAR_WORDS 3456
#define XB_SPIN_CAP (1u << 18)
__device__ __forceinline__ unsigned xb_ld(unsigned* p)              { return __hip_atomic_load(p, __ATOMIC_RELAXED, __HIP_MEMORY_SCOPE_AGENT); }
__device__ __forceinline__ unsigned xb_add(unsigned* p, unsigned v) { return __hip_atomic_fetch_add(p, v, __ATOMIC_RELAXED, __HIP_MEMORY_SCOPE_AGENT); }
__device__ __forceinline__ unsigned xb_xcc_id() { return (unsigned)__builtin_amdgcn_s_getreg((3 << 11) | 20) & 0xFu; }
#define XB_SPIN(cond, bar) do { unsigned _sp = 0; while (cond) { __builtin_amdgcn_s_sleep(1); \
    if ((++_sp & 255u) == 0u) { if (xb_ld(&(bar)[XB_TMO])) break; if (_sp > XB_SPIN_CAP) { atomicAdd(&(bar)[XB_TMO], 1u); break; } } } } while (0)
struct XcdBarrier { unsigned* bar; unsigned x; volatile LAS unsigned* st; };
__device__ __forceinline__ XcdBarrier xcd_barrier_post(unsigned* bar, volatile LAS unsigned* st) {
    XcdBarrier b; b.bar = bar; b.x = xb_xcc_id(); b.st = st;
    if (threadIdx.x == 0) (void)xb_add(&bar[XB_XCNT(b.x)], 1u);
    return b;
}
__device__ __forceinline__ void xcd_barrier_complete(unsigned* bar, unsigned x, unsigned& nloc, unsigned& nx) {
    const unsigned G = gridDim.x * gridDim.y * gridDim.z;
    unsigned sum, cnt, mine, sp = 0u;
    for (;;) {
        sum = 0u; cnt = 0u; mine = 0u;
#pragma unroll
        for (unsigned j = 0; j < 16; ++j) { const unsigned c = xb_ld(&bar[XB_XCNT(j)]); sum += c; cnt += (c > 0u) ? 1u : 0u; mine = (j == x) ? c : mine; }
        if (sum == G) break;
        __builtin_amdgcn_s_sleep(1);
        if ((++sp & 255u) == 0u) { if (xb_ld(&bar[XB_TMO])) break; if (sp > XB_SPIN_CAP) { atomicAdd(&bar[XB_TMO], 1u); break; } }
    }
    nloc = mine > 0u ? mine : 1u; nx = cnt > 0u ? cnt : 1u;
}
__device__ __forceinline__ void xcd_barrier(const XcdBarrier& b) {
    asm volatile("s_waitcnt vmcnt(0)" ::: "memory");
    __syncthreads();
    if (threadIdx.x == 0) {
        unsigned* bar = b.bar;
        __builtin_amdgcn_s_waitcnt(0);
        unsigned nloc = b.st[0], nx = b.st[1];
        if (nloc == 0u) { xcd_barrier_complete(bar, b.x, nloc, nx); b.st[0] = nloc; b.st[1] = nx; }
        const unsigned old = xb_add(&bar[XB_XSUB(b.x)], 1u);
        const unsigned gen = old / nloc;
        if (old + 1u == (gen + 1u) * nloc) {
            __builtin_amdgcn_fence(__ATOMIC_RELEASE, "agent");
            asm volatile("s_waitcnt vmcnt(0)" ::: "memory");
            const unsigned og = xb_add(&bar[XB_TOP], 1u);
            const unsigned tg = og / nx;
            if (og + 1u == (tg + 1u) * nx) xb_add(&bar[XB_TOPGEN], 1u);
            else XB_SPIN(xb_ld(&bar[XB_TOPGEN]) == tg, bar);
            __builtin_amdgcn_fence(__ATOMIC_ACQUIRE, "agent");
            xb_add(&bar[XB_XGEN(b.x)], 1u);
            asm volatile("s_waitcnt vmcnt(0)" ::: "memory");
        } else {
            XB_SPIN(xb_ld(&bar[XB_XGEN(b.x)]) == gen, bar);
            __builtin_amdgcn_fence(__ATOMIC_ACQUIRE, "agent");
            asm volatile("s_waitcnt vmcnt(0)" ::: "memory");
        }
    }
    __syncthreads();
}

namespace pg8 {
#define PG8_LAS __attribute__((address_space(3)))
typedef unsigned short bf16_t;
typedef short bf16x8 __attribute__((ext_vector_type(8)));
typedef float f32x4 __attribute__((ext_vector_type(4)));
typedef unsigned u32x4 __attribute__((ext_vector_type(4)));
constexpr int BM = 256, BK = 64, HALF = 128, HTB = HALF * BK * 2  , STAGE_BYTES = 8 * HTB, NXCD = 8, WGM = 8;

__host__ __device__ __forceinline__ int lds_byte(int r, int c) { const int st = (r >> 4) * 2 + (c >> 5), rr = r & 15, cc = c & 31, ob = rr * 64 + cc * 2; return st * 1024 + (ob ^ (((ob >> 9) & 1) << 5)); }
__host__ __device__ __forceinline__ void stage_rc(int b, int& R, int& C) { const int st = b / 1024, sb = b % 1024, swz = sb ^ (((sb >> 9) & 1) << 5); R = (st >> 1) * 16 + swz / 64; C = (st & 1) * 32 + (swz % 64) / 2; }
__host__ __device__ __forceinline__ int perm32(int rho) { const int n = rho >> 4, i = rho & 15; return 8 * (i >> 2) + 4 * n + (i & 3); }

struct Unit { int pm, pn, kofs; };
struct Gemm { const bf16_t* A; const bf16_t* Bt; int M, N, K, ld; };

struct StaticOrder {
    int nM, nN, nwg, G, c;
    __host__ __device__ void init(int M, int N, int G_, int c_) { nM = M / BM; nN = N / BM; nwg = nM * nN; G = G_; c = c_; }
    __host__ __device__ bool next(int i, Unit& u) const {
        const long L = (long)i * G + c; if (L >= nwg) return false;
        int wgid = (int)L; { const int q = nwg / NXCD, r = nwg % NXCD, xcd = wgid % NXCD, off = wgid / NXCD; wgid = (xcd < r ? xcd * (q + 1) : r * (q + 1) + (xcd - r) * q) + off; }
        const int nig = WGM * nN, gid = wgid / nig, fm = gid * WGM, gsz = (nM - fm) < WGM ? (nM - fm) : WGM;
        u.pm = fm + ((wgid % nig) % gsz); u.pn = (wgid % nig) / gsz; u.kofs = 0; return true;
    }
    __device__ __forceinline__ void a_ready(const Unit&) const {}
    __device__ __forceinline__ void done(const Unit&) const {}
};

__device__ __forceinline__ unsigned cvt_pk_bf16(float lo, float hi) { unsigned r; asm volatile("v_cvt_pk_bf16_f32 %0, %1, %2" : "=v"(r) : "v"(lo), "v"(hi)); return r; }
typedef float f32x2 __attribute__((ext_vector_type(2)));
__device__ __forceinline__ f32x2 gelu_pk(f32x2 v) {
    const f32x2 av = __builtin_elementwise_abs(v), d = av * 0.2316418882f + 1.0f;
    f32x2 t; t.x = __builtin_amdgcn_rcpf(d.x); t.y = __builtin_amdgcn_rcpf(d.y);
    f32x2 q = t * 0.5307027145f + (-0.7265760135f); q = q * t + 0.7107068705f; q = q * t + (-0.142248368f); q = q * t + 0.127414796f; q = q * t;
    const f32x2 s = (v * v) * (-0.72134752044f);
    f32x2 e; e.x = __builtin_amdgcn_exp2f(s.x); e.y = __builtin_amdgcn_exp2f(s.y);
    const f32x2 m = v * (q * e), r = v - m;
    f32x2 o; o.x = v.x < 0.f ? m.x : r.x; o.y = v.y < 0.f ? m.y : r.y; return o;
}

template <int ACT  > struct EpiBf16 {
    static constexpr bool PERM = true, AFTER_DRAIN = false; static_assert(ACT == 0 || ACT == 1, "EpiBf16: ACT is 0 (none) or 1 (gelu_pk)");
    bf16_t* O; int ldc; const float* bias; int split_cols; size_t split_stride; float scale0;
    __device__ __forceinline__ void operator()(const f32x4 (&acc)[2][2][4][2], const Unit& u, int wr, int wc, int fr, int fq) const {
        const int row0 = u.pm * BM + wr * 64 + fr; int colt = u.pn * BM; bf16_t* base = O;
        float sc = 1.f; if (split_cols) { const int t = colt / split_cols; base += (size_t)t * split_stride; colt -= t * split_cols; if (t == 0) sc = scale0; }
        const int col0 = colt + wc * 32 + 8 * fq, bcol0 = u.pn * BM + wc * 32 + 8 * fq;
        f32x4 bv[2][2];
#pragma unroll
        for (int bj = 0; bj < 2; ++bj)
#pragma unroll
            for (int n = 0; n < 2; ++n) bv[bj][n] = bias ? *(const f32x4*)(bias + bcol0 + bj * HALF + 4 * n) : (f32x4){0.f, 0.f, 0.f, 0.f};
#pragma unroll
        for (int ai = 0; ai < 2; ++ai)
#pragma unroll
            for (int m = 0; m < 4; ++m) { bf16_t* rowp = base + (size_t)(row0 + ai * HALF + m * 16) * ldc + col0;
#pragma unroll
                for (int bj = 0; bj < 2; ++bj) { f32x4 v0 = acc[ai][bj][m][0] + bv[bj][0], v1 = acc[ai][bj][m][1] + bv[bj][1];
                    if (ACT == 1) { f32x2 a = gelu_pk((f32x2){v0[0], v0[1]}), b = gelu_pk((f32x2){v0[2], v0[3]}), c = gelu_pk((f32x2){v1[0], v1[1]}), d = gelu_pk((f32x2){v1[2], v1[3]});
                        v0 = (f32x4){a.x, a.y, b.x, b.y}; v1 = (f32x4){c.x, c.y, d.x, d.y}; }
                    v0 = v0 * sc; v1 = v1 * sc; u32x4 w; w.x = cvt_pk_bf16(v0[0], v0[1]); w.y = cvt_pk_bf16(v0[2], v0[3]); w.z = cvt_pk_bf16(v1[0], v1[1]); w.w = cvt_pk_bf16(v1[2], v1[3]);
                    *(u32x4*)(rowp + bj * HALF) = w; } }
    }
};


struct EpiF32 {
    static constexpr bool PERM = false, AFTER_DRAIN = false;
    float* C; int ldc; const float* bias;
    __device__ __forceinline__ void operator()(const f32x4 (&acc)[2][2][4][2], const Unit& u, int wr, int wc, int fr, int fq) const {
        const int row0 = u.pm * BM + wr * 64 + fr, col0 = u.pn * BM + wc * 32 + 4 * fq;
        f32x4 bv[2][2];
#pragma unroll
        for (int bj = 0; bj < 2; ++bj)
#pragma unroll
            for (int n = 0; n < 2; ++n) bv[bj][n] = bias ? *(const f32x4*)(bias + col0 + bj * HALF + n * 16) : (f32x4){0.f, 0.f, 0.f, 0.f};
#pragma unroll
        for (int ai = 0; ai < 2; ++ai)
#pragma unroll
            for (int m = 0; m < 4; ++m) { float* rowp = C + (size_t)(row0 + ai * HALF + m * 16) * ldc + col0;
#pragma unroll
                for (int bj = 0; bj < 2; ++bj)
#pragma unroll
                    for (int n = 0; n < 2; ++n) *(f32x4*)(rowp + bj * HALF + n * 16) = acc[ai][bj][m][n] + bv[bj][n]; }
    }
};

template <class Epi, class Sched, bool ALIGN_EPI = false, bool SP2 = false>
__device__ __forceinline__ void gemm_phase(PG8_LAS unsigned char* lds, const Gemm g, const Sched& S, const Epi& E) {
    int tid_l = threadIdx.x; asm volatile("" : "+v"(tid_l));
    const int tid = tid_l, wid = __builtin_amdgcn_readfirstlane(tid >> 6), lane = tid & 63, wr = wid >> 2, wc = wid & 3, fr = lane & 15, fq = lane >> 4;
    const int K = g.K, nt = K / BK;
    unsigned voffA[2], voffB[2];
#pragma unroll
    for (int i = 0; i < 2; ++i) { int R, C; stage_rc(tid * 16 + i * 8192, R, C); const int Rb = Epi::PERM ? ((R & ~31) + perm32(R & 31)) : R;
        voffA[i] = (unsigned)(R * g.ld + C) * 2u; voffB[i] = (unsigned)(Rb * g.ld + C) * 2u; }
    const size_t kstep = (size_t)(BK * 2);
    const size_t hstep = (size_t)HALF * g.ld * 2;
    const size_t tstep = 2 * hstep;
    const unsigned ldsw = (unsigned)wid * 1024u;
    const int aoff = lds_byte(wr * 64 + fr, fq * 8), boff = lds_byte(wc * 32 + fr, fq * 8);
#define PG8_SA(b, h) (((b) * 2 + (h)) * HTB)
#define PG8_SB(b, h) ((4 + (b) * 2 + (h)) * HTB)
#define PG8_STAGE(bufoff, gbase, voff) do { _Pragma("unroll") for (int _i = 0; _i < 2; ++_i) \
        __builtin_amdgcn_global_load_lds((const unsigned*)((const char*)(gbase) + (voff)[_i]), (PG8_LAS unsigned*)(lds + (bufoff) + ldsw + _i * 8192), 16, 0, 0); } while (0)
#define PG8_LDA(dst, b, h) do { _Pragma("unroll") for (int m = 0; m < 4; ++m) _Pragma("unroll") for (int k = 0; k < 2; ++k) dst[m][k] = *(const PG8_LAS bf16x8*)(lds + PG8_SA(b, h) + aoff + m * 2048 + k * 1024); } while (0)
#define PG8_LDB(dst, b, h) do { _Pragma("unroll") for (int n = 0; n < 2; ++n) _Pragma("unroll") for (int k = 0; k < 2; ++k) dst[n][k] = *(const PG8_LAS bf16x8*)(lds + PG8_SB(b, h) + boff + n * 2048 + k * 1024); } while (0)
#define PG8_MMA(ai, bj, At, Bt) do { __builtin_amdgcn_s_setprio(1); _Pragma("unroll") for (int m = 0; m < 4; ++m) _Pragma("unroll") for (int n = 0; n < 2; ++n) _Pragma("unroll") for (int k = 0; k < 2; ++k) \
        acc[ai][bj][m][n] = __builtin_amdgcn_mfma_f32_16x16x32_bf16(Bt[n][k], At[m][k], acc[ai][bj][m][n], 0, 0, 0); __builtin_amdgcn_s_setprio(0); } while (0)
#define PG8_WAIT_V(n) asm volatile("s_waitcnt vmcnt(" #n ")" ::: "memory")
#define PG8_WAIT_L(n) asm volatile("s_waitcnt lgkmcnt(" #n ")" ::: "memory")
#define PG8_BAR __builtin_amdgcn_s_barrier()
#define PG8_SCHED __builtin_amdgcn_sched_barrier(0)
    Unit cur, nxt; int ui = 0;
    if (!S.next(0, cur)) return;
    f32x4 acc[2][2][4][2];
#pragma unroll
    for (int a = 0; a < 2; ++a)
#pragma unroll
        for (int b = 0; b < 2; ++b)
#pragma unroll
            for (int m = 0; m < 4; ++m)
#pragma unroll
                for (int n = 0; n < 2; ++n) acc[a][b][m][n] = (f32x4){0.f, 0.f, 0.f, 0.f};
    bf16x8 At[4][2], B0[2][2], B1[2][2];
    const char* cA = (const char*)g.A + (size_t)cur.pm * tstep + (size_t)cur.kofs * 2; const char* cB = (const char*)g.Bt + (size_t)cur.pn * tstep + (size_t)cur.kofs * 2;
    S.a_ready(cur);
    if constexpr (SP2) {
        PG8_STAGE(PG8_SB(0, 0), cB, voffB); PG8_STAGE(PG8_SB(0, 1), cB + hstep, voffB); PG8_STAGE(PG8_SA(0, 0), cA, voffA); PG8_STAGE(PG8_SA(0, 1), cA + hstep, voffA);
        if (wr == 1) PG8_BAR;
        PG8_WAIT_V(2); PG8_BAR;
        PG8_STAGE(PG8_SB(1, 0), cB + kstep, voffB); PG8_STAGE(PG8_SA(1, 0), cA + kstep, voffA); PG8_STAGE(PG8_SB(1, 1), cB + hstep + kstep, voffB);
        PG8_WAIT_V(6); PG8_BAR;
    } else {
        PG8_STAGE(PG8_SB(0, 0), cB, voffB); PG8_STAGE(PG8_SA(0, 0), cA, voffA); PG8_STAGE(PG8_SB(0, 1), cB + hstep, voffB); PG8_STAGE(PG8_SA(0, 1), cA + hstep, voffA);
        if (wr == 1) PG8_BAR;
        PG8_WAIT_V(4); PG8_BAR;
        PG8_STAGE(PG8_SB(1, 0), cB + kstep, voffB); PG8_STAGE(PG8_SA(1, 0), cA + kstep, voffA); PG8_STAGE(PG8_SB(1, 1), cB + hstep + kstep, voffB);
        PG8_WAIT_V(6); PG8_BAR;
    }
    for (;;) {
        const bool has_next = S.next(ui + 1, nxt);
        const char* nA = has_next ? (const char*)g.A + (size_t)nxt.pm * tstep + (size_t)nxt.kofs * 2 : cA; const char* nB = has_next ? (const char*)g.Bt + (size_t)nxt.pn * tstep + (size_t)nxt.kofs * 2 : cB;
        for (int t = 0; t < nt; t += 2) {
            const bool last = (t == nt - 2);
            const char* a1 = cA + (size_t)(t + 1) * kstep;
            const char* a2 = last ? nA : cA + (size_t)(t + 2) * kstep; const char* b2 = last ? nB : cB + (size_t)(t + 2) * kstep;
            const char* a3 = a2 + kstep; const char* b3 = b2 + kstep;
            if (last && has_next) S.a_ready(nxt);
            if constexpr (SP2) {
            PG8_LDB(B0, 0, 0); PG8_LDB(B1, 0, 1); PG8_SCHED; PG8_LDA(At, 0, 0); PG8_STAGE(PG8_SA(1, 1), a1 + hstep, voffA);
            PG8_WAIT_V(8); PG8_WAIT_L(0); PG8_BAR; PG8_MMA(0, 0, At, B0); PG8_MMA(0, 1, At, B1); PG8_BAR; PG8_SCHED;
            PG8_LDA(At, 0, 1); PG8_STAGE(PG8_SB(0, 0), b2, voffB); PG8_STAGE(PG8_SB(0, 1), b2 + hstep, voffB); PG8_STAGE(PG8_SA(0, 0), a2, voffA);
            PG8_WAIT_V(8); PG8_WAIT_L(0); PG8_BAR; PG8_MMA(1, 0, At, B0); PG8_MMA(1, 1, At, B1); PG8_BAR; PG8_SCHED;
            PG8_LDB(B0, 1, 0); PG8_LDB(B1, 1, 1); PG8_SCHED; PG8_LDA(At, 1, 0); PG8_STAGE(PG8_SA(0, 1), a2 + hstep, voffA);
            PG8_WAIT_V(8); PG8_WAIT_L(0); PG8_BAR; PG8_MMA(0, 0, At, B0); PG8_MMA(0, 1, At, B1); PG8_BAR; PG8_SCHED;
            PG8_LDA(At, 1, 1); PG8_STAGE(PG8_SB(1, 0), b3, voffB); PG8_STAGE(PG8_SB(1, 1), b3 + hstep, voffB); PG8_STAGE(PG8_SA(1, 0), a3, voffA);
            PG8_WAIT_V(8); PG8_WAIT_L(0); PG8_BAR; PG8_MMA(1, 0, At, B0); PG8_MMA(1, 1, At, B1); PG8_BAR; PG8_SCHED;
            } else {
            PG8_LDB(B0, 0, 0); PG8_SCHED; PG8_LDA(At, 0, 0); PG8_STAGE(PG8_SA(1, 1), a1 + hstep, voffA);
            PG8_WAIT_L(8); PG8_BAR; PG8_WAIT_L(0); PG8_MMA(0, 0, At, B0); PG8_BAR; PG8_SCHED;
            PG8_LDB(B1, 0, 1); PG8_STAGE(PG8_SB(0, 0), b2, voffB);
            PG8_BAR; PG8_WAIT_L(0); PG8_MMA(0, 1, At, B1); PG8_BAR;
            PG8_LDA(At, 0, 1); PG8_STAGE(PG8_SA(0, 0), a2, voffA);
            PG8_BAR; PG8_WAIT_L(0); PG8_MMA(1, 0, At, B0); PG8_BAR; PG8_SCHED;
            PG8_STAGE(PG8_SB(0, 1), b2 + hstep, voffB);
            PG8_WAIT_V(6); PG8_BAR; PG8_MMA(1, 1, At, B1); PG8_BAR;
            PG8_LDB(B0, 1, 0); PG8_SCHED; PG8_LDA(At, 1, 0); PG8_STAGE(PG8_SA(0, 1), a2 + hstep, voffA);
            PG8_WAIT_L(8); PG8_BAR; PG8_WAIT_L(0); PG8_MMA(0, 0, At, B0); PG8_BAR; PG8_SCHED;
            PG8_LDB(B1, 1, 1); PG8_STAGE(PG8_SB(1, 0), b3, voffB);
            PG8_BAR; PG8_WAIT_L(0); PG8_MMA(0, 1, At, B1); PG8_BAR;
            PG8_LDA(At, 1, 1); PG8_STAGE(PG8_SA(1, 0), a3, voffA);
            PG8_BAR; PG8_WAIT_L(0); PG8_MMA(1, 0, At, B0); PG8_BAR; PG8_SCHED;
            PG8_STAGE(PG8_SB(1, 1), b3 + hstep, voffB);
            PG8_WAIT_V(6); PG8_BAR; PG8_MMA(1, 1, At, B1); PG8_BAR;
            }
        }
        if constexpr (ALIGN_EPI) { if (wr == 0) PG8_BAR; }
        if constexpr (!Epi::AFTER_DRAIN) { E(acc, cur, wr, wc, fr, fq); S.done(cur); }
        if (!has_next) break;
#pragma unroll
        for (int a = 0; a < 2; ++a)
#pragma unroll
            for (int b = 0; b < 2; ++b)
#pragma unroll
                for (int m = 0; m < 4; ++m)
#pragma unroll
                    for (int n = 0; n < 2; ++n) acc[a][b][m][n] = (f32x4){0.f, 0.f, 0.f, 0.f};
        cur = nxt; cA = nA; cB = nB; ++ui;
        if constexpr (ALIGN_EPI) { if (wr == 1) PG8_BAR; }
    }
    PG8_WAIT_V(0);
    if constexpr (!ALIGN_EPI) { if (wr == 0) PG8_BAR; }
    PG8_BAR;
    if constexpr (Epi::AFTER_DRAIN) { E.fused(acc, cur, wr, wc, fr, fq, lds, wid, lane); S.done(cur); }
#undef PG8_SA
#undef PG8_SB
#undef PG8_STAGE
#undef PG8_LDA
#undef PG8_LDB
#undef PG8_MMA
#undef PG8_WAIT_V
#undef PG8_WAIT_L
#undef PG8_BAR
#undef PG8_SCHED
}
}
namespace pg8 {
struct SplitKOrder {
    int G, c;
    __host__ __device__ void init(int G_, int c_) { G = G_; c = c_; }
    __host__ __device__ bool next(int i, Unit& u) const { const long L = (long)i * G + c; if (L >= 128) return false; const int ks = (int)L >> 4, r = (int)L & 15; u.pm = r >> 3; u.pn = r & 7; u.kofs = ks * 256; return true; }
    __device__ __forceinline__ void a_ready(const Unit&) const {}
    __device__ __forceinline__ void done(const Unit&) const {}
};
struct EpiF32Part {
    static constexpr bool PERM = false, AFTER_DRAIN = false;
    float* C;
    __device__ __forceinline__ void operator()(const f32x4 (&acc)[2][2][4][2], const Unit& u, int wr, int wc, int fr, int fq) const {
        const int row0 = u.pm * BM + wr * 64 + fr, col0 = u.pn * BM + wc * 32 + 4 * fq; float* base = C + (size_t)(u.kofs >> 8) * 512 * 2048;
#pragma unroll
        for (int ai = 0; ai < 2; ++ai)
#pragma unroll
            for (int m = 0; m < 4; ++m) { float* rowp = base + (size_t)(row0 + ai * HALF + m * 16) * 2048 + col0;
#pragma unroll
                for (int bj = 0; bj < 2; ++bj)
#pragma unroll
                    for (int n = 0; n < 2; ++n) *(f32x4*)(rowp + bj * HALF + n * 16) = acc[ai][bj][m][n]; }
    }
};
}
#define PG8_SP2 true
#define PG8_ALIGN true

#define LDS_FENCE() asm volatile("s_waitcnt lgkmcnt(0)" ::: "memory")
__device__ __forceinline__ unsigned f2bf(float f) { unsigned u = __builtin_bit_cast(unsigned, f); return (u + 0x7fffu + ((u >> 16) & 1u)) >> 16; }
__device__ __forceinline__ unsigned pk2(float lo, float hi) { return f2bf(lo) | (f2bf(hi) << 16); }
__device__ __forceinline__ float wave_sum(float v) {
#pragma unroll
    for (int o = 1; o < 64; o <<= 1) v += __shfl_xor(v, o);
    return v;
}
__device__ __forceinline__ float wave_max(float v) {
#pragma unroll
    for (int o = 1; o < 64; o <<= 1) v = fmaxf(v, __shfl_xor(v, o));
    return v;
}
__device__ __forceinline__ float silu_f(float x) { return x / (1.0f + __expf(-x)); }
__device__ __forceinline__ float gelu_f(float v) {
    const float t = __builtin_amdgcn_rcpf(fabsf(v) * 0.2316418882f + 1.0f);
    float q = t * 0.5307027145f + (-0.7265760135f); q = q * t + 0.7107068705f; q = q * t + (-0.142248368f); q = q * t + 0.127414796f; q = q * t;
    const float m = v * (q * __builtin_amdgcn_exp2f(v * v * (-0.72134752044f)));
    return v < 0.f ? m : v - m;
}
__device__ __forceinline__ float log_sigmoid_f(float z) { return fminf(z, 0.0f) - __logf(1.0f + __expf(-fabsf(z))); }


__device__ __forceinline__ float bflo(unsigned w) { return __builtin_bit_cast(float, w << 16); }
__device__ __forceinline__ float bfhi(unsigned w) { return __builtin_bit_cast(float, w & 0xffff0000u); }
__device__ __forceinline__ void unpack8(const u32x4 w, float (&f)[8]) { f[0] = bflo(w.x); f[1] = bfhi(w.x); f[2] = bflo(w.y); f[3] = bfhi(w.y); f[4] = bflo(w.z); f[5] = bfhi(w.z); f[6] = bflo(w.w); f[7] = bfhi(w.w); }
__device__ __forceinline__ u32x4 pack8(const float (&f)[8]) { u32x4 o; o.x = pk2(f[0], f[1]); o.y = pk2(f[2], f[3]); o.z = pk2(f[4], f[5]); o.w = pk2(f[6], f[7]); return o; }


__device__ __forceinline__ u32x6 pack_fp6_2x16(const f32x16 a, const f32x16 b) { u32x6 r; asm("v_cvt_scalef32_2xpk16_fp6_f32 %0, %1, %2, 1.0" : "=&v"(r) : "v"(a), "v"(b)); return r; }
__device__ __forceinline__ f32x32 unpack_fp6_32(const u32x6 w) { f32x32 r; asm volatile("v_cvt_scalef32_pk32_f32_fp6 %0, %1, 1.0" : "=&v"(r) : "v"(w)); return r; }

struct Params {
    const float* in[19];
    float* out;
    unsigned char* ws;
    int ph_lo, ph_hi;
};
enum { I_X = 0, I_C, I_CTX, I_CCTX, I_WADA, I_BADA, I_WIN, I_CONVW, I_GW2, I_GB2, I_GNORM, I_SINK, I_WOUT, I_LNG, I_LNB, I_PWQ, I_PSUB, I_PU, I_PV };

__device__ __forceinline__ int row_stream(int r) { return r < TL ? r / SEQ : 2; }

__device__ __forceinline__ void transpose_item(const float* W, int K, int N, bf16_t* WT, LAS float* scr, int item, int lane) {
    const int nblk = N / 32, kb = item / nblk, nb = item % nblk, k0 = 64 * kb, n0 = 32 * nb;
#pragma unroll 8
    for (int i = 0; i < 32; ++i) { const int kk = 2 * i + (lane >> 5); scr[kk * 33 + (lane & 31)] = W[(size_t)(k0 + kk) * N + n0 + (lane & 31)]; }
    LDS_FENCE();
    const int c = lane & 7;
#pragma unroll
    for (int j = 0; j < 4; ++j) { const int n = (lane >> 3) + 8 * j; const LAS float* s = scr + (8 * c) * 33 + n;
        u32x4 o; o.x = pk2(s[0 * 33], s[1 * 33]); o.y = pk2(s[2 * 33], s[3 * 33]); o.z = pk2(s[4 * 33], s[5 * 33]); o.w = pk2(s[6 * 33], s[7 * 33]);
        *(u32x4*)(WT + (size_t)(n0 + n) * K + k0 + 8 * c) = o; }
    LDS_FENCE();
}

__device__ __forceinline__ void phase_prologue(const Params& p, LAS unsigned char* lds, int tid, int lane, int wave, int bid, int G) {
    const int gw = bid * NWAVES + wave, NGW = G * NWAVES;
    LAS float* scr = (LAS float*)(lds + wave * 16384);
    bf16_t* WIN = (bf16_t*)(p.ws + WS_WIN); bf16_t* WOUT = (bf16_t*)(p.ws + WS_WOUT); bf16_t* WQ = (bf16_t*)(p.ws + WS_WQ);
    constexpr int IT_IN = (DM / 64) * (INW / 32), IT_SQ = (DM / 64) * (DM / 32), IT_L = IT_IN + 2 * IT_SQ;
    for (int it = gw; it < DEPTH * IT_L; it += NGW) {
        const int l = it / IT_L; int r = it % IT_L;
        if (r < IT_IN) { transpose_item(p.in[I_WIN] + (size_t)l * DM * INW, DM, INW, WIN + (size_t)l * INWP * DM, scr, r, lane); continue; } r -= IT_IN;
        if (r < IT_SQ) { transpose_item(p.in[I_WOUT] + (size_t)l * DM * DM, DM, DM, WOUT + (size_t)l * DM * DM, scr, r, lane); continue; } r -= IT_SQ;
        transpose_item(p.in[I_PWQ] + (size_t)l * DM * DM, DM, DM, WQ + (size_t)l * DM * DM, scr, r, lane);
    }
    {
        constexpr int PADV = (INWP - INW) * DM / 8;
        const int gt = bid * NTHREADS + tid, NGT = G * NTHREADS;
        for (int i = gt; i < DEPTH * PADV; i += NGT) { const int l = i / PADV, o = i % PADV;
            *(u32x4*)(WIN + (size_t)l * INWP * DM + (size_t)INW * DM + (size_t)o * 8) = (u32x4){0u, 0u, 0u, 0u}; }
    }
    {
        const float* U = p.in[I_PU]; const float* V = p.in[I_PV];
        unsigned char* UB = p.ws + WS_UB; unsigned char* VB = p.ws + WS_VB; float* USC = (float*)(p.ws + WS_USC); (void)USC; float* VSC = (float*)(p.ws + WS_VSC); (void)VSC;
        for (size_t row = gw; row < (size_t)DEPTH * NEXP; row += NGW) {
            f32x4 xx[2][8];
#pragma unroll
            for (int tb = 0; tb < 2; ++tb)
#pragma unroll
                for (int j = 0; j < 8; ++j) xx[tb][j] = *(const f32x4*)((tb ? V : U) + row * DM + lane * 32 + 4 * j);
#pragma unroll
            for (int tb = 0; tb < 2; ++tb) {
                f32x4 x[8]; float am = 0.f;
#pragma unroll
                for (int j = 0; j < 8; ++j) { x[j] = xx[tb][j]; am = fmaxf(am, fmaxf(fmaxf(fabsf(x[j].x), fabsf(x[j].y)), fmaxf(fabsf(x[j].z), fabsf(x[j].w)))); }
                if (tb == 0 && TBL_U_I4) {
#if U_ROWSCALE
                    unsigned char* dst = UB + row * ROWB_U;
                    float ssq = 0.f;
#pragma unroll
                    for (int j = 0; j < 8; ++j) ssq += (x[j].x * x[j].x + x[j].y * x[j].y) + (x[j].z * x[j].z + x[j].w * x[j].w);
                    const float amr = wave_max(am), rms = sqrtf(wave_sum(ssq) * (1.0f / DM));
                    const float srow = amr > 0.f ? fminf(amr * (1.0f / 7.0f), 0.36f * rms) : 1.0f; const float inv = 1.0f / srow; const int code = 0; (void)code;
                    if (lane == 0) USC[row] = srow;
#else
                    unsigned char* dst = UB + row * ROWB4;
                    const float sb = am * (1.0f / 7.0f); const unsigned ub = (__builtin_bit_cast(unsigned, sb) + 0x000fffffu) & 0xfff00000u;
                    int code = ((int)ub - (int)I4_BASE) >> 20; code = code < 0 ? 0 : (code > 255 ? 255 : code);
                    const float inv = 1.0f / __builtin_bit_cast(float, ((unsigned)code << 20) + I4_BASE);
#endif
                    u32x4 w;
#pragma unroll
                    for (int d = 0; d < 4; ++d) { unsigned t = 0u;
#pragma unroll
                        for (int e = 0; e < 8; ++e) { const float xv = (e < 4 ? x[2 * d] : x[2 * d + 1])[e & 3];
                            int q = (int)__builtin_rintf(xv * inv); q = q < -7 ? -7 : (q > 7 ? 7 : q); t |= ((unsigned)q & 15u) << (4 * e); }
                        w[d] = t; }
                    *(u32x4*)(dst + lane * 16) = w;
#if !U_ROWSCALE
                    dst[1024 + lane] = (unsigned char)code;
#endif
                } else if (tb == 1 && V_ROWSCALE) {
                    unsigned char* dst = VB + row * ROWB_V;
                    float ssq = 0.f;
#pragma unroll
                    for (int j = 0; j < 8; ++j) ssq += (x[j].x * x[j].x + x[j].y * x[j].y) + (x[j].z * x[j].z + x[j].w * x[j].w);
                    const float amr = wave_max(am), rms = sqrtf(wave_sum(ssq) * (1.0f / DM));
                    const float srow = amr > 0.f ? fminf(amr * (1.0f / 6.0f), (2.8f / 6.0f) * rms) : 1.0f; const float inv = 1.0f / srow;
                    if (lane == 0) VSC[row] = srow;
                    u32x4 w;
#pragma unroll
                    for (int d = 0; d < 4; ++d) { unsigned t = 0u;
                        t = __builtin_amdgcn_cvt_scalef32_pk_fp4_f32(t, x[2 * d].x * inv, x[2 * d].y * inv, 1.0f, 0); t = __builtin_amdgcn_cvt_scalef32_pk_fp4_f32(t, x[2 * d].z * inv, x[2 * d].w * inv, 1.0f, 1);
                        t = __builtin_amdgcn_cvt_scalef32_pk_fp4_f32(t, x[2 * d + 1].x * inv, x[2 * d + 1].y * inv, 1.0f, 2); t = __builtin_amdgcn_cvt_scalef32_pk_fp4_f32(t, x[2 * d + 1].z * inv, x[2 * d + 1].w * inv, 1.0f, 3);
                        w[d] = t; }
                    *(u32x4*)(dst + lane * 16) = w;
                } else if (tb == 1 || TBL_U_FP4) {
                    unsigned char* dst = (tb ? VB : UB) + row * ROWB4;
                    const float sb = am * (1.0f / 6.0f); unsigned ub = __builtin_bit_cast(unsigned, sb); ub = (ub & 0x007fffffu) ? ((ub & 0x7f800000u) + 0x00800000u) : (ub & 0x7f800000u);
                    if (!(am > 0.f) || ub < 0x00800000u) ub = 0x00800000u;
                    const float scl = __builtin_bit_cast(float, ub);
                    u32x4 w;
#pragma unroll
                    for (int d = 0; d < 4; ++d) { unsigned t = 0u;
                        t = __builtin_amdgcn_cvt_scalef32_pk_fp4_f32(t, x[2 * d].x, x[2 * d].y, scl, 0); t = __builtin_amdgcn_cvt_scalef32_pk_fp4_f32(t, x[2 * d].z, x[2 * d].w, scl, 1);
                        t = __builtin_amdgcn_cvt_scalef32_pk_fp4_f32(t, x[2 * d + 1].x, x[2 * d + 1].y, scl, 2); t = __builtin_amdgcn_cvt_scalef32_pk_fp4_f32(t, x[2 * d + 1].z, x[2 * d + 1].w, scl, 3);
                        w[d] = t; }
                    *(u32x4*)(dst + lane * 16) = w; dst[1024 + lane] = (unsigned char)(ub >> 23);
                } else {
                    unsigned char* dst = UB + row * ROWB;
                    am = wave_max(am);
                    const float inv = am > 0.f ? 7.0f / am : 0.f;
                    f32x16 x0, x1;
#pragma unroll
                    for (int j = 0; j < 4; ++j) { x0[4 * j + 0] = x[j].x * inv; x0[4 * j + 1] = x[j].y * inv; x0[4 * j + 2] = x[j].z * inv; x0[4 * j + 3] = x[j].w * inv;
                        x1[4 * j + 0] = x[4 + j].x * inv; x1[4 * j + 1] = x[4 + j].y * inv; x1[4 * j + 2] = x[4 + j].z * inv; x1[4 * j + 3] = x[4 + j].w * inv; }
                    const u32x6 w = pack_fp6_2x16(x0, x1);
                    *(u32x4*)(dst + lane * 16) = (u32x4){w[0], w[1], w[2], w[3]}; *(u32x2*)(dst + 1024 + lane * 8) = (u32x2){w[4], w[5]};
                    if (lane == 0) USC[row] = am * (1.0f / 7.0f);
                }
            }
        }
        const size_t gt = (size_t)bid * NTHREADS + tid, NGT = (size_t)G * NTHREADS;
        const float* SUB = p.in[I_PSUB]; bf16_t* SUBB = (bf16_t*)(p.ws + WS_SUBB);
        for (size_t i = gt; i < (size_t)DEPTH * 2 * 128 * 128 / 2; i += NGT) ((unsigned*)SUBB)[i] = pk2(SUB[2 * i], SUB[2 * i + 1]);
    }
    __syncthreads();
    LAS float* sc = (LAS float*)lds;
    LAS float* red = (LAS float*)(lds + 32768);
    for (int i = tid; i < 3 * DM; i += NTHREADS) { const int s = i / DM, k = i % DM; const float v = s < 2 ? p.in[I_C][s * DM + k] : p.in[I_CCTX][k]; sc[i] = silu_f(v); }
    __syncthreads();
    float* MOD = (float*)(p.ws + WS_MOD);
    LAS float* red2 = (LAS float*)(lds + 32768);
    constexpr int NCH = 6 * DM / 256;
    for (int it = bid; it < DEPTH * NCH; it += G) {
        const int l = it / NCH, n0 = (it % NCH) * 256;
        const float* wp = p.in[I_WADA] + (size_t)l * DM * 6 * DM + n0 + lane * 4;
        f32x4 a0 = (f32x4){0.f, 0.f, 0.f, 0.f}, a1 = a0, a2 = a0;
        const int kb = wave * (DM / NWAVES);
#pragma unroll 16
        for (int k = kb; k < kb + DM / NWAVES; ++k) { const f32x4 w = *(const f32x4*)(wp + (size_t)k * 6 * DM); a0 += w * sc[k]; a1 += w * sc[DM + k]; a2 += w * sc[2 * DM + k]; }
        *(LAS f32x4*)(red2 + (wave * 3 + 0) * 256 + lane * 4) = a0; *(LAS f32x4*)(red2 + (wave * 3 + 1) * 256 + lane * 4) = a1; *(LAS f32x4*)(red2 + (wave * 3 + 2) * 256 + lane * 4) = a2;
        __syncthreads();
        for (int i = tid; i < 768; i += NTHREADS) { const int st = i >> 8, c = i & 255; float v = 0.f;
#pragma unroll
            for (int w = 0; w < NWAVES; ++w) v += red2[(w * 3 + st) * 256 + c];
            MOD[((size_t)l * 3 + st) * 6 * DM + n0 + c] = v + p.in[I_BADA][(size_t)l * 6 * DM + n0 + c]; }
        __syncthreads();
    }
}


__device__ __forceinline__ int row_first(int wave, int bid, int G) { const int gw = bid * NWAVES + wave; return gw < TL ? gw : -1; }
__device__ __forceinline__ int row_next(int r, int wave, int bid, int G, int nrows) {
    const int NGW = G * NWAVES;
    if (r < TL) { if (r + NGW < TL) return r + NGW; const int c = TL + wave * G + bid; return c < nrows ? c : -1; }
    return r + NGW < nrows ? r + NGW : -1;
}
__device__ __forceinline__ const float* xsrc(const Params& p, int l, int r) {
    return r < TL ? p.in[I_X] + (size_t)r * DM : p.in[I_CTX] + (size_t)(r - TL) * DM;
}

__device__ __forceinline__ void modulate_row(const float* xr, const float* mod, int sh_off, int sc_off, bf16_t* hb, int lane) {
    f32x4 xx[8];
#pragma unroll
    for (int j = 0; j < 8; ++j) xx[j] = *(const f32x4*)(xr + lane * 4 + 256 * j);
#pragma unroll
    for (int j = 0; j < 8; ++j) { const int c = lane * 4 + 256 * j;
        const f32x4 x = xx[j], sh = *(const f32x4*)(mod + sh_off + c), s = *(const f32x4*)(mod + sc_off + c);
        u32x2 o; o.x = pk2(x.x * (1.f + s.x) + sh.x, x.y * (1.f + s.y) + sh.y); o.y = pk2(x.z * (1.f + s.z) + sh.z, x.w * (1.f + s.w) + sh.w);
        *(u32x2*)(hb + c) = o; }
}
__device__ __forceinline__ void phase_modulate0(const Params& p, int lane, int wave, int bid, int G) {
    const int gw = bid * NWAVES + wave, NGW = G * NWAVES;
    const float* MOD = (const float*)(p.ws + WS_MOD); bf16_t* HB = (bf16_t*)(p.ws + WS_HB);
    for (int r = row_first(wave, bid, G); r >= 0; r = row_next(r, wave, bid, G, TA)) modulate_row(xsrc(p, 0, r), MOD + (size_t)(0 * 3 + row_stream(r)) * 6 * DM, 0, DM, HB + (size_t)r * DM, lane);
}

__device__ __forceinline__ void gemm_direct(const bf16_t* A, const bf16_t* Bt, float* C, int M, int N, int K, int ldc, int gw, int NGW, int lane) {
    const int nTn = N / 64, nItems = (M / 32) * nTn;
    const int fr = lane & 15, fq = lane >> 4;
    for (int it = gw; it < nItems; it += NGW) {
        const int mt = it / nTn, nt = it % nTn;
        const bf16_t* a0 = A + (size_t)(mt * 32 + fr) * K + fq * 8;
        const bf16_t* b0 = Bt + (size_t)(nt * 64 + fr) * K + fq * 8;
        f32x4 acc[2][4];
#pragma unroll
        for (int i = 0; i < 2; ++i)
#pragma unroll
            for (int j = 0; j < 4; ++j) acc[i][j] = (f32x4){0.f, 0.f, 0.f, 0.f};
#pragma unroll 2
        for (int k0 = 0; k0 < K; k0 += 32) {
            bf16x8 af[2], bfr[4];
#pragma unroll
            for (int i = 0; i < 2; ++i) af[i] = *(const bf16x8*)(a0 + (size_t)i * 16 * K + k0);
#pragma unroll
            for (int j = 0; j < 4; ++j) bfr[j] = *(const bf16x8*)(b0 + (size_t)j * 16 * K + k0);
#pragma unroll
            for (int i = 0; i < 2; ++i)
#pragma unroll
                for (int j = 0; j < 4; ++j) acc[i][j] = __builtin_amdgcn_mfma_f32_16x16x32_bf16(af[i], bfr[j], acc[i][j], 0, 0, 0);
        }
#pragma unroll
        for (int i = 0; i < 2; ++i)
#pragma unroll
            for (int j = 0; j < 4; ++j)
#pragma unroll
                for (int g = 0; g < 4; ++g) C[(size_t)(mt * 32 + i * 16 + fq * 4 + g) * ldc + nt * 64 + j * 16 + fr] = acc[i][j][g];
    }
}

__device__ __forceinline__ void phase_post_in(const Params& p, int l, int lane, int wave, int bid, int G) {
    const int gw = bid * NWAVES + wave, NGW = G * NWAVES;
    const bf16_t* P = (const bf16_t*)(p.ws + WS_P);
    bf16_t* QR = (bf16_t*)(p.ws + WS_QR); bf16_t* KR = (bf16_t*)(p.ws + WS_KR); bf16_t* VR = (bf16_t*)(p.ws + WS_ALF);
    bf16_t* MIX = (bf16_t*)(p.ws + WS_MIX);
    const float* cw = p.in[I_CONVW] + (size_t)l * 3 * 512;
    const int c8 = lane * 8, rh = lane >> 3, rf = (lane >> 2) & 1, rg = lane & 3, roff = rh * 128 + rf * 64 + rg * 8;
    float w0[8], w1[8], w2[8], invf[8];
#pragma unroll
    for (int e = 0; e < 8; ++e) { w0[e] = cw[c8 + e]; w1[e] = cw[512 + c8 + e]; w2[e] = cw[1024 + c8 + e]; invf[e] = __builtin_amdgcn_exp2f(-(float)(rg * 8 + e) * 0.4152410118609203f); }
    for (int r = row_first(wave, bid, G); r >= 0; r = row_next(r, wave, bid, G, TA)) {
        const bf16_t* pr = P + (size_t)r * INWP;
        int pos, len;
        if (r < TL) { pos = r % SEQ; len = SEQ; } else { pos = (r - TL) % CTXL; len = CTXL; }
        const bool hp = pos > 0, hn = pos < len - 1;
        const u32x4 z4 = (u32x4){0u, 0u, 0u, 0u};
        const u32x4 xC = *(const u32x4*)(pr + C_CC + c8), xX = *(const u32x4*)(pr + C_CX + c8), xB = *(const u32x4*)(pr + C_CB + c8);
        const u32x4 pC = hp ? *(const u32x4*)(pr - INWP + C_CC + c8) : z4, pX = hp ? *(const u32x4*)(pr - INWP + C_CX + c8) : z4;
        const u32x4 nC = hn ? *(const u32x4*)(pr + INWP + C_CC + c8) : z4, nX = hn ? *(const u32x4*)(pr + INWP + C_CX + c8) : z4;
        const u32x4 q1 = *(const u32x4*)(pr + C_SQ + roff), q2 = *(const u32x4*)(pr + C_SQ + roff + 32);
        u32x4 k1 = z4, k2 = z4, vv = z4;
        if (lane < 16) { k1 = *(const u32x4*)(pr + C_SK + roff); k2 = *(const u32x4*)(pr + C_SK + roff + 32); }
        if (lane < 32) vv = *(const u32x4*)(pr + C_SV + c8);
        { float fC[8], fX[8], fB[8], gC[8], gX[8], hC[8], hX[8], o[8];
          unpack8(xC, fC); unpack8(xX, fX); unpack8(xB, fB); unpack8(pC, gC); unpack8(pX, gX); unpack8(nC, hC); unpack8(nX, hX);
#pragma unroll
          for (int e = 0; e < 8; ++e) o[e] = fB[e] * (w0[e] * gC[e] * gX[e] + w1[e] * fC[e] * fX[e] + w2[e] * hC[e] * hX[e]);
          *(u32x4*)(MIX + (size_t)r * DM + c8) = pack8(o); }
        { float cs[8], sn[8];
#pragma unroll
          for (int e = 0; e < 8; ++e) { cs[e] = 1.f; sn[e] = 0.f; }
          if (r < TL) { const float pv = (float)(rf ? (pos % 64) : (pos / 64));
#pragma unroll
              for (int e = 0; e < 8; ++e) { sn[e] = __sinf(pv * invf[e]); cs[e] = __cosf(pv * invf[e]); } }
          float x1[8], x2[8], o1[8], o2[8];
          unpack8(q1, x1); unpack8(q2, x2);
#pragma unroll
          for (int e = 0; e < 8; ++e) { o1[e] = (x1[e] * cs[e] - x2[e] * sn[e]) * 0.08838834764831845f; o2[e] = (x2[e] * cs[e] + x1[e] * sn[e]) * 0.08838834764831845f; }
          *(u32x4*)(QR + (size_t)r * 1024 + roff) = pack8(o1); *(u32x4*)(QR + (size_t)r * 1024 + roff + 32) = pack8(o2);
          if (lane < 16) { unpack8(k1, x1); unpack8(k2, x2);
#pragma unroll
              for (int e = 0; e < 8; ++e) { o1[e] = x1[e] * cs[e] - x2[e] * sn[e]; o2[e] = x2[e] * cs[e] + x1[e] * sn[e]; }
              *(u32x4*)(KR + (size_t)r * 256 + roff) = pack8(o1); *(u32x4*)(KR + (size_t)r * 256 + roff + 32) = pack8(o2); }
          if (lane < 32) *(u32x4*)(VR + (size_t)r * 256 + c8) = vv; }
    }
}

#ifndef SWA_THR
#define SWA_THR 6.0f
#endif
constexpr int KP = 136, VP = 72;
constexpr int SWA_BUF = 64 * KP * 2 + 128 * VP * 2;
typedef short bf16x4 __attribute__((ext_vector_type(4)));
__device__ __forceinline__ void phase_mixers(const Params& p, int l, LAS unsigned char* lds, int tid, int lane, int wave, int bid, int G, int qsel = 0) {
    const bf16_t* QR = (const bf16_t*)(p.ws + WS_QR); const bf16_t* KR = (const bf16_t*)(p.ws + WS_KR); const bf16_t* VR = (const bf16_t*)(p.ws + WS_ALF);
    bf16_t* MIX = (bf16_t*)(p.ws + WS_MIX);
    const float* sinkp = p.in[I_SINK] + l * 8;
    const int fr = lane & 15, fq = lane >> 4, g = wave & 3, qh = wave >> 2;
    const int nItems = 512 + ((l < DEPTH - 1) ? 16 : 0);
    unsigned* qhead = (unsigned*)(p.ws + WS_CTL) + CW_QUEUE + 64 * (l + 4 * qsel);
    volatile LAS int* itw = (volatile LAS int*)(lds + MISC_OFF + 64);
    for (;;) {
        if (tid == 0) itw[0] = (int)__hip_atomic_fetch_add(qhead, 1u, __ATOMIC_RELAXED, __HIP_MEMORY_SCOPE_AGENT);
        __syncthreads();
        const int it = itw[0];
        __syncthreads();
        if (it >= nItems) break;
        int b, tile, hk, s0; size_t qrow0;
        if (it < 512) { b = it >> 8; tile = (it >> 1) & 127; hk = it & 1; s0 = 0; qrow0 = (size_t)b * SEQ + tile * 64; }
        else { const int c = it - 512; b = c >> 3; tile = (c >> 1) & 3; hk = c & 1; s0 = 5; qrow0 = (size_t)TL + b * CTXL + tile * 64; }
        const int n0 = tile * 64, hq = hk * 4 + g;
        bf16x8 qf[2][4];
#pragma unroll
        for (int qt = 0; qt < 2; ++qt)
#pragma unroll
            for (int ks = 0; ks < 4; ++ks) qf[qt][ks] = *(const bf16x8*)(QR + (qrow0 + qh * 32 + qt * 16 + fr) * 1024 + hq * 128 + ks * 32 + fq * 8);
        f32x4 O[2][8];
#pragma unroll
        for (int qt = 0; qt < 2; ++qt)
#pragma unroll
            for (int dt = 0; dt < 8; ++dt) O[qt][dt] = (f32x4){0.f, 0.f, 0.f, 0.f};
        float m[2], lsum[2];
        m[0] = m[1] = sinkp[hq]; lsum[0] = lsum[1] = (fq == 0) ? 1.f : 0.f;
        u32x4 kreg[2], vreg[2];
#define SWA_ROW(s, kk) ((s) < 5 ? (size_t)b * SEQ + (size_t)min(max(n0 - 128 + (s) * 64 + (kk), 0), SEQ - 1) : (size_t)TL + (size_t)b * CTXL + ((s) - 5) * 64 + (kk))
#define SWA_LOAD(s) do { _Pragma("unroll") for (int j = 0; j < 2; ++j) { const int v = tid + NTHREADS * j; \
            kreg[j] = *(const u32x4*)(KR + SWA_ROW(s, v >> 4) * 256 + hk * 128 + (v & 15) * 8); \
            vreg[j] = *(const u32x4*)(VR + SWA_ROW(s, tid & 63) * 256 + hk * 128 + ((tid >> 6) + 8 * j) * 8); } } while (0)
#define SWA_WRITE(buf) do { LAS bf16_t* Kd = (LAS bf16_t*)(lds + (buf) * SWA_BUF); LAS bf16_t* Vd = Kd + 64 * KP; \
            _Pragma("unroll") for (int j = 0; j < 2; ++j) { const int v = tid + NTHREADS * j; *(LAS u32x4*)(Kd + (v >> 4) * KP + (v & 15) * 8) = kreg[j]; \
                const int d0 = ((tid >> 6) + 8 * j) * 8, key = tid & 63; const u32x4 w = vreg[j]; \
                Vd[(d0 + 0) * VP + key] = (bf16_t)(w.x & 0xffffu); Vd[(d0 + 1) * VP + key] = (bf16_t)(w.x >> 16); Vd[(d0 + 2) * VP + key] = (bf16_t)(w.y & 0xffffu); Vd[(d0 + 3) * VP + key] = (bf16_t)(w.y >> 16); \
                Vd[(d0 + 4) * VP + key] = (bf16_t)(w.z & 0xffffu); Vd[(d0 + 5) * VP + key] = (bf16_t)(w.z >> 16); Vd[(d0 + 6) * VP + key] = (bf16_t)(w.w & 0xffffu); Vd[(d0 + 7) * VP + key] = (bf16_t)(w.w >> 16); } } while (0)
        SWA_LOAD(s0); SWA_WRITE(0);
        __syncthreads();
#pragma unroll 1
        for (int s = s0; s < 9; ++s) {
            const int buf = (s - s0) & 1;
            if (s + 1 < 9) SWA_LOAD(s + 1);
            const LAS bf16_t* Ks = (const LAS bf16_t*)(lds + buf * SWA_BUF); const LAS bf16_t* Vs = Ks + 64 * KP;
#pragma unroll 1
            for (int sc = 0; sc < 2; ++sc) {
                f32x4 sT[2][2];
#pragma unroll
                for (int qt = 0; qt < 2; ++qt) { sT[qt][0] = (f32x4){0.f, 0.f, 0.f, 0.f}; sT[qt][1] = (f32x4){0.f, 0.f, 0.f, 0.f}; }
#pragma unroll
                for (int ks = 0; ks < 4; ++ks)
#pragma unroll
                    for (int kt = 0; kt < 2; ++kt) { const bf16x8 ka = *(const LAS bf16x8*)(Ks + (sc * 32 + kt * 16 + fr) * KP + ks * 32 + fq * 8);
#pragma unroll
                        for (int qt = 0; qt < 2; ++qt) sT[qt][kt] = __builtin_amdgcn_mfma_f32_16x16x32_bf16(ka, qf[qt][ks], sT[qt][kt], 0, 0, 0); }
                bf16x8 pb[2];
                float cm[2];
#pragma unroll
                for (int qt = 0; qt < 2; ++qt) {
                    if (s < 5) {
                        const int qpos = n0 + qh * 32 + qt * 16 + fr;
#pragma unroll
                        for (int kt = 0; kt < 2; ++kt)
#pragma unroll
                            for (int e = 0; e < 4; ++e) { const int kpos = n0 - 128 + s * 64 + sc * 32 + kt * 16 + fq * 4 + e; const int dlt = qpos - kpos;
                                const bool ok = kpos >= 0 && kpos < SEQ && dlt <= 128 && dlt >= -128; sT[qt][kt][e] = ok ? sT[qt][kt][e] : -1e30f; } }
                    cm[qt] = fmaxf(fmaxf(fmaxf(sT[qt][0][0], sT[qt][0][1]), fmaxf(sT[qt][0][2], sT[qt][0][3])), fmaxf(fmaxf(sT[qt][1][0], sT[qt][1][1]), fmaxf(sT[qt][1][2], sT[qt][1][3])));
                }
                if (__any((cm[0] > m[0] + SWA_THR) || (cm[1] > m[1] + SWA_THR))) {
#pragma unroll
                    for (int qt = 0; qt < 2; ++qt) { float c = cm[qt]; c = fmaxf(c, __shfl_xor(c, 16)); c = fmaxf(c, __shfl_xor(c, 32));
                        const float mn = fmaxf(m[qt], c), scl = __expf(m[qt] - mn); m[qt] = mn; lsum[qt] *= scl;
#pragma unroll
                        for (int dt = 0; dt < 8; ++dt) O[qt][dt] = O[qt][dt] * scl; }
                }
#pragma unroll
                for (int qt = 0; qt < 2; ++qt) {
                    float pe[8]; float ps = 0.f;
#pragma unroll
                    for (int kt = 0; kt < 2; ++kt)
#pragma unroll
                        for (int e = 0; e < 4; ++e) { pe[kt * 4 + e] = __expf(sT[qt][kt][e] - m[qt]); ps += pe[kt * 4 + e]; }
                    lsum[qt] += ps;
                    u32x4 pw; pw.x = pk2(pe[0], pe[1]); pw.y = pk2(pe[2], pe[3]); pw.z = pk2(pe[4], pe[5]); pw.w = pk2(pe[6], pe[7]);
                    pb[qt] = __builtin_bit_cast(bf16x8, pw);
                }
#pragma unroll
                for (int dt = 0; dt < 8; ++dt) {
                    const bf16x4 v0 = *(const LAS bf16x4*)(Vs + (dt * 16 + fr) * VP + sc * 32 + 4 * fq), v1 = *(const LAS bf16x4*)(Vs + (dt * 16 + fr) * VP + sc * 32 + 16 + 4 * fq);
                    const bf16x8 va = __builtin_shufflevector(v0, v1, 0, 1, 2, 3, 4, 5, 6, 7);
#pragma unroll
                    for (int qt = 0; qt < 2; ++qt) O[qt][dt] = __builtin_amdgcn_mfma_f32_16x16x32_bf16(va, pb[qt], O[qt][dt], 0, 0, 0);
                }
            }
            if (s + 1 < 9) SWA_WRITE(buf ^ 1);
            __syncthreads();
        }
#undef SWA_ROW
#undef SWA_LOAD
#undef SWA_WRITE
#pragma unroll
        for (int qt = 0; qt < 2; ++qt) {
            float lt = lsum[qt]; lt += __shfl_xor(lt, 16); lt += __shfl_xor(lt, 32);
            const float inv = 1.0f / lt;
            bf16_t* o = MIX + (qrow0 + qh * 32 + qt * 16 + fr) * DM + 1024 + hq * 128 + fq * 4;
#pragma unroll
            for (int dt = 0; dt < 8; ++dt) { u32x2 w; w.x = pk2(O[qt][dt][0] * inv, O[qt][dt][1] * inv); w.y = pk2(O[qt][dt][2] * inv, O[qt][dt][3] * inv); *(u32x2*)(o + dt * 16) = w; }
        }
    }
}

__device__ __forceinline__ int chunk_row0(int cid) { return cid < 256 ? (cid >> 7) * SEQ + (cid & 127) * 64 : TL + ((cid - 256) >> 2) * CTXL + ((cid - 256) & 3) * 64; }
constexpr int GP = 72;

constexpr int LTP = 65;
__device__ __forceinline__ void gla_g1(const Params& p, int l, LAS unsigned char* lds, int tid, int lane, int wave, int bid, int G) {
    LAS float* LTf = (LAS float*)lds; LAS float* LTb = LTf + 64 * LTP;
    LAS bf16_t* KTf = (LAS bf16_t*)(lds + 2 * 64 * LTP * 4); LAS bf16_t* KTb = KTf + 64 * GP;
    LAS bf16_t* VT = KTb + 64 * GP;
    const bf16_t* P = (const bf16_t*)(p.ws + WS_P);
    float* BF = (float*)(p.ws + WS_OF); float* BB = (float*)(p.ws + WS_OB);
    float* DELTA = (float*)(p.ws + WS_DELTA); float* DEC = (float*)(p.ws + WS_DEC);
    const float* w2 = p.in[I_GW2] + (size_t)l * 2 * 16 * 256; const float* b2 = p.in[I_GB2] + (size_t)l * 2 * 256;
    const int fr = lane & 15, fq = lane >> 4, ti = tid >> 3, tk0 = (tid & 7) * 8;
    float wr[2][16], br[2];
    const bool fixed_h = (G & 3) == 0;
#define G1_LOADW(hh_) do { _Pragma("unroll") for (int d = 0; d < 2; ++d) { br[d] = b2[d * 256 + (hh_) * 64 + lane]; \
        _Pragma("unroll") for (int q = 0; q < 16; ++q) wr[d][q] = w2[(d * 16 + q) * 256 + (hh_) * 64 + lane]; } } while (0)
    if (fixed_h) G1_LOADW(bid & 3);
    u32x4 kraw, vraw[2], lrr[2][4];
#define G1_LOADX(item_) do { const int cid_ = (item_) >> 2, h_ = (item_) & 3, row0_ = chunk_row0(cid_); \
        kraw = *(const u32x4*)(P + (size_t)(row0_ + ti) * INWP + C_GK + h_ * 64 + tk0); \
        _Pragma("unroll") for (int j = 0; j < 2; ++j) { const int vi = tid + NTHREADS * j; vraw[j] = *(const u32x4*)(P + (size_t)(row0_ + (vi >> 4)) * INWP + C_GV + h_ * 128 + (vi & 15) * 8); } \
        _Pragma("unroll") for (int jj = 0; jj < 2; ++jj) _Pragma("unroll") for (int c = 0; c < 4; ++c) lrr[jj][c] = *(const u32x4*)(P + (size_t)(row0_ + wave + 8 * jj) * INWP + C_LRF + c * 8); } while (0)
    if (bid < GLA_ITEMS) G1_LOADX(bid);
    for (int item = bid; item < GLA_ITEMS; item += G) {
        const int cid = item >> 2, h = item & 3, row0 = chunk_row0(cid);
        const u32x4 kraw_c = kraw; u32x4 vraw_c[2] = {vraw[0], vraw[1]};
        {
            if (!fixed_h) G1_LOADW(h);
#pragma unroll
            for (int jj = 0; jj < 8; ++jj) { const int i = wave + 8 * jj;
                float lf[4][8];
                if (jj < 2) {
#pragma unroll
                    for (int c = 0; c < 4; ++c) unpack8(lrr[jj][c], lf[c]);
                } else { const bf16_t* lrp = P + (size_t)(row0 + i) * INWP + C_LRF;
#pragma unroll
                    for (int c = 0; c < 4; ++c) unpack8(*(const u32x4*)(lrp + c * 8), lf[c]); }
#pragma unroll
                for (int d = 0; d < 2; ++d) { float z = br[d];
#pragma unroll
                    for (int q = 0; q < 16; ++q) z += lf[d * 2 + (q >> 3)][q & 7] * wr[d][q];
                    (d ? LTb : LTf)[lane * LTP + i] = log_sigmoid_f(z) * (1.0f / 16.0f); } }
        }
        if (item + G < GLA_ITEMS) G1_LOADX(item + G);
        __syncthreads();
#pragma unroll 2
        for (int kk = 0; kk < 8; ++kk) { const int k = wave * 8 + kk;
            float xf = LTf[k * LTP + lane], xb = LTb[k * LTP + lane];
            float pf = xf, pb = xb;
#pragma unroll
            for (int o = 1; o < 64; o <<= 1) { const float tf = __shfl_up(pf, o), tb = __shfl_up(pb, o); if (lane >= o) { pf += tf; pb += tb; } }
            const float totb = __shfl(pb, 63);
            LTf[k * LTP + lane] = pf; LTb[k * LTP + lane] = totb - pb + xb; }
        __syncthreads();
        { float kv[8]; unpack8(kraw_c, kv);
          float bfv[8], bbv[8];
#pragma unroll
          for (int e = 0; e < 8; ++e) { const int k = tk0 + e; bfv[e] = LTf[k * LTP + ti]; bbv[e] = LTb[k * LTP + ti];
              KTf[k * GP + ti] = (bf16_t)f2bf(kv[e] * __expf(LTf[k * LTP + 63] - bfv[e]));
              KTb[k * GP + ti] = (bf16_t)f2bf(kv[e] * __expf(LTb[k * LTP] - bbv[e])); }
          float* bg = BF + (size_t)(row0 + ti) * 256 + h * 64 + tk0; *(f32x4*)bg = (f32x4){bfv[0], bfv[1], bfv[2], bfv[3]}; *(f32x4*)(bg + 4) = (f32x4){bfv[4], bfv[5], bfv[6], bfv[7]};
          bg = BB + (size_t)(row0 + ti) * 256 + h * 64 + tk0; *(f32x4*)bg = (f32x4){bbv[0], bbv[1], bbv[2], bbv[3]}; *(f32x4*)(bg + 4) = (f32x4){bbv[4], bbv[5], bbv[6], bbv[7]};
#pragma unroll
          for (int j = 0; j < 2; ++j) { const int vi = tid + NTHREADS * j, i = vi >> 4, v0 = (vi & 15) * 8; const u32x4 w = vraw_c[j];
              VT[(v0 + 0) * GP + i] = (bf16_t)(w.x & 0xffffu); VT[(v0 + 1) * GP + i] = (bf16_t)(w.x >> 16); VT[(v0 + 2) * GP + i] = (bf16_t)(w.y & 0xffffu); VT[(v0 + 3) * GP + i] = (bf16_t)(w.y >> 16);
              VT[(v0 + 4) * GP + i] = (bf16_t)(w.z & 0xffffu); VT[(v0 + 5) * GP + i] = (bf16_t)(w.z >> 16); VT[(v0 + 6) * GP + i] = (bf16_t)(w.w & 0xffffu); VT[(v0 + 7) * GP + i] = (bf16_t)(w.w >> 16); }
          if (tid < 128) { const int dir = tid >> 6, k = tid & 63; DEC[((size_t)item * 2 + dir) * 64 + k] = __expf(dir ? LTb[k * LTP] : LTf[k * LTP + 63]); } }
        __syncthreads();
        { const int dir = wave >> 2, vq = wave & 3; const LAS bf16_t* KT = dir ? KTb : KTf;
            f32x4 acc[2][4];
#pragma unroll
            for (int a = 0; a < 2; ++a)
#pragma unroll
                for (int b = 0; b < 4; ++b) acc[a][b] = (f32x4){0.f, 0.f, 0.f, 0.f};
#pragma unroll
            for (int ks = 0; ks < 2; ++ks) { bf16x8 af[2], bfr[4];
#pragma unroll
                for (int a = 0; a < 2; ++a) af[a] = *(const LAS bf16x8*)(VT + ((vq * 2 + a) * 16 + fr) * GP + ks * 32 + fq * 8);
#pragma unroll
                for (int b = 0; b < 4; ++b) bfr[b] = *(const LAS bf16x8*)(KT + (b * 16 + fr) * GP + ks * 32 + fq * 8);
#pragma unroll
                for (int a = 0; a < 2; ++a)
#pragma unroll
                    for (int b = 0; b < 4; ++b) acc[a][b] = __builtin_amdgcn_mfma_f32_16x16x32_bf16(af[a], bfr[b], acc[a][b], 0, 0, 0); }
            float* dst = DELTA + ((size_t)item * 2 + dir) * 8192;
#pragma unroll
            for (int a = 0; a < 2; ++a)
#pragma unroll
                for (int b = 0; b < 4; ++b)
#pragma unroll
                    for (int g = 0; g < 4; ++g) dst[((vq * 2 + a) * 16 + fq * 4 + g) * 64 + b * 16 + fr] = acc[a][b][g]; }
        __syncthreads();
    }
}

#undef G1_LOADW
#undef G1_LOADX
__device__ __forceinline__ void gla_g2(const Params& p, int tid, int bid, int G) {
    const float* DELTA = (const float*)(p.ws + WS_DELTA); const float* DEC = (const float*)(p.ws + WS_DEC); bf16_t* SST = (bf16_t*)(p.ws + WS_SST);
    for (int u = bid; u < 64; u += G) {
        const int s = u >> 2, dir = s >> 3, b = (s >> 2) & 1, h = s & 3, off = ((u & 3) * NTHREADS + tid) * 4, k0 = off & 63;
        f32x4 S = (f32x4){0.f, 0.f, 0.f, 0.f};
#pragma unroll 1
        for (int st = 0; st < 132; st += 12) {
            f32x4 d[12], dc[12]; size_t base[12];
#pragma unroll
            for (int q = 0; q < 12; ++q) { const int t = st + q;
                const int cid = t < 4 ? 256 + b * 4 + (dir ? 3 - t : t) : b * 128 + (dir ? 127 - (t - 4) : (t - 4));
                const size_t it2 = (size_t)(cid * 4 + h) * 2 + dir; base[q] = it2 * 8192 + off;
                d[q] = *(const f32x4*)(DELTA + base[q]); dc[q] = *(const f32x4*)(DEC + it2 * 64 + k0); }
#pragma unroll
            for (int q = 0; q < 12; ++q) { u32x2 o; o.x = pk2(S.x, S.y); o.y = pk2(S.z, S.w); *(u32x2*)(SST + base[q]) = o; S = dc[q] * S + d[q]; }
        }
    }
}

__device__ __forceinline__ void gla_g3(const Params& p, int l, LAS unsigned char* lds, int tid, int lane, int wave, int bid, int G) {
    LAS bf16_t* QEf = (LAS bf16_t*)lds; LAS bf16_t* QEb = QEf + 64 * GP; LAS bf16_t* KEf = QEb + 64 * GP; LAS bf16_t* KEb = KEf + 64 * GP;
    LAS bf16_t* VT = KEb + 64 * GP;
    LAS bf16_t* ATT = VT + 128 * GP + wave * (16 * GP);
    LAS float* RS = (LAS float*)(lds + 2 * (4 * 64 * GP + 128 * GP + 8 * 16 * GP));
    const bf16_t* P = (const bf16_t*)(p.ws + WS_P);
    const float* BF = (const float*)(p.ws + WS_OF); const float* BB = (const float*)(p.ws + WS_OB);
    const bf16_t* SST = (const bf16_t*)(p.ws + WS_SST); bf16_t* MIX = (bf16_t*)(p.ws + WS_MIX);
    const float* nw = p.in[I_GNORM] + l * 128;
    const int fr = lane & 15, fq = lane >> 4, it = wave >> 1, vh = wave & 1, ti = tid >> 3, tk0 = (tid & 7) * 8;
    const int n_items = (l < DEPTH - 1) ? GLA_ITEMS : 256 * 4;
    for (int item = bid; item < n_items; item += G) {
        const int cid = item >> 2, h = item & 3, row0 = chunk_row0(cid);
        {
            const size_t r = (size_t)(row0 + ti);
            const u32x4 qraw = *(const u32x4*)(P + r * INWP + C_GQ + h * 64 + tk0), kraw = *(const u32x4*)(P + r * INWP + C_GK + h * 64 + tk0);
            const f32x4 f0 = *(const f32x4*)(BF + r * 256 + h * 64 + tk0), f1 = *(const f32x4*)(BF + r * 256 + h * 64 + tk0 + 4);
            const f32x4 b0 = *(const f32x4*)(BB + r * 256 + h * 64 + tk0), b1 = *(const f32x4*)(BB + r * 256 + h * 64 + tk0 + 4);
            u32x4 vraw[2];
#pragma unroll
            for (int j = 0; j < 2; ++j) { const int vi = tid + NTHREADS * j; vraw[j] = *(const u32x4*)(P + (size_t)(row0 + (vi >> 4)) * INWP + C_GV + h * 128 + (vi & 15) * 8); }
            float q[8], kk[8]; unpack8(qraw, q); unpack8(kraw, kk);
            const float bf[8] = {f0.x, f0.y, f0.z, f0.w, f1.x, f1.y, f1.z, f1.w}, bb[8] = {b0.x, b0.y, b0.z, b0.w, b1.x, b1.y, b1.z, b1.w};
            float o0[8], o1[8], o2[8], o3[8];
#pragma unroll
            for (int e = 0; e < 8; ++e) { const float ef = __expf(bf[e]), eb = __expf(bb[e]); const float qs = q[e] * 0.125f;
                o0[e] = qs * ef; o1[e] = kk[e] / ef; o2[e] = qs * eb; o3[e] = kk[e] / eb; }
            *(LAS u32x4*)(QEf + ti * GP + tk0) = pack8(o0); *(LAS u32x4*)(KEf + ti * GP + tk0) = pack8(o1); *(LAS u32x4*)(QEb + ti * GP + tk0) = pack8(o2); *(LAS u32x4*)(KEb + ti * GP + tk0) = pack8(o3);
#pragma unroll
            for (int j = 0; j < 2; ++j) { const int vi = tid + NTHREADS * j, i = vi >> 4, v0 = (vi & 15) * 8; const u32x4 w = vraw[j];
                VT[(v0 + 0) * GP + i] = (bf16_t)(w.x & 0xffffu); VT[(v0 + 1) * GP + i] = (bf16_t)(w.x >> 16); VT[(v0 + 2) * GP + i] = (bf16_t)(w.y & 0xffffu); VT[(v0 + 3) * GP + i] = (bf16_t)(w.y >> 16);
                VT[(v0 + 4) * GP + i] = (bf16_t)(w.z & 0xffffu); VT[(v0 + 5) * GP + i] = (bf16_t)(w.z >> 16); VT[(v0 + 6) * GP + i] = (bf16_t)(w.w & 0xffffu); VT[(v0 + 7) * GP + i] = (bf16_t)(w.w >> 16); }
        }
        float gt[4][4];
#pragma unroll
        for (int g = 0; g < 4; ++g)
#pragma unroll
            for (int vt = 0; vt < 4; ++vt) gt[g][vt] = bflo((unsigned)P[(size_t)(row0 + it * 16 + fq * 4 + g) * INWP + C_GG + h * 128 + (vh * 4 + vt) * 16 + fr]);
        __syncthreads();
        f32x4 acc[4];
#pragma unroll
        for (int vt = 0; vt < 4; ++vt) acc[vt] = (f32x4){0.f, 0.f, 0.f, 0.f};
#pragma unroll
        for (int dir = 0; dir < 2; ++dir) {
            const LAS bf16_t* QE = dir ? QEb : QEf; const LAS bf16_t* KE = dir ? KEb : KEf;
            bf16x8 qa[2], sbf[2][4];
            const bf16_t* Sg = SST + ((size_t)item * 2 + dir) * 8192;
#pragma unroll
            for (int ks = 0; ks < 2; ++ks)
#pragma unroll
                for (int vt = 0; vt < 4; ++vt) sbf[ks][vt] = *(const bf16x8*)(Sg + ((vh * 4 + vt) * 16 + fr) * 64 + ks * 32 + fq * 8);
#pragma unroll
            for (int ks = 0; ks < 2; ++ks) qa[ks] = *(const LAS bf16x8*)(QE + (it * 16 + fr) * GP + ks * 32 + fq * 8);
#pragma unroll
            for (int jt = 0; jt < 4; ++jt) { f32x4 a = (f32x4){0.f, 0.f, 0.f, 0.f};
#pragma unroll
                for (int ks = 0; ks < 2; ++ks) { const bf16x8 kb = *(const LAS bf16x8*)(KE + (jt * 16 + fr) * GP + ks * 32 + fq * 8); a = __builtin_amdgcn_mfma_f32_16x16x32_bf16(qa[ks], kb, a, 0, 0, 0); }
#pragma unroll
                for (int g = 0; g < 4; ++g) { const int ii = it * 16 + fq * 4 + g, jj = jt * 16 + fr; const bool keep = dir ? (jj >= ii) : (jj <= ii);
                    ATT[(fq * 4 + g) * GP + jt * 16 + fr] = (bf16_t)f2bf(keep ? a[g] : 0.f); } }
            LDS_FENCE();
#pragma unroll
            for (int ks = 0; ks < 2; ++ks) { const bf16x8 aa = *(const LAS bf16x8*)(ATT + fr * GP + ks * 32 + fq * 8);
#pragma unroll
                for (int vt = 0; vt < 4; ++vt) { const int v = (vh * 4 + vt) * 16 + fr;
                    const bf16x8 vb = *(const LAS bf16x8*)(VT + v * GP + ks * 32 + fq * 8);
                    acc[vt] = __builtin_amdgcn_mfma_f32_16x16x32_bf16(aa, vb, acc[vt], 0, 0, 0);
                    acc[vt] = __builtin_amdgcn_mfma_f32_16x16x32_bf16(qa[ks], sbf[ks][vt], acc[vt], 0, 0, 0); } }
            LDS_FENCE();
        }
        float ss[4];
#pragma unroll
        for (int g = 0; g < 4; ++g) { float t = 0.f;
#pragma unroll
            for (int vt = 0; vt < 4; ++vt) t += acc[vt][g] * acc[vt][g];
            t += __shfl_xor(t, 1); t += __shfl_xor(t, 2); t += __shfl_xor(t, 4); t += __shfl_xor(t, 8); ss[g] = t; }
        if (fr == 0) {
#pragma unroll
            for (int g = 0; g < 4; ++g) RS[(it * 16 + fq * 4 + g) * 2 + vh] = ss[g]; }
        __syncthreads();
#pragma unroll
        for (int g = 0; g < 4; ++g) { const int i = it * 16 + fq * 4 + g; const float tot = RS[i * 2] + RS[i * 2 + 1];
            const float rs = 1.0f / sqrtf(tot * (1.0f / 128.0f) + LN_EPS); const size_t r = (size_t)(row0 + i);
#pragma unroll
            for (int vt = 0; vt < 4; ++vt) { const int v = (vh * 4 + vt) * 16 + fr;
                MIX[r * DM + 512 + h * 128 + v] = (bf16_t)f2bf(acc[vt][g] * rs * nw[v] * silu_f(gt[g][vt])); } }
        __syncthreads();
    }
}

__device__ __forceinline__ void ln_row(f32x4 (&v)[8], const float* lg, const float* lb, int lane) {
    float s = 0.f;
#pragma unroll
    for (int j = 0; j < 8; ++j) s += (v[j].x + v[j].y) + (v[j].z + v[j].w);
    const float mean = wave_sum(s) * (1.0f / DM);
    float s2 = 0.f;
#pragma unroll
    for (int j = 0; j < 8; ++j) { v[j] = v[j] - mean; s2 += (v[j].x * v[j].x + v[j].y * v[j].y) + (v[j].z * v[j].z + v[j].w * v[j].w); }
    const float rstd = 1.0f / sqrtf(wave_sum(s2) * (1.0f / DM) + LN_EPS);
#pragma unroll
    for (int j = 0; j < 8; ++j) { const int c = lane * 4 + 256 * j; const f32x4 g = *(const f32x4*)(lg + c), b = *(const f32x4*)(lb + c); v[j] = v[j] * rstd * g + b; }
}

__device__ __forceinline__ void phase_ln1(const Params& p, int l, LAS unsigned char* lds, int tid, int lane, int wave, int bid, int G) {
    const int gw = bid * NWAVES + wave, NGW = G * NWAVES;
    const float* MOD = (const float*)(p.ws + WS_MOD); const bf16_t* Y = (const bf16_t*)(p.ws + WS_Y); const float* YP = (const float*)(p.ws + WS_YPART);
    bf16_t* XM = (bf16_t*)(p.ws + WS_XM); bf16_t* HB = (bf16_t*)(p.ws + WS_HB);
    LAS float* VEC = (LAS float*)lds;
    for (int i = tid; i < 11 * DM / 4; i += NTHREADS) { const int vi = i / (DM / 4), c = (i % (DM / 4)) * 4;
        const float* src = vi < 9 ? MOD + (size_t)(l * 3 + (vi % 3)) * 6 * DM + (2 + vi / 3) * DM + c : (vi == 9 ? p.in[I_LNG] : p.in[I_LNB]) + (size_t)(l * 2 + 0) * DM + c;
        *(LAS f32x4*)(VEC + vi * DM + c) = *(const f32x4*)src; }
    __syncthreads();
    f32x4 xn[8]; u32x2 yn[8];
#define LN1_LOAD(rr) do { if (l == 0) { const float* xr_ = xsrc(p, 0, (rr)); _Pragma("unroll") for (int j = 0; j < 8; ++j) xn[j] = *(const f32x4*)(xr_ + lane * 4 + 256 * j); } \
        else { const bf16_t* xb_ = (const bf16_t*)(p.ws + WS_XL) + (size_t)(rr) * DM; _Pragma("unroll") for (int j = 0; j < 8; ++j) { const u32x2 w_ = *(const u32x2*)(xb_ + lane * 4 + 256 * j); xn[j] = (f32x4){bflo(w_.x), bfhi(w_.x), bflo(w_.y), bfhi(w_.y)}; } } \
        if ((rr) < TL) { _Pragma("unroll") for (int j = 0; j < 8; ++j) yn[j] = *(const u32x2*)(Y + (size_t)(rr) * DM + lane * 4 + 256 * j); } } while (0)
    if (row_first(wave, bid, G) >= 0) LN1_LOAD(row_first(wave, bid, G));
    for (int r = row_first(wave, bid, G); r >= 0; r = row_next(r, wave, bid, G, TA)) {
        const int st = row_stream(r);
        f32x4 v[8], yy[8];
#pragma unroll
        for (int j = 0; j < 8; ++j) v[j] = xn[j];
        if (r < TL) {
#pragma unroll
            for (int j = 0; j < 8; ++j) yy[j] = (f32x4){bflo(yn[j].x), bfhi(yn[j].x), bflo(yn[j].y), bfhi(yn[j].y)};
        } else {
#pragma unroll
            for (int j = 0; j < 8; j += 2) { f32x4 pp[2][8];
#pragma unroll
                for (int jj = 0; jj < 2; ++jj)
#pragma unroll
                    for (int ks = 0; ks < 8; ++ks) pp[jj][ks] = *(const f32x4*)(YP + ((size_t)ks * 512 + (r - TL)) * DM + lane * 4 + 256 * (j + jj));
#pragma unroll
                for (int jj = 0; jj < 2; ++jj) yy[j + jj] = ((pp[jj][0] + pp[jj][1]) + (pp[jj][2] + pp[jj][3])) + ((pp[jj][4] + pp[jj][5]) + (pp[jj][6] + pp[jj][7])); }
        }
        { const int rn = row_next(r, wave, bid, G, TA); if (rn >= 0) LN1_LOAD(rn); }
#pragma unroll
        for (int j = 0; j < 8; ++j) { const f32x4 g = *(const LAS f32x4*)(VEC + st * DM + lane * 4 + 256 * j); v[j] = v[j] * DN_ALPHA + g * yy[j]; }
        float s = 0.f;
#pragma unroll
        for (int j = 0; j < 8; ++j) s += (v[j].x + v[j].y) + (v[j].z + v[j].w);
        const float mean = wave_sum(s) * (1.0f / DM);
        float s2 = 0.f;
#pragma unroll
        for (int j = 0; j < 8; ++j) { v[j] = v[j] - mean; s2 += (v[j].x * v[j].x + v[j].y * v[j].y) + (v[j].z * v[j].z + v[j].w * v[j].w); }
        const float rstd = 1.0f / sqrtf(wave_sum(s2) * (1.0f / DM) + LN_EPS);
#pragma unroll
        for (int j = 0; j < 8; ++j) { const int c = lane * 4 + 256 * j;
            const f32x4 g = *(const LAS f32x4*)(VEC + 9 * DM + c), b = *(const LAS f32x4*)(VEC + 10 * DM + c), sh = *(const LAS f32x4*)(VEC + (3 + st) * DM + c), sc = *(const LAS f32x4*)(VEC + (6 + st) * DM + c);
            const f32x4 o = v[j] * rstd * g + b;
            { u32x2 xw; xw.x = pk2(o.x, o.y); xw.y = pk2(o.z, o.w); *(u32x2*)(XM + (size_t)r * DM + c) = xw; }
            u32x2 w; w.x = pk2(o.x * (1.f + sc.x) + sh.x, o.y * (1.f + sc.y) + sh.y); w.y = pk2(o.z * (1.f + sc.z) + sh.z, o.w * (1.f + sc.w) + sh.w);
            *(u32x2*)(HB + (size_t)r * DM + c) = w; }
    }
#undef LN1_LOAD
}

constexpr int SKP = 136;
__device__ __forceinline__ unsigned f2key(float f) { const unsigned u = __builtin_bit_cast(unsigned, f); return u ^ ((u >> 31) ? 0xFFFFFFFFu : 0x80000000u); }
__device__ __forceinline__ float key2f(unsigned k) { const unsigned u = (k >> 31) ? (k ^ 0x80000000u) : ~k; return __builtin_bit_cast(float, u); }
__device__ __forceinline__ unsigned row16_max_u32(unsigned k) {
    unsigned o;
    o = (unsigned)__builtin_amdgcn_update_dpp(0, (int)k, 0xB1, 0xF, 0xF, false); k = k > o ? k : o;
    o = (unsigned)__builtin_amdgcn_update_dpp(0, (int)k, 0x4E, 0xF, 0xF, false); k = k > o ? k : o;
    o = (unsigned)__builtin_amdgcn_update_dpp(0, (int)k, 0x141, 0xF, 0xF, false); k = k > o ? k : o;
    o = (unsigned)__builtin_amdgcn_update_dpp(0, (int)k, 0x140, 0xF, 0xF, false); k = k > o ? k : o;
    return k;
}
__device__ __forceinline__ void peer_retrieve(const Params& p, int l, LAS unsigned char* lds, int tid, int lane, int wave, int bid, int G, int ntok) {
    LAS bf16_t* SK = (LAS bf16_t*)lds;
    const bf16_t* SUBB = (const bf16_t*)(p.ws + WS_SUBB) + (size_t)l * 2 * 128 * 128;
#pragma unroll 1
    for (int j = 0; j < 8; ++j) { const int vv = tid + NTHREADS * j, row = vv >> 4, c = vv & 15; *(LAS u32x4*)(SK + row * SKP + c * 8) = *(const u32x4*)(SUBB + row * 128 + c * 8); }
    __syncthreads();
    const bf16_t* QP = (const bf16_t*)(p.ws + WS_QP); const float* QPP = (const float*)(p.ws + WS_QPART);
    int* EIDX = (int*)(p.ws + WS_EIDX); float* EGATE = (float*)(p.ws + WS_EGATE);
    const int gw = bid * NWAVES + wave, NGW = G * NWAVES, fr = lane & 15, fq = lane >> 4, gbase = lane & 48;
    const int nitems = (ntok / 16) * 8;
    const int nmain = nitems / NGW, nfull = nmain * NGW, nextra = (wave == 0 && nfull + bid < nitems) ? (nitems - nfull - bid + G - 1) / G : 0;
    for (int ri = 0; ri < nmain + nextra; ++ri) {
        const int item = ri < nmain ? gw + NGW * ri : nfull + bid + (ri - nmain) * G;
        const int tile = item >> 3, h = item & 7;
        unsigned tkp[2][4];
        bf16x8 afr[2][4];
        if (tile * 16 < TL) {
#pragma unroll
            for (int pp = 0; pp < 2; ++pp)
#pragma unroll
                for (int ks = 0; ks < 4; ++ks) afr[pp][ks] = *(const bf16x8*)(QP + (size_t)(tile * 16 + fr) * DM + h * 256 + pp * 128 + ks * 32 + fq * 8);
        } else {
#pragma unroll
            for (int pp = 0; pp < 2; ++pp)
#pragma unroll
                for (int ks = 0; ks < 4; ++ks) { const float* qp = QPP + (size_t)(tile * 16 - TL + fr) * DM + h * 256 + pp * 128 + ks * 32 + fq * 8;
                    f32x4 pa[8], pb[8];
#pragma unroll
                    for (int sl = 0; sl < 8; ++sl) { pa[sl] = *(const f32x4*)(qp + (size_t)sl * 512 * DM); pb[sl] = *(const f32x4*)(qp + (size_t)sl * 512 * DM + 4); }
                    const f32x4 s0 = ((pa[0] + pa[1]) + (pa[2] + pa[3])) + ((pa[4] + pa[5]) + (pa[6] + pa[7])), s1 = ((pb[0] + pb[1]) + (pb[2] + pb[3])) + ((pb[4] + pb[5]) + (pb[6] + pb[7]));
                    u32x4 w; w.x = pk2(s0.x, s0.y); w.y = pk2(s0.z, s0.w); w.z = pk2(s1.x, s1.y); w.w = pk2(s1.z, s1.w); afr[pp][ks] = __builtin_bit_cast(bf16x8, w); }
        }
#pragma unroll
        for (int pp = 0; pp < 2; ++pp) {
            asm volatile("" ::: "memory"); __builtin_amdgcn_sched_barrier(0);
            f32x4 acc[8];
#pragma unroll
            for (int kt = 0; kt < 8; ++kt) acc[kt] = (f32x4){0.f, 0.f, 0.f, 0.f};
#pragma unroll
            for (int ks = 0; ks < 4; ++ks) { const bf16x8 a = afr[pp][ks];
#pragma unroll
                for (int kt = 0; kt < 8; ++kt) { const bf16x8 bb = *(const LAS bf16x8*)(SK + (pp * 128 + kt * 16 + fr) * SKP + ks * 32 + fq * 8); acc[kt] = __builtin_amdgcn_mfma_f32_16x16x32_bf16(a, bb, acc[kt], 0, 0, 0); } }
            unsigned kv[4][8];
#pragma unroll
            for (int g = 0; g < 4; ++g)
#pragma unroll
                for (int kt = 0; kt < 8; ++kt) kv[g][kt] = (f2key(acc[kt][g]) & ~127u) | (unsigned)(127 - (kt * 16 + fr));
#define CSWAP(a_, b_) do { const unsigned hi_ = a_ > b_ ? a_ : b_, lo_ = a_ > b_ ? b_ : a_; a_ = hi_; b_ = lo_; } while (0)
#pragma unroll
            for (int g = 0; g < 4; ++g) {
                CSWAP(kv[g][0], kv[g][1]); CSWAP(kv[g][2], kv[g][3]); CSWAP(kv[g][4], kv[g][5]); CSWAP(kv[g][6], kv[g][7]);
                CSWAP(kv[g][0], kv[g][2]); CSWAP(kv[g][1], kv[g][3]); CSWAP(kv[g][4], kv[g][6]); CSWAP(kv[g][5], kv[g][7]);
                CSWAP(kv[g][1], kv[g][2]); CSWAP(kv[g][5], kv[g][6]);
                CSWAP(kv[g][0], kv[g][4]); CSWAP(kv[g][1], kv[g][5]); CSWAP(kv[g][2], kv[g][6]); CSWAP(kv[g][3], kv[g][7]);
                CSWAP(kv[g][2], kv[g][4]); CSWAP(kv[g][3], kv[g][5]);
                CSWAP(kv[g][1], kv[g][2]); CSWAP(kv[g][3], kv[g][4]); CSWAP(kv[g][5], kv[g][6]);
            }
#undef CSWAP
            unsigned tk[4] = {0u, 0u, 0u, 0u};
#pragma unroll 1
            for (int it = 0; it < 16; ++it) {
#pragma unroll
                for (int g = 0; g < 4; ++g) {
                    const unsigned m = row16_max_u32(kv[g][0]);
                    tk[g] = fr == it ? m : tk[g];
                    const bool won = kv[g][0] == m;
#pragma unroll
                    for (int kt = 0; kt < 7; ++kt) kv[g][kt] = won ? kv[g][kt + 1] : kv[g][kt];
                    kv[g][7] = won ? 0u : kv[g][7];
                }
            }
#pragma unroll
            for (int g = 0; g < 4; ++g) tkp[pp][g] = tk[g];
        }
        float av[4], bv[4]; int ptr[4]; unsigned best[4];
#pragma unroll
        for (int g = 0; g < 4; ++g) { av[g] = key2f(tkp[0][g] & ~127u); bv[g] = key2f(tkp[1][g] & ~127u); ptr[g] = 0; best[g] = 0u; }
#pragma unroll 1
        for (int it = 0; it < 16; ++it) {
#pragma unroll
            for (int g = 0; g < 4; ++g) {
                const float bj = __shfl(bv[g], gbase + (ptr[g] & 15));
                const unsigned mine = ptr[g] < 16 ? ((f2key(av[g] + bj) & ~255u) | (unsigned)(255 - (fr * 16 + (ptr[g] & 15)))) : 0u;
                const unsigned m = row16_max_u32(mine);
                best[g] = fr == it ? m : best[g];
                ptr[g] += (m == mine) ? 1 : 0;
            }
        }
#pragma unroll
        for (int g = 0; g < 4; ++g) {
            const int bc = 255 - (int)(best[g] & 255u);
            const float bval = key2f(best[g] & ~255u);
            const int k1 = 127 - (int)(tkp[0][g] & 127u), k2 = 127 - (int)(tkp[1][g] & 127u);
            const int i1 = __shfl(k1, gbase + (bc >> 4)), i2 = __shfl(k2, gbase + (bc & 15));
            const float mx = __shfl(bval, gbase);
            const float ex = __expf(bval - mx);
            float sm = ex;
#pragma unroll
            for (int o = 1; o < 16; o <<= 1) sm += __shfl_xor(sm, o);
            const size_t tok = (size_t)tile * 16 + fq * 4 + g;
            EIDX[tok * 128 + h * 16 + fr] = i1 * 128 + i2; EGATE[tok * 128 + h * 16 + fr] = ex / sm;
        }
    }
}

template <int CTRL> __device__ __forceinline__ float dppf(float x) { return __builtin_bit_cast(float, __builtin_amdgcn_mov_dpp(__builtin_bit_cast(int, x), CTRL, 0xf, 0xf, true)); }
__device__ __forceinline__ float rs_group8(float (&d)[8], bool b8) {
    asm volatile("s_nop 1\n\tv_permlane32_swap_b32 %0, %4\n\tv_permlane32_swap_b32 %1, %5\n\tv_permlane32_swap_b32 %2, %6\n\tv_permlane32_swap_b32 %3, %7"
                 : "+v"(d[0]), "+v"(d[1]), "+v"(d[2]), "+v"(d[3]), "+v"(d[4]), "+v"(d[5]), "+v"(d[6]), "+v"(d[7]));
    float s0 = d[0] + d[4], s1 = d[1] + d[5], s2 = d[2] + d[6], s3 = d[3] + d[7];
    asm volatile("s_nop 1\n\tv_permlane16_swap_b32 %0, %2\n\tv_permlane16_swap_b32 %1, %3" : "+v"(s0), "+v"(s1), "+v"(s2), "+v"(s3));
    const float t0 = s0 + s2, t1 = s1 + s3;
    const float m = b8 ? t1 : t0, o = b8 ? t0 : t1;
    return m + dppf<0x128>(o);
}
template <int CTRL> __device__ __forceinline__ float rs_merge(float a, float b, bool bit) { const float m = bit ? b : a, o = bit ? a : b; return m + dppf<CTRL>(o); }
constexpr int PG = 8;
__device__ __forceinline__ void phase_peer(const Params& p, int l, LAS unsigned char* lds, int tid, int lane, int wave, int bid, int G) {
    const int gw = bid * NWAVES + wave, NGW = G * NWAVES;
    const float* MOD = (const float*)(p.ws + WS_MOD);
    bf16_t* XL = (bf16_t*)(p.ws + WS_XL); bf16_t* HB = (bf16_t*)(p.ws + WS_HB);
    const float* lg = p.in[I_LNG] + (size_t)(l * 2 + 1) * DM; const float* lb = p.in[I_LNB] + (size_t)(l * 2 + 1) * DM;
    const unsigned char* UB = p.ws + WS_UB + (size_t)l * NEXP * ROWB_U; const unsigned char* VB = p.ws + WS_VB + (size_t)l * NEXP * ROWB_V;
    const float* USC = (const float*)(p.ws + WS_USC) + (size_t)l * NEXP; (void)USC; const float* VSC = (const float*)(p.ws + WS_VSC) + (size_t)l * NEXP; (void)VSC;
    const int* EIDX = (const int*)(p.ws + WS_EIDX); const float* EGATE = (const float*)(p.ws + WS_EGATE);
    const bool last = (l == DEPTH - 1);
    const int nrows = last ? TL : TA;
    constexpr int HLW = 64 * 33 * 4 + 128;
    LAS float* HL = (LAS float*)(lds + wave * HLW) + lane * 33;
    LAS int* PI = (LAS int*)((LAS float*)(lds + wave * HLW) + 64 * 33);
    LAS float* VEC = (LAS float*)(lds + 8 * HLW);
    for (int i = tid; i < 11 * DM / 4; i += NTHREADS) { const int vi = i / (DM / 4), c = (i % (DM / 4)) * 4; const int ln = last ? l : l + 1;
        const float* src = vi < 3 ? MOD + (size_t)(l * 3 + vi) * 6 * DM + 5 * DM + c : (vi < 9 ? MOD + (size_t)(ln * 3 + (vi % 3)) * 6 * DM + (vi / 3 - 1) * DM + c : (vi == 9 ? lg : lb) + c);
        *(LAS f32x4*)(VEC + vi * DM + c) = *(const f32x4*)src; }
    __syncthreads();
#if !TBL_U_FP4
    {
        float one = 1.0f; asm volatile("" : "+v"(one));
        f32x16 t0, t1;
#pragma unroll
        for (int c = 0; c < 32; ++c) { const float v = one * (c < 8 ? (float)c * 0.125f : (1.0f + (float)(c & 7) * 0.125f) * (float)(1 << ((c >> 3) - 1))); if (c < 16) t0[c] = v; else t1[c - 16] = v; }
        const u32x6 pw = pack_fp6_2x16(t0, t1);
        const f32x32 un = unpack_fp6_32(pw);
#pragma unroll
        for (int j = 0; j < 32; ++j) { const float y = un[j]; int c;
            if (y < 1.0f) c = (int)(y * 8.0f + 0.5f); else { const int e = y < 2.0f ? 0 : (y < 4.0f ? 1 : 2); c = 8 * (e + 1) + (int)((y / (float)(1 << e) - 1.0f) * 8.0f + 0.5f); }
            if (lane == 0) PI[j] = c & 31; }
        LDS_FENCE();
#if defined(DIAG_PI)
        { unsigned mk = 0u;
#pragma unroll
          for (int j = 0; j < 32; ++j) mk |= 1u << PI[j];
          if (mk != 0xFFFFFFFFu && l == 0 && gw == 0 && lane == 0) ((float*)(p.ws + WS_CTL + 131072))[0] = 1.0f; }
#endif
    }
#endif
    const unsigned ulane = (unsigned)lane & 63u, loff16 = ulane * 16u; (void)ulane; (void)loff16;
    const bool lb8 = (lane & 8) != 0, lb4 = (lane & 4) != 0, lb2 = (lane & 2) != 0, lb1 = (lane & 1) != 0; (void)lb8; (void)lb4; (void)lb2; (void)lb1;
    const int lsrc = ((lane & 6) << 3) | ((lane & 1) << 3) | (((lane >> 3) & 1) << 2) | (((lane >> 4) & 1) << 1) | ((lane >> 5) & 1); (void)lsrc;
    for (int r = row_first(wave, bid, G); r >= 0; r = row_next(r, wave, bid, G, nrows)) {
        const float* mod = MOD + (size_t)(l * 3 + row_stream(r)) * 6 * DM;
        f32x2v hn[16];
#pragma unroll
        for (int c = 0; c < 4; ++c) { float f[8]; unpack8(*(const u32x4*)(HB + (size_t)r * DM + lane * 32 + c * 8), f);
#pragma unroll
            for (int e = 0; e < 4; ++e) hn[c * 4 + e] = (f32x2v){f[2 * e], f[2 * e + 1]}; }
#if !TBL_U_FP4
#pragma unroll
        for (int j = 0; j < 16; ++j) { HL[2 * j] = hn[j].x; HL[2 * j + 1] = hn[j].y; }
        LDS_FENCE();
        f32x2v hf[16];
#pragma unroll
        for (int j = 0; j < 16; ++j) hf[j] = (f32x2v){HL[PI[2 * j]], HL[PI[2 * j + 1]]};
        LDS_FENCE();
#endif
#if TBL_U_I4
        int hlo[4], hhi[4]; unsigned basel;
        { float am = 0.f;
#pragma unroll
          for (int j = 0; j < 16; ++j) am = fmaxf(am, fmaxf(fabsf(hn[j].x), fabsf(hn[j].y)));
          const unsigned ab = __builtin_bit_cast(unsigned, am * (1.0f / 119.0f)); unsigned eb = (ab >> 23) + ((ab & 0x007fffffu) ? 1u : 0u); eb = eb < 1u ? 1u : (eb > 253u ? 253u : eb);
          const float inv = __builtin_bit_cast(float, (254u - eb) << 23);
          basel = U_ROWSCALE ? (eb << 23) : (I4_BASE + ((eb - 127u) << 23));
#pragma unroll
          for (int d = 0; d < 4; ++d) { unsigned tl = 0u, th = 0u;
#pragma unroll
              for (int e = 0; e < 8; ++e) { const f32x2v pr = hn[d * 4 + (e >> 1)]; const float xv = (e & 1) ? pr.y : pr.x;
                  const unsigned qb = __builtin_bit_cast(unsigned, xv * inv + 12582912.0f);
                  tl |= (qb & 15u) << (4 * e); th |= (((qb + 8u) >> 4) & 15u) << (4 * e); }
              hlo[d] = (int)tl; hhi[d] = (int)th; } }
#endif
        const int e0 = EIDX[(size_t)r * 128 + lane], e1 = EIDX[(size_t)r * 128 + 64 + lane];
        const float g0 = EGATE[(size_t)r * 128 + lane], g1 = EGATE[(size_t)r * 128 + 64 + lane];
#if !TBL_U_FP4 || U_ROWSCALE
        const float su0 = USC[e0], su1 = USC[e1];
#else
        const float su0 = 1.0f, su1 = 1.0f;
#endif
        float wgt[2] = {0.f, 0.f};
#define P4_LOAD(dq, ds, TB, eh, j0) do { unsigned lo_ = loff16, ul_ = ulane; asm volatile("" : "+v"(lo_), "+v"(ul_));    \
        _Pragma("unroll") for (int c = 0; c < PG; ++c) { const int e_ = __builtin_amdgcn_readlane(eh, (j0) + c); \
            const unsigned char* rp_ = (TB) + (size_t)e_ * ROWB4; dq[c] = *(const u32x4*)(rp_ + lo_); ds[c] = rp_[1024u + ul_]; } } while (0)
#if V_ROWSCALE
#define P4_LDV P4_LOADU
#else
#define P4_LDV P4_LOAD
#endif
#if U_ROWSCALE
#define P4_LDU P4_LOADU
#else
#define P4_LDU P4_LOAD
#endif
#define P4_LOADU(dq, ds, TB, eh, j0) do { const __amdgpu_buffer_rsrc_t rs_ = __builtin_amdgcn_make_buffer_rsrc((void*)(TB), 0, NEXP * 1024, 0x00020000); \
        _Pragma("unroll") for (int c = 0; c < PG; ++c) { const int e_ = __builtin_amdgcn_readlane(eh, (j0) + c); \
            dq[c] = __builtin_bit_cast(u32x4, __builtin_amdgcn_raw_buffer_load_b128(rs_, (int)loff16, (int)((unsigned)e_ << 10), 0)); ds[c] = 0; } } while (0)
#define P4_CVT(dq, c, d, b, sc) __builtin_amdgcn_cvt_scalef32_pk_f32_fp4(dq[c][d], sc, b)
#if TBL_U_I4
#define P4_DOT(dq, ds, rr) do { float d_[PG]; _Pragma("unroll") for (int c = 0; c < PG; ++c) { int t_ = 0;        \
            _Pragma("unroll") for (int d = 0; d < 4; ++d) t_ = __builtin_amdgcn_sdot8((int)dq[c][d], hhi[d], t_, false); \
            t_ <<= 4; \
            _Pragma("unroll") for (int d = 0; d < 4; ++d) t_ = __builtin_amdgcn_sdot8((int)dq[c][d], hlo[d], t_, false); \
            d_[c] = (float)t_ * (U_ROWSCALE ? __builtin_bit_cast(float, basel) : __builtin_bit_cast(float, ((unsigned)ds[c] << 20) + basel)); } \
        rr = rs_group8(d_, lb8); } while (0)
#else
#define P4_DOT(dq, ds, rr) do { float d_[PG]; _Pragma("unroll") for (int c = 0; c < PG; ++c) { const float sc_ = __builtin_bit_cast(float, (unsigned)ds[c] << 23); f32x2v a0_ = (f32x2v){0.f, 0.f}, a1_ = (f32x2v){0.f, 0.f}; \
            _Pragma("unroll") for (int d = 0; d < 4; ++d) { a0_ += P4_CVT(dq, c, d, 0, sc_) * hn[d * 4 + 0]; a1_ += P4_CVT(dq, c, d, 1, sc_) * hn[d * 4 + 1]; a0_ += P4_CVT(dq, c, d, 2, sc_) * hn[d * 4 + 2]; a1_ += P4_CVT(dq, c, d, 3, sc_) * hn[d * 4 + 3]; } \
            d_[c] = (a0_.x + a0_.y) + (a1_.x + a1_.y); asm volatile("" : "+v"(d_[c])); } \
        rr = rs_group8(d_, lb8); } while (0)
#endif
#define P4_AXPY(dq, ds, wh, j0) do { _Pragma("unroll") for (int c = 0; c < PG; ++c) { const float wj_ = __builtin_bit_cast(float, __builtin_amdgcn_readlane(wh, (j0) + c)); const f32x2v w2_ = (f32x2v){wj_, wj_}; \
            const float sc_ = V_ROWSCALE ? 1.0f : __builtin_bit_cast(float, (unsigned)ds[c] << 23); \
            _Pragma("unroll") for (int d = 0; d < 4; ++d) { yv[d * 4 + 0] += P4_CVT(dq, c, d, 0, sc_) * w2_; yv[d * 4 + 1] += P4_CVT(dq, c, d, 1, sc_) * w2_; yv[d * 4 + 2] += P4_CVT(dq, c, d, 2, sc_) * w2_; yv[d * 4 + 3] += P4_CVT(dq, c, d, 3, sc_) * w2_; } \
            asm volatile("" : "+v"(yv[0]), "+v"(yv[1]), "+v"(yv[2]), "+v"(yv[3]), "+v"(yv[4]), "+v"(yv[5]), "+v"(yv[6]), "+v"(yv[7]), "+v"(yv[8]), "+v"(yv[9]), "+v"(yv[10]), "+v"(yv[11]), "+v"(yv[12]), "+v"(yv[13]), "+v"(yv[14]), "+v"(yv[15]));   } } while (0)
#if !TBL_U_FP4
#define PEER_LOAD(dq, dd, TB, eh, j0) do { _Pragma("unroll") for (int c = 0; c < PG; ++c) { const int e_ = __builtin_amdgcn_readlane(eh, (j0) + c); \
            const unsigned char* rp_ = (TB) + (size_t)e_ * ROWB; dq[c] = *(const u32x4*)(rp_ + lane * 16); dd[c] = *(const u32x2*)(rp_ + 1024 + lane * 8); } } while (0)
#define PEER_UNPACK(dq, dd, c) unpack_fp6_32((u32x6){dq[c].x, dq[c].y, dq[c].z, dq[c].w, dd[c].x, dd[c].y})
#define PEER_DOT(dq, dd, j0) do { float d_[PG]; _Pragma("unroll") for (int c = 0; c < PG; ++c) { const f32x32 u_ = PEER_UNPACK(dq, dd, c); f32x2v a0_ = (f32x2v){0.f, 0.f}, a1_ = (f32x2v){0.f, 0.f}; \
            _Pragma("unroll") for (int t = 0; t < 8; ++t) { a0_ += (f32x2v){u_[4 * t], u_[4 * t + 1]} * hf[2 * t]; a1_ += (f32x2v){u_[4 * t + 2], u_[4 * t + 3]} * hf[2 * t + 1]; } \
            d_[c] = (a0_.x + a0_.y) + (a1_.x + a1_.y); __builtin_amdgcn_sched_barrier(0); } \
        _Pragma("unroll") for (int o = 1; o < 64; o <<= 1) { _Pragma("unroll") for (int c = 0; c < PG; ++c) d_[c] += __shfl_xor(d_[c], o); } \
        _Pragma("unroll") for (int c = 0; c < PG; ++c) wacc = (lane == (j0) + c) ? d_[c] : wacc; } while (0)
#endif
#pragma unroll
        for (int hh = 0; hh < 2; ++hh) {
            const int eh = hh ? e1 : e0; float wacc = 0.f;
#if TBL_U_FP4
            u32x4 qa[PG], qb[PG]; unsigned char sa[PG], sb[PG];
            P4_LDU(qa, sa, UB, eh, 0);
            float wq = 0.f, wp = 0.f;
#pragma unroll 1
            for (int j0 = 0; j0 < 64; j0 += 2 * PG) {
                float ra, rb;
                P4_LDU(qb, sb, UB, eh, j0 + PG);
                P4_DOT(qa, sa, ra);
                if (j0 + 2 * PG < 64) P4_LDU(qa, sa, UB, eh, j0 + 2 * PG);
                P4_DOT(qb, sb, rb);
                const float q = rs_merge<0x141>(ra, rb, lb4);
                if ((j0 & 16) == 0) wq = q;
                else { const float pm = rs_merge<0x4E>(wq, q, lb2);
                       if (j0 == 16) wp = pm; else wacc = rs_merge<0xB1>(wp, pm, lb1); }
            }
            wacc = __shfl(wacc, lsrc);
#else
            u32x4 qa[PG], qb[PG]; u32x2 da[PG], db[PG];
            PEER_LOAD(qa, da, UB, eh, 0);
#pragma unroll 1
            for (int j0 = 0; j0 < 64; j0 += 2 * PG) {
                PEER_LOAD(qb, db, UB, eh, j0 + PG);
                PEER_DOT(qa, da, j0);
                if (j0 + 2 * PG < 64) PEER_LOAD(qa, da, UB, eh, j0 + 2 * PG);
                PEER_DOT(qb, db, j0 + PG);
            }
#endif
            wgt[hh] = gelu_f(wacc * (hh ? su1 : su0)) * (hh ? g1 : g0) * (V_ROWSCALE ? VSC[eh] : 1.0f);
        }
        f32x2v yv[16];
#pragma unroll
        for (int i = 0; i < 16; ++i) yv[i] = (f32x2v){0.f, 0.f};
#pragma unroll
        for (int hh = 0; hh < 2; ++hh) {
            const int eh = hh ? e1 : e0; const int wh = __builtin_bit_cast(int, wgt[hh]);
            u32x4 qa[PG], qb[PG]; unsigned char sa[PG], sb[PG];
            P4_LDV(qa, sa, VB, eh, 0);
#pragma unroll 1
            for (int j0 = 0; j0 < 64; j0 += 2 * PG) {
                P4_LDV(qb, sb, VB, eh, j0 + PG);
                P4_AXPY(qa, sa, wh, j0);
                if (j0 + 2 * PG < 64) P4_LDV(qa, sa, VB, eh, j0 + 2 * PG);
                P4_AXPY(qb, sb, wh, j0 + PG);
            }
        }
#undef P4_LOAD
#undef P4_CVT
#undef P4_DOT
#undef P4_AXPY
#if !TBL_U_FP4
#undef PEER_LOAD
#undef PEER_UNPACK
#undef PEER_DOT
#endif
        const int st = row_stream(r);
        const bf16_t* xr = (const bf16_t*)(p.ws + WS_XM) + (size_t)r * DM + lane * 32;
        f32x4 xv[8];
#pragma unroll
        for (int t = 0; t < 4; ++t) { const u32x4 w = *(const u32x4*)(xr + t * 8); xv[2 * t] = (f32x4){bflo(w.x), bfhi(w.x), bflo(w.y), bfhi(w.y)}; xv[2 * t + 1] = (f32x4){bflo(w.z), bfhi(w.z), bflo(w.w), bfhi(w.w)}; }
        float s = 0.f;
#pragma unroll
        for (int t = 0; t < 8; ++t) { const f32x4 ga = *(const LAS f32x4*)(VEC + st * DM + lane * 32 + t * 4);
            f32x2v& ya = yv[t * 2]; f32x2v& yb = yv[t * 2 + 1];
            ya.x = xv[t].x * DN_ALPHA + ga.x * ya.x; ya.y = xv[t].y * DN_ALPHA + ga.y * ya.y; yb.x = xv[t].z * DN_ALPHA + ga.z * yb.x; yb.y = xv[t].w * DN_ALPHA + ga.w * yb.y;
            s += (ya.x + ya.y) + (yb.x + yb.y); }
        const float mean = wave_sum(s) * (1.0f / DM);
        float s2 = 0.f;
#pragma unroll
        for (int i = 0; i < 16; ++i) { yv[i] = yv[i] - mean; s2 += yv[i].x * yv[i].x + yv[i].y * yv[i].y; }
        const float rstd = 1.0f / sqrtf(wave_sum(s2) * (1.0f / DM) + LN_EPS);
        float* dst = p.out + (size_t)r * DM + lane * 32; bf16_t* dstb = XL + (size_t)r * DM + lane * 32;
#pragma unroll
        for (int t = 0; t < 8; t += 2) { const int c = t * 4;
            const f32x4 ga = *(const LAS f32x4*)(VEC + 9 * DM + lane * 32 + c), gb = *(const LAS f32x4*)(VEC + 9 * DM + lane * 32 + c + 4), ba = *(const LAS f32x4*)(VEC + 10 * DM + lane * 32 + c), bb = *(const LAS f32x4*)(VEC + 10 * DM + lane * 32 + c + 4);
            const f32x2v y0 = yv[t * 2], y1 = yv[t * 2 + 1], y2 = yv[t * 2 + 2], y3 = yv[t * 2 + 3];
            f32x4 o0, o1;
            o0.x = y0.x * rstd * ga.x + ba.x; o0.y = y0.y * rstd * ga.y + ba.y; o0.z = y1.x * rstd * ga.z + ba.z; o0.w = y1.y * rstd * ga.w + ba.w;
            o1.x = y2.x * rstd * gb.x + bb.x; o1.y = y2.y * rstd * gb.y + bb.y; o1.z = y3.x * rstd * gb.z + bb.z; o1.w = y3.y * rstd * gb.w + bb.w;
            if (last) { *(f32x4*)(dst + c) = o0; *(f32x4*)(dst + c + 4) = o1; }
            else { u32x4 xw; xw.x = pk2(o0.x, o0.y); xw.y = pk2(o0.z, o0.w); xw.z = pk2(o1.x, o1.y); xw.w = pk2(o1.z, o1.w); *(u32x4*)(dstb + c) = xw; }
            if (!last) {
                const f32x4 sa = *(const LAS f32x4*)(VEC + (3 + st) * DM + lane * 32 + c), sb = *(const LAS f32x4*)(VEC + (3 + st) * DM + lane * 32 + c + 4), ca = *(const LAS f32x4*)(VEC + (6 + st) * DM + lane * 32 + c), cb = *(const LAS f32x4*)(VEC + (6 + st) * DM + lane * 32 + c + 4);
                u32x4 o; o.x = pk2(o0.x * (1.f + ca.x) + sa.x, o0.y * (1.f + ca.y) + sa.y); o.y = pk2(o0.z * (1.f + ca.z) + sa.z, o0.w * (1.f + ca.w) + sa.w);
                o.z = pk2(o1.x * (1.f + cb.x) + sb.x, o1.y * (1.f + cb.y) + sb.y); o.w = pk2(o1.z * (1.f + cb.z) + sb.z, o1.w * (1.f + cb.w) + sb.w);
                *(u32x4*)(HB + (size_t)r * DM + lane * 32 + c) = o; }
        }
#if defined(DIAG_PI)
        if (last && r == 5 && lane == 0 && ((const float*)(p.ws + WS_CTL + 131072))[0] != 0.0f) p.out[(size_t)5 * DM] = __builtin_nanf("");
#endif
    }
}

__device__ __forceinline__ void gemm_rows_bf16(LAS unsigned char* lds, const bf16_t* A, const bf16_t* Bt, bf16_t* C, float* Cpart, bool with_ctx, int G, int bid) {
    { pg8::Gemm g{A, Bt, TL, DM, DM, DM}; pg8::StaticOrder S; S.init(TL, DM, G, bid); pg8::EpiBf16<0> E{C, DM, nullptr, 0, 0, 1.f};
      pg8::gemm_phase<pg8::EpiBf16<0>, pg8::StaticOrder, PG8_ALIGN, PG8_SP2>(lds, g, S, E); }
    if (with_ctx) { int ksl = 256; asm volatile("" : "+s"(ksl));
      pg8::Gemm g{A + (size_t)TL * DM, Bt, TC, DM, ksl, DM}; pg8::SplitKOrder S; S.init(G, bid); pg8::EpiF32Part E{Cpart};
      pg8::gemm_phase<pg8::EpiF32Part, pg8::SplitKOrder, PG8_ALIGN, PG8_SP2>(lds, g, S, E); }
}

constexpr int PH_PER_LAYER = 9, N_PHASES = 2 + DEPTH * PH_PER_LAYER;
__global__ void __launch_bounds__(NTHREADS, 2) fwd_kernel(Params p) {
    extern __shared__ __attribute__((aligned(16))) unsigned char lds_raw[];
    LAS unsigned char* lds = (LAS unsigned char*)lds_raw;
    const int tid = threadIdx.x, lane = tid & 63, wave = __builtin_amdgcn_readfirstlane(tid >> 6), bid = blockIdx.x, G = gridDim.x;
    volatile LAS unsigned* MISC = (volatile LAS unsigned*)(lds + MISC_OFF);
    if (tid < 32) MISC[tid] = 0u;
    __syncthreads();
    if (hipThreadIdx_x == 0) (void)xb_add(&((unsigned*)(p.ws + WS_CTL))[CW_BAR + XB_XCNT(xb_xcc_id())], 1u);
#define IN(k) true
#if defined(PROBE_MASK)
    volatile LAS unsigned long long* PT = (volatile LAS unsigned long long*)(lds + MISC_OFF + 96);
    if (tid == 0) PT[0] = __builtin_amdgcn_s_memrealtime();
#define SEAM(k) do { { XcdBarrier bar_; bar_.bar = (unsigned*)(((const __attribute__((address_space(4))) Params*)__builtin_amdgcn_kernarg_segment_ptr())->ws + WS_CTL) + CW_BAR; bar_.x = xb_xcc_id(); bar_.st = MISC + 8; xcd_barrier(bar_); } if (bid == 0) { const int kind_ = (k) < 2 ? (k) : 2 + ((k) - 2) % PH_PER_LAYER; \
        if (tid == 0) { const unsigned long long now_ = __builtin_amdgcn_s_memrealtime(); if ((PROBE_MASK >> kind_) & 1) { const unsigned long long d_ = (now_ - PT[0]) * PROBE_MULT; \
            while (__builtin_amdgcn_s_memrealtime() - now_ < d_) __builtin_amdgcn_s_sleep(8); } PT[0] = __builtin_amdgcn_s_memrealtime(); } __syncthreads(); } } while (0)
#elif defined(PROBE_DUP_BAR)
#define SEAM(k) do { XcdBarrier bar_; bar_.bar = (unsigned*)(((const __attribute__((address_space(4))) Params*)__builtin_amdgcn_kernarg_segment_ptr())->ws + WS_CTL) + CW_BAR; bar_.x = xb_xcc_id(); bar_.st = MISC + 8; xcd_barrier(bar_); xcd_barrier(bar_); } while (0)
#else
#define SEAM(k) do { XcdBarrier bar_; bar_.bar = (unsigned*)(((const __attribute__((address_space(4))) Params*)__builtin_amdgcn_kernarg_segment_ptr())->ws + WS_CTL) + CW_BAR; bar_.x = xb_xcc_id(); bar_.st = MISC + 8; xcd_barrier(bar_); } while (0)
#endif
    const int NGW = G * NWAVES;
#if defined(__HIP_DEVICE_COMPILE__)
#define KARGS_COPY const Params p_ = *kp_
#else
#define KARGS_COPY const Params p_ = p; (void)kp_
#endif
#define FRESH() int tid_ = threadIdx.x, bid_ = blockIdx.x; asm volatile("" : "+v"(tid_), "+s"(bid_)); const int lane_ = tid_ & 63, wave_ = __builtin_amdgcn_readfirstlane(tid_ >> 6); (void)lane_; (void)wave_; \
    const __attribute__((address_space(4))) Params* kp_ = (const __attribute__((address_space(4))) Params*)__builtin_amdgcn_kernarg_segment_ptr(); asm volatile("" : "+s"(kp_)); KARGS_COPY
    if (IN(0)) { FRESH(); phase_prologue(p_, lds, tid_, lane_, wave_, bid_, G); }
    SEAM(0);
    if (IN(1)) { FRESH(); phase_modulate0(p_, lane_, wave_, bid_, G); }
    SEAM(1);
    for (int l = 0; l < DEPTH; ++l) {
        const int b0 = 2 + l * PH_PER_LAYER;
        if (IN(b0 + 0)) { FRESH();
            pg8::Gemm g{(const bf16_t*)(p_.ws + WS_HB), (const bf16_t*)(p_.ws + WS_WIN) + (size_t)l * INWP * DM, TA, INWP, DM, DM}; pg8::StaticOrder S; S.init(TA, INWP, G, bid_);
            pg8::EpiBf16<0> E{(bf16_t*)(p_.ws + WS_P), INWP, nullptr, 0, 0, 1.f};
            pg8::gemm_phase<pg8::EpiBf16<0>, pg8::StaticOrder, PG8_ALIGN, PG8_SP2>(lds, g, S, E);
#if defined(PROBE_DUP_GEMM)
            __syncthreads(); pg8::gemm_phase<pg8::EpiBf16<0>, pg8::StaticOrder, PG8_ALIGN, PG8_SP2>(lds, g, S, E);
#endif
        }
        SEAM(b0 + 0);
        if (IN(b0 + 1)) { { FRESH(); gla_g1(p_, l, lds, tid_, lane_, wave_, bid_, G); } { FRESH(); phase_post_in(p_, l, lane_, wave_, bid_, G); } }
#if defined(PROBE_DUP_A)
        if (IN(b0 + 1)) { __syncthreads(); { FRESH(); gla_g1(p_, l, lds, tid_, lane_, wave_, bid_, G); } { FRESH(); phase_post_in(p_, l, lane_, wave_, bid_, G); } }
#endif
        SEAM(b0 + 1);
        if (IN(b0 + 2)) { { FRESH(); gla_g2(p_, tid_, bid_, G); } { FRESH(); phase_mixers(p_, l, lds, tid_, lane_, wave_, bid_, G); } }
#if defined(PROBE_DUP_B)
        if (IN(b0 + 2)) { __syncthreads(); { FRESH(); gla_g2(p_, tid_, bid_, G); } { FRESH(); phase_mixers(p_, l, lds, tid_, lane_, wave_, bid_, G, 1); } }
#endif
        SEAM(b0 + 2);
        if (IN(b0 + 3)) { FRESH(); gla_g3(p_, l, lds, tid_, lane_, wave_, bid_, G); }
#if defined(PROBE_DUP_C)
        if (IN(b0 + 3)) { __syncthreads(); FRESH(); gla_g3(p_, l, lds, tid_, lane_, wave_, bid_, G); }
#endif
        SEAM(b0 + 3);
        if (IN(b0 + 4)) { FRESH();
            gemm_rows_bf16(lds, (const bf16_t*)(p_.ws + WS_MIX), (const bf16_t*)(p_.ws + WS_WOUT) + (size_t)l * DM * DM, (bf16_t*)(p_.ws + WS_Y), (float*)(p_.ws + WS_YPART), l < DEPTH - 1, G, bid_);
#if defined(PROBE_DUP_GEMM)
            __syncthreads(); gemm_rows_bf16(lds, (const bf16_t*)(p_.ws + WS_MIX), (const bf16_t*)(p_.ws + WS_WOUT) + (size_t)l * DM * DM, (bf16_t*)(p_.ws + WS_Y), (float*)(p_.ws + WS_YPART), l < DEPTH - 1, G, bid_);
#endif
        }
        SEAM(b0 + 4);
        if (IN(b0 + 5)) { FRESH(); phase_ln1(p_, l, lds, tid_, lane_, wave_, bid_, G); }
#if defined(PROBE_DUP_E)
        if (IN(b0 + 5)) { __syncthreads(); FRESH(); phase_ln1(p_, l, lds, tid_, lane_, wave_, bid_, G); }
#endif
        SEAM(b0 + 5);
        if (IN(b0 + 6)) { FRESH();
            gemm_rows_bf16(lds, (const bf16_t*)(p_.ws + WS_HB), (const bf16_t*)(p_.ws + WS_WQ) + (size_t)l * DM * DM, (bf16_t*)(p_.ws + WS_QP), (float*)(p_.ws + WS_QPART), l < DEPTH - 1, G, bid_);
#if defined(PROBE_DUP_GEMM)
            __syncthreads(); gemm_rows_bf16(lds, (const bf16_t*)(p_.ws + WS_HB), (const bf16_t*)(p_.ws + WS_WQ) + (size_t)l * DM * DM, (bf16_t*)(p_.ws + WS_QP), (float*)(p_.ws + WS_QPART), l < DEPTH - 1, G, bid_);
#endif
        }
        SEAM(b0 + 6);
        if (IN(b0 + 7)) { FRESH(); peer_retrieve(p_, l, lds, tid_, lane_, wave_, bid_, G, l < DEPTH - 1 ? TA : TL); }
#if defined(PROBE_DUP_D)
        if (IN(b0 + 7)) { __syncthreads(); FRESH(); peer_retrieve(p_, l, lds, tid_, lane_, wave_, bid_, G, l < DEPTH - 1 ? TA : TL); }
#endif
        SEAM(b0 + 7);
        if (IN(b0 + 8)) { FRESH(); phase_peer(p_, l, lds, tid_, lane_, wave_, bid_, G); }
        if (l < DEPTH - 1) SEAM(b0 + 8);
    }
#undef FRESH
#undef IN
#undef SEAM
}

#ifndef MK_PER_PHASE
#define MK_PER_PHASE 0
#endif
extern "C" void kernel_launch(void* const* d_in, const int* in_sizes, int n_in, void* d_out, int out_size, void* d_ws, size_t ws_size, hipStream_t stream) {
    static int grid = 0;
    if (grid == 0) {
        if (n_in != 19 || out_size != TL * DM || ws_size < WS_END) { fprintf(stderr, "kernel_launch: unexpected shapes (n_in %d out %d ws %zu)\n", n_in, out_size, ws_size); grid = -1; return; }
        int dev = 0, cus = 0;
        if (hipGetDevice(&dev) != hipSuccess || hipDeviceGetAttribute(&cus, hipDeviceAttributeMultiprocessorCount, dev) != hipSuccess) { grid = -1; return; }
        if (hipFuncSetAttribute((const void*)fwd_kernel, hipFuncAttributeMaxDynamicSharedMemorySize, LDS_BYTES) != hipSuccess) { fprintf(stderr, "kernel_launch: hipFuncSetAttribute failed\n"); grid = -1; return; }
        int per_cu = 0;
        (void)hipOccupancyMaxActiveBlocksPerMultiprocessor(&per_cu, (const void*)fwd_kernel, NTHREADS, LDS_BYTES);
        (void)hipGetLastError();
        if (per_cu < 1) fprintf(stderr, "kernel_launch: occupancy query reports %d blocks per CU\n", per_cu);
        grid = cus;
    }
    if (grid < 0) return;
    (void)hipMemsetAsync((char*)d_ws + WS_CTL, 0, CTL_ZERO_BYTES, stream);
    Params p{};
    for (int i = 0; i < 19; ++i) p.in[i] = (const float*)d_in[i];
    p.out = (float*)d_out; p.ws = (unsigned char*)d_ws;
#if MK_PER_PHASE
    for (int ph = 0; ph < N_PHASES; ++ph) { p.ph_lo = ph; p.ph_hi = ph + 1; hipLaunchKernelGGL(fwd_kernel, dim3(grid), dim3(NTHREADS), LDS_BYTES, stream, p); }
#else
    p.ph_lo = 0; p.ph_hi = N_PHASES;
    hipLaunchKernelGGL(fwd_kernel, dim3(grid), dim3(NTHREADS), LDS_BYTES, stream, p);
#endif
}
```

```cpp
#include <hip/hip_runtime.h>
#include <cstdio>
#include <cstdint>

#define LAS __attribute__((address_space(3)))
typedef unsigned short bf16_t;
typedef short bf16x8 __attribute__((ext_vector_type(8)));
typedef float f32x4 __attribute__((ext_vector_type(4)));
typedef unsigned u32x4 __attribute__((ext_vector_type(4)));
typedef unsigned u32x2 __attribute__((ext_vector_type(2)));
typedef unsigned u32x6 __attribute__((ext_vector_type(6)));
typedef float f32x2v __attribute__((ext_vector_type(2)));
typedef float f32x16 __attribute__((ext_vector_type(16)));
typedef float f32x32 __attribute__((ext_vector_type(32)));

constexpr int DM = 2048, NBATCH = 2, SEQ = 8192, DEPTH = 4, CTXL = 256;
constexpr int TL = NBATCH * SEQ, TC = NBATCH * CTXL, TA = TL + TC;
constexpr int INW = 4640, INWP = 4864;
constexpr int C_CX = 0, C_CB = 512, C_CC = 1024, C_GQ = 1536, C_GK = 1792, C_GV = 2048, C_GG = 2560, C_LRF = 3072, C_LRB = 3088,
              C_SQ = 3104, C_SK = 4128, C_SV = 4384;
constexpr int NEXP = 16384;
constexpr int ROWB = 1536;
constexpr int ROWB4 = 1088;
#ifndef TBL_U_FP4
#define TBL_U_FP4 1
#endif
#ifndef TBL_U_I4
#define TBL_U_I4 (TBL_U_FP4)
#endif
constexpr unsigned I4_BASE = 103u << 23;
#ifndef U_ROWSCALE
#define U_ROWSCALE (TBL_U_I4)
#endif
#ifndef V_ROWSCALE
#define V_ROWSCALE 1
#endif
constexpr int ROWB_U = U_ROWSCALE ? 1024 : (TBL_U_FP4 ? ROWB4 : ROWB), ROWB_V = V_ROWSCALE ? 1024 : ROWB4;
constexpr float DN_ALPHA = 1.6817928305074290f;
constexpr float LN_EPS = 1e-6f;
constexpr int NWAVES = 8, NTHREADS = 512;

constexpr size_t MiB = 1u << 20;
constexpr size_t WS_CTL = 0, CTL_ZERO_BYTES = 256 * 1024;
constexpr size_t WS_MOD = 2 * MiB;
constexpr size_t WS_WIN = 4 * MiB;
constexpr size_t WS_WOUT = 80 * MiB;
constexpr size_t WS_WQ = 112 * MiB;
constexpr size_t WS_XL = 144 * MiB;
constexpr size_t WS_HB = 276 * MiB;
constexpr size_t WS_P = 342 * MiB;
constexpr size_t WS_QR = 656 * MiB;
constexpr size_t WS_KR = 720 * MiB;
constexpr size_t WS_ALF = 736 * MiB;
constexpr size_t WS_ALB = 753 * MiB;
constexpr size_t WS_OF = 770 * MiB;
constexpr size_t WS_OB = 803 * MiB;
constexpr size_t WS_MIX = 836 * MiB;
constexpr size_t WS_Y = 902 * MiB;
constexpr size_t WS_QP = 1034 * MiB;
constexpr size_t WS_DELTA = 1166 * MiB;
constexpr size_t WS_DEC = 1233 * MiB;
constexpr size_t WS_SST = 1234 * MiB;
constexpr size_t WS_UB = 1268 * MiB;
constexpr size_t WS_VB = 1524 * MiB;
constexpr size_t WS_EIDX = 1780 * MiB;
constexpr size_t WS_EGATE = 1789 * MiB;
constexpr size_t WS_SUBB = 1798 * MiB;
constexpr size_t WS_USC = 1799 * MiB;
constexpr size_t WS_VSC = 1799 * MiB + 512 * 1024;
constexpr size_t WS_YPART = 1800 * MiB;
constexpr size_t WS_QPART = 1832 * MiB;
constexpr size_t WS_XM = 1864 * MiB;
constexpr size_t WS_END = 1996 * MiB;
constexpr int GLA_ITEMS = (TA / 64) * 4;
static_assert(WS_DELTA + (size_t)GLA_ITEMS * 2 * 8192 * 4 <= WS_DEC && WS_DEC + (size_t)GLA_ITEMS * 2 * 64 * 4 <= WS_SST && WS_SST + (size_t)GLA_ITEMS * 2 * 8192 * 2 <= WS_END, "map");
static_assert(WS_WIN + (size_t)4 * INWP * DM * 2 <= WS_WOUT, "map");
static_assert(WS_P + (size_t)TA * INWP * 2 <= WS_QR, "map");
static_assert(WS_XL + (size_t)TA * DM * 4 <= WS_HB, "map");
constexpr int CW_BAR = 4096;
constexpr int CW_QUEUE = 8192;
constexpr int LDS_BYTES = 163840;
constexpr int MISC_OFF = 163840 - 512;

#define XB_TMO      128
#define XB_XCNT(j)  (256  + 64 * (j))
#define XB_XSUB(j)  (1280 + 64 * (j))
#define XB_XGEN(j)  (2304 + 64 * (j))
#define XB_TOP      3328
#define XB_TOPGEN   3392
#define XCD_BAR_WORDS 3456
#define XB_SPIN_CAP (1u << 18)
__device__ __forceinline__ unsigned xb_ld(unsigned* p)              { return __hip_atomic_load(p, __ATOMIC_RELAXED, __HIP_MEMORY_SCOPE_AGENT); }
__device__ __forceinline__ unsigned xb_add(unsigned* p, unsigned v) { return __hip_atomic_fetch_add(p, v, __ATOMIC_RELAXED, __HIP_MEMORY_SCOPE_AGENT); }
__device__ __forceinline__ unsigned xb_xcc_id() { return (unsigned)__builtin_amdgcn_s_getreg((3 << 11) | 20) & 0xFu; }
#define XB_SPIN(cond, bar) do { unsigned _sp = 0; while (cond) { __builtin_amdgcn_s_sleep(1); \
    if ((++_sp & 255u) == 0u) { if (xb_ld(&(bar)[XB_TMO])) break; if (_sp > XB_SPIN_CAP) { atomicAdd(&(bar)[XB_TMO], 1u); break; } } } } while (0)
struct XcdBarrier { unsigned* bar; unsigned x; volatile LAS unsigned* st; };
__device__ __forceinline__ XcdBarrier xcd_barrier_post(unsigned* bar, volatile LAS unsigned* st) {
    XcdBarrier b; b.bar = bar; b.x = xb_xcc_id(); b.st = st;
    if (threadIdx.x == 0) (void)xb_add(&bar[XB_XCNT(b.x)], 1u);
    return b;
}
__device__ __forceinline__ void xcd_barrier_complete(unsigned* bar, unsigned x, unsigned& nloc, unsigned& nx) {
    const unsigned G = gridDim.x * gridDim.y * gridDim.z;
    unsigned sum, cnt, mine, sp = 0u;
    for (;;) {
        sum = 0u; cnt = 0u; mine = 0u;
#pragma unroll
        for (unsigned j = 0; j < 16; ++j) { const unsigned c = xb_ld(&bar[XB_XCNT(j)]); sum += c; cnt += (c > 0u) ? 1u : 0u; mine = (j == x) ? c : mine; }
        if (sum == G) break;
        __builtin_amdgcn_s_sleep(1);
        if ((++sp & 255u) == 0u) { if (xb_ld(&bar[XB_TMO])) break; if (sp > XB_SPIN_CAP) { atomicAdd(&bar[XB_TMO], 1u); break; } }
    }
    nloc = mine > 0u ? mine : 1u; nx = cnt > 0u ? cnt : 1u;
}
__device__ __forceinline__ void xcd_barrier(const XcdBarrier& b) {
    asm volatile("s_waitcnt vmcnt(0)" ::: "memory");
    __syncthreads();
    if (threadIdx.x == 0) {
        unsigned* bar = b.bar;
        __builtin_amdgcn_s_waitcnt(0);
        unsigned nloc = b.st[0], nx = b.st[1];
        if (nloc == 0u) { xcd_barrier_complete(bar, b.x, nloc, nx); b.st[0] = nloc; b.st[1] = nx; }
        const unsigned old = xb_add(&bar[XB_XSUB(b.x)], 1u);
        const unsigned gen = old / nloc;
        if (old + 1u == (gen + 1u) * nloc) {
            __builtin_amdgcn_fence(__ATOMIC_RELEASE, "agent");
            asm volatile("s_waitcnt vmcnt(0)" ::: "memory");
            const unsigned og = xb_add(&bar[XB_TOP], 1u);
            const unsigned tg = og / nx;
            if (og + 1u == (tg + 1u) * nx) xb_add(&bar[XB_TOPGEN], 1u);
            else XB_SPIN(xb_ld(&bar[XB_TOPGEN]) == tg, bar);
            __builtin_amdgcn_fence(__ATOMIC_ACQUIRE, "agent");
            xb_add(&bar[XB_XGEN(b.x)], 1u);
            asm volatile("s_waitcnt vmcnt(0)" ::: "memory");
        } else {
            XB_SPIN(xb_ld(&bar[XB_XGEN(b.x)]) == gen, bar);
            __builtin_amdgcn_fence(__ATOMIC_ACQUIRE, "agent");
            asm volatile("s_waitcnt vmcnt(0)" ::: "memory");
        }
    }
    __syncthreads();
}

namespace pg8 {
#define PG8_LAS __attribute__((address_space(3)))
typedef unsigned short bf16_t;
typedef short bf16x8 __attribute__((ext_vector_type(8)));
typedef float f32x4 __attribute__((ext_vector_type(4)));
typedef unsigned u32x4 __attribute__((ext_vector_type(4)));
constexpr int BM = 256, BK = 64, HALF = 128, HTB = HALF * BK * 2  , STAGE_BYTES = 8 * HTB, NXCD = 8, WGM = 8;

__host__ __device__ __forceinline__ int lds_byte(int r, int c) { const int st = (r >> 4) * 2 + (c >> 5), rr = r & 15, cc = c & 31, ob = rr * 64 + cc * 2; return st * 1024 + (ob ^ (((ob >> 9) & 1) << 5)); }
__host__ __device__ __forceinline__ void stage_rc(int b, int& R, int& C) { const int st = b / 1024, sb = b % 1024, swz = sb ^ (((sb >> 9) & 1) << 5); R = (st >> 1) * 16 + swz / 64; C = (st & 1) * 32 + (swz % 64) / 2; }
__host__ __device__ __forceinline__ int perm32(int rho) { const int n = rho >> 4, i = rho & 15; return 8 * (i >> 2) + 4 * n + (i & 3); }

struct Unit { int pm, pn, kofs; };
struct Gemm { const bf16_t* A; const bf16_t* Bt; int M, N, K, ld; };

struct StaticOrder {
    int nM, nN, nwg, G, c;
    __host__ __device__ void init(int M, int N, int G_, int c_) { nM = M / BM; nN = N / BM; nwg = nM * nN; G = G_; c = c_; }
    __host__ __device__ bool next(int i, Unit& u) const {
        const long L = (long)i * G + c; if (L >= nwg) return false;
        int wgid = (int)L; { const int q = nwg / NXCD, r = nwg % NXCD, xcd = wgid % NXCD, off = wgid / NXCD; wgid = (xcd < r ? xcd * (q + 1) : r * (q + 1) + (xcd - r) * q) + off; }
        const int nig = WGM * nN, gid = wgid / nig, fm = gid * WGM, gsz = (nM - fm) < WGM ? (nM - fm) : WGM;
        u.pm = fm + ((wgid % nig) % gsz); u.pn = (wgid % nig) / gsz; u.kofs = 0; return true;
    }
    __device__ __forceinline__ void a_ready(const Unit&) const {}
    __device__ __forceinline__ void done(const Unit&) const {}
};

__device__ __forceinline__ unsigned cvt_pk_bf16(float lo, float hi) { unsigned r; asm volatile("v_cvt_pk_bf16_f32 %0, %1, %2" : "=v"(r) : "v"(lo), "v"(hi)); return r; }
typedef float f32x2 __attribute__((ext_vector_type(2)));
__device__ __forceinline__ f32x2 gelu_pk(f32x2 v) {
    const f32x2 av = __builtin_elementwise_abs(v), d = av * 0.2316418882f + 1.0f;
    f32x2 t; t.x = __builtin_amdgcn_rcpf(d.x); t.y = __builtin_amdgcn_rcpf(d.y);
    f32x2 q = t * 0.5307027145f + (-0.7265760135f); q = q * t + 0.7107068705f; q = q * t + (-0.142248368f); q = q * t + 0.127414796f; q = q * t;
    const f32x2 s = (v * v) * (-0.72134752044f);
    f32x2 e; e.x = __builtin_amdgcn_exp2f(s.x); e.y = __builtin_amdgcn_exp2f(s.y);
    const f32x2 m = v * (q * e), r = v - m;
    f32x2 o; o.x = v.x < 0.f ? m.x : r.x; o.y = v.y < 0.f ? m.y : r.y; return o;
}

template <int ACT  > struct EpiBf16 {
    static constexpr bool PERM = true, AFTER_DRAIN = false; static_assert(ACT == 0 || ACT == 1, "EpiBf16: ACT is 0 (none) or 1 (gelu_pk)");
    bf16_t* O; int ldc; const float* bias; int split_cols; size_t split_stride; float scale0;
    __device__ __forceinline__ void operator()(const f32x4 (&acc)[2][2][4][2], const Unit& u, int wr, int wc, int fr, int fq) const {
        const int row0 = u.pm * BM + wr * 64 + fr; int colt = u.pn * BM; bf16_t* base = O;
        float sc = 1.f; if (split_cols) { const int t = colt / split_cols; base += (size_t)t * split_stride; colt -= t * split_cols; if (t == 0) sc = scale0; }
        const int col0 = colt + wc * 32 + 8 * fq, bcol0 = u.pn * BM + wc * 32 + 8 * fq;
        f32x4 bv[2][2];
#pragma unroll
        for (int bj = 0; bj < 2; ++bj)
#pragma unroll
            for (int n = 0; n < 2; ++n) bv[bj][n] = bias ? *(const f32x4*)(bias + bcol0 + bj * HALF + 4 * n) : (f32x4){0.f, 0.f, 0.f, 0.f};
#pragma unroll
        for (int ai = 0; ai < 2; ++ai)
#pragma unroll
            for (int m = 0; m < 4; ++m) { bf16_t* rowp = base + (size_t)(row0 + ai * HALF + m * 16) * ldc + col0;
#pragma unroll
                for (int bj = 0; bj < 2; ++bj) { f32x4 v0 = acc[ai][bj][m][0] + bv[bj][0], v1 = acc[ai][bj][m][1] + bv[bj][1];
                    if (ACT == 1) { f32x2 a = gelu_pk((f32x2){v0[0], v0[1]}), b = gelu_pk((f32x2){v0[2], v0[3]}), c = gelu_pk((f32x2){v1[0], v1[1]}), d = gelu_pk((f32x2){v1[2], v1[3]});
                        v0 = (f32x4){a.x, a.y, b.x, b.y}; v1 = (f32x4){c.x, c.y, d.x, d.y}; }
                    v0 = v0 * sc; v1 = v1 * sc; u32x4 w; w.x = cvt_pk_bf16(v0[0], v0[1]); w.y = cvt_pk_bf16(v0[2], v0[3]); w.z = cvt_pk_bf16(v1[0], v1[1]); w.w = cvt_pk_bf16(v1[2], v1[3]);
                    *(u32x4*)(rowp + bj * HALF) = w; } }
    }
};


struct EpiF32 {
    static constexpr bool PERM = false, AFTER_DRAIN = false;
    float* C; int ldc; const float* bias;
    __device__ __forceinline__ void operator()(const f32x4 (&acc)[2][2][4][2], const Unit& u, int wr, int wc, int fr, int fq) const {
        const int row0 = u.pm * BM + wr * 64 + fr, col0 = u.pn * BM + wc * 32 + 4 * fq;
        f32x4 bv[2][2];
#pragma unroll
        for (int bj = 0; bj < 2; ++bj)
#pragma unroll
            for (int n = 0; n < 2; ++n) bv[bj][n] = bias ? *(const f32x4*)(bias + col0 + bj * HALF + n * 16) : (f32x4){0.f, 0.f, 0.f, 0.f};
#pragma unroll
        for (int ai = 0; ai < 2; ++ai)
#pragma unroll
            for (int m = 0; m < 4; ++m) { float* rowp = C + (size_t)(row0 + ai * HALF + m * 16) * ldc + col0;
#pragma unroll
                for (int bj = 0; bj < 2; ++bj)
#pragma unroll
                    for (int n = 0; n < 2; ++n) *(f32x4*)(rowp + bj * HALF + n * 16) = acc[ai][bj][m][n] + bv[bj][n]; }
    }
};

template <class Epi, class Sched, bool ALIGN_EPI = false, bool SP2 = false>
__device__ __forceinline__ void gemm_phase(PG8_LAS unsigned char* lds, const Gemm g, const Sched& S, const Epi& E) {
    int tid_l = threadIdx.x; asm volatile("" : "+v"(tid_l));
    const int tid = tid_l, wid = __builtin_amdgcn_readfirstlane(tid >> 6), lane = tid & 63, wr = wid >> 2, wc = wid & 3, fr = lane & 15, fq = lane >> 4;
    const int K = g.K, nt = K / BK;
    unsigned voffA[2], voffB[2];
#pragma unroll
    for (int i = 0; i < 2; ++i) { int R, C; stage_rc(tid * 16 + i * 8192, R, C); const int Rb = Epi::PERM ? ((R & ~31) + perm32(R & 31)) : R;
        voffA[i] = (unsigned)(R * g.ld + C) * 2u; voffB[i] = (unsigned)(Rb * g.ld + C) * 2u; }
    const size_t kstep = (size_t)(BK * 2);
    const size_t hstep = (size_t)HALF * g.ld * 2;
    const size_t tstep = 2 * hstep;
    const unsigned ldsw = (unsigned)wid * 1024u;
    const int aoff = lds_byte(wr * 64 + fr, fq * 8), boff = lds_byte(wc * 32 + fr, fq * 8);
#define PG8_SA(b, h) (((b) * 2 + (h)) * HTB)
#define PG8_SB(b, h) ((4 + (b) * 2 + (h)) * HTB)
#define PG8_STAGE(bufoff, gbase, voff) do { _Pragma("unroll") for (int _i = 0; _i < 2; ++_i) \
        __builtin_amdgcn_global_load_lds((const unsigned*)((const char*)(gbase) + (voff)[_i]), (PG8_LAS unsigned*)(lds + (bufoff) + ldsw + _i * 8192), 16, 0, 0); } while (0)
#define PG8_LDA(dst, b, h) do { _Pragma("unroll") for (int m = 0; m < 4; ++m) _Pragma("unroll") for (int k = 0; k < 2; ++k) dst[m][k] = *(const PG8_LAS bf16x8*)(lds + PG8_SA(b, h) + aoff + m * 2048 + k * 1024); } while (0)
#define PG8_LDB(dst, b, h) do { _Pragma("unroll") for (int n = 0; n < 2; ++n) _Pragma("unroll") for (int k = 0; k < 2; ++k) dst[n][k] = *(const PG8_LAS bf16x8*)(lds + PG8_SB(b, h) + boff + n * 2048 + k * 1024); } while (0)
#define PG8_MMA(ai, bj, At, Bt) do { __builtin_amdgcn_s_setprio(1); _Pragma("unroll") for (int m = 0; m < 4; ++m) _Pragma("unroll") for (int n = 0; n < 2; ++n) _Pragma("unroll") for (int k = 0; k < 2; ++k) \
        acc[ai][bj][m][n] = __builtin_amdgcn_mfma_f32_16x16x32_bf16(Bt[n][k], At[m][k], acc[ai][bj][m][n], 0, 0, 0); __builtin_amdgcn_s_setprio(0); } while (0)
#define PG8_WAIT_V(n) asm volatile("s_waitcnt vmcnt(" #n ")" ::: "memory")
#define PG8_WAIT_L(n) asm volatile("s_waitcnt lgkmcnt(" #n ")" ::: "memory")
#define PG8_BAR __builtin_amdgcn_s_barrier()
#define PG8_SCHED __builtin_amdgcn_sched_barrier(0)
    Unit cur, nxt; int ui = 0;
    if (!S.next(0, cur)) return;
    f32x4 acc[2][2][4][2];
#pragma unroll
    for (int a = 0; a < 2; ++a)
#pragma unroll
        for (int b = 0; b < 2; ++b)
#pragma unroll
            for (int m = 0; m < 4; ++m)
#pragma unroll
                for (int n = 0; n < 2; ++n) acc[a][b][m][n] = (f32x4){0.f, 0.f, 0.f, 0.f};
    bf16x8 At[4][2], B0[2][2], B1[2][2];
    const char* cA = (const char*)g.A + (size_t)cur.pm * tstep + (size_t)cur.kofs * 2; const char* cB = (const char*)g.Bt + (size_t)cur.pn * tstep + (size_t)cur.kofs * 2;
    S.a_ready(cur);
    if constexpr (SP2) {
        PG8_STAGE(PG8_SB(0, 0), cB, voffB); PG8_STAGE(PG8_SB(0, 1), cB + hstep, voffB); PG8_STAGE(PG8_SA(0, 0), cA, voffA); PG8_STAGE(PG8_SA(0, 1), cA + hstep, voffA);
        if (wr == 1) PG8_BAR;
        PG8_WAIT_V(2); PG8_BAR;
        PG8_STAGE(PG8_SB(1, 0), cB + kstep, voffB); PG8_STAGE(PG8_SA(1, 0), cA + kstep, voffA); PG8_STAGE(PG8_SB(1, 1), cB + hstep + kstep, voffB);
        PG8_WAIT_V(6); PG8_BAR;
    } else {
        PG8_STAGE(PG8_SB(0, 0), cB, voffB); PG8_STAGE(PG8_SA(0, 0), cA, voffA); PG8_STAGE(PG8_SB(0, 1), cB + hstep, voffB); PG8_STAGE(PG8_SA(0, 1), cA + hstep, voffA);
        if (wr == 1) PG8_BAR;
        PG8_WAIT_V(4); PG8_BAR;
        PG8_STAGE(PG8_SB(1, 0), cB + kstep, voffB); PG8_STAGE(PG8_SA(1, 0), cA + kstep, voffA); PG8_STAGE(PG8_SB(1, 1), cB + hstep + kstep, voffB);
        PG8_WAIT_V(6); PG8_BAR;
    }
    for (;;) {
        const bool has_next = S.next(ui + 1, nxt);
        const char* nA = has_next ? (const char*)g.A + (size_t)nxt.pm * tstep + (size_t)nxt.kofs * 2 : cA; const char* nB = has_next ? (const char*)g.Bt + (size_t)nxt.pn * tstep + (size_t)nxt.kofs * 2 : cB;
        for (int t = 0; t < nt; t += 2) {
            const bool last = (t == nt - 2);
            const char* a1 = cA + (size_t)(t + 1) * kstep;
            const char* a2 = last ? nA : cA + (size_t)(t + 2) * kstep; const char* b2 = last ? nB : cB + (size_t)(t + 2) * kstep;
            const char* a3 = a2 + kstep; const char* b3 = b2 + kstep;
            if (last && has_next) S.a_ready(nxt);
            if constexpr (SP2) {
            PG8_LDB(B0, 0, 0); PG8_LDB(B1, 0, 1); PG8_SCHED; PG8_LDA(At, 0, 0); PG8_STAGE(PG8_SA(1, 1), a1 + hstep, voffA);
            PG8_WAIT_V(8); PG8_WAIT_L(0); PG8_BAR; PG8_MMA(0, 0, At, B0); PG8_MMA(0, 1, At, B1); PG8_BAR; PG8_SCHED;
            PG8_LDA(At, 0, 1); PG8_STAGE(PG8_SB(0, 0), b2, voffB); PG8_STAGE(PG8_SB(0, 1), b2 + hstep, voffB); PG8_STAGE(PG8_SA(0, 0), a2, voffA);
            PG8_WAIT_V(8); PG8_WAIT_L(0); PG8_BAR; PG8_MMA(1, 0, At, B0); PG8_MMA(1, 1, At, B1); PG8_BAR; PG8_SCHED;
            PG8_LDB(B0, 1, 0); PG8_LDB(B1, 1, 1); PG8_SCHED; PG8_LDA(At, 1, 0); PG8_STAGE(PG8_SA(0, 1), a2 + hstep, voffA);
            PG8_WAIT_V(8); PG8_WAIT_L(0); PG8_BAR; PG8_MMA(0, 0, At, B0); PG8_MMA(0, 1, At, B1); PG8_BAR; PG8_SCHED;
            PG8_LDA(At, 1, 1); PG8_STAGE(PG8_SB(1, 0), b3, voffB); PG8_STAGE(PG8_SB(1, 1), b3 + hstep, voffB); PG8_STAGE(PG8_SA(1, 0), a3, voffA);
            PG8_WAIT_V(8); PG8_WAIT_L(0); PG8_BAR; PG8_MMA(1, 0, At, B0); PG8_MMA(1, 1, At, B1); PG8_BAR; PG8_SCHED;
            } else {
            PG8_LDB(B0, 0, 0); PG8_SCHED; PG8_LDA(At, 0, 0); PG8_STAGE(PG8_SA(1, 1), a1 + hstep, voffA);
            PG8_WAIT_L(8); PG8_BAR; PG8_WAIT_L(0); PG8_MMA(0, 0, At, B0); PG8_BAR; PG8_SCHED;
            PG8_LDB(B1, 0, 1); PG8_STAGE(PG8_SB(0, 0), b2, voffB);
            PG8_BAR; PG8_WAIT_L(0); PG8_MMA(0, 1, At, B1); PG8_BAR;
            PG8_LDA(At, 0, 1); PG8_STAGE(PG8_SA(0, 0), a2, voffA);
            PG8_BAR; PG8_WAIT_L(0); PG8_MMA(1, 0, At, B0); PG8_BAR; PG8_SCHED;
            PG8_STAGE(PG8_SB(0, 1), b2 + hstep, voffB);
            PG8_WAIT_V(6); PG8_BAR; PG8_MMA(1, 1, At, B1); PG8_BAR;
            PG8_LDB(B0, 1, 0); PG8_SCHED; PG8_LDA(At, 1, 0); PG8_STAGE(PG8_SA(0, 1), a2 + hstep, voffA);
            PG8_WAIT_L(8); PG8_BAR; PG8_WAIT_L(0); PG8_MMA(0, 0, At, B0); PG8_BAR; PG8_SCHED;
            PG8_LDB(B1, 1, 1); PG8_STAGE(PG8_SB(1, 0), b3, voffB);
            PG8_BAR; PG8_WAIT_L(0); PG8_MMA(0, 1, At, B1); PG8_BAR;
            PG8_LDA(At, 1, 1); PG8_STAGE(PG8_SA(1, 0), a3, voffA);
            PG8_BAR; PG8_WAIT_L(0); PG8_MMA(1, 0, At, B0); PG8_BAR; PG8_SCHED;
            PG8_STAGE(PG8_SB(1, 1), b3 + hstep, voffB);
            PG8_WAIT_V(6); PG8_BAR; PG8_MMA(1, 1, At, B1); PG8_BAR;
            }
        }
        if constexpr (ALIGN_EPI) { if (wr == 0) PG8_BAR; }
        if constexpr (!Epi::AFTER_DRAIN) { E(acc, cur, wr, wc, fr, fq); S.done(cur); }
        if (!has_next) break;
#pragma unroll
        for (int a = 0; a < 2; ++a)
#pragma unroll
            for (int b = 0; b < 2; ++b)
#pragma unroll
                for (int m = 0; m < 4; ++m)
#pragma unroll
                    for (int n = 0; n < 2; ++n) acc[a][b][m][n] = (f32x4){0.f, 0.f, 0.f, 0.f};
        cur = nxt; cA = nA; cB = nB; ++ui;
        if constexpr (ALIGN_EPI) { if (wr == 1) PG8_BAR; }
    }
    PG8_WAIT_V(0);
    if constexpr (!ALIGN_EPI) { if (wr == 0) PG8_BAR; }
    PG8_BAR;
    if constexpr (Epi::AFTER_DRAIN) { E.fused(acc, cur, wr, wc, fr, fq, lds, wid, lane); S.done(cur); }
#undef PG8_SA
#undef PG8_SB
#undef PG8_STAGE
#undef PG8_LDA
#undef PG8_LDB
#undef PG8_MMA
#undef PG8_WAIT_V
#undef PG8_WAIT_L
#undef PG8_BAR
#undef PG8_SCHED
}
}
namespace pg8 {
struct SplitKOrder {
    int G, c;
    __host__ __device__ void init(int G_, int c_) { G = G_; c = c_; }
    __host__ __device__ bool next(int i, Unit& u) const { const long L = (long)i * G + c; if (L >= 128) return false; const int ks = (int)L >> 4, r = (int)L & 15; u.pm = r >> 3; u.pn = r & 7; u.kofs = ks * 256; return true; }
    __device__ __forceinline__ void a_ready(const Unit&) const {}
    __device__ __forceinline__ void done(const Unit&) const {}
};
struct EpiF32Part {
    static constexpr bool PERM = false, AFTER_DRAIN = false;
    float* C;
    __device__ __forceinline__ void operator()(const f32x4 (&acc)[2][2][4][2], const Unit& u, int wr, int wc, int fr, int fq) const {
        const int row0 = u.pm * BM + wr * 64 + fr, col0 = u.pn * BM + wc * 32 + 4 * fq; float* base = C + (size_t)(u.kofs >> 8) * 512 * 2048;
#pragma unroll
        for (int ai = 0; ai < 2; ++ai)
#pragma unroll
            for (int m = 0; m < 4; ++m) { float* rowp = base + (size_t)(row0 + ai * HALF + m * 16) * 2048 + col0;
#pragma unroll
                for (int bj = 0; bj < 2; ++bj)
#pragma unroll
                    for (int n = 0; n < 2; ++n) *(f32x4*)(rowp + bj * HALF + n * 16) = acc[ai][bj][m][n]; }
    }
};
}
#define PG8_SP2 true
#define PG8_ALIGN true

#define LDS_FENCE() asm volatile("s_waitcnt lgkmcnt(0)" ::: "memory")
__device__ __forceinline__ unsigned f2bf(float f) { unsigned u = __builtin_bit_cast(unsigned, f); return (u + 0x7fffu + ((u >> 16) & 1u)) >> 16; }
__device__ __forceinline__ unsigned pk2(float lo, float hi) { return f2bf(lo) | (f2bf(hi) << 16); }
__device__ __forceinline__ float wave_sum(float v) {
#pragma unroll
    for (int o = 1; o < 64; o <<= 1) v += __shfl_xor(v, o);
    return v;
}
__device__ __forceinline__ float wave_max(float v) {
#pragma unroll
    for (int o = 1; o < 64; o <<= 1) v = fmaxf(v, __shfl_xor(v, o));
    return v;
}
__device__ __forceinline__ float silu_f(float x) { return x / (1.0f + __expf(-x)); }
__device__ __forceinline__ float gelu_f(float v) {
    const float t = __builtin_amdgcn_rcpf(fabsf(v) * 0.2316418882f + 1.0f);
    float q = t * 0.5307027145f + (-0.7265760135f); q = q * t + 0.7107068705f; q = q * t + (-0.142248368f); q = q * t + 0.127414796f; q = q * t;
    const float m = v * (q * __builtin_amdgcn_exp2f(v * v * (-0.72134752044f)));
    return v < 0.f ? m : v - m;
}
__device__ __forceinline__ float log_sigmoid_f(float z) { return fminf(z, 0.0f) - __logf(1.0f + __expf(-fabsf(z))); }


__device__ __forceinline__ float bflo(unsigned w) { return __builtin_bit_cast(float, w << 16); }
__device__ __forceinline__ float bfhi(unsigned w) { return __builtin_bit_cast(float, w & 0xffff0000u); }
__device__ __forceinline__ void unpack8(const u32x4 w, float (&f)[8]) { f[0] = bflo(w.x); f[1] = bfhi(w.x); f[2] = bflo(w.y); f[3] = bfhi(w.y); f[4] = bflo(w.z); f[5] = bfhi(w.z); f[6] = bflo(w.w); f[7] = bfhi(w.w); }
__device__ __forceinline__ u32x4 pack8(const float (&f)[8]) { u32x4 o; o.x = pk2(f[0], f[1]); o.y = pk2(f[2], f[3]); o.z = pk2(f[4], f[5]); o.w = pk2(f[6], f[7]); return o; }


__device__ __forceinline__ u32x6 pack_fp6_2x16(const f32x16 a, const f32x16 b) { u32x6 r; asm("v_cvt_scalef32_2xpk16_fp6_f32 %0, %1, %2, 1.0" : "=&v"(r) : "v"(a), "v"(b)); return r; }
__device__ __forceinline__ f32x32 unpack_fp6_32(const u32x6 w) { f32x32 r; asm volatile("v_cvt_scalef32_pk32_f32_fp6 %0, %1, 1.0" : "=&v"(r) : "v"(w)); return r; }

struct Params {
    const float* in[19];
    float* out;
    unsigned char* ws;
    int ph_lo, ph_hi;
};
enum { I_X = 0, I_C, I_CTX, I_CCTX, I_WADA, I_BADA, I_WIN, I_CONVW, I_GW2, I_GB2, I_GNORM, I_SINK, I_WOUT, I_LNG, I_LNB, I_PWQ, I_PSUB, I_PU, I_PV };

__device__ __forceinline__ int row_stream(int r) { return r < TL ? r / SEQ : 2; }

__device__ __forceinline__ void transpose_item(const float* W, int K, int N, bf16_t* WT, LAS float* scr, int item, int lane) {
    const int nblk = N / 32, kb = item / nblk, nb = item % nblk, k0 = 64 * kb, n0 = 32 * nb;
#pragma unroll 8
    for (int i = 0; i < 32; ++i) { const int kk = 2 * i + (lane >> 5); scr[kk * 33 + (lane & 31)] = W[(size_t)(k0 + kk) * N + n0 + (lane & 31)]; }
    LDS_FENCE();
    const int c = lane & 7;
#pragma unroll
    for (int j = 0; j < 4; ++j) { const int n = (lane >> 3) + 8 * j; const LAS float* s = scr + (8 * c) * 33 + n;
        u32x4 o; o.x = pk2(s[0 * 33], s[1 * 33]); o.y = pk2(s[2 * 33], s[3 * 33]); o.z = pk2(s[4 * 33], s[5 * 33]); o.w = pk2(s[6 * 33], s[7 * 33]);
        *(u32x4*)(WT + (size_t)(n0 + n) * K + k0 + 8 * c) = o; }
    LDS_FENCE();
}

__device__ __forceinline__ void phase_prologue(const Params& p, LAS unsigned char* lds, int tid, int lane, int wave, int bid, int G) {
    const int gw = bid * NWAVES + wave, NGW = G * NWAVES;
    LAS float* scr = (LAS float*)(lds + wave * 16384);
    bf16_t* WIN = (bf16_t*)(p.ws + WS_WIN); bf16_t* WOUT = (bf16_t*)(p.ws + WS_WOUT); bf16_t* WQ = (bf16_t*)(p.ws + WS_WQ);
    constexpr int IT_IN = (DM / 64) * (INW / 32), IT_SQ = (DM / 64) * (DM / 32), IT_L = IT_IN + 2 * IT_SQ;
    for (int it = gw; it < DEPTH * IT_L; it += NGW) {
        const int l = it / IT_L; int r = it % IT_L;
        if (r < IT_IN) { transpose_item(p.in[I_WIN] + (size_t)l * DM * INW, DM, INW, WIN + (size_t)l * INWP * DM, scr, r, lane); continue; } r -= IT_IN;
        if (r < IT_SQ) { transpose_item(p.in[I_WOUT] + (size_t)l * DM * DM, DM, DM, WOUT + (size_t)l * DM * DM, scr, r, lane); continue; } r -= IT_SQ;
        transpose_item(p.in[I_PWQ] + (size_t)l * DM * DM, DM, DM, WQ + (size_t)l * DM * DM, scr, r, lane);
    }
    {
        constexpr int PADV = (INWP - INW) * DM / 8;
        const int gt = bid * NTHREADS + tid, NGT = G * NTHREADS;
        for (int i = gt; i < DEPTH * PADV; i += NGT) { const int l = i / PADV, o = i % PADV;
            *(u32x4*)(WIN + (size_t)l * INWP * DM + (size_t)INW * DM + (size_t)o * 8) = (u32x4){0u, 0u, 0u, 0u}; }
    }
    {
        const float* U = p.in[I_PU]; const float* V = p.in[I_PV];
        unsigned char* UB = p.ws + WS_UB; unsigned char* VB = p.ws + WS_VB; float* USC = (float*)(p.ws + WS_USC); (void)USC; float* VSC = (float*)(p.ws + WS_VSC); (void)VSC;
        for (size_t row = gw; row < (size_t)DEPTH * NEXP; row += NGW) {
            f32x4 xx[2][8];
#pragma unroll
            for (int tb = 0; tb < 2; ++tb)
#pragma unroll
                for (int j = 0; j < 8; ++j) xx[tb][j] = *(const f32x4*)((tb ? V : U) + row * DM + lane * 32 + 4 * j);
#pragma unroll
            for (int tb = 0; tb < 2; ++tb) {
                f32x4 x[8]; float am = 0.f;
#pragma unroll
                for (int j = 0; j < 8; ++j) { x[j] = xx[tb][j]; am = fmaxf(am, fmaxf(fmaxf(fabsf(x[j].x), fabsf(x[j].y)), fmaxf(fabsf(x[j].z), fabsf(x[j].w)))); }
                if (tb == 0 && TBL_U_I4) {
#if U_ROWSCALE
                    unsigned char* dst = UB + row * ROWB_U;
                    float ssq = 0.f;
#pragma unroll
                    for (int j = 0; j < 8; ++j) ssq += (x[j].x * x[j].x + x[j].y * x[j].y) + (x[j].z * x[j].z + x[j].w * x[j].w);
                    const float amr = wave_max(am), rms = sqrtf(wave_sum(ssq) * (1.0f / DM));
                    const float srow = amr > 0.f ? fminf(amr * (1.0f / 7.0f), 0.36f * rms) : 1.0f; const float inv = 1.0f / srow; const int code = 0; (void)code;
                    if (lane == 0) USC[row] = srow;
#else
                    unsigned char* dst = UB + row * ROWB4;
                    const float sb = am * (1.0f / 7.0f); const unsigned ub = (__builtin_bit_cast(unsigned, sb) + 0x000fffffu) & 0xfff00000u;
                    int code = ((int)ub - (int)I4_BASE) >> 20; code = code < 0 ? 0 : (code > 255 ? 255 : code);
                    const float inv = 1.0f / __builtin_bit_cast(float, ((unsigned)code << 20) + I4_BASE);
#endif
                    u32x4 w;
#pragma unroll
                    for (int d = 0; d < 4; ++d) { unsigned t = 0u;
#pragma unroll
                        for (int e = 0; e < 8; ++e) { const float xv = (e < 4 ? x[2 * d] : x[2 * d + 1])[e & 3];
                            int q = (int)__builtin_rintf(xv * inv); q = q < -7 ? -7 : (q > 7 ? 7 : q); t |= ((unsigned)q & 15u) << (4 * e); }
                        w[d] = t; }
                    *(u32x4*)(dst + lane * 16) = w;
#if !U_ROWSCALE
                    dst[1024 + lane] = (unsigned char)code;
#endif
                } else if (tb == 1 && V_ROWSCALE) {
                    unsigned char* dst = VB + row * ROWB_V;
                    float ssq = 0.f;
#pragma unroll
                    for (int j = 0; j < 8; ++j) ssq += (x[j].x * x[j].x + x[j].y * x[j].y) + (x[j].z * x[j].z + x[j].w * x[j].w);
                    const float amr = wave_max(am), rms = sqrtf(wave_sum(ssq) * (1.0f / DM));
                    const float srow = amr > 0.f ? fminf(amr * (1.0f / 6.0f), (2.8f / 6.0f) * rms) : 1.0f; const float inv = 1.0f / srow;
                    if (lane == 0) VSC[row] = srow;
                    u32x4 w;
#pragma unroll
                    for (int d = 0; d < 4; ++d) { unsigned t = 0u;
                        t = __builtin_amdgcn_cvt_scalef32_pk_fp4_f32(t, x[2 * d].x * inv, x[2 * d].y * inv, 1.0f, 0); t = __builtin_amdgcn_cvt_scalef32_pk_fp4_f32(t, x[2 * d].z * inv, x[2 * d].w * inv, 1.0f, 1);
                        t = __builtin_amdgcn_cvt_scalef32_pk_fp4_f32(t, x[2 * d + 1].x * inv, x[2 * d + 1].y * inv, 1.0f, 2); t = __builtin_amdgcn_cvt_scalef32_pk_fp4_f32(t, x[2 * d + 1].z * inv, x[2 * d + 1].w * inv, 1.0f, 3);
                        w[d] = t; }
                    *(u32x4*)(dst + lane * 16) = w;
                } else if (tb == 1 || TBL_U_FP4) {
                    unsigned char* dst = (tb ? VB : UB) + row * ROWB4;
                    const float sb = am * (1.0f / 6.0f); unsigned ub = __builtin_bit_cast(unsigned, sb); ub = (ub & 0x007fffffu) ? ((ub & 0x7f800000u) + 0x00800000u) : (ub & 0x7f800000u);
                    if (!(am > 0.f) || ub < 0x00800000u) ub = 0x00800000u;
                    const float scl = __builtin_bit_cast(float, ub);
                    u32x4 w;
#pragma unroll
                    for (int d = 0; d < 4; ++d) { unsigned t = 0u;
                        t = __builtin_amdgcn_cvt_scalef32_pk_fp4_f32(t, x[2 * d].x, x[2 * d].y, scl, 0); t = __builtin_amdgcn_cvt_scalef32_pk_fp4_f32(t, x[2 * d].z, x[2 * d].w, scl, 1);
                        t = __builtin_amdgcn_cvt_scalef32_pk_fp4_f32(t, x[2 * d + 1].x, x[2 * d + 1].y, scl, 2); t = __builtin_amdgcn_cvt_scalef32_pk_fp4_f32(t, x[2 * d + 1].z, x[2 * d + 1].w, scl, 3);
                        w[d] = t; }
                    *(u32x4*)(dst + lane * 16) = w; dst[1024 + lane] = (unsigned char)(ub >> 23);
                } else {
                    unsigned char* dst = UB + row * ROWB;
                    am = wave_max(am);
                    const float inv = am > 0.f ? 7.0f / am : 0.f;
                    f32x16 x0, x1;
#pragma unroll
                    for (int j = 0; j < 4; ++j) { x0[4 * j + 0] = x[j].x * inv; x0[4 * j + 1] = x[j].y * inv; x0[4 * j + 2] = x[j].z * inv; x0[4 * j + 3] = x[j].w * inv;
                        x1[4 * j + 0] = x[4 + j].x * inv; x1[4 * j + 1] = x[4 + j].y * inv; x1[4 * j + 2] = x[4 + j].z * inv; x1[4 * j + 3] = x[4 + j].w * inv; }
                    const u32x6 w = pack_fp6_2x16(x0, x1);
                    *(u32x4*)(dst + lane * 16) = (u32x4){w[0], w[1], w[2], w[3]}; *(u32x2*)(dst + 1024 + lane * 8) = (u32x2){w[4], w[5]};
                    if (lane == 0) USC[row] = am * (1.0f / 7.0f);
                }
            }
        }
        const size_t gt = (size_t)bid * NTHREADS + tid, NGT = (size_t)G * NTHREADS;
        const float* SUB = p.in[I_PSUB]; bf16_t* SUBB = (bf16_t*)(p.ws + WS_SUBB);
        for (size_t i = gt; i < (size_t)DEPTH * 2 * 128 * 128 / 2; i += NGT) ((unsigned*)SUBB)[i] = pk2(SUB[2 * i], SUB[2 * i + 1]);
    }
    __syncthreads();
    LAS float* sc = (LAS float*)lds;
    LAS float* red = (LAS float*)(lds + 32768);
    for (int i = tid; i < 3 * DM; i += NTHREADS) { const int s = i / DM, k = i % DM; const float v = s < 2 ? p.in[I_C][s * DM + k] : p.in[I_CCTX][k]; sc[i] = silu_f(v); }
    __syncthreads();
    float* MOD = (float*)(p.ws + WS_MOD);
    LAS float* red2 = (LAS float*)(lds + 32768);
    constexpr int NCH = 6 * DM / 256;
    for (int it = bid; it < DEPTH * NCH; it += G) {
        const int l = it / NCH, n0 = (it % NCH) * 256;
        const float* wp = p.in[I_WADA] + (size_t)l * DM * 6 * DM + n0 + lane * 4;
        f32x4 a0 = (f32x4){0.f, 0.f, 0.f, 0.f}, a1 = a0, a2 = a0;
        const int kb = wave * (DM / NWAVES);
#pragma unroll 16
        for (int k = kb; k < kb + DM / NWAVES; ++k) { const f32x4 w = *(const f32x4*)(wp + (size_t)k * 6 * DM); a0 += w * sc[k]; a1 += w * sc[DM + k]; a2 += w * sc[2 * DM + k]; }
        *(LAS f32x4*)(red2 + (wave * 3 + 0) * 256 + lane * 4) = a0; *(LAS f32x4*)(red2 + (wave * 3 + 1) * 256 + lane * 4) = a1; *(LAS f32x4*)(red2 + (wave * 3 + 2) * 256 + lane * 4) = a2;
        __syncthreads();
        for (int i = tid; i < 768; i += NTHREADS) { const int st = i >> 8, c = i & 255; float v = 0.f;
#pragma unroll
            for (int w = 0; w < NWAVES; ++w) v += red2[(w * 3 + st) * 256 + c];
            MOD[((size_t)l * 3 + st) * 6 * DM + n0 + c] = v + p.in[I_BADA][(size_t)l * 6 * DM + n0 + c]; }
        __syncthreads();
    }
}


__device__ __forceinline__ int row_first(int wave, int bid, int G) { const int gw = bid * NWAVES + wave; return gw < TL ? gw : -1; }
__device__ __forceinline__ int row_next(int r, int wave, int bid, int G, int nrows) {
    const int NGW = G * NWAVES;
    if (r < TL) { if (r + NGW < TL) return r + NGW; const int c = TL + wave * G + bid; return c < nrows ? c : -1; }
    return r + NGW < nrows ? r + NGW : -1;
}
__device__ __forceinline__ const float* xsrc(const Params& p, int l, int r) {
    return r < TL ? p.in[I_X] + (size_t)r * DM : p.in[I_CTX] + (size_t)(r - TL) * DM;
}

__device__ __forceinline__ void modulate_row(const float* xr, const float* mod, int sh_off, int sc_off, bf16_t* hb, int lane) {
    f32x4 xx[8];
#pragma unroll
    for (int j = 0; j < 8; ++j) xx[j] = *(const f32x4*)(xr + lane * 4 + 256 * j);
#pragma unroll
    for (int j = 0; j < 8; ++j) { const int c = lane * 4 + 256 * j;
        const f32x4 x = xx[j], sh = *(const f32x4*)(mod + sh_off + c), s = *(const f32x4*)(mod + sc_off + c);
        u32x2 o; o.x = pk2(x.x * (1.f + s.x) + sh.x, x.y * (1.f + s.y) + sh.y); o.y = pk2(x.z * (1.f + s.z) + sh.z, x.w * (1.f + s.w) + sh.w);
        *(u32x2*)(hb + c) = o; }
}
__device__ __forceinline__ void phase_modulate0(const Params& p, int lane, int wave, int bid, int G) {
    const int gw = bid * NWAVES + wave, NGW = G * NWAVES;
    const float* MOD = (const float*)(p.ws + WS_MOD); bf16_t* HB = (bf16_t*)(p.ws + WS_HB);
    for (int r = row_first(wave, bid, G); r >= 0; r = row_next(r, wave, bid, G, TA)) modulate_row(xsrc(p, 0, r), MOD + (size_t)(0 * 3 + row_stream(r)) * 6 * DM, 0, DM, HB + (size_t)r * DM, lane);
}

__device__ __forceinline__ void gemm_direct(const bf16_t* A, const bf16_t* Bt, float* C, int M, int N, int K, int ldc, int gw, int NGW, int lane) {
    const int nTn = N / 64, nItems = (M / 32) * nTn;
    const int fr = lane & 15, fq = lane >> 4;
    for (int it = gw; it < nItems; it += NGW) {
        const int mt = it / nTn, nt = it % nTn;
        const bf16_t* a0 = A + (size_t)(mt * 32 + fr) * K + fq * 8;
        const bf16_t* b0 = Bt + (size_t)(nt * 64 + fr) * K + fq * 8;
        f32x4 acc[2][4];
#pragma unroll
        for (int i = 0; i < 2; ++i)
#pragma unroll
            for (int j = 0; j < 4; ++j) acc[i][j] = (f32x4){0.f, 0.f, 0.f, 0.f};
#pragma unroll 2
        for (int k0 = 0; k0 < K; k0 += 32) {
            bf16x8 af[2], bfr[4];
#pragma unroll
            for (int i = 0; i < 2; ++i) af[i] = *(const bf16x8*)(a0 + (size_t)i * 16 * K + k0);
#pragma unroll
            for (int j = 0; j < 4; ++j) bfr[j] = *(const bf16x8*)(b0 + (size_t)j * 16 * K + k0);
#pragma unroll
            for (int i = 0; i < 2; ++i)
#pragma unroll
                for (int j = 0; j < 4; ++j) acc[i][j] = __builtin_amdgcn_mfma_f32_16x16x32_bf16(af[i], bfr[j], acc[i][j], 0, 0, 0);
        }
#pragma unroll
        for (int i = 0; i < 2; ++i)
#pragma unroll
            for (int j = 0; j < 4; ++j)
#pragma unroll
                for (int g = 0; g < 4; ++g) C[(size_t)(mt * 32 + i * 16 + fq * 4 + g) * ldc + nt * 64 + j * 16 + fr] = acc[i][j][g];
    }
}

__device__ __forceinline__ void phase_post_in(const Params& p, int l, int lane, int wave, int bid, int G) {
    const int gw = bid * NWAVES + wave, NGW = G * NWAVES;
    const bf16_t* P = (const bf16_t*)(p.ws + WS_P);
    bf16_t* QR = (bf16_t*)(p.ws + WS_QR); bf16_t* KR = (bf16_t*)(p.ws + WS_KR); bf16_t* VR = (bf16_t*)(p.ws + WS_ALF);
    bf16_t* MIX = (bf16_t*)(p.ws + WS_MIX);
    const float* cw = p.in[I_CONVW] + (size_t)l * 3 * 512;
    const int c8 = lane * 8, rh = lane >> 3, rf = (lane >> 2) & 1, rg = lane & 3, roff = rh * 128 + rf * 64 + rg * 8;
    float w0[8], w1[8], w2[8], invf[8];
#pragma unroll
    for (int e = 0; e < 8; ++e) { w0[e] = cw[c8 + e]; w1[e] = cw[512 + c8 + e]; w2[e] = cw[1024 + c8 + e]; invf[e] = __builtin_amdgcn_exp2f(-(float)(rg * 8 + e) * 0.4152410118609203f); }
    for (int r = row_first(wave, bid, G); r >= 0; r = row_next(r, wave, bid, G, TA)) {
        const bf16_t* pr = P + (size_t)r * INWP;
        int pos, len;
        if (r < TL) { pos = r % SEQ; len = SEQ; } else { pos = (r - TL) % CTXL; len = CTXL; }
        const bool hp = pos > 0, hn = pos < len - 1;
        const u32x4 z4 = (u32x4){0u, 0u, 0u, 0u};
        const u32x4 xC = *(const u32x4*)(pr + C_CC + c8), xX = *(const u32x4*)(pr + C_CX + c8), xB = *(const u32x4*)(pr + C_CB + c8);
        const u32x4 pC = hp ? *(const u32x4*)(pr - INWP + C_CC + c8) : z4, pX = hp ? *(const u32x4*)(pr - INWP + C_CX + c8) : z4;
        const u32x4 nC = hn ? *(const u32x4*)(pr + INWP + C_CC + c8) : z4, nX = hn ? *(const u32x4*)(pr + INWP + C_CX + c8) : z4;
        const u32x4 q1 = *(const u32x4*)(pr + C_SQ + roff), q2 = *(const u32x4*)(pr + C_SQ + roff + 32);
        u32x4 k1 = z4, k2 = z4, vv = z4;
        if (lane < 16) { k1 = *(const u32x4*)(pr + C_SK + roff); k2 = *(const u32x4*)(pr + C_SK + roff + 32); }
        if (lane < 32) vv = *(const u32x4*)(pr + C_SV + c8);
        { float fC[8], fX[8], fB[8], gC[8], gX[8], hC[8], hX[8], o[8];
          unpack8(xC, fC); unpack8(xX, fX); unpack8(xB, fB); unpack8(pC, gC); unpack8(pX, gX); unpack8(nC, hC); unpack8(nX, hX);
#pragma unroll
          for (int e = 0; e < 8; ++e) o[e] = fB[e] * (w0[e] * gC[e] * gX[e] + w1[e] * fC[e] * fX[e] + w2[e] * hC[e] * hX[e]);
          *(u32x4*)(MIX + (size_t)r * DM + c8) = pack8(o); }
        { float cs[8], sn[8];
#pragma unroll
          for (int e = 0; e < 8; ++e) { cs[e] = 1.f; sn[e] = 0.f; }
          if (r < TL) { const float pv = (float)(rf ? (pos % 64) : (pos / 64));
#pragma unroll
              for (int e = 0; e < 8; ++e) { sn[e] = __sinf(pv * invf[e]); cs[e] = __cosf(pv * invf[e]); } }
          float x1[8], x2[8], o1[8], o2[8];
          unpack8(q1, x1); unpack8(q2, x2);
#pragma unroll
          for (int e = 0; e < 8; ++e) { o1[e] = (x1[e] * cs[e] - x2[e] * sn[e]) * 0.08838834764831845f; o2[e] = (x2[e] * cs[e] + x1[e] * sn[e]) * 0.08838834764831845f; }
          *(u32x4*)(QR + (size_t)r * 1024 + roff) = pack8(o1); *(u32x4*)(QR + (size_t)r * 1024 + roff + 32) = pack8(o2);
          if (lane < 16) { unpack8(k1, x1); unpack8(k2, x2);
#pragma unroll
              for (int e = 0; e < 8; ++e) { o1[e] = x1[e] * cs[e] - x2[e] * sn[e]; o2[e] = x2[e] * cs[e] + x1[e] * sn[e]; }
              *(u32x4*)(KR + (size_t)r * 256 + roff) = pack8(o1); *(u32x4*)(KR + (size_t)r * 256 + roff + 32) = pack8(o2); }
          if (lane < 32) *(u32x4*)(VR + (size_t)r * 256 + c8) = vv; }
    }
}

#ifndef SWA_THR
#define SWA_THR 6.0f
#endif
constexpr int KP = 136, VP = 72;
constexpr int SWA_BUF = 64 * KP * 2 + 128 * VP * 2;
typedef short bf16x4 __attribute__((ext_vector_type(4)));
__device__ __forceinline__ void phase_mixers(const Params& p, int l, LAS unsigned char* lds, int tid, int lane, int wave, int bid, int G, int qsel = 0) {
    const bf16_t* QR = (const bf16_t*)(p.ws + WS_QR); const bf16_t* KR = (const bf16_t*)(p.ws + WS_KR); const bf16_t* VR = (const bf16_t*)(p.ws + WS_ALF);
    bf16_t* MIX = (bf16_t*)(p.ws + WS_MIX);
    const float* sinkp = p.in[I_SINK] + l * 8;
    const int fr = lane & 15, fq = lane >> 4, g = wave & 3, qh = wave >> 2;
    const int nItems = 512 + ((l < DEPTH - 1) ? 16 : 0);
    unsigned* qhead = (unsigned*)(p.ws + WS_CTL) + CW_QUEUE + 64 * (l + 4 * qsel);
    volatile LAS int* itw = (volatile LAS int*)(lds + MISC_OFF + 64);
    for (;;) {
        if (tid == 0) itw[0] = (int)__hip_atomic_fetch_add(qhead, 1u, __ATOMIC_RELAXED, __HIP_MEMORY_SCOPE_AGENT);
        __syncthreads();
        const int it = itw[0];
        __syncthreads();
        if (it >= nItems) break;
        int b, tile, hk, s0; size_t qrow0;
        if (it < 512) { b = it >> 8; tile = (it >> 1) & 127; hk = it & 1; s0 = 0; qrow0 = (size_t)b * SEQ + tile * 64; }
        else { const int c = it - 512; b = c >> 3; tile = (c >> 1) & 3; hk = c & 1; s0 = 5; qrow0 = (size_t)TL + b * CTXL + tile * 64; }
        const int n0 = tile * 64, hq = hk * 4 + g;
        bf16x8 qf[2][4];
#pragma unroll
        for (int qt = 0; qt < 2; ++qt)
#pragma unroll
            for (int ks = 0; ks < 4; ++ks) qf[qt][ks] = *(const bf16x8*)(QR + (qrow0 + qh * 32 + qt * 16 + fr) * 1024 + hq * 128 + ks * 32 + fq * 8);
        f32x4 O[2][8];
#pragma unroll
        for (int qt = 0; qt < 2; ++qt)
#pragma unroll
            for (int dt = 0; dt < 8; ++dt) O[qt][dt] = (f32x4){0.f, 0.f, 0.f, 0.f};
        float m[2], lsum[2];
        m[0] = m[1] = sinkp[hq]; lsum[0] = lsum[1] = (fq == 0) ? 1.f : 0.f;
        u32x4 kreg[2], vreg[2];
#define SWA_ROW(s, kk) ((s) < 5 ? (size_t)b * SEQ + (size_t)min(max(n0 - 128 + (s) * 64 + (kk), 0), SEQ - 1) : (size_t)TL + (size_t)b * CTXL + ((s) - 5) * 64 + (kk))
#define SWA_LOAD(s) do { _Pragma("unroll") for (int j = 0; j < 2; ++j) { const int v = tid + NTHREADS * j; \
            kreg[j] = *(const u32x4*)(KR + SWA_ROW(s, v >> 4) * 256 + hk * 128 + (v & 15) * 8); \
            vreg[j] = *(const u32x4*)(VR + SWA_ROW(s, tid & 63) * 256 + hk * 128 + ((tid >> 6) + 8 * j) * 8); } } while (0)
#define SWA_WRITE(buf) do { LAS bf16_t* Kd = (LAS bf16_t*)(lds + (buf) * SWA_BUF); LAS bf16_t* Vd = Kd + 64 * KP; \
            _Pragma("unroll") for (int j = 0; j < 2; ++j) { const int v = tid + NTHREADS * j; *(LAS u32x4*)(Kd + (v >> 4) * KP + (v & 15) * 8) = kreg[j]; \
                const int d0 = ((tid >> 6) + 8 * j) * 8, key = tid & 63; const u32x4 w = vreg[j]; \
                Vd[(d0 + 0) * VP + key] = (bf16_t)(w.x & 0xffffu); Vd[(d0 + 1) * VP + key] = (bf16_t)(w.x >> 16); Vd[(d0 + 2) * VP + key] = (bf16_t)(w.y & 0xffffu); Vd[(d0 + 3) * VP + key] = (bf16_t)(w.y >> 16); \
                Vd[(d0 + 4) * VP + key] = (bf16_t)(w.z & 0xffffu); Vd[(d0 + 5) * VP + key] = (bf16_t)(w.z >> 16); Vd[(d0 + 6) * VP + key] = (bf16_t)(w.w & 0xffffu); Vd[(d0 + 7) * VP + key] = (bf16_t)(w.w >> 16); } } while (0)
        SWA_LOAD(s0); SWA_WRITE(0);
        __syncthreads();
#pragma unroll 1
        for (int s = s0; s < 9; ++s) {
            const int buf = (s - s0) & 1;
            if (s + 1 < 9) SWA_LOAD(s + 1);
            const LAS bf16_t* Ks = (const LAS bf16_t*)(lds + buf * SWA_BUF); const LAS bf16_t* Vs = Ks + 64 * KP;
#pragma unroll 1
            for (int sc = 0; sc < 2; ++sc) {
                f32x4 sT[2][2];
#pragma unroll
                for (int qt = 0; qt < 2; ++qt) { sT[qt][0] = (f32x4){0.f, 0.f, 0.f, 0.f}; sT[qt][1] = (f32x4){0.f, 0.f, 0.f, 0.f}; }
#pragma unroll
                for (int ks = 0; ks < 4; ++ks)
#pragma unroll
                    for (int kt = 0; kt < 2; ++kt) { const bf16x8 ka = *(const LAS bf16x8*)(Ks + (sc * 32 + kt * 16 + fr) * KP + ks * 32 + fq * 8);
#pragma unroll
                        for (int qt = 0; qt < 2; ++qt) sT[qt][kt] = __builtin_amdgcn_mfma_f32_16x16x32_bf16(ka, qf[qt][ks], sT[qt][kt], 0, 0, 0); }
                bf16x8 pb[2];
                float cm[2];
#pragma unroll
                for (int qt = 0; qt < 2; ++qt) {
                    if (s < 5) {
                        const int qpos = n0 + qh * 32 + qt * 16 + fr;
#pragma unroll
                        for (int kt = 0; kt < 2; ++kt)
#pragma unroll
                            for (int e = 0; e < 4; ++e) { const int kpos = n0 - 128 + s * 64 + sc * 32 + kt * 16 + fq * 4 + e; const int dlt = qpos - kpos;
                                const bool ok = kpos >= 0 && kpos < SEQ && dlt <= 128 && dlt >= -128; sT[qt][kt][e] = ok ? sT[qt][kt][e] : -1e30f; } }
                    cm[qt] = fmaxf(fmaxf(fmaxf(sT[qt][0][0], sT[qt][0][1]), fmaxf(sT[qt][0][2], sT[qt][0][3])), fmaxf(fmaxf(sT[qt][1][0], sT[qt][1][1]), fmaxf(sT[qt][1][2], sT[qt][1][3])));
                }
                if (__any((cm[0] > m[0] + SWA_THR) || (cm[1] > m[1] + SWA_THR))) {
#pragma unroll
                    for (int qt = 0; qt < 2; ++qt) { float c = cm[qt]; c = fmaxf(c, __shfl_xor(c, 16)); c = fmaxf(c, __shfl_xor(c, 32));
                        const float mn = fmaxf(m[qt], c), scl = __expf(m[qt] - mn); m[qt] = mn; lsum[qt] *= scl;
#pragma unroll
                        for (int dt = 0; dt < 8; ++dt) O[qt][dt] = O[qt][dt] * scl; }
                }
#pragma unroll
                for (int qt = 0; qt < 2; ++qt) {
                    float pe[8]; float ps = 0.f;
#pragma unroll
                    for (int kt = 0; kt < 2; ++kt)
#pragma unroll
                        for (int e = 0; e < 4; ++e) { pe[kt * 4 + e] = __expf(sT[qt][kt][e] - m[qt]); ps += pe[kt * 4 + e]; }
                    lsum[qt] += ps;
                    u32x4 pw; pw.x = pk2(pe[0], pe[1]); pw.y = pk2(pe[2], pe[3]); pw.z = pk2(pe[4], pe[5]); pw.w = pk2(pe[6], pe[7]);
                    pb[qt] = __builtin_bit_cast(bf16x8, pw);
                }
#pragma unroll
                for (int dt = 0; dt < 8; ++dt) {
                    const bf16x4 v0 = *(const LAS bf16x4*)(Vs + (dt * 16 + fr) * VP + sc * 32 + 4 * fq), v1 = *(const LAS bf16x4*)(Vs + (dt * 16 + fr) * VP + sc * 32 + 16 + 4 * fq);
                    const bf16x8 va = __builtin_shufflevector(v0, v1, 0, 1, 2, 3, 4, 5, 6, 7);
#pragma unroll
                    for (int qt = 0; qt < 2; ++qt) O[qt][dt] = __builtin_amdgcn_mfma_f32_16x16x32_bf16(va, pb[qt], O[qt][dt], 0, 0, 0);
                }
            }
            if (s + 1 < 9) SWA_WRITE(buf ^ 1);
            __syncthreads();
        }
#undef SWA_ROW
#undef SWA_LOAD
#undef SWA_WRITE
#pragma unroll
        for (int qt = 0; qt < 2; ++qt) {
            float lt = lsum[qt]; lt += __shfl_xor(lt, 16); lt += __shfl_xor(lt, 32);
            const float inv = 1.0f / lt;
            bf16_t* o = MIX + (qrow0 + qh * 32 + qt * 16 + fr) * DM + 1024 + hq * 128 + fq * 4;
#pragma unroll
            for (int dt = 0; dt < 8; ++dt) { u32x2 w; w.x = pk2(O[qt][dt][0] * inv, O[qt][dt][1] * inv); w.y = pk2(O[qt][dt][2] * inv, O[qt][dt][3] * inv); *(u32x2*)(o + dt * 16) = w; }
        }
    }
}

__device__ __forceinline__ int chunk_row0(int cid) { return cid < 256 ? (cid >> 7) * SEQ + (cid & 127) * 64 : TL + ((cid - 256) >> 2) * CTXL + ((cid - 256) & 3) * 64; }
constexpr int GP = 72;

constexpr int LTP = 65;
__device__ __forceinline__ void gla_g1(const Params& p, int l, LAS unsigned char* lds, int tid, int lane, int wave, int bid, int G) {
    LAS float* LTf = (LAS float*)lds; LAS float* LTb = LTf + 64 * LTP;
    LAS bf16_t* KTf = (LAS bf16_t*)(lds + 2 * 64 * LTP * 4); LAS bf16_t* KTb = KTf + 64 * GP;
    LAS bf16_t* VT = KTb + 64 * GP;
    const bf16_t* P = (const bf16_t*)(p.ws + WS_P);
    float* BF = (float*)(p.ws + WS_OF); float* BB = (float*)(p.ws + WS_OB);
    float* DELTA = (float*)(p.ws + WS_DELTA); float* DEC = (float*)(p.ws + WS_DEC);
    const float* w2 = p.in[I_GW2] + (size_t)l * 2 * 16 * 256; const float* b2 = p.in[I_GB2] + (size_t)l * 2 * 256;
    const int fr = lane & 15, fq = lane >> 4, ti = tid >> 3, tk0 = (tid & 7) * 8;
    float wr[2][16], br[2];
    const bool fixed_h = (G & 3) == 0;
#define G1_LOADW(hh_) do { _Pragma("unroll") for (int d = 0; d < 2; ++d) { br[d] = b2[d * 256 + (hh_) * 64 + lane]; \
        _Pragma("unroll") for (int q = 0; q < 16; ++q) wr[d][q] = w2[(d * 16 + q) * 256 + (hh_) * 64 + lane]; } } while (0)
    if (fixed_h) G1_LOADW(bid & 3);
    u32x4 kraw, vraw[2], lrr[2][4];
#define G1_LOADX(item_) do { const int cid_ = (item_) >> 2, h_ = (item_) & 3, row0_ = chunk_row0(cid_); \
        kraw = *(const u32x4*)(P + (size_t)(row0_ + ti) * INWP + C_GK + h_ * 64 + tk0); \
        _Pragma("unroll") for (int j = 0; j < 2; ++j) { const int vi = tid + NTHREADS * j; vraw[j] = *(const u32x4*)(P + (size_t)(row0_ + (vi >> 4)) * INWP + C_GV + h_ * 128 + (vi & 15) * 8); } \
        _Pragma("unroll") for (int jj = 0; jj < 2; ++jj) _Pragma("unroll") for (int c = 0; c < 4; ++c) lrr[jj][c] = *(const u32x4*)(P + (size_t)(row0_ + wave + 8 * jj) * INWP + C_LRF + c * 8); } while (0)
    if (bid < GLA_ITEMS) G1_LOADX(bid);
    for (int item = bid; item < GLA_ITEMS; item += G) {
        const int cid = item >> 2, h = item & 3, row0 = chunk_row0(cid);
        const u32x4 kraw_c = kraw; u32x4 vraw_c[2] = {vraw[0], vraw[1]};
        {
            if (!fixed_h) G1_LOADW(h);
#pragma unroll
            for (int jj = 0; jj < 8; ++jj) { const int i = wave + 8 * jj;
                float lf[4][8];
                if (jj < 2) {
#pragma unroll
                    for (int c = 0; c < 4; ++c) unpack8(lrr[jj][c], lf[c]);
                } else { const bf16_t* lrp = P + (size_t)(row0 + i) * INWP + C_LRF;
#pragma unroll
                    for (int c = 0; c < 4; ++c) unpack8(*(const u32x4*)(lrp + c * 8), lf[c]); }
#pragma unroll
                for (int d = 0; d < 2; ++d) { float z = br[d];
#pragma unroll
                    for (int q = 0; q < 16; ++q) z += lf[d * 2 + (q >> 3)][q & 7] * wr[d][q];
                    (d ? LTb : LTf)[lane * LTP + i] = log_sigmoid_f(z) * (1.0f / 16.0f); } }
        }
        if (item + G < GLA_ITEMS) G1_LOADX(item + G);
        __syncthreads();
#pragma unroll 2
        for (int kk = 0; kk < 8; ++kk) { const int k = wave * 8 + kk;
            float xf = LTf[k * LTP + lane], xb = LTb[k * LTP + lane];
            float pf = xf, pb = xb;
#pragma unroll
            for (int o = 1; o < 64; o <<= 1) { const float tf = __shfl_up(pf, o), tb = __shfl_up(pb, o); if (lane >= o) { pf += tf; pb += tb; } }
            const float totb = __shfl(pb, 63);
            LTf[k * LTP + lane] = pf; LTb[k * LTP + lane] = totb - pb + xb; }
        __syncthreads();
        { float kv[8]; unpack8(kraw_c, kv);
          float bfv[8], bbv[8];
#pragma unroll
          for (int e = 0; e < 8; ++e) { const int k = tk0 + e; bfv[e] = LTf[k * LTP + ti]; bbv[e] = LTb[k * LTP + ti];
              KTf[k * GP + ti] = (bf16_t)f2bf(kv[e] * __expf(LTf[k * LTP + 63] - bfv[e]));
              KTb[k * GP + ti] = (bf16_t)f2bf(kv[e] * __expf(LTb[k * LTP] - bbv[e])); }
          float* bg = BF + (size_t)(row0 + ti) * 256 + h * 64 + tk0; *(f32x4*)bg = (f32x4){bfv[0], bfv[1], bfv[2], bfv[3]}; *(f32x4*)(bg + 4) = (f32x4){bfv[4], bfv[5], bfv[6], bfv[7]};
          bg = BB + (size_t)(row0 + ti) * 256 + h * 64 + tk0; *(f32x4*)bg = (f32x4){bbv[0], bbv[1], bbv[2], bbv[3]}; *(f32x4*)(bg + 4) = (f32x4){bbv[4], bbv[5], bbv[6], bbv[7]};
#pragma unroll
          for (int j = 0; j < 2; ++j) { const int vi = tid + NTHREADS * j, i = vi >> 4, v0 = (vi & 15) * 8; const u32x4 w = vraw_c[j];
              VT[(v0 + 0) * GP + i] = (bf16_t)(w.x & 0xffffu); VT[(v0 + 1) * GP + i] = (bf16_t)(w.x >> 16); VT[(v0 + 2) * GP + i] = (bf16_t)(w.y & 0xffffu); VT[(v0 + 3) * GP + i] = (bf16_t)(w.y >> 16);
              VT[(v0 + 4) * GP + i] = (bf16_t)(w.z & 0xffffu); VT[(v0 + 5) * GP + i] = (bf16_t)(w.z >> 16); VT[(v0 + 6) * GP + i] = (bf16_t)(w.w & 0xffffu); VT[(v0 + 7) * GP + i] = (bf16_t)(w.w >> 16); }
          if (tid < 128) { const int dir = tid >> 6, k = tid & 63; DEC[((size_t)item * 2 + dir) * 64 + k] = __expf(dir ? LTb[k * LTP] : LTf[k * LTP + 63]); } }
        __syncthreads();
        { const int dir = wave >> 2, vq = wave & 3; const LAS bf16_t* KT = dir ? KTb : KTf;
            f32x4 acc[2][4];
#pragma unroll
            for (int a = 0; a < 2; ++a)
#pragma unroll
                for (int b = 0; b < 4; ++b) acc[a][b] = (f32x4){0.f, 0.f, 0.f, 0.f};
#pragma unroll
            for (int ks = 0; ks < 2; ++ks) { bf16x8 af[2], bfr[4];
#pragma unroll
                for (int a = 0; a < 2; ++a) af[a] = *(const LAS bf16x8*)(VT + ((vq * 2 + a) * 16 + fr) * GP + ks * 32 + fq * 8);
#pragma unroll
                for (int b = 0; b < 4; ++b) bfr[b] = *(const LAS bf16x8*)(KT + (b * 16 + fr) * GP + ks * 32 + fq * 8);
#pragma unroll
                for (int a = 0; a < 2; ++a)
#pragma unroll
                    for (int b = 0; b < 4; ++b) acc[a][b] = __builtin_amdgcn_mfma_f32_16x16x32_bf16(af[a], bfr[b], acc[a][b], 0, 0, 0); }
            float* dst = DELTA + ((size_t)item * 2 + dir) * 8192;
#pragma unroll
            for (int a = 0; a < 2; ++a)
#pragma unroll
                for (int b = 0; b < 4; ++b)
#pragma unroll
                    for (int g = 0; g < 4; ++g) dst[((vq * 2 + a) * 16 + fq * 4 + g) * 64 + b * 16 + fr] = acc[a][b][g]; }
        __syncthreads();
    }
}

#undef G1_LOADW
#undef G1_LOADX
__device__ __forceinline__ void gla_g2(const Params& p, int tid, int bid, int G) {
    const float* DELTA = (const float*)(p.ws + WS_DELTA); const float* DEC = (const float*)(p.ws + WS_DEC); bf16_t* SST = (bf16_t*)(p.ws + WS_SST);
    for (int u = bid; u < 64; u += G) {
        const int s = u >> 2, dir = s >> 3, b = (s >> 2) & 1, h = s & 3, off = ((u & 3) * NTHREADS + tid) * 4, k0 = off & 63;
        f32x4 S = (f32x4){0.f, 0.f, 0.f, 0.f};
#pragma unroll 1
        for (int st = 0; st < 132; st += 12) {
            f32x4 d[12], dc[12]; size_t base[12];
#pragma unroll
            for (int q = 0; q < 12; ++q) { const int t = st + q;
                const int cid = t < 4 ? 256 + b * 4 + (dir ? 3 - t : t) : b * 128 + (dir ? 127 - (t - 4) : (t - 4));
                const size_t it2 = (size_t)(cid * 4 + h) * 2 + dir; base[q] = it2 * 8192 + off;
                d[q] = *(const f32x4*)(DELTA + base[q]); dc[q] = *(const f32x4*)(DEC + it2 * 64 + k0); }
#pragma unroll
            for (int q = 0; q < 12; ++q) { u32x2 o; o.x = pk2(S.x, S.y); o.y = pk2(S.z, S.w); *(u32x2*)(SST + base[q]) = o; S = dc[q] * S + d[q]; }
        }
    }
}

__device__ __forceinline__ void gla_g3(const Params& p, int l, LAS unsigned char* lds, int tid, int lane, int wave, int bid, int G) {
    LAS bf16_t* QEf = (LAS bf16_t*)lds; LAS bf16_t* QEb = QEf + 64 * GP; LAS bf16_t* KEf = QEb + 64 * GP; LAS bf16_t* KEb = KEf + 64 * GP;
    LAS bf16_t* VT = KEb + 64 * GP;
    LAS bf16_t* ATT = VT + 128 * GP + wave * (16 * GP);
    LAS float* RS = (LAS float*)(lds + 2 * (4 * 64 * GP + 128 * GP + 8 * 16 * GP));
    const bf16_t* P = (const bf16_t*)(p.ws + WS_P);
    const float* BF = (const float*)(p.ws + WS_OF); const float* BB = (const float*)(p.ws + WS_OB);
    const bf16_t* SST = (const bf16_t*)(p.ws + WS_SST); bf16_t* MIX = (bf16_t*)(p.ws + WS_MIX);
    const float* nw = p.in[I_GNORM] + l * 128;
    const int fr = lane & 15, fq = lane >> 4, it = wave >> 1, vh = wave & 1, ti = tid >> 3, tk0 = (tid & 7) * 8;
    const int n_items = (l < DEPTH - 1) ? GLA_ITEMS : 256 * 4;
    for (int item = bid; item < n_items; item += G) {
        const int cid = item >> 2, h = item & 3, row0 = chunk_row0(cid);
        {
            const size_t r = (size_t)(row0 + ti);
            const u32x4 qraw = *(const u32x4*)(P + r * INWP + C_GQ + h * 64 + tk0), kraw = *(const u32x4*)(P + r * INWP + C_GK + h * 64 + tk0);
            const f32x4 f0 = *(const f32x4*)(BF + r * 256 + h * 64 + tk0), f1 = *(const f32x4*)(BF + r * 256 + h * 64 + tk0 + 4);
            const f32x4 b0 = *(const f32x4*)(BB + r * 256 + h * 64 + tk0), b1 = *(const f32x4*)(BB + r * 256 + h * 64 + tk0 + 4);
            u32x4 vraw[2];
#pragma unroll
            for (int j = 0; j < 2; ++j) { const int vi = tid + NTHREADS * j; vraw[j] = *(const u32x4*)(P + (size_t)(row0 + (vi >> 4)) * INWP + C_GV + h * 128 + (vi & 15) * 8); }
            float q[8], kk[8]; unpack8(qraw, q); unpack8(kraw, kk);
            const float bf[8] = {f0.x, f0.y, f0.z, f0.w, f1.x, f1.y, f1.z, f1.w}, bb[8] = {b0.x, b0.y, b0.z, b0.w, b1.x, b1.y, b1.z, b1.w};
            float o0[8], o1[8], o2[8], o3[8];
#pragma unroll
            for (int e = 0; e < 8; ++e) { const float ef = __expf(bf[e]), eb = __expf(bb[e]); const float qs = q[e] * 0.125f;
                o0[e] = qs * ef; o1[e] = kk[e] / ef; o2[e] = qs * eb; o3[e] = kk[e] / eb; }
            *(LAS u32x4*)(QEf + ti * GP + tk0) = pack8(o0); *(LAS u32x4*)(KEf + ti * GP + tk0) = pack8(o1); *(LAS u32x4*)(QEb + ti * GP + tk0) = pack8(o2); *(LAS u32x4*)(KEb + ti * GP + tk0) = pack8(o3);
#pragma unroll
            for (int j = 0; j < 2; ++j) { const int vi = tid + NTHREADS * j, i = vi >> 4, v0 = (vi & 15) * 8; const u32x4 w = vraw[j];
                VT[(v0 + 0) * GP + i] = (bf16_t)(w.x & 0xffffu); VT[(v0 + 1) * GP + i] = (bf16_t)(w.x >> 16); VT[(v0 + 2) * GP + i] = (bf16_t)(w.y & 0xffffu); VT[(v0 + 3) * GP + i] = (bf16_t)(w.y >> 16);
                VT[(v0 + 4) * GP + i] = (bf16_t)(w.z & 0xffffu); VT[(v0 + 5) * GP + i] = (bf16_t)(w.z >> 16); VT[(v0 + 6) * GP + i] = (bf16_t)(w.w & 0xffffu); VT[(v0 + 7) * GP + i] = (bf16_t)(w.w >> 16); }
        }
        float gt[4][4];
#pragma unroll
        for (int g = 0; g < 4; ++g)
#pragma unroll
            for (int vt = 0; vt < 4; ++vt) gt[g][vt] = bflo((unsigned)P[(size_t)(row0 + it * 16 + fq * 4 + g) * INWP + C_GG + h * 128 + (vh * 4 + vt) * 16 + fr]);
        __syncthreads();
        f32x4 acc[4];
#pragma unroll
        for (int vt = 0; vt < 4; ++vt) acc[vt] = (f32x4){0.f, 0.f, 0.f, 0.f};
#pragma unroll
        for (int dir = 0; dir < 2; ++dir) {
            const LAS bf16_t* QE = dir ? QEb : QEf; const LAS bf16_t* KE = dir ? KEb : KEf;
            bf16x8 qa[2], sbf[2][4];
            const bf16_t* Sg = SST + ((size_t)item * 2 + dir) * 8192;
#pragma unroll
            for (int ks = 0; ks < 2; ++ks)
#pragma unroll
                for (int vt = 0; vt < 4; ++vt) sbf[ks][vt] = *(const bf16x8*)(Sg + ((vh * 4 + vt) * 16 + fr) * 64 + ks * 32 + fq * 8);
#pragma unroll
            for (int ks = 0; ks < 2; ++ks) qa[ks] = *(const LAS bf16x8*)(QE + (it * 16 + fr) * GP + ks * 32 + fq * 8);
#pragma unroll
            for (int jt = 0; jt < 4; ++jt) { f32x4 a = (f32x4){0.f, 0.f, 0.f, 0.f};
#pragma unroll
                for (int ks = 0; ks < 2; ++ks) { const bf16x8 kb = *(const LAS bf16x8*)(KE + (jt * 16 + fr) * GP + ks * 32 + fq * 8); a = __builtin_amdgcn_mfma_f32_16x16x32_bf16(qa[ks], kb, a, 0, 0, 0); }
#pragma unroll
                for (int g = 0; g < 4; ++g) { const int ii = it * 16 + fq * 4 + g, jj = jt * 16 + fr; const bool keep = dir ? (jj >= ii) : (jj <= ii);
                    ATT[(fq * 4 + g) * GP + jt * 16 + fr] = (bf16_t)f2bf(keep ? a[g] : 0.f); } }
            LDS_FENCE();
#pragma unroll
            for (int ks = 0; ks < 2; ++ks) { const bf16x8 aa = *(const LAS bf16x8*)(ATT + fr * GP + ks * 32 + fq * 8);
#pragma unroll
                for (int vt = 0; vt < 4; ++vt) { const int v = (vh * 4 + vt) * 16 + fr;
                    const bf16x8 vb = *(const LAS bf16x8*)(VT + v * GP + ks * 32 + fq * 8);
                    acc[vt] = __builtin_amdgcn_mfma_f32_16x16x32_bf16(aa, vb, acc[vt], 0, 0, 0);
                    acc[vt] = __builtin_amdgcn_mfma_f32_16x16x32_bf16(qa[ks], sbf[ks][vt], acc[vt], 0, 0, 0); } }
            LDS_FENCE();
        }
        float ss[4];
#pragma unroll
        for (int g = 0; g < 4; ++g) { float t = 0.f;
#pragma unroll
            for (int vt = 0; vt < 4; ++vt) t += acc[vt][g] * acc[vt][g];
            t += __shfl_xor(t, 1); t += __shfl_xor(t, 2); t += __shfl_xor(t, 4); t += __shfl_xor(t, 8); ss[g] = t; }
        if (fr == 0) {
#pragma unroll
            for (int g = 0; g < 4; ++g) RS[(it * 16 + fq * 4 + g) * 2 + vh] = ss[g]; }
        __syncthreads();
#pragma unroll
        for (int g = 0; g < 4; ++g) { const int i = it * 16 + fq * 4 + g; const float tot = RS[i * 2] + RS[i * 2 + 1];
            const float rs = 1.0f / sqrtf(tot * (1.0f / 128.0f) + LN_EPS); const size_t r = (size_t)(row0 + i);
#pragma unroll
            for (int vt = 0; vt < 4; ++vt) { const int v = (vh * 4 + vt) * 16 + fr;
                MIX[r * DM + 512 + h * 128 + v] = (bf16_t)f2bf(acc[vt][g] * rs * nw[v] * silu_f(gt[g][vt])); } }
        __syncthreads();
    }
}

__device__ __forceinline__ void ln_row(f32x4 (&v)[8], const float* lg, const float* lb, int lane) {
    float s = 0.f;
#pragma unroll
    for (int j = 0; j < 8; ++j) s += (v[j].x + v[j].y) + (v[j].z + v[j].w);
    const float mean = wave_sum(s) * (1.0f / DM);
    float s2 = 0.f;
#pragma unroll
    for (int j = 0; j < 8; ++j) { v[j] = v[j] - mean; s2 += (v[j].x * v[j].x + v[j].y * v[j].y) + (v[j].z * v[j].z + v[j].w * v[j].w); }
    const float rstd = 1.0f / sqrtf(wave_sum(s2) * (1.0f / DM) + LN_EPS);
#pragma unroll
    for (int j = 0; j < 8; ++j) { const int c = lane * 4 + 256 * j; const f32x4 g = *(const f32x4*)(lg + c), b = *(const f32x4*)(lb + c); v[j] = v[j] * rstd * g + b; }
}

__device__ __forceinline__ void phase_ln1(const Params& p, int l, LAS unsigned char* lds, int tid, int lane, int wave, int bid, int G) {
    const int gw = bid * NWAVES + wave, NGW = G * NWAVES;
    const float* MOD = (const float*)(p.ws + WS_MOD); const bf16_t* Y = (const bf16_t*)(p.ws + WS_Y); const float* YP = (const float*)(p.ws + WS_YPART);
    bf16_t* XM = (bf16_t*)(p.ws + WS_XM); bf16_t* HB = (bf16_t*)(p.ws + WS_HB);
    LAS float* VEC = (LAS float*)lds;
    for (int i = tid; i < 11 * DM / 4; i += NTHREADS) { const int vi = i / (DM / 4), c = (i % (DM / 4)) * 4;
        const float* src = vi < 9 ? MOD + (size_t)(l * 3 + (vi % 3)) * 6 * DM + (2 + vi / 3) * DM + c : (vi == 9 ? p.in[I_LNG] : p.in[I_LNB]) + (size_t)(l * 2 + 0) * DM + c;
        *(LAS f32x4*)(VEC + vi * DM + c) = *(const f32x4*)src; }
    __syncthreads();
    f32x4 xn[8]; u32x2 yn[8];
#define LN1_LOAD(rr) do { if (l == 0) { const float* xr_ = xsrc(p, 0, (rr)); _Pragma("unroll") for (int j = 0; j < 8; ++j) xn[j] = *(const f32x4*)(xr_ + lane * 4 + 256 * j); } \
        else { const bf16_t* xb_ = (const bf16_t*)(p.ws + WS_XL) + (size_t)(rr) * DM; _Pragma("unroll") for (int j = 0; j < 8; ++j) { const u32x2 w_ = *(const u32x2*)(xb_ + lane * 4 + 256 * j); xn[j] = (f32x4){bflo(w_.x), bfhi(w_.x), bflo(w_.y), bfhi(w_.y)}; } } \
        if ((rr) < TL) { _Pragma("unroll") for (int j = 0; j < 8; ++j) yn[j] = *(const u32x2*)(Y + (size_t)(rr) * DM + lane * 4 + 256 * j); } } while (0)
    if (row_first(wave, bid, G) >= 0) LN1_LOAD(row_first(wave, bid, G));
    for (int r = row_first(wave, bid, G); r >= 0; r = row_next(r, wave, bid, G, TA)) {
        const int st = row_stream(r);
        f32x4 v[8], yy[8];
#pragma unroll
        for (int j = 0; j < 8; ++j) v[j] = xn[j];
        if (r < TL) {
#pragma unroll
            for (int j = 0; j < 8; ++j) yy[j] = (f32x4){bflo(yn[j].x), bfhi(yn[j].x), bflo(yn[j].y), bfhi(yn[j].y)};
        } else {
#pragma unroll
            for (int j = 0; j < 8; j += 2) { f32x4 pp[2][8];
#pragma unroll
                for (int jj = 0; jj < 2; ++jj)
#pragma unroll
                    for (int ks = 0; ks < 8; ++ks) pp[jj][ks] = *(const f32x4*)(YP + ((size_t)ks * 512 + (r - TL)) * DM + lane * 4 + 256 * (j + jj));
#pragma unroll
                for (int jj = 0; jj < 2; ++jj) yy[j + jj] = ((pp[jj][0] + pp[jj][1]) + (pp[jj][2] + pp[jj][3])) + ((pp[jj][4] + pp[jj][5]) + (pp[jj][6] + pp[jj][7])); }
        }
        { const int rn = row_next(r, wave, bid, G, TA); if (rn >= 0) LN1_LOAD(rn); }
#pragma unroll
        for (int j = 0; j < 8; ++j) { const f32x4 g = *(const LAS f32x4*)(VEC + st * DM + lane * 4 + 256 * j); v[j] = v[j] * DN_ALPHA + g * yy[j]; }
        float s = 0.f;
#pragma unroll
        for (int j = 0; j < 8; ++j) s += (v[j].x + v[j].y) + (v[j].z + v[j].w);
        const float mean = wave_sum(s) * (1.0f / DM);
        float s2 = 0.f;
#pragma unroll
        for (int j = 0; j < 8; ++j) { v[j] = v[j] - mean; s2 += (v[j].x * v[j].x + v[j].y * v[j].y) + (v[j].z * v[j].z + v[j].w * v[j].w); }
        const float rstd = 1.0f / sqrtf(wave_sum(s2) * (1.0f / DM) + LN_EPS);
#pragma unroll
        for (int j = 0; j < 8; ++j) { const int c = lane * 4 + 256 * j;
            const f32x4 g = *(const LAS f32x4*)(VEC + 9 * DM + c), b = *(const LAS f32x4*)(VEC + 10 * DM + c), sh = *(const LAS f32x4*)(VEC + (3 + st) * DM + c), sc = *(const LAS f32x4*)(VEC + (6 + st) * DM + c);
            const f32x4 o = v[j] * rstd * g + b;
            { u32x2 xw; xw.x = pk2(o.x, o.y); xw.y = pk2(o.z, o.w); *(u32x2*)(XM + (size_t)r * DM + c) = xw; }
            u32x2 w; w.x = pk2(o.x * (1.f + sc.x) + sh.x, o.y * (1.f + sc.y) + sh.y); w.y = pk2(o.z * (1.f + sc.z) + sh.z, o.w * (1.f + sc.w) + sh.w);
            *(u32x2*)(HB + (size_t)r * DM + c) = w; }
    }
#undef LN1_LOAD
}

constexpr int SKP = 136;
__device__ __forceinline__ unsigned f2key(float f) { const unsigned u = __builtin_bit_cast(unsigned, f); return u ^ ((u >> 31) ? 0xFFFFFFFFu : 0x80000000u); }
__device__ __forceinline__ float key2f(unsigned k) { const unsigned u = (k >> 31) ? (k ^ 0x80000000u) : ~k; return __builtin_bit_cast(float, u); }
__device__ __forceinline__ unsigned row16_max_u32(unsigned k) {
    unsigned o;
    o = (unsigned)__builtin_amdgcn_update_dpp(0, (int)k, 0xB1, 0xF, 0xF, false); k = k > o ? k : o;
    o = (unsigned)__builtin_amdgcn_update_dpp(0, (int)k, 0x4E, 0xF, 0xF, false); k = k > o ? k : o;
    o = (unsigned)__builtin_amdgcn_update_dpp(0, (int)k, 0x141, 0xF, 0xF, false); k = k > o ? k : o;
    o = (unsigned)__builtin_amdgcn_update_dpp(0, (int)k, 0x140, 0xF, 0xF, false); k = k > o ? k : o;
    return k;
}
__device__ __forceinline__ void peer_retrieve(const Params& p, int l, LAS unsigned char* lds, int tid, int lane, int wave, int bid, int G, int ntok) {
    LAS bf16_t* SK = (LAS bf16_t*)lds;
    const bf16_t* SUBB = (const bf16_t*)(p.ws + WS_SUBB) + (size_t)l * 2 * 128 * 128;
#pragma unroll 1
    for (int j = 0; j < 8; ++j) { const int vv = tid + NTHREADS * j, row = vv >> 4, c = vv & 15; *(LAS u32x4*)(SK + row * SKP + c * 8) = *(const u32x4*)(SUBB + row * 128 + c * 8); }
    __syncthreads();
    const bf16_t* QP = (const bf16_t*)(p.ws + WS_QP); const float* QPP = (const float*)(p.ws + WS_QPART);
    int* EIDX = (int*)(p.ws + WS_EIDX); float* EGATE = (float*)(p.ws + WS_EGATE);
    const int gw = bid * NWAVES + wave, NGW = G * NWAVES, fr = lane & 15, fq = lane >> 4, gbase = lane & 48;
    const int nitems = (ntok / 16) * 8;
    const int nmain = nitems / NGW, nfull = nmain * NGW, nextra = (wave == 0 && nfull + bid < nitems) ? (nitems - nfull - bid + G - 1) / G : 0;
    for (int ri = 0; ri < nmain + nextra; ++ri) {
        const int item = ri < nmain ? gw + NGW * ri : nfull + bid + (ri - nmain) * G;
        const int tile = item >> 3, h = item & 7;
        unsigned tkp[2][4];
        bf16x8 afr[2][4];
        if (tile * 16 < TL) {
#pragma unroll
            for (int pp = 0; pp < 2; ++pp)
#pragma unroll
                for (int ks = 0; ks < 4; ++ks) afr[pp][ks] = *(const bf16x8*)(QP + (size_t)(tile * 16 + fr) * DM + h * 256 + pp * 128 + ks * 32 + fq * 8);
        } else {
#pragma unroll
            for (int pp = 0; pp < 2; ++pp)
#pragma unroll
                for (int ks = 0; ks < 4; ++ks) { const float* qp = QPP + (size_t)(tile * 16 - TL + fr) * DM + h * 256 + pp * 128 + ks * 32 + fq * 8;
                    f32x4 pa[8], pb[8];
#pragma unroll
                    for (int sl = 0; sl < 8; ++sl) { pa[sl] = *(const f32x4*)(qp + (size_t)sl * 512 * DM); pb[sl] = *(const f32x4*)(qp + (size_t)sl * 512 * DM + 4); }
                    const f32x4 s0 = ((pa[0] + pa[1]) + (pa[2] + pa[3])) + ((pa[4] + pa[5]) + (pa[6] + pa[7])), s1 = ((pb[0] + pb[1]) + (pb[2] + pb[3])) + ((pb[4] + pb[5]) + (pb[6] + pb[7]));
                    u32x4 w; w.x = pk2(s0.x, s0.y); w.y = pk2(s0.z, s0.w); w.z = pk2(s1.x, s1.y); w.w = pk2(s1.z, s1.w); afr[pp][ks] = __builtin_bit_cast(bf16x8, w); }
        }
#pragma unroll
        for (int pp = 0; pp < 2; ++pp) {
            asm volatile("" ::: "memory"); __builtin_amdgcn_sched_barrier(0);
            f32x4 acc[8];
#pragma unroll
            for (int kt = 0; kt < 8; ++kt) acc[kt] = (f32x4){0.f, 0.f, 0.f, 0.f};
#pragma unroll
            for (int ks = 0; ks < 4; ++ks) { const bf16x8 a = afr[pp][ks];
#pragma unroll
                for (int kt = 0; kt < 8; ++kt) { const bf16x8 bb = *(const LAS bf16x8*)(SK + (pp * 128 + kt * 16 + fr) * SKP + ks * 32 + fq * 8); acc[kt] = __builtin_amdgcn_mfma_f32_16x16x32_bf16(a, bb, acc[kt], 0, 0, 0); } }
            unsigned kv[4][8];
#pragma unroll
            for (int g = 0; g < 4; ++g)
#pragma unroll
                for (int kt = 0; kt < 8; ++kt) kv[g][kt] = (f2key(acc[kt][g]) & ~127u) | (unsigned)(127 - (kt * 16 + fr));
#define CSWAP(a_, b_) do { const unsigned hi_ = a_ > b_ ? a_ : b_, lo_ = a_ > b_ ? b_ : a_; a_ = hi_; b_ = lo_; } while (0)
#pragma unroll
            for (int g = 0; g < 4; ++g) {
                CSWAP(kv[g][0], kv[g][1]); CSWAP(kv[g][2], kv[g][3]); CSWAP(kv[g][4], kv[g][5]); CSWAP(kv[g][6], kv[g][7]);
                CSWAP(kv[g][0], kv[g][2]); CSWAP(kv[g][1], kv[g][3]); CSWAP(kv[g][4], kv[g][6]); CSWAP(kv[g][5], kv[g][7]);
                CSWAP(kv[g][1], kv[g][2]); CSWAP(kv[g][5], kv[g][6]);
                CSWAP(kv[g][0], kv[g][4]); CSWAP(kv[g][1], kv[g][5]); CSWAP(kv[g][2], kv[g][6]); CSWAP(kv[g][3], kv[g][7]);
                CSWAP(kv[g][2], kv[g][4]); CSWAP(kv[g][3], kv[g][5]);
                CSWAP(kv[g][1], kv[g][2]); CSWAP(kv[g][3], kv[g][4]); CSWAP(kv[g][5], kv[g][6]);
            }
#undef CSWAP
            unsigned tk[4] = {0u, 0u, 0u, 0u};
#pragma unroll 1
            for (int it = 0; it < 16; ++it) {
#pragma unroll
                for (int g = 0; g < 4; ++g) {
                    const unsigned m = row16_max_u32(kv[g][0]);
                    tk[g] = fr == it ? m : tk[g];
                    const bool won = kv[g][0] == m;
#pragma unroll
                    for (int kt = 0; kt < 7; ++kt) kv[g][kt] = won ? kv[g][kt + 1] : kv[g][kt];
                    kv[g][7] = won ? 0u : kv[g][7];
                }
            }
#pragma unroll
            for (int g = 0; g < 4; ++g) tkp[pp][g] = tk[g];
        }
        float av[4], bv[4]; int ptr[4]; unsigned best[4];
#pragma unroll
        for (int g = 0; g < 4; ++g) { av[g] = key2f(tkp[0][g] & ~127u); bv[g] = key2f(tkp[1][g] & ~127u); ptr[g] = 0; best[g] = 0u; }
#pragma unroll 1
        for (int it = 0; it < 16; ++it) {
#pragma unroll
            for (int g = 0; g < 4; ++g) {
                const float bj = __shfl(bv[g], gbase + (ptr[g] & 15));
                const unsigned mine = ptr[g] < 16 ? ((f2key(av[g] + bj) & ~255u) | (unsigned)(255 - (fr * 16 + (ptr[g] & 15)))) : 0u;
                const unsigned m = row16_max_u32(mine);
                best[g] = fr == it ? m : best[g];
                ptr[g] += (m == mine) ? 1 : 0;
            }
        }
#pragma unroll
        for (int g = 0; g < 4; ++g) {
            const int bc = 255 - (int)(best[g] & 255u);
            const float bval = key2f(best[g] & ~255u);
            const int k1 = 127 - (int)(tkp[0][g] & 127u), k2 = 127 - (int)(tkp[1][g] & 127u);
            const int i1 = __shfl(k1, gbase + (bc >> 4)), i2 = __shfl(k2, gbase + (bc & 15));
            const float mx = __shfl(bval, gbase);
            const float ex = __expf(bval - mx);
            float sm = ex;
#pragma unroll
            for (int o = 1; o < 16; o <<= 1) sm += __shfl_xor(sm, o);
            const size_t tok = (size_t)tile * 16 + fq * 4 + g;
            EIDX[tok * 128 + h * 16 + fr] = i1 * 128 + i2; EGATE[tok * 128 + h * 16 + fr] = ex / sm;
        }
    }
}

template <int CTRL> __device__ __forceinline__ float dppf(float x) { return __builtin_bit_cast(float, __builtin_amdgcn_mov_dpp(__builtin_bit_cast(int, x), CTRL, 0xf, 0xf, true)); }
__device__ __forceinline__ float rs_group8(float (&d)[8], bool b8) {
    asm volatile("s_nop 1\n\tv_permlane32_swap_b32 %0, %4\n\tv_permlane32_swap_b32 %1, %5\n\tv_permlane32_swap_b32 %2, %6\n\tv_permlane32_swap_b32 %3, %7"
                 : "+v"(d[0]), "+v"(d[1]), "+v"(d[2]), "+v"(d[3]), "+v"(d[4]), "+v"(d[5]), "+v"(d[6]), "+v"(d[7]));
    float s0 = d[0] + d[4], s1 = d[1] + d[5], s2 = d[2] + d[6], s3 = d[3] + d[7];
    asm volatile("s_nop 1\n\tv_permlane16_swap_b32 %0, %2\n\tv_permlane16_swap_b32 %1, %3" : "+v"(s0), "+v"(s1), "+v"(s2), "+v"(s3));
    const float t0 = s0 + s2, t1 = s1 + s3;
    const float m = b8 ? t1 : t0, o = b8 ? t0 : t1;
    return m + dppf<0x128>(o);
}
template <int CTRL> __device__ __forceinline__ float rs_merge(float a, float b, bool bit) { const float m = bit ? b : a, o = bit ? a : b; return m + dppf<CTRL>(o); }
constexpr int PG = 8;
__device__ __forceinline__ void phase_peer(const Params& p, int l, LAS unsigned char* lds, int tid, int lane, int wave, int bid, int G) {
    const int gw = bid * NWAVES + wave, NGW = G * NWAVES;
    const float* MOD = (const float*)(p.ws + WS_MOD);
    bf16_t* XL = (bf16_t*)(p.ws + WS_XL); bf16_t* HB = (bf16_t*)(p.ws + WS_HB);
    const float* lg = p.in[I_LNG] + (size_t)(l * 2 + 1) * DM; const float* lb = p.in[I_LNB] + (size_t)(l * 2 + 1) * DM;
    const unsigned char* UB = p.ws + WS_UB + (size_t)l * NEXP * ROWB_U; const unsigned char* VB = p.ws + WS_VB + (size_t)l * NEXP * ROWB_V;
    const float* USC = (const float*)(p.ws + WS_USC) + (size_t)l * NEXP; (void)USC; const float* VSC = (const float*)(p.ws + WS_VSC) + (size_t)l * NEXP; (void)VSC;
    const int* EIDX = (const int*)(p.ws + WS_EIDX); const float* EGATE = (const float*)(p.ws + WS_EGATE);
    const bool last = (l == DEPTH - 1);
    const int nrows = last ? TL : TA;
    constexpr int HLW = 64 * 33 * 4 + 128;
    LAS float* HL = (LAS float*)(lds + wave * HLW) + lane * 33;
    LAS int* PI = (LAS int*)((LAS float*)(lds + wave * HLW) + 64 * 33);
    LAS float* VEC = (LAS float*)(lds + 8 * HLW);
    for (int i = tid; i < 11 * DM / 4; i += NTHREADS) { const int vi = i / (DM / 4), c = (i % (DM / 4)) * 4; const int ln = last ? l : l + 1;
        const float* src = vi < 3 ? MOD + (size_t)(l * 3 + vi) * 6 * DM + 5 * DM + c : (vi < 9 ? MOD + (size_t)(ln * 3 + (vi % 3)) * 6 * DM + (vi / 3 - 1) * DM + c : (vi == 9 ? lg : lb) + c);
        *(LAS f32x4*)(VEC + vi * DM + c) = *(const f32x4*)src; }
    __syncthreads();
#if !TBL_U_FP4
    {
        float one = 1.0f; asm volatile("" : "+v"(one));
        f32x16 t0, t1;
#pragma unroll
        for (int c = 0; c < 32; ++c) { const float v = one * (c < 8 ? (float)c * 0.125f : (1.0f + (float)(c & 7) * 0.125f) * (float)(1 << ((c >> 3) - 1))); if (c < 16) t0[c] = v; else t1[c - 16] = v; }
        const u32x6 pw = pack_fp6_2x16(t0, t1);
        const f32x32 un = unpack_fp6_32(pw);
#pragma unroll
        for (int j = 0; j < 32; ++j) { const float y = un[j]; int c;
            if (y < 1.0f) c = (int)(y * 8.0f + 0.5f); else { const int e = y < 2.0f ? 0 : (y < 4.0f ? 1 : 2); c = 8 * (e + 1) + (int)((y / (float)(1 << e) - 1.0f) * 8.0f + 0.5f); }
            if (lane == 0) PI[j] = c & 31; }
        LDS_FENCE();
#if defined(DIAG_PI)
        { unsigned mk = 0u;
#pragma unroll
          for (int j = 0; j < 32; ++j) mk |= 1u << PI[j];
          if (mk != 0xFFFFFFFFu && l == 0 && gw == 0 && lane == 0) ((float*)(p.ws + WS_CTL + 131072))[0] = 1.0f; }
#endif
    }
#endif
    const unsigned ulane = (unsigned)lane & 63u, loff16 = ulane * 16u; (void)ulane; (void)loff16;
    const bool lb8 = (lane & 8) != 0, lb4 = (lane & 4) != 0, lb2 = (lane & 2) != 0, lb1 = (lane & 1) != 0; (void)lb8; (void)lb4; (void)lb2; (void)lb1;
    const int lsrc = ((lane & 6) << 3) | ((lane & 1) << 3) | (((lane >> 3) & 1) << 2) | (((lane >> 4) & 1) << 1) | ((lane >> 5) & 1); (void)lsrc;
    for (int r = row_first(wave, bid, G); r >= 0; r = row_next(r, wave, bid, G, nrows)) {
        const float* mod = MOD + (size_t)(l * 3 + row_stream(r)) * 6 * DM;
        f32x2v hn[16];
#pragma unroll
        for (int c = 0; c < 4; ++c) { float f[8]; unpack8(*(const u32x4*)(HB + (size_t)r * DM + lane * 32 + c * 8), f);
#pragma unroll
            for (int e = 0; e < 4; ++e) hn[c * 4 + e] = (f32x2v){f[2 * e], f[2 * e + 1]}; }
#if !TBL_U_FP4
#pragma unroll
        for (int j = 0; j < 16; ++j) { HL[2 * j] = hn[j].x; HL[2 * j + 1] = hn[j].y; }
        LDS_FENCE();
        f32x2v hf[16];
#pragma unroll
        for (int j = 0; j < 16; ++j) hf[j] = (f32x2v){HL[PI[2 * j]], HL[PI[2 * j + 1]]};
        LDS_FENCE();
#endif
#if TBL_U_I4
        int hlo[4], hhi[4]; unsigned basel;
        { float am = 0.f;
#pragma unroll
          for (int j = 0; j < 16; ++j) am = fmaxf(am, fmaxf(fabsf(hn[j].x), fabsf(hn[j].y)));
          const unsigned ab = __builtin_bit_cast(unsigned, am * (1.0f / 119.0f)); unsigned eb = (ab >> 23) + ((ab & 0x007fffffu) ? 1u : 0u); eb = eb < 1u ? 1u : (eb > 253u ? 253u : eb);
          const float inv = __builtin_bit_cast(float, (254u - eb) << 23);
          basel = U_ROWSCALE ? (eb << 23) : (I4_BASE + ((eb - 127u) << 23));
#pragma unroll
          for (int d = 0; d < 4; ++d) { unsigned tl = 0u, th = 0u;
#pragma unroll
              for (int e = 0; e < 8; ++e) { const f32x2v pr = hn[d * 4 + (e >> 1)]; const float xv = (e & 1) ? pr.y : pr.x;
                  const unsigned qb = __builtin_bit_cast(unsigned, xv * inv + 12582912.0f);
                  tl |= (qb & 15u) << (4 * e); th |= (((qb + 8u) >> 4) & 15u) << (4 * e); }
              hlo[d] = (int)tl; hhi[d] = (int)th; } }
#endif
        const int e0 = EIDX[(size_t)r * 128 + lane], e1 = EIDX[(size_t)r * 128 + 64 + lane];
        const float g0 = EGATE[(size_t)r * 128 + lane], g1 = EGATE[(size_t)r * 128 + 64 + lane];
#if !TBL_U_FP4 || U_ROWSCALE
        const float su0 = USC[e0], su1 = USC[e1];
#else
        const float su0 = 1.0f, su1 = 1.0f;
#endif
        float wgt[2] = {0.f, 0.f};
#define P4_LOAD(dq, ds, TB, eh, j0) do { unsigned lo_ = loff16, ul_ = ulane; asm volatile("" : "+v"(lo_), "+v"(ul_));    \
        _Pragma("unroll") for (int c = 0; c < PG; ++c) { const int e_ = __builtin_amdgcn_readlane(eh, (j0) + c); \
            const unsigned char* rp_ = (TB) + (size_t)e_ * ROWB4; dq[c] = *(const u32x4*)(rp_ + lo_); ds[c] = rp_[1024u + ul_]; } } while (0)
#if V_ROWSCALE
#define P4_LDV P4_LOADU
#else
#define P4_LDV P4_LOAD
#endif
#if U_ROWSCALE
#define P4_LDU P4_LOADU
#else
#define P4_LDU P4_LOAD
#endif
#define P4_LOADU(dq, ds, TB, eh, j0) do { const __amdgpu_buffer_rsrc_t rs_ = __builtin_amdgcn_make_buffer_rsrc((void*)(TB), 0, NEXP * 1024, 0x00020000); \
        _Pragma("unroll") for (int c = 0; c < PG; ++c) { const int e_ = __builtin_amdgcn_readlane(eh, (j0) + c); \
            dq[c] = __builtin_bit_cast(u32x4, __builtin_amdgcn_raw_buffer_load_b128(rs_, (int)loff16, (int)(((unsigned)e_ & 0x3fffu) << 10), 0)); ds[c] = e_; } } while (0)
#define P4_CVT(dq, c, d, b, sc) __builtin_amdgcn_cvt_scalef32_pk_f32_fp4(dq[c][d], sc, b)
#if TBL_U_I4
#define P4_DOT(dq, ds, rr) do { float d_[PG]; _Pragma("unroll") for (int c = 0; c < PG; ++c) { int t_ = 0;        \
            _Pragma("unroll") for (int d = 0; d < 4; ++d) t_ = __builtin_amdgcn_sdot8((int)dq[c][d], hhi[d], t_, false); \
            t_ <<= 4; \
            _Pragma("unroll") for (int d = 0; d < 4; ++d) t_ = __builtin_amdgcn_sdot8((int)dq[c][d], hlo[d], t_, false); \
            d_[c] = (float)t_ * (U_ROWSCALE ? __builtin_bit_cast(float, basel) : __builtin_bit_cast(float, ((unsigned)ds[c] << 20) + basel)); } \
        rr = rs_group8(d_, lb8); } while (0)
#else
#define P4_DOT(dq, ds, rr) do { float d_[PG]; _Pragma("unroll") for (int c = 0; c < PG; ++c) { const float sc_ = __builtin_bit_cast(float, (unsigned)ds[c] << 23); f32x2v a0_ = (f32x2v){0.f, 0.f}, a1_ = (f32x2v){0.f, 0.f}; \
            _Pragma("unroll") for (int d = 0; d < 4; ++d) { a0_ += P4_CVT(dq, c, d, 0, sc_) * hn[d * 4 + 0]; a1_ += P4_CVT(dq, c, d, 1, sc_) * hn[d * 4 + 1]; a0_ += P4_CVT(dq, c, d, 2, sc_) * hn[d * 4 + 2]; a1_ += P4_CVT(dq, c, d, 3, sc_) * hn[d * 4 + 3]; } \
            d_[c] = (a0_.x + a0_.y) + (a1_.x + a1_.y); asm volatile("" : "+v"(d_[c])); } \
        rr = rs_group8(d_, lb8); } while (0)
#endif
#define P4_AXPY(dq, ds, wh, j0) do { _Pragma("unroll") for (int c = 0; c < PG; ++c) { const float wj_ = V_ROWSCALE ? __builtin_bit_cast(float, (unsigned)ds[c] & 0xffff0000u) : __builtin_bit_cast(float, __builtin_amdgcn_readlane(wh, (j0) + c)); const f32x2v w2_ = (f32x2v){wj_, wj_}; \
            const float sc_ = V_ROWSCALE ? 1.0f : __builtin_bit_cast(float, (unsigned)ds[c] << 23); \
            _Pragma("unroll") for (int d = 0; d < 4; ++d) { yv[d * 4 + 0] += P4_CVT(dq, c, d, 0, sc_) * w2_; yv[d * 4 + 1] += P4_CVT(dq, c, d, 1, sc_) * w2_; yv[d * 4 + 2] += P4_CVT(dq, c, d, 2, sc_) * w2_; yv[d * 4 + 3] += P4_CVT(dq, c, d, 3, sc_) * w2_; } \
            asm volatile("" : "+v"(yv[0]), "+v"(yv[1]), "+v"(yv[2]), "+v"(yv[3]), "+v"(yv[4]), "+v"(yv[5]), "+v"(yv[6]), "+v"(yv[7]), "+v"(yv[8]), "+v"(yv[9]), "+v"(yv[10]), "+v"(yv[11]), "+v"(yv[12]), "+v"(yv[13]), "+v"(yv[14]), "+v"(yv[15]));   } } while (0)
#if !TBL_U_FP4
#define PEER_LOAD(dq, dd, TB, eh, j0) do { _Pragma("unroll") for (int c = 0; c < PG; ++c) { const int e_ = __builtin_amdgcn_readlane(eh, (j0) + c); \
            const unsigned char* rp_ = (TB) + (size_t)e_ * ROWB; dq[c] = *(const u32x4*)(rp_ + lane * 16); dd[c] = *(const u32x2*)(rp_ + 1024 + lane * 8); } } while (0)
#define PEER_UNPACK(dq, dd, c) unpack_fp6_32((u32x6){dq[c].x, dq[c].y, dq[c].z, dq[c].w, dd[c].x, dd[c].y})
#define PEER_DOT(dq, dd, j0) do { float d_[PG]; _Pragma("unroll") for (int c = 0; c < PG; ++c) { const f32x32 u_ = PEER_UNPACK(dq, dd, c); f32x2v a0_ = (f32x2v){0.f, 0.f}, a1_ = (f32x2v){0.f, 0.f}; \
            _Pragma("unroll") for (int t = 0; t < 8; ++t) { a0_ += (f32x2v){u_[4 * t], u_[4 * t + 1]} * hf[2 * t]; a1_ += (f32x2v){u_[4 * t + 2], u_[4 * t + 3]} * hf[2 * t + 1]; } \
            d_[c] = (a0_.x + a0_.y) + (a1_.x + a1_.y); __builtin_amdgcn_sched_barrier(0); } \
        _Pragma("unroll") for (int o = 1; o < 64; o <<= 1) { _Pragma("unroll") for (int c = 0; c < PG; ++c) d_[c] += __shfl_xor(d_[c], o); } \
        _Pragma("unroll") for (int c = 0; c < PG; ++c) wacc = (lane == (j0) + c) ? d_[c] : wacc; } while (0)
#endif
#pragma unroll
        for (int hh = 0; hh < 2; ++hh) {
            const int eh = hh ? e1 : e0; float wacc = 0.f;
#if TBL_U_FP4
            u32x4 qa[PG], qb[PG]; int sa[PG], sb[PG];
            P4_LDU(qa, sa, UB, eh, 0);
            float wq = 0.f, wp = 0.f;
#pragma unroll 1
            for (int j0 = 0; j0 < 64; j0 += 2 * PG) {
                float ra, rb;
                P4_LDU(qb, sb, UB, eh, j0 + PG);
                P4_DOT(qa, sa, ra);
                if (j0 + 2 * PG < 64) P4_LDU(qa, sa, UB, eh, j0 + 2 * PG);
                P4_DOT(qb, sb, rb);
                const float q = rs_merge<0x141>(ra, rb, lb4);
                if ((j0 & 16) == 0) wq = q;
                else { const float pm = rs_merge<0x4E>(wq, q, lb2);
                       if (j0 == 16) wp = pm; else wacc = rs_merge<0xB1>(wp, pm, lb1); }
            }
            wacc = __shfl(wacc, lsrc);
#else
            u32x4 qa[PG], qb[PG]; u32x2 da[PG], db[PG];
            PEER_LOAD(qa, da, UB, eh, 0);
#pragma unroll 1
            for (int j0 = 0; j0 < 64; j0 += 2 * PG) {
                PEER_LOAD(qb, db, UB, eh, j0 + PG);
                PEER_DOT(qa, da, j0);
                if (j0 + 2 * PG < 64) PEER_LOAD(qa, da, UB, eh, j0 + 2 * PG);
                PEER_DOT(qb, db, j0 + PG);
            }
#endif
            wgt[hh] = gelu_f(wacc * (hh ? su1 : su0)) * (hh ? g1 : g0) * (V_ROWSCALE ? VSC[eh] : 1.0f);
        }
        f32x2v yv[16];
#pragma unroll
        for (int i = 0; i < 16; ++i) yv[i] = (f32x2v){0.f, 0.f};
#pragma unroll
        for (int hh = 0; hh < 2; ++hh) {
            const int eh = V_ROWSCALE ? ((hh ? e1 : e0) | (int)((__builtin_bit_cast(unsigned, wgt[hh]) + 0x8000u) & 0xffff0000u)) : (hh ? e1 : e0); const int wh = __builtin_bit_cast(int, wgt[hh]); (void)wh;
            u32x4 qa[PG], qb[PG]; int sa[PG], sb[PG];
            P4_LDV(qa, sa, VB, eh, 0);
#pragma unroll 1
            for (int j0 = 0; j0 < 64; j0 += 2 * PG) {
                P4_LDV(qb, sb, VB, eh, j0 + PG);
                P4_AXPY(qa, sa, wh, j0);
                if (j0 + 2 * PG < 64) P4_LDV(qa, sa, VB, eh, j0 + 2 * PG);
                P4_AXPY(qb, sb, wh, j0 + PG);
            }
        }
#undef P4_LOAD
#undef P4_CVT
#undef P4_DOT
#undef P4_AXPY
#if !TBL_U_FP4
#undef PEER_LOAD
#undef PEER_UNPACK
#undef PEER_DOT
#endif
        const int st = row_stream(r);
        const bf16_t* xr = (const bf16_t*)(p.ws + WS_XM) + (size_t)r * DM + lane * 32;
        f32x4 xv[8];
#pragma unroll
        for (int t = 0; t < 4; ++t) { const u32x4 w = *(const u32x4*)(xr + t * 8); xv[2 * t] = (f32x4){bflo(w.x), bfhi(w.x), bflo(w.y), bfhi(w.y)}; xv[2 * t + 1] = (f32x4){bflo(w.z), bfhi(w.z), bflo(w.w), bfhi(w.w)}; }
        float s = 0.f;
#pragma unroll
        for (int t = 0; t < 8; ++t) { const f32x4 ga = *(const LAS f32x4*)(VEC + st * DM + lane * 32 + t * 4);
            f32x2v& ya = yv[t * 2]; f32x2v& yb = yv[t * 2 + 1];
            ya.x = xv[t].x * DN_ALPHA + ga.x * ya.x; ya.y = xv[t].y * DN_ALPHA + ga.y * ya.y; yb.x = xv[t].z * DN_ALPHA + ga.z * yb.x; yb.y = xv[t].w * DN_ALPHA + ga.w * yb.y;
            s += (ya.x + ya.y) + (yb.x + yb.y); }
        const float mean = wave_sum(s) * (1.0f / DM);
        float s2 = 0.f;
#pragma unroll
        for (int i = 0; i < 16; ++i) { yv[i] = yv[i] - mean; s2 += yv[i].x * yv[i].x + yv[i].y * yv[i].y; }
        const float rstd = 1.0f / sqrtf(wave_sum(s2) * (1.0f / DM) + LN_EPS);
        float* dst = p.out + (size_t)r * DM + lane * 32; bf16_t* dstb = XL + (size_t)r * DM + lane * 32;
#pragma unroll
        for (int t = 0; t < 8; t += 2) { const int c = t * 4;
            const f32x4 ga = *(const LAS f32x4*)(VEC + 9 * DM + lane * 32 + c), gb = *(const LAS f32x4*)(VEC + 9 * DM + lane * 32 + c + 4), ba = *(const LAS f32x4*)(VEC + 10 * DM + lane * 32 + c), bb = *(const LAS f32x4*)(VEC + 10 * DM + lane * 32 + c + 4);
            const f32x2v y0 = yv[t * 2], y1 = yv[t * 2 + 1], y2 = yv[t * 2 + 2], y3 = yv[t * 2 + 3];
            f32x4 o0, o1;
            o0.x = y0.x * rstd * ga.x + ba.x; o0.y = y0.y * rstd * ga.y + ba.y; o0.z = y1.x * rstd * ga.z + ba.z; o0.w = y1.y * rstd * ga.w + ba.w;
            o1.x = y2.x * rstd * gb.x + bb.x; o1.y = y2.y * rstd * gb.y + bb.y; o1.z = y3.x * rstd * gb.z + bb.z; o1.w = y3.y * rstd * gb.w + bb.w;
            if (last) { *(f32x4*)(dst + c) = o0; *(f32x4*)(dst + c + 4) = o1; }
            else { u32x4 xw; xw.x = pk2(o0.x, o0.y); xw.y = pk2(o0.z, o0.w); xw.z = pk2(o1.x, o1.y); xw.w = pk2(o1.z, o1.w); *(u32x4*)(dstb + c) = xw; }
            if (!last) {
                const f32x4 sa = *(const LAS f32x4*)(VEC + (3 + st) * DM + lane * 32 + c), sb = *(const LAS f32x4*)(VEC + (3 + st) * DM + lane * 32 + c + 4), ca = *(const LAS f32x4*)(VEC + (6 + st) * DM + lane * 32 + c), cb = *(const LAS f32x4*)(VEC + (6 + st) * DM + lane * 32 + c + 4);
                u32x4 o; o.x = pk2(o0.x * (1.f + ca.x) + sa.x, o0.y * (1.f + ca.y) + sa.y); o.y = pk2(o0.z * (1.f + ca.z) + sa.z, o0.w * (1.f + ca.w) + sa.w);
                o.z = pk2(o1.x * (1.f + cb.x) + sb.x, o1.y * (1.f + cb.y) + sb.y); o.w = pk2(o1.z * (1.f + cb.z) + sb.z, o1.w * (1.f + cb.w) + sb.w);
                *(u32x4*)(HB + (size_t)r * DM + lane * 32 + c) = o; }
        }
#if defined(DIAG_PI)
        if (last && r == 5 && lane == 0 && ((const float*)(p.ws + WS_CTL + 131072))[0] != 0.0f) p.out[(size_t)5 * DM] = __builtin_nanf("");
#endif
    }
}

__device__ __forceinline__ void gemm_rows_bf16(LAS unsigned char* lds, const bf16_t* A, const bf16_t* Bt, bf16_t* C, float* Cpart, bool with_ctx, int G, int bid) {
    { pg8::Gemm g{A, Bt, TL, DM, DM, DM}; pg8::StaticOrder S; S.init(TL, DM, G, bid); pg8::EpiBf16<0> E{C, DM, nullptr, 0, 0, 1.f};
      pg8::gemm_phase<pg8::EpiBf16<0>, pg8::StaticOrder, PG8_ALIGN, PG8_SP2>(lds, g, S, E); }
    if (with_ctx) { int ksl = 256; asm volatile("" : "+s"(ksl));
      pg8::Gemm g{A + (size_t)TL * DM, Bt, TC, DM, ksl, DM}; pg8::SplitKOrder S; S.init(G, bid); pg8::EpiF32Part E{Cpart};
      pg8::gemm_phase<pg8::EpiF32Part, pg8::SplitKOrder, PG8_ALIGN, PG8_SP2>(lds, g, S, E); }
}

constexpr int PH_PER_LAYER = 9, N_PHASES = 2 + DEPTH * PH_PER_LAYER;
__global__ void __launch_bounds__(NTHREADS, 2) fwd_kernel(Params p) {
    extern __shared__ __attribute__((aligned(16))) unsigned char lds_raw[];
    LAS unsigned char* lds = (LAS unsigned char*)lds_raw;
    const int tid = threadIdx.x, lane = tid & 63, wave = __builtin_amdgcn_readfirstlane(tid >> 6), bid = blockIdx.x, G = gridDim.x;
    volatile LAS unsigned* MISC = (volatile LAS unsigned*)(lds + MISC_OFF);
    if (tid < 32) MISC[tid] = 0u;
    __syncthreads();
    if (hipThreadIdx_x == 0) (void)xb_add(&((unsigned*)(p.ws + WS_CTL))[CW_BAR + XB_XCNT(xb_xcc_id())], 1u);
#define IN(k) true
#if defined(PROBE_MASK)
    volatile LAS unsigned long long* PT = (volatile LAS unsigned long long*)(lds + MISC_OFF + 96);
    if (tid == 0) PT[0] = __builtin_amdgcn_s_memrealtime();
#define SEAM(k) do { { XcdBarrier bar_; bar_.bar = (unsigned*)(((const __attribute__((address_space(4))) Params*)__builtin_amdgcn_kernarg_segment_ptr())->ws + WS_CTL) + CW_BAR; bar_.x = xb_xcc_id(); bar_.st = MISC + 8; xcd_barrier(bar_); } if (bid == 0) { const int kind_ = (k) < 2 ? (k) : 2 + ((k) - 2) % PH_PER_LAYER; \
        if (tid == 0) { const unsigned long long now_ = __builtin_amdgcn_s_memrealtime(); if ((PROBE_MASK >> kind_) & 1) { const unsigned long long d_ = (now_ - PT[0]) * PROBE_MULT; \
            while (__builtin_amdgcn_s_memrealtime() - now_ < d_) __builtin_amdgcn_s_sleep(8); } PT[0] = __builtin_amdgcn_s_memrealtime(); } __syncthreads(); } } while (0)
#elif defined(PROBE_DUP_BAR)
#define SEAM(k) do { XcdBarrier bar_; bar_.bar = (unsigned*)(((const __attribute__((address_space(4))) Params*)__builtin_amdgcn_kernarg_segment_ptr())->ws + WS_CTL) + CW_BAR; bar_.x = xb_xcc_id(); bar_.st = MISC + 8; xcd_barrier(bar_); xcd_barrier(bar_); } while (0)
#else
#define SEAM(k) do { XcdBarrier bar_; bar_.bar = (unsigned*)(((const __attribute__((address_space(4))) Params*)__builtin_amdgcn_kernarg_segment_ptr())->ws + WS_CTL) + CW_BAR; bar_.x = xb_xcc_id(); bar_.st = MISC + 8; xcd_barrier(bar_); } while (0)
#endif
    const int NGW = G * NWAVES;
#if defined(__HIP_DEVICE_COMPILE__)
#define KARGS_COPY const Params p_ = *kp_
#else
#define KARGS_COPY const Params p_ = p; (void)kp_
#endif
#define FRESH() int tid_ = threadIdx.x, bid_ = blockIdx.x; asm volatile("" : "+v"(tid_), "+s"(bid_)); const int lane_ = tid_ & 63, wave_ = __builtin_amdgcn_readfirstlane(tid_ >> 6); (void)lane_; (void)wave_; \
    const __attribute__((address_space(4))) Params* kp_ = (const __attribute__((address_space(4))) Params*)__builtin_amdgcn_kernarg_segment_ptr(); asm volatile("" : "+s"(kp_)); KARGS_COPY
    if (IN(0)) { FRESH(); phase_prologue(p_, lds, tid_, lane_, wave_, bid_, G); }
    SEAM(0);
    if (IN(1)) { FRESH(); phase_modulate0(p_, lane_, wave_, bid_, G); }
    SEAM(1);
    for (int l = 0; l < DEPTH; ++l) {
        const int b0 = 2 + l * PH_PER_LAYER;
        if (IN(b0 + 0)) { FRESH();
            pg8::Gemm g{(const bf16_t*)(p_.ws + WS_HB), (const bf16_t*)(p_.ws + WS_WIN) + (size_t)l * INWP * DM, TA, INWP, DM, DM}; pg8::StaticOrder S; S.init(TA, INWP, G, bid_);
            pg8::EpiBf16<0> E{(bf16_t*)(p_.ws + WS_P), INWP, nullptr, 0, 0, 1.f};
            pg8::gemm_phase<pg8::EpiBf16<0>, pg8::StaticOrder, PG8_ALIGN, PG8_SP2>(lds, g, S, E);
#if defined(PROBE_DUP_GEMM)
            __syncthreads(); pg8::gemm_phase<pg8::EpiBf16<0>, pg8::StaticOrder, PG8_ALIGN, PG8_SP2>(lds, g, S, E);
#endif
        }
        SEAM(b0 + 0);
        if (IN(b0 + 1)) { { FRESH(); gla_g1(p_, l, lds, tid_, lane_, wave_, bid_, G); } { FRESH(); phase_post_in(p_, l, lane_, wave_, bid_, G); } }
#if defined(PROBE_DUP_A)
        if (IN(b0 + 1)) { __syncthreads(); { FRESH(); gla_g1(p_, l, lds, tid_, lane_, wave_, bid_, G); } { FRESH(); phase_post_in(p_, l, lane_, wave_, bid_, G); } }
#endif
        SEAM(b0 + 1);
        if (IN(b0 + 2)) { { FRESH(); gla_g2(p_, tid_, bid_, G); } { FRESH(); phase_mixers(p_, l, lds, tid_, lane_, wave_, bid_, G); } }
#if defined(PROBE_DUP_B)
        if (IN(b0 + 2)) { __syncthreads(); { FRESH(); gla_g2(p_, tid_, bid_, G); } { FRESH(); phase_mixers(p_, l, lds, tid_, lane_, wave_, bid_, G, 1); } }
#endif
        SEAM(b0 + 2);
        if (IN(b0 + 3)) { FRESH(); gla_g3(p_, l, lds, tid_, lane_, wave_, bid_, G); }
#if defined(PROBE_DUP_C)
        if (IN(b0 + 3)) { __syncthreads(); FRESH(); gla_g3(p_, l, lds, tid_, lane_, wave_, bid_, G); }
#endif
        SEAM(b0 + 3);
        if (IN(b0 + 4)) { FRESH();
            gemm_rows_bf16(lds, (const bf16_t*)(p_.ws + WS_MIX), (const bf16_t*)(p_.ws + WS_WOUT) + (size_t)l * DM * DM, (bf16_t*)(p_.ws + WS_Y), (float*)(p_.ws + WS_YPART), l < DEPTH - 1, G, bid_);
#if defined(PROBE_DUP_GEMM)
            __syncthreads(); gemm_rows_bf16(lds, (const bf16_t*)(p_.ws + WS_MIX), (const bf16_t*)(p_.ws + WS_WOUT) + (size_t)l * DM * DM, (bf16_t*)(p_.ws + WS_Y), (float*)(p_.ws + WS_YPART), l < DEPTH - 1, G, bid_);
#endif
        }
        SEAM(b0 + 4);
        if (IN(b0 + 5)) { FRESH(); phase_ln1(p_, l, lds, tid_, lane_, wave_, bid_, G); }
#if defined(PROBE_DUP_E)
        if (IN(b0 + 5)) { __syncthreads(); FRESH(); phase_ln1(p_, l, lds, tid_, lane_, wave_, bid_, G); }
#endif
        SEAM(b0 + 5);
        if (IN(b0 + 6)) { FRESH();
            gemm_rows_bf16(lds, (const bf16_t*)(p_.ws + WS_HB), (const bf16_t*)(p_.ws + WS_WQ) + (size_t)l * DM * DM, (bf16_t*)(p_.ws + WS_QP), (float*)(p_.ws + WS_QPART), l < DEPTH - 1, G, bid_);
#if defined(PROBE_DUP_GEMM)
            __syncthreads(); gemm_rows_bf16(lds, (const bf16_t*)(p_.ws + WS_HB), (const bf16_t*)(p_.ws + WS_WQ) + (size_t)l * DM * DM, (bf16_t*)(p_.ws + WS_QP), (float*)(p_.ws + WS_QPART), l < DEPTH - 1, G, bid_);
#endif
        }
        SEAM(b0 + 6);
        if (IN(b0 + 7)) { FRESH(); peer_retrieve(p_, l, lds, tid_, lane_, wave_, bid_, G, l < DEPTH - 1 ? TA : TL); }
#if defined(PROBE_DUP_D)
        if (IN(b0 + 7)) { __syncthreads(); FRESH(); peer_retrieve(p_, l, lds, tid_, lane_, wave_, bid_, G, l < DEPTH - 1 ? TA : TL); }
#endif
        SEAM(b0 + 7);
        if (IN(b0 + 8)) { FRESH(); phase_peer(p_, l, lds, tid_, lane_, wave_, bid_, G); }
        if (l < DEPTH - 1) SEAM(b0 + 8);
    }
#undef FRESH
#undef IN
#undef SEAM
}

#ifndef MK_PER_PHASE
#define MK_PER_PHASE 0
#endif
extern "C" void kernel_launch(void* const* d_in, const int* in_sizes, int n_in, void* d_out, int out_size, void* d_ws, size_t ws_size, hipStream_t stream) {
    static int grid = 0;
    if (grid == 0) {
        if (n_in != 19 || out_size != TL * DM || ws_size < WS_END) { fprintf(stderr, "kernel_launch: unexpected shapes (n_in %d out %d ws %zu)\n", n_in, out_size, ws_size); grid = -1; return; }
        int dev = 0, cus = 0;
        if (hipGetDevice(&dev) != hipSuccess || hipDeviceGetAttribute(&cus, hipDeviceAttributeMultiprocessorCount, dev) != hipSuccess) { grid = -1; return; }
        if (hipFuncSetAttribute((const void*)fwd_kernel, hipFuncAttributeMaxDynamicSharedMemorySize, LDS_BYTES) != hipSuccess) { fprintf(stderr, "kernel_launch: hipFuncSetAttribute failed\n"); grid = -1; return; }
        int per_cu = 0;
        (void)hipOccupancyMaxActiveBlocksPerMultiprocessor(&per_cu, (const void*)fwd_kernel, NTHREADS, LDS_BYTES);
        (void)hipGetLastError();
        if (per_cu < 1) fprintf(stderr, "kernel_launch: occupancy query reports %d blocks per CU\n", per_cu);
        grid = cus;
    }
    if (grid < 0) return;
    (void)hipMemsetAsync((char*)d_ws + WS_CTL, 0, CTL_ZERO_BYTES, stream);
    Params p{};
    for (int i = 0; i < 19; ++i) p.in[i] = (const float*)d_in[i];
    p.out = (float*)d_out; p.ws = (unsigned char*)d_ws;
#if MK_PER_PHASE
    for (int ph = 0; ph < N_PHASES; ++ph) { p.ph_lo = ph; p.ph_hi = ph + 1; hipLaunchKernelGGL(fwd_kernel, dim3(grid), dim3(NTHREADS), LDS_BYTES, stream, p); }
#else
    p.ph_lo = 0; p.ph_hi = N_PHASES;
    hipLaunchKernelGGL(fwd_kernel, dim3(grid), dim3(NTHREADS), LDS_BYTES, stream, p);
#endif
}
```

```cpp
#include <hip/hip_runtime.h>
#include <cstdio>
#include <cstdint>

#define LAS __attribute__((address_space(3)))
typedef unsigned short bf16_t;
typedef short bf16x8 __attribute__((ext_vector_type(8)));
typedef float f32x4 __attribute__((ext_vector_type(4)));
typedef unsigned u32x4 __attribute__((ext_vector_type(4)));
typedef unsigned u32x2 __attribute__((ext_vector_type(2)));
typedef unsigned u32x6 __attribute__((ext_vector_type(6)));
typedef float f32x2v __attribute__((ext_vector_type(2)));
typedef float f32x16 __attribute__((ext_vector_type(16)));
typedef float f32x32 __attribute__((ext_vector_type(32)));

constexpr int DM = 2048, NBATCH = 2, SEQ = 8192, DEPTH = 4, CTXL = 256;
constexpr int TL = NBATCH * SEQ, TC = NBATCH * CTXL, TA = TL + TC;
constexpr int INW = 4640, INWP = 4864;
constexpr int C_CX = 0, C_CB = 512, C_CC = 1024, C_GQ = 1536, C_GK = 1792, C_GV = 2048, C_GG = 2560, C_LRF = 3072, C_LRB = 3088,
              C_SQ = 3104, C_SK = 4128, C_SV = 4384;
constexpr int NEXP = 16384;
constexpr int ROWB = 1536;
constexpr int ROWB4 = 1088;
#ifndef TBL_U_FP4
#define TBL_U_FP4 1
#endif
#ifndef TBL_U_I4
#define TBL_U_I4 (TBL_U_FP4)
#endif
constexpr unsigned I4_BASE = 103u << 23;
#ifndef U_ROWSCALE
#define U_ROWSCALE (TBL_U_I4)
#endif
#ifndef V_ROWSCALE
#define V_ROWSCALE 1
#endif
constexpr int ROWB_U = U_ROWSCALE ? 1024 : (TBL_U_FP4 ? ROWB4 : ROWB), ROWB_V = V_ROWSCALE ? 1024 : ROWB4;
constexpr float DN_ALPHA = 1.6817928305074290f;
constexpr float LN_EPS = 1e-6f;
constexpr int NWAVES = 8, NTHREADS = 512;

constexpr size_t MiB = 1u << 20;
constexpr size_t WS_CTL = 0, CTL_ZERO_BYTES = 256 * 1024;
constexpr size_t WS_MOD = 2 * MiB;
constexpr size_t WS_WIN = 4 * MiB;
constexpr size_t WS_WOUT = 80 * MiB;
constexpr size_t WS_WQ = 112 * MiB;
constexpr size_t WS_XL = 144 * MiB;
constexpr size_t WS_HB = 276 * MiB;
constexpr size_t WS_P = 342 * MiB;
constexpr size_t WS_QR = 656 * MiB;
constexpr size_t WS_KR = 720 * MiB;
constexpr size_t WS_ALF = 736 * MiB;
constexpr size_t WS_ALB = 753 * MiB;
constexpr size_t WS_OF = 770 * MiB;
constexpr size_t WS_OB = 803 * MiB;
constexpr size_t WS_MIX = 836 * MiB;
constexpr size_t WS_Y = 902 * MiB;
constexpr size_t WS_QP = 1034 * MiB;
constexpr size_t WS_DELTA = 1166 * MiB;
constexpr size_t WS_DEC = 1233 * MiB;
constexpr size_t WS_SST = 1234 * MiB;
constexpr size_t WS_UB = 1268 * MiB;
constexpr size_t WS_VB = 1524 * MiB;
constexpr size_t WS_EIDX = 1780 * MiB;
constexpr size_t WS_EGATE = 1789 * MiB;
constexpr size_t WS_SUBB = 1798 * MiB;
constexpr size_t WS_USC = 1799 * MiB;
constexpr size_t WS_VSC = 1799 * MiB + 512 * 1024;
constexpr size_t WS_YPART = 1800 * MiB;
constexpr size_t WS_QPART = 1832 * MiB;
constexpr size_t WS_XM = 1864 * MiB;
constexpr size_t WS_END = 1996 * MiB;
constexpr int GLA_ITEMS = (TA / 64) * 4;
static_assert(WS_DELTA + (size_t)GLA_ITEMS * 2 * 8192 * 4 <= WS_DEC && WS_DEC + (size_t)GLA_ITEMS * 2 * 64 * 4 <= WS_SST && WS_SST + (size_t)GLA_ITEMS * 2 * 8192 * 2 <= WS_END, "map");
static_assert(WS_WIN + (size_t)4 * INWP * DM * 2 <= WS_WOUT, "map");
static_assert(WS_P + (size_t)TA * INWP * 2 <= WS_QR, "map");
static_assert(WS_XL + (size_t)TA * DM * 4 <= WS_HB, "map");
constexpr int CW_BAR = 4096;
constexpr int CW_QUEUE = 8192;
constexpr int LDS_BYTES = 163840;
constexpr int MISC_OFF = 163840 - 512;

#define XB_TMO      128
#define XB_XCNT(j)  (256  + 64 * (j))
#define XB_XSUB(j)  (1280 + 64 * (j))
#define XB_XGEN(j)  (2304 + 64 * (j))
#define XB_TOP      3328
#define XB_TOPGEN   3392
#define XCD_BAR_WORDS 3456
#define XB_SPIN_CAP (1u << 18)
__device__ __forceinline__ unsigned xb_ld(unsigned* p)              { return __hip_atomic_load(p, __ATOMIC_RELAXED, __HIP_MEMORY_SCOPE_AGENT); }
__device__ __forceinline__ unsigned xb_add(unsigned* p, unsigned v) { return __hip_atomic_fetch_add(p, v, __ATOMIC_RELAXED, __HIP_MEMORY_SCOPE_AGENT); }
__device__ __forceinline__ unsigned xb_xcc_id() { return (unsigned)__builtin_amdgcn_s_getreg((3 << 11) | 20) & 0xFu; }
#define XB_SPIN(cond, bar) do { unsigned _sp = 0; while (cond) { __builtin_amdgcn_s_sleep(1); \
    if ((++_sp & 255u) == 0u) { if (xb_ld(&(bar)[XB_TMO])) break; if (_sp > XB_SPIN_CAP) { atomicAdd(&(bar)[XB_TMO], 1u); break; } } } } while (0)
struct XcdBarrier { unsigned* bar; unsigned x; volatile LAS unsigned* st; };
__device__ __forceinline__ XcdBarrier xcd_barrier_post(unsigned* bar, volatile LAS unsigned* st) {
    XcdBarrier b; b.bar = bar; b.x = xb_xcc_id(); b.st = st;
    if (threadIdx.x == 0) (void)xb_add(&bar[XB_XCNT(b.x)], 1u);
    return b;
}
__device__ __forceinline__ void xcd_barrier_complete(unsigned* bar, unsigned x, unsigned& nloc, unsigned& nx) {
    const unsigned G = gridDim.x * gridDim.y * gridDim.z;
    unsigned sum, cnt, mine, sp = 0u;
    for (;;) {
        sum = 0u; cnt = 0u; mine = 0u;
#pragma unroll
        for (unsigned j = 0; j < 16; ++j) { const unsigned c = xb_ld(&bar[XB_XCNT(j)]); sum += c; cnt += (c > 0u) ? 1u : 0u; mine = (j == x) ? c : mine; }
        if (sum == G) break;
        __builtin_amdgcn_s_sleep(1);
        if ((++sp & 255u) == 0u) { if (xb_ld(&bar[XB_TMO])) break; if (sp > XB_SPIN_CAP) { atomicAdd(&bar[XB_TMO], 1u); break; } }
    }
    nloc = mine > 0u ? mine : 1u; nx = cnt > 0u ? cnt : 1u;
}
__device__ __forceinline__ void xcd_barrier(const XcdBarrier& b) {
    asm volatile("s_waitcnt vmcnt(0)" ::: "memory");
    __syncthreads();
    if (threadIdx.x == 0) {
        unsigned* bar = b.bar;
        __builtin_amdgcn_s_waitcnt(0);
        unsigned nloc = b.st[0], nx = b.st[1];
        if (nloc == 0u) { xcd_barrier_complete(bar, b.x, nloc, nx); b.st[0] = nloc; b.st[1] = nx; }
        const unsigned old = xb_add(&bar[XB_XSUB(b.x)], 1u);
        const unsigned gen = old / nloc;
        if (old + 1u == (gen + 1u) * nloc) {
            __builtin_amdgcn_fence(__ATOMIC_RELEASE, "agent");
            asm volatile("s_waitcnt vmcnt(0)" ::: "memory");
            const unsigned og = xb_add(&bar[XB_TOP], 1u);
            const unsigned tg = og / nx;
            if (og + 1u == (tg + 1u) * nx) xb_add(&bar[XB_TOPGEN], 1u);
            else XB_SPIN(xb_ld(&bar[XB_TOPGEN]) == tg, bar);
            __builtin_amdgcn_fence(__ATOMIC_ACQUIRE, "agent");
            xb_add(&bar[XB_XGEN(b.x)], 1u);
            asm volatile("s_waitcnt vmcnt(0)" ::: "memory");
        } else {
            XB_SPIN(xb_ld(&bar[XB_XGEN(b.x)]) == gen, bar);
            __builtin_amdgcn_fence(__ATOMIC_ACQUIRE, "agent");
            asm volatile("s_waitcnt vmcnt(0)" ::: "memory");
        }
    }
    __syncthreads();
}

namespace pg8 {
#define PG8_LAS __attribute__((address_space(3)))
typedef unsigned short bf16_t;
typedef short bf16x8 __attribute__((ext_vector_type(8)));
typedef float f32x4 __attribute__((ext_vector_type(4)));
typedef unsigned u32x4 __attribute__((ext_vector_type(4)));
constexpr int BM = 256, BK = 64, HALF = 128, HTB = HALF * BK * 2  , STAGE_BYTES = 8 * HTB, NXCD = 8, WGM = 8;

__host__ __device__ __forceinline__ int lds_byte(int r, int c) { const int st = (r >> 4) * 2 + (c >> 5), rr = r & 15, cc = c & 31, ob = rr * 64 + cc * 2; return st * 1024 + (ob ^ (((ob >> 9) & 1) << 5)); }
__host__ __device__ __forceinline__ void stage_rc(int b, int& R, int& C) { const int st = b / 1024, sb = b % 1024, swz = sb ^ (((sb >> 9) & 1) << 5); R = (st >> 1) * 16 + swz / 64; C = (st & 1) * 32 + (swz % 64) / 2; }
__host__ __device__ __forceinline__ int perm32(int rho) { const int n = rho >> 4, i = rho & 15; return 8 * (i >> 2) + 4 * n + (i & 3); }

struct Unit { int pm, pn, kofs; };
struct Gemm { const bf16_t* A; const bf16_t* Bt; int M, N, K, ld; };

struct StaticOrder {
    int nM, nN, nwg, G, c;
    __host__ __device__ void init(int M, int N, int G_, int c_) { nM = M / BM; nN = N / BM; nwg = nM * nN; G = G_; c = c_; }
    __host__ __device__ bool next(int i, Unit& u) const {
        const long L = (long)i * G + c; if (L >= nwg) return false;
        int wgid = (int)L; { const int q = nwg / NXCD, r = nwg % NXCD, xcd = wgid % NXCD, off = wgid / NXCD; wgid = (xcd < r ? xcd * (q + 1) : r * (q + 1) + (xcd - r) * q) + off; }
        const int nig = WGM * nN, gid = wgid / nig, fm = gid * WGM, gsz = (nM - fm) < WGM ? (nM - fm) : WGM;
        u.pm = fm + ((wgid % nig) % gsz); u.pn = (wgid % nig) / gsz; u.kofs = 0; return true;
    }
    __device__ __forceinline__ void a_ready(const Unit&) const {}
    __device__ __forceinline__ void done(const Unit&) const {}
};

__device__ __forceinline__ unsigned cvt_pk_bf16(float lo, float hi) { unsigned r; asm volatile("v_cvt_pk_bf16_f32 %0, %1, %2" : "=v"(r) : "v"(lo), "v"(hi)); return r; }
typedef float f32x2 __attribute__((ext_vector_type(2)));
__device__ __forceinline__ f32x2 gelu_pk(f32x2 v) {
    const f32x2 av = __builtin_elementwise_abs(v), d = av * 0.2316418882f + 1.0f;
    f32x2 t; t.x = __builtin_amdgcn_rcpf(d.x); t.y = __builtin_amdgcn_rcpf(d.y);
    f32x2 q = t * 0.5307027145f + (-0.7265760135f); q = q * t + 0.7107068705f; q = q * t + (-0.142248368f); q = q * t + 0.127414796f; q = q * t;
    const f32x2 s = (v * v) * (-0.72134752044f);
    f32x2 e; e.x = __builtin_amdgcn_exp2f(s.x); e.y = __builtin_amdgcn_exp2f(s.y);
    const f32x2 m = v * (q * e), r = v - m;
    f32x2 o; o.x = v.x < 0.f ? m.x : r.x; o.y = v.y < 0.f ? m.y : r.y; return o;
}

template <int ACT  > struct EpiBf16 {
    static constexpr bool PERM = true, AFTER_DRAIN = false; static_assert(ACT == 0 || ACT == 1, "EpiBf16: ACT is 0 (none) or 1 (gelu_pk)");
    bf16_t* O; int ldc; const float* bias; int split_cols; size_t split_stride; float scale0;
    __device__ __forceinline__ void operator()(const f32x4 (&acc)[2][2][4][2], const Unit& u, int wr, int wc, int fr, int fq) const {
        const int row0 = u.pm * BM + wr * 64 + fr; int colt = u.pn * BM; bf16_t* base = O;
        float sc = 1.f; if (split_cols) { const int t = colt / split_cols; base += (size_t)t * split_stride; colt -= t * split_cols; if (t == 0) sc = scale0; }
        const int col0 = colt + wc * 32 + 8 * fq, bcol0 = u.pn * BM + wc * 32 + 8 * fq;
        f32x4 bv[2][2];
#pragma unroll
        for (int bj = 0; bj < 2; ++bj)
#pragma unroll
            for (int n = 0; n < 2; ++n) bv[bj][n] = bias ? *(const f32x4*)(bias + bcol0 + bj * HALF + 4 * n) : (f32x4){0.f, 0.f, 0.f, 0.f};
#pragma unroll
        for (int ai = 0; ai < 2; ++ai)
#pragma unroll
            for (int m = 0; m < 4; ++m) { bf16_t* rowp = base + (size_t)(row0 + ai * HALF + m * 16) * ldc + col0;
#pragma unroll
                for (int bj = 0; bj < 2; ++bj) { f32x4 v0 = acc[ai][bj][m][0] + bv[bj][0], v1 = acc[ai][bj][m][1] + bv[bj][1];
                    if (ACT == 1) { f32x2 a = gelu_pk((f32x2){v0[0], v0[1]}), b = gelu_pk((f32x2){v0[2], v0[3]}), c = gelu_pk((f32x2){v1[0], v1[1]}), d = gelu_pk((f32x2){v1[2], v1[3]});
                        v0 = (f32x4){a.x, a.y, b.x, b.y}; v1 = (f32x4){c.x, c.y, d.x, d.y}; }
                    v0 = v0 * sc; v1 = v1 * sc; u32x4 w; w.x = cvt_pk_bf16(v0[0], v0[1]); w.y = cvt_pk_bf16(v0[2], v0[3]); w.z = cvt_pk_bf16(v1[0], v1[1]); w.w = cvt_pk_bf16(v1[2], v1[3]);
                    *(u32x4*)(rowp + bj * HALF) = w; } }
    }
};


struct EpiF32 {
    static constexpr bool PERM = false, AFTER_DRAIN = false;
    float* C; int ldc; const float* bias;
    __device__ __forceinline__ void operator()(const f32x4 (&acc)[2][2][4][2], const Unit& u, int wr, int wc, int fr, int fq) const {
        const int row0 = u.pm * BM + wr * 64 + fr, col0 = u.pn * BM + wc * 32 + 4 * fq;
        f32x4 bv[2][2];
#pragma unroll
        for (int bj = 0; bj < 2; ++bj)
#pragma unroll
            for (int n = 0; n < 2; ++n) bv[bj][n] = bias ? *(const f32x4*)(bias + col0 + bj * HALF + n * 16) : (f32x4){0.f, 0.f, 0.f, 0.f};
#pragma unroll
        for (int ai = 0; ai < 2; ++ai)
#pragma unroll
            for (int m = 0; m < 4; ++m) { float* rowp = C + (size_t)(row0 + ai * HALF + m * 16) * ldc + col0;
#pragma unroll
                for (int bj = 0; bj < 2; ++bj)
#pragma unroll
                    for (int n = 0; n < 2; ++n) *(f32x4*)(rowp + bj * HALF + n * 16) = acc[ai][bj][m][n] + bv[bj][n]; }
    }
};

template <class Epi, class Sched, bool ALIGN_EPI = false, bool SP2 = false>
__device__ __forceinline__ void gemm_phase(PG8_LAS unsigned char* lds, const Gemm g, const Sched& S, const Epi& E) {
    int tid_l = threadIdx.x; asm volatile("" : "+v"(tid_l));
    const int tid = tid_l, wid = __builtin_amdgcn_readfirstlane(tid >> 6), lane = tid & 63, wr = wid >> 2, wc = wid & 3, fr = lane & 15, fq = lane >> 4;
    const int K = g.K, nt = K / BK;
    unsigned voffA[2], voffB[2];
#pragma unroll
    for (int i = 0; i < 2; ++i) { int R, C; stage_rc(tid * 16 + i * 8192, R, C); const int Rb = Epi::PERM ? ((R & ~31) + perm32(R & 31)) : R;
        voffA[i] = (unsigned)(R * g.ld + C) * 2u; voffB[i] = (unsigned)(Rb * g.ld + C) * 2u; }
    const size_t kstep = (size_t)(BK * 2);
    const size_t hstep = (size_t)HALF * g.ld * 2;
    const size_t tstep = 2 * hstep;
    const unsigned ldsw = (unsigned)wid * 1024u;
    const int aoff = lds_byte(wr * 64 + fr, fq * 8), boff = lds_byte(wc * 32 + fr, fq * 8);
#define PG8_SA(b, h) (((b) * 2 + (h)) * HTB)
#define PG8_SB(b, h) ((4 + (b) * 2 + (h)) * HTB)
#define PG8_STAGE(bufoff, gbase, voff) do { _Pragma("unroll") for (int _i = 0; _i < 2; ++_i) \
        __builtin_amdgcn_global_load_lds((const unsigned*)((const char*)(gbase) + (voff)[_i]), (PG8_LAS unsigned*)(lds + (bufoff) + ldsw + _i * 8192), 16, 0, 0); } while (0)
#define PG8_LDA(dst, b, h) do { _Pragma("unroll") for (int m = 0; m < 4; ++m) _Pragma("unroll") for (int k = 0; k < 2; ++k) dst[m][k] = *(const PG8_LAS bf16x8*)(lds + PG8_SA(b, h) + aoff + m * 2048 + k * 1024); } while (0)
#define PG8_LDB(dst, b, h) do { _Pragma("unroll") for (int n = 0; n < 2; ++n) _Pragma("unroll") for (int k = 0; k < 2; ++k) dst[n][k] = *(const PG8_LAS bf16x8*)(lds + PG8_SB(b, h) + boff + n * 2048 + k * 1024); } while (0)
#define PG8_MMA(ai, bj, At, Bt) do { __builtin_amdgcn_s_setprio(1); _Pragma("unroll") for (int m = 0; m < 4; ++m) _Pragma("unroll") for (int n = 0; n < 2; ++n) _Pragma("unroll") for (int k = 0; k < 2; ++k) \
        acc[ai][bj][m][n] = __builtin_amdgcn_mfma_f32_16x16x32_bf16(Bt[n][k], At[m][k], acc[ai][bj][m][n], 0, 0, 0); __builtin_amdgcn_s_setprio(0); } while (0)
#define PG8_WAIT_V(n) asm volatile("s_waitcnt vmcnt(" #n ")" ::: "memory")
#define PG8_WAIT_L(n) asm volatile("s_waitcnt lgkmcnt(" #n ")" ::: "memory")
#define PG8_BAR __builtin_amdgcn_s_barrier()
#define PG8_SCHED __builtin_amdgcn_sched_barrier(0)
    Unit cur, nxt; int ui = 0;
    if (!S.next(0, cur)) return;
    f32x4 acc[2][2][4][2];
#pragma unroll
    for (int a = 0; a < 2; ++a)
#pragma unroll
        for (int b = 0; b < 2; ++b)
#pragma unroll
            for (int m = 0; m < 4; ++m)
#pragma unroll
                for (int n = 0; n < 2; ++n) acc[a][b][m][n] = (f32x4){0.f, 0.f, 0.f, 0.f};
    bf16x8 At[4][2], B0[2][2], B1[2][2];
    const char* cA = (const char*)g.A + (size_t)cur.pm * tstep + (size_t)cur.kofs * 2; const char* cB = (const char*)g.Bt + (size_t)cur.pn * tstep + (size_t)cur.kofs * 2;
    S.a_ready(cur);
    if constexpr (SP2) {
        PG8_STAGE(PG8_SB(0, 0), cB, voffB); PG8_STAGE(PG8_SB(0, 1), cB + hstep, voffB); PG8_STAGE(PG8_SA(0, 0), cA, voffA); PG8_STAGE(PG8_SA(0, 1), cA + hstep, voffA);
        if (wr == 1) PG8_BAR;
        PG8_WAIT_V(2); PG8_BAR;
        PG8_STAGE(PG8_SB(1, 0), cB + kstep, voffB); PG8_STAGE(PG8_SA(1, 0), cA + kstep, voffA); PG8_STAGE(PG8_SB(1, 1), cB + hstep + kstep, voffB);
        PG8_WAIT_V(6); PG8_BAR;
    } else {
        PG8_STAGE(PG8_SB(0, 0), cB, voffB); PG8_STAGE(PG8_SA(0, 0), cA, voffA); PG8_STAGE(PG8_SB(0, 1), cB + hstep, voffB); PG8_STAGE(PG8_SA(0, 1), cA + hstep, voffA);
        if (wr == 1) PG8_BAR;
        PG8_WAIT_V(4); PG8_BAR;
        PG8_STAGE(PG8_SB(1, 0), cB + kstep, voffB); PG8_STAGE(PG8_SA(1, 0), cA + kstep, voffA); PG8_STAGE(PG8_SB(1, 1), cB + hstep + kstep, voffB);
        PG8_WAIT_V(6); PG8_BAR;
    }
    for (;;) {
        const bool has_next = S.next(ui + 1, nxt);
        const char* nA = has_next ? (const char*)g.A + (size_t)nxt.pm * tstep + (size_t)nxt.kofs * 2 : cA; const char* nB = has_next ? (const char*)g.Bt + (size_t)nxt.pn * tstep + (size_t)nxt.kofs * 2 : cB;
        for (int t = 0; t < nt; t += 2) {
            const bool last = (t == nt - 2);
            const char* a1 = cA + (size_t)(t + 1) * kstep;
            const char* a2 = last ? nA : cA + (size_t)(t + 2) * kstep; const char* b2 = last ? nB : cB + (size_t)(t + 2) * kstep;
            const char* a3 = a2 + kstep; const char* b3 = b2 + kstep;
            if (last && has_next) S.a_ready(nxt);
            if constexpr (SP2) {
            PG8_LDB(B0, 0, 0); PG8_LDB(B1, 0, 1); PG8_SCHED; PG8_LDA(At, 0, 0); PG8_STAGE(PG8_SA(1, 1), a1 + hstep, voffA);
            PG8_WAIT_V(8); PG8_WAIT_L(0); PG8_BAR; PG8_MMA(0, 0, At, B0); PG8_MMA(0, 1, At, B1); PG8_BAR; PG8_SCHED;
            PG8_LDA(At, 0, 1); PG8_STAGE(PG8_SB(0, 0), b2, voffB); PG8_STAGE(PG8_SB(0, 1), b2 + hstep, voffB); PG8_STAGE(PG8_SA(0, 0), a2, voffA);
            PG8_WAIT_V(8); PG8_WAIT_L(0); PG8_BAR; PG8_MMA(1, 0, At, B0); PG8_MMA(1, 1, At, B1); PG8_BAR; PG8_SCHED;
            PG8_LDB(B0, 1, 0); PG8_LDB(B1, 1, 1); PG8_SCHED; PG8_LDA(At, 1, 0); PG8_STAGE(PG8_SA(0, 1), a2 + hstep, voffA);
            PG8_WAIT_V(8); PG8_WAIT_L(0); PG8_BAR; PG8_MMA(0, 0, At, B0); PG8_MMA(0, 1, At, B1); PG8_BAR; PG8_SCHED;
            PG8_LDA(At, 1, 1); PG8_STAGE(PG8_SB(1, 0), b3, voffB); PG8_STAGE(PG8_SB(1, 1), b3 + hstep, voffB); PG8_STAGE(PG8_SA(1, 0), a3, voffA);
            PG8_WAIT_V(8); PG8_WAIT_L(0); PG8_BAR; PG8_MMA(1, 0, At, B0); PG8_MMA(1, 1, At, B1); PG8_BAR; PG8_SCHED;
            } else {
            PG8_LDB(B0, 0, 0); PG8_SCHED; PG8_LDA(At, 0, 0); PG8_STAGE(PG8_SA(1, 1), a1 + hstep, voffA);
            PG8_WAIT_L(8); PG8_BAR; PG8_WAIT_L(0); PG8_MMA(0, 0, At, B0); PG8_BAR; PG8_SCHED;
            PG8_LDB(B1, 0, 1); PG8_STAGE(PG8_SB(0, 0), b2, voffB);
            PG8_BAR; PG8_WAIT_L(0); PG8_MMA(0, 1, At, B1); PG8_BAR;
            PG8_LDA(At, 0, 1); PG8_STAGE(PG8_SA(0, 0), a2, voffA);
            PG8_BAR; PG8_WAIT_L(0); PG8_MMA(1, 0, At, B0); PG8_BAR; PG8_SCHED;
            PG8_STAGE(PG8_SB(0, 1), b2 + hstep, voffB);
            PG8_WAIT_V(6); PG8_BAR; PG8_MMA(1, 1, At, B1); PG8_BAR;
            PG8_LDB(B0, 1, 0); PG8_SCHED; PG8_LDA(At, 1, 0); PG8_STAGE(PG8_SA(0, 1), a2 + hstep, voffA);
            PG8_WAIT_L(8); PG8_BAR; PG8_WAIT_L(0); PG8_MMA(0, 0, At, B0); PG8_BAR; PG8_SCHED;
            PG8_LDB(B1, 1, 1); PG8_STAGE(PG8_SB(1, 0), b3, voffB);
            PG8_BAR; PG8_WAIT_L(0); PG8_MMA(0, 1, At, B1); PG8_BAR;
            PG8_LDA(At, 1, 1); PG8_STAGE(PG8_SA(1, 0), a3, voffA);
            PG8_BAR; PG8_WAIT_L(0); PG8_MMA(1, 0, At, B0); PG8_BAR; PG8_SCHED;
            PG8_STAGE(PG8_SB(1, 1), b3 + hstep, voffB);
            PG8_WAIT_V(6); PG8_BAR; PG8_MMA(1, 1, At, B1); PG8_BAR;
            }
        }
        if constexpr (ALIGN_EPI) { if (wr == 0) PG8_BAR; }
        if constexpr (!Epi::AFTER_DRAIN) { E(acc, cur, wr, wc, fr, fq); S.done(cur); }
        if (!has_next) break;
#pragma unroll
        for (int a = 0; a < 2; ++a)
#pragma unroll
            for (int b = 0; b < 2; ++b)
#pragma unroll
                for (int m = 0; m < 4; ++m)
#pragma unroll
                    for (int n = 0; n < 2; ++n) acc[a][b][m][n] = (f32x4){0.f, 0.f, 0.f, 0.f};
        cur = nxt; cA = nA; cB = nB; ++ui;
        if constexpr (ALIGN_EPI) { if (wr == 1) PG8_BAR; }
    }
    PG8_WAIT_V(0);
    if constexpr (!ALIGN_EPI) { if (wr == 0) PG8_BAR; }
    PG8_BAR;
    if constexpr (Epi::AFTER_DRAIN) { E.fused(acc, cur, wr, wc, fr, fq, lds, wid, lane); S.done(cur); }
#undef PG8_SA
#undef PG8_SB
#undef PG8_STAGE
#undef PG8_LDA
#undef PG8_LDB
#undef PG8_MMA
#undef PG8_WAIT_V
#undef PG8_WAIT_L
#undef PG8_BAR
#undef PG8_SCHED
}
}
namespace pg8 {
struct SplitKOrder {
    int G, c;
    __host__ __device__ void init(int G_, int c_) { G = G_; c = c_; }
    __host__ __device__ bool next(int i, Unit& u) const { const long L = (long)i * G + c; if (L >= 128) return false; const int ks = (int)L >> 4, r = (int)L & 15; u.pm = r >> 3; u.pn = r & 7; u.kofs = ks * 256; return true; }
    __device__ __forceinline__ void a_ready(const Unit&) const {}
    __device__ __forceinline__ void done(const Unit&) const {}
};
struct EpiF32Part {
    static constexpr bool PERM = false, AFTER_DRAIN = false;
    float* C;
    __device__ __forceinline__ void operator()(const f32x4 (&acc)[2][2][4][2], const Unit& u, int wr, int wc, int fr, int fq) const {
        const int row0 = u.pm * BM + wr * 64 + fr, col0 = u.pn * BM + wc * 32 + 4 * fq; float* base = C + (size_t)(u.kofs >> 8) * 512 * 2048;
#pragma unroll
        for (int ai = 0; ai < 2; ++ai)
#pragma unroll
            for (int m = 0; m < 4; ++m) { float* rowp = base + (size_t)(row0 + ai * HALF + m * 16) * 2048 + col0;
#pragma unroll
                for (int bj = 0; bj < 2; ++bj)
#pragma unroll
                    for (int n = 0; n < 2; ++n) *(f32x4*)(rowp + bj * HALF + n * 16) = acc[ai][bj][m][n]; }
    }
};
}
#define PG8_SP2 true
#define PG8_ALIGN true

#define LDS_FENCE() asm volatile("s_waitcnt lgkmcnt(0)" ::: "memory")
__device__ __forceinline__ unsigned f2bf(float f) { unsigned u = __builtin_bit_cast(unsigned, f); return (u + 0x7fffu + ((u >> 16) & 1u)) >> 16; }
__device__ __forceinline__ unsigned pk2(float lo, float hi) { return f2bf(lo) | (f2bf(hi) << 16); }
__device__ __forceinline__ float wave_sum(float v) {
#pragma unroll
    for (int o = 1; o < 64; o <<= 1) v += __shfl_xor(v, o);
    return v;
}
__device__ __forceinline__ float wave_max(float v) {
#pragma unroll
    for (int o = 1; o < 64; o <<= 1) v = fmaxf(v, __shfl_xor(v, o));
    return v;
}
__device__ __forceinline__ float silu_f(float x) { return x / (1.0f + __expf(-x)); }
__device__ __forceinline__ float gelu_f(float v) {
    const float t = __builtin_amdgcn_rcpf(fabsf(v) * 0.2316418882f + 1.0f);
    float q = t * 0.5307027145f + (-0.7265760135f); q = q * t + 0.7107068705f; q = q * t + (-0.142248368f); q = q * t + 0.127414796f; q = q * t;
    const float m = v * (q * __builtin_amdgcn_exp2f(v * v * (-0.72134752044f)));
    return v < 0.f ? m : v - m;
}
__device__ __forceinline__ float log_sigmoid_f(float z) { return fminf(z, 0.0f) - __logf(1.0f + __expf(-fabsf(z))); }


__device__ __forceinline__ float bflo(unsigned w) { return __builtin_bit_cast(float, w << 16); }
__device__ __forceinline__ float bfhi(unsigned w) { return __builtin_bit_cast(float, w & 0xffff0000u); }
__device__ __forceinline__ void unpack8(const u32x4 w, float (&f)[8]) { f[0] = bflo(w.x); f[1] = bfhi(w.x); f[2] = bflo(w.y); f[3] = bfhi(w.y); f[4] = bflo(w.z); f[5] = bfhi(w.z); f[6] = bflo(w.w); f[7] = bfhi(w.w); }
__device__ __forceinline__ u32x4 pack8(const float (&f)[8]) { u32x4 o; o.x = pk2(f[0], f[1]); o.y = pk2(f[2], f[3]); o.z = pk2(f[4], f[5]); o.w = pk2(f[6], f[7]); return o; }


__device__ __forceinline__ u32x6 pack_fp6_2x16(const f32x16 a, const f32x16 b) { u32x6 r; asm("v_cvt_scalef32_2xpk16_fp6_f32 %0, %1, %2, 1.0" : "=&v"(r) : "v"(a), "v"(b)); return r; }
__device__ __forceinline__ f32x32 unpack_fp6_32(const u32x6 w) { f32x32 r; asm volatile("v_cvt_scalef32_pk32_f32_fp6 %0, %1, 1.0" : "=&v"(r) : "v"(w)); return r; }

struct Params {
    const float* in[19];
    float* out;
    unsigned char* ws;
    int ph_lo, ph_hi;
};
enum { I_X = 0, I_C, I_CTX, I_CCTX, I_WADA, I_BADA, I_WIN, I_CONVW, I_GW2, I_GB2, I_GNORM, I_SINK, I_WOUT, I_LNG, I_LNB, I_PWQ, I_PSUB, I_PU, I_PV };

__device__ __forceinline__ int row_stream(int r) { return r < TL ? r / SEQ : 2; }

__device__ __forceinline__ void transpose_item(const float* W, int K, int N, bf16_t* WT, LAS float* scr, int item, int lane) {
    const int nblk = N / 32, kb = item / nblk, nb = item % nblk, k0 = 64 * kb, n0 = 32 * nb;
#pragma unroll 8
    for (int i = 0; i < 32; ++i) { const int kk = 2 * i + (lane >> 5); scr[kk * 33 + (lane & 31)] = W[(size_t)(k0 + kk) * N + n0 + (lane & 31)]; }
    LDS_FENCE();
    const int c = lane & 7;
#pragma unroll
    for (int j = 0; j < 4; ++j) { const int n = (lane >> 3) + 8 * j; const LAS float* s = scr + (8 * c) * 33 + n;
        u32x4 o; o.x = pk2(s[0 * 33], s[1 * 33]); o.y = pk2(s[2 * 33], s[3 * 33]); o.z = pk2(s[4 * 33], s[5 * 33]); o.w = pk2(s[6 * 33], s[7 * 33]);
        *(u32x4*)(WT + (size_t)(n0 + n) * K + k0 + 8 * c) = o; }
    LDS_FENCE();
}

__device__ __forceinline__ void phase_prologue(const Params& p, LAS unsigned char* lds, int tid, int lane, int wave, int bid, int G) {
    const int gw = bid * NWAVES + wave, NGW = G * NWAVES;
    LAS float* scr = (LAS float*)(lds + wave * 16384);
    bf16_t* WIN = (bf16_t*)(p.ws + WS_WIN); bf16_t* WOUT = (bf16_t*)(p.ws + WS_WOUT); bf16_t* WQ = (bf16_t*)(p.ws + WS_WQ);
    constexpr int IT_IN = (DM / 64) * (INW / 32), IT_SQ = (DM / 64) * (DM / 32), IT_L = IT_IN + 2 * IT_SQ;
    for (int it = gw; it < DEPTH * IT_L; it += NGW) {
        const int l = it / IT_L; int r = it % IT_L;
        if (r < IT_IN) { transpose_item(p.in[I_WIN] + (size_t)l * DM * INW, DM, INW, WIN + (size_t)l * INWP * DM, scr, r, lane); continue; } r -= IT_IN;
        if (r < IT_SQ) { transpose_item(p.in[I_WOUT] + (size_t)l * DM * DM, DM, DM, WOUT + (size_t)l * DM * DM, scr, r, lane); continue; } r -= IT_SQ;
        transpose_item(p.in[I_PWQ] + (size_t)l * DM * DM, DM, DM, WQ + (size_t)l * DM * DM, scr, r, lane);
    }
    {
        constexpr int PADV = (INWP - INW) * DM / 8;
        const int gt = bid * NTHREADS + tid, NGT = G * NTHREADS;
        for (int i = gt; i < DEPTH * PADV; i += NGT) { const int l = i / PADV, o = i % PADV;
            *(u32x4*)(WIN + (size_t)l * INWP * DM + (size_t)INW * DM + (size_t)o * 8) = (u32x4){0u, 0u, 0u, 0u}; }
    }
    {
        const float* U = p.in[I_PU]; const float* V = p.in[I_PV];
        unsigned char* UB = p.ws + WS_UB; unsigned char* VB = p.ws + WS_VB; float* USC = (float*)(p.ws + WS_USC); (void)USC; float* VSC = (float*)(p.ws + WS_VSC); (void)VSC;
        for (size_t row = gw; row < (size_t)DEPTH * NEXP; row += NGW) {
            f32x4 xx[2][8];
#pragma unroll
            for (int tb = 0; tb < 2; ++tb)
#pragma unroll
                for (int j = 0; j < 8; ++j) xx[tb][j] = *(const f32x4*)((tb ? V : U) + row * DM + lane * 32 + 4 * j);
#pragma unroll
            for (int tb = 0; tb < 2; ++tb) {
                f32x4 x[8]; float am = 0.f;
#pragma unroll
                for (int j = 0; j < 8; ++j) { x[j] = xx[tb][j]; am = fmaxf(am, fmaxf(fmaxf(fabsf(x[j].x), fabsf(x[j].y)), fmaxf(fabsf(x[j].z), fabsf(x[j].w)))); }
                if (tb == 0 && TBL_U_I4) {
#if U_ROWSCALE
                    unsigned char* dst = UB + row * ROWB_U;
                    float ssq = 0.f;
#pragma unroll
                    for (int j = 0; j < 8; ++j) ssq += (x[j].x * x[j].x + x[j].y * x[j].y) + (x[j].z * x[j].z + x[j].w * x[j].w);
                    const float amr = wave_max(am), rms = sqrtf(wave_sum(ssq) * (1.0f / DM));
                    const float srow = amr > 0.f ? fminf(amr * (1.0f / 7.0f), 0.36f * rms) : 1.0f; const float inv = 1.0f / srow; const int code = 0; (void)code;
                    if (lane == 0) USC[row] = srow;
#else
                    unsigned char* dst = UB + row * ROWB4;
                    const float sb = am * (1.0f / 7.0f); const unsigned ub = (__builtin_bit_cast(unsigned, sb) + 0x000fffffu) & 0xfff00000u;
                    int code = ((int)ub - (int)I4_BASE) >> 20; code = code < 0 ? 0 : (code > 255 ? 255 : code);
                    const float inv = 1.0f / __builtin_bit_cast(float, ((unsigned)code << 20) + I4_BASE);
#endif
                    u32x4 w;
#pragma unroll
                    for (int d = 0; d < 4; ++d) { unsigned t = 0u;
#pragma unroll
                        for (int e = 0; e < 8; ++e) { const float xv = (e < 4 ? x[2 * d] : x[2 * d + 1])[e & 3];
                            int q = (int)__builtin_rintf(xv * inv); q = q < -7 ? -7 : (q > 7 ? 7 : q); t |= ((unsigned)q & 15u) << (4 * e); }
                        w[d] = t; }
                    *(u32x4*)(dst + lane * 16) = w;
#if !U_ROWSCALE
                    dst[1024 + lane] = (unsigned char)code;
#endif
                } else if (tb == 1 && V_ROWSCALE) {
                    unsigned char* dst = VB + row * ROWB_V;
                    float ssq = 0.f;
#pragma unroll
                    for (int j = 0; j < 8; ++j) ssq += (x[j].x * x[j].x + x[j].y * x[j].y) + (x[j].z * x[j].z + x[j].w * x[j].w);
                    const float amr = wave_max(am), rms = sqrtf(wave_sum(ssq) * (1.0f / DM));
                    const float srow = amr > 0.f ? fminf(amr * (1.0f / 6.0f), (2.8f / 6.0f) * rms) : 1.0f; const float inv = 1.0f / srow;
                    if (lane == 0) VSC[row] = srow;
                    u32x4 w;
#pragma unroll
                    for (int d = 0; d < 4; ++d) { unsigned t = 0u;
                        t = __builtin_amdgcn_cvt_scalef32_pk_fp4_f32(t, x[2 * d].x * inv, x[2 * d].y * inv, 1.0f, 0); t = __builtin_amdgcn_cvt_scalef32_pk_fp4_f32(t, x[2 * d].z * inv, x[2 * d].w * inv, 1.0f, 1);
                        t = __builtin_amdgcn_cvt_scalef32_pk_fp4_f32(t, x[2 * d + 1].x * inv, x[2 * d + 1].y * inv, 1.0f, 2); t = __builtin_amdgcn_cvt_scalef32_pk_fp4_f32(t, x[2 * d + 1].z * inv, x[2 * d + 1].w * inv, 1.0f, 3);
                        w[d] = t; }
                    *(u32x4*)(dst + lane * 16) = w;
                } else if (tb == 1 || TBL_U_FP4) {
                    unsigned char* dst = (tb ? VB : UB) + row * ROWB4;
                    const float sb = am * (1.0f / 6.0f); unsigned ub = __builtin_bit_cast(unsigned, sb); ub = (ub & 0x007fffffu) ? ((ub & 0x7f800000u) + 0x00800000u) : (ub & 0x7f800000u);
                    if (!(am > 0.f) || ub < 0x00800000u) ub = 0x00800000u;
                    const float scl = __builtin_bit_cast(float, ub);
                    u32x4 w;
#pragma unroll
                    for (int d = 0; d < 4; ++d) { unsigned t = 0u;
                        t = __builtin_amdgcn_cvt_scalef32_pk_fp4_f32(t, x[2 * d].x, x[2 * d].y, scl, 0); t = __builtin_amdgcn_cvt_scalef32_pk_fp4_f32(t, x[2 * d].z, x[2 * d].w, scl, 1);
                        t = __builtin_amdgcn_cvt_scalef32_pk_fp4_f32(t, x[2 * d + 1].x, x[2 * d + 1].y, scl, 2); t = __builtin_amdgcn_cvt_scalef32_pk_fp4_f32(t, x[2 * d + 1].z, x[2 * d + 1].w, scl, 3);
                        w[d] = t; }
                    *(u32x4*)(dst + lane * 16) = w; dst[1024 + lane] = (unsigned char)(ub >> 23);
                } else {
                    unsigned char* dst = UB + row * ROWB;
                    am = wave_max(am);
                    const float inv = am > 0.f ? 7.0f / am : 0.f;
                    f32x16 x0, x1;
#pragma unroll
                    for (int j = 0; j < 4; ++j) { x0[4 * j + 0] = x[j].x * inv; x0[4 * j + 1] = x[j].y * inv; x0[4 * j + 2] = x[j].z * inv; x0[4 * j + 3] = x[j].w * inv;
                        x1[4 * j + 0] = x[4 + j].x * inv; x1[4 * j + 1] = x[4 + j].y * inv; x1[4 * j + 2] = x[4 + j].z * inv; x1[4 * j + 3] = x[4 + j].w * inv; }
                    const u32x6 w = pack_fp6_2x16(x0, x1);
                    *(u32x4*)(dst + lane * 16) = (u32x4){w[0], w[1], w[2], w[3]}; *(u32x2*)(dst + 1024 + lane * 8) = (u32x2){w[4], w[5]};
                    if (lane == 0) USC[row] = am * (1.0f / 7.0f);
                }
            }
        }
        const size_t gt = (size_t)bid * NTHREADS + tid, NGT = (size_t)G * NTHREADS;
        const float* SUB = p.in[I_PSUB]; bf16_t* SUBB = (bf16_t*)(p.ws + WS_SUBB);
        for (size_t i = gt; i < (size_t)DEPTH * 2 * 128 * 128 / 2; i += NGT) ((unsigned*)SUBB)[i] = pk2(SUB[2 * i], SUB[2 * i + 1]);
    }
    __syncthreads();
    LAS float* sc = (LAS float*)lds;
    LAS float* red = (LAS float*)(lds + 32768);
    for (int i = tid; i < 3 * DM; i += NTHREADS) { const int s = i / DM, k = i % DM; const float v = s < 2 ? p.in[I_C][s * DM + k] : p.in[I_CCTX][k]; sc[i] = silu_f(v); }
    __syncthreads();
    float* MOD = (float*)(p.ws + WS_MOD);
    LAS float* red2 = (LAS float*)(lds + 32768);
    constexpr int NCH = 6 * DM / 256;
    for (int it = bid; it < DEPTH * NCH; it += G) {
        const int l = it / NCH, n0 = (it % NCH) * 256;
        const float* wp = p.in[I_WADA] + (size_t)l * DM * 6 * DM + n0 + lane * 4;
        f32x4 a0 = (f32x4){0.f, 0.f, 0.f, 0.f}, a1 = a0, a2 = a0;
        const int kb = wave * (DM / NWAVES);
#pragma unroll 16
        for (int k = kb; k < kb + DM / NWAVES; ++k) { const f32x4 w = *(const f32x4*)(wp + (size_t)k * 6 * DM); a0 += w * sc[k]; a1 += w * sc[DM + k]; a2 += w * sc[2 * DM + k]; }
        *(LAS f32x4*)(red2 + (wave * 3 + 0) * 256 + lane * 4) = a0; *(LAS f32x4*)(red2 + (wave * 3 + 1) * 256 + lane * 4) = a1; *(LAS f32x4*)(red2 + (wave * 3 + 2) * 256 + lane * 4) = a2;
        __syncthreads();
        for (int i = tid; i < 768; i += NTHREADS) { const int st = i >> 8, c = i & 255; float v = 0.f;
#pragma unroll
            for (int w = 0; w < NWAVES; ++w) v += red2[(w * 3 + st) * 256 + c];
            MOD[((size_t)l * 3 + st) * 6 * DM + n0 + c] = v + p.in[I_BADA][(size_t)l * 6 * DM + n0 + c]; }
        __syncthreads();
    }
}


__device__ __forceinline__ int row_first(int wave, int bid, int G) { const int gw = bid * NWAVES + wave; return gw < TL ? gw : -1; }
__device__ __forceinline__ int row_next(int r, int wave, int bid, int G, int nrows) {
    const int NGW = G * NWAVES;
    if (r < TL) { if (r + NGW < TL) return r + NGW; const int c = TL + wave * G + bid; return c < nrows ? c : -1; }
    return r + NGW < nrows ? r + NGW : -1;
}
__device__ __forceinline__ const float* xsrc(const Params& p, int l, int r) {
    return r < TL ? p.in[I_X] + (size_t)r * DM : p.in[I_CTX] + (size_t)(r - TL) * DM;
}

__device__ __forceinline__ void modulate_row(const float* xr, const float* mod, int sh_off, int sc_off, bf16_t* hb, int lane) {
    f32x4 xx[8];
#pragma unroll
    for (int j = 0; j < 8; ++j) xx[j] = *(const f32x4*)(xr + lane * 4 + 256 * j);
#pragma unroll
    for (int j = 0; j < 8; ++j) { const int c = lane * 4 + 256 * j;
        const f32x4 x = xx[j], sh = *(const f32x4*)(mod + sh_off + c), s = *(const f32x4*)(mod + sc_off + c);
        u32x2 o; o.x = pk2(x.x * (1.f + s.x) + sh.x, x.y * (1.f + s.y) + sh.y); o.y = pk2(x.z * (1.f + s.z) + sh.z, x.w * (1.f + s.w) + sh.w);
        *(u32x2*)(hb + c) = o; }
}
__device__ __forceinline__ void phase_modulate0(const Params& p, int lane, int wave, int bid, int G) {
    const int gw = bid * NWAVES + wave, NGW = G * NWAVES;
    const float* MOD = (const float*)(p.ws + WS_MOD); bf16_t* HB = (bf16_t*)(p.ws + WS_HB);
    for (int r = row_first(wave, bid, G); r >= 0; r = row_next(r, wave, bid, G, TA)) modulate_row(xsrc(p, 0, r), MOD + (size_t)(0 * 3 + row_stream(r)) * 6 * DM, 0, DM, HB + (size_t)r * DM, lane);
}

__device__ __forceinline__ void gemm_direct(const bf16_t* A, const bf16_t* Bt, float* C, int M, int N, int K, int ldc, int gw, int NGW, int lane) {
    const int nTn = N / 64, nItems = (M / 32) * nTn;
    const int fr = lane & 15, fq = lane >> 4;
    for (int it = gw; it < nItems; it += NGW) {
        const int mt = it / nTn, nt = it % nTn;
        const bf16_t* a0 = A + (size_t)(mt * 32 + fr) * K + fq * 8;
        const bf16_t* b0 = Bt + (size_t)(nt * 64 + fr) * K + fq * 8;
        f32x4 acc[2][4];
#pragma unroll
        for (int i = 0; i < 2; ++i)
#pragma unroll
            for (int j = 0; j < 4; ++j) acc[i][j] = (f32x4){0.f, 0.f, 0.f, 0.f};
#pragma unroll 2
        for (int k0 = 0; k0 < K; k0 += 32) {
            bf16x8 af[2], bfr[4];
#pragma unroll
            for (int i = 0; i < 2; ++i) af[i] = *(const bf16x8*)(a0 + (size_t)i * 16 * K + k0);
#pragma unroll
            for (int j = 0; j < 4; ++j) bfr[j] = *(const bf16x8*)(b0 + (size_t)j * 16 * K + k0);
#pragma unroll
            for (int i = 0; i < 2; ++i)
#pragma unroll
                for (int j = 0; j < 4; ++j) acc[i][j] = __builtin_amdgcn_mfma_f32_16x16x32_bf16(af[i], bfr[j], acc[i][j], 0, 0, 0);
        }
#pragma unroll
        for (int i = 0; i < 2; ++i)
#pragma unroll
            for (int j = 0; j < 4; ++j)
#pragma unroll
                for (int g = 0; g < 4; ++g) C[(size_t)(mt * 32 + i * 16 + fq * 4 + g) * ldc + nt * 64 + j * 16 + fr] = acc[i][j][g];
    }
}

__device__ __forceinline__ void phase_post_in(const Params& p, int l, int lane, int wave, int bid, int G) {
    const int gw = bid * NWAVES + wave, NGW = G * NWAVES;
    const bf16_t* P = (const bf16_t*)(p.ws + WS_P);
    bf16_t* QR = (bf16_t*)(p.ws + WS_QR); bf16_t* KR = (bf16_t*)(p.ws + WS_KR); bf16_t* VR = (bf16_t*)(p.ws + WS_ALF);
    bf16_t* MIX = (bf16_t*)(p.ws + WS_MIX);
    const float* cw = p.in[I_CONVW] + (size_t)l * 3 * 512;
    const int c8 = lane * 8, rh = lane >> 3, rf = (lane >> 2) & 1, rg = lane & 3, roff = rh * 128 + rf * 64 + rg * 8;
    float w0[8], w1[8], w2[8], invf[8];
#pragma unroll
    for (int e = 0; e < 8; ++e) { w0[e] = cw[c8 + e]; w1[e] = cw[512 + c8 + e]; w2[e] = cw[1024 + c8 + e]; invf[e] = __builtin_amdgcn_exp2f(-(float)(rg * 8 + e) * 0.4152410118609203f); }
    for (int r = row_first(wave, bid, G); r >= 0; r = row_next(r, wave, bid, G, TA)) {
        const bf16_t* pr = P + (size_t)r * INWP;
        int pos, len;
        if (r < TL) { pos = r % SEQ; len = SEQ; } else { pos = (r - TL) % CTXL; len = CTXL; }
        const bool hp = pos > 0, hn = pos < len - 1;
        const u32x4 z4 = (u32x4){0u, 0u, 0u, 0u};
        const u32x4 xC = *(const u32x4*)(pr + C_CC + c8), xX = *(const u32x4*)(pr + C_CX + c8), xB = *(const u32x4*)(pr + C_CB + c8);
        const u32x4 pC = hp ? *(const u32x4*)(pr - INWP + C_CC + c8) : z4, pX = hp ? *(const u32x4*)(pr - INWP + C_CX + c8) : z4;
        const u32x4 nC = hn ? *(const u32x4*)(pr + INWP + C_CC + c8) : z4, nX = hn ? *(const u32x4*)(pr + INWP + C_CX + c8) : z4;
        const u32x4 q1 = *(const u32x4*)(pr + C_SQ + roff), q2 = *(const u32x4*)(pr + C_SQ + roff + 32);
        u32x4 k1 = z4, k2 = z4, vv = z4;
        if (lane < 16) { k1 = *(const u32x4*)(pr + C_SK + roff); k2 = *(const u32x4*)(pr + C_SK + roff + 32); }
        if (lane < 32) vv = *(const u32x4*)(pr + C_SV + c8);
        { float fC[8], fX[8], fB[8], gC[8], gX[8], hC[8], hX[8], o[8];
          unpack8(xC, fC); unpack8(xX, fX); unpack8(xB, fB); unpack8(pC, gC); unpack8(pX, gX); unpack8(nC, hC); unpack8(nX, hX);
#pragma unroll
          for (int e = 0; e < 8; ++e) o[e] = fB[e] * (w0[e] * gC[e] * gX[e] + w1[e] * fC[e] * fX[e] + w2[e] * hC[e] * hX[e]);
          *(u32x4*)(MIX + (size_t)r * DM + c8) = pack8(o); }
        { float cs[8], sn[8];
#pragma unroll
          for (int e = 0; e < 8; ++e) { cs[e] = 1.f; sn[e] = 0.f; }
          if (r < TL) { const float pv = (float)(rf ? (pos % 64) : (pos / 64));
#pragma unroll
              for (int e = 0; e < 8; ++e) { sn[e] = __sinf(pv * invf[e]); cs[e] = __cosf(pv * invf[e]); } }
          float x1[8], x2[8], o1[8], o2[8];
          unpack8(q1, x1); unpack8(q2, x2);
#pragma unroll
          for (int e = 0; e < 8; ++e) { o1[e] = (x1[e] * cs[e] - x2[e] * sn[e]) * 0.08838834764831845f; o2[e] = (x2[e] * cs[e] + x1[e] * sn[e]) * 0.08838834764831845f; }
          *(u32x4*)(QR + (size_t)r * 1024 + roff) = pack8(o1); *(u32x4*)(QR + (size_t)r * 1024 + roff + 32) = pack8(o2);
          if (lane < 16) { unpack8(k1, x1); unpack8(k2, x2);
#pragma unroll
              for (int e = 0; e < 8; ++e) { o1[e] = x1[e] * cs[e] - x2[e] * sn[e]; o2[e] = x2[e] * cs[e] + x1[e] * sn[e]; }
              *(u32x4*)(KR + (size_t)r * 256 + roff) = pack8(o1); *(u32x4*)(KR + (size_t)r * 256 + roff + 32) = pack8(o2); }
          if (lane < 32) *(u32x4*)(VR + (size_t)r * 256 + c8) = vv; }
    }
}

#ifndef SWA_THR
#define SWA_THR 6.0f
#endif
constexpr int KP = 136, VP = 72;
constexpr int SWA_BUF = 64 * KP * 2 + 128 * VP * 2;
typedef short bf16x4 __attribute__((ext_vector_type(4)));
__device__ __forceinline__ void phase_mixers(const Params& p, int l, LAS unsigned char* lds, int tid, int lane, int wave, int bid, int G, int qsel = 0) {
    const bf16_t* QR = (const bf16_t*)(p.ws + WS_QR); const bf16_t* KR = (const bf16_t*)(p.ws + WS_KR); const bf16_t* VR = (const bf16_t*)(p.ws + WS_ALF);
    bf16_t* MIX = (bf16_t*)(p.ws + WS_MIX);
    const float* sinkp = p.in[I_SINK] + l * 8;
    const int fr = lane & 15, fq = lane >> 4, g = wave & 3, qh = wave >> 2;
    const int nItems = 512 + ((l < DEPTH - 1) ? 16 : 0);
    unsigned* qhead = (unsigned*)(p.ws + WS_CTL) + CW_QUEUE + 64 * (l + 4 * qsel);
    volatile LAS int* itw = (volatile LAS int*)(lds + MISC_OFF + 64);
    for (;;) {
        if (tid == 0) itw[0] = (int)__hip_atomic_fetch_add(qhead, 1u, __ATOMIC_RELAXED, __HIP_MEMORY_SCOPE_AGENT);
        __syncthreads();
        const int it = itw[0];
        __syncthreads();
        if (it >= nItems) break;
        int b, tile, hk, s0; size_t qrow0;
        if (it < 512) { b = it >> 8; tile = (it >> 1) & 127; hk = it & 1; s0 = 0; qrow0 = (size_t)b * SEQ + tile * 64; }
        else { const int c = it - 512; b = c >> 3; tile = (c >> 1) & 3; hk = c & 1; s0 = 5; qrow0 = (size_t)TL + b * CTXL + tile * 64; }
        const int n0 = tile * 64, hq = hk * 4 + g;
        bf16x8 qf[2][4];
#pragma unroll
        for (int qt = 0; qt < 2; ++qt)
#pragma unroll
            for (int ks = 0; ks < 4; ++ks) qf[qt][ks] = *(const bf16x8*)(QR + (qrow0 + qh * 32 + qt * 16 + fr) * 1024 + hq * 128 + ks * 32 + fq * 8);
        f32x4 O[2][8];
#pragma unroll
        for (int qt = 0; qt < 2; ++qt)
#pragma unroll
            for (int dt = 0; dt < 8; ++dt) O[qt][dt] = (f32x4){0.f, 0.f, 0.f, 0.f};
        float m[2], lsum[2];
        m[0] = m[1] = sinkp[hq]; lsum[0] = lsum[1] = (fq == 0) ? 1.f : 0.f;
        u32x4 kreg[2], vreg[2];
#define SWA_ROW(s, kk) ((s) < 5 ? (size_t)b * SEQ + (size_t)min(max(n0 - 128 + (s) * 64 + (kk), 0), SEQ - 1) : (size_t)TL + (size_t)b * CTXL + ((s) - 5) * 64 + (kk))
#define SWA_LOAD(s) do { _Pragma("unroll") for (int j = 0; j < 2; ++j) { const int v = tid + NTHREADS * j; \
            kreg[j] = *(const u32x4*)(KR + SWA_ROW(s, v >> 4) * 256 + hk * 128 + (v & 15) * 8); \
            vreg[j] = *(const u32x4*)(VR + SWA_ROW(s, tid & 63) * 256 + hk * 128 + ((tid >> 6) + 8 * j) * 8); } } while (0)
#define SWA_WRITE(buf) do { LAS bf16_t* Kd = (LAS bf16_t*)(lds + (buf) * SWA_BUF); LAS bf16_t* Vd = Kd + 64 * KP; \
            _Pragma("unroll") for (int j = 0; j < 2; ++j) { const int v = tid + NTHREADS * j; *(LAS u32x4*)(Kd + (v >> 4) * KP + (v & 15) * 8) = kreg[j]; \
                const int d0 = ((tid >> 6) + 8 * j) * 8, key = tid & 63; const u32x4 w = vreg[j]; \
                Vd[(d0 + 0) * VP + key] = (bf16_t)(w.x & 0xffffu); Vd[(d0 + 1) * VP + key] = (bf16_t)(w.x >> 16); Vd[(d0 + 2) * VP + key] = (bf16_t)(w.y & 0xffffu); Vd[(d0 + 3) * VP + key] = (bf16_t)(w.y >> 16); \
                Vd[(d0 + 4) * VP + key] = (bf16_t)(w.z & 0xffffu); Vd[(d0 + 5) * VP + key] = (bf16_t)(w.z >> 16); Vd[(d0 + 6) * VP + key] = (bf16_t)(w.w & 0xffffu); Vd[(d0 + 7) * VP + key] = (bf16_t)(w.w >> 16); } } while (0)
        SWA_LOAD(s0); SWA_WRITE(0);
        __syncthreads();
#pragma unroll 1
        for (int s = s0; s < 9; ++s) {
            const int buf = (s - s0) & 1;
            if (s + 1 < 9) SWA_LOAD(s + 1);
            const LAS bf16_t* Ks = (const LAS bf16_t*)(lds + buf * SWA_BUF); const LAS bf16_t* Vs = Ks + 64 * KP;
#pragma unroll 1
            for (int sc = 0; sc < 2; ++sc) {
                f32x4 sT[2][2];
#pragma unroll
                for (int qt = 0; qt < 2; ++qt) { sT[qt][0] = (f32x4){0.f, 0.f, 0.f, 0.f}; sT[qt][1] = (f32x4){0.f, 0.f, 0.f, 0.f}; }
#pragma unroll
                for (int ks = 0; ks < 4; ++ks)
#pragma unroll
                    for (int kt = 0; kt < 2; ++kt) { const bf16x8 ka = *(const LAS bf16x8*)(Ks + (sc * 32 + kt * 16 + fr) * KP + ks * 32 + fq * 8);
#pragma unroll
                        for (int qt = 0; qt < 2; ++qt) sT[qt][kt] = __builtin_amdgcn_mfma_f32_16x16x32_bf16(ka, qf[qt][ks], sT[qt][kt], 0, 0, 0); }
                bf16x8 pb[2];
                float cm[2];
#pragma unroll
                for (int qt = 0; qt < 2; ++qt) {
                    if (s < 5) {
                        const int qpos = n0 + qh * 32 + qt * 16 + fr;
#pragma unroll
                        for (int kt = 0; kt < 2; ++kt)
#pragma unroll
                            for (int e = 0; e < 4; ++e) { const int kpos = n0 - 128 + s * 64 + sc * 32 + kt * 16 + fq * 4 + e; const int dlt = qpos - kpos;
                                const bool ok = kpos >= 0 && kpos < SEQ && dlt <= 128 && dlt >= -128; sT[qt][kt][e] = ok ? sT[qt][kt][e] : -1e30f; } }
                    cm[qt] = fmaxf(fmaxf(fmaxf(sT[qt][0][0], sT[qt][0][1]), fmaxf(sT[qt][0][2], sT[qt][0][3])), fmaxf(fmaxf(sT[qt][1][0], sT[qt][1][1]), fmaxf(sT[qt][1][2], sT[qt][1][3])));
                }
                if (__any((cm[0] > m[0] + SWA_THR) || (cm[1] > m[1] + SWA_THR))) {
#pragma unroll
                    for (int qt = 0; qt < 2; ++qt) { float c = cm[qt]; c = fmaxf(c, __shfl_xor(c, 16)); c = fmaxf(c, __shfl_xor(c, 32));
                        const float mn = fmaxf(m[qt], c), scl = __expf(m[qt] - mn); m[qt] = mn; lsum[qt] *= scl;
#pragma unroll
                        for (int dt = 0; dt < 8; ++dt) O[qt][dt] = O[qt][dt] * scl; }
                }
#pragma unroll
                for (int qt = 0; qt < 2; ++qt) {
                    float pe[8]; float ps = 0.f;
#pragma unroll
                    for (int kt = 0; kt < 2; ++kt)
#pragma unroll
                        for (int e = 0; e < 4; ++e) { pe[kt * 4 + e] = __expf(sT[qt][kt][e] - m[qt]); ps += pe[kt * 4 + e]; }
                    lsum[qt] += ps;
                    u32x4 pw; pw.x = pk2(pe[0], pe[1]); pw.y = pk2(pe[2], pe[3]); pw.z = pk2(pe[4], pe[5]); pw.w = pk2(pe[6], pe[7]);
                    pb[qt] = __builtin_bit_cast(bf16x8, pw);
                }
#pragma unroll
                for (int dt = 0; dt < 8; ++dt) {
                    const bf16x4 v0 = *(const LAS bf16x4*)(Vs + (dt * 16 + fr) * VP + sc * 32 + 4 * fq), v1 = *(const LAS bf16x4*)(Vs + (dt * 16 + fr) * VP + sc * 32 + 16 + 4 * fq);
                    const bf16x8 va = __builtin_shufflevector(v0, v1, 0, 1, 2, 3, 4, 5, 6, 7);
#pragma unroll
                    for (int qt = 0; qt < 2; ++qt) O[qt][dt] = __builtin_amdgcn_mfma_f32_16x16x32_bf16(va, pb[qt], O[qt][dt], 0, 0, 0);
                }
            }
            if (s + 1 < 9) SWA_WRITE(buf ^ 1);
            __syncthreads();
        }
#undef SWA_ROW
#undef SWA_LOAD
#undef SWA_WRITE
#pragma unroll
        for (int qt = 0; qt < 2; ++qt) {
            float lt = lsum[qt]; lt += __shfl_xor(lt, 16); lt += __shfl_xor(lt, 32);
            const float inv = 1.0f / lt;
            bf16_t* o = MIX + (qrow0 + qh * 32 + qt * 16 + fr) * DM + 1024 + hq * 128 + fq * 4;
#pragma unroll
            for (int dt = 0; dt < 8; ++dt) { u32x2 w; w.x = pk2(O[qt][dt][0] * inv, O[qt][dt][1] * inv); w.y = pk2(O[qt][dt][2] * inv, O[qt][dt][3] * inv); *(u32x2*)(o + dt * 16) = w; }
        }
    }
}

__device__ __forceinline__ int chunk_row0(int cid) { return cid < 256 ? (cid >> 7) * SEQ + (cid & 127) * 64 : TL + ((cid - 256) >> 2) * CTXL + ((cid - 256) & 3) * 64; }
constexpr int GP = 72;

constexpr int LTP = 65;
__device__ __forceinline__ void gla_g1(const Params& p, int l, LAS unsigned char* lds, int tid, int lane, int wave, int bid, int G) {
    LAS float* LTf = (LAS float*)lds; LAS float* LTb = LTf + 64 * LTP;
    LAS bf16_t* KTf = (LAS bf16_t*)(lds + 2 * 64 * LTP * 4); LAS bf16_t* KTb = KTf + 64 * GP;
    LAS bf16_t* VT = KTb + 64 * GP;
    const bf16_t* P = (const bf16_t*)(p.ws + WS_P);
    float* BF = (float*)(p.ws + WS_OF); float* BB = (float*)(p.ws + WS_OB);
    float* DELTA = (float*)(p.ws + WS_DELTA); float* DEC = (float*)(p.ws + WS_DEC);
    const float* w2 = p.in[I_GW2] + (size_t)l * 2 * 16 * 256; const float* b2 = p.in[I_GB2] + (size_t)l * 2 * 256;
    const int fr = lane & 15, fq = lane >> 4, ti = tid >> 3, tk0 = (tid & 7) * 8;
    float wr[2][16], br[2];
    const bool fixed_h = (G & 3) == 0;
#define G1_LOADW(hh_) do { _Pragma("unroll") for (int d = 0; d < 2; ++d) { br[d] = b2[d * 256 + (hh_) * 64 + lane]; \
        _Pragma("unroll") for (int q = 0; q < 16; ++q) wr[d][q] = w2[(d * 16 + q) * 256 + (hh_) * 64 + lane]; } } while (0)
    if (fixed_h) G1_LOADW(bid & 3);
    u32x4 kraw, vraw[2], lrr[2][4];
#define G1_LOADX(item_) do { const int cid_ = (item_) >> 2, h_ = (item_) & 3, row0_ = chunk_row0(cid_); \
        kraw = *(const u32x4*)(P + (size_t)(row0_ + ti) * INWP + C_GK + h_ * 64 + tk0); \
        _Pragma("unroll") for (int j = 0; j < 2; ++j) { const int vi = tid + NTHREADS * j; vraw[j] = *(const u32x4*)(P + (size_t)(row0_ + (vi >> 4)) * INWP + C_GV + h_ * 128 + (vi & 15) * 8); } \
        _Pragma("unroll") for (int jj = 0; jj < 2; ++jj) _Pragma("unroll") for (int c = 0; c < 4; ++c) lrr[jj][c] = *(const u32x4*)(P + (size_t)(row0_ + wave + 8 * jj) * INWP + C_LRF + c * 8); } while (0)
    if (bid < GLA_ITEMS) G1_LOADX(bid);
    for (int item = bid; item < GLA_ITEMS; item += G) {
        const int cid = item >> 2, h = item & 3, row0 = chunk_row0(cid);
        const u32x4 kraw_c = kraw; u32x4 vraw_c[2] = {vraw[0], vraw[1]};
        {
            if (!fixed_h) G1_LOADW(h);
#pragma unroll
            for (int jj = 0; jj < 8; ++jj) { const int i = wave + 8 * jj;
                float lf[4][8];
                if (jj < 2) {
#pragma unroll
                    for (int c = 0; c < 4; ++c) unpack8(lrr[jj][c], lf[c]);
                } else { const bf16_t* lrp = P + (size_t)(row0 + i) * INWP + C_LRF;
#pragma unroll
                    for (int c = 0; c < 4; ++c) unpack8(*(const u32x4*)(lrp + c * 8), lf[c]); }
#pragma unroll
                for (int d = 0; d < 2; ++d) { float z = br[d];
#pragma unroll
                    for (int q = 0; q < 16; ++q) z += lf[d * 2 + (q >> 3)][q & 7] * wr[d][q];
                    (d ? LTb : LTf)[lane * LTP + i] = log_sigmoid_f(z) * (1.0f / 16.0f); } }
        }
        if (item + G < GLA_ITEMS) G1_LOADX(item + G);
        __syncthreads();
#pragma unroll 2
        for (int kk = 0; kk < 8; ++kk) { const int k = wave * 8 + kk;
            float xf = LTf[k * LTP + lane], xb = LTb[k * LTP + lane];
            float pf = xf, pb = xb;
#pragma unroll
            for (int o = 1; o < 64; o <<= 1) { const float tf = __shfl_up(pf, o), tb = __shfl_up(pb, o); if (lane >= o) { pf += tf; pb += tb; } }
            const float totb = __shfl(pb, 63);
            LTf[k * LTP + lane] = pf; LTb[k * LTP + lane] = totb - pb + xb; }
        __syncthreads();
        { float kv[8]; unpack8(kraw_c, kv);
          float bfv[8], bbv[8];
#pragma unroll
          for (int e = 0; e < 8; ++e) { const int k = tk0 + e; bfv[e] = LTf[k * LTP + ti]; bbv[e] = LTb[k * LTP + ti];
              KTf[k * GP + ti] = (bf16_t)f2bf(kv[e] * __expf(LTf[k * LTP + 63] - bfv[e]));
              KTb[k * GP + ti] = (bf16_t)f2bf(kv[e] * __expf(LTb[k * LTP] - bbv[e])); }
          float* bg = BF + (size_t)(row0 + ti) * 256 + h * 64 + tk0; *(f32x4*)bg = (f32x4){bfv[0], bfv[1], bfv[2], bfv[3]}; *(f32x4*)(bg + 4) = (f32x4){bfv[4], bfv[5], bfv[6], bfv[7]};
          bg = BB + (size_t)(row0 + ti) * 256 + h * 64 + tk0; *(f32x4*)bg = (f32x4){bbv[0], bbv[1], bbv[2], bbv[3]}; *(f32x4*)(bg + 4) = (f32x4){bbv[4], bbv[5], bbv[6], bbv[7]};
#pragma unroll
          for (int j = 0; j < 2; ++j) { const int vi = tid + NTHREADS * j, i = vi >> 4, v0 = (vi & 15) * 8; const u32x4 w = vraw_c[j];
              VT[(v0 + 0) * GP + i] = (bf16_t)(w.x & 0xffffu); VT[(v0 + 1) * GP + i] = (bf16_t)(w.x >> 16); VT[(v0 + 2) * GP + i] = (bf16_t)(w.y & 0xffffu); VT[(v0 + 3) * GP + i] = (bf16_t)(w.y >> 16);
              VT[(v0 + 4) * GP + i] = (bf16_t)(w.z & 0xffffu); VT[(v0 + 5) * GP + i] = (bf16_t)(w.z >> 16); VT[(v0 + 6) * GP + i] = (bf16_t)(w.w & 0xffffu); VT[(v0 + 7) * GP + i] = (bf16_t)(w.w >> 16); }
          if (tid < 128) { const int dir = tid >> 6, k = tid & 63; DEC[((size_t)item * 2 + dir) * 64 + k] = __expf(dir ? LTb[k * LTP] : LTf[k * LTP + 63]); } }
        __syncthreads();
        { const int dir = wave >> 2, vq = wave & 3; const LAS bf16_t* KT = dir ? KTb : KTf;
            f32x4 acc[2][4];
#pragma unroll
            for (int a = 0; a < 2; ++a)
#pragma unroll
                for (int b = 0; b < 4; ++b) acc[a][b] = (f32x4){0.f, 0.f, 0.f, 0.f};
#pragma unroll
            for (int ks = 0; ks < 2; ++ks) { bf16x8 af[2], bfr[4];
#pragma unroll
                for (int a = 0; a < 2; ++a) af[a] = *(const LAS bf16x8*)(VT + ((vq * 2 + a) * 16 + fr) * GP + ks * 32 + fq * 8);
#pragma unroll
                for (int b = 0; b < 4; ++b) bfr[b] = *(const LAS bf16x8*)(KT + (b * 16 + fr) * GP + ks * 32 + fq * 8);
#pragma unroll
                for (int a = 0; a < 2; ++a)
#pragma unroll
                    for (int b = 0; b < 4; ++b) acc[a][b] = __builtin_amdgcn_mfma_f32_16x16x32_bf16(af[a], bfr[b], acc[a][b], 0, 0, 0); }
            float* dst = DELTA + ((size_t)item * 2 + dir) * 8192;
#pragma unroll
            for (int a = 0; a < 2; ++a)
#pragma unroll
                for (int b = 0; b < 4; ++b)
#pragma unroll
                    for (int g = 0; g < 4; ++g) dst[((vq * 2 + a) * 16 + fq * 4 + g) * 64 + b * 16 + fr] = acc[a][b][g]; }
        __syncthreads();
    }
}

#undef G1_LOADW
#undef G1_LOADX
__device__ __forceinline__ void gla_g2(const Params& p, int tid, int bid, int G) {
    const float* DELTA = (const float*)(p.ws + WS_DELTA); const float* DEC = (const float*)(p.ws + WS_DEC); bf16_t* SST = (bf16_t*)(p.ws + WS_SST);
    for (int u = bid; u < 64; u += G) {
        const int s = u >> 2, dir = s >> 3, b = (s >> 2) & 1, h = s & 3, off = ((u & 3) * NTHREADS + tid) * 4, k0 = off & 63;
        f32x4 S = (f32x4){0.f, 0.f, 0.f, 0.f};
#pragma unroll 1
        for (int st = 0; st < 132; st += 12) {
            f32x4 d[12], dc[12]; size_t base[12];
#pragma unroll
            for (int q = 0; q < 12; ++q) { const int t = st + q;
                const int cid = t < 4 ? 256 + b * 4 + (dir ? 3 - t : t) : b * 128 + (dir ? 127 - (t - 4) : (t - 4));
                const size_t it2 = (size_t)(cid * 4 + h) * 2 + dir; base[q] = it2 * 8192 + off;
                d[q] = *(const f32x4*)(DELTA + base[q]); dc[q] = *(const f32x4*)(DEC + it2 * 64 + k0); }
#pragma unroll
            for (int q = 0; q < 12; ++q) { u32x2 o; o.x = pk2(S.x, S.y); o.y = pk2(S.z, S.w); *(u32x2*)(SST + base[q]) = o; S = dc[q] * S + d[q]; }
        }
    }
}

__device__ __forceinline__ void gla_g3(const Params& p, int l, LAS unsigned char* lds, int tid, int lane, int wave, int bid, int G, unsigned* qhead3 = nullptr) {
    LAS bf16_t* QEf = (LAS bf16_t*)lds; LAS bf16_t* QEb = QEf + 64 * GP; LAS bf16_t* KEf = QEb + 64 * GP; LAS bf16_t* KEb = KEf + 64 * GP;
    LAS bf16_t* VT = KEb + 64 * GP;
    LAS bf16_t* ATT = VT + 128 * GP + wave * (16 * GP);
    LAS float* RS = (LAS float*)(lds + 2 * (4 * 64 * GP + 128 * GP + 8 * 16 * GP));
    const bf16_t* P = (const bf16_t*)(p.ws + WS_P);
    const float* BF = (const float*)(p.ws + WS_OF); const float* BB = (const float*)(p.ws + WS_OB);
    const bf16_t* SST = (const bf16_t*)(p.ws + WS_SST); bf16_t* MIX = (bf16_t*)(p.ws + WS_MIX);
    const float* nw = p.in[I_GNORM] + l * 128;
    const int fr = lane & 15, fq = lane >> 4, it = wave >> 1, vh = wave & 1, ti = tid >> 3, tk0 = (tid & 7) * 8;
    const int n_items = (l < DEPTH - 1) ? GLA_ITEMS : 256 * 4;
    volatile LAS int* itw3 = (volatile LAS int*)(lds + MISC_OFF + 64);
    for (int item = bid;; item += G) {
        if (qhead3) {
            if (tid == 0) itw3[0] = (int)__hip_atomic_fetch_add(qhead3, 1u, __ATOMIC_RELAXED, __HIP_MEMORY_SCOPE_AGENT);
            __syncthreads(); item = itw3[0]; __syncthreads(); }
        if (item >= n_items) break;
        const int cid = item >> 2, h = item & 3, row0 = chunk_row0(cid);
        {
            const size_t r = (size_t)(row0 + ti);
            const u32x4 qraw = *(const u32x4*)(P + r * INWP + C_GQ + h * 64 + tk0), kraw = *(const u32x4*)(P + r * INWP + C_GK + h * 64 + tk0);
            const f32x4 f0 = *(const f32x4*)(BF + r * 256 + h * 64 + tk0), f1 = *(const f32x4*)(BF + r * 256 + h * 64 + tk0 + 4);
            const f32x4 b0 = *(const f32x4*)(BB + r * 256 + h * 64 + tk0), b1 = *(const f32x4*)(BB + r * 256 + h * 64 + tk0 + 4);
            u32x4 vraw[2];
#pragma unroll
            for (int j = 0; j < 2; ++j) { const int vi = tid + NTHREADS * j; vraw[j] = *(const u32x4*)(P + (size_t)(row0 + (vi >> 4)) * INWP + C_GV + h * 128 + (vi & 15) * 8); }
            float q[8], kk[8]; unpack8(qraw, q); unpack8(kraw, kk);
            const float bf[8] = {f0.x, f0.y, f0.z, f0.w, f1.x, f1.y, f1.z, f1.w}, bb[8] = {b0.x, b0.y, b0.z, b0.w, b1.x, b1.y, b1.z, b1.w};
            float o0[8], o1[8], o2[8], o3[8];
#pragma unroll
            for (int e = 0; e < 8; ++e) { const float ef = __expf(bf[e]), eb = __expf(bb[e]); const float qs = q[e] * 0.125f;
                o0[e] = qs * ef; o1[e] = kk[e] / ef; o2[e] = qs * eb; o3[e] = kk[e] / eb; }
            *(LAS u32x4*)(QEf + ti * GP + tk0) = pack8(o0); *(LAS u32x4*)(KEf + ti * GP + tk0) = pack8(o1); *(LAS u32x4*)(QEb + ti * GP + tk0) = pack8(o2); *(LAS u32x4*)(KEb + ti * GP + tk0) = pack8(o3);
#pragma unroll
            for (int j = 0; j < 2; ++j) { const int vi = tid + NTHREADS * j, i = vi >> 4, v0 = (vi & 15) * 8; const u32x4 w = vraw[j];
                VT[(v0 + 0) * GP + i] = (bf16_t)(w.x & 0xffffu); VT[(v0 + 1) * GP + i] = (bf16_t)(w.x >> 16); VT[(v0 + 2) * GP + i] = (bf16_t)(w.y & 0xffffu); VT[(v0 + 3) * GP + i] = (bf16_t)(w.y >> 16);
                VT[(v0 + 4) * GP + i] = (bf16_t)(w.z & 0xffffu); VT[(v0 + 5) * GP + i] = (bf16_t)(w.z >> 16); VT[(v0 + 6) * GP + i] = (bf16_t)(w.w & 0xffffu); VT[(v0 + 7) * GP + i] = (bf16_t)(w.w >> 16); }
        }
        float gt[4][4];
#pragma unroll
        for (int g = 0; g < 4; ++g)
#pragma unroll
            for (int vt = 0; vt < 4; ++vt) gt[g][vt] = bflo((unsigned)P[(size_t)(row0 + it * 16 + fq * 4 + g) * INWP + C_GG + h * 128 + (vh * 4 + vt) * 16 + fr]);
        __syncthreads();
        f32x4 acc[4];
#pragma unroll
        for (int vt = 0; vt < 4; ++vt) acc[vt] = (f32x4){0.f, 0.f, 0.f, 0.f};
#pragma unroll
        for (int dir = 0; dir < 2; ++dir) {
            const LAS bf16_t* QE = dir ? QEb : QEf; const LAS bf16_t* KE = dir ? KEb : KEf;
            bf16x8 qa[2], sbf[2][4];
            const bf16_t* Sg = SST + ((size_t)item * 2 + dir) * 8192;
#pragma unroll
            for (int ks = 0; ks < 2; ++ks)
#pragma unroll
                for (int vt = 0; vt < 4; ++vt) sbf[ks][vt] = *(const bf16x8*)(Sg + ((vh * 4 + vt) * 16 + fr) * 64 + ks * 32 + fq * 8);
#pragma unroll
            for (int ks = 0; ks < 2; ++ks) qa[ks] = *(const LAS bf16x8*)(QE + (it * 16 + fr) * GP + ks * 32 + fq * 8);
#pragma unroll
            for (int jt = 0; jt < 4; ++jt) { f32x4 a = (f32x4){0.f, 0.f, 0.f, 0.f};
#pragma unroll
                for (int ks = 0; ks < 2; ++ks) { const bf16x8 kb = *(const LAS bf16x8*)(KE + (jt * 16 + fr) * GP + ks * 32 + fq * 8); a = __builtin_amdgcn_mfma_f32_16x16x32_bf16(qa[ks], kb, a, 0, 0, 0); }
#pragma unroll
                for (int g = 0; g < 4; ++g) { const int ii = it * 16 + fq * 4 + g, jj = jt * 16 + fr; const bool keep = dir ? (jj >= ii) : (jj <= ii);
                    ATT[(fq * 4 + g) * GP + jt * 16 + fr] = (bf16_t)f2bf(keep ? a[g] : 0.f); } }
            LDS_FENCE();
#pragma unroll
            for (int ks = 0; ks < 2; ++ks) { const bf16x8 aa = *(const LAS bf16x8*)(ATT + fr * GP + ks * 32 + fq * 8);
#pragma unroll
                for (int vt = 0; vt < 4; ++vt) { const int v = (vh * 4 + vt) * 16 + fr;
                    const bf16x8 vb = *(const LAS bf16x8*)(VT + v * GP + ks * 32 + fq * 8);
                    acc[vt] = __builtin_amdgcn_mfma_f32_16x16x32_bf16(aa, vb, acc[vt], 0, 0, 0);
                    acc[vt] = __builtin_amdgcn_mfma_f32_16x16x32_bf16(qa[ks], sbf[ks][vt], acc[vt], 0, 0, 0); } }
            LDS_FENCE();
        }
        float ss[4];
#pragma unroll
        for (int g = 0; g < 4; ++g) { float t = 0.f;
#pragma unroll
            for (int vt = 0; vt < 4; ++vt) t += acc[vt][g] * acc[vt][g];
            t += __shfl_xor(t, 1); t += __shfl_xor(t, 2); t += __shfl_xor(t, 4); t += __shfl_xor(t, 8); ss[g] = t; }
        if (fr == 0) {
#pragma unroll
            for (int g = 0; g < 4; ++g) RS[(it * 16 + fq * 4 + g) * 2 + vh] = ss[g]; }
        __syncthreads();
#pragma unroll
        for (int g = 0; g < 4; ++g) { const int i = it * 16 + fq * 4 + g; const float tot = RS[i * 2] + RS[i * 2 + 1];
            const float rs = 1.0f / sqrtf(tot * (1.0f / 128.0f) + LN_EPS); const size_t r = (size_t)(row0 + i);
#pragma unroll
            for (int vt = 0; vt < 4; ++vt) { const int v = (vh * 4 + vt) * 16 + fr;
                MIX[r * DM + 512 + h * 128 + v] = (bf16_t)f2bf(acc[vt][g] * rs * nw[v] * silu_f(gt[g][vt])); } }
        __syncthreads();
    }
}

__device__ __forceinline__ void ln_row(f32x4 (&v)[8], const float* lg, const float* lb, int lane) {
    float s = 0.f;
#pragma unroll
    for (int j = 0; j < 8; ++j) s += (v[j].x + v[j].y) + (v[j].z + v[j].w);
    const float mean = wave_sum(s) * (1.0f / DM);
    float s2 = 0.f;
#pragma unroll
    for (int j = 0; j < 8; ++j) { v[j] = v[j] - mean; s2 += (v[j].x * v[j].x + v[j].y * v[j].y) + (v[j].z * v[j].z + v[j].w * v[j].w); }
    const float rstd = 1.0f / sqrtf(wave_sum(s2) * (1.0f / DM) + LN_EPS);
#pragma unroll
    for (int j = 0; j < 8; ++j) { const int c = lane * 4 + 256 * j; const f32x4 g = *(const f32x4*)(lg + c), b = *(const f32x4*)(lb + c); v[j] = v[j] * rstd * g + b; }
}

__device__ __forceinline__ void phase_ln1(const Params& p, int l, LAS unsigned char* lds, int tid, int lane, int wave, int bid, int G) {
    const int gw = bid * NWAVES + wave, NGW = G * NWAVES;
    const float* MOD = (const float*)(p.ws + WS_MOD); const bf16_t* Y = (const bf16_t*)(p.ws + WS_Y); const float* YP = (const float*)(p.ws + WS_YPART);
    bf16_t* XM = (bf16_t*)(p.ws + WS_XM); bf16_t* HB = (bf16_t*)(p.ws + WS_HB);
    LAS float* VEC = (LAS float*)lds;
    for (int i = tid; i < 11 * DM / 4; i += NTHREADS) { const int vi = i / (DM / 4), c = (i % (DM / 4)) * 4;
        const float* src = vi < 9 ? MOD + (size_t)(l * 3 + (vi % 3)) * 6 * DM + (2 + vi / 3) * DM + c : (vi == 9 ? p.in[I_LNG] : p.in[I_LNB]) + (size_t)(l * 2 + 0) * DM + c;
        *(LAS f32x4*)(VEC + vi * DM + c) = *(const f32x4*)src; }
    __syncthreads();
    f32x4 xn[8]; u32x2 yn[8];
#define LN1_LOAD(rr) do { if (l == 0) { const float* xr_ = xsrc(p, 0, (rr)); _Pragma("unroll") for (int j = 0; j < 8; ++j) xn[j] = *(const f32x4*)(xr_ + lane * 4 + 256 * j); } \
        else { const bf16_t* xb_ = (const bf16_t*)(p.ws + WS_XL) + (size_t)(rr) * DM; _Pragma("unroll") for (int j = 0; j < 8; ++j) { const u32x2 w_ = *(const u32x2*)(xb_ + lane * 4 + 256 * j); xn[j] = (f32x4){bflo(w_.x), bfhi(w_.x), bflo(w_.y), bfhi(w_.y)}; } } \
        if ((rr) < TL) { _Pragma("unroll") for (int j = 0; j < 8; ++j) yn[j] = *(const u32x2*)(Y + (size_t)(rr) * DM + lane * 4 + 256 * j); } } while (0)
    if (row_first(wave, bid, G) >= 0) LN1_LOAD(row_first(wave, bid, G));
    for (int r = row_first(wave, bid, G); r >= 0; r = row_next(r, wave, bid, G, TA)) {
        const int st = row_stream(r);
        f32x4 v[8], yy[8];
#pragma unroll
        for (int j = 0; j < 8; ++j) v[j] = xn[j];
        if (r < TL) {
#pragma unroll
            for (int j = 0; j < 8; ++j) yy[j] = (f32x4){bflo(yn[j].x), bfhi(yn[j].x), bflo(yn[j].y), bfhi(yn[j].y)};
        } else {
#pragma unroll
            for (int j = 0; j < 8; j += 2) { f32x4 pp[2][8];
#pragma unroll
                for (int jj = 0; jj < 2; ++jj)
#pragma unroll
                    for (int ks = 0; ks < 8; ++ks) pp[jj][ks] = *(const f32x4*)(YP + ((size_t)ks * 512 + (r - TL)) * DM + lane * 4 + 256 * (j + jj));
#pragma unroll
                for (int jj = 0; jj < 2; ++jj) yy[j + jj] = ((pp[jj][0] + pp[jj][1]) + (pp[jj][2] + pp[jj][3])) + ((pp[jj][4] + pp[jj][5]) + (pp[jj][6] + pp[jj][7])); }
        }
        { const int rn = row_next(r, wave, bid, G, TA); if (rn >= 0) LN1_LOAD(rn); }
#pragma unroll
        for (int j = 0; j < 8; ++j) { const f32x4 g = *(const LAS f32x4*)(VEC + st * DM + lane * 4 + 256 * j); v[j] = v[j] * DN_ALPHA + g * yy[j]; }
        float s = 0.f;
#pragma unroll
        for (int j = 0; j < 8; ++j) s += (v[j].x + v[j].y) + (v[j].z + v[j].w);
        const float mean = wave_sum(s) * (1.0f / DM);
        float s2 = 0.f;
#pragma unroll
        for (int j = 0; j < 8; ++j) { v[j] = v[j] - mean; s2 += (v[j].x * v[j].x + v[j].y * v[j].y) + (v[j].z * v[j].z + v[j].w * v[j].w); }
        const float rstd = 1.0f / sqrtf(wave_sum(s2) * (1.0f / DM) + LN_EPS);
#pragma unroll
        for (int j = 0; j < 8; ++j) { const int c = lane * 4 + 256 * j;
            const f32x4 g = *(const LAS f32x4*)(VEC + 9 * DM + c), b = *(const LAS f32x4*)(VEC + 10 * DM + c), sh = *(const LAS f32x4*)(VEC + (3 + st) * DM + c), sc = *(const LAS f32x4*)(VEC + (6 + st) * DM + c);
            const f32x4 o = v[j] * rstd * g + b;
            { u32x2 xw; xw.x = pk2(o.x, o.y); xw.y = pk2(o.z, o.w); *(u32x2*)(XM + (size_t)r * DM + c) = xw; }
            u32x2 w; w.x = pk2(o.x * (1.f + sc.x) + sh.x, o.y * (1.f + sc.y) + sh.y); w.y = pk2(o.z * (1.f + sc.z) + sh.z, o.w * (1.f + sc.w) + sh.w);
            *(u32x2*)(HB + (size_t)r * DM + c) = w; }
    }
#undef LN1_LOAD
}

constexpr int SKP = 136;
__device__ __forceinline__ unsigned f2key(float f) { const unsigned u = __builtin_bit_cast(unsigned, f); return u ^ ((u >> 31) ? 0xFFFFFFFFu : 0x80000000u); }
__device__ __forceinline__ float key2f(unsigned k) { const unsigned u = (k >> 31) ? (k ^ 0x80000000u) : ~k; return __builtin_bit_cast(float, u); }
__device__ __forceinline__ unsigned row16_max_u32(unsigned k) {
    unsigned o;
    o = (unsigned)__builtin_amdgcn_update_dpp(0, (int)k, 0xB1, 0xF, 0xF, false); k = k > o ? k : o;
    o = (unsigned)__builtin_amdgcn_update_dpp(0, (int)k, 0x4E, 0xF, 0xF, false); k = k > o ? k : o;
    o = (unsigned)__builtin_amdgcn_update_dpp(0, (int)k, 0x141, 0xF, 0xF, false); k = k > o ? k : o;
    o = (unsigned)__builtin_amdgcn_update_dpp(0, (int)k, 0x140, 0xF, 0xF, false); k = k > o ? k : o;
    return k;
}
__device__ __forceinline__ void peer_retrieve(const Params& p, int l, LAS unsigned char* lds, int tid, int lane, int wave, int bid, int G, int ntok) {
    LAS bf16_t* SK = (LAS bf16_t*)lds;
    const bf16_t* SUBB = (const bf16_t*)(p.ws + WS_SUBB) + (size_t)l * 2 * 128 * 128;
#pragma unroll 1
    for (int j = 0; j < 8; ++j) { const int vv = tid + NTHREADS * j, row = vv >> 4, c = vv & 15; *(LAS u32x4*)(SK + row * SKP + c * 8) = *(const u32x4*)(SUBB + row * 128 + c * 8); }
    __syncthreads();
    const bf16_t* QP = (const bf16_t*)(p.ws + WS_QP); const float* QPP = (const float*)(p.ws + WS_QPART);
    int* EIDX = (int*)(p.ws + WS_EIDX); float* EGATE = (float*)(p.ws + WS_EGATE);
    const int gw = bid * NWAVES + wave, NGW = G * NWAVES, fr = lane & 15, fq = lane >> 4, gbase = lane & 48;
    const int nitems = (ntok / 16) * 8;
    const int nmain = nitems / NGW, nfull = nmain * NGW, nextra = (wave == 0 && nfull + bid < nitems) ? (nitems - nfull - bid + G - 1) / G : 0;
    for (int ri = 0; ri < nmain + nextra; ++ri) {
        const int item = ri < nmain ? gw + NGW * ri : nfull + bid + (ri - nmain) * G;
        const int tile = item >> 3, h = item & 7;
        unsigned tkp[2][4];
        bf16x8 afr[2][4];
        if (tile * 16 < TL) {
#pragma unroll
            for (int pp = 0; pp < 2; ++pp)
#pragma unroll
                for (int ks = 0; ks < 4; ++ks) afr[pp][ks] = *(const bf16x8*)(QP + (size_t)(tile * 16 + fr) * DM + h * 256 + pp * 128 + ks * 32 + fq * 8);
        } else {
#pragma unroll
            for (int pp = 0; pp < 2; ++pp)
#pragma unroll
                for (int ks = 0; ks < 4; ++ks) { const float* qp = QPP + (size_t)(tile * 16 - TL + fr) * DM + h * 256 + pp * 128 + ks * 32 + fq * 8;
                    f32x4 pa[8], pb[8];
#pragma unroll
                    for (int sl = 0; sl < 8; ++sl) { pa[sl] = *(const f32x4*)(qp + (size_t)sl * 512 * DM); pb[sl] = *(const f32x4*)(qp + (size_t)sl * 512 * DM + 4); }
                    const f32x4 s0 = ((pa[0] + pa[1]) + (pa[2] + pa[3])) + ((pa[4] + pa[5]) + (pa[6] + pa[7])), s1 = ((pb[0] + pb[1]) + (pb[2] + pb[3])) + ((pb[4] + pb[5]) + (pb[6] + pb[7]));
                    u32x4 w; w.x = pk2(s0.x, s0.y); w.y = pk2(s0.z, s0.w); w.z = pk2(s1.x, s1.y); w.w = pk2(s1.z, s1.w); afr[pp][ks] = __builtin_bit_cast(bf16x8, w); }
        }
#pragma unroll
        for (int pp = 0; pp < 2; ++pp) {
            asm volatile("" ::: "memory"); __builtin_amdgcn_sched_barrier(0);
            f32x4 acc[8];
#pragma unroll
            for (int kt = 0; kt < 8; ++kt) acc[kt] = (f32x4){0.f, 0.f, 0.f, 0.f};
#pragma unroll
            for (int ks = 0; ks < 4; ++ks) { const bf16x8 a = afr[pp][ks];
#pragma unroll
                for (int kt = 0; kt < 8; ++kt) { const bf16x8 bb = *(const LAS bf16x8*)(SK + (pp * 128 + kt * 16 + fr) * SKP + ks * 32 + fq * 8); acc[kt] = __builtin_amdgcn_mfma_f32_16x16x32_bf16(a, bb, acc[kt], 0, 0, 0); } }
            unsigned kv[4][8];
#pragma unroll
            for (int g = 0; g < 4; ++g)
#pragma unroll
                for (int kt = 0; kt < 8; ++kt) kv[g][kt] = (f2key(acc[kt][g]) & ~127u) | (unsigned)(127 - (kt * 16 + fr));
#define CSWAP(a_, b_) do { const unsigned hi_ = a_ > b_ ? a_ : b_, lo_ = a_ > b_ ? b_ : a_; a_ = hi_; b_ = lo_; } while (0)
#pragma unroll
            for (int g = 0; g < 4; ++g) {
                CSWAP(kv[g][0], kv[g][1]); CSWAP(kv[g][2], kv[g][3]); CSWAP(kv[g][4], kv[g][5]); CSWAP(kv[g][6], kv[g][7]);
                CSWAP(kv[g][0], kv[g][2]); CSWAP(kv[g][1], kv[g][3]); CSWAP(kv[g][4], kv[g][6]); CSWAP(kv[g][5], kv[g][7]);
                CSWAP(kv[g][1], kv[g][2]); CSWAP(kv[g][5], kv[g][6]);
                CSWAP(kv[g][0], kv[g][4]); CSWAP(kv[g][1], kv[g][5]); CSWAP(kv[g][2], kv[g][6]); CSWAP(kv[g][3], kv[g][7]);
                CSWAP(kv[g][2], kv[g][4]); CSWAP(kv[g][3], kv[g][5]);
                CSWAP(kv[g][1], kv[g][2]); CSWAP(kv[g][3], kv[g][4]); CSWAP(kv[g][5], kv[g][6]);
            }
#undef CSWAP
            unsigned tk[4] = {0u, 0u, 0u, 0u};
#pragma unroll 1
            for (int it = 0; it < 16; ++it) {
#pragma unroll
                for (int g = 0; g < 4; ++g) {
                    const unsigned m = row16_max_u32(kv[g][0]);
                    tk[g] = fr == it ? m : tk[g];
                    const bool won = kv[g][0] == m;
#pragma unroll
                    for (int kt = 0; kt < 7; ++kt) kv[g][kt] = won ? kv[g][kt + 1] : kv[g][kt];
                    kv[g][7] = won ? 0u : kv[g][7];
                }
            }
#pragma unroll
            for (int g = 0; g < 4; ++g) tkp[pp][g] = tk[g];
        }
        float av[4], bv[4]; int ptr[4]; unsigned best[4];
#pragma unroll
        for (int g = 0; g < 4; ++g) { av[g] = key2f(tkp[0][g] & ~127u); bv[g] = key2f(tkp[1][g] & ~127u); ptr[g] = 0; best[g] = 0u; }
#pragma unroll 1
        for (int it = 0; it < 16; ++it) {
#pragma unroll
            for (int g = 0; g < 4; ++g) {
                const float bj = __shfl(bv[g], gbase + (ptr[g] & 15));
                const unsigned mine = ptr[g] < 16 ? ((f2key(av[g] + bj) & ~255u) | (unsigned)(255 - (fr * 16 + (ptr[g] & 15)))) : 0u;
                const unsigned m = row16_max_u32(mine);
                best[g] = fr == it ? m : best[g];
                ptr[g] += (m == mine) ? 1 : 0;
            }
        }
#pragma unroll
        for (int g = 0; g < 4; ++g) {
            const int bc = 255 - (int)(best[g] & 255u);
            const float bval = key2f(best[g] & ~255u);
            const int k1 = 127 - (int)(tkp[0][g] & 127u), k2 = 127 - (int)(tkp[1][g] & 127u);
            const int i1 = __shfl(k1, gbase + (bc >> 4)), i2 = __shfl(k2, gbase + (bc & 15));
            const float mx = __shfl(bval, gbase);
            const float ex = __expf(bval - mx);
            float sm = ex;
#pragma unroll
            for (int o = 1; o < 16; o <<= 1) sm += __shfl_xor(sm, o);
            const size_t tok = (size_t)tile * 16 + fq * 4 + g;
            EIDX[tok * 128 + h * 16 + fr] = i1 * 128 + i2; EGATE[tok * 128 + h * 16 + fr] = ex / sm;
        }
    }
}

template <int CTRL> __device__ __forceinline__ float dppf(float x) { return __builtin_bit_cast(float, __builtin_amdgcn_mov_dpp(__builtin_bit_cast(int, x), CTRL, 0xf, 0xf, true)); }
__device__ __forceinline__ float rs_group8(float (&d)[8], bool b8) {
    asm volatile("s_nop 1\n\tv_permlane32_swap_b32 %0, %4\n\tv_permlane32_swap_b32 %1, %5\n\tv_permlane32_swap_b32 %2, %6\n\tv_permlane32_swap_b32 %3, %7"
                 : "+v"(d[0]), "+v"(d[1]), "+v"(d[2]), "+v"(d[3]), "+v"(d[4]), "+v"(d[5]), "+v"(d[6]), "+v"(d[7]));
    float s0 = d[0] + d[4], s1 = d[1] + d[5], s2 = d[2] + d[6], s3 = d[3] + d[7];
    asm volatile("s_nop 1\n\tv_permlane16_swap_b32 %0, %2\n\tv_permlane16_swap_b32 %1, %3" : "+v"(s0), "+v"(s1), "+v"(s2), "+v"(s3));
    const float t0 = s0 + s2, t1 = s1 + s3;
    const float m = b8 ? t1 : t0, o = b8 ? t0 : t1;
    return m + dppf<0x128>(o);
}
template <int CTRL> __device__ __forceinline__ float rs_merge(float a, float b, bool bit) { const float m = bit ? b : a, o = bit ? a : b; return m + dppf<CTRL>(o); }
constexpr int PG = 8;
__device__ __forceinline__ void phase_peer(const Params& p, int l, LAS unsigned char* lds, int tid, int lane, int wave, int bid, int G) {
    const int gw = bid * NWAVES + wave, NGW = G * NWAVES;
    const float* MOD = (const float*)(p.ws + WS_MOD);
    bf16_t* XL = (bf16_t*)(p.ws + WS_XL); bf16_t* HB = (bf16_t*)(p.ws + WS_HB);
    const float* lg = p.in[I_LNG] + (size_t)(l * 2 + 1) * DM; const float* lb = p.in[I_LNB] + (size_t)(l * 2 + 1) * DM;
    const unsigned char* UB = p.ws + WS_UB + (size_t)l * NEXP * ROWB_U; const unsigned char* VB = p.ws + WS_VB + (size_t)l * NEXP * ROWB_V;
    const float* USC = (const float*)(p.ws + WS_USC) + (size_t)l * NEXP; (void)USC; const float* VSC = (const float*)(p.ws + WS_VSC) + (size_t)l * NEXP; (void)VSC;
    const int* EIDX = (const int*)(p.ws + WS_EIDX); const float* EGATE = (const float*)(p.ws + WS_EGATE);
    const bool last = (l == DEPTH - 1);
    const int nrows = last ? TL : TA;
    constexpr int HLW = 64 * 33 * 4 + 128;
    LAS float* HL = (LAS float*)(lds + wave * HLW) + lane * 33;
    LAS int* PI = (LAS int*)((LAS float*)(lds + wave * HLW) + 64 * 33);
    LAS float* VEC = (LAS float*)(lds + 8 * HLW);
    for (int i = tid; i < 11 * DM / 4; i += NTHREADS) { const int vi = i / (DM / 4), c = (i % (DM / 4)) * 4; const int ln = last ? l : l + 1;
        const float* src = vi < 3 ? MOD + (size_t)(l * 3 + vi) * 6 * DM + 5 * DM + c : (vi < 9 ? MOD + (size_t)(ln * 3 + (vi % 3)) * 6 * DM + (vi / 3 - 1) * DM + c : (vi == 9 ? lg : lb) + c);
        *(LAS f32x4*)(VEC + vi * DM + c) = *(const f32x4*)src; }
    __syncthreads();
#if !TBL_U_FP4
    {
        float one = 1.0f; asm volatile("" : "+v"(one));
        f32x16 t0, t1;
#pragma unroll
        for (int c = 0; c < 32; ++c) { const float v = one * (c < 8 ? (float)c * 0.125f : (1.0f + (float)(c & 7) * 0.125f) * (float)(1 << ((c >> 3) - 1))); if (c < 16) t0[c] = v; else t1[c - 16] = v; }
        const u32x6 pw = pack_fp6_2x16(t0, t1);
        const f32x32 un = unpack_fp6_32(pw);
#pragma unroll
        for (int j = 0; j < 32; ++j) { const float y = un[j]; int c;
            if (y < 1.0f) c = (int)(y * 8.0f + 0.5f); else { const int e = y < 2.0f ? 0 : (y < 4.0f ? 1 : 2); c = 8 * (e + 1) + (int)((y / (float)(1 << e) - 1.0f) * 8.0f + 0.5f); }
            if (lane == 0) PI[j] = c & 31; }
        LDS_FENCE();
#if defined(DIAG_PI)
        { unsigned mk = 0u;
#pragma unroll
          for (int j = 0; j < 32; ++j) mk |= 1u << PI[j];
          if (mk != 0xFFFFFFFFu && l == 0 && gw == 0 && lane == 0) ((float*)(p.ws + WS_CTL + 131072))[0] = 1.0f; }
#endif
    }
#endif
    const unsigned ulane = (unsigned)lane & 63u, loff16 = ulane * 16u; (void)ulane; (void)loff16;
    const bool lb8 = (lane & 8) != 0, lb4 = (lane & 4) != 0, lb2 = (lane & 2) != 0, lb1 = (lane & 1) != 0; (void)lb8; (void)lb4; (void)lb2; (void)lb1;
    const int lsrc = ((lane & 6) << 3) | ((lane & 1) << 3) | (((lane >> 3) & 1) << 2) | (((lane >> 4) & 1) << 1) | ((lane >> 5) & 1); (void)lsrc;
    for (int r = row_first(wave, bid, G); r >= 0; r = row_next(r, wave, bid, G, nrows)) {
        const float* mod = MOD + (size_t)(l * 3 + row_stream(r)) * 6 * DM;
        f32x2v hn[16];
#pragma unroll
        for (int c = 0; c < 4; ++c) { float f[8]; unpack8(*(const u32x4*)(HB + (size_t)r * DM + lane * 32 + c * 8), f);
#pragma unroll
            for (int e = 0; e < 4; ++e) hn[c * 4 + e] = (f32x2v){f[2 * e], f[2 * e + 1]}; }
#if !TBL_U_FP4
#pragma unroll
        for (int j = 0; j < 16; ++j) { HL[2 * j] = hn[j].x; HL[2 * j + 1] = hn[j].y; }
        LDS_FENCE();
        f32x2v hf[16];
#pragma unroll
        for (int j = 0; j < 16; ++j) hf[j] = (f32x2v){HL[PI[2 * j]], HL[PI[2 * j + 1]]};
        LDS_FENCE();
#endif
#if TBL_U_I4
        int hlo[4], hhi[4]; unsigned basel;
        { float am = 0.f;
#pragma unroll
          for (int j = 0; j < 16; ++j) am = fmaxf(am, fmaxf(fabsf(hn[j].x), fabsf(hn[j].y)));
          const unsigned ab = __builtin_bit_cast(unsigned, am * (1.0f / 119.0f)); unsigned eb = (ab >> 23) + ((ab & 0x007fffffu) ? 1u : 0u); eb = eb < 1u ? 1u : (eb > 253u ? 253u : eb);
          const float inv = __builtin_bit_cast(float, (254u - eb) << 23);
          basel = U_ROWSCALE ? (eb << 23) : (I4_BASE + ((eb - 127u) << 23));
#pragma unroll
          for (int d = 0; d < 4; ++d) { unsigned tl = 0u, th = 0u;
#pragma unroll
              for (int e = 0; e < 8; ++e) { const f32x2v pr = hn[d * 4 + (e >> 1)]; const float xv = (e & 1) ? pr.y : pr.x;
                  const unsigned qb = __builtin_bit_cast(unsigned, xv * inv + 12582912.0f);
                  tl |= (qb & 15u) << (4 * e); th |= (((qb + 8u) >> 4) & 15u) << (4 * e); }
              hlo[d] = (int)tl; hhi[d] = (int)th; } }
#endif
        const int e0 = EIDX[(size_t)r * 128 + lane], e1 = EIDX[(size_t)r * 128 + 64 + lane];
        const float g0 = EGATE[(size_t)r * 128 + lane], g1 = EGATE[(size_t)r * 128 + 64 + lane];
#if !TBL_U_FP4 || U_ROWSCALE
        const float su0 = USC[e0], su1 = USC[e1];
#else
        const float su0 = 1.0f, su1 = 1.0f;
#endif
        float wgt[2] = {0.f, 0.f};
#define P4_LOAD(dq, ds, TB, eh, j0) do { unsigned lo_ = loff16, ul_ = ulane; asm volatile("" : "+v"(lo_), "+v"(ul_));    \
        _Pragma("unroll") for (int c = 0; c < PG; ++c) { const int e_ = __builtin_amdgcn_readlane(eh, (j0) + c); \
            const unsigned char* rp_ = (TB) + (size_t)e_ * ROWB4; dq[c] = *(const u32x4*)(rp_ + lo_); ds[c] = rp_[1024u + ul_]; } } while (0)
#if V_ROWSCALE
#define P4_LDV P4_LOADU
#else
#define P4_LDV P4_LOAD
#endif
#if U_ROWSCALE
#define P4_LDU P4_LOADU
#else
#define P4_LDU P4_LOAD
#endif
#define P4_LOADU(dq, ds, TB, eh, j0) do { const __amdgpu_buffer_rsrc_t rs_ = __builtin_amdgcn_make_buffer_rsrc((void*)(TB), 0, NEXP * 1024, 0x00020000); \
        _Pragma("unroll") for (int c = 0; c < PG; ++c) { const int e_ = __builtin_amdgcn_readlane(eh, (j0) + c); \
            dq[c] = __builtin_bit_cast(u32x4, __builtin_amdgcn_raw_buffer_load_b128(rs_, (int)loff16, (int)(((unsigned)e_ & 0x3fffu) << 10), 0)); ds[c] = e_; } } while (0)
#define P4_CVT(dq, c, d, b, sc) __builtin_amdgcn_cvt_scalef32_pk_f32_fp4(dq[c][d], sc, b)
#if TBL_U_I4
#define P4_DOT(dq, ds, rr) do { float d_[PG]; _Pragma("unroll") for (int c = 0; c < PG; ++c) { int t_ = 0;        \
            _Pragma("unroll") for (int d = 0; d < 4; ++d) t_ = __builtin_amdgcn_sdot8((int)dq[c][d], hhi[d], t_, false); \
            t_ <<= 4; \
            _Pragma("unroll") for (int d = 0; d < 4; ++d) t_ = __builtin_amdgcn_sdot8((int)dq[c][d], hlo[d], t_, false); \
            d_[c] = (float)t_ * (U_ROWSCALE ? __builtin_bit_cast(float, basel) : __builtin_bit_cast(float, ((unsigned)ds[c] << 20) + basel)); } \
        rr = rs_group8(d_, lb8); } while (0)
#else
#define P4_DOT(dq, ds, rr) do { float d_[PG]; _Pragma("unroll") for (int c = 0; c < PG; ++c) { const float sc_ = __builtin_bit_cast(float, (unsigned)ds[c] << 23); f32x2v a0_ = (f32x2v){0.f, 0.f}, a1_ = (f32x2v){0.f, 0.f}; \
            _Pragma("unroll") for (int d = 0; d < 4; ++d) { a0_ += P4_CVT(dq, c, d, 0, sc_) * hn[d * 4 + 0]; a1_ += P4_CVT(dq, c, d, 1, sc_) * hn[d * 4 + 1]; a0_ += P4_CVT(dq, c, d, 2, sc_) * hn[d * 4 + 2]; a1_ += P4_CVT(dq, c, d, 3, sc_) * hn[d * 4 + 3]; } \
            d_[c] = (a0_.x + a0_.y) + (a1_.x + a1_.y); asm volatile("" : "+v"(d_[c])); } \
        rr = rs_group8(d_, lb8); } while (0)
#endif
#define P4_AXPY(dq, ds, wh, j0) do { _Pragma("unroll") for (int c = 0; c < PG; ++c) { const float wj_ = V_ROWSCALE ? __builtin_bit_cast(float, (unsigned)ds[c] & 0xffff0000u) : __builtin_bit_cast(float, __builtin_amdgcn_readlane(wh, (j0) + c)); const f32x2v w2_ = (f32x2v){wj_, wj_}; \
            const float sc_ = V_ROWSCALE ? 1.0f : __builtin_bit_cast(float, (unsigned)ds[c] << 23); \
            _Pragma("unroll") for (int d = 0; d < 4; ++d) { yv[d * 4 + 0] += P4_CVT(dq, c, d, 0, sc_) * w2_; yv[d * 4 + 1] += P4_CVT(dq, c, d, 1, sc_) * w2_; yv[d * 4 + 2] += P4_CVT(dq, c, d, 2, sc_) * w2_; yv[d * 4 + 3] += P4_CVT(dq, c, d, 3, sc_) * w2_; } \
            asm volatile("" : "+v"(yv[0]), "+v"(yv[1]), "+v"(yv[2]), "+v"(yv[3]), "+v"(yv[4]), "+v"(yv[5]), "+v"(yv[6]), "+v"(yv[7]), "+v"(yv[8]), "+v"(yv[9]), "+v"(yv[10]), "+v"(yv[11]), "+v"(yv[12]), "+v"(yv[13]), "+v"(yv[14]), "+v"(yv[15]));   } } while (0)
#if !TBL_U_FP4
#define PEER_LOAD(dq, dd, TB, eh, j0) do { _Pragma("unroll") for (int c = 0; c < PG; ++c) { const int e_ = __builtin_amdgcn_readlane(eh, (j0) + c); \
            const unsigned char* rp_ = (TB) + (size_t)e_ * ROWB; dq[c] = *(const u32x4*)(rp_ + lane * 16); dd[c] = *(const u32x2*)(rp_ + 1024 + lane * 8); } } while (0)
#define PEER_UNPACK(dq, dd, c) unpack_fp6_32((u32x6){dq[c].x, dq[c].y, dq[c].z, dq[c].w, dd[c].x, dd[c].y})
#define PEER_DOT(dq, dd, j0) do { float d_[PG]; _Pragma("unroll") for (int c = 0; c < PG; ++c) { const f32x32 u_ = PEER_UNPACK(dq, dd, c); f32x2v a0_ = (f32x2v){0.f, 0.f}, a1_ = (f32x2v){0.f, 0.f}; \
            _Pragma("unroll") for (int t = 0; t < 8; ++t) { a0_ += (f32x2v){u_[4 * t], u_[4 * t + 1]} * hf[2 * t]; a1_ += (f32x2v){u_[4 * t + 2], u_[4 * t + 3]} * hf[2 * t + 1]; } \
            d_[c] = (a0_.x + a0_.y) + (a1_.x + a1_.y); __builtin_amdgcn_sched_barrier(0); } \
        _Pragma("unroll") for (int o = 1; o < 64; o <<= 1) { _Pragma("unroll") for (int c = 0; c < PG; ++c) d_[c] += __shfl_xor(d_[c], o); } \
        _Pragma("unroll") for (int c = 0; c < PG; ++c) wacc = (lane == (j0) + c) ? d_[c] : wacc; } while (0)
#endif
#pragma unroll
        for (int hh = 0; hh < 2; ++hh) {
            const int eh = hh ? e1 : e0; float wacc = 0.f;
#if TBL_U_FP4
            u32x4 qa[PG], qb[PG]; int sa[PG], sb[PG];
            P4_LDU(qa, sa, UB, eh, 0);
            float wq = 0.f, wp = 0.f;
#pragma unroll 1
            for (int j0 = 0; j0 < 64; j0 += 2 * PG) {
                float ra, rb;
                P4_LDU(qb, sb, UB, eh, j0 + PG);
                P4_DOT(qa, sa, ra);
                if (j0 + 2 * PG < 64) P4_LDU(qa, sa, UB, eh, j0 + 2 * PG);
                P4_DOT(qb, sb, rb);
                const float q = rs_merge<0x141>(ra, rb, lb4);
                if ((j0 & 16) == 0) wq = q;
                else { const float pm = rs_merge<0x4E>(wq, q, lb2);
                       if (j0 == 16) wp = pm; else wacc = rs_merge<0xB1>(wp, pm, lb1); }
            }
            wacc = __shfl(wacc, lsrc);
#else
            u32x4 qa[PG], qb[PG]; u32x2 da[PG], db[PG];
            PEER_LOAD(qa, da, UB, eh, 0);
#pragma unroll 1
            for (int j0 = 0; j0 < 64; j0 += 2 * PG) {
                PEER_LOAD(qb, db, UB, eh, j0 + PG);
                PEER_DOT(qa, da, j0);
                if (j0 + 2 * PG < 64) PEER_LOAD(qa, da, UB, eh, j0 + 2 * PG);
                PEER_DOT(qb, db, j0 + PG);
            }
#endif
            wgt[hh] = gelu_f(wacc * (hh ? su1 : su0)) * (hh ? g1 : g0) * (V_ROWSCALE ? VSC[eh] : 1.0f);
        }
        f32x2v yv[16];
#pragma unroll
        for (int i = 0; i < 16; ++i) yv[i] = (f32x2v){0.f, 0.f};
#pragma unroll
        for (int hh = 0; hh < 2; ++hh) {
            const int eh = V_ROWSCALE ? ((hh ? e1 : e0) | (int)((__builtin_bit_cast(unsigned, wgt[hh]) + 0x8000u) & 0xffff0000u)) : (hh ? e1 : e0); const int wh = __builtin_bit_cast(int, wgt[hh]); (void)wh;
            u32x4 qa[PG], qb[PG]; int sa[PG], sb[PG];
            P4_LDV(qa, sa, VB, eh, 0);
#pragma unroll 1
            for (int j0 = 0; j0 < 64; j0 += 2 * PG) {
                P4_LDV(qb, sb, VB, eh, j0 + PG);
                P4_AXPY(qa, sa, wh, j0);
                if (j0 + 2 * PG < 64) P4_LDV(qa, sa, VB, eh, j0 + 2 * PG);
                P4_AXPY(qb, sb, wh, j0 + PG);
            }
        }
#undef P4_LOAD
#undef P4_CVT
#undef P4_DOT
#undef P4_AXPY
#if !TBL_U_FP4
#undef PEER_LOAD
#undef PEER_UNPACK
#undef PEER_DOT
#endif
        const int st = row_stream(r);
        const bf16_t* xr = (const bf16_t*)(p.ws + WS_XM) + (size_t)r * DM + lane * 32;
        f32x4 xv[8];
#pragma unroll
        for (int t = 0; t < 4; ++t) { const u32x4 w = *(const u32x4*)(xr + t * 8); xv[2 * t] = (f32x4){bflo(w.x), bfhi(w.x), bflo(w.y), bfhi(w.y)}; xv[2 * t + 1] = (f32x4){bflo(w.z), bfhi(w.z), bflo(w.w), bfhi(w.w)}; }
        float s = 0.f;
#pragma unroll
        for (int t = 0; t < 8; ++t) { const f32x4 ga = *(const LAS f32x4*)(VEC + st * DM + lane * 32 + t * 4);
            f32x2v& ya = yv[t * 2]; f32x2v& yb = yv[t * 2 + 1];
            ya.x = xv[t].x * DN_ALPHA + ga.x * ya.x; ya.y = xv[t].y * DN_ALPHA + ga.y * ya.y; yb.x = xv[t].z * DN_ALPHA + ga.z * yb.x; yb.y = xv[t].w * DN_ALPHA + ga.w * yb.y;
            s += (ya.x + ya.y) + (yb.x + yb.y); }
        const float mean = wave_sum(s) * (1.0f / DM);
        float s2 = 0.f;
#pragma unroll
        for (int i = 0; i < 16; ++i) { yv[i] = yv[i] - mean; s2 += yv[i].x * yv[i].x + yv[i].y * yv[i].y; }
        const float rstd = 1.0f / sqrtf(wave_sum(s2) * (1.0f / DM) + LN_EPS);
        float* dst = p.out + (size_t)r * DM + lane * 32; bf16_t* dstb = XL + (size_t)r * DM + lane * 32;
#pragma unroll
        for (int t = 0; t < 8; t += 2) { const int c = t * 4;
            const f32x4 ga = *(const LAS f32x4*)(VEC + 9 * DM + lane * 32 + c), gb = *(const LAS f32x4*)(VEC + 9 * DM + lane * 32 + c + 4), ba = *(const LAS f32x4*)(VEC + 10 * DM + lane * 32 + c), bb = *(const LAS f32x4*)(VEC + 10 * DM + lane * 32 + c + 4);
            const f32x2v y0 = yv[t * 2], y1 = yv[t * 2 + 1], y2 = yv[t * 2 + 2], y3 = yv[t * 2 + 3];
            f32x4 o0, o1;
            o0.x = y0.x * rstd * ga.x + ba.x; o0.y = y0.y * rstd * ga.y + ba.y; o0.z = y1.x * rstd * ga.z + ba.z; o0.w = y1.y * rstd * ga.w + ba.w;
            o1.x = y2.x * rstd * gb.x + bb.x; o1.y = y2.y * rstd * gb.y + bb.y; o1.z = y3.x * rstd * gb.z + bb.z; o1.w = y3.y * rstd * gb.w + bb.w;
            if (last) { *(f32x4*)(dst + c) = o0; *(f32x4*)(dst + c + 4) = o1; }
            else { u32x4 xw; xw.x = pk2(o0.x, o0.y); xw.y = pk2(o0.z, o0.w); xw.z = pk2(o1.x, o1.y); xw.w = pk2(o1.z, o1.w); *(u32x4*)(dstb + c) = xw; }
            if (!last) {
                const f32x4 sa = *(const LAS f32x4*)(VEC + (3 + st) * DM + lane * 32 + c), sb = *(const LAS f32x4*)(VEC + (3 + st) * DM + lane * 32 + c + 4), ca = *(const LAS f32x4*)(VEC + (6 + st) * DM + lane * 32 + c), cb = *(const LAS f32x4*)(VEC + (6 + st) * DM + lane * 32 + c + 4);
                u32x4 o; o.x = pk2(o0.x * (1.f + ca.x) + sa.x, o0.y * (1.f + ca.y) + sa.y); o.y = pk2(o0.z * (1.f + ca.z) + sa.z, o0.w * (1.f + ca.w) + sa.w);
                o.z = pk2(o1.x * (1.f + cb.x) + sb.x, o1.y * (1.f + cb.y) + sb.y); o.w = pk2(o1.z * (1.f + cb.z) + sb.z, o1.w * (1.f + cb.w) + sb.w);
                *(u32x4*)(HB + (size_t)r * DM + lane * 32 + c) = o; }
        }
#if defined(DIAG_PI)
        if (last && r == 5 && lane == 0 && ((const float*)(p.ws + WS_CTL + 131072))[0] != 0.0f) p.out[(size_t)5 * DM] = __builtin_nanf("");
#endif
    }
}

__device__ __forceinline__ void gemm_rows_bf16(LAS unsigned char* lds, const bf16_t* A, const bf16_t* Bt, bf16_t* C, float* Cpart, bool with_ctx, int G, int bid) {
    { pg8::Gemm g{A, Bt, TL, DM, DM, DM}; pg8::StaticOrder S; S.init(TL, DM, G, bid); pg8::EpiBf16<0> E{C, DM, nullptr, 0, 0, 1.f};
      pg8::gemm_phase<pg8::EpiBf16<0>, pg8::StaticOrder, PG8_ALIGN, PG8_SP2>(lds, g, S, E); }
    if (with_ctx) { int ksl = 256; asm volatile("" : "+s"(ksl));
      pg8::Gemm g{A + (size_t)TL * DM, Bt, TC, DM, ksl, DM}; pg8::SplitKOrder S; S.init(G, bid); pg8::EpiF32Part E{Cpart};
      pg8::gemm_phase<pg8::EpiF32Part, pg8::SplitKOrder, PG8_ALIGN, PG8_SP2>(lds, g, S, E); }
}

constexpr int PH_PER_LAYER = 9, N_PHASES = 2 + DEPTH * PH_PER_LAYER;
__global__ void __launch_bounds__(NTHREADS, 2) fwd_kernel(Params p) {
    extern __shared__ __attribute__((aligned(16))) unsigned char lds_raw[];
    LAS unsigned char* lds = (LAS unsigned char*)lds_raw;
    const int tid = threadIdx.x, lane = tid & 63, wave = __builtin_amdgcn_readfirstlane(tid >> 6), bid = blockIdx.x, G = gridDim.x;
    volatile LAS unsigned* MISC = (volatile LAS unsigned*)(lds + MISC_OFF);
    if (tid < 32) MISC[tid] = 0u;
    __syncthreads();
    if (hipThreadIdx_x == 0) (void)xb_add(&((unsigned*)(p.ws + WS_CTL))[CW_BAR + XB_XCNT(xb_xcc_id())], 1u);
#define IN(k) true
#if defined(PROBE_MASK)
    volatile LAS unsigned long long* PT = (volatile LAS unsigned long long*)(lds + MISC_OFF + 96);
    if (tid == 0) PT[0] = __builtin_amdgcn_s_memrealtime();
#define SEAM(k) do { { XcdBarrier bar_; bar_.bar = (unsigned*)(((const __attribute__((address_space(4))) Params*)__builtin_amdgcn_kernarg_segment_ptr())->ws + WS_CTL) + CW_BAR; bar_.x = xb_xcc_id(); bar_.st = MISC + 8; xcd_barrier(bar_); } if (bid == 0) { const int kind_ = (k) < 2 ? (k) : 2 + ((k) - 2) % PH_PER_LAYER; \
        if (tid == 0) { const unsigned long long now_ = __builtin_amdgcn_s_memrealtime(); if ((PROBE_MASK >> kind_) & 1) { const unsigned long long d_ = (now_ - PT[0]) * PROBE_MULT; \
            while (__builtin_amdgcn_s_memrealtime() - now_ < d_) __builtin_amdgcn_s_sleep(8); } PT[0] = __builtin_amdgcn_s_memrealtime(); } __syncthreads(); } } while (0)
#elif defined(PROBE_DUP_BAR)
#define SEAM(k) do { XcdBarrier bar_; bar_.bar = (unsigned*)(((const __attribute__((address_space(4))) Params*)__builtin_amdgcn_kernarg_segment_ptr())->ws + WS_CTL) + CW_BAR; bar_.x = xb_xcc_id(); bar_.st = MISC + 8; xcd_barrier(bar_); xcd_barrier(bar_); } while (0)
#else
#define SEAM(k) do { XcdBarrier bar_; bar_.bar = (unsigned*)(((const __attribute__((address_space(4))) Params*)__builtin_amdgcn_kernarg_segment_ptr())->ws + WS_CTL) + CW_BAR; bar_.x = xb_xcc_id(); bar_.st = MISC + 8; xcd_barrier(bar_); } while (0)
#endif
    const int NGW = G * NWAVES;
#if defined(__HIP_DEVICE_COMPILE__)
#define KARGS_COPY const Params p_ = *kp_
#else
#define KARGS_COPY const Params p_ = p; (void)kp_
#endif
#define FRESH() int tid_ = threadIdx.x, bid_ = blockIdx.x; asm volatile("" : "+v"(tid_), "+s"(bid_)); const int lane_ = tid_ & 63, wave_ = __builtin_amdgcn_readfirstlane(tid_ >> 6); (void)lane_; (void)wave_; \
    const __attribute__((address_space(4))) Params* kp_ = (const __attribute__((address_space(4))) Params*)__builtin_amdgcn_kernarg_segment_ptr(); asm volatile("" : "+s"(kp_)); KARGS_COPY
    if (IN(0)) { FRESH(); phase_prologue(p_, lds, tid_, lane_, wave_, bid_, G); }
    SEAM(0);
    if (IN(1)) { FRESH(); phase_modulate0(p_, lane_, wave_, bid_, G); }
    SEAM(1);
    for (int l = 0; l < DEPTH; ++l) {
        const int b0 = 2 + l * PH_PER_LAYER;
        if (IN(b0 + 0)) { FRESH();
            pg8::Gemm g{(const bf16_t*)(p_.ws + WS_HB), (const bf16_t*)(p_.ws + WS_WIN) + (size_t)l * INWP * DM, TA, INWP, DM, DM}; pg8::StaticOrder S; S.init(TA, INWP, G, bid_);
            pg8::EpiBf16<0> E{(bf16_t*)(p_.ws + WS_P), INWP, nullptr, 0, 0, 1.f};
            pg8::gemm_phase<pg8::EpiBf16<0>, pg8::StaticOrder, PG8_ALIGN, PG8_SP2>(lds, g, S, E);
#if defined(PROBE_DUP_GEMM)
            __syncthreads(); pg8::gemm_phase<pg8::EpiBf16<0>, pg8::StaticOrder, PG8_ALIGN, PG8_SP2>(lds, g, S, E);
#endif
        }
        SEAM(b0 + 0);
        if (IN(b0 + 1)) { { FRESH(); gla_g1(p_, l, lds, tid_, lane_, wave_, bid_, G); } { FRESH(); phase_post_in(p_, l, lane_, wave_, bid_, G); } }
#if defined(PROBE_DUP_A)
        if (IN(b0 + 1)) { __syncthreads(); { FRESH(); gla_g1(p_, l, lds, tid_, lane_, wave_, bid_, G); } { FRESH(); phase_post_in(p_, l, lane_, wave_, bid_, G); } }
#endif
        SEAM(b0 + 1);
        if (IN(b0 + 2)) {
            unsigned* ctl_ = (unsigned*)(((const __attribute__((address_space(4))) Params*)__builtin_amdgcn_kernarg_segment_ptr())->ws + WS_CTL);
            { FRESH(); gla_g2(p_, tid_, bid_, G);
              if (bid_ < 64) { asm volatile("s_waitcnt vmcnt(0)" ::: "memory"); __syncthreads();
                  if (tid_ == 0) { __builtin_amdgcn_fence(__ATOMIC_RELEASE, "agent"); asm volatile("s_waitcnt vmcnt(0)" ::: "memory"); (void)xb_add(ctl_ + CW_QUEUE + 64 * (12 + l), 1u); } } }
            { FRESH(); phase_mixers(p_, l, lds, tid_, lane_, wave_, bid_, G); }
            { FRESH();
              if (tid_ == 0) { unsigned* bar = ctl_ + CW_BAR; XB_SPIN(xb_ld(ctl_ + CW_QUEUE + 64 * (12 + l)) < (G < 64 ? (unsigned)G : 64u), bar);
                  __builtin_amdgcn_fence(__ATOMIC_ACQUIRE, "agent"); asm volatile("s_waitcnt vmcnt(0)" ::: "memory"); }
              __syncthreads();
              gla_g3(p_, l, lds, tid_, lane_, wave_, bid_, G, ctl_ + CW_QUEUE + 64 * (8 + l)); }
        }
#if defined(PROBE_DUP_B)
        if (IN(b0 + 2)) { __syncthreads(); { FRESH(); gla_g2(p_, tid_, bid_, G); } { FRESH(); phase_mixers(p_, l, lds, tid_, lane_, wave_, bid_, G, 1); } }
#endif
#if defined(PROBE_DUP_C)
        if (IN(b0 + 3)) { __syncthreads(); FRESH(); gla_g3(p_, l, lds, tid_, lane_, wave_, bid_, G); }
#endif
        SEAM(b0 + 3);
        if (IN(b0 + 4)) { FRESH();
            gemm_rows_bf16(lds, (const bf16_t*)(p_.ws + WS_MIX), (const bf16_t*)(p_.ws + WS_WOUT) + (size_t)l * DM * DM, (bf16_t*)(p_.ws + WS_Y), (float*)(p_.ws + WS_YPART), l < DEPTH - 1, G, bid_);
#if defined(PROBE_DUP_GEMM)
            __syncthreads(); gemm_rows_bf16(lds, (const bf16_t*)(p_.ws + WS_MIX), (const bf16_t*)(p_.ws + WS_WOUT) + (size_t)l * DM * DM, (bf16_t*)(p_.ws + WS_Y), (float*)(p_.ws + WS_YPART), l < DEPTH - 1, G, bid_);
#endif
        }
        SEAM(b0 + 4);
        if (IN(b0 + 5)) { FRESH(); phase_ln1(p_, l, lds, tid_, lane_, wave_, bid_, G); }
#if defined(PROBE_DUP_E)
        if (IN(b0 + 5)) { __syncthreads(); FRESH(); phase_ln1(p_, l, lds, tid_, lane_, wave_, bid_, G); }
#endif
        SEAM(b0 + 5);
        if (IN(b0 + 6)) { FRESH();
            gemm_rows_bf16(lds, (const bf16_t*)(p_.ws + WS_HB), (const bf16_t*)(p_.ws + WS_WQ) + (size_t)l * DM * DM, (bf16_t*)(p_.ws + WS_QP), (float*)(p_.ws + WS_QPART), l < DEPTH - 1, G, bid_);
#if defined(PROBE_DUP_GEMM)
            __syncthreads(); gemm_rows_bf16(lds, (const bf16_t*)(p_.ws + WS_HB), (const bf16_t*)(p_.ws + WS_WQ) + (size_t)l * DM * DM, (bf16_t*)(p_.ws + WS_QP), (float*)(p_.ws + WS_QPART), l < DEPTH - 1, G, bid_);
#endif
        }
        SEAM(b0 + 6);
        if (IN(b0 + 7)) { FRESH(); peer_retrieve(p_, l, lds, tid_, lane_, wave_, bid_, G, l < DEPTH - 1 ? TA : TL); }
#if defined(PROBE_DUP_D)
        if (IN(b0 + 7)) { __syncthreads(); FRESH(); peer_retrieve(p_, l, lds, tid_, lane_, wave_, bid_, G, l < DEPTH - 1 ? TA : TL); }
#endif
        SEAM(b0 + 7);
        if (IN(b0 + 8)) { FRESH(); phase_peer(p_, l, lds, tid_, lane_, wave_, bid_, G); }
        if (l < DEPTH - 1) SEAM(b0 + 8);
    }
#undef FRESH
#undef IN
#undef SEAM
}

#ifndef MK_PER_PHASE
#define MK_PER_PHASE 0
#endif
extern "C" void kernel_launch(void* const* d_in, const int* in_sizes, int n_in, void* d_out, int out_size, void* d_ws, size_t ws_size, hipStream_t stream) {
    static int grid = 0;
    if (grid == 0) {
        if (n_in != 19 || out_size != TL * DM || ws_size < WS_END) { fprintf(stderr, "kernel_launch: unexpected shapes (n_in %d out %d ws %zu)\n", n_in, out_size, ws_size); grid = -1; return; }
        int dev = 0, cus = 0;
        if (hipGetDevice(&dev) != hipSuccess || hipDeviceGetAttribute(&cus, hipDeviceAttributeMultiprocessorCount, dev) != hipSuccess) { grid = -1; return; }
        if (hipFuncSetAttribute((const void*)fwd_kernel, hipFuncAttributeMaxDynamicSharedMemorySize, LDS_BYTES) != hipSuccess) { fprintf(stderr, "kernel_launch: hipFuncSetAttribute failed\n"); grid = -1; return; }
        int per_cu = 0;
        (void)hipOccupancyMaxActiveBlocksPerMultiprocessor(&per_cu, (const void*)fwd_kernel, NTHREADS, LDS_BYTES);
        (void)hipGetLastError();
        if (per_cu < 1) fprintf(stderr, "kernel_launch: occupancy query reports %d blocks per CU\n", per_cu);
        grid = cus;
    }
    if (grid < 0) return;
    (void)hipMemsetAsync((char*)d_ws + WS_CTL, 0, CTL_ZERO_BYTES, stream);
    Params p{};
    for (int i = 0; i < 19; ++i) p.in[i] = (const float*)d_in[i];
    p.out = (float*)d_out; p.ws = (unsigned char*)d_ws;
#if MK_PER_PHASE
    for (int ph = 0; ph < N_PHASES; ++ph) { p.ph_lo = ph; p.ph_hi = ph + 1; hipLaunchKernelGGL(fwd_kernel, dim3(grid), dim3(NTHREADS), LDS_BYTES, stream, p); }
#else
    p.ph_lo = 0; p.ph_hi = N_PHASES;
    hipLaunchKernelGGL(fwd_kernel, dim3(grid), dim3(NTHREADS), LDS_BYTES, stream, p);
#endif
}
```

```cpp
#include <hip/hip_runtime.h>
#include <cstdio>
#include <cstdint>

#define LAS __attribute__((address_space(3)))
typedef unsigned short bf16_t;
typedef short bf16x8 __attribute__((ext_vector_type(8)));
typedef float f32x4 __attribute__((ext_vector_type(4)));
typedef unsigned u32x4 __attribute__((ext_vector_type(4)));
typedef unsigned u32x2 __attribute__((ext_vector_type(2)));
typedef unsigned u32x6 __attribute__((ext_vector_type(6)));
typedef float f32x2v __attribute__((ext_vector_type(2)));
typedef float f32x16 __attribute__((ext_vector_type(16)));
typedef float f32x32 __attribute__((ext_vector_type(32)));

constexpr int DM = 2048, NBATCH = 2, SEQ = 8192, DEPTH = 4, CTXL = 256;
constexpr int TL = NBATCH * SEQ, TC = NBATCH * CTXL, TA = TL + TC;
constexpr int INW = 4640, INWP = 4864;
constexpr int C_CX = 0, C_CB = 512, C_CC = 1024, C_GQ = 1536, C_GK = 1792, C_GV = 2048, C_GG = 2560, C_LRF = 3072, C_LRB = 3088,
              C_SQ = 3104, C_SK = 4128, C_SV = 4384;
constexpr int NEXP = 16384;
constexpr int ROWB = 1536;
constexpr int ROWB4 = 1088;
#ifndef TBL_U_FP4
#define TBL_U_FP4 1
#endif
#ifndef TBL_U_I4
#define TBL_U_I4 (TBL_U_FP4)
#endif
constexpr unsigned I4_BASE = 103u << 23;
#ifndef U_ROWSCALE
#define U_ROWSCALE (TBL_U_I4)
#endif
#ifndef V_ROWSCALE
#define V_ROWSCALE 1
#endif
constexpr int ROWB_U = U_ROWSCALE ? 1024 : (TBL_U_FP4 ? ROWB4 : ROWB), ROWB_V = V_ROWSCALE ? 1024 : ROWB4;
constexpr float DN_ALPHA = 1.6817928305074290f;
constexpr float LN_EPS = 1e-6f;
constexpr int NWAVES = 8, NTHREADS = 512;

constexpr size_t MiB = 1u << 20;
constexpr size_t WS_CTL = 0, CTL_ZERO_BYTES = 256 * 1024;
constexpr size_t WS_MOD = 2 * MiB;
constexpr size_t WS_WIN = 4 * MiB;
constexpr size_t WS_WOUT = 80 * MiB;
constexpr size_t WS_WQ = 112 * MiB;
constexpr size_t WS_XL = 144 * MiB;
constexpr size_t WS_HB = 276 * MiB;
constexpr size_t WS_P = 342 * MiB;
constexpr size_t WS_QR = 656 * MiB;
constexpr size_t WS_KR = 720 * MiB;
constexpr size_t WS_ALF = 736 * MiB;
constexpr size_t WS_ALB = 753 * MiB;
constexpr size_t WS_OF = 770 * MiB;
constexpr size_t WS_OB = 803 * MiB;
constexpr size_t WS_MIX = 836 * MiB;
constexpr size_t WS_Y = 902 * MiB;
constexpr size_t WS_QP = 1034 * MiB;
constexpr size_t WS_DELTA = 1166 * MiB;
constexpr size_t WS_DEC = 1233 * MiB;
constexpr size_t WS_SST = 1234 * MiB;
constexpr size_t WS_UB = 1268 * MiB;
constexpr size_t WS_VB = 1524 * MiB;
constexpr size_t WS_EIDX = 1780 * MiB;
constexpr size_t WS_EGATE = 1789 * MiB;
constexpr size_t WS_SUBB = 1798 * MiB;
constexpr size_t WS_USC = 1799 * MiB;
constexpr size_t WS_VSC = 1799 * MiB + 512 * 1024;
constexpr size_t WS_YPART = 1800 * MiB;
constexpr size_t WS_QPART = 1832 * MiB;
constexpr size_t WS_XM = 1864 * MiB;
constexpr size_t WS_END = 1996 * MiB;
constexpr int GLA_ITEMS = (TA / 64) * 4;
static_assert(WS_DELTA + (size_t)GLA_ITEMS * 2 * 8192 * 4 <= WS_DEC && WS_DEC + (size_t)GLA_ITEMS * 2 * 64 * 4 <= WS_SST && WS_SST + (size_t)GLA_ITEMS * 2 * 8192 * 2 <= WS_END, "map");
static_assert(WS_WIN + (size_t)4 * INWP * DM * 2 <= WS_WOUT, "map");
static_assert(WS_P + (size_t)TA * INWP * 2 <= WS_QR, "map");
static_assert(WS_XL + (size_t)TA * DM * 4 <= WS_HB, "map");
constexpr int CW_BAR = 4096;
constexpr int CW_QUEUE = 8192;
constexpr int LDS_BYTES = 163840;
constexpr int MISC_OFF = 163840 - 512;

#define XB_TMO      128
#define XB_XCNT(j)  (256  + 64 * (j))
#define XB_XSUB(j)  (1280 + 64 * (j))
#define XB_XGEN(j)  (2304 + 64 * (j))
#define XB_TOP      3328
#define XB_TOPGEN   3392
#define XCD_BAR_WORDS 3456
#define XB_SPIN_CAP (1u << 18)
__device__ __forceinline__ unsigned xb_ld(unsigned* p)              { return __hip_atomic_load(p, __ATOMIC_RELAXED, __HIP_MEMORY_SCOPE_AGENT); }
__device__ __forceinline__ unsigned xb_add(unsigned* p, unsigned v) { return __hip_atomic_fetch_add(p, v, __ATOMIC_RELAXED, __HIP_MEMORY_SCOPE_AGENT); }
__device__ __forceinline__ unsigned xb_xcc_id() { return (unsigned)__builtin_amdgcn_s_getreg((3 << 11) | 20) & 0xFu; }
#define XB_SPIN(cond, bar) do { unsigned _sp = 0; while (cond) { __builtin_amdgcn_s_sleep(1); \
    if ((++_sp & 255u) == 0u) { if (xb_ld(&(bar)[XB_TMO])) break; if (_sp > XB_SPIN_CAP) { atomicAdd(&(bar)[XB_TMO], 1u); break; } } } } while (0)
struct XcdBarrier { unsigned* bar; unsigned x; volatile LAS unsigned* st; };
__device__ __forceinline__ XcdBarrier xcd_barrier_post(unsigned* bar, volatile LAS unsigned* st) {
    XcdBarrier b; b.bar = bar; b.x = xb_xcc_id(); b.st = st;
    if (threadIdx.x == 0) (void)xb_add(&bar[XB_XCNT(b.x)], 1u);
    return b;
}
__device__ __forceinline__ void xcd_barrier_complete(unsigned* bar, unsigned x, unsigned& nloc, unsigned& nx) {
    const unsigned G = gridDim.x * gridDim.y * gridDim.z;
    unsigned sum, cnt, mine, sp = 0u;
    for (;;) {
        sum = 0u; cnt = 0u; mine = 0u;
#pragma unroll
        for (unsigned j = 0; j < 16; ++j) { const unsigned c = xb_ld(&bar[XB_XCNT(j)]); sum += c; cnt += (c > 0u) ? 1u : 0u; mine = (j == x) ? c : mine; }
        if (sum == G) break;
        __builtin_amdgcn_s_sleep(1);
        if ((++sp & 255u) == 0u) { if (xb_ld(&bar[XB_TMO])) break; if (sp > XB_SPIN_CAP) { atomicAdd(&bar[XB_TMO], 1u); break; } }
    }
    nloc = mine > 0u ? mine : 1u; nx = cnt > 0u ? cnt : 1u;
}
__device__ __forceinline__ void xcd_barrier(const XcdBarrier& b) {
    asm volatile("s_waitcnt vmcnt(0)" ::: "memory");
    __syncthreads();
    if (threadIdx.x == 0) {
        unsigned* bar = b.bar;
        __builtin_amdgcn_s_waitcnt(0);
        unsigned nloc = b.st[0], nx = b.st[1];
        if (nloc == 0u) { xcd_barrier_complete(bar, b.x, nloc, nx); b.st[0] = nloc; b.st[1] = nx; }
        const unsigned old = xb_add(&bar[XB_XSUB(b.x)], 1u);
        const unsigned gen = old / nloc;
        if (old + 1u == (gen + 1u) * nloc) {
            __builtin_amdgcn_fence(__ATOMIC_RELEASE, "agent");
            asm volatile("s_waitcnt vmcnt(0)" ::: "memory");
            const unsigned og = xb_add(&bar[XB_TOP], 1u);
            const unsigned tg = og / nx;
            if (og + 1u == (tg + 1u) * nx) xb_add(&bar[XB_TOPGEN], 1u);
            else XB_SPIN(xb_ld(&bar[XB_TOPGEN]) == tg, bar);
            __builtin_amdgcn_fence(__ATOMIC_ACQUIRE, "agent");
            xb_add(&bar[XB_XGEN(b.x)], 1u);
            asm volatile("s_waitcnt vmcnt(0)" ::: "memory");
        } else {
            XB_SPIN(xb_ld(&bar[XB_XGEN(b.x)]) == gen, bar);
            __builtin_amdgcn_fence(__ATOMIC_ACQUIRE, "agent");
            asm volatile("s_waitcnt vmcnt(0)" ::: "memory");
        }
    }
    __syncthreads();
}

namespace pg8 {
#define PG8_LAS __attribute__((address_space(3)))
typedef unsigned short bf16_t;
typedef short bf16x8 __attribute__((ext_vector_type(8)));
typedef float f32x4 __attribute__((ext_vector_type(4)));
typedef unsigned u32x4 __attribute__((ext_vector_type(4)));
constexpr int BM = 256, BK = 64, HALF = 128, HTB = HALF * BK * 2  , STAGE_BYTES = 8 * HTB, NXCD = 8, WGM = 8;

__host__ __device__ __forceinline__ int lds_byte(int r, int c) { const int st = (r >> 4) * 2 + (c >> 5), rr = r & 15, cc = c & 31, ob = rr * 64 + cc * 2; return st * 1024 + (ob ^ (((ob >> 9) & 1) << 5)); }
__host__ __device__ __forceinline__ void stage_rc(int b, int& R, int& C) { const int st = b / 1024, sb = b % 1024, swz = sb ^ (((sb >> 9) & 1) << 5); R = (st >> 1) * 16 + swz / 64; C = (st & 1) * 32 + (swz % 64) / 2; }
__host__ __device__ __forceinline__ int perm32(int rho) { const int n = rho >> 4, i = rho & 15; return 8 * (i >> 2) + 4 * n + (i & 3); }

struct Unit { int pm, pn, kofs; };
struct Gemm { const bf16_t* A; const bf16_t* Bt; int M, N, K, ld; };

struct StaticOrder {
    int nM, nN, nwg, G, c;
    __host__ __device__ void init(int M, int N, int G_, int c_) { nM = M / BM; nN = N / BM; nwg = nM * nN; G = G_; c = c_; }
    __host__ __device__ bool next(int i, Unit& u) const {
        const long L = (long)i * G + c; if (L >= nwg) return false;
        int wgid = (int)L; { const int q = nwg / NXCD, r = nwg % NXCD, xcd = wgid % NXCD, off = wgid / NXCD; wgid = (xcd < r ? xcd * (q + 1) : r * (q + 1) + (xcd - r) * q) + off; }
        const int nig = WGM * nN, gid = wgid / nig, fm = gid * WGM, gsz = (nM - fm) < WGM ? (nM - fm) : WGM;
        u.pm = fm + ((wgid % nig) % gsz); u.pn = (wgid % nig) / gsz; u.kofs = 0; return true;
    }
    __device__ __forceinline__ void a_ready(const Unit&) const {}
    __device__ __forceinline__ void done(const Unit&) const {}
};

__device__ __forceinline__ unsigned cvt_pk_bf16(float lo, float hi) { unsigned r; asm volatile("v_cvt_pk_bf16_f32 %0, %1, %2" : "=v"(r) : "v"(lo), "v"(hi)); return r; }
typedef float f32x2 __attribute__((ext_vector_type(2)));
__device__ __forceinline__ f32x2 gelu_pk(f32x2 v) {
    const f32x2 av = __builtin_elementwise_abs(v), d = av * 0.2316418882f + 1.0f;
    f32x2 t; t.x = __builtin_amdgcn_rcpf(d.x); t.y = __builtin_amdgcn_rcpf(d.y);
    f32x2 q = t * 0.5307027145f + (-0.7265760135f); q = q * t + 0.7107068705f; q = q * t + (-0.142248368f); q = q * t + 0.127414796f; q = q * t;
    const f32x2 s = (v * v) * (-0.72134752044f);
    f32x2 e; e.x = __builtin_amdgcn_exp2f(s.x); e.y = __builtin_amdgcn_exp2f(s.y);
    const f32x2 m = v * (q * e), r = v - m;
    f32x2 o; o.x = v.x < 0.f ? m.x : r.x; o.y = v.y < 0.f ? m.y : r.y; return o;
}

template <int ACT  > struct EpiBf16 {
    static constexpr bool PERM = true, AFTER_DRAIN = false; static_assert(ACT == 0 || ACT == 1, "EpiBf16: ACT is 0 (none) or 1 (gelu_pk)");
    bf16_t* O; int ldc; const float* bias; int split_cols; size_t split_stride; float scale0;
    __device__ __forceinline__ void operator()(const f32x4 (&acc)[2][2][4][2], const Unit& u, int wr, int wc, int fr, int fq) const {
        const int row0 = u.pm * BM + wr * 64 + fr; int colt = u.pn * BM; bf16_t* base = O;
        float sc = 1.f; if (split_cols) { const int t = colt / split_cols; base += (size_t)t * split_stride; colt -= t * split_cols; if (t == 0) sc = scale0; }
        const int col0 = colt + wc * 32 + 8 * fq, bcol0 = u.pn * BM + wc * 32 + 8 * fq;
        f32x4 bv[2][2];
#pragma unroll
        for (int bj = 0; bj < 2; ++bj)
#pragma unroll
            for (int n = 0; n < 2; ++n) bv[bj][n] = bias ? *(const f32x4*)(bias + bcol0 + bj * HALF + 4 * n) : (f32x4){0.f, 0.f, 0.f, 0.f};
#pragma unroll
        for (int ai = 0; ai < 2; ++ai)
#pragma unroll
            for (int m = 0; m < 4; ++m) { bf16_t* rowp = base + (size_t)(row0 + ai * HALF + m * 16) * ldc + col0;
#pragma unroll
                for (int bj = 0; bj < 2; ++bj) { f32x4 v0 = acc[ai][bj][m][0] + bv[bj][0], v1 = acc[ai][bj][m][1] + bv[bj][1];
                    if (ACT == 1) { f32x2 a = gelu_pk((f32x2){v0[0], v0[1]}), b = gelu_pk((f32x2){v0[2], v0[3]}), c = gelu_pk((f32x2){v1[0], v1[1]}), d = gelu_pk((f32x2){v1[2], v1[3]});
                        v0 = (f32x4){a.x, a.y, b.x, b.y}; v1 = (f32x4){c.x, c.y, d.x, d.y}; }
                    v0 = v0 * sc; v1 = v1 * sc; u32x4 w; w.x = cvt_pk_bf16(v0[0], v0[1]); w.y = cvt_pk_bf16(v0[2], v0[3]); w.z = cvt_pk_bf16(v1[0], v1[1]); w.w = cvt_pk_bf16(v1[2], v1[3]);
                    *(u32x4*)(rowp + bj * HALF) = w; } }
    }
};


struct EpiF32 {
    static constexpr bool PERM = false, AFTER_DRAIN = false;
    float* C; int ldc; const float* bias;
    __device__ __forceinline__ void operator()(const f32x4 (&acc)[2][2][4][2], const Unit& u, int wr, int wc, int fr, int fq) const {
        const int row0 = u.pm * BM + wr * 64 + fr, col0 = u.pn * BM + wc * 32 + 4 * fq;
        f32x4 bv[2][2];
#pragma unroll
        for (int bj = 0; bj < 2; ++bj)
#pragma unroll
            for (int n = 0; n < 2; ++n) bv[bj][n] = bias ? *(const f32x4*)(bias + col0 + bj * HALF + n * 16) : (f32x4){0.f, 0.f, 0.f, 0.f};
#pragma unroll
        for (int ai = 0; ai < 2; ++ai)
#pragma unroll
            for (int m = 0; m < 4; ++m) { float* rowp = C + (size_t)(row0 + ai * HALF + m * 16) * ldc + col0;
#pragma unroll
                for (int bj = 0; bj < 2; ++bj)
#pragma unroll
                    for (int n = 0; n < 2; ++n) *(f32x4*)(rowp + bj * HALF + n * 16) = acc[ai][bj][m][n] + bv[bj][n]; }
    }
};

template <class Epi, class Sched, bool ALIGN_EPI = false, bool SP2 = false>
__device__ __forceinline__ void gemm_phase(PG8_LAS unsigned char* lds, const Gemm g, const Sched& S, const Epi& E) {
    int tid_l = threadIdx.x; asm volatile("" : "+v"(tid_l));
    const int tid = tid_l, wid = __builtin_amdgcn_readfirstlane(tid >> 6), lane = tid & 63, wr = wid >> 2, wc = wid & 3, fr = lane & 15, fq = lane >> 4;
    const int K = g.K, nt = K / BK;
    unsigned voffA[2], voffB[2];
#pragma unroll
    for (int i = 0; i < 2; ++i) { int R, C; stage_rc(tid * 16 + i * 8192, R, C); const int Rb = Epi::PERM ? ((R & ~31) + perm32(R & 31)) : R;
        voffA[i] = (unsigned)(R * g.ld + C) * 2u; voffB[i] = (unsigned)(Rb * g.ld + C) * 2u; }
    const size_t kstep = (size_t)(BK * 2);
    const size_t hstep = (size_t)HALF * g.ld * 2;
    const size_t tstep = 2 * hstep;
    const unsigned ldsw = (unsigned)wid * 1024u;
    const int aoff = lds_byte(wr * 64 + fr, fq * 8), boff = lds_byte(wc * 32 + fr, fq * 8);
#define PG8_SA(b, h) (((b) * 2 + (h)) * HTB)
#define PG8_SB(b, h) ((4 + (b) * 2 + (h)) * HTB)
#define PG8_STAGE(bufoff, gbase, voff) do { _Pragma("unroll") for (int _i = 0; _i < 2; ++_i) \
        __builtin_amdgcn_global_load_lds((const unsigned*)((const char*)(gbase) + (voff)[_i]), (PG8_LAS unsigned*)(lds + (bufoff) + ldsw + _i * 8192), 16, 0, 0); } while (0)
#define PG8_LDA(dst, b, h) do { _Pragma("unroll") for (int m = 0; m < 4; ++m) _Pragma("unroll") for (int k = 0; k < 2; ++k) dst[m][k] = *(const PG8_LAS bf16x8*)(lds + PG8_SA(b, h) + aoff + m * 2048 + k * 1024); } while (0)
#define PG8_LDB(dst, b, h) do { _Pragma("unroll") for (int n = 0; n < 2; ++n) _Pragma("unroll") for (int k = 0; k < 2; ++k) dst[n][k] = *(const PG8_LAS bf16x8*)(lds + PG8_SB(b, h) + boff + n * 2048 + k * 1024); } while (0)
#define PG8_MMA(ai, bj, At, Bt) do { __builtin_amdgcn_s_setprio(1); _Pragma("unroll") for (int m = 0; m < 4; ++m) _Pragma("unroll") for (int n = 0; n < 2; ++n) _Pragma("unroll") for (int k = 0; k < 2; ++k) \
        acc[ai][bj][m][n] = __builtin_amdgcn_mfma_f32_16x16x32_bf16(Bt[n][k], At[m][k], acc[ai][bj][m][n], 0, 0, 0); __builtin_amdgcn_s_setprio(0); } while (0)
#define PG8_WAIT_V(n) asm volatile("s_waitcnt vmcnt(" #n ")" ::: "memory")
#define PG8_WAIT_L(n) asm volatile("s_waitcnt lgkmcnt(" #n ")" ::: "memory")
#define PG8_BAR __builtin_amdgcn_s_barrier()
#define PG8_SCHED __builtin_amdgcn_sched_barrier(0)
    Unit cur, nxt; int ui = 0;
    if (!S.next(0, cur)) return;
    f32x4 acc[2][2][4][2];
#pragma unroll
    for (int a = 0; a < 2; ++a)
#pragma unroll
        for (int b = 0; b < 2; ++b)
#pragma unroll
            for (int m = 0; m < 4; ++m)
#pragma unroll
                for (int n = 0; n < 2; ++n) acc[a][b][m][n] = (f32x4){0.f, 0.f, 0.f, 0.f};
    bf16x8 At[4][2], B0[2][2], B1[2][2];
    const char* cA = (const char*)g.A + (size_t)cur.pm * tstep + (size_t)cur.kofs * 2; const char* cB = (const char*)g.Bt + (size_t)cur.pn * tstep + (size_t)cur.kofs * 2;
    S.a_ready(cur);
    if constexpr (SP2) {
        PG8_STAGE(PG8_SB(0, 0), cB, voffB); PG8_STAGE(PG8_SB(0, 1), cB + hstep, voffB); PG8_STAGE(PG8_SA(0, 0), cA, voffA); PG8_STAGE(PG8_SA(0, 1), cA + hstep, voffA);
        if (wr == 1) PG8_BAR;
        PG8_WAIT_V(2); PG8_BAR;
        PG8_STAGE(PG8_SB(1, 0), cB + kstep, voffB); PG8_STAGE(PG8_SA(1, 0), cA + kstep, voffA); PG8_STAGE(PG8_SB(1, 1), cB + hstep + kstep, voffB);
        PG8_WAIT_V(6); PG8_BAR;
    } else {
        PG8_STAGE(PG8_SB(0, 0), cB, voffB); PG8_STAGE(PG8_SA(0, 0), cA, voffA); PG8_STAGE(PG8_SB(0, 1), cB + hstep, voffB); PG8_STAGE(PG8_SA(0, 1), cA + hstep, voffA);
        if (wr == 1) PG8_BAR;
        PG8_WAIT_V(4); PG8_BAR;
        PG8_STAGE(PG8_SB(1, 0), cB + kstep, voffB); PG8_STAGE(PG8_SA(1, 0), cA + kstep, voffA); PG8_STAGE(PG8_SB(1, 1), cB + hstep + kstep, voffB);
        PG8_WAIT_V(6); PG8_BAR;
    }
    for (;;) {
        const bool has_next = S.next(ui + 1, nxt);
        const char* nA = has_next ? (const char*)g.A + (size_t)nxt.pm * tstep + (size_t)nxt.kofs * 2 : cA; const char* nB = has_next ? (const char*)g.Bt + (size_t)nxt.pn * tstep + (size_t)nxt.kofs * 2 : cB;
        for (int t = 0; t < nt; t += 2) {
            const bool last = (t == nt - 2);
            const char* a1 = cA + (size_t)(t + 1) * kstep;
            const char* a2 = last ? nA : cA + (size_t)(t + 2) * kstep; const char* b2 = last ? nB : cB + (size_t)(t + 2) * kstep;
            const char* a3 = a2 + kstep; const char* b3 = b2 + kstep;
            if (last && has_next) S.a_ready(nxt);
            if constexpr (SP2) {
            PG8_LDB(B0, 0, 0); PG8_LDB(B1, 0, 1); PG8_SCHED; PG8_LDA(At, 0, 0); PG8_STAGE(PG8_SA(1, 1), a1 + hstep, voffA);
            PG8_WAIT_V(8); PG8_WAIT_L(0); PG8_BAR; PG8_MMA(0, 0, At, B0); PG8_MMA(0, 1, At, B1); PG8_BAR; PG8_SCHED;
            PG8_LDA(At, 0, 1); PG8_STAGE(PG8_SB(0, 0), b2, voffB); PG8_STAGE(PG8_SB(0, 1), b2 + hstep, voffB); PG8_STAGE(PG8_SA(0, 0), a2, voffA);
            PG8_WAIT_V(8); PG8_WAIT_L(0); PG8_BAR; PG8_MMA(1, 0, At, B0); PG8_MMA(1, 1, At, B1); PG8_BAR; PG8_SCHED;
            PG8_LDB(B0, 1, 0); PG8_LDB(B1, 1, 1); PG8_SCHED; PG8_LDA(At, 1, 0); PG8_STAGE(PG8_SA(0, 1), a2 + hstep, voffA);
            PG8_WAIT_V(8); PG8_WAIT_L(0); PG8_BAR; PG8_MMA(0, 0, At, B0); PG8_MMA(0, 1, At, B1); PG8_BAR; PG8_SCHED;
            PG8_LDA(At, 1, 1); PG8_STAGE(PG8_SB(1, 0), b3, voffB); PG8_STAGE(PG8_SB(1, 1), b3 + hstep, voffB); PG8_STAGE(PG8_SA(1, 0), a3, voffA);
            PG8_WAIT_V(8); PG8_WAIT_L(0); PG8_BAR; PG8_MMA(1, 0, At, B0); PG8_MMA(1, 1, At, B1); PG8_BAR; PG8_SCHED;
            } else {
            PG8_LDB(B0, 0, 0); PG8_SCHED; PG8_LDA(At, 0, 0); PG8_STAGE(PG8_SA(1, 1), a1 + hstep, voffA);
            PG8_WAIT_L(8); PG8_BAR; PG8_WAIT_L(0); PG8_MMA(0, 0, At, B0); PG8_BAR; PG8_SCHED;
            PG8_LDB(B1, 0, 1); PG8_STAGE(PG8_SB(0, 0), b2, voffB);
            PG8_BAR; PG8_WAIT_L(0); PG8_MMA(0, 1, At, B1); PG8_BAR;
            PG8_LDA(At, 0, 1); PG8_STAGE(PG8_SA(0, 0), a2, voffA);
            PG8_BAR; PG8_WAIT_L(0); PG8_MMA(1, 0, At, B0); PG8_BAR; PG8_SCHED;
            PG8_STAGE(PG8_SB(0, 1), b2 + hstep, voffB);
            PG8_WAIT_V(6); PG8_BAR; PG8_MMA(1, 1, At, B1); PG8_BAR;
            PG8_LDB(B0, 1, 0); PG8_SCHED; PG8_LDA(At, 1, 0); PG8_STAGE(PG8_SA(0, 1), a2 + hstep, voffA);
            PG8_WAIT_L(8); PG8_BAR; PG8_WAIT_L(0); PG8_MMA(0, 0, At, B0); PG8_BAR; PG8_SCHED;
            PG8_LDB(B1, 1, 1); PG8_STAGE(PG8_SB(1, 0), b3, voffB);
            PG8_BAR; PG8_WAIT_L(0); PG8_MMA(0, 1, At, B1); PG8_BAR;
            PG8_LDA(At, 1, 1); PG8_STAGE(PG8_SA(1, 0), a3, voffA);
            PG8_BAR; PG8_WAIT_L(0); PG8_MMA(1, 0, At, B0); PG8_BAR; PG8_SCHED;
            PG8_STAGE(PG8_SB(1, 1), b3 + hstep, voffB);
            PG8_WAIT_V(6); PG8_BAR; PG8_MMA(1, 1, At, B1); PG8_BAR;
            }
        }
        if constexpr (ALIGN_EPI) { if (wr == 0) PG8_BAR; }
        if constexpr (!Epi::AFTER_DRAIN) { E(acc, cur, wr, wc, fr, fq); S.done(cur); }
        if (!has_next) break;
#pragma unroll
        for (int a = 0; a < 2; ++a)
#pragma unroll
            for (int b = 0; b < 2; ++b)
#pragma unroll
                for (int m = 0; m < 4; ++m)
#pragma unroll
                    for (int n = 0; n < 2; ++n) acc[a][b][m][n] = (f32x4){0.f, 0.f, 0.f, 0.f};
        cur = nxt; cA = nA; cB = nB; ++ui;
        if constexpr (ALIGN_EPI) { if (wr == 1) PG8_BAR; }
    }
    PG8_WAIT_V(0);
    if constexpr (!ALIGN_EPI) { if (wr == 0) PG8_BAR; }
    PG8_BAR;
    if constexpr (Epi::AFTER_DRAIN) { E.fused(acc, cur, wr, wc, fr, fq, lds, wid, lane); S.done(cur); }
#undef PG8_SA
#undef PG8_SB
#undef PG8_STAGE
#undef PG8_LDA
#undef PG8_LDB
#undef PG8_MMA
#undef PG8_WAIT_V
#undef PG8_WAIT_L
#undef PG8_BAR
#undef PG8_SCHED
}
}
namespace pg8 {
struct SplitKOrder {
    int G, c;
    __host__ __device__ void init(int G_, int c_) { G = G_; c = c_; }
    __host__ __device__ bool next(int i, Unit& u) const { const long L = (long)i * G + c; if (L >= 128) return false; const int ks = (int)L >> 4, r = (int)L & 15; u.pm = r >> 3; u.pn = r & 7; u.kofs = ks * 256; return true; }
    __device__ __forceinline__ void a_ready(const Unit&) const {}
    __device__ __forceinline__ void done(const Unit&) const {}
};
struct EpiF32Part {
    static constexpr bool PERM = false, AFTER_DRAIN = false;
    float* C;
    __device__ __forceinline__ void operator()(const f32x4 (&acc)[2][2][4][2], const Unit& u, int wr, int wc, int fr, int fq) const {
        const int row0 = u.pm * BM + wr * 64 + fr, col0 = u.pn * BM + wc * 32 + 4 * fq; float* base = C + (size_t)(u.kofs >> 8) * 512 * 2048;
#pragma unroll
        for (int ai = 0; ai < 2; ++ai)
#pragma unroll
            for (int m = 0; m < 4; ++m) { float* rowp = base + (size_t)(row0 + ai * HALF + m * 16) * 2048 + col0;
#pragma unroll
                for (int bj = 0; bj < 2; ++bj)
#pragma unroll
                    for (int n = 0; n < 2; ++n) *(f32x4*)(rowp + bj * HALF + n * 16) = acc[ai][bj][m][n]; }
    }
};
}
#define PG8_SP2 true
#define PG8_ALIGN true

#define LDS_FENCE() asm volatile("s_waitcnt lgkmcnt(0)" ::: "memory")
__device__ __forceinline__ unsigned f2bf(float f) { unsigned u = __builtin_bit_cast(unsigned, f); return (u + 0x7fffu + ((u >> 16) & 1u)) >> 16; }
__device__ __forceinline__ unsigned pk2(float lo, float hi) { return f2bf(lo) | (f2bf(hi) << 16); }
__device__ __forceinline__ float wave_sum(float v) {
#pragma unroll
    for (int o = 1; o < 64; o <<= 1) v += __shfl_xor(v, o);
    return v;
}
__device__ __forceinline__ float wave_max(float v) {
#pragma unroll
    for (int o = 1; o < 64; o <<= 1) v = fmaxf(v, __shfl_xor(v, o));
    return v;
}
__device__ __forceinline__ float silu_f(float x) { return x / (1.0f + __expf(-x)); }
__device__ __forceinline__ float gelu_f(float v) {
    const float t = __builtin_amdgcn_rcpf(fabsf(v) * 0.2316418882f + 1.0f);
    float q = t * 0.5307027145f + (-0.7265760135f); q = q * t + 0.7107068705f; q = q * t + (-0.142248368f); q = q * t + 0.127414796f; q = q * t;
    const float m = v * (q * __builtin_amdgcn_exp2f(v * v * (-0.72134752044f)));
    return v < 0.f ? m : v - m;
}
__device__ __forceinline__ float log_sigmoid_f(float z) { return fminf(z, 0.0f) - __logf(1.0f + __expf(-fabsf(z))); }


__device__ __forceinline__ float bflo(unsigned w) { return __builtin_bit_cast(float, w << 16); }
__device__ __forceinline__ float bfhi(unsigned w) { return __builtin_bit_cast(float, w & 0xffff0000u); }
__device__ __forceinline__ void unpack8(const u32x4 w, float (&f)[8]) { f[0] = bflo(w.x); f[1] = bfhi(w.x); f[2] = bflo(w.y); f[3] = bfhi(w.y); f[4] = bflo(w.z); f[5] = bfhi(w.z); f[6] = bflo(w.w); f[7] = bfhi(w.w); }
__device__ __forceinline__ u32x4 pack8(const float (&f)[8]) { u32x4 o; o.x = pk2(f[0], f[1]); o.y = pk2(f[2], f[3]); o.z = pk2(f[4], f[5]); o.w = pk2(f[6], f[7]); return o; }


__device__ __forceinline__ u32x6 pack_fp6_2x16(const f32x16 a, const f32x16 b) { u32x6 r; asm("v_cvt_scalef32_2xpk16_fp6_f32 %0, %1, %2, 1.0" : "=&v"(r) : "v"(a), "v"(b)); return r; }
__device__ __forceinline__ f32x32 unpack_fp6_32(const u32x6 w) { f32x32 r; asm volatile("v_cvt_scalef32_pk32_f32_fp6 %0, %1, 1.0" : "=&v"(r) : "v"(w)); return r; }

struct Params {
    const float* in[19];
    float* out;
    unsigned char* ws;
    int ph_lo, ph_hi;
};
enum { I_X = 0, I_C, I_CTX, I_CCTX, I_WADA, I_BADA, I_WIN, I_CONVW, I_GW2, I_GB2, I_GNORM, I_SINK, I_WOUT, I_LNG, I_LNB, I_PWQ, I_PSUB, I_PU, I_PV };

__device__ __forceinline__ int row_stream(int r) { return r < TL ? r / SEQ : 2; }

__device__ __forceinline__ void transpose_item(const float* W, int K, int N, bf16_t* WT, LAS float* scr, int item, int lane) {
    const int nblk = N / 32, kb = item / nblk, nb = item % nblk, k0 = 64 * kb, n0 = 32 * nb;
#pragma unroll 8
    for (int i = 0; i < 32; ++i) { const int kk = 2 * i + (lane >> 5); scr[kk * 33 + (lane & 31)] = W[(size_t)(k0 + kk) * N + n0 + (lane & 31)]; }
    LDS_FENCE();
    const int c = lane & 7;
#pragma unroll
    for (int j = 0; j < 4; ++j) { const int n = (lane >> 3) + 8 * j; const LAS float* s = scr + (8 * c) * 33 + n;
        u32x4 o; o.x = pk2(s[0 * 33], s[1 * 33]); o.y = pk2(s[2 * 33], s[3 * 33]); o.z = pk2(s[4 * 33], s[5 * 33]); o.w = pk2(s[6 * 33], s[7 * 33]);
        *(u32x4*)(WT + (size_t)(n0 + n) * K + k0 + 8 * c) = o; }
    LDS_FENCE();
}

__device__ __forceinline__ void phase_prologue(const Params& p, LAS unsigned char* lds, int tid, int lane, int wave, int bid, int G) {
    const int gw = bid * NWAVES + wave, NGW = G * NWAVES;
    LAS float* scr = (LAS float*)(lds + wave * 16384);
    bf16_t* WIN = (bf16_t*)(p.ws + WS_WIN); bf16_t* WOUT = (bf16_t*)(p.ws + WS_WOUT); bf16_t* WQ = (bf16_t*)(p.ws + WS_WQ);
    constexpr int IT_IN = (DM / 64) * (INW / 32), IT_SQ = (DM / 64) * (DM / 32), IT_L = IT_IN + 2 * IT_SQ;
    for (int it = gw; it < DEPTH * IT_L; it += NGW) {
        const int l = it / IT_L; int r = it % IT_L;
        if (r < IT_IN) { transpose_item(p.in[I_WIN] + (size_t)l * DM * INW, DM, INW, WIN + (size_t)l * INWP * DM, scr, r, lane); continue; } r -= IT_IN;
        if (r < IT_SQ) { transpose_item(p.in[I_WOUT] + (size_t)l * DM * DM, DM, DM, WOUT + (size_t)l * DM * DM, scr, r, lane); continue; } r -= IT_SQ;
        transpose_item(p.in[I_PWQ] + (size_t)l * DM * DM, DM, DM, WQ + (size_t)l * DM * DM, scr, r, lane);
    }
    {
        constexpr int PADV = (INWP - INW) * DM / 8;
        const int gt = bid * NTHREADS + tid, NGT = G * NTHREADS;
        for (int i = gt; i < DEPTH * PADV; i += NGT) { const int l = i / PADV, o = i % PADV;
            *(u32x4*)(WIN + (size_t)l * INWP * DM + (size_t)INW * DM + (size_t)o * 8) = (u32x4){0u, 0u, 0u, 0u}; }
    }
    {
        const float* U = p.in[I_PU]; const float* V = p.in[I_PV];
        unsigned char* UB = p.ws + WS_UB; unsigned char* VB = p.ws + WS_VB; float* USC = (float*)(p.ws + WS_USC); (void)USC; float* VSC = (float*)(p.ws + WS_VSC); (void)VSC;
        for (size_t row = gw; row < (size_t)DEPTH * NEXP; row += NGW) {
            f32x4 xx[2][8];
#pragma unroll
            for (int tb = 0; tb < 2; ++tb)
#pragma unroll
                for (int j = 0; j < 8; ++j) xx[tb][j] = *(const f32x4*)((tb ? V : U) + row * DM + lane * 32 + 4 * j);
#pragma unroll
            for (int tb = 0; tb < 2; ++tb) {
                f32x4 x[8]; float am = 0.f;
#pragma unroll
                for (int j = 0; j < 8; ++j) { x[j] = xx[tb][j]; am = fmaxf(am, fmaxf(fmaxf(fabsf(x[j].x), fabsf(x[j].y)), fmaxf(fabsf(x[j].z), fabsf(x[j].w)))); }
                if (tb == 0 && TBL_U_I4) {
#if U_ROWSCALE
                    unsigned char* dst = UB + row * ROWB_U;
                    float ssq = 0.f;
#pragma unroll
                    for (int j = 0; j < 8; ++j) ssq += (x[j].x * x[j].x + x[j].y * x[j].y) + (x[j].z * x[j].z + x[j].w * x[j].w);
                    const float amr = wave_max(am), rms = sqrtf(wave_sum(ssq) * (1.0f / DM));
                    const float srow = amr > 0.f ? fminf(amr * (1.0f / 7.0f), 0.36f * rms) : 1.0f; const float inv = 1.0f / srow; const int code = 0; (void)code;
                    if (lane == 0) USC[row] = srow;
#else
                    unsigned char* dst = UB + row * ROWB4;
                    const float sb = am * (1.0f / 7.0f); const unsigned ub = (__builtin_bit_cast(unsigned, sb) + 0x000fffffu) & 0xfff00000u;
                    int code = ((int)ub - (int)I4_BASE) >> 20; code = code < 0 ? 0 : (code > 255 ? 255 : code);
                    const float inv = 1.0f / __builtin_bit_cast(float, ((unsigned)code << 20) + I4_BASE);
#endif
                    u32x4 w;
#pragma unroll
                    for (int d = 0; d < 4; ++d) { unsigned t = 0u;
#pragma unroll
                        for (int e = 0; e < 8; ++e) { const float xv = (e < 4 ? x[2 * d] : x[2 * d + 1])[e & 3];
                            int q = (int)__builtin_rintf(xv * inv); q = q < -7 ? -7 : (q > 7 ? 7 : q); t |= ((unsigned)q & 15u) << (4 * e); }
                        w[d] = t; }
                    *(u32x4*)(dst + lane * 16) = w;
#if !U_ROWSCALE
                    dst[1024 + lane] = (unsigned char)code;
#endif
                } else if (tb == 1 && V_ROWSCALE) {
                    unsigned char* dst = VB + row * ROWB_V;
                    float ssq = 0.f;
#pragma unroll
                    for (int j = 0; j < 8; ++j) ssq += (x[j].x * x[j].x + x[j].y * x[j].y) + (x[j].z * x[j].z + x[j].w * x[j].w);
                    const float amr = wave_max(am), rms = sqrtf(wave_sum(ssq) * (1.0f / DM));
                    const float srow = amr > 0.f ? fminf(amr * (1.0f / 6.0f), (2.8f / 6.0f) * rms) : 1.0f; const float inv = 1.0f / srow;
                    if (lane == 0) VSC[row] = srow;
                    u32x4 w;
#pragma unroll
                    for (int d = 0; d < 4; ++d) { unsigned t = 0u;
                        t = __builtin_amdgcn_cvt_scalef32_pk_fp4_f32(t, x[2 * d].x * inv, x[2 * d].y * inv, 1.0f, 0); t = __builtin_amdgcn_cvt_scalef32_pk_fp4_f32(t, x[2 * d].z * inv, x[2 * d].w * inv, 1.0f, 1);
                        t = __builtin_amdgcn_cvt_scalef32_pk_fp4_f32(t, x[2 * d + 1].x * inv, x[2 * d + 1].y * inv, 1.0f, 2); t = __builtin_amdgcn_cvt_scalef32_pk_fp4_f32(t, x[2 * d + 1].z * inv, x[2 * d + 1].w * inv, 1.0f, 3);
                        w[d] = t; }
                    *(u32x4*)(dst + lane * 16) = w;
                } else if (tb == 1 || TBL_U_FP4) {
                    unsigned char* dst = (tb ? VB : UB) + row * ROWB4;
                    const float sb = am * (1.0f / 6.0f); unsigned ub = __builtin_bit_cast(unsigned, sb); ub = (ub & 0x007fffffu) ? ((ub & 0x7f800000u) + 0x00800000u) : (ub & 0x7f800000u);
                    if (!(am > 0.f) || ub < 0x00800000u) ub = 0x00800000u;
                    const float scl = __builtin_bit_cast(float, ub);
                    u32x4 w;
#pragma unroll
                    for (int d = 0; d < 4; ++d) { unsigned t = 0u;
                        t = __builtin_amdgcn_cvt_scalef32_pk_fp4_f32(t, x[2 * d].x, x[2 * d].y, scl, 0); t = __builtin_amdgcn_cvt_scalef32_pk_fp4_f32(t, x[2 * d].z, x[2 * d].w, scl, 1);
                        t = __builtin_amdgcn_cvt_scalef32_pk_fp4_f32(t, x[2 * d + 1].x, x[2 * d + 1].y, scl, 2); t = __builtin_amdgcn_cvt_scalef32_pk_fp4_f32(t, x[2 * d + 1].z, x[2 * d + 1].w, scl, 3);
                        w[d] = t; }
                    *(u32x4*)(dst + lane * 16) = w; dst[1024 + lane] = (unsigned char)(ub >> 23);
                } else {
                    unsigned char* dst = UB + row * ROWB;
                    am = wave_max(am);
                    const float inv = am > 0.f ? 7.0f / am : 0.f;
                    f32x16 x0, x1;
#pragma unroll
                    for (int j = 0; j < 4; ++j) { x0[4 * j + 0] = x[j].x * inv; x0[4 * j + 1] = x[j].y * inv; x0[4 * j + 2] = x[j].z * inv; x0[4 * j + 3] = x[j].w * inv;
                        x1[4 * j + 0] = x[4 + j].x * inv; x1[4 * j + 1] = x[4 + j].y * inv; x1[4 * j + 2] = x[4 + j].z * inv; x1[4 * j + 3] = x[4 + j].w * inv; }
                    const u32x6 w = pack_fp6_2x16(x0, x1);
                    *(u32x4*)(dst + lane * 16) = (u32x4){w[0], w[1], w[2], w[3]}; *(u32x2*)(dst + 1024 + lane * 8) = (u32x2){w[4], w[5]};
                    if (lane == 0) USC[row] = am * (1.0f / 7.0f);
                }
            }
        }
        const size_t gt = (size_t)bid * NTHREADS + tid, NGT = (size_t)G * NTHREADS;
        const float* SUB = p.in[I_PSUB]; bf16_t* SUBB = (bf16_t*)(p.ws + WS_SUBB);
        for (size_t i = gt; i < (size_t)DEPTH * 2 * 128 * 128 / 2; i += NGT) ((unsigned*)SUBB)[i] = pk2(SUB[2 * i], SUB[2 * i + 1]);
    }
    __syncthreads();
    LAS float* sc = (LAS float*)lds;
    LAS float* red = (LAS float*)(lds + 32768);
    for (int i = tid; i < 3 * DM; i += NTHREADS) { const int s = i / DM, k = i % DM; const float v = s < 2 ? p.in[I_C][s * DM + k] : p.in[I_CCTX][k]; sc[i] = silu_f(v); }
    __syncthreads();
    float* MOD = (float*)(p.ws + WS_MOD);
    LAS float* red2 = (LAS float*)(lds + 32768);
    constexpr int NCH = 6 * DM / 256;
    for (int it = bid; it < DEPTH * NCH; it += G) {
        const int l = it / NCH, n0 = (it % NCH) * 256;
        const float* wp = p.in[I_WADA] + (size_t)l * DM * 6 * DM + n0 + lane * 4;
        f32x4 a0 = (f32x4){0.f, 0.f, 0.f, 0.f}, a1 = a0, a2 = a0;
        const int kb = wave * (DM / NWAVES);
#pragma unroll 16
        for (int k = kb; k < kb + DM / NWAVES; ++k) { const f32x4 w = *(const f32x4*)(wp + (size_t)k * 6 * DM); a0 += w * sc[k]; a1 += w * sc[DM + k]; a2 += w * sc[2 * DM + k]; }
        *(LAS f32x4*)(red2 + (wave * 3 + 0) * 256 + lane * 4) = a0; *(LAS f32x4*)(red2 + (wave * 3 + 1) * 256 + lane * 4) = a1; *(LAS f32x4*)(red2 + (wave * 3 + 2) * 256 + lane * 4) = a2;
        __syncthreads();
        for (int i = tid; i < 768; i += NTHREADS) { const int st = i >> 8, c = i & 255; float v = 0.f;
#pragma unroll
            for (int w = 0; w < NWAVES; ++w) v += red2[(w * 3 + st) * 256 + c];
            MOD[((size_t)l * 3 + st) * 6 * DM + n0 + c] = v + p.in[I_BADA][(size_t)l * 6 * DM + n0 + c]; }
        __syncthreads();
    }
}


__device__ __forceinline__ int row_first(int wave, int bid, int G) { const int gw = bid * NWAVES + wave; return gw < TL ? gw : -1; }
__device__ __forceinline__ int row_next(int r, int wave, int bid, int G, int nrows) {
    const int NGW = G * NWAVES;
    if (r < TL) { if (r + NGW < TL) return r + NGW; const int c = TL + wave * G + bid; return c < nrows ? c : -1; }
    return r + NGW < nrows ? r + NGW : -1;
}
__device__ __forceinline__ const float* xsrc(const Params& p, int l, int r) {
    return r < TL ? p.in[I_X] + (size_t)r * DM : p.in[I_CTX] + (size_t)(r - TL) * DM;
}

__device__ __forceinline__ void modulate_row(const float* xr, const float* mod, int sh_off, int sc_off, bf16_t* hb, int lane) {
    f32x4 xx[8];
#pragma unroll
    for (int j = 0; j < 8; ++j) xx[j] = *(const f32x4*)(xr + lane * 4 + 256 * j);
#pragma unroll
    for (int j = 0; j < 8; ++j) { const int c = lane * 4 + 256 * j;
        const f32x4 x = xx[j], sh = *(const f32x4*)(mod + sh_off + c), s = *(const f32x4*)(mod + sc_off + c);
        u32x2 o; o.x = pk2(x.x * (1.f + s.x) + sh.x, x.y * (1.f + s.y) + sh.y); o.y = pk2(x.z * (1.f + s.z) + sh.z, x.w * (1.f + s.w) + sh.w);
        *(u32x2*)(hb + c) = o; }
}
__device__ __forceinline__ void phase_modulate0(const Params& p, int lane, int wave, int bid, int G) {
    const int gw = bid * NWAVES + wave, NGW = G * NWAVES;
    const float* MOD = (const float*)(p.ws + WS_MOD); bf16_t* HB = (bf16_t*)(p.ws + WS_HB);
    for (int r = row_first(wave, bid, G); r >= 0; r = row_next(r, wave, bid, G, TA)) modulate_row(xsrc(p, 0, r), MOD + (size_t)(0 * 3 + row_stream(r)) * 6 * DM, 0, DM, HB + (size_t)r * DM, lane);
}

__device__ __forceinline__ void gemm_direct(const bf16_t* A, const bf16_t* Bt, float* C, int M, int N, int K, int ldc, int gw, int NGW, int lane) {
    const int nTn = N / 64, nItems = (M / 32) * nTn;
    const int fr = lane & 15, fq = lane >> 4;
    for (int it = gw; it < nItems; it += NGW) {
        const int mt = it / nTn, nt = it % nTn;
        const bf16_t* a0 = A + (size_t)(mt * 32 + fr) * K + fq * 8;
        const bf16_t* b0 = Bt + (size_t)(nt * 64 + fr) * K + fq * 8;
        f32x4 acc[2][4];
#pragma unroll
        for (int i = 0; i < 2; ++i)
#pragma unroll
            for (int j = 0; j < 4; ++j) acc[i][j] = (f32x4){0.f, 0.f, 0.f, 0.f};
#pragma unroll 2
        for (int k0 = 0; k0 < K; k0 += 32) {
            bf16x8 af[2], bfr[4];
#pragma unroll
            for (int i = 0; i < 2; ++i) af[i] = *(const bf16x8*)(a0 + (size_t)i * 16 * K + k0);
#pragma unroll
            for (int j = 0; j < 4; ++j) bfr[j] = *(const bf16x8*)(b0 + (size_t)j * 16 * K + k0);
#pragma unroll
            for (int i = 0; i < 2; ++i)
#pragma unroll
                for (int j = 0; j < 4; ++j) acc[i][j] = __builtin_amdgcn_mfma_f32_16x16x32_bf16(af[i], bfr[j], acc[i][j], 0, 0, 0);
        }
#pragma unroll
        for (int i = 0; i < 2; ++i)
#pragma unroll
            for (int j = 0; j < 4; ++j)
#pragma unroll
                for (int g = 0; g < 4; ++g) C[(size_t)(mt * 32 + i * 16 + fq * 4 + g) * ldc + nt * 64 + j * 16 + fr] = acc[i][j][g];
    }
}

__device__ __forceinline__ void phase_post_in(const Params& p, int l, int lane, int wave, int bid, int G) {
    const int gw = bid * NWAVES + wave, NGW = G * NWAVES;
    const bf16_t* P = (const bf16_t*)(p.ws + WS_P);
    bf16_t* QR = (bf16_t*)(p.ws + WS_QR); bf16_t* KR = (bf16_t*)(p.ws + WS_KR); bf16_t* VR = (bf16_t*)(p.ws + WS_ALF);
    bf16_t* MIX = (bf16_t*)(p.ws + WS_MIX);
    const float* cw = p.in[I_CONVW] + (size_t)l * 3 * 512;
    const int c8 = lane * 8, rh = lane >> 3, rf = (lane >> 2) & 1, rg = lane & 3, roff = rh * 128 + rf * 64 + rg * 8;
    float w0[8], w1[8], w2[8], invf[8];
#pragma unroll
    for (int e = 0; e < 8; ++e) { w0[e] = cw[c8 + e]; w1[e] = cw[512 + c8 + e]; w2[e] = cw[1024 + c8 + e]; invf[e] = __builtin_amdgcn_exp2f(-(float)(rg * 8 + e) * 0.4152410118609203f); }
    for (int r = row_first(wave, bid, G); r >= 0; r = row_next(r, wave, bid, G, TA)) {
        const bf16_t* pr = P + (size_t)r * INWP;
        int pos, len;
        if (r < TL) { pos = r % SEQ; len = SEQ; } else { pos = (r - TL) % CTXL; len = CTXL; }
        const bool hp = pos > 0, hn = pos < len - 1;
        const u32x4 z4 = (u32x4){0u, 0u, 0u, 0u};
        const u32x4 xC = *(const u32x4*)(pr + C_CC + c8), xX = *(const u32x4*)(pr + C_CX + c8), xB = *(const u32x4*)(pr + C_CB + c8);
        const u32x4 pC = hp ? *(const u32x4*)(pr - INWP + C_CC + c8) : z4, pX = hp ? *(const u32x4*)(pr - INWP + C_CX + c8) : z4;
        const u32x4 nC = hn ? *(const u32x4*)(pr + INWP + C_CC + c8) : z4, nX = hn ? *(const u32x4*)(pr + INWP + C_CX + c8) : z4;
        const u32x4 q1 = *(const u32x4*)(pr + C_SQ + roff), q2 = *(const u32x4*)(pr + C_SQ + roff + 32);
        u32x4 k1 = z4, k2 = z4, vv = z4;
        if (lane < 16) { k1 = *(const u32x4*)(pr + C_SK + roff); k2 = *(const u32x4*)(pr + C_SK + roff + 32); }
        if (lane < 32) vv = *(const u32x4*)(pr + C_SV + c8);
        { float fC[8], fX[8], fB[8], gC[8], gX[8], hC[8], hX[8], o[8];
          unpack8(xC, fC); unpack8(xX, fX); unpack8(xB, fB); unpack8(pC, gC); unpack8(pX, gX); unpack8(nC, hC); unpack8(nX, hX);
#pragma unroll
          for (int e = 0; e < 8; ++e) o[e] = fB[e] * (w0[e] * gC[e] * gX[e] + w1[e] * fC[e] * fX[e] + w2[e] * hC[e] * hX[e]);
          *(u32x4*)(MIX + (size_t)r * DM + c8) = pack8(o); }
        { float cs[8], sn[8];
#pragma unroll
          for (int e = 0; e < 8; ++e) { cs[e] = 1.f; sn[e] = 0.f; }
          if (r < TL) { const float pv = (float)(rf ? (pos % 64) : (pos / 64));
#pragma unroll
              for (int e = 0; e < 8; ++e) { sn[e] = __sinf(pv * invf[e]); cs[e] = __cosf(pv * invf[e]); } }
          float x1[8], x2[8], o1[8], o2[8];
          unpack8(q1, x1); unpack8(q2, x2);
#pragma unroll
          for (int e = 0; e < 8; ++e) { o1[e] = (x1[e] * cs[e] - x2[e] * sn[e]) * 0.08838834764831845f; o2[e] = (x2[e] * cs[e] + x1[e] * sn[e]) * 0.08838834764831845f; }
          *(u32x4*)(QR + (size_t)r * 1024 + roff) = pack8(o1); *(u32x4*)(QR + (size_t)r * 1024 + roff + 32) = pack8(o2);
          if (lane < 16) { unpack8(k1, x1); unpack8(k2, x2);
#pragma unroll
              for (int e = 0; e < 8; ++e) { o1[e] = x1[e] * cs[e] - x2[e] * sn[e]; o2[e] = x2[e] * cs[e] + x1[e] * sn[e]; }
              *(u32x4*)(KR + (size_t)r * 256 + roff) = pack8(o1); *(u32x4*)(KR + (size_t)r * 256 + roff + 32) = pack8(o2); }
          if (lane < 32) *(u32x4*)(VR + (size_t)r * 256 + c8) = vv; }
    }
}

#ifndef SWA_THR
#define SWA_THR 6.0f
#endif
constexpr int KP = 136, VP = 72;
constexpr int SWA_BUF = 64 * KP * 2 + 128 * VP * 2;
typedef short bf16x4 __attribute__((ext_vector_type(4)));
__device__ __forceinline__ void phase_mixers(const Params& p, int l, LAS unsigned char* lds, int tid, int lane, int wave, int bid, int G, int qsel = 0) {
    const bf16_t* QR = (const bf16_t*)(p.ws + WS_QR); const bf16_t* KR = (const bf16_t*)(p.ws + WS_KR); const bf16_t* VR = (const bf16_t*)(p.ws + WS_ALF);
    bf16_t* MIX = (bf16_t*)(p.ws + WS_MIX);
    const float* sinkp = p.in[I_SINK] + l * 8;
    const int fr = lane & 15, fq = lane >> 4, g = wave & 3, qh = wave >> 2;
    const int nItems = 512 + ((l < DEPTH - 1) ? 16 : 0);
    unsigned* qhead = (unsigned*)(p.ws + WS_CTL) + CW_QUEUE + 64 * (l + 4 * qsel);
    volatile LAS int* itw = (volatile LAS int*)(lds + MISC_OFF + 64);
    for (;;) {
        if (tid == 0) itw[0] = (int)__hip_atomic_fetch_add(qhead, 1u, __ATOMIC_RELAXED, __HIP_MEMORY_SCOPE_AGENT);
        __syncthreads();
        const int it = itw[0];
        __syncthreads();
        if (it >= nItems) break;
        int b, tile, hk, s0; size_t qrow0;
        if (it < 512) { b = it >> 8; tile = (it >> 1) & 127; hk = it & 1; s0 = 0; qrow0 = (size_t)b * SEQ + tile * 64; }
        else { const int c = it - 512; b = c >> 3; tile = (c >> 1) & 3; hk = c & 1; s0 = 5; qrow0 = (size_t)TL + b * CTXL + tile * 64; }
        const int n0 = tile * 64, hq = hk * 4 + g;
        bf16x8 qf[2][4];
#pragma unroll
        for (int qt = 0; qt < 2; ++qt)
#pragma unroll
            for (int ks = 0; ks < 4; ++ks) qf[qt][ks] = *(const bf16x8*)(QR + (qrow0 + qh * 32 + qt * 16 + fr) * 1024 + hq * 128 + ks * 32 + fq * 8);
        f32x4 O[2][8];
#pragma unroll
        for (int qt = 0; qt < 2; ++qt)
#pragma unroll
            for (int dt = 0; dt < 8; ++dt) O[qt][dt] = (f32x4){0.f, 0.f, 0.f, 0.f};
        float m[2], lsum[2];
        m[0] = m[1] = sinkp[hq]; lsum[0] = lsum[1] = (fq == 0) ? 1.f : 0.f;
        u32x4 kreg[2], vreg[2];
#define SWA_ROW(s, kk) ((s) < 5 ? (size_t)b * SEQ + (size_t)min(max(n0 - 128 + (s) * 64 + (kk), 0), SEQ - 1) : (size_t)TL + (size_t)b * CTXL + ((s) - 5) * 64 + (kk))
#define SWA_LOAD(s) do { _Pragma("unroll") for (int j = 0; j < 2; ++j) { const int v = tid + NTHREADS * j; \
            kreg[j] = *(const u32x4*)(KR + SWA_ROW(s, v >> 4) * 256 + hk * 128 + (v & 15) * 8); \
            vreg[j] = *(const u32x4*)(VR + SWA_ROW(s, tid & 63) * 256 + hk * 128 + ((tid >> 6) + 8 * j) * 8); } } while (0)
#define SWA_WRITE(buf) do { LAS bf16_t* Kd = (LAS bf16_t*)(lds + (buf) * SWA_BUF); LAS bf16_t* Vd = Kd + 64 * KP; \
            _Pragma("unroll") for (int j = 0; j < 2; ++j) { const int v = tid + NTHREADS * j; *(LAS u32x4*)(Kd + (v >> 4) * KP + (v & 15) * 8) = kreg[j]; \
                const int d0 = ((tid >> 6) + 8 * j) * 8, key = tid & 63; const u32x4 w = vreg[j]; \
                Vd[(d0 + 0) * VP + key] = (bf16_t)(w.x & 0xffffu); Vd[(d0 + 1) * VP + key] = (bf16_t)(w.x >> 16); Vd[(d0 + 2) * VP + key] = (bf16_t)(w.y & 0xffffu); Vd[(d0 + 3) * VP + key] = (bf16_t)(w.y >> 16); \
                Vd[(d0 + 4) * VP + key] = (bf16_t)(w.z & 0xffffu); Vd[(d0 + 5) * VP + key] = (bf16_t)(w.z >> 16); Vd[(d0 + 6) * VP + key] = (bf16_t)(w.w & 0xffffu); Vd[(d0 + 7) * VP + key] = (bf16_t)(w.w >> 16); } } while (0)
        SWA_LOAD(s0); SWA_WRITE(0);
        __syncthreads();
#pragma unroll 1
        for (int s = s0; s < 9; ++s) {
            const int buf = (s - s0) & 1;
            if (s + 1 < 9) SWA_LOAD(s + 1);
            const LAS bf16_t* Ks = (const LAS bf16_t*)(lds + buf * SWA_BUF); const LAS bf16_t* Vs = Ks + 64 * KP;
#pragma unroll 1
            for (int sc = 0; sc < 2; ++sc) {
                f32x4 sT[2][2];
#pragma unroll
                for (int qt = 0; qt < 2; ++qt) { sT[qt][0] = (f32x4){0.f, 0.f, 0.f, 0.f}; sT[qt][1] = (f32x4){0.f, 0.f, 0.f, 0.f}; }
#pragma unroll
                for (int ks = 0; ks < 4; ++ks)
#pragma unroll
                    for (int kt = 0; kt < 2; ++kt) { const bf16x8 ka = *(const LAS bf16x8*)(Ks + (sc * 32 + kt * 16 + fr) * KP + ks * 32 + fq * 8);
#pragma unroll
                        for (int qt = 0; qt < 2; ++qt) sT[qt][kt] = __builtin_amdgcn_mfma_f32_16x16x32_bf16(ka, qf[qt][ks], sT[qt][kt], 0, 0, 0); }
                bf16x8 pb[2];
                float cm[2];
#pragma unroll
                for (int qt = 0; qt < 2; ++qt) {
                    if (s < 5) {
                        const int qpos = n0 + qh * 32 + qt * 16 + fr;
#pragma unroll
                        for (int kt = 0; kt < 2; ++kt)
#pragma unroll
                            for (int e = 0; e < 4; ++e) { const int kpos = n0 - 128 + s * 64 + sc * 32 + kt * 16 + fq * 4 + e; const int dlt = qpos - kpos;
                                const bool ok = kpos >= 0 && kpos < SEQ && dlt <= 128 && dlt >= -128; sT[qt][kt][e] = ok ? sT[qt][kt][e] : -1e30f; } }
                    cm[qt] = fmaxf(fmaxf(fmaxf(sT[qt][0][0], sT[qt][0][1]), fmaxf(sT[qt][0][2], sT[qt][0][3])), fmaxf(fmaxf(sT[qt][1][0], sT[qt][1][1]), fmaxf(sT[qt][1][2], sT[qt][1][3])));
                }
                if (__any((cm[0] > m[0] + SWA_THR) || (cm[1] > m[1] + SWA_THR))) {
#pragma unroll
                    for (int qt = 0; qt < 2; ++qt) { float c = cm[qt]; c = fmaxf(c, __shfl_xor(c, 16)); c = fmaxf(c, __shfl_xor(c, 32));
                        const float mn = fmaxf(m[qt], c), scl = __expf(m[qt] - mn); m[qt] = mn; lsum[qt] *= scl;
#pragma unroll
                        for (int dt = 0; dt < 8; ++dt) O[qt][dt] = O[qt][dt] * scl; }
                }
#pragma unroll
                for (int qt = 0; qt < 2; ++qt) {
                    float pe[8]; float ps = 0.f;
#pragma unroll
                    for (int kt = 0; kt < 2; ++kt)
#pragma unroll
                        for (int e = 0; e < 4; ++e) { pe[kt * 4 + e] = __expf(sT[qt][kt][e] - m[qt]); ps += pe[kt * 4 + e]; }
                    lsum[qt] += ps;
                    u32x4 pw; pw.x = pk2(pe[0], pe[1]); pw.y = pk2(pe[2], pe[3]); pw.z = pk2(pe[4], pe[5]); pw.w = pk2(pe[6], pe[7]);
                    pb[qt] = __builtin_bit_cast(bf16x8, pw);
                }
#pragma unroll
                for (int dt = 0; dt < 8; ++dt) {
                    const bf16x4 v0 = *(const LAS bf16x4*)(Vs + (dt * 16 + fr) * VP + sc * 32 + 4 * fq), v1 = *(const LAS bf16x4*)(Vs + (dt * 16 + fr) * VP + sc * 32 + 16 + 4 * fq);
                    const bf16x8 va = __builtin_shufflevector(v0, v1, 0, 1, 2, 3, 4, 5, 6, 7);
#pragma unroll
                    for (int qt = 0; qt < 2; ++qt) O[qt][dt] = __builtin_amdgcn_mfma_f32_16x16x32_bf16(va, pb[qt], O[qt][dt], 0, 0, 0);
                }
            }
            if (s + 1 < 9) SWA_WRITE(buf ^ 1);
            __syncthreads();
        }
#undef SWA_ROW
#undef SWA_LOAD
#undef SWA_WRITE
#pragma unroll
        for (int qt = 0; qt < 2; ++qt) {
            float lt = lsum[qt]; lt += __shfl_xor(lt, 16); lt += __shfl_xor(lt, 32);
            const float inv = 1.0f / lt;
            bf16_t* o = MIX + (qrow0 + qh * 32 + qt * 16 + fr) * DM + 1024 + hq * 128 + fq * 4;
#pragma unroll
            for (int dt = 0; dt < 8; ++dt) { u32x2 w; w.x = pk2(O[qt][dt][0] * inv, O[qt][dt][1] * inv); w.y = pk2(O[qt][dt][2] * inv, O[qt][dt][3] * inv); *(u32x2*)(o + dt * 16) = w; }
        }
    }
}

__device__ __forceinline__ int chunk_row0(int cid) { return cid < 256 ? (cid >> 7) * SEQ + (cid & 127) * 64 : TL + ((cid - 256) >> 2) * CTXL + ((cid - 256) & 3) * 64; }
constexpr int GP = 72;

constexpr int LTP = 65;
__device__ __forceinline__ float wave_incl_scan(float x) {
    x += __builtin_bit_cast(float, __builtin_amdgcn_update_dpp(0, __builtin_bit_cast(int, x), 0x111, 0xF, 0xF, true));
    x += __builtin_bit_cast(float, __builtin_amdgcn_update_dpp(0, __builtin_bit_cast(int, x), 0x112, 0xF, 0xF, true));
    x += __builtin_bit_cast(float, __builtin_amdgcn_update_dpp(0, __builtin_bit_cast(int, x), 0x114, 0xF, 0xF, true));
    x += __builtin_bit_cast(float, __builtin_amdgcn_update_dpp(0, __builtin_bit_cast(int, x), 0x118, 0xF, 0xF, true));
    x += __builtin_bit_cast(float, __builtin_amdgcn_update_dpp(0, __builtin_bit_cast(int, x), 0x142, 0xA, 0xF, false));
    x += __builtin_bit_cast(float, __builtin_amdgcn_update_dpp(0, __builtin_bit_cast(int, x), 0x143, 0xC, 0xF, false));
    return x;
}
__device__ __forceinline__ void gla_g1(const Params& p, int l, LAS unsigned char* lds, int tid, int lane, int wave, int bid, int G) {
    LAS float* LTf = (LAS float*)lds; LAS float* LTb = LTf + 64 * LTP;
    LAS bf16_t* KTf = (LAS bf16_t*)(lds + 2 * 64 * LTP * 4); LAS bf16_t* KTb = KTf + 64 * GP;
    LAS bf16_t* VT = KTb + 64 * GP;
    const bf16_t* P = (const bf16_t*)(p.ws + WS_P);
    float* BF = (float*)(p.ws + WS_OF); float* BB = (float*)(p.ws + WS_OB);
    float* DELTA = (float*)(p.ws + WS_DELTA); float* DEC = (float*)(p.ws + WS_DEC);
    const float* w2 = p.in[I_GW2] + (size_t)l * 2 * 16 * 256; const float* b2 = p.in[I_GB2] + (size_t)l * 2 * 256;
    const int fr = lane & 15, fq = lane >> 4, ti = tid >> 3, tk0 = (tid & 7) * 8;
    float wr[2][16], br[2];
    const bool fixed_h = (G & 3) == 0;
#define G1_LOADW(hh_) do { _Pragma("unroll") for (int d = 0; d < 2; ++d) { br[d] = b2[d * 256 + (hh_) * 64 + lane]; \
        _Pragma("unroll") for (int q = 0; q < 16; ++q) wr[d][q] = w2[(d * 16 + q) * 256 + (hh_) * 64 + lane]; } } while (0)
    if (fixed_h) G1_LOADW(bid & 3);
    u32x4 kraw, vraw[2], lrr[2][4];
#define G1_LOADX(item_) do { const int cid_ = (item_) >> 2, h_ = (item_) & 3, row0_ = chunk_row0(cid_); \
        kraw = *(const u32x4*)(P + (size_t)(row0_ + ti) * INWP + C_GK + h_ * 64 + tk0); \
        _Pragma("unroll") for (int j = 0; j < 2; ++j) { const int vi = tid + NTHREADS * j; vraw[j] = *(const u32x4*)(P + (size_t)(row0_ + (vi >> 4)) * INWP + C_GV + h_ * 128 + (vi & 15) * 8); } \
        _Pragma("unroll") for (int jj = 0; jj < 2; ++jj) _Pragma("unroll") for (int c = 0; c < 4; ++c) lrr[jj][c] = *(const u32x4*)(P + (size_t)(row0_ + wave + 8 * jj) * INWP + C_LRF + c * 8); } while (0)
    if (bid < GLA_ITEMS) G1_LOADX(bid);
    for (int item = bid; item < GLA_ITEMS; item += G) {
        const int cid = item >> 2, h = item & 3, row0 = chunk_row0(cid);
        const u32x4 kraw_c = kraw; u32x4 vraw_c[2] = {vraw[0], vraw[1]};
        {
            if (!fixed_h) G1_LOADW(h);
#pragma unroll
            for (int jj = 0; jj < 8; ++jj) { const int i = wave + 8 * jj;
                float lf[4][8];
                if (jj < 2) {
#pragma unroll
                    for (int c = 0; c < 4; ++c) unpack8(lrr[jj][c], lf[c]);
                } else { const bf16_t* lrp = P + (size_t)(row0 + i) * INWP + C_LRF;
#pragma unroll
                    for (int c = 0; c < 4; ++c) unpack8(*(const u32x4*)(lrp + c * 8), lf[c]); }
#pragma unroll
                for (int d = 0; d < 2; ++d) { float z = br[d];
#pragma unroll
                    for (int q = 0; q < 16; ++q) z += lf[d * 2 + (q >> 3)][q & 7] * wr[d][q];
                    (d ? LTb : LTf)[lane * LTP + i] = log_sigmoid_f(z) * (1.0f / 16.0f); } }
        }
        if (item + G < GLA_ITEMS) G1_LOADX(item + G);
        __syncthreads();
#pragma unroll 2
        for (int kk = 0; kk < 8; ++kk) { const int k = wave * 8 + kk;
            float xf = LTf[k * LTP + lane], xb = LTb[k * LTP + lane];
            const float pf = wave_incl_scan(xf), pb = wave_incl_scan(xb);
            const float totb = __builtin_bit_cast(float, __builtin_amdgcn_readlane(__builtin_bit_cast(int, pb), 63));
            LTf[k * LTP + lane] = pf; LTb[k * LTP + lane] = totb - pb + xb; }
        __syncthreads();
        { float kv[8]; unpack8(kraw_c, kv);
          float bfv[8], bbv[8];
#pragma unroll
          for (int e = 0; e < 8; ++e) { const int k = tk0 + e; bfv[e] = LTf[k * LTP + ti]; bbv[e] = LTb[k * LTP + ti];
              KTf[k * GP + ti] = (bf16_t)f2bf(kv[e] * __expf(LTf[k * LTP + 63] - bfv[e]));
              KTb[k * GP + ti] = (bf16_t)f2bf(kv[e] * __expf(LTb[k * LTP] - bbv[e])); }
          float* bg = BF + (size_t)(row0 + ti) * 256 + h * 64 + tk0; *(f32x4*)bg = (f32x4){bfv[0], bfv[1], bfv[2], bfv[3]}; *(f32x4*)(bg + 4) = (f32x4){bfv[4], bfv[5], bfv[6], bfv[7]};
          bg = BB + (size_t)(row0 + ti) * 256 + h * 64 + tk0; *(f32x4*)bg = (f32x4){bbv[0], bbv[1], bbv[2], bbv[3]}; *(f32x4*)(bg + 4) = (f32x4){bbv[4], bbv[5], bbv[6], bbv[7]};
#pragma unroll
          for (int j = 0; j < 2; ++j) { const int vi = tid + NTHREADS * j, i = vi >> 4, v0 = (vi & 15) * 8; const u32x4 w = vraw_c[j];
              VT[(v0 + 0) * GP + i] = (bf16_t)(w.x & 0xffffu); VT[(v0 + 1) * GP + i] = (bf16_t)(w.x >> 16); VT[(v0 + 2) * GP + i] = (bf16_t)(w.y & 0xffffu); VT[(v0 + 3) * GP + i] = (bf16_t)(w.y >> 16);
              VT[(v0 + 4) * GP + i] = (bf16_t)(w.z & 0xffffu); VT[(v0 + 5) * GP + i] = (bf16_t)(w.z >> 16); VT[(v0 + 6) * GP + i] = (bf16_t)(w.w & 0xffffu); VT[(v0 + 7) * GP + i] = (bf16_t)(w.w >> 16); }
          if (tid < 128) { const int dir = tid >> 6, k = tid & 63; DEC[((size_t)item * 2 + dir) * 64 + k] = __expf(dir ? LTb[k * LTP] : LTf[k * LTP + 63]); } }
        __syncthreads();
        { const int dir = wave >> 2, vq = wave & 3; const LAS bf16_t* KT = dir ? KTb : KTf;
            f32x4 acc[2][4];
#pragma unroll
            for (int a = 0; a < 2; ++a)
#pragma unroll
                for (int b = 0; b < 4; ++b) acc[a][b] = (f32x4){0.f, 0.f, 0.f, 0.f};
#pragma unroll
            for (int ks = 0; ks < 2; ++ks) { bf16x8 af[2], bfr[4];
#pragma unroll
                for (int a = 0; a < 2; ++a) af[a] = *(const LAS bf16x8*)(VT + ((vq * 2 + a) * 16 + fr) * GP + ks * 32 + fq * 8);
#pragma unroll
                for (int b = 0; b < 4; ++b) bfr[b] = *(const LAS bf16x8*)(KT + (b * 16 + fr) * GP + ks * 32 + fq * 8);
#pragma unroll
                for (int a = 0; a < 2; ++a)
#pragma unroll
                    for (int b = 0; b < 4; ++b) acc[a][b] = __builtin_amdgcn_mfma_f32_16x16x32_bf16(af[a], bfr[b], acc[a][b], 0, 0, 0); }
            float* dst = DELTA + ((size_t)item * 2 + dir) * 8192;
#pragma unroll
            for (int a = 0; a < 2; ++a)
#pragma unroll
                for (int b = 0; b < 4; ++b)
#pragma unroll
                    for (int g = 0; g < 4; ++g) dst[((vq * 2 + a) * 16 + fq * 4 + g) * 64 + b * 16 + fr] = acc[a][b][g]; }
        __syncthreads();
    }
}

#undef G1_LOADW
#undef G1_LOADX
__device__ __forceinline__ void gla_g2(const Params& p, int tid, int bid, int G) {
    const float* DELTA = (const float*)(p.ws + WS_DELTA); const float* DEC = (const float*)(p.ws + WS_DEC); bf16_t* SST = (bf16_t*)(p.ws + WS_SST);
    for (int u = bid; u < 64; u += G) {
        const int s = u >> 2, dir = s >> 3, b = (s >> 2) & 1, h = s & 3, off = ((u & 3) * NTHREADS + tid) * 4, k0 = off & 63;
        f32x4 S = (f32x4){0.f, 0.f, 0.f, 0.f};
#pragma unroll 1
        for (int st = 0; st < 132; st += 12) {
            f32x4 d[12], dc[12]; size_t base[12];
#pragma unroll
            for (int q = 0; q < 12; ++q) { const int t = st + q;
                const int cid = t < 4 ? 256 + b * 4 + (dir ? 3 - t : t) : b * 128 + (dir ? 127 - (t - 4) : (t - 4));
                const size_t it2 = (size_t)(cid * 4 + h) * 2 + dir; base[q] = it2 * 8192 + off;
                d[q] = *(const f32x4*)(DELTA + base[q]); dc[q] = *(const f32x4*)(DEC + it2 * 64 + k0); }
#pragma unroll
            for (int q = 0; q < 12; ++q) { u32x2 o; o.x = pk2(S.x, S.y); o.y = pk2(S.z, S.w); *(u32x2*)(SST + base[q]) = o; S = dc[q] * S + d[q]; }
        }
    }
}

__device__ __forceinline__ void gla_g3(const Params& p, int l, LAS unsigned char* lds, int tid, int lane, int wave, int bid, int G, unsigned* qhead3 = nullptr) {
    LAS bf16_t* QEf = (LAS bf16_t*)lds; LAS bf16_t* QEb = QEf + 64 * GP; LAS bf16_t* KEf = QEb + 64 * GP; LAS bf16_t* KEb = KEf + 64 * GP;
    LAS bf16_t* VT = KEb + 64 * GP;
    LAS bf16_t* ATT = VT + 128 * GP + wave * (16 * GP);
    LAS float* RS = (LAS float*)(lds + 2 * (4 * 64 * GP + 128 * GP + 8 * 16 * GP));
    const bf16_t* P = (const bf16_t*)(p.ws + WS_P);
    const float* BF = (const float*)(p.ws + WS_OF); const float* BB = (const float*)(p.ws + WS_OB);
    const bf16_t* SST = (const bf16_t*)(p.ws + WS_SST); bf16_t* MIX = (bf16_t*)(p.ws + WS_MIX);
    const float* nw = p.in[I_GNORM] + l * 128;
    const int fr = lane & 15, fq = lane >> 4, it = wave >> 1, vh = wave & 1, ti = tid >> 3, tk0 = (tid & 7) * 8;
    const int n_items = (l < DEPTH - 1) ? GLA_ITEMS : 256 * 4;
    volatile LAS int* itw3 = (volatile LAS int*)(lds + MISC_OFF + 64);
    for (int item = bid;; item += G) {
        if (qhead3) {
            if (tid == 0) itw3[0] = (int)__hip_atomic_fetch_add(qhead3, 1u, __ATOMIC_RELAXED, __HIP_MEMORY_SCOPE_AGENT);
            __syncthreads(); item = itw3[0]; __syncthreads(); }
        if (item >= n_items) break;
        const int cid = item >> 2, h = item & 3, row0 = chunk_row0(cid);
        {
            const size_t r = (size_t)(row0 + ti);
            const u32x4 qraw = *(const u32x4*)(P + r * INWP + C_GQ + h * 64 + tk0), kraw = *(const u32x4*)(P + r * INWP + C_GK + h * 64 + tk0);
            const f32x4 f0 = *(const f32x4*)(BF + r * 256 + h * 64 + tk0), f1 = *(const f32x4*)(BF + r * 256 + h * 64 + tk0 + 4);
            const f32x4 b0 = *(const f32x4*)(BB + r * 256 + h * 64 + tk0), b1 = *(const f32x4*)(BB + r * 256 + h * 64 + tk0 + 4);
            u32x4 vraw[2];
#pragma unroll
            for (int j = 0; j < 2; ++j) { const int vi = tid + NTHREADS * j; vraw[j] = *(const u32x4*)(P + (size_t)(row0 + (vi >> 4)) * INWP + C_GV + h * 128 + (vi & 15) * 8); }
            float q[8], kk[8]; unpack8(qraw, q); unpack8(kraw, kk);
            const float bf[8] = {f0.x, f0.y, f0.z, f0.w, f1.x, f1.y, f1.z, f1.w}, bb[8] = {b0.x, b0.y, b0.z, b0.w, b1.x, b1.y, b1.z, b1.w};
            float o0[8], o1[8], o2[8], o3[8];
#pragma unroll
            for (int e = 0; e < 8; ++e) { const float ef = __expf(bf[e]), eb = __expf(bb[e]); const float qs = q[e] * 0.125f;
                o0[e] = qs * ef; o1[e] = kk[e] / ef; o2[e] = qs * eb; o3[e] = kk[e] / eb; }
            *(LAS u32x4*)(QEf + ti * GP + tk0) = pack8(o0); *(LAS u32x4*)(KEf + ti * GP + tk0) = pack8(o1); *(LAS u32x4*)(QEb + ti * GP + tk0) = pack8(o2); *(LAS u32x4*)(KEb + ti * GP + tk0) = pack8(o3);
#pragma unroll
            for (int j = 0; j < 2; ++j) { const int vi = tid + NTHREADS * j, i = vi >> 4, v0 = (vi & 15) * 8; const u32x4 w = vraw[j];
                VT[(v0 + 0) * GP + i] = (bf16_t)(w.x & 0xffffu); VT[(v0 + 1) * GP + i] = (bf16_t)(w.x >> 16); VT[(v0 + 2) * GP + i] = (bf16_t)(w.y & 0xffffu); VT[(v0 + 3) * GP + i] = (bf16_t)(w.y >> 16);
                VT[(v0 + 4) * GP + i] = (bf16_t)(w.z & 0xffffu); VT[(v0 + 5) * GP + i] = (bf16_t)(w.z >> 16); VT[(v0 + 6) * GP + i] = (bf16_t)(w.w & 0xffffu); VT[(v0 + 7) * GP + i] = (bf16_t)(w.w >> 16); }
        }
        float gt[4][4];
#pragma unroll
        for (int g = 0; g < 4; ++g)
#pragma unroll
            for (int vt = 0; vt < 4; ++vt) gt[g][vt] = bflo((unsigned)P[(size_t)(row0 + it * 16 + fq * 4 + g) * INWP + C_GG + h * 128 + (vh * 4 + vt) * 16 + fr]);
        __syncthreads();
        f32x4 acc[4];
#pragma unroll
        for (int vt = 0; vt < 4; ++vt) acc[vt] = (f32x4){0.f, 0.f, 0.f, 0.f};
#pragma unroll
        for (int dir = 0; dir < 2; ++dir) {
            const LAS bf16_t* QE = dir ? QEb : QEf; const LAS bf16_t* KE = dir ? KEb : KEf;
            bf16x8 qa[2], sbf[2][4];
            const bf16_t* Sg = SST + ((size_t)item * 2 + dir) * 8192;
#pragma unroll
            for (int ks = 0; ks < 2; ++ks)
#pragma unroll
                for (int vt = 0; vt < 4; ++vt) sbf[ks][vt] = *(const bf16x8*)(Sg + ((vh * 4 + vt) * 16 + fr) * 64 + ks * 32 + fq * 8);
#pragma unroll
            for (int ks = 0; ks < 2; ++ks) qa[ks] = *(const LAS bf16x8*)(QE + (it * 16 + fr) * GP + ks * 32 + fq * 8);
#pragma unroll
            for (int jt = 0; jt < 4; ++jt) { f32x4 a = (f32x4){0.f, 0.f, 0.f, 0.f};
#pragma unroll
                for (int ks = 0; ks < 2; ++ks) { const bf16x8 kb = *(const LAS bf16x8*)(KE + (jt * 16 + fr) * GP + ks * 32 + fq * 8); a = __builtin_amdgcn_mfma_f32_16x16x32_bf16(qa[ks], kb, a, 0, 0, 0); }
#pragma unroll
                for (int g = 0; g < 4; ++g) { const int ii = it * 16 + fq * 4 + g, jj = jt * 16 + fr; const bool keep = dir ? (jj >= ii) : (jj <= ii);
                    ATT[(fq * 4 + g) * GP + jt * 16 + fr] = (bf16_t)f2bf(keep ? a[g] : 0.f); } }
            LDS_FENCE();
#pragma unroll
            for (int ks = 0; ks < 2; ++ks) { const bf16x8 aa = *(const LAS bf16x8*)(ATT + fr * GP + ks * 32 + fq * 8);
#pragma unroll
                for (int vt = 0; vt < 4; ++vt) { const int v = (vh * 4 + vt) * 16 + fr;
                    const bf16x8 vb = *(const LAS bf16x8*)(VT + v * GP + ks * 32 + fq * 8);
                    acc[vt] = __builtin_amdgcn_mfma_f32_16x16x32_bf16(aa, vb, acc[vt], 0, 0, 0);
                    acc[vt] = __builtin_amdgcn_mfma_f32_16x16x32_bf16(qa[ks], sbf[ks][vt], acc[vt], 0, 0, 0); } }
            LDS_FENCE();
        }
        float ss[4];
#pragma unroll
        for (int g = 0; g < 4; ++g) { float t = 0.f;
#pragma unroll
            for (int vt = 0; vt < 4; ++vt) t += acc[vt][g] * acc[vt][g];
            t += __shfl_xor(t, 1); t += __shfl_xor(t, 2); t += __shfl_xor(t, 4); t += __shfl_xor(t, 8); ss[g] = t; }
        if (fr == 0) {
#pragma unroll
            for (int g = 0; g < 4; ++g) RS[(it * 16 + fq * 4 + g) * 2 + vh] = ss[g]; }
        __syncthreads();
#pragma unroll
        for (int g = 0; g < 4; ++g) { const int i = it * 16 + fq * 4 + g; const float tot = RS[i * 2] + RS[i * 2 + 1];
            const float rs = 1.0f / sqrtf(tot * (1.0f / 128.0f) + LN_EPS); const size_t r = (size_t)(row0 + i);
#pragma unroll
            for (int vt = 0; vt < 4; ++vt) { const int v = (vh * 4 + vt) * 16 + fr;
                MIX[r * DM + 512 + h * 128 + v] = (bf16_t)f2bf(acc[vt][g] * rs * nw[v] * silu_f(gt[g][vt])); } }
        __syncthreads();
    }
}

__device__ __forceinline__ void ln_row(f32x4 (&v)[8], const float* lg, const float* lb, int lane) {
    float s = 0.f;
#pragma unroll
    for (int j = 0; j < 8; ++j) s += (v[j].x + v[j].y) + (v[j].z + v[j].w);
    const float mean = wave_sum(s) * (1.0f / DM);
    float s2 = 0.f;
#pragma unroll
    for (int j = 0; j < 8; ++j) { v[j] = v[j] - mean; s2 += (v[j].x * v[j].x + v[j].y * v[j].y) + (v[j].z * v[j].z + v[j].w * v[j].w); }
    const float rstd = 1.0f / sqrtf(wave_sum(s2) * (1.0f / DM) + LN_EPS);
#pragma unroll
    for (int j = 0; j < 8; ++j) { const int c = lane * 4 + 256 * j; const f32x4 g = *(const f32x4*)(lg + c), b = *(const f32x4*)(lb + c); v[j] = v[j] * rstd * g + b; }
}

__device__ __forceinline__ void phase_ln1(const Params& p, int l, LAS unsigned char* lds, int tid, int lane, int wave, int bid, int G) {
    const int gw = bid * NWAVES + wave, NGW = G * NWAVES;
    const float* MOD = (const float*)(p.ws + WS_MOD); const bf16_t* Y = (const bf16_t*)(p.ws + WS_Y); const float* YP = (const float*)(p.ws + WS_YPART);
    bf16_t* XM = (bf16_t*)(p.ws + WS_XM); bf16_t* HB = (bf16_t*)(p.ws + WS_HB);
    LAS float* VEC = (LAS float*)lds;
    for (int i = tid; i < 11 * DM / 4; i += NTHREADS) { const int vi = i / (DM / 4), c = (i % (DM / 4)) * 4;
        const float* src = vi < 9 ? MOD + (size_t)(l * 3 + (vi % 3)) * 6 * DM + (2 + vi / 3) * DM + c : (vi == 9 ? p.in[I_LNG] : p.in[I_LNB]) + (size_t)(l * 2 + 0) * DM + c;
        *(LAS f32x4*)(VEC + vi * DM + c) = *(const f32x4*)src; }
    __syncthreads();
    f32x4 xn[8]; u32x2 yn[8];
#define LN1_LOAD(rr) do { if (l == 0) { const float* xr_ = xsrc(p, 0, (rr)); _Pragma("unroll") for (int j = 0; j < 8; ++j) xn[j] = *(const f32x4*)(xr_ + lane * 4 + 256 * j); } \
        else { const bf16_t* xb_ = (const bf16_t*)(p.ws + WS_XL) + (size_t)(rr) * DM; _Pragma("unroll") for (int j = 0; j < 8; ++j) { const u32x2 w_ = *(const u32x2*)(xb_ + lane * 4 + 256 * j); xn[j] = (f32x4){bflo(w_.x), bfhi(w_.x), bflo(w_.y), bfhi(w_.y)}; } } \
        if ((rr) < TL) { _Pragma("unroll") for (int j = 0; j < 8; ++j) yn[j] = *(const u32x2*)(Y + (size_t)(rr) * DM + lane * 4 + 256 * j); } } while (0)
    if (row_first(wave, bid, G) >= 0) LN1_LOAD(row_first(wave, bid, G));
    for (int r = row_first(wave, bid, G); r >= 0; r = row_next(r, wave, bid, G, TA)) {
        const int st = row_stream(r);
        f32x4 v[8], yy[8];
#pragma unroll
        for (int j = 0; j < 8; ++j) v[j] = xn[j];
        if (r < TL) {
#pragma unroll
            for (int j = 0; j < 8; ++j) yy[j] = (f32x4){bflo(yn[j].x), bfhi(yn[j].x), bflo(yn[j].y), bfhi(yn[j].y)};
        } else {
#pragma unroll
            for (int j = 0; j < 8; j += 2) { f32x4 pp[2][8];
#pragma unroll
                for (int jj = 0; jj < 2; ++jj)
#pragma unroll
                    for (int ks = 0; ks < 8; ++ks) pp[jj][ks] = *(const f32x4*)(YP + ((size_t)ks * 512 + (r - TL)) * DM + lane * 4 + 256 * (j + jj));
#pragma unroll
                for (int jj = 0; jj < 2; ++jj) yy[j + jj] = ((pp[jj][0] + pp[jj][1]) + (pp[jj][2] + pp[jj][3])) + ((pp[jj][4] + pp[jj][5]) + (pp[jj][6] + pp[jj][7])); }
        }
        { const int rn = row_next(r, wave, bid, G, TA); if (rn >= 0) LN1_LOAD(rn); }
#pragma unroll
        for (int j = 0; j < 8; ++j) { const f32x4 g = *(const LAS f32x4*)(VEC + st * DM + lane * 4 + 256 * j); v[j] = v[j] * DN_ALPHA + g * yy[j]; }
        float s = 0.f;
#pragma unroll
        for (int j = 0; j < 8; ++j) s += (v[j].x + v[j].y) + (v[j].z + v[j].w);
        const float mean = wave_sum(s) * (1.0f / DM);
        float s2 = 0.f;
#pragma unroll
        for (int j = 0; j < 8; ++j) { v[j] = v[j] - mean; s2 += (v[j].x * v[j].x + v[j].y * v[j].y) + (v[j].z * v[j].z + v[j].w * v[j].w); }
        const float rstd = 1.0f / sqrtf(wave_sum(s2) * (1.0f / DM) + LN_EPS);
#pragma unroll
        for (int j = 0; j < 8; ++j) { const int c = lane * 4 + 256 * j;
            const f32x4 g = *(const LAS f32x4*)(VEC + 9 * DM + c), b = *(const LAS f32x4*)(VEC + 10 * DM + c), sh = *(const LAS f32x4*)(VEC + (3 + st) * DM + c), sc = *(const LAS f32x4*)(VEC + (6 + st) * DM + c);
            const f32x4 o = v[j] * rstd * g + b;
            { u32x2 xw; xw.x = pk2(o.x, o.y); xw.y = pk2(o.z, o.w); *(u32x2*)(XM + (size_t)r * DM + c) = xw; }
            u32x2 w; w.x = pk2(o.x * (1.f + sc.x) + sh.x, o.y * (1.f + sc.y) + sh.y); w.y = pk2(o.z * (1.f + sc.z) + sh.z, o.w * (1.f + sc.w) + sh.w);
            *(u32x2*)(HB + (size_t)r * DM + c) = w; }
    }
#undef LN1_LOAD
}

constexpr int SKP = 136;
__device__ __forceinline__ unsigned f2key(float f) { const unsigned u = __builtin_bit_cast(unsigned, f); return u ^ ((u >> 31) ? 0xFFFFFFFFu : 0x80000000u); }
__device__ __forceinline__ float key2f(unsigned k) { const unsigned u = (k >> 31) ? (k ^ 0x80000000u) : ~k; return __builtin_bit_cast(float, u); }
__device__ __forceinline__ unsigned row16_max_u32(unsigned k) {
    unsigned o;
    o = (unsigned)__builtin_amdgcn_update_dpp(0, (int)k, 0xB1, 0xF, 0xF, false); k = k > o ? k : o;
    o = (unsigned)__builtin_amdgcn_update_dpp(0, (int)k, 0x4E, 0xF, 0xF, false); k = k > o ? k : o;
    o = (unsigned)__builtin_amdgcn_update_dpp(0, (int)k, 0x141, 0xF, 0xF, false); k = k > o ? k : o;
    o = (unsigned)__builtin_amdgcn_update_dpp(0, (int)k, 0x140, 0xF, 0xF, false); k = k > o ? k : o;
    return k;
}
__device__ __forceinline__ void peer_retrieve(const Params& p, int l, LAS unsigned char* lds, int tid, int lane, int wave, int bid, int G, int ntok) {
    LAS bf16_t* SK = (LAS bf16_t*)lds;
    const bf16_t* SUBB = (const bf16_t*)(p.ws + WS_SUBB) + (size_t)l * 2 * 128 * 128;
#pragma unroll 1
    for (int j = 0; j < 8; ++j) { const int vv = tid + NTHREADS * j, row = vv >> 4, c = vv & 15; *(LAS u32x4*)(SK + row * SKP + c * 8) = *(const u32x4*)(SUBB + row * 128 + c * 8); }
    __syncthreads();
    const bf16_t* QP = (const bf16_t*)(p.ws + WS_QP); const float* QPP = (const float*)(p.ws + WS_QPART);
    int* EIDX = (int*)(p.ws + WS_EIDX); float* EGATE = (float*)(p.ws + WS_EGATE);
    const int gw = bid * NWAVES + wave, NGW = G * NWAVES, fr = lane & 15, fq = lane >> 4, gbase = lane & 48;
    const int nitems = (ntok / 16) * 8;
    const int nmain = nitems / NGW, nfull = nmain * NGW, nextra = (wave == 0 && nfull + bid < nitems) ? (nitems - nfull - bid + G - 1) / G : 0;
    for (int ri = 0; ri < nmain + nextra; ++ri) {
        const int item = ri < nmain ? gw + NGW * ri : nfull + bid + (ri - nmain) * G;
        const int tile = item >> 3, h = item & 7;
        unsigned tkp[2][4];
        bf16x8 afr[2][4];
        if (tile * 16 < TL) {
#pragma unroll
            for (int pp = 0; pp < 2; ++pp)
#pragma unroll
                for (int ks = 0; ks < 4; ++ks) afr[pp][ks] = *(const bf16x8*)(QP + (size_t)(tile * 16 + fr) * DM + h * 256 + pp * 128 + ks * 32 + fq * 8);
        } else {
#pragma unroll
            for (int pp = 0; pp < 2; ++pp)
#pragma unroll
                for (int ks = 0; ks < 4; ++ks) { const float* qp = QPP + (size_t)(tile * 16 - TL + fr) * DM + h * 256 + pp * 128 + ks * 32 + fq * 8;
                    f32x4 pa[8], pb[8];
#pragma unroll
                    for (int sl = 0; sl < 8; ++sl) { pa[sl] = *(const f32x4*)(qp + (size_t)sl * 512 * DM); pb[sl] = *(const f32x4*)(qp + (size_t)sl * 512 * DM + 4); }
                    const f32x4 s0 = ((pa[0] + pa[1]) + (pa[2] + pa[3])) + ((pa[4] + pa[5]) + (pa[6] + pa[7])), s1 = ((pb[0] + pb[1]) + (pb[2] + pb[3])) + ((pb[4] + pb[5]) + (pb[6] + pb[7]));
                    u32x4 w; w.x = pk2(s0.x, s0.y); w.y = pk2(s0.z, s0.w); w.z = pk2(s1.x, s1.y); w.w = pk2(s1.z, s1.w); afr[pp][ks] = __builtin_bit_cast(bf16x8, w); }
        }
#pragma unroll
        for (int pp = 0; pp < 2; ++pp) {
            asm volatile("" ::: "memory"); __builtin_amdgcn_sched_barrier(0);
            f32x4 acc[8];
#pragma unroll
            for (int kt = 0; kt < 8; ++kt) acc[kt] = (f32x4){0.f, 0.f, 0.f, 0.f};
#pragma unroll
            for (int ks = 0; ks < 4; ++ks) { const bf16x8 a = afr[pp][ks];
#pragma unroll
                for (int kt = 0; kt < 8; ++kt) { const bf16x8 bb = *(const LAS bf16x8*)(SK + (pp * 128 + kt * 16 + fr) * SKP + ks * 32 + fq * 8); acc[kt] = __builtin_amdgcn_mfma_f32_16x16x32_bf16(a, bb, acc[kt], 0, 0, 0); } }
            unsigned kv[4][8];
#pragma unroll
            for (int g = 0; g < 4; ++g)
#pragma unroll
                for (int kt = 0; kt < 8; ++kt) kv[g][kt] = (f2key(acc[kt][g]) & ~127u) | (unsigned)(127 - (kt * 16 + fr));
#define CSWAP(a_, b_) do { const unsigned hi_ = a_ > b_ ? a_ : b_, lo_ = a_ > b_ ? b_ : a_; a_ = hi_; b_ = lo_; } while (0)
#pragma unroll
            for (int g = 0; g < 4; ++g) {
                CSWAP(kv[g][0], kv[g][1]); CSWAP(kv[g][2], kv[g][3]); CSWAP(kv[g][4], kv[g][5]); CSWAP(kv[g][6], kv[g][7]);
                CSWAP(kv[g][0], kv[g][2]); CSWAP(kv[g][1], kv[g][3]); CSWAP(kv[g][4], kv[g][6]); CSWAP(kv[g][5], kv[g][7]);
                CSWAP(kv[g][1], kv[g][2]); CSWAP(kv[g][5], kv[g][6]);
                CSWAP(kv[g][0], kv[g][4]); CSWAP(kv[g][1], kv[g][5]); CSWAP(kv[g][2], kv[g][6]); CSWAP(kv[g][3], kv[g][7]);
                CSWAP(kv[g][2], kv[g][4]); CSWAP(kv[g][3], kv[g][5]);
                CSWAP(kv[g][1], kv[g][2]); CSWAP(kv[g][3], kv[g][4]); CSWAP(kv[g][5], kv[g][6]);
            }
#undef CSWAP
            unsigned tk[4] = {0u, 0u, 0u, 0u};
#pragma unroll 1
            for (int it = 0; it < 16; ++it) {
#pragma unroll
                for (int g = 0; g < 4; ++g) {
                    const unsigned m = row16_max_u32(kv[g][0]);
                    tk[g] = fr == it ? m : tk[g];
                    const bool won = kv[g][0] == m;
#pragma unroll
                    for (int kt = 0; kt < 7; ++kt) kv[g][kt] = won ? kv[g][kt + 1] : kv[g][kt];
                    kv[g][7] = won ? 0u : kv[g][7];
                }
            }
#pragma unroll
            for (int g = 0; g < 4; ++g) tkp[pp][g] = tk[g];
        }
        float av[4], bv[4]; int ptr[4]; unsigned best[4];
#pragma unroll
        for (int g = 0; g < 4; ++g) { av[g] = key2f(tkp[0][g] & ~127u); bv[g] = key2f(tkp[1][g] & ~127u); ptr[g] = 0; best[g] = 0u; }
#pragma unroll 1
        for (int it = 0; it < 16; ++it) {
#pragma unroll
            for (int g = 0; g < 4; ++g) {
                const float bj = __shfl(bv[g], gbase + (ptr[g] & 15));
                const unsigned mine = ptr[g] < 16 ? ((f2key(av[g] + bj) & ~255u) | (unsigned)(255 - (fr * 16 + (ptr[g] & 15)))) : 0u;
                const unsigned m = row16_max_u32(mine);
                best[g] = fr == it ? m : best[g];
                ptr[g] += (m == mine) ? 1 : 0;
            }
        }
#pragma unroll
        for (int g = 0; g < 4; ++g) {
            const int bc = 255 - (int)(best[g] & 255u);
            const float bval = key2f(best[g] & ~255u);
            const int k1 = 127 - (int)(tkp[0][g] & 127u), k2 = 127 - (int)(tkp[1][g] & 127u);
            const int i1 = __shfl(k1, gbase + (bc >> 4)), i2 = __shfl(k2, gbase + (bc & 15));
            const float mx = __shfl(bval, gbase);
            const float ex = __expf(bval - mx);
            float sm = ex;
#pragma unroll
            for (int o = 1; o < 16; o <<= 1) sm += __shfl_xor(sm, o);
            const size_t tok = (size_t)tile * 16 + fq * 4 + g;
            EIDX[tok * 128 + h * 16 + fr] = i1 * 128 + i2; EGATE[tok * 128 + h * 16 + fr] = ex / sm;
        }
    }
}

template <int CTRL> __device__ __forceinline__ float dppf(float x) { return __builtin_bit_cast(float, __builtin_amdgcn_mov_dpp(__builtin_bit_cast(int, x), CTRL, 0xf, 0xf, true)); }
__device__ __forceinline__ float rs_group8(float (&d)[8], bool b8) {
    asm volatile("s_nop 1\n\tv_permlane32_swap_b32 %0, %4\n\tv_permlane32_swap_b32 %1, %5\n\tv_permlane32_swap_b32 %2, %6\n\tv_permlane32_swap_b32 %3, %7"
                 : "+v"(d[0]), "+v"(d[1]), "+v"(d[2]), "+v"(d[3]), "+v"(d[4]), "+v"(d[5]), "+v"(d[6]), "+v"(d[7]));
    float s0 = d[0] + d[4], s1 = d[1] + d[5], s2 = d[2] + d[6], s3 = d[3] + d[7];
    asm volatile("s_nop 1\n\tv_permlane16_swap_b32 %0, %2\n\tv_permlane16_swap_b32 %1, %3" : "+v"(s0), "+v"(s1), "+v"(s2), "+v"(s3));
    const float t0 = s0 + s2, t1 = s1 + s3;
    const float m = b8 ? t1 : t0, o = b8 ? t0 : t1;
    return m + dppf<0x128>(o);
}
template <int CTRL> __device__ __forceinline__ float rs_merge(float a, float b, bool bit) { const float m = bit ? b : a, o = bit ? a : b; return m + dppf<CTRL>(o); }
constexpr int PG = 8;
__device__ __forceinline__ void phase_peer(const Params& p, int l, LAS unsigned char* lds, int tid, int lane, int wave, int bid, int G) {
    const int gw = bid * NWAVES + wave, NGW = G * NWAVES;
    const float* MOD = (const float*)(p.ws + WS_MOD);
    bf16_t* XL = (bf16_t*)(p.ws + WS_XL); bf16_t* HB = (bf16_t*)(p.ws + WS_HB);
    const float* lg = p.in[I_LNG] + (size_t)(l * 2 + 1) * DM; const float* lb = p.in[I_LNB] + (size_t)(l * 2 + 1) * DM;
    const unsigned char* UB = p.ws + WS_UB + (size_t)l * NEXP * ROWB_U; const unsigned char* VB = p.ws + WS_VB + (size_t)l * NEXP * ROWB_V;
    const float* USC = (const float*)(p.ws + WS_USC) + (size_t)l * NEXP; (void)USC; const float* VSC = (const float*)(p.ws + WS_VSC) + (size_t)l * NEXP; (void)VSC;
    const int* EIDX = (const int*)(p.ws + WS_EIDX); const float* EGATE = (const float*)(p.ws + WS_EGATE);
    const bool last = (l == DEPTH - 1);
    const int nrows = last ? TL : TA;
    constexpr int HLW = 64 * 33 * 4 + 128;
    LAS float* HL = (LAS float*)(lds + wave * HLW) + lane * 33;
    LAS int* PI = (LAS int*)((LAS float*)(lds + wave * HLW) + 64 * 33);
    LAS float* VEC = (LAS float*)(lds + 8 * HLW);
    for (int i = tid; i < 11 * DM / 4; i += NTHREADS) { const int vi = i / (DM / 4), c = (i % (DM / 4)) * 4; const int ln = last ? l : l + 1;
        const float* src = vi < 3 ? MOD + (size_t)(l * 3 + vi) * 6 * DM + 5 * DM + c : (vi < 9 ? MOD + (size_t)(ln * 3 + (vi % 3)) * 6 * DM + (vi / 3 - 1) * DM + c : (vi == 9 ? lg : lb) + c);
        *(LAS f32x4*)(VEC + vi * DM + c) = *(const f32x4*)src; }
    __syncthreads();
#if !TBL_U_FP4
    {
        float one = 1.0f; asm volatile("" : "+v"(one));
        f32x16 t0, t1;
#pragma unroll
        for (int c = 0; c < 32; ++c) { const float v = one * (c < 8 ? (float)c * 0.125f : (1.0f + (float)(c & 7) * 0.125f) * (float)(1 << ((c >> 3) - 1))); if (c < 16) t0[c] = v; else t1[c - 16] = v; }
        const u32x6 pw = pack_fp6_2x16(t0, t1);
        const f32x32 un = unpack_fp6_32(pw);
#pragma unroll
        for (int j = 0; j < 32; ++j) { const float y = un[j]; int c;
            if (y < 1.0f) c = (int)(y * 8.0f + 0.5f); else { const int e = y < 2.0f ? 0 : (y < 4.0f ? 1 : 2); c = 8 * (e + 1) + (int)((y / (float)(1 << e) - 1.0f) * 8.0f + 0.5f); }
            if (lane == 0) PI[j] = c & 31; }
        LDS_FENCE();
#if defined(DIAG_PI)
        { unsigned mk = 0u;
#pragma unroll
          for (int j = 0; j < 32; ++j) mk |= 1u << PI[j];
          if (mk != 0xFFFFFFFFu && l == 0 && gw == 0 && lane == 0) ((float*)(p.ws + WS_CTL + 131072))[0] = 1.0f; }
#endif
    }
#endif
    const unsigned ulane = (unsigned)lane & 63u, loff16 = ulane * 16u; (void)ulane; (void)loff16;
    const bool lb8 = (lane & 8) != 0, lb4 = (lane & 4) != 0, lb2 = (lane & 2) != 0, lb1 = (lane & 1) != 0; (void)lb8; (void)lb4; (void)lb2; (void)lb1;
    const int lsrc = ((lane & 6) << 3) | ((lane & 1) << 3) | (((lane >> 3) & 1) << 2) | (((lane >> 4) & 1) << 1) | ((lane >> 5) & 1); (void)lsrc;
    for (int r = row_first(wave, bid, G); r >= 0; r = row_next(r, wave, bid, G, nrows)) {
        const float* mod = MOD + (size_t)(l * 3 + row_stream(r)) * 6 * DM;
        f32x2v hn[16];
#pragma unroll
        for (int c = 0; c < 4; ++c) { float f[8]; unpack8(*(const u32x4*)(HB + (size_t)r * DM + lane * 32 + c * 8), f);
#pragma unroll
            for (int e = 0; e < 4; ++e) hn[c * 4 + e] = (f32x2v){f[2 * e], f[2 * e + 1]}; }
#if !TBL_U_FP4
#pragma unroll
        for (int j = 0; j < 16; ++j) { HL[2 * j] = hn[j].x; HL[2 * j + 1] = hn[j].y; }
        LDS_FENCE();
        f32x2v hf[16];
#pragma unroll
        for (int j = 0; j < 16; ++j) hf[j] = (f32x2v){HL[PI[2 * j]], HL[PI[2 * j + 1]]};
        LDS_FENCE();
#endif
#if TBL_U_I4
        int hlo[4], hhi[4]; unsigned basel;
        { float am = 0.f;
#pragma unroll
          for (int j = 0; j < 16; ++j) am = fmaxf(am, fmaxf(fabsf(hn[j].x), fabsf(hn[j].y)));
          const unsigned ab = __builtin_bit_cast(unsigned, am * (1.0f / 119.0f)); unsigned eb = (ab >> 23) + ((ab & 0x007fffffu) ? 1u : 0u); eb = eb < 1u ? 1u : (eb > 253u ? 253u : eb);
          const float inv = __builtin_bit_cast(float, (254u - eb) << 23);
          basel = U_ROWSCALE ? (eb << 23) : (I4_BASE + ((eb - 127u) << 23));
#pragma unroll
          for (int d = 0; d < 4; ++d) { unsigned tl = 0u, th = 0u;
#pragma unroll
              for (int e = 0; e < 8; ++e) { const f32x2v pr = hn[d * 4 + (e >> 1)]; const float xv = (e & 1) ? pr.y : pr.x;
                  const unsigned qb = __builtin_bit_cast(unsigned, xv * inv + 12582912.0f);
                  tl |= (qb & 15u) << (4 * e); th |= (((qb + 8u) >> 4) & 15u) << (4 * e); }
              hlo[d] = (int)tl; hhi[d] = (int)th; } }
#endif
        const int e0 = EIDX[(size_t)r * 128 + lane], e1 = EIDX[(size_t)r * 128 + 64 + lane];
        const float g0 = EGATE[(size_t)r * 128 + lane], g1 = EGATE[(size_t)r * 128 + 64 + lane];
#if !TBL_U_FP4 || U_ROWSCALE
        const float su0 = USC[e0], su1 = USC[e1];
#else
        const float su0 = 1.0f, su1 = 1.0f;
#endif
        float wgt[2] = {0.f, 0.f};
#define P4_LOAD(dq, ds, TB, eh, j0) do { unsigned lo_ = loff16, ul_ = ulane; asm volatile("" : "+v"(lo_), "+v"(ul_));    \
        _Pragma("unroll") for (int c = 0; c < PG; ++c) { const int e_ = __builtin_amdgcn_readlane(eh, (j0) + c); \
            const unsigned char* rp_ = (TB) + (size_t)e_ * ROWB4; dq[c] = *(const u32x4*)(rp_ + lo_); ds[c] = rp_[1024u + ul_]; } } while (0)
#if V_ROWSCALE
#define P4_LDV P4_LOADU
#else
#define P4_LDV P4_LOAD
#endif
#if U_ROWSCALE
#define P4_LDU P4_LOADU
#else
#define P4_LDU P4_LOAD
#endif
#define P4_LOADU(dq, ds, TB, eh, j0) do { const __amdgpu_buffer_rsrc_t rs_ = __builtin_amdgcn_make_buffer_rsrc((void*)(TB), 0, NEXP * 1024, 0x00020000); \
        _Pragma("unroll") for (int c = 0; c < PG; ++c) { const int e_ = __builtin_amdgcn_readlane(eh, (j0) + c); \
            dq[c] = __builtin_bit_cast(u32x4, __builtin_amdgcn_raw_buffer_load_b128(rs_, (int)loff16, (int)(((unsigned)e_ & 0x3fffu) << 10), 0)); ds[c] = e_; } } while (0)
#define P4_CVT(dq, c, d, b, sc) __builtin_amdgcn_cvt_scalef32_pk_f32_fp4(dq[c][d], sc, b)
#if TBL_U_I4
#define P4_DOT(dq, ds, rr) do { float d_[PG]; _Pragma("unroll") for (int c = 0; c < PG; ++c) { int t_ = 0;        \
            _Pragma("unroll") for (int d = 0; d < 4; ++d) t_ = __builtin_amdgcn_sdot8((int)dq[c][d], hhi[d], t_, false); \
            t_ <<= 4; \
            _Pragma("unroll") for (int d = 0; d < 4; ++d) t_ = __builtin_amdgcn_sdot8((int)dq[c][d], hlo[d], t_, false); \
            d_[c] = (float)t_ * (U_ROWSCALE ? __builtin_bit_cast(float, basel) : __builtin_bit_cast(float, ((unsigned)ds[c] << 20) + basel)); } \
        rr = rs_group8(d_, lb8); } while (0)
#else
#define P4_DOT(dq, ds, rr) do { float d_[PG]; _Pragma("unroll") for (int c = 0; c < PG; ++c) { const float sc_ = __builtin_bit_cast(float, (unsigned)ds[c] << 23); f32x2v a0_ = (f32x2v){0.f, 0.f}, a1_ = (f32x2v){0.f, 0.f}; \
            _Pragma("unroll") for (int d = 0; d < 4; ++d) { a0_ += P4_CVT(dq, c, d, 0, sc_) * hn[d * 4 + 0]; a1_ += P4_CVT(dq, c, d, 1, sc_) * hn[d * 4 + 1]; a0_ += P4_CVT(dq, c, d, 2, sc_) * hn[d * 4 + 2]; a1_ += P4_CVT(dq, c, d, 3, sc_) * hn[d * 4 + 3]; } \
            d_[c] = (a0_.x + a0_.y) + (a1_.x + a1_.y); asm volatile("" : "+v"(d_[c])); } \
        rr = rs_group8(d_, lb8); } while (0)
#endif
#define P4_AXPY(dq, ds, wh, j0) do { _Pragma("unroll") for (int c = 0; c < PG; ++c) { const float wj_ = V_ROWSCALE ? __builtin_bit_cast(float, (unsigned)ds[c] & 0xffff0000u) : __builtin_bit_cast(float, __builtin_amdgcn_readlane(wh, (j0) + c)); const f32x2v w2_ = (f32x2v){wj_, wj_}; \
            const float sc_ = V_ROWSCALE ? 1.0f : __builtin_bit_cast(float, (unsigned)ds[c] << 23); \
            _Pragma("unroll") for (int d = 0; d < 4; ++d) { yv[d * 4 + 0] += P4_CVT(dq, c, d, 0, sc_) * w2_; yv[d * 4 + 1] += P4_CVT(dq, c, d, 1, sc_) * w2_; yv[d * 4 + 2] += P4_CVT(dq, c, d, 2, sc_) * w2_; yv[d * 4 + 3] += P4_CVT(dq, c, d, 3, sc_) * w2_; } \
            asm volatile("" : "+v"(yv[0]), "+v"(yv[1]), "+v"(yv[2]), "+v"(yv[3]), "+v"(yv[4]), "+v"(yv[5]), "+v"(yv[6]), "+v"(yv[7]), "+v"(yv[8]), "+v"(yv[9]), "+v"(yv[10]), "+v"(yv[11]), "+v"(yv[12]), "+v"(yv[13]), "+v"(yv[14]), "+v"(yv[15]));   } } while (0)
#if !TBL_U_FP4
#define PEER_LOAD(dq, dd, TB, eh, j0) do { _Pragma("unroll") for (int c = 0; c < PG; ++c) { const int e_ = __builtin_amdgcn_readlane(eh, (j0) + c); \
            const unsigned char* rp_ = (TB) + (size_t)e_ * ROWB; dq[c] = *(const u32x4*)(rp_ + lane * 16); dd[c] = *(const u32x2*)(rp_ + 1024 + lane * 8); } } while (0)
#define PEER_UNPACK(dq, dd, c) unpack_fp6_32((u32x6){dq[c].x, dq[c].y, dq[c].z, dq[c].w, dd[c].x, dd[c].y})
#define PEER_DOT(dq, dd, j0) do { float d_[PG]; _Pragma("unroll") for (int c = 0; c < PG; ++c) { const f32x32 u_ = PEER_UNPACK(dq, dd, c); f32x2v a0_ = (f32x2v){0.f, 0.f}, a1_ = (f32x2v){0.f, 0.f}; \
            _Pragma("unroll") for (int t = 0; t < 8; ++t) { a0_ += (f32x2v){u_[4 * t], u_[4 * t + 1]} * hf[2 * t]; a1_ += (f32x2v){u_[4 * t + 2], u_[4 * t + 3]} * hf[2 * t + 1]; } \
            d_[c] = (a0_.x + a0_.y) + (a1_.x + a1_.y); __builtin_amdgcn_sched_barrier(0); } \
        _Pragma("unroll") for (int o = 1; o < 64; o <<= 1) { _Pragma("unroll") for (int c = 0; c < PG; ++c) d_[c] += __shfl_xor(d_[c], o); } \
        _Pragma("unroll") for (int c = 0; c < PG; ++c) wacc = (lane == (j0) + c) ? d_[c] : wacc; } while (0)
#endif
#pragma unroll
        for (int hh = 0; hh < 2; ++hh) {
            const int eh = hh ? e1 : e0; float wacc = 0.f;
#if TBL_U_FP4
            u32x4 qa[PG], qb[PG]; int sa[PG], sb[PG];
            P4_LDU(qa, sa, UB, eh, 0);
            float wq = 0.f, wp = 0.f;
#pragma unroll 1
            for (int j0 = 0; j0 < 64; j0 += 2 * PG) {
                float ra, rb;
                P4_LDU(qb, sb, UB, eh, j0 + PG);
                P4_DOT(qa, sa, ra);
                if (j0 + 2 * PG < 64) P4_LDU(qa, sa, UB, eh, j0 + 2 * PG);
                P4_DOT(qb, sb, rb);
                const float q = rs_merge<0x141>(ra, rb, lb4);
                if ((j0 & 16) == 0) wq = q;
                else { const float pm = rs_merge<0x4E>(wq, q, lb2);
                       if (j0 == 16) wp = pm; else wacc = rs_merge<0xB1>(wp, pm, lb1); }
            }
            wacc = __shfl(wacc, lsrc);
#else
            u32x4 qa[PG], qb[PG]; u32x2 da[PG], db[PG];
            PEER_LOAD(qa, da, UB, eh, 0);
#pragma unroll 1
            for (int j0 = 0; j0 < 64; j0 += 2 * PG) {
                PEER_LOAD(qb, db, UB, eh, j0 + PG);
                PEER_DOT(qa, da, j0);
                if (j0 + 2 * PG < 64) PEER_LOAD(qa, da, UB, eh, j0 + 2 * PG);
                PEER_DOT(qb, db, j0 + PG);
            }
#endif
            wgt[hh] = gelu_f(wacc * (hh ? su1 : su0)) * (hh ? g1 : g0) * (V_ROWSCALE ? VSC[eh] : 1.0f);
        }
        f32x2v yv[16];
#pragma unroll
        for (int i = 0; i < 16; ++i) yv[i] = (f32x2v){0.f, 0.f};
#pragma unroll
        for (int hh = 0; hh < 2; ++hh) {
            const int eh = V_ROWSCALE ? ((hh ? e1 : e0) | (int)((__builtin_bit_cast(unsigned, wgt[hh]) + 0x8000u) & 0xffff0000u)) : (hh ? e1 : e0); const int wh = __builtin_bit_cast(int, wgt[hh]); (void)wh;
            u32x4 qa[PG], qb[PG]; int sa[PG], sb[PG];
            P4_LDV(qa, sa, VB, eh, 0);
#pragma unroll 1
            for (int j0 = 0; j0 < 64; j0 += 2 * PG) {
                P4_LDV(qb, sb, VB, eh, j0 + PG);
                P4_AXPY(qa, sa, wh, j0);
                if (j0 + 2 * PG < 64) P4_LDV(qa, sa, VB, eh, j0 + 2 * PG);
                P4_AXPY(qb, sb, wh, j0 + PG);
            }
        }
#undef P4_LOAD
#undef P4_CVT
#undef P4_DOT
#undef P4_AXPY
#if !TBL_U_FP4
#undef PEER_LOAD
#undef PEER_UNPACK
#undef PEER_DOT
#endif
        const int st = row_stream(r);
        const bf16_t* xr = (const bf16_t*)(p.ws + WS_XM) + (size_t)r * DM + lane * 32;
        f32x4 xv[8];
#pragma unroll
        for (int t = 0; t < 4; ++t) { const u32x4 w = *(const u32x4*)(xr + t * 8); xv[2 * t] = (f32x4){bflo(w.x), bfhi(w.x), bflo(w.y), bfhi(w.y)}; xv[2 * t + 1] = (f32x4){bflo(w.z), bfhi(w.z), bflo(w.w), bfhi(w.w)}; }
        float s = 0.f;
#pragma unroll
        for (int t = 0; t < 8; ++t) { const f32x4 ga = *(const LAS f32x4*)(VEC + st * DM + lane * 32 + t * 4);
            f32x2v& ya = yv[t * 2]; f32x2v& yb = yv[t * 2 + 1];
            ya.x = xv[t].x * DN_ALPHA + ga.x * ya.x; ya.y = xv[t].y * DN_ALPHA + ga.y * ya.y; yb.x = xv[t].z * DN_ALPHA + ga.z * yb.x; yb.y = xv[t].w * DN_ALPHA + ga.w * yb.y;
            s += (ya.x + ya.y) + (yb.x + yb.y); }
        const float mean = wave_sum(s) * (1.0f / DM);
        float s2 = 0.f;
#pragma unroll
        for (int i = 0; i < 16; ++i) { yv[i] = yv[i] - mean; s2 += yv[i].x * yv[i].x + yv[i].y * yv[i].y; }
        const float rstd = 1.0f / sqrtf(wave_sum(s2) * (1.0f / DM) + LN_EPS);
        float* dst = p.out + (size_t)r * DM + lane * 32; bf16_t* dstb = XL + (size_t)r * DM + lane * 32;
#pragma unroll
        for (int t = 0; t < 8; t += 2) { const int c = t * 4;
            const f32x4 ga = *(const LAS f32x4*)(VEC + 9 * DM + lane * 32 + c), gb = *(const LAS f32x4*)(VEC + 9 * DM + lane * 32 + c + 4), ba = *(const LAS f32x4*)(VEC + 10 * DM + lane * 32 + c), bb = *(const LAS f32x4*)(VEC + 10 * DM + lane * 32 + c + 4);
            const f32x2v y0 = yv[t * 2], y1 = yv[t * 2 + 1], y2 = yv[t * 2 + 2], y3 = yv[t * 2 + 3];
            f32x4 o0, o1;
            o0.x = y0.x * rstd * ga.x + ba.x; o0.y = y0.y * rstd * ga.y + ba.y; o0.z = y1.x * rstd * ga.z + ba.z; o0.w = y1.y * rstd * ga.w + ba.w;
            o1.x = y2.x * rstd * gb.x + bb.x; o1.y = y2.y * rstd * gb.y + bb.y; o1.z = y3.x * rstd * gb.z + bb.z; o1.w = y3.y * rstd * gb.w + bb.w;
            if (last) { *(f32x4*)(dst + c) = o0; *(f32x4*)(dst + c + 4) = o1; }
            else { u32x4 xw; xw.x = pk2(o0.x, o0.y); xw.y = pk2(o0.z, o0.w); xw.z = pk2(o1.x, o1.y); xw.w = pk2(o1.z, o1.w); *(u32x4*)(dstb + c) = xw; }
            if (!last) {
                const f32x4 sa = *(const LAS f32x4*)(VEC + (3 + st) * DM + lane * 32 + c), sb = *(const LAS f32x4*)(VEC + (3 + st) * DM + lane * 32 + c + 4), ca = *(const LAS f32x4*)(VEC + (6 + st) * DM + lane * 32 + c), cb = *(const LAS f32x4*)(VEC + (6 + st) * DM + lane * 32 + c + 4);
                u32x4 o; o.x = pk2(o0.x * (1.f + ca.x) + sa.x, o0.y * (1.f + ca.y) + sa.y); o.y = pk2(o0.z * (1.f + ca.z) + sa.z, o0.w * (1.f + ca.w) + sa.w);
                o.z = pk2(o1.x * (1.f + cb.x) + sb.x, o1.y * (1.f + cb.y) + sb.y); o.w = pk2(o1.z * (1.f + cb.z) + sb.z, o1.w * (1.f + cb.w) + sb.w);
                *(u32x4*)(HB + (size_t)r * DM + lane * 32 + c) = o; }
        }
#if defined(DIAG_PI)
        if (last && r == 5 && lane == 0 && ((const float*)(p.ws + WS_CTL + 131072))[0] != 0.0f) p.out[(size_t)5 * DM] = __builtin_nanf("");
#endif
    }
}

__device__ __forceinline__ void gemm_rows_bf16(LAS unsigned char* lds, const bf16_t* A, const bf16_t* Bt, bf16_t* C, float* Cpart, bool with_ctx, int G, int bid) {
    { pg8::Gemm g{A, Bt, TL, DM, DM, DM}; pg8::StaticOrder S; S.init(TL, DM, G, bid); pg8::EpiBf16<0> E{C, DM, nullptr, 0, 0, 1.f};
      pg8::gemm_phase<pg8::EpiBf16<0>, pg8::StaticOrder, PG8_ALIGN, PG8_SP2>(lds, g, S, E); }
    if (with_ctx) { int ksl = 256; asm volatile("" : "+s"(ksl));
      pg8::Gemm g{A + (size_t)TL * DM, Bt, TC, DM, ksl, DM}; pg8::SplitKOrder S; S.init(G, bid); pg8::EpiF32Part E{Cpart};
      pg8::gemm_phase<pg8::EpiF32Part, pg8::SplitKOrder, PG8_ALIGN, PG8_SP2>(lds, g, S, E); }
}

constexpr int PH_PER_LAYER = 9, N_PHASES = 2 + DEPTH * PH_PER_LAYER;
__global__ void __launch_bounds__(NTHREADS, 2) fwd_kernel(Params p) {
    extern __shared__ __attribute__((aligned(16))) unsigned char lds_raw[];
    LAS unsigned char* lds = (LAS unsigned char*)lds_raw;
    const int tid = threadIdx.x, lane = tid & 63, wave = __builtin_amdgcn_readfirstlane(tid >> 6), bid = blockIdx.x, G = gridDim.x;
    volatile LAS unsigned* MISC = (volatile LAS unsigned*)(lds + MISC_OFF);
    if (tid < 32) MISC[tid] = 0u;
    __syncthreads();
    if (hipThreadIdx_x == 0) (void)xb_add(&((unsigned*)(p.ws + WS_CTL))[CW_BAR + XB_XCNT(xb_xcc_id())], 1u);
#define IN(k) true
#if defined(PROBE_MASK)
    volatile LAS unsigned long long* PT = (volatile LAS unsigned long long*)(lds + MISC_OFF + 96);
    if (tid == 0) PT[0] = __builtin_amdgcn_s_memrealtime();
#define SEAM(k) do { { XcdBarrier bar_; bar_.bar = (unsigned*)(((const __attribute__((address_space(4))) Params*)__builtin_amdgcn_kernarg_segment_ptr())->ws + WS_CTL) + CW_BAR; bar_.x = xb_xcc_id(); bar_.st = MISC + 8; xcd_barrier(bar_); } if (bid == 0) { const int kind_ = (k) < 2 ? (k) : 2 + ((k) - 2) % PH_PER_LAYER; \
        if (tid == 0) { const unsigned long long now_ = __builtin_amdgcn_s_memrealtime(); if ((PROBE_MASK >> kind_) & 1) { const unsigned long long d_ = (now_ - PT[0]) * PROBE_MULT; \
            while (__builtin_amdgcn_s_memrealtime() - now_ < d_) __builtin_amdgcn_s_sleep(8); } PT[0] = __builtin_amdgcn_s_memrealtime(); } __syncthreads(); } } while (0)
#elif defined(PROBE_DUP_BAR)
#define SEAM(k) do { XcdBarrier bar_; bar_.bar = (unsigned*)(((const __attribute__((address_space(4))) Params*)__builtin_amdgcn_kernarg_segment_ptr())->ws + WS_CTL) + CW_BAR; bar_.x = xb_xcc_id(); bar_.st = MISC + 8; xcd_barrier(bar_); xcd_barrier(bar_); } while (0)
#else
#define SEAM(k) do { XcdBarrier bar_; bar_.bar = (unsigned*)(((const __attribute__((address_space(4))) Params*)__builtin_amdgcn_kernarg_segment_ptr())->ws + WS_CTL) + CW_BAR; bar_.x = xb_xcc_id(); bar_.st = MISC + 8; xcd_barrier(bar_); } while (0)
#endif
    const int NGW = G * NWAVES;
#if defined(__HIP_DEVICE_COMPILE__)
#define KARGS_COPY const Params p_ = *kp_
#else
#define KARGS_COPY const Params p_ = p; (void)kp_
#endif
#define FRESH() int tid_ = threadIdx.x, bid_ = blockIdx.x; asm volatile("" : "+v"(tid_), "+s"(bid_)); const int lane_ = tid_ & 63, wave_ = __builtin_amdgcn_readfirstlane(tid_ >> 6); (void)lane_; (void)wave_; \
    const __attribute__((address_space(4))) Params* kp_ = (const __attribute__((address_space(4))) Params*)__builtin_amdgcn_kernarg_segment_ptr(); asm volatile("" : "+s"(kp_)); KARGS_COPY
    if (IN(0)) { FRESH(); phase_prologue(p_, lds, tid_, lane_, wave_, bid_, G); }
    SEAM(0);
    if (IN(1)) { FRESH(); phase_modulate0(p_, lane_, wave_, bid_, G); }
    SEAM(1);
    for (int l = 0; l < DEPTH; ++l) {
        const int b0 = 2 + l * PH_PER_LAYER;
        if (IN(b0 + 0)) { FRESH();
            pg8::Gemm g{(const bf16_t*)(p_.ws + WS_HB), (const bf16_t*)(p_.ws + WS_WIN) + (size_t)l * INWP * DM, TA, INWP, DM, DM}; pg8::StaticOrder S; S.init(TA, INWP, G, bid_);
            pg8::EpiBf16<0> E{(bf16_t*)(p_.ws + WS_P), INWP, nullptr, 0, 0, 1.f};
            pg8::gemm_phase<pg8::EpiBf16<0>, pg8::StaticOrder, PG8_ALIGN, PG8_SP2>(lds, g, S, E);
#if defined(PROBE_DUP_GEMM)
            __syncthreads(); pg8::gemm_phase<pg8::EpiBf16<0>, pg8::StaticOrder, PG8_ALIGN, PG8_SP2>(lds, g, S, E);
#endif
        }
        SEAM(b0 + 0);
        if (IN(b0 + 1)) { { FRESH(); gla_g1(p_, l, lds, tid_, lane_, wave_, bid_, G); } { FRESH(); phase_post_in(p_, l, lane_, wave_, bid_, G); } }
#if defined(PROBE_DUP_A)
        if (IN(b0 + 1)) { __syncthreads(); { FRESH(); gla_g1(p_, l, lds, tid_, lane_, wave_, bid_, G); } { FRESH(); phase_post_in(p_, l, lane_, wave_, bid_, G); } }
#endif
        SEAM(b0 + 1);
        if (IN(b0 + 2)) {
            unsigned* ctl_ = (unsigned*)(((const __attribute__((address_space(4))) Params*)__builtin_amdgcn_kernarg_segment_ptr())->ws + WS_CTL);
            { FRESH(); gla_g2(p_, tid_, bid_, G);
              if (bid_ < 64) { asm volatile("s_waitcnt vmcnt(0)" ::: "memory"); __syncthreads();
                  if (tid_ == 0) { __builtin_amdgcn_fence(__ATOMIC_RELEASE, "agent"); asm volatile("s_waitcnt vmcnt(0)" ::: "memory"); (void)xb_add(ctl_ + CW_QUEUE + 64 * (12 + l), 1u); } } }
            { FRESH(); phase_mixers(p_, l, lds, tid_, lane_, wave_, bid_, G); }
            { FRESH();
              if (tid_ == 0) { unsigned* bar = ctl_ + CW_BAR; XB_SPIN(xb_ld(ctl_ + CW_QUEUE + 64 * (12 + l)) < (G < 64 ? (unsigned)G : 64u), bar);
                  __builtin_amdgcn_fence(__ATOMIC_ACQUIRE, "agent"); asm volatile("s_waitcnt vmcnt(0)" ::: "memory"); }
              __syncthreads();
              gla_g3(p_, l, lds, tid_, lane_, wave_, bid_, G, ctl_ + CW_QUEUE + 64 * (8 + l)); }
        }
#if defined(PROBE_DUP_B)
        if (IN(b0 + 2)) { __syncthreads(); { FRESH(); gla_g2(p_, tid_, bid_, G); } { FRESH(); phase_mixers(p_, l, lds, tid_, lane_, wave_, bid_, G, 1); } }
#endif
#if defined(PROBE_DUP_C)
        if (IN(b0 + 3)) { __syncthreads(); FRESH(); gla_g3(p_, l, lds, tid_, lane_, wave_, bid_, G); }
#endif
        SEAM(b0 + 3);
        if (IN(b0 + 4)) { FRESH();
            gemm_rows_bf16(lds, (const bf16_t*)(p_.ws + WS_MIX), (const bf16_t*)(p_.ws + WS_WOUT) + (size_t)l * DM * DM, (bf16_t*)(p_.ws + WS_Y), (float*)(p_.ws + WS_YPART), l < DEPTH - 1, G, bid_);
#if defined(PROBE_DUP_GEMM)
            __syncthreads(); gemm_rows_bf16(lds, (const bf16_t*)(p_.ws + WS_MIX), (const bf16_t*)(p_.ws + WS_WOUT) + (size_t)l * DM * DM, (bf16_t*)(p_.ws + WS_Y), (float*)(p_.ws + WS_YPART), l < DEPTH - 1, G, bid_);
#endif
        }
        SEAM(b0 + 4);
        if (IN(b0 + 5)) { FRESH(); phase_ln1(p_, l, lds, tid_, lane_, wave_, bid_, G); }
#if defined(PROBE_DUP_E)
        if (IN(b0 + 5)) { __syncthreads(); FRESH(); phase_ln1(p_, l, lds, tid_, lane_, wave_, bid_, G); }
#endif
        SEAM(b0 + 5);
        if (IN(b0 + 6)) { FRESH();
            gemm_rows_bf16(lds, (const bf16_t*)(p_.ws + WS_HB), (const bf16_t*)(p_.ws + WS_WQ) + (size_t)l * DM * DM, (bf16_t*)(p_.ws + WS_QP), (float*)(p_.ws + WS_QPART), l < DEPTH - 1, G, bid_);
#if defined(PROBE_DUP_GEMM)
            __syncthreads(); gemm_rows_bf16(lds, (const bf16_t*)(p_.ws + WS_HB), (const bf16_t*)(p_.ws + WS_WQ) + (size_t)l * DM * DM, (bf16_t*)(p_.ws + WS_QP), (float*)(p_.ws + WS_QPART), l < DEPTH - 1, G, bid_);
#endif
        }
        SEAM(b0 + 6);
        if (IN(b0 + 7)) { FRESH(); peer_retrieve(p_, l, lds, tid_, lane_, wave_, bid_, G, l < DEPTH - 1 ? TA : TL); }
#if defined(PROBE_DUP_D)
        if (IN(b0 + 7)) { __syncthreads(); FRESH(); peer_retrieve(p_, l, lds, tid_, lane_, wave_, bid_, G, l < DEPTH - 1 ? TA : TL); }
#endif
        SEAM(b0 + 7);
        if (IN(b0 + 8)) { FRESH(); phase_peer(p_, l, lds, tid_, lane_, wave_, bid_, G); }
        if (l < DEPTH - 1) SEAM(b0 + 8);
    }
#undef FRESH
#undef IN
#undef SEAM
}

#ifndef MK_PER_PHASE
#define MK_PER_PHASE 0
#endif
extern "C" void kernel_launch(void* const* d_in, const int* in_sizes, int n_in, void* d_out, int out_size, void* d_ws, size_t ws_size, hipStream_t stream) {
    static int grid = 0;
    if (grid == 0) {
        if (n_in != 19 || out_size != TL * DM || ws_size < WS_END) { fprintf(stderr, "kernel_launch: unexpected shapes (n_in %d out %d ws %zu)\n", n_in, out_size, ws_size); grid = -1; return; }
        int dev = 0, cus = 0;
        if (hipGetDevice(&dev) != hipSuccess || hipDeviceGetAttribute(&cus, hipDeviceAttributeMultiprocessorCount, dev) != hipSuccess) { grid = -1; return; }
        if (hipFuncSetAttribute((const void*)fwd_kernel, hipFuncAttributeMaxDynamicSharedMemorySize, LDS_BYTES) != hipSuccess) { fprintf(stderr, "kernel_launch: hipFuncSetAttribute failed\n"); grid = -1; return; }
        int per_cu = 0;
        (void)hipOccupancyMaxActiveBlocksPerMultiprocessor(&per_cu, (const void*)fwd_kernel, NTHREADS, LDS_BYTES);
        (void)hipGetLastError();
        if (per_cu < 1) fprintf(stderr, "kernel_launch: occupancy query reports %d blocks per CU\n", per_cu);
        grid = cus;
    }
    if (grid < 0) return;
    (void)hipMemsetAsync((char*)d_ws + WS_CTL, 0, CTL_ZERO_BYTES, stream);
    Params p{};
    for (int i = 0; i < 19; ++i) p.in[i] = (const float*)d_in[i];
    p.out = (float*)d_out; p.ws = (unsigned char*)d_ws;
#if MK_PER_PHASE
    for (int ph = 0; ph < N_PHASES; ++ph) { p.ph_lo = ph; p.ph_hi = ph + 1; hipLaunchKernelGGL(fwd_kernel, dim3(grid), dim3(NTHREADS), LDS_BYTES, stream, p); }
#else
    p.ph_lo = 0; p.ph_hi = N_PHASES;
    hipLaunchKernelGGL(fwd_kernel, dim3(grid), dim3(NTHREADS), LDS_BYTES, stream, p);
#endif
}
```

```cpp
#include <hip/hip_runtime.h>
#include <cstdio>
#include <cstdint>

#define LAS __attribute__((address_space(3)))
typedef unsigned short bf16_t;
typedef short bf16x8 __attribute__((ext_vector_type(8)));
typedef float f32x4 __attribute__((ext_vector_type(4)));
typedef unsigned u32x4 __attribute__((ext_vector_type(4)));
typedef unsigned u32x2 __attribute__((ext_vector_type(2)));
typedef unsigned u32x6 __attribute__((ext_vector_type(6)));
typedef float f32x2v __attribute__((ext_vector_type(2)));
typedef float f32x16 __attribute__((ext_vector_type(16)));
typedef float f32x32 __attribute__((ext_vector_type(32)));

constexpr int DM = 2048, NBATCH = 2, SEQ = 8192, DEPTH = 4, CTXL = 256;
constexpr int TL = NBATCH * SEQ, TC = NBATCH * CTXL, TA = TL + TC;
constexpr int INW = 4640, INWP = 4864;
constexpr int C_CX = 0, C_CB = 512, C_CC = 1024, C_GQ = 1536, C_GK = 1792, C_GV = 2048, C_GG = 2560, C_LRF = 3072, C_LRB = 3088,
              C_SQ = 3104, C_SK = 4128, C_SV = 4384;
constexpr int NEXP = 16384;
constexpr int ROWB = 1536;
constexpr int ROWB4 = 1088;
#ifndef TBL_U_FP4
#define TBL_U_FP4 1
#endif
#ifndef TBL_U_I4
#define TBL_U_I4 (TBL_U_FP4)
#endif
constexpr unsigned I4_BASE = 103u << 23;
#ifndef U_ROWSCALE
#define U_ROWSCALE (TBL_U_I4)
#endif
#ifndef V_ROWSCALE
#define V_ROWSCALE 1
#endif
constexpr int ROWB_U = U_ROWSCALE ? 1024 : (TBL_U_FP4 ? ROWB4 : ROWB), ROWB_V = V_ROWSCALE ? 1024 : ROWB4;
constexpr float DN_ALPHA = 1.6817928305074290f;
constexpr float LN_EPS = 1e-6f;
constexpr int NWAVES = 8, NTHREADS = 512;

constexpr size_t MiB = 1u << 20;
constexpr size_t WS_CTL = 0, CTL_ZERO_BYTES = 256 * 1024;
constexpr size_t WS_MOD = 2 * MiB;
constexpr size_t WS_WIN = 4 * MiB;
constexpr size_t WS_WOUT = 80 * MiB;
constexpr size_t WS_WQ = 112 * MiB;
constexpr size_t WS_XL = 144 * MiB;
constexpr size_t WS_HB = 276 * MiB;
constexpr size_t WS_P = 342 * MiB;
constexpr size_t WS_QR = 656 * MiB;
constexpr size_t WS_KR = 720 * MiB;
constexpr size_t WS_ALF = 736 * MiB;
constexpr size_t WS_ALB = 753 * MiB;
constexpr size_t WS_OF = 770 * MiB;
constexpr size_t WS_OB = 803 * MiB;
constexpr size_t WS_MIX = 836 * MiB;
constexpr size_t WS_Y = 902 * MiB;
constexpr size_t WS_QP = 1034 * MiB;
constexpr size_t WS_DELTA = 1166 * MiB;
constexpr size_t WS_DEC = 1233 * MiB;
constexpr size_t WS_SST = 1234 * MiB;
constexpr size_t WS_UB = 1268 * MiB;
constexpr size_t WS_VB = 1524 * MiB;
constexpr size_t WS_EIDX = 1780 * MiB;
constexpr size_t WS_EGATE = 1789 * MiB;
constexpr size_t WS_SUBB = 1798 * MiB;
constexpr size_t WS_USC = 1799 * MiB;
constexpr size_t WS_VSC = 1799 * MiB + 512 * 1024;
constexpr size_t WS_YPART = 1800 * MiB;
constexpr size_t WS_QPART = 1832 * MiB;
constexpr size_t WS_XM = 1864 * MiB;
constexpr size_t WS_END = 1996 * MiB;
constexpr int GLA_ITEMS = (TA / 64) * 4;
static_assert(WS_DELTA + (size_t)GLA_ITEMS * 2 * 8192 * 4 <= WS_DEC && WS_DEC + (size_t)GLA_ITEMS * 2 * 64 * 4 <= WS_SST && WS_SST + (size_t)GLA_ITEMS * 2 * 8192 * 2 <= WS_END, "map");
static_assert(WS_WIN + (size_t)4 * INWP * DM * 2 <= WS_WOUT, "map");
static_assert(WS_P + (size_t)TA * INWP * 2 <= WS_QR, "map");
static_assert(WS_XL + (size_t)TA * DM * 4 <= WS_HB, "map");
constexpr int CW_BAR = 4096;
constexpr int CW_QUEUE = 8192;
constexpr int LDS_BYTES = 163840;
constexpr int MISC_OFF = 163840 - 512;

#define XB_TMO      128
#define XB_XCNT(j)  (256  + 64 * (j))
#define XB_XSUB(j)  (1280 + 64 * (j))
#define XB_XGEN(j)  (2304 + 64 * (j))
#define XB_TOP      3328
#define XB_TOPGEN   3392
#define XCD_BAR_WORDS 3456
#define XB_SPIN_CAP (1u << 18)
__device__ __forceinline__ unsigned xb_ld(unsigned* p)              { return __hip_atomic_load(p, __ATOMIC_RELAXED, __HIP_MEMORY_SCOPE_AGENT); }
__device__ __forceinline__ unsigned xb_add(unsigned* p, unsigned v) { return __hip_atomic_fetch_add(p, v, __ATOMIC_RELAXED, __HIP_MEMORY_SCOPE_AGENT); }
__device__ __forceinline__ unsigned xb_xcc_id() { return (unsigned)__builtin_amdgcn_s_getreg((3 << 11) | 20) & 0xFu; }
#define XB_SPIN(cond, bar) do { unsigned _sp = 0; while (cond) { __builtin_amdgcn_s_sleep(1); \
    if ((++_sp & 255u) == 0u) { if (xb_ld(&(bar)[XB_TMO])) break; if (_sp > XB_SPIN_CAP) { atomicAdd(&(bar)[XB_TMO], 1u); break; } } } } while (0)
struct XcdBarrier { unsigned* bar; unsigned x; volatile LAS unsigned* st; };
__device__ __forceinline__ XcdBarrier xcd_barrier_post(unsigned* bar, volatile LAS unsigned* st) {
    XcdBarrier b; b.bar = bar; b.x = xb_xcc_id(); b.st = st;
    if (threadIdx.x == 0) (void)xb_add(&bar[XB_XCNT(b.x)], 1u);
    return b;
}
__device__ __forceinline__ void xcd_barrier_complete(unsigned* bar, unsigned x, unsigned& nloc, unsigned& nx) {
    const unsigned G = gridDim.x * gridDim.y * gridDim.z;
    unsigned sum, cnt, mine, sp = 0u;
    for (;;) {
        sum = 0u; cnt = 0u; mine = 0u;
#pragma unroll
        for (unsigned j = 0; j < 16; ++j) { const unsigned c = xb_ld(&bar[XB_XCNT(j)]); sum += c; cnt += (c > 0u) ? 1u : 0u; mine = (j == x) ? c : mine; }
        if (sum == G) break;
        __builtin_amdgcn_s_sleep(1);
        if ((++sp & 255u) == 0u) { if (xb_ld(&bar[XB_TMO])) break; if (sp > XB_SPIN_CAP) { atomicAdd(&bar[XB_TMO], 1u); break; } }
    }
    nloc = mine > 0u ? mine : 1u; nx = cnt > 0u ? cnt : 1u;
}
__device__ __forceinline__ void xcd_barrier(const XcdBarrier& b) {
    asm volatile("s_waitcnt vmcnt(0)" ::: "memory");
    __syncthreads();
    if (threadIdx.x == 0) {
        unsigned* bar = b.bar;
        __builtin_amdgcn_s_waitcnt(0);
        unsigned nloc = b.st[0], nx = b.st[1];
        if (nloc == 0u) { xcd_barrier_complete(bar, b.x, nloc, nx); b.st[0] = nloc; b.st[1] = nx; }
        const unsigned old = xb_add(&bar[XB_XSUB(b.x)], 1u);
        const unsigned gen = old / nloc;
        if (old + 1u == (gen + 1u) * nloc) {
            __builtin_amdgcn_fence(__ATOMIC_RELEASE, "agent");
            asm volatile("s_waitcnt vmcnt(0)" ::: "memory");
            const unsigned og = xb_add(&bar[XB_TOP], 1u);
            const unsigned tg = og / nx;
            if (og + 1u == (tg + 1u) * nx) xb_add(&bar[XB_TOPGEN], 1u);
            else XB_SPIN(xb_ld(&bar[XB_TOPGEN]) == tg, bar);
            __builtin_amdgcn_fence(__ATOMIC_ACQUIRE, "agent");
            xb_add(&bar[XB_XGEN(b.x)], 1u);
            asm volatile("s_waitcnt vmcnt(0)" ::: "memory");
        } else {
            XB_SPIN(xb_ld(&bar[XB_XGEN(b.x)]) == gen, bar);
            __builtin_amdgcn_fence(__ATOMIC_ACQUIRE, "agent");
            asm volatile("s_waitcnt vmcnt(0)" ::: "memory");
        }
    }
    __syncthreads();
}

namespace pg8 {
#define PG8_LAS __attribute__((address_space(3)))
typedef unsigned short bf16_t;
typedef short bf16x8 __attribute__((ext_vector_type(8)));
typedef float f32x4 __attribute__((ext_vector_type(4)));
typedef unsigned u32x4 __attribute__((ext_vector_type(4)));
constexpr int BM = 256, BK = 64, HALF = 128, HTB = HALF * BK * 2  , STAGE_BYTES = 8 * HTB, NXCD = 8, WGM = 8;

__host__ __device__ __forceinline__ int lds_byte(int r, int c) { const int st = (r >> 4) * 2 + (c >> 5), rr = r & 15, cc = c & 31, ob = rr * 64 + cc * 2; return st * 1024 + (ob ^ (((ob >> 9) & 1) << 5)); }
__host__ __device__ __forceinline__ void stage_rc(int b, int& R, int& C) { const int st = b / 1024, sb = b % 1024, swz = sb ^ (((sb >> 9) & 1) << 5); R = (st >> 1) * 16 + swz / 64; C = (st & 1) * 32 + (swz % 64) / 2; }
__host__ __device__ __forceinline__ int perm32(int rho) { const int n = rho >> 4, i = rho & 15; return 8 * (i >> 2) + 4 * n + (i & 3); }

struct Unit { int pm, pn, kofs; };
struct Gemm { const bf16_t* A; const bf16_t* Bt; int M, N, K, ld; };

struct StaticOrder {
    int nM, nN, nwg, G, c;
    __host__ __device__ void init(int M, int N, int G_, int c_) { nM = M / BM; nN = N / BM; nwg = nM * nN; G = G_; c = c_; }
    __host__ __device__ bool next(int i, Unit& u) const {
        const long L = (long)i * G + c; if (L >= nwg) return false;
        int wgid = (int)L; { const int q = nwg / NXCD, r = nwg % NXCD, xcd = wgid % NXCD, off = wgid / NXCD; wgid = (xcd < r ? xcd * (q + 1) : r * (q + 1) + (xcd - r) * q) + off; }
        const int nig = WGM * nN, gid = wgid / nig, fm = gid * WGM, gsz = (nM - fm) < WGM ? (nM - fm) : WGM;
        u.pm = fm + ((wgid % nig) % gsz); u.pn = (wgid % nig) / gsz; u.kofs = 0; return true;
    }
    __device__ __forceinline__ void a_ready(const Unit&) const {}
    __device__ __forceinline__ void done(const Unit&) const {}
};

__device__ __forceinline__ unsigned cvt_pk_bf16(float lo, float hi) { unsigned r; asm volatile("v_cvt_pk_bf16_f32 %0, %1, %2" : "=v"(r) : "v"(lo), "v"(hi)); return r; }
typedef float f32x2 __attribute__((ext_vector_type(2)));
__device__ __forceinline__ f32x2 gelu_pk(f32x2 v) {
    const f32x2 av = __builtin_elementwise_abs(v), d = av * 0.2316418882f + 1.0f;
    f32x2 t; t.x = __builtin_amdgcn_rcpf(d.x); t.y = __builtin_amdgcn_rcpf(d.y);
    f32x2 q = t * 0.5307027145f + (-0.7265760135f); q = q * t + 0.7107068705f; q = q * t + (-0.142248368f); q = q * t + 0.127414796f; q = q * t;
    const f32x2 s = (v * v) * (-0.72134752044f);
    f32x2 e; e.x = __builtin_amdgcn_exp2f(s.x); e.y = __builtin_amdgcn_exp2f(s.y);
    const f32x2 m = v * (q * e), r = v - m;
    f32x2 o; o.x = v.x < 0.f ? m.x : r.x; o.y = v.y < 0.f ? m.y : r.y; return o;
}

template <int ACT  > struct EpiBf16 {
    static constexpr bool PERM = true, AFTER_DRAIN = false; static_assert(ACT == 0 || ACT == 1, "EpiBf16: ACT is 0 (none) or 1 (gelu_pk)");
    bf16_t* O; int ldc; const float* bias; int split_cols; size_t split_stride; float scale0;
    __device__ __forceinline__ void operator()(const f32x4 (&acc)[2][2][4][2], const Unit& u, int wr, int wc, int fr, int fq) const {
        const int row0 = u.pm * BM + wr * 64 + fr; int colt = u.pn * BM; bf16_t* base = O;
        float sc = 1.f; if (split_cols) { const int t = colt / split_cols; base += (size_t)t * split_stride; colt -= t * split_cols; if (t == 0) sc = scale0; }
        const int col0 = colt + wc * 32 + 8 * fq, bcol0 = u.pn * BM + wc * 32 + 8 * fq;
        f32x4 bv[2][2];
#pragma unroll
        for (int bj = 0; bj < 2; ++bj)
#pragma unroll
            for (int n = 0; n < 2; ++n) bv[bj][n] = bias ? *(const f32x4*)(bias + bcol0 + bj * HALF + 4 * n) : (f32x4){0.f, 0.f, 0.f, 0.f};
#pragma unroll
        for (int ai = 0; ai < 2; ++ai)
#pragma unroll
            for (int m = 0; m < 4; ++m) { bf16_t* rowp = base + (size_t)(row0 + ai * HALF + m * 16) * ldc + col0;
#pragma unroll
                for (int bj = 0; bj < 2; ++bj) { f32x4 v0 = acc[ai][bj][m][0] + bv[bj][0], v1 = acc[ai][bj][m][1] + bv[bj][1];
                    if (ACT == 1) { f32x2 a = gelu_pk((f32x2){v0[0], v0[1]}), b = gelu_pk((f32x2){v0[2], v0[3]}), c = gelu_pk((f32x2){v1[0], v1[1]}), d = gelu_pk((f32x2){v1[2], v1[3]});
                        v0 = (f32x4){a.x, a.y, b.x, b.y}; v1 = (f32x4){c.x, c.y, d.x, d.y}; }
                    v0 = v0 * sc; v1 = v1 * sc; u32x4 w; w.x = cvt_pk_bf16(v0[0], v0[1]); w.y = cvt_pk_bf16(v0[2], v0[3]); w.z = cvt_pk_bf16(v1[0], v1[1]); w.w = cvt_pk_bf16(v1[2], v1[3]);
                    *(u32x4*)(rowp + bj * HALF) = w; } }
    }
};


struct EpiF32 {
    static constexpr bool PERM = false, AFTER_DRAIN = false;
    float* C; int ldc; const float* bias;
    __device__ __forceinline__ void operator()(const f32x4 (&acc)[2][2][4][2], const Unit& u, int wr, int wc, int fr, int fq) const {
        const int row0 = u.pm * BM + wr * 64 + fr, col0 = u.pn * BM + wc * 32 + 4 * fq;
        f32x4 bv[2][2];
#pragma unroll
        for (int bj = 0; bj < 2; ++bj)
#pragma unroll
            for (int n = 0; n < 2; ++n) bv[bj][n] = bias ? *(const f32x4*)(bias + col0 + bj * HALF + n * 16) : (f32x4){0.f, 0.f, 0.f, 0.f};
#pragma unroll
        for (int ai = 0; ai < 2; ++ai)
#pragma unroll
            for (int m = 0; m < 4; ++m) { float* rowp = C + (size_t)(row0 + ai * HALF + m * 16) * ldc + col0;
#pragma unroll
                for (int bj = 0; bj < 2; ++bj)
#pragma unroll
                    for (int n = 0; n < 2; ++n) *(f32x4*)(rowp + bj * HALF + n * 16) = acc[ai][bj][m][n] + bv[bj][n]; }
    }
};

template <class Epi, class Sched, bool ALIGN_EPI = false, bool SP2 = false>
__device__ __forceinline__ void gemm_phase(PG8_LAS unsigned char* lds, const Gemm g, const Sched& S, const Epi& E) {
    int tid_l = threadIdx.x; asm volatile("" : "+v"(tid_l));
    const int tid = tid_l, wid = __builtin_amdgcn_readfirstlane(tid >> 6), lane = tid & 63, wr = wid >> 2, wc = wid & 3, fr = lane & 15, fq = lane >> 4;
    const int K = g.K, nt = K / BK;
    unsigned voffA[2], voffB[2];
#pragma unroll
    for (int i = 0; i < 2; ++i) { int R, C; stage_rc(tid * 16 + i * 8192, R, C); const int Rb = Epi::PERM ? ((R & ~31) + perm32(R & 31)) : R;
        voffA[i] = (unsigned)(R * g.ld + C) * 2u; voffB[i] = (unsigned)(Rb * g.ld + C) * 2u; }
    const size_t kstep = (size_t)(BK * 2);
    const size_t hstep = (size_t)HALF * g.ld * 2;
    const size_t tstep = 2 * hstep;
    const unsigned ldsw = (unsigned)wid * 1024u;
    const int aoff = lds_byte(wr * 64 + fr, fq * 8), boff = lds_byte(wc * 32 + fr, fq * 8);
#define PG8_SA(b, h) (((b) * 2 + (h)) * HTB)
#define PG8_SB(b, h) ((4 + (b) * 2 + (h)) * HTB)
#define PG8_STAGE(bufoff, gbase, voff) do { _Pragma("unroll") for (int _i = 0; _i < 2; ++_i) \
        __builtin_amdgcn_global_load_lds((const unsigned*)((const char*)(gbase) + (voff)[_i]), (PG8_LAS unsigned*)(lds + (bufoff) + ldsw + _i * 8192), 16, 0, 0); } while (0)
#define PG8_LDA(dst, b, h) do { _Pragma("unroll") for (int m = 0; m < 4; ++m) _Pragma("unroll") for (int k = 0; k < 2; ++k) dst[m][k] = *(const PG8_LAS bf16x8*)(lds + PG8_SA(b, h) + aoff + m * 2048 + k * 1024); } while (0)
#define PG8_LDB(dst, b, h) do { _Pragma("unroll") for (int n = 0; n < 2; ++n) _Pragma("unroll") for (int k = 0; k < 2; ++k) dst[n][k] = *(const PG8_LAS bf16x8*)(lds + PG8_SB(b, h) + boff + n * 2048 + k * 1024); } while (0)
#define PG8_MMA(ai, bj, At, Bt) do { __builtin_amdgcn_s_setprio(1); _Pragma("unroll") for (int m = 0; m < 4; ++m) _Pragma("unroll") for (int n = 0; n < 2; ++n) _Pragma("unroll") for (int k = 0; k < 2; ++k) \
        acc[ai][bj][m][n] = __builtin_amdgcn_mfma_f32_16x16x32_bf16(Bt[n][k], At[m][k], acc[ai][bj][m][n], 0, 0, 0); __builtin_amdgcn_s_setprio(0); } while (0)
#define PG8_WAIT_V(n) asm volatile("s_waitcnt vmcnt(" #n ")" ::: "memory")
#define PG8_WAIT_L(n) asm volatile("s_waitcnt lgkmcnt(" #n ")" ::: "memory")
#define PG8_BAR __builtin_amdgcn_s_barrier()
#define PG8_SCHED __builtin_amdgcn_sched_barrier(0)
    Unit cur, nxt; int ui = 0;
    if (!S.next(0, cur)) return;
    f32x4 acc[2][2][4][2];
#pragma unroll
    for (int a = 0; a < 2; ++a)
#pragma unroll
        for (int b = 0; b < 2; ++b)
#pragma unroll
            for (int m = 0; m < 4; ++m)
#pragma unroll
                for (int n = 0; n < 2; ++n) acc[a][b][m][n] = (f32x4){0.f, 0.f, 0.f, 0.f};
    bf16x8 At[4][2], B0[2][2], B1[2][2];
    const char* cA = (const char*)g.A + (size_t)cur.pm * tstep + (size_t)cur.kofs * 2; const char* cB = (const char*)g.Bt + (size_t)cur.pn * tstep + (size_t)cur.kofs * 2;
    S.a_ready(cur);
    if constexpr (SP2) {
        PG8_STAGE(PG8_SB(0, 0), cB, voffB); PG8_STAGE(PG8_SB(0, 1), cB + hstep, voffB); PG8_STAGE(PG8_SA(0, 0), cA, voffA); PG8_STAGE(PG8_SA(0, 1), cA + hstep, voffA);
        if (wr == 1) PG8_BAR;
        PG8_WAIT_V(2); PG8_BAR;
        PG8_STAGE(PG8_SB(1, 0), cB + kstep, voffB); PG8_STAGE(PG8_SA(1, 0), cA + kstep, voffA); PG8_STAGE(PG8_SB(1, 1), cB + hstep + kstep, voffB);
        PG8_WAIT_V(6); PG8_BAR;
    } else {
        PG8_STAGE(PG8_SB(0, 0), cB, voffB); PG8_STAGE(PG8_SA(0, 0), cA, voffA); PG8_STAGE(PG8_SB(0, 1), cB + hstep, voffB); PG8_STAGE(PG8_SA(0, 1), cA + hstep, voffA);
        if (wr == 1) PG8_BAR;
        PG8_WAIT_V(4); PG8_BAR;
        PG8_STAGE(PG8_SB(1, 0), cB + kstep, voffB); PG8_STAGE(PG8_SA(1, 0), cA + kstep, voffA); PG8_STAGE(PG8_SB(1, 1), cB + hstep + kstep, voffB);
        PG8_WAIT_V(6); PG8_BAR;
    }
    for (;;) {
        const bool has_next = S.next(ui + 1, nxt);
        const char* nA = has_next ? (const char*)g.A + (size_t)nxt.pm * tstep + (size_t)nxt.kofs * 2 : cA; const char* nB = has_next ? (const char*)g.Bt + (size_t)nxt.pn * tstep + (size_t)nxt.kofs * 2 : cB;
        for (int t = 0; t < nt; t += 2) {
            const bool last = (t == nt - 2);
            const char* a1 = cA + (size_t)(t + 1) * kstep;
            const char* a2 = last ? nA : cA + (size_t)(t + 2) * kstep; const char* b2 = last ? nB : cB + (size_t)(t + 2) * kstep;
            const char* a3 = a2 + kstep; const char* b3 = b2 + kstep;
            if (last && has_next) S.a_ready(nxt);
            if constexpr (SP2) {
            PG8_LDB(B0, 0, 0); PG8_LDB(B1, 0, 1); PG8_SCHED; PG8_LDA(At, 0, 0); PG8_STAGE(PG8_SA(1, 1), a1 + hstep, voffA);
            PG8_WAIT_V(8); PG8_WAIT_L(0); PG8_BAR; PG8_MMA(0, 0, At, B0); PG8_MMA(0, 1, At, B1); PG8_BAR; PG8_SCHED;
            PG8_LDA(At, 0, 1); PG8_STAGE(PG8_SB(0, 0), b2, voffB); PG8_STAGE(PG8_SB(0, 1), b2 + hstep, voffB); PG8_STAGE(PG8_SA(0, 0), a2, voffA);
            PG8_WAIT_V(8); PG8_WAIT_L(0); PG8_BAR; PG8_MMA(1, 0, At, B0); PG8_MMA(1, 1, At, B1); PG8_BAR; PG8_SCHED;
            PG8_LDB(B0, 1, 0); PG8_LDB(B1, 1, 1); PG8_SCHED; PG8_LDA(At, 1, 0); PG8_STAGE(PG8_SA(0, 1), a2 + hstep, voffA);
            PG8_WAIT_V(8); PG8_WAIT_L(0); PG8_BAR; PG8_MMA(0, 0, At, B0); PG8_MMA(0, 1, At, B1); PG8_BAR; PG8_SCHED;
            PG8_LDA(At, 1, 1); PG8_STAGE(PG8_SB(1, 0), b3, voffB); PG8_STAGE(PG8_SB(1, 1), b3 + hstep, voffB); PG8_STAGE(PG8_SA(1, 0), a3, voffA);
            PG8_WAIT_V(8); PG8_WAIT_L(0); PG8_BAR; PG8_MMA(1, 0, At, B0); PG8_MMA(1, 1, At, B1); PG8_BAR; PG8_SCHED;
            } else {
            PG8_LDB(B0, 0, 0); PG8_SCHED; PG8_LDA(At, 0, 0); PG8_STAGE(PG8_SA(1, 1), a1 + hstep, voffA);
            PG8_WAIT_L(8); PG8_BAR; PG8_WAIT_L(0); PG8_MMA(0, 0, At, B0); PG8_BAR; PG8_SCHED;
            PG8_LDB(B1, 0, 1); PG8_STAGE(PG8_SB(0, 0), b2, voffB);
            PG8_BAR; PG8_WAIT_L(0); PG8_MMA(0, 1, At, B1); PG8_BAR;
            PG8_LDA(At, 0, 1); PG8_STAGE(PG8_SA(0, 0), a2, voffA);
            PG8_BAR; PG8_WAIT_L(0); PG8_MMA(1, 0, At, B0); PG8_BAR; PG8_SCHED;
            PG8_STAGE(PG8_SB(0, 1), b2 + hstep, voffB);
            PG8_WAIT_V(6); PG8_BAR; PG8_MMA(1, 1, At, B1); PG8_BAR;
            PG8_LDB(B0, 1, 0); PG8_SCHED; PG8_LDA(At, 1, 0); PG8_STAGE(PG8_SA(0, 1), a2 + hstep, voffA);
            PG8_WAIT_L(8); PG8_BAR; PG8_WAIT_L(0); PG8_MMA(0, 0, At, B0); PG8_BAR; PG8_SCHED;
            PG8_LDB(B1, 1, 1); PG8_STAGE(PG8_SB(1, 0), b3, voffB);
            PG8_BAR; PG8_WAIT_L(0); PG8_MMA(0, 1, At, B1); PG8_BAR;
            PG8_LDA(At, 1, 1); PG8_STAGE(PG8_SA(1, 0), a3, voffA);
            PG8_BAR; PG8_WAIT_L(0); PG8_MMA(1, 0, At, B0); PG8_BAR; PG8_SCHED;
            PG8_STAGE(PG8_SB(1, 1), b3 + hstep, voffB);
            PG8_WAIT_V(6); PG8_BAR; PG8_MMA(1, 1, At, B1); PG8_BAR;
            }
        }
        if constexpr (ALIGN_EPI) { if (wr == 0) PG8_BAR; }
        if constexpr (!Epi::AFTER_DRAIN) { E(acc, cur, wr, wc, fr, fq); S.done(cur); }
        if (!has_next) break;
#pragma unroll
        for (int a = 0; a < 2; ++a)
#pragma unroll
            for (int b = 0; b < 2; ++b)
#pragma unroll
                for (int m = 0; m < 4; ++m)
#pragma unroll
                    for (int n = 0; n < 2; ++n) acc[a][b][m][n] = (f32x4){0.f, 0.f, 0.f, 0.f};
        cur = nxt; cA = nA; cB = nB; ++ui;
        if constexpr (ALIGN_EPI) { if (wr == 1) PG8_BAR; }
    }
    PG8_WAIT_V(0);
    if constexpr (!ALIGN_EPI) { if (wr == 0) PG8_BAR; }
    PG8_BAR;
    if constexpr (Epi::AFTER_DRAIN) { E.fused(acc, cur, wr, wc, fr, fq, lds, wid, lane); S.done(cur); }
#undef PG8_SA
#undef PG8_SB
#undef PG8_STAGE
#undef PG8_LDA
#undef PG8_LDB
#undef PG8_MMA
#undef PG8_WAIT_V
#undef PG8_WAIT_L
#undef PG8_BAR
#undef PG8_SCHED
}
}
namespace pg8 {
struct SplitKOrder {
    int G, c;
    __host__ __device__ void init(int G_, int c_) { G = G_; c = c_; }
    __host__ __device__ bool next(int i, Unit& u) const { const long L = (long)i * G + c; if (L >= 128) return false; const int ks = (int)L >> 4, r = (int)L & 15; u.pm = r >> 3; u.pn = r & 7; u.kofs = ks * 256; return true; }
    __device__ __forceinline__ void a_ready(const Unit&) const {}
    __device__ __forceinline__ void done(const Unit&) const {}
};
struct EpiF32Part {
    static constexpr bool PERM = false, AFTER_DRAIN = false;
    float* C;
    __device__ __forceinline__ void operator()(const f32x4 (&acc)[2][2][4][2], const Unit& u, int wr, int wc, int fr, int fq) const {
        const int row0 = u.pm * BM + wr * 64 + fr, col0 = u.pn * BM + wc * 32 + 4 * fq; float* base = C + (size_t)(u.kofs >> 8) * 512 * 2048;
#pragma unroll
        for (int ai = 0; ai < 2; ++ai)
#pragma unroll
            for (int m = 0; m < 4; ++m) { float* rowp = base + (size_t)(row0 + ai * HALF + m * 16) * 2048 + col0;
#pragma unroll
                for (int bj = 0; bj < 2; ++bj)
#pragma unroll
                    for (int n = 0; n < 2; ++n) *(f32x4*)(rowp + bj * HALF + n * 16) = acc[ai][bj][m][n]; }
    }
};
}
#define PG8_SP2 true
#define PG8_ALIGN true

#define LDS_FENCE() asm volatile("s_waitcnt lgkmcnt(0)" ::: "memory")
__device__ __forceinline__ unsigned f2bf(float f) { unsigned u = __builtin_bit_cast(unsigned, f); return (u + 0x7fffu + ((u >> 16) & 1u)) >> 16; }
__device__ __forceinline__ unsigned pk2(float lo, float hi) { return f2bf(lo) | (f2bf(hi) << 16); }
template <int CTRL> __device__ __forceinline__ float dppm(float x) { return __builtin_bit_cast(float, __builtin_amdgcn_mov_dpp(__builtin_bit_cast(int, x), CTRL, 0xf, 0xf, true)); }
__device__ __forceinline__ float row16_sum(float v) { v += dppm<0xB1>(v); v += dppm<0x4E>(v); v += dppm<0x141>(v); v += dppm<0x140>(v); return v; }
__device__ __forceinline__ float row16_maxf(float v) { v = fmaxf(v, dppm<0xB1>(v)); v = fmaxf(v, dppm<0x4E>(v)); v = fmaxf(v, dppm<0x141>(v)); v = fmaxf(v, dppm<0x140>(v)); return v; }
__device__ __forceinline__ float wave_sum(float v) {
    v = row16_sum(v);
    float a = v, b = v; asm volatile("s_nop 1\n\tv_permlane16_swap_b32 %0, %1" : "+v"(a), "+v"(b)); v = a + b;
    a = v; b = v; asm volatile("s_nop 1\n\tv_permlane32_swap_b32 %0, %1" : "+v"(a), "+v"(b)); return a + b;
}
__device__ __forceinline__ float wave_max(float v) {
    v = row16_maxf(v);
    float a = v, b = v; asm volatile("s_nop 1\n\tv_permlane16_swap_b32 %0, %1" : "+v"(a), "+v"(b)); v = fmaxf(a, b);
    a = v; b = v; asm volatile("s_nop 1\n\tv_permlane32_swap_b32 %0, %1" : "+v"(a), "+v"(b)); return fmaxf(a, b);
}
__device__ __forceinline__ float silu_f(float x) { return x / (1.0f + __expf(-x)); }
__device__ __forceinline__ float gelu_f(float v) {
    const float t = __builtin_amdgcn_rcpf(fabsf(v) * 0.2316418882f + 1.0f);
    float q = t * 0.5307027145f + (-0.7265760135f); q = q * t + 0.7107068705f; q = q * t + (-0.142248368f); q = q * t + 0.127414796f; q = q * t;
    const float m = v * (q * __builtin_amdgcn_exp2f(v * v * (-0.72134752044f)));
    return v < 0.f ? m : v - m;
}
__device__ __forceinline__ float log_sigmoid_f(float z) { return fminf(z, 0.0f) - __logf(1.0f + __expf(-fabsf(z))); }


__device__ __forceinline__ float bflo(unsigned w) { return __builtin_bit_cast(float, w << 16); }
__device__ __forceinline__ float bfhi(unsigned w) { return __builtin_bit_cast(float, w & 0xffff0000u); }
__device__ __forceinline__ void unpack8(const u32x4 w, float (&f)[8]) { f[0] = bflo(w.x); f[1] = bfhi(w.x); f[2] = bflo(w.y); f[3] = bfhi(w.y); f[4] = bflo(w.z); f[5] = bfhi(w.z); f[6] = bflo(w.w); f[7] = bfhi(w.w); }
__device__ __forceinline__ u32x4 pack8(const float (&f)[8]) { u32x4 o; o.x = pk2(f[0], f[1]); o.y = pk2(f[2], f[3]); o.z = pk2(f[4], f[5]); o.w = pk2(f[6], f[7]); return o; }


__device__ __forceinline__ u32x6 pack_fp6_2x16(const f32x16 a, const f32x16 b) { u32x6 r; asm("v_cvt_scalef32_2xpk16_fp6_f32 %0, %1, %2, 1.0" : "=&v"(r) : "v"(a), "v"(b)); return r; }
__device__ __forceinline__ f32x32 unpack_fp6_32(const u32x6 w) { f32x32 r; asm volatile("v_cvt_scalef32_pk32_f32_fp6 %0, %1, 1.0" : "=&v"(r) : "v"(w)); return r; }

struct Params {
    const float* in[19];
    float* out;
    unsigned char* ws;
    int ph_lo, ph_hi;
};
enum { I_X = 0, I_C, I_CTX, I_CCTX, I_WADA, I_BADA, I_WIN, I_CONVW, I_GW2, I_GB2, I_GNORM, I_SINK, I_WOUT, I_LNG, I_LNB, I_PWQ, I_PSUB, I_PU, I_PV };

__device__ __forceinline__ int row_stream(int r) { return r < TL ? r / SEQ : 2; }

__device__ __forceinline__ void transpose_item(const float* W, int K, int N, bf16_t* WT, LAS float* scr, int item, int lane) {
    const int nblk = N / 32, kb = item / nblk, nb = item % nblk, k0 = 64 * kb, n0 = 32 * nb;
#pragma unroll 8
    for (int i = 0; i < 32; ++i) { const int kk = 2 * i + (lane >> 5); scr[kk * 33 + (lane & 31)] = W[(size_t)(k0 + kk) * N + n0 + (lane & 31)]; }
    LDS_FENCE();
    const int c = lane & 7;
#pragma unroll
    for (int j = 0; j < 4; ++j) { const int n = (lane >> 3) + 8 * j; const LAS float* s = scr + (8 * c) * 33 + n;
        u32x4 o; o.x = pk2(s[0 * 33], s[1 * 33]); o.y = pk2(s[2 * 33], s[3 * 33]); o.z = pk2(s[4 * 33], s[5 * 33]); o.w = pk2(s[6 * 33], s[7 * 33]);
        *(u32x4*)(WT + (size_t)(n0 + n) * K + k0 + 8 * c) = o; }
    LDS_FENCE();
}

__device__ __forceinline__ void phase_prologue(const Params& p, LAS unsigned char* lds, int tid, int lane, int wave, int bid, int G) {
    const int gw = bid * NWAVES + wave, NGW = G * NWAVES;
    LAS float* scr = (LAS float*)(lds + wave * 16384);
    bf16_t* WIN = (bf16_t*)(p.ws + WS_WIN); bf16_t* WOUT = (bf16_t*)(p.ws + WS_WOUT); bf16_t* WQ = (bf16_t*)(p.ws + WS_WQ);
    constexpr int IT_IN = (DM / 64) * (INW / 32), IT_SQ = (DM / 64) * (DM / 32), IT_L = IT_IN + 2 * IT_SQ;
    for (int it = gw; it < DEPTH * IT_L; it += NGW) {
        const int l = it / IT_L; int r = it % IT_L;
        if (r < IT_IN) { transpose_item(p.in[I_WIN] + (size_t)l * DM * INW, DM, INW, WIN + (size_t)l * INWP * DM, scr, r, lane); continue; } r -= IT_IN;
        if (r < IT_SQ) { transpose_item(p.in[I_WOUT] + (size_t)l * DM * DM, DM, DM, WOUT + (size_t)l * DM * DM, scr, r, lane); continue; } r -= IT_SQ;
        transpose_item(p.in[I_PWQ] + (size_t)l * DM * DM, DM, DM, WQ + (size_t)l * DM * DM, scr, r, lane);
    }
    {
        constexpr int PADV = (INWP - INW) * DM / 8;
        const int gt = bid * NTHREADS + tid, NGT = G * NTHREADS;
        for (int i = gt; i < DEPTH * PADV; i += NGT) { const int l = i / PADV, o = i % PADV;
            *(u32x4*)(WIN + (size_t)l * INWP * DM + (size_t)INW * DM + (size_t)o * 8) = (u32x4){0u, 0u, 0u, 0u}; }
    }
    {
        const float* U = p.in[I_PU]; const float* V = p.in[I_PV];
        unsigned char* UB = p.ws + WS_UB; unsigned char* VB = p.ws + WS_VB; float* USC = (float*)(p.ws + WS_USC); (void)USC; float* VSC = (float*)(p.ws + WS_VSC); (void)VSC;
        for (size_t row = gw; row < (size_t)DEPTH * NEXP; row += NGW) {
            f32x4 xx[2][8];
#pragma unroll
            for (int tb = 0; tb < 2; ++tb)
#pragma unroll
                for (int j = 0; j < 8; ++j) xx[tb][j] = *(const f32x4*)((tb ? V : U) + row * DM + lane * 32 + 4 * j);
#pragma unroll
            for (int tb = 0; tb < 2; ++tb) {
                f32x4 x[8]; float am = 0.f;
#pragma unroll
                for (int j = 0; j < 8; ++j) { x[j] = xx[tb][j]; am = fmaxf(am, fmaxf(fmaxf(fabsf(x[j].x), fabsf(x[j].y)), fmaxf(fabsf(x[j].z), fabsf(x[j].w)))); }
                if (tb == 0 && TBL_U_I4) {
#if U_ROWSCALE
                    unsigned char* dst = UB + row * ROWB_U;
                    float ssq = 0.f;
#pragma unroll
                    for (int j = 0; j < 8; ++j) ssq += (x[j].x * x[j].x + x[j].y * x[j].y) + (x[j].z * x[j].z + x[j].w * x[j].w);
                    const float amr = wave_max(am), rms = sqrtf(wave_sum(ssq) * (1.0f / DM));
                    const float srow = amr > 0.f ? fminf(amr * (1.0f / 7.0f), 0.36f * rms) : 1.0f; const float inv = 1.0f / srow; const int code = 0; (void)code;
                    if (lane == 0) USC[row] = srow;
#else
                    unsigned char* dst = UB + row * ROWB4;
                    const float sb = am * (1.0f / 7.0f); const unsigned ub = (__builtin_bit_cast(unsigned, sb) + 0x000fffffu) & 0xfff00000u;
                    int code = ((int)ub - (int)I4_BASE) >> 20; code = code < 0 ? 0 : (code > 255 ? 255 : code);
                    const float inv = 1.0f / __builtin_bit_cast(float, ((unsigned)code << 20) + I4_BASE);
#endif
                    u32x4 w;
#pragma unroll
                    for (int d = 0; d < 4; ++d) { unsigned t = 0u;
#pragma unroll
                        for (int e = 0; e < 8; ++e) { const float xv = (e < 4 ? x[2 * d] : x[2 * d + 1])[e & 3];
                            int q = (int)__builtin_rintf(xv * inv); q = q < -7 ? -7 : (q > 7 ? 7 : q); t |= ((unsigned)q & 15u) << (4 * e); }
                        w[d] = t; }
                    *(u32x4*)(dst + lane * 16) = w;
#if !U_ROWSCALE
                    dst[1024 + lane] = (unsigned char)code;
#endif
                } else if (tb == 1 && V_ROWSCALE) {
                    unsigned char* dst = VB + row * ROWB_V;
                    float ssq = 0.f;
#pragma unroll
                    for (int j = 0; j < 8; ++j) ssq += (x[j].x * x[j].x + x[j].y * x[j].y) + (x[j].z * x[j].z + x[j].w * x[j].w);
                    const float amr = wave_max(am), rms = sqrtf(wave_sum(ssq) * (1.0f / DM));
                    const float srow = amr > 0.f ? fminf(amr * (1.0f / 6.0f), (2.8f / 6.0f) * rms) : 1.0f; const float inv = 1.0f / srow;
                    if (lane == 0) VSC[row] = srow;
                    u32x4 w;
#pragma unroll
                    for (int d = 0; d < 4; ++d) { unsigned t = 0u;
                        t = __builtin_amdgcn_cvt_scalef32_pk_fp4_f32(t, x[2 * d].x * inv, x[2 * d].y * inv, 1.0f, 0); t = __builtin_amdgcn_cvt_scalef32_pk_fp4_f32(t, x[2 * d].z * inv, x[2 * d].w * inv, 1.0f, 1);
                        t = __builtin_amdgcn_cvt_scalef32_pk_fp4_f32(t, x[2 * d + 1].x * inv, x[2 * d + 1].y * inv, 1.0f, 2); t = __builtin_amdgcn_cvt_scalef32_pk_fp4_f32(t, x[2 * d + 1].z * inv, x[2 * d + 1].w * inv, 1.0f, 3);
                        w[d] = t; }
                    *(u32x4*)(dst + lane * 16) = w;
                } else if (tb == 1 || TBL_U_FP4) {
                    unsigned char* dst = (tb ? VB : UB) + row * ROWB4;
                    const float sb = am * (1.0f / 6.0f); unsigned ub = __builtin_bit_cast(unsigned, sb); ub = (ub & 0x007fffffu) ? ((ub & 0x7f800000u) + 0x00800000u) : (ub & 0x7f800000u);
                    if (!(am > 0.f) || ub < 0x00800000u) ub = 0x00800000u;
                    const float scl = __builtin_bit_cast(float, ub);
                    u32x4 w;
#pragma unroll
                    for (int d = 0; d < 4; ++d) { unsigned t = 0u;
                        t = __builtin_amdgcn_cvt_scalef32_pk_fp4_f32(t, x[2 * d].x, x[2 * d].y, scl, 0); t = __builtin_amdgcn_cvt_scalef32_pk_fp4_f32(t, x[2 * d].z, x[2 * d].w, scl, 1);
                        t = __builtin_amdgcn_cvt_scalef32_pk_fp4_f32(t, x[2 * d + 1].x, x[2 * d + 1].y, scl, 2); t = __builtin_amdgcn_cvt_scalef32_pk_fp4_f32(t, x[2 * d + 1].z, x[2 * d + 1].w, scl, 3);
                        w[d] = t; }
                    *(u32x4*)(dst + lane * 16) = w; dst[1024 + lane] = (unsigned char)(ub >> 23);
                } else {
                    unsigned char* dst = UB + row * ROWB;
                    am = wave_max(am);
                    const float inv = am > 0.f ? 7.0f / am : 0.f;
                    f32x16 x0, x1;
#pragma unroll
                    for (int j = 0; j < 4; ++j) { x0[4 * j + 0] = x[j].x * inv; x0[4 * j + 1] = x[j].y * inv; x0[4 * j + 2] = x[j].z * inv; x0[4 * j + 3] = x[j].w * inv;
                        x1[4 * j + 0] = x[4 + j].x * inv; x1[4 * j + 1] = x[4 + j].y * inv; x1[4 * j + 2] = x[4 + j].z * inv; x1[4 * j + 3] = x[4 + j].w * inv; }
                    const u32x6 w = pack_fp6_2x16(x0, x1);
                    *(u32x4*)(dst + lane * 16) = (u32x4){w[0], w[1], w[2], w[3]}; *(u32x2*)(dst + 1024 + lane * 8) = (u32x2){w[4], w[5]};
                    if (lane == 0) USC[row] = am * (1.0f / 7.0f);
                }
            }
        }
        const size_t gt = (size_t)bid * NTHREADS + tid, NGT = (size_t)G * NTHREADS;
        const float* SUB = p.in[I_PSUB]; bf16_t* SUBB = (bf16_t*)(p.ws + WS_SUBB);
        for (size_t i = gt; i < (size_t)DEPTH * 2 * 128 * 128 / 2; i += NGT) ((unsigned*)SUBB)[i] = pk2(SUB[2 * i], SUB[2 * i + 1]);
    }
    __syncthreads();
    LAS float* sc = (LAS float*)lds;
    LAS float* red = (LAS float*)(lds + 32768);
    for (int i = tid; i < 3 * DM; i += NTHREADS) { const int s = i / DM, k = i % DM; const float v = s < 2 ? p.in[I_C][s * DM + k] : p.in[I_CCTX][k]; sc[i] = silu_f(v); }
    __syncthreads();
    float* MOD = (float*)(p.ws + WS_MOD);
    LAS float* red2 = (LAS float*)(lds + 32768);
    constexpr int NCH = 6 * DM / 256;
    for (int it = bid; it < DEPTH * NCH; it += G) {
        const int l = it / NCH, n0 = (it % NCH) * 256;
        const float* wp = p.in[I_WADA] + (size_t)l * DM * 6 * DM + n0 + lane * 4;
        f32x4 a0 = (f32x4){0.f, 0.f, 0.f, 0.f}, a1 = a0, a2 = a0;
        const int kb = wave * (DM / NWAVES);
#pragma unroll 16
        for (int k = kb; k < kb + DM / NWAVES; ++k) { const f32x4 w = *(const f32x4*)(wp + (size_t)k * 6 * DM); a0 += w * sc[k]; a1 += w * sc[DM + k]; a2 += w * sc[2 * DM + k]; }
        *(LAS f32x4*)(red2 + (wave * 3 + 0) * 256 + lane * 4) = a0; *(LAS f32x4*)(red2 + (wave * 3 + 1) * 256 + lane * 4) = a1; *(LAS f32x4*)(red2 + (wave * 3 + 2) * 256 + lane * 4) = a2;
        __syncthreads();
        for (int i = tid; i < 768; i += NTHREADS) { const int st = i >> 8, c = i & 255; float v = 0.f;
#pragma unroll
            for (int w = 0; w < NWAVES; ++w) v += red2[(w * 3 + st) * 256 + c];
            MOD[((size_t)l * 3 + st) * 6 * DM + n0 + c] = v + p.in[I_BADA][(size_t)l * 6 * DM + n0 + c]; }
        __syncthreads();
    }
}


__device__ __forceinline__ int row_first(int wave, int bid, int G) { const int gw = bid * NWAVES + wave; return gw < TL ? gw : -1; }
__device__ __forceinline__ int row_next(int r, int wave, int bid, int G, int nrows) {
    const int NGW = G * NWAVES;
    if (r < TL) { if (r + NGW < TL) return r + NGW; const int c = TL + wave * G + bid; return c < nrows ? c : -1; }
    return r + NGW < nrows ? r + NGW : -1;
}
__device__ __forceinline__ const float* xsrc(const Params& p, int l, int r) {
    return r < TL ? p.in[I_X] + (size_t)r * DM : p.in[I_CTX] + (size_t)(r - TL) * DM;
}

__device__ __forceinline__ void modulate_row(const float* xr, const float* mod, int sh_off, int sc_off, bf16_t* hb, int lane) {
    f32x4 xx[8];
#pragma unroll
    for (int j = 0; j < 8; ++j) xx[j] = *(const f32x4*)(xr + lane * 4 + 256 * j);
#pragma unroll
    for (int j = 0; j < 8; ++j) { const int c = lane * 4 + 256 * j;
        const f32x4 x = xx[j], sh = *(const f32x4*)(mod + sh_off + c), s = *(const f32x4*)(mod + sc_off + c);
        u32x2 o; o.x = pk2(x.x * (1.f + s.x) + sh.x, x.y * (1.f + s.y) + sh.y); o.y = pk2(x.z * (1.f + s.z) + sh.z, x.w * (1.f + s.w) + sh.w);
        *(u32x2*)(hb + c) = o; }
}
__device__ __forceinline__ void phase_modulate0(const Params& p, int lane, int wave, int bid, int G) {
    const int gw = bid * NWAVES + wave, NGW = G * NWAVES;
    const float* MOD = (const float*)(p.ws + WS_MOD); bf16_t* HB = (bf16_t*)(p.ws + WS_HB);
    for (int r = row_first(wave, bid, G); r >= 0; r = row_next(r, wave, bid, G, TA)) modulate_row(xsrc(p, 0, r), MOD + (size_t)(0 * 3 + row_stream(r)) * 6 * DM, 0, DM, HB + (size_t)r * DM, lane);
}

__device__ __forceinline__ void gemm_direct(const bf16_t* A, const bf16_t* Bt, float* C, int M, int N, int K, int ldc, int gw, int NGW, int lane) {
    const int nTn = N / 64, nItems = (M / 32) * nTn;
    const int fr = lane & 15, fq = lane >> 4;
    for (int it = gw; it < nItems; it += NGW) {
        const int mt = it / nTn, nt = it % nTn;
        const bf16_t* a0 = A + (size_t)(mt * 32 + fr) * K + fq * 8;
        const bf16_t* b0 = Bt + (size_t)(nt * 64 + fr) * K + fq * 8;
        f32x4 acc[2][4];
#pragma unroll
        for (int i = 0; i < 2; ++i)
#pragma unroll
            for (int j = 0; j < 4; ++j) acc[i][j] = (f32x4){0.f, 0.f, 0.f, 0.f};
#pragma unroll 2
        for (int k0 = 0; k0 < K; k0 += 32) {
            bf16x8 af[2], bfr[4];
#pragma unroll
            for (int i = 0; i < 2; ++i) af[i] = *(const bf16x8*)(a0 + (size_t)i * 16 * K + k0);
#pragma unroll
            for (int j = 0; j < 4; ++j) bfr[j] = *(const bf16x8*)(b0 + (size_t)j * 16 * K + k0);
#pragma unroll
            for (int i = 0; i < 2; ++i)
#pragma unroll
                for (int j = 0; j < 4; ++j) acc[i][j] = __builtin_amdgcn_mfma_f32_16x16x32_bf16(af[i], bfr[j], acc[i][j], 0, 0, 0);
        }
#pragma unroll
        for (int i = 0; i < 2; ++i)
#pragma unroll
            for (int j = 0; j < 4; ++j)
#pragma unroll
                for (int g = 0; g < 4; ++g) C[(size_t)(mt * 32 + i * 16 + fq * 4 + g) * ldc + nt * 64 + j * 16 + fr] = acc[i][j][g];
    }
}

__device__ __forceinline__ void phase_post_in(const Params& p, int l, int lane, int wave, int bid, int G) {
    const int gw = bid * NWAVES + wave, NGW = G * NWAVES;
    const bf16_t* P = (const bf16_t*)(p.ws + WS_P);
    bf16_t* QR = (bf16_t*)(p.ws + WS_QR); bf16_t* KR = (bf16_t*)(p.ws + WS_KR); bf16_t* VR = (bf16_t*)(p.ws + WS_ALF);
    bf16_t* MIX = (bf16_t*)(p.ws + WS_MIX);
    const float* cw = p.in[I_CONVW] + (size_t)l * 3 * 512;
    const int c8 = lane * 8, rh = lane >> 3, rf = (lane >> 2) & 1, rg = lane & 3, roff = rh * 128 + rf * 64 + rg * 8;
    float w0[8], w1[8], w2[8], invf[8];
#pragma unroll
    for (int e = 0; e < 8; ++e) { w0[e] = cw[c8 + e]; w1[e] = cw[512 + c8 + e]; w2[e] = cw[1024 + c8 + e]; invf[e] = __builtin_amdgcn_exp2f(-(float)(rg * 8 + e) * 0.4152410118609203f); }
    for (int r = row_first(wave, bid, G); r >= 0; r = row_next(r, wave, bid, G, TA)) {
        const bf16_t* pr = P + (size_t)r * INWP;
        int pos, len;
        if (r < TL) { pos = r % SEQ; len = SEQ; } else { pos = (r - TL) % CTXL; len = CTXL; }
        const bool hp = pos > 0, hn = pos < len - 1;
        const u32x4 z4 = (u32x4){0u, 0u, 0u, 0u};
        const u32x4 xC = *(const u32x4*)(pr + C_CC + c8), xX = *(const u32x4*)(pr + C_CX + c8), xB = *(const u32x4*)(pr + C_CB + c8);
        const u32x4 pC = hp ? *(const u32x4*)(pr - INWP + C_CC + c8) : z4, pX = hp ? *(const u32x4*)(pr - INWP + C_CX + c8) : z4;
        const u32x4 nC = hn ? *(const u32x4*)(pr + INWP + C_CC + c8) : z4, nX = hn ? *(const u32x4*)(pr + INWP + C_CX + c8) : z4;
        const u32x4 q1 = *(const u32x4*)(pr + C_SQ + roff), q2 = *(const u32x4*)(pr + C_SQ + roff + 32);
        u32x4 k1 = z4, k2 = z4, vv = z4;
        if (lane < 16) { k1 = *(const u32x4*)(pr + C_SK + roff); k2 = *(const u32x4*)(pr + C_SK + roff + 32); }
        if (lane < 32) vv = *(const u32x4*)(pr + C_SV + c8);
        { float fC[8], fX[8], fB[8], gC[8], gX[8], hC[8], hX[8], o[8];
          unpack8(xC, fC); unpack8(xX, fX); unpack8(xB, fB); unpack8(pC, gC); unpack8(pX, gX); unpack8(nC, hC); unpack8(nX, hX);
#pragma unroll
          for (int e = 0; e < 8; ++e) o[e] = fB[e] * (w0[e] * gC[e] * gX[e] + w1[e] * fC[e] * fX[e] + w2[e] * hC[e] * hX[e]);
          *(u32x4*)(MIX + (size_t)r * DM + c8) = pack8(o); }
        { float cs[8], sn[8];
#pragma unroll
          for (int e = 0; e < 8; ++e) { cs[e] = 1.f; sn[e] = 0.f; }
          if (r < TL) { const float pv = (float)(rf ? (pos % 64) : (pos / 64));
#pragma unroll
              for (int e = 0; e < 8; ++e) { sn[e] = __sinf(pv * invf[e]); cs[e] = __cosf(pv * invf[e]); } }
          float x1[8], x2[8], o1[8], o2[8];
          unpack8(q1, x1); unpack8(q2, x2);
#pragma unroll
          for (int e = 0; e < 8; ++e) { o1[e] = (x1[e] * cs[e] - x2[e] * sn[e]) * 0.08838834764831845f; o2[e] = (x2[e] * cs[e] + x1[e] * sn[e]) * 0.08838834764831845f; }
          *(u32x4*)(QR + (size_t)r * 1024 + roff) = pack8(o1); *(u32x4*)(QR + (size_t)r * 1024 + roff + 32) = pack8(o2);
          if (lane < 16) { unpack8(k1, x1); unpack8(k2, x2);
#pragma unroll
              for (int e = 0; e < 8; ++e) { o1[e] = x1[e] * cs[e] - x2[e] * sn[e]; o2[e] = x2[e] * cs[e] + x1[e] * sn[e]; }
              *(u32x4*)(KR + (size_t)r * 256 + roff) = pack8(o1); *(u32x4*)(KR + (size_t)r * 256 + roff + 32) = pack8(o2); }
          if (lane < 32) *(u32x4*)(VR + (size_t)r * 256 + c8) = vv; }
    }
}

#ifndef SWA_THR
#define SWA_THR 6.0f
#endif
constexpr int KP = 136, VP = 72;
constexpr int SWA_BUF = 64 * KP * 2 + 128 * VP * 2;
typedef short bf16x4 __attribute__((ext_vector_type(4)));
__device__ __forceinline__ void phase_mixers(const Params& p, int l, LAS unsigned char* lds, int tid, int lane, int wave, int bid, int G, int qsel = 0) {
    const bf16_t* QR = (const bf16_t*)(p.ws + WS_QR); const bf16_t* KR = (const bf16_t*)(p.ws + WS_KR); const bf16_t* VR = (const bf16_t*)(p.ws + WS_ALF);
    bf16_t* MIX = (bf16_t*)(p.ws + WS_MIX);
    const float* sinkp = p.in[I_SINK] + l * 8;
    const int fr = lane & 15, fq = lane >> 4, g = wave & 3, qh = wave >> 2;
    const int nItems = 512 + ((l < DEPTH - 1) ? 16 : 0);
    unsigned* qhead = (unsigned*)(p.ws + WS_CTL) + CW_QUEUE + 64 * (l + 4 * qsel);
    volatile LAS int* itw = (volatile LAS int*)(lds + MISC_OFF + 64);
    for (;;) {
        if (tid == 0) itw[0] = (int)__hip_atomic_fetch_add(qhead, 1u, __ATOMIC_RELAXED, __HIP_MEMORY_SCOPE_AGENT);
        __syncthreads();
        const int it = itw[0];
        __syncthreads();
        if (it >= nItems) break;
        int b, tile, hk, s0; size_t qrow0;
        if (it < 512) { b = it >> 8; tile = (it >> 1) & 127; hk = it & 1; s0 = 0; qrow0 = (size_t)b * SEQ + tile * 64; }
        else { const int c = it - 512; b = c >> 3; tile = (c >> 1) & 3; hk = c & 1; s0 = 5; qrow0 = (size_t)TL + b * CTXL + tile * 64; }
        const int n0 = tile * 64, hq = hk * 4 + g;
        bf16x8 qf[2][4];
#pragma unroll
        for (int qt = 0; qt < 2; ++qt)
#pragma unroll
            for (int ks = 0; ks < 4; ++ks) qf[qt][ks] = *(const bf16x8*)(QR + (qrow0 + qh * 32 + qt * 16 + fr) * 1024 + hq * 128 + ks * 32 + fq * 8);
        f32x4 O[2][8];
#pragma unroll
        for (int qt = 0; qt < 2; ++qt)
#pragma unroll
            for (int dt = 0; dt < 8; ++dt) O[qt][dt] = (f32x4){0.f, 0.f, 0.f, 0.f};
        float m[2], lsum[2];
        m[0] = m[1] = sinkp[hq]; lsum[0] = lsum[1] = (fq == 0) ? 1.f : 0.f;
        u32x4 kreg[2], vreg[2];
#define SWA_ROW(s, kk) ((s) < 5 ? (size_t)b * SEQ + (size_t)min(max(n0 - 128 + (s) * 64 + (kk), 0), SEQ - 1) : (size_t)TL + (size_t)b * CTXL + ((s) - 5) * 64 + (kk))
#define SWA_LOAD(s) do { _Pragma("unroll") for (int j = 0; j < 2; ++j) { const int v = tid + NTHREADS * j; \
            kreg[j] = *(const u32x4*)(KR + SWA_ROW(s, v >> 4) * 256 + hk * 128 + (v & 15) * 8); \
            vreg[j] = *(const u32x4*)(VR + SWA_ROW(s, tid & 63) * 256 + hk * 128 + ((tid >> 6) + 8 * j) * 8); } } while (0)
#define SWA_WRITE(buf) do { LAS bf16_t* Kd = (LAS bf16_t*)(lds + (buf) * SWA_BUF); LAS bf16_t* Vd = Kd + 64 * KP; \
            _Pragma("unroll") for (int j = 0; j < 2; ++j) { const int v = tid + NTHREADS * j; *(LAS u32x4*)(Kd + (v >> 4) * KP + (v & 15) * 8) = kreg[j]; \
                const int d0 = ((tid >> 6) + 8 * j) * 8, key = tid & 63; const u32x4 w = vreg[j]; \
                Vd[(d0 + 0) * VP + key] = (bf16_t)(w.x & 0xffffu); Vd[(d0 + 1) * VP + key] = (bf16_t)(w.x >> 16); Vd[(d0 + 2) * VP + key] = (bf16_t)(w.y & 0xffffu); Vd[(d0 + 3) * VP + key] = (bf16_t)(w.y >> 16); \
                Vd[(d0 + 4) * VP + key] = (bf16_t)(w.z & 0xffffu); Vd[(d0 + 5) * VP + key] = (bf16_t)(w.z >> 16); Vd[(d0 + 6) * VP + key] = (bf16_t)(w.w & 0xffffu); Vd[(d0 + 7) * VP + key] = (bf16_t)(w.w >> 16); } } while (0)
        SWA_LOAD(s0); SWA_WRITE(0);
        __syncthreads();
#pragma unroll 1
        for (int s = s0; s < 9; ++s) {
            const int buf = (s - s0) & 1;
            if (s + 1 < 9) SWA_LOAD(s + 1);
            const LAS bf16_t* Ks = (const LAS bf16_t*)(lds + buf * SWA_BUF); const LAS bf16_t* Vs = Ks + 64 * KP;
#pragma unroll 1
            for (int sc = 0; sc < 2; ++sc) {
                f32x4 sT[2][2];
#pragma unroll
                for (int qt = 0; qt < 2; ++qt) { sT[qt][0] = (f32x4){0.f, 0.f, 0.f, 0.f}; sT[qt][1] = (f32x4){0.f, 0.f, 0.f, 0.f}; }
#pragma unroll
                for (int ks = 0; ks < 4; ++ks)
#pragma unroll
                    for (int kt = 0; kt < 2; ++kt) { const bf16x8 ka = *(const LAS bf16x8*)(Ks + (sc * 32 + kt * 16 + fr) * KP + ks * 32 + fq * 8);
#pragma unroll
                        for (int qt = 0; qt < 2; ++qt) sT[qt][kt] = __builtin_amdgcn_mfma_f32_16x16x32_bf16(ka, qf[qt][ks], sT[qt][kt], 0, 0, 0); }
                bf16x8 pb[2];
                float cm[2];
#pragma unroll
                for (int qt = 0; qt < 2; ++qt) {
                    if (s < 5) {
                        const int qpos = n0 + qh * 32 + qt * 16 + fr;
#pragma unroll
                        for (int kt = 0; kt < 2; ++kt)
#pragma unroll
                            for (int e = 0; e < 4; ++e) { const int kpos = n0 - 128 + s * 64 + sc * 32 + kt * 16 + fq * 4 + e; const int dlt = qpos - kpos;
                                const bool ok = kpos >= 0 && kpos < SEQ && dlt <= 128 && dlt >= -128; sT[qt][kt][e] = ok ? sT[qt][kt][e] : -1e30f; } }
                    cm[qt] = fmaxf(fmaxf(fmaxf(sT[qt][0][0], sT[qt][0][1]), fmaxf(sT[qt][0][2], sT[qt][0][3])), fmaxf(fmaxf(sT[qt][1][0], sT[qt][1][1]), fmaxf(sT[qt][1][2], sT[qt][1][3])));
                }
                if (__any((cm[0] > m[0] + SWA_THR) || (cm[1] > m[1] + SWA_THR))) {
#pragma unroll
                    for (int qt = 0; qt < 2; ++qt) { float c = cm[qt]; c = fmaxf(c, __shfl_xor(c, 16)); c = fmaxf(c, __shfl_xor(c, 32));
                        const float mn = fmaxf(m[qt], c), scl = __expf(m[qt] - mn); m[qt] = mn; lsum[qt] *= scl;
#pragma unroll
                        for (int dt = 0; dt < 8; ++dt) O[qt][dt] = O[qt][dt] * scl; }
                }
#pragma unroll
                for (int qt = 0; qt < 2; ++qt) {
                    float pe[8]; float ps = 0.f;
#pragma unroll
                    for (int kt = 0; kt < 2; ++kt)
#pragma unroll
                        for (int e = 0; e < 4; ++e) { pe[kt * 4 + e] = __expf(sT[qt][kt][e] - m[qt]); ps += pe[kt * 4 + e]; }
                    lsum[qt] += ps;
                    u32x4 pw; pw.x = pk2(pe[0], pe[1]); pw.y = pk2(pe[2], pe[3]); pw.z = pk2(pe[4], pe[5]); pw.w = pk2(pe[6], pe[7]);
                    pb[qt] = __builtin_bit_cast(bf16x8, pw);
                }
#pragma unroll
                for (int dt = 0; dt < 8; ++dt) {
                    const bf16x4 v0 = *(const LAS bf16x4*)(Vs + (dt * 16 + fr) * VP + sc * 32 + 4 * fq), v1 = *(const LAS bf16x4*)(Vs + (dt * 16 + fr) * VP + sc * 32 + 16 + 4 * fq);
                    const bf16x8 va = __builtin_shufflevector(v0, v1, 0, 1, 2, 3, 4, 5, 6, 7);
#pragma unroll
                    for (int qt = 0; qt < 2; ++qt) O[qt][dt] = __builtin_amdgcn_mfma_f32_16x16x32_bf16(va, pb[qt], O[qt][dt], 0, 0, 0);
                }
            }
            if (s + 1 < 9) SWA_WRITE(buf ^ 1);
            __syncthreads();
        }
#undef SWA_ROW
#undef SWA_LOAD
#undef SWA_WRITE
#pragma unroll
        for (int qt = 0; qt < 2; ++qt) {
            float lt = lsum[qt]; lt += __shfl_xor(lt, 16); lt += __shfl_xor(lt, 32);
            const float inv = 1.0f / lt;
            bf16_t* o = MIX + (qrow0 + qh * 32 + qt * 16 + fr) * DM + 1024 + hq * 128 + fq * 4;
#pragma unroll
            for (int dt = 0; dt < 8; ++dt) { u32x2 w; w.x = pk2(O[qt][dt][0] * inv, O[qt][dt][1] * inv); w.y = pk2(O[qt][dt][2] * inv, O[qt][dt][3] * inv); *(u32x2*)(o + dt * 16) = w; }
        }
    }
}

__device__ __forceinline__ int chunk_row0(int cid) { return cid < 256 ? (cid >> 7) * SEQ + (cid & 127) * 64 : TL + ((cid - 256) >> 2) * CTXL + ((cid - 256) & 3) * 64; }
constexpr int GP = 72;

constexpr int LTP = 65;
__device__ __forceinline__ float wave_incl_scan(float x) {
    x += __builtin_bit_cast(float, __builtin_amdgcn_update_dpp(0, __builtin_bit_cast(int, x), 0x111, 0xF, 0xF, true));
    x += __builtin_bit_cast(float, __builtin_amdgcn_update_dpp(0, __builtin_bit_cast(int, x), 0x112, 0xF, 0xF, true));
    x += __builtin_bit_cast(float, __builtin_amdgcn_update_dpp(0, __builtin_bit_cast(int, x), 0x114, 0xF, 0xF, true));
    x += __builtin_bit_cast(float, __builtin_amdgcn_update_dpp(0, __builtin_bit_cast(int, x), 0x118, 0xF, 0xF, true));
    x += __builtin_bit_cast(float, __builtin_amdgcn_update_dpp(0, __builtin_bit_cast(int, x), 0x142, 0xA, 0xF, false));
    x += __builtin_bit_cast(float, __builtin_amdgcn_update_dpp(0, __builtin_bit_cast(int, x), 0x143, 0xC, 0xF, false));
    return x;
}
__device__ __forceinline__ void gla_g1(const Params& p, int l, LAS unsigned char* lds, int tid, int lane, int wave, int bid, int G) {
    LAS float* LTf = (LAS float*)lds; LAS float* LTb = LTf + 64 * LTP;
    LAS bf16_t* KTf = (LAS bf16_t*)(lds + 2 * 64 * LTP * 4); LAS bf16_t* KTb = KTf + 64 * GP;
    LAS bf16_t* VT = KTb + 64 * GP;
    const bf16_t* P = (const bf16_t*)(p.ws + WS_P);
    float* BF = (float*)(p.ws + WS_OF); float* BB = (float*)(p.ws + WS_OB);
    float* DELTA = (float*)(p.ws + WS_DELTA); float* DEC = (float*)(p.ws + WS_DEC);
    const float* w2 = p.in[I_GW2] + (size_t)l * 2 * 16 * 256; const float* b2 = p.in[I_GB2] + (size_t)l * 2 * 256;
    const int fr = lane & 15, fq = lane >> 4, ti = tid >> 3, tk0 = (tid & 7) * 8;
    float wr[2][16], br[2];
    const bool fixed_h = (G & 3) == 0;
#define G1_LOADW(hh_) do { _Pragma("unroll") for (int d = 0; d < 2; ++d) { br[d] = b2[d * 256 + (hh_) * 64 + lane]; \
        _Pragma("unroll") for (int q = 0; q < 16; ++q) wr[d][q] = w2[(d * 16 + q) * 256 + (hh_) * 64 + lane]; } } while (0)
    if (fixed_h) G1_LOADW(bid & 3);
    u32x4 kraw, vraw[2], lrr[2][4];
#define G1_LOADX(item_) do { const int cid_ = (item_) >> 2, h_ = (item_) & 3, row0_ = chunk_row0(cid_); \
        kraw = *(const u32x4*)(P + (size_t)(row0_ + ti) * INWP + C_GK + h_ * 64 + tk0); \
        _Pragma("unroll") for (int j = 0; j < 2; ++j) { const int vi = tid + NTHREADS * j; vraw[j] = *(const u32x4*)(P + (size_t)(row0_ + (vi >> 4)) * INWP + C_GV + h_ * 128 + (vi & 15) * 8); } \
        _Pragma("unroll") for (int jj = 0; jj < 2; ++jj) _Pragma("unroll") for (int c = 0; c < 4; ++c) lrr[jj][c] = *(const u32x4*)(P + (size_t)(row0_ + wave + 8 * jj) * INWP + C_LRF + c * 8); } while (0)
    if (bid < GLA_ITEMS) G1_LOADX(bid);
    for (int item = bid; item < GLA_ITEMS; item += G) {
        const int cid = item >> 2, h = item & 3, row0 = chunk_row0(cid);
        const u32x4 kraw_c = kraw; u32x4 vraw_c[2] = {vraw[0], vraw[1]};
        {
            if (!fixed_h) G1_LOADW(h);
#pragma unroll
            for (int jj = 0; jj < 8; ++jj) { const int i = wave + 8 * jj;
                float lf[4][8];
                if (jj < 2) {
#pragma unroll
                    for (int c = 0; c < 4; ++c) unpack8(lrr[jj][c], lf[c]);
                } else { const bf16_t* lrp = P + (size_t)(row0 + i) * INWP + C_LRF;
#pragma unroll
                    for (int c = 0; c < 4; ++c) unpack8(*(const u32x4*)(lrp + c * 8), lf[c]); }
#pragma unroll
                for (int d = 0; d < 2; ++d) { float z = br[d];
#pragma unroll
                    for (int q = 0; q < 16; ++q) z += lf[d * 2 + (q >> 3)][q & 7] * wr[d][q];
                    (d ? LTb : LTf)[lane * LTP + i] = log_sigmoid_f(z) * (1.0f / 16.0f); } }
        }
        if (item + G < GLA_ITEMS) G1_LOADX(item + G);
        __syncthreads();
#pragma unroll 2
        for (int kk = 0; kk < 8; ++kk) { const int k = wave * 8 + kk;
            float xf = LTf[k * LTP + lane], xb = LTb[k * LTP + lane];
            const float pf = wave_incl_scan(xf), pb = wave_incl_scan(xb);
            const float totb = __builtin_bit_cast(float, __builtin_amdgcn_readlane(__builtin_bit_cast(int, pb), 63));
            LTf[k * LTP + lane] = pf; LTb[k * LTP + lane] = totb - pb + xb; }
        __syncthreads();
        { float kv[8]; unpack8(kraw_c, kv);
          float bfv[8], bbv[8];
#pragma unroll
          for (int e = 0; e < 8; ++e) { const int k = tk0 + e; bfv[e] = LTf[k * LTP + ti]; bbv[e] = LTb[k * LTP + ti];
              KTf[k * GP + ti] = (bf16_t)f2bf(kv[e] * __expf(LTf[k * LTP + 63] - bfv[e]));
              KTb[k * GP + ti] = (bf16_t)f2bf(kv[e] * __expf(LTb[k * LTP] - bbv[e])); }
          float* bg = BF + (size_t)(row0 + ti) * 256 + h * 64 + tk0; *(f32x4*)bg = (f32x4){bfv[0], bfv[1], bfv[2], bfv[3]}; *(f32x4*)(bg + 4) = (f32x4){bfv[4], bfv[5], bfv[6], bfv[7]};
          bg = BB + (size_t)(row0 + ti) * 256 + h * 64 + tk0; *(f32x4*)bg = (f32x4){bbv[0], bbv[1], bbv[2], bbv[3]}; *(f32x4*)(bg + 4) = (f32x4){bbv[4], bbv[5], bbv[6], bbv[7]};
#pragma unroll
          for (int j = 0; j < 2; ++j) { const int vi = tid + NTHREADS * j, i = vi >> 4, v0 = (vi & 15) * 8; const u32x4 w = vraw_c[j];
              VT[(v0 + 0) * GP + i] = (bf16_t)(w.x & 0xffffu); VT[(v0 + 1) * GP + i] = (bf16_t)(w.x >> 16); VT[(v0 + 2) * GP + i] = (bf16_t)(w.y & 0xffffu); VT[(v0 + 3) * GP + i] = (bf16_t)(w.y >> 16);
              VT[(v0 + 4) * GP + i] = (bf16_t)(w.z & 0xffffu); VT[(v0 + 5) * GP + i] = (bf16_t)(w.z >> 16); VT[(v0 + 6) * GP + i] = (bf16_t)(w.w & 0xffffu); VT[(v0 + 7) * GP + i] = (bf16_t)(w.w >> 16); }
          if (tid < 128) { const int dir = tid >> 6, k = tid & 63; DEC[((size_t)item * 2 + dir) * 64 + k] = __expf(dir ? LTb[k * LTP] : LTf[k * LTP + 63]); } }
        __syncthreads();
        { const int dir = wave >> 2, vq = wave & 3; const LAS bf16_t* KT = dir ? KTb : KTf;
            f32x4 acc[2][4];
#pragma unroll
            for (int a = 0; a < 2; ++a)
#pragma unroll
                for (int b = 0; b < 4; ++b) acc[a][b] = (f32x4){0.f, 0.f, 0.f, 0.f};
#pragma unroll
            for (int ks = 0; ks < 2; ++ks) { bf16x8 af[2], bfr[4];
#pragma unroll
                for (int a = 0; a < 2; ++a) af[a] = *(const LAS bf16x8*)(VT + ((vq * 2 + a) * 16 + fr) * GP + ks * 32 + fq * 8);
#pragma unroll
                for (int b = 0; b < 4; ++b) bfr[b] = *(const LAS bf16x8*)(KT + (b * 16 + fr) * GP + ks * 32 + fq * 8);
#pragma unroll
                for (int a = 0; a < 2; ++a)
#pragma unroll
                    for (int b = 0; b < 4; ++b) acc[a][b] = __builtin_amdgcn_mfma_f32_16x16x32_bf16(af[a], bfr[b], acc[a][b], 0, 0, 0); }
            float* dst = DELTA + ((size_t)item * 2 + dir) * 8192;
#pragma unroll
            for (int a = 0; a < 2; ++a)
#pragma unroll
                for (int b = 0; b < 4; ++b)
#pragma unroll
                    for (int g = 0; g < 4; ++g) dst[((vq * 2 + a) * 16 + fq * 4 + g) * 64 + b * 16 + fr] = acc[a][b][g]; }
        __syncthreads();
    }
}

#undef G1_LOADW
#undef G1_LOADX
__device__ __forceinline__ void gla_g2(const Params& p, int tid, int bid, int G) {
    const float* DELTA = (const float*)(p.ws + WS_DELTA); const float* DEC = (const float*)(p.ws + WS_DEC); bf16_t* SST = (bf16_t*)(p.ws + WS_SST);
    for (int u = bid; u < 64; u += G) {
        const int s = u >> 2, dir = s >> 3, b = (s >> 2) & 1, h = s & 3, off = ((u & 3) * NTHREADS + tid) * 4, k0 = off & 63;
        f32x4 S = (f32x4){0.f, 0.f, 0.f, 0.f};
#pragma unroll 1
        for (int st = 0; st < 132; st += 12) {
            f32x4 d[12], dc[12]; size_t base[12];
#pragma unroll
            for (int q = 0; q < 12; ++q) { const int t = st + q;
                const int cid = t < 4 ? 256 + b * 4 + (dir ? 3 - t : t) : b * 128 + (dir ? 127 - (t - 4) : (t - 4));
                const size_t it2 = (size_t)(cid * 4 + h) * 2 + dir; base[q] = it2 * 8192 + off;
                d[q] = *(const f32x4*)(DELTA + base[q]); dc[q] = *(const f32x4*)(DEC + it2 * 64 + k0); }
#pragma unroll
            for (int q = 0; q < 12; ++q) { u32x2 o; o.x = pk2(S.x, S.y); o.y = pk2(S.z, S.w); *(u32x2*)(SST + base[q]) = o; S = dc[q] * S + d[q]; }
        }
    }
}

__device__ __forceinline__ void gla_g3(const Params& p, int l, LAS unsigned char* lds, int tid, int lane, int wave, int bid, int G, unsigned* qhead3 = nullptr) {
    LAS bf16_t* QEf = (LAS bf16_t*)lds; LAS bf16_t* QEb = QEf + 64 * GP; LAS bf16_t* KEf = QEb + 64 * GP; LAS bf16_t* KEb = KEf + 64 * GP;
    LAS bf16_t* VT = KEb + 64 * GP;
    LAS bf16_t* ATT = VT + 128 * GP + wave * (16 * GP);
    LAS float* RS = (LAS float*)(lds + 2 * (4 * 64 * GP + 128 * GP + 8 * 16 * GP));
    const bf16_t* P = (const bf16_t*)(p.ws + WS_P);
    const float* BF = (const float*)(p.ws + WS_OF); const float* BB = (const float*)(p.ws + WS_OB);
    const bf16_t* SST = (const bf16_t*)(p.ws + WS_SST); bf16_t* MIX = (bf16_t*)(p.ws + WS_MIX);
    const float* nw = p.in[I_GNORM] + l * 128;
    const int fr = lane & 15, fq = lane >> 4, it = wave >> 1, vh = wave & 1, ti = tid >> 3, tk0 = (tid & 7) * 8;
    const int n_items = (l < DEPTH - 1) ? GLA_ITEMS : 256 * 4;
    volatile LAS int* itw3 = (volatile LAS int*)(lds + MISC_OFF + 64);
    for (int item = bid;; item += G) {
        if (qhead3) {
            if (tid == 0) itw3[0] = (int)__hip_atomic_fetch_add(qhead3, 1u, __ATOMIC_RELAXED, __HIP_MEMORY_SCOPE_AGENT);
            __syncthreads(); item = itw3[0]; __syncthreads(); }
        if (item >= n_items) break;
        const int cid = item >> 2, h = item & 3, row0 = chunk_row0(cid);
        {
            const size_t r = (size_t)(row0 + ti);
            const u32x4 qraw = *(const u32x4*)(P + r * INWP + C_GQ + h * 64 + tk0), kraw = *(const u32x4*)(P + r * INWP + C_GK + h * 64 + tk0);
            const f32x4 f0 = *(const f32x4*)(BF + r * 256 + h * 64 + tk0), f1 = *(const f32x4*)(BF + r * 256 + h * 64 + tk0 + 4);
            const f32x4 b0 = *(const f32x4*)(BB + r * 256 + h * 64 + tk0), b1 = *(const f32x4*)(BB + r * 256 + h * 64 + tk0 + 4);
            u32x4 vraw[2];
#pragma unroll
            for (int j = 0; j < 2; ++j) { const int vi = tid + NTHREADS * j; vraw[j] = *(const u32x4*)(P + (size_t)(row0 + (vi >> 4)) * INWP + C_GV + h * 128 + (vi & 15) * 8); }
            float q[8], kk[8]; unpack8(qraw, q); unpack8(kraw, kk);
            const float bf[8] = {f0.x, f0.y, f0.z, f0.w, f1.x, f1.y, f1.z, f1.w}, bb[8] = {b0.x, b0.y, b0.z, b0.w, b1.x, b1.y, b1.z, b1.w};
            float o0[8], o1[8], o2[8], o3[8];
#pragma unroll
            for (int e = 0; e < 8; ++e) { const float ef = __expf(bf[e]), eb = __expf(bb[e]); const float qs = q[e] * 0.125f;
                o0[e] = qs * ef; o1[e] = kk[e] / ef; o2[e] = qs * eb; o3[e] = kk[e] / eb; }
            *(LAS u32x4*)(QEf + ti * GP + tk0) = pack8(o0); *(LAS u32x4*)(KEf + ti * GP + tk0) = pack8(o1); *(LAS u32x4*)(QEb + ti * GP + tk0) = pack8(o2); *(LAS u32x4*)(KEb + ti * GP + tk0) = pack8(o3);
#pragma unroll
            for (int j = 0; j < 2; ++j) { const int vi = tid + NTHREADS * j, i = vi >> 4, v0 = (vi & 15) * 8; const u32x4 w = vraw[j];
                VT[(v0 + 0) * GP + i] = (bf16_t)(w.x & 0xffffu); VT[(v0 + 1) * GP + i] = (bf16_t)(w.x >> 16); VT[(v0 + 2) * GP + i] = (bf16_t)(w.y & 0xffffu); VT[(v0 + 3) * GP + i] = (bf16_t)(w.y >> 16);
                VT[(v0 + 4) * GP + i] = (bf16_t)(w.z & 0xffffu); VT[(v0 + 5) * GP + i] = (bf16_t)(w.z >> 16); VT[(v0 + 6) * GP + i] = (bf16_t)(w.w & 0xffffu); VT[(v0 + 7) * GP + i] = (bf16_t)(w.w >> 16); }
        }
        float gt[4][4];
#pragma unroll
        for (int g = 0; g < 4; ++g)
#pragma unroll
            for (int vt = 0; vt < 4; ++vt) gt[g][vt] = bflo((unsigned)P[(size_t)(row0 + it * 16 + fq * 4 + g) * INWP + C_GG + h * 128 + (vh * 4 + vt) * 16 + fr]);
        __syncthreads();
        f32x4 acc[4];
#pragma unroll
        for (int vt = 0; vt < 4; ++vt) acc[vt] = (f32x4){0.f, 0.f, 0.f, 0.f};
#pragma unroll
        for (int dir = 0; dir < 2; ++dir) {
            const LAS bf16_t* QE = dir ? QEb : QEf; const LAS bf16_t* KE = dir ? KEb : KEf;
            bf16x8 qa[2], sbf[2][4];
            const bf16_t* Sg = SST + ((size_t)item * 2 + dir) * 8192;
#pragma unroll
            for (int ks = 0; ks < 2; ++ks)
#pragma unroll
                for (int vt = 0; vt < 4; ++vt) sbf[ks][vt] = *(const bf16x8*)(Sg + ((vh * 4 + vt) * 16 + fr) * 64 + ks * 32 + fq * 8);
#pragma unroll
            for (int ks = 0; ks < 2; ++ks) qa[ks] = *(const LAS bf16x8*)(QE + (it * 16 + fr) * GP + ks * 32 + fq * 8);
#pragma unroll
            for (int jt = 0; jt < 4; ++jt) { f32x4 a = (f32x4){0.f, 0.f, 0.f, 0.f};
#pragma unroll
                for (int ks = 0; ks < 2; ++ks) { const bf16x8 kb = *(const LAS bf16x8*)(KE + (jt * 16 + fr) * GP + ks * 32 + fq * 8); a = __builtin_amdgcn_mfma_f32_16x16x32_bf16(qa[ks], kb, a, 0, 0, 0); }
#pragma unroll
                for (int g = 0; g < 4; ++g) { const int ii = it * 16 + fq * 4 + g, jj = jt * 16 + fr; const bool keep = dir ? (jj >= ii) : (jj <= ii);
                    ATT[(fq * 4 + g) * GP + jt * 16 + fr] = (bf16_t)f2bf(keep ? a[g] : 0.f); } }
            LDS_FENCE();
#pragma unroll
            for (int ks = 0; ks < 2; ++ks) { const bf16x8 aa = *(const LAS bf16x8*)(ATT + fr * GP + ks * 32 + fq * 8);
#pragma unroll
                for (int vt = 0; vt < 4; ++vt) { const int v = (vh * 4 + vt) * 16 + fr;
                    const bf16x8 vb = *(const LAS bf16x8*)(VT + v * GP + ks * 32 + fq * 8);
                    acc[vt] = __builtin_amdgcn_mfma_f32_16x16x32_bf16(aa, vb, acc[vt], 0, 0, 0);
                    acc[vt] = __builtin_amdgcn_mfma_f32_16x16x32_bf16(qa[ks], sbf[ks][vt], acc[vt], 0, 0, 0); } }
            LDS_FENCE();
        }
        float ss[4];
#pragma unroll
        for (int g = 0; g < 4; ++g) { float t = 0.f;
#pragma unroll
            for (int vt = 0; vt < 4; ++vt) t += acc[vt][g] * acc[vt][g];
            ss[g] = row16_sum(t); }
        if (fr == 0) {
#pragma unroll
            for (int g = 0; g < 4; ++g) RS[(it * 16 + fq * 4 + g) * 2 + vh] = ss[g]; }
        __syncthreads();
#pragma unroll
        for (int g = 0; g < 4; ++g) { const int i = it * 16 + fq * 4 + g; const float tot = RS[i * 2] + RS[i * 2 + 1];
            const float rs = 1.0f / sqrtf(tot * (1.0f / 128.0f) + LN_EPS); const size_t r = (size_t)(row0 + i);
#pragma unroll
            for (int vt = 0; vt < 4; ++vt) { const int v = (vh * 4 + vt) * 16 + fr;
                MIX[r * DM + 512 + h * 128 + v] = (bf16_t)f2bf(acc[vt][g] * rs * nw[v] * silu_f(gt[g][vt])); } }
        __syncthreads();
    }
}

__device__ __forceinline__ void ln_row(f32x4 (&v)[8], const float* lg, const float* lb, int lane) {
    float s = 0.f;
#pragma unroll
    for (int j = 0; j < 8; ++j) s += (v[j].x + v[j].y) + (v[j].z + v[j].w);
    const float mean = wave_sum(s) * (1.0f / DM);
    float s2 = 0.f;
#pragma unroll
    for (int j = 0; j < 8; ++j) { v[j] = v[j] - mean; s2 += (v[j].x * v[j].x + v[j].y * v[j].y) + (v[j].z * v[j].z + v[j].w * v[j].w); }
    const float rstd = 1.0f / sqrtf(wave_sum(s2) * (1.0f / DM) + LN_EPS);
#pragma unroll
    for (int j = 0; j < 8; ++j) { const int c = lane * 4 + 256 * j; const f32x4 g = *(const f32x4*)(lg + c), b = *(const f32x4*)(lb + c); v[j] = v[j] * rstd * g + b; }
}

__device__ __forceinline__ void phase_ln1(const Params& p, int l, LAS unsigned char* lds, int tid, int lane, int wave, int bid, int G) {
    const int gw = bid * NWAVES + wave, NGW = G * NWAVES;
    const float* MOD = (const float*)(p.ws + WS_MOD); const bf16_t* Y = (const bf16_t*)(p.ws + WS_Y); const float* YP = (const float*)(p.ws + WS_YPART);
    bf16_t* XM = (bf16_t*)(p.ws + WS_XM); bf16_t* HB = (bf16_t*)(p.ws + WS_HB);
    LAS float* VEC = (LAS float*)lds;
    for (int i = tid; i < 11 * DM / 4; i += NTHREADS) { const int vi = i / (DM / 4), c = (i % (DM / 4)) * 4;
        const float* src = vi < 9 ? MOD + (size_t)(l * 3 + (vi % 3)) * 6 * DM + (2 + vi / 3) * DM + c : (vi == 9 ? p.in[I_LNG] : p.in[I_LNB]) + (size_t)(l * 2 + 0) * DM + c;
        *(LAS f32x4*)(VEC + vi * DM + c) = *(const f32x4*)src; }
    __syncthreads();
    f32x4 xn[8]; u32x2 yn[8];
#define LN1_LOAD(rr) do { if (l == 0) { const float* xr_ = xsrc(p, 0, (rr)); _Pragma("unroll") for (int j = 0; j < 8; ++j) xn[j] = *(const f32x4*)(xr_ + lane * 4 + 256 * j); } \
        else { const bf16_t* xb_ = (const bf16_t*)(p.ws + WS_XL) + (size_t)(rr) * DM; _Pragma("unroll") for (int j = 0; j < 8; ++j) { const u32x2 w_ = *(const u32x2*)(xb_ + lane * 4 + 256 * j); xn[j] = (f32x4){bflo(w_.x), bfhi(w_.x), bflo(w_.y), bfhi(w_.y)}; } } \
        if ((rr) < TL) { _Pragma("unroll") for (int j = 0; j < 8; ++j) yn[j] = *(const u32x2*)(Y + (size_t)(rr) * DM + lane * 4 + 256 * j); } } while (0)
    if (row_first(wave, bid, G) >= 0) LN1_LOAD(row_first(wave, bid, G));
    for (int r = row_first(wave, bid, G); r >= 0; r = row_next(r, wave, bid, G, TA)) {
        const int st = row_stream(r);
        f32x4 v[8], yy[8];
#pragma unroll
        for (int j = 0; j < 8; ++j) v[j] = xn[j];
        if (r < TL) {
#pragma unroll
            for (int j = 0; j < 8; ++j) yy[j] = (f32x4){bflo(yn[j].x), bfhi(yn[j].x), bflo(yn[j].y), bfhi(yn[j].y)};
        } else {
#pragma unroll
            for (int j = 0; j < 8; j += 2) { f32x4 pp[2][8];
#pragma unroll
                for (int jj = 0; jj < 2; ++jj)
#pragma unroll
                    for (int ks = 0; ks < 8; ++ks) pp[jj][ks] = *(const f32x4*)(YP + ((size_t)ks * 512 + (r - TL)) * DM + lane * 4 + 256 * (j + jj));
#pragma unroll
                for (int jj = 0; jj < 2; ++jj) yy[j + jj] = ((pp[jj][0] + pp[jj][1]) + (pp[jj][2] + pp[jj][3])) + ((pp[jj][4] + pp[jj][5]) + (pp[jj][6] + pp[jj][7])); }
        }
        { const int rn = row_next(r, wave, bid, G, TA); if (rn >= 0) LN1_LOAD(rn); }
#pragma unroll
        for (int j = 0; j < 8; ++j) { const f32x4 g = *(const LAS f32x4*)(VEC + st * DM + lane * 4 + 256 * j); v[j] = v[j] * DN_ALPHA + g * yy[j]; }
        float s = 0.f;
#pragma unroll
        for (int j = 0; j < 8; ++j) s += (v[j].x + v[j].y) + (v[j].z + v[j].w);
        const float mean = wave_sum(s) * (1.0f / DM);
        float s2 = 0.f;
#pragma unroll
        for (int j = 0; j < 8; ++j) { v[j] = v[j] - mean; s2 += (v[j].x * v[j].x + v[j].y * v[j].y) + (v[j].z * v[j].z + v[j].w * v[j].w); }
        const float rstd = 1.0f / sqrtf(wave_sum(s2) * (1.0f / DM) + LN_EPS);
#pragma unroll
        for (int j = 0; j < 8; ++j) { const int c = lane * 4 + 256 * j;
            const f32x4 g = *(const LAS f32x4*)(VEC + 9 * DM + c), b = *(const LAS f32x4*)(VEC + 10 * DM + c), sh = *(const LAS f32x4*)(VEC + (3 + st) * DM + c), sc = *(const LAS f32x4*)(VEC + (6 + st) * DM + c);
            const f32x4 o = v[j] * rstd * g + b;
            { u32x2 xw; xw.x = pk2(o.x, o.y); xw.y = pk2(o.z, o.w); *(u32x2*)(XM + (size_t)r * DM + c) = xw; }
            u32x2 w; w.x = pk2(o.x * (1.f + sc.x) + sh.x, o.y * (1.f + sc.y) + sh.y); w.y = pk2(o.z * (1.f + sc.z) + sh.z, o.w * (1.f + sc.w) + sh.w);
            *(u32x2*)(HB + (size_t)r * DM + c) = w; }
    }
#undef LN1_LOAD
}

constexpr int SKP = 136;
__device__ __forceinline__ unsigned f2key(float f) { const unsigned u = __builtin_bit_cast(unsigned, f); return u ^ ((u >> 31) ? 0xFFFFFFFFu : 0x80000000u); }
__device__ __forceinline__ float key2f(unsigned k) { const unsigned u = (k >> 31) ? (k ^ 0x80000000u) : ~k; return __builtin_bit_cast(float, u); }
__device__ __forceinline__ unsigned row16_max_u32(unsigned k) {
    unsigned o;
    o = (unsigned)__builtin_amdgcn_update_dpp(0, (int)k, 0xB1, 0xF, 0xF, false); k = k > o ? k : o;
    o = (unsigned)__builtin_amdgcn_update_dpp(0, (int)k, 0x4E, 0xF, 0xF, false); k = k > o ? k : o;
    o = (unsigned)__builtin_amdgcn_update_dpp(0, (int)k, 0x141, 0xF, 0xF, false); k = k > o ? k : o;
    o = (unsigned)__builtin_amdgcn_update_dpp(0, (int)k, 0x140, 0xF, 0xF, false); k = k > o ? k : o;
    return k;
}
__device__ __forceinline__ void peer_retrieve(const Params& p, int l, LAS unsigned char* lds, int tid, int lane, int wave, int bid, int G, int ntok) {
    LAS bf16_t* SK = (LAS bf16_t*)lds;
    const bf16_t* SUBB = (const bf16_t*)(p.ws + WS_SUBB) + (size_t)l * 2 * 128 * 128;
#pragma unroll 1
    for (int j = 0; j < 8; ++j) { const int vv = tid + NTHREADS * j, row = vv >> 4, c = vv & 15; *(LAS u32x4*)(SK + row * SKP + c * 8) = *(const u32x4*)(SUBB + row * 128 + c * 8); }
    __syncthreads();
    const bf16_t* QP = (const bf16_t*)(p.ws + WS_QP); const float* QPP = (const float*)(p.ws + WS_QPART);
    int* EIDX = (int*)(p.ws + WS_EIDX); float* EGATE = (float*)(p.ws + WS_EGATE);
    const int gw = bid * NWAVES + wave, NGW = G * NWAVES, fr = lane & 15, fq = lane >> 4, gbase = lane & 48;
    const int nitems = (ntok / 16) * 8;
    const int nmain = nitems / NGW, nfull = nmain * NGW, nextra = (wave == 0 && nfull + bid < nitems) ? (nitems - nfull - bid + G - 1) / G : 0;
    for (int ri = 0; ri < nmain + nextra; ++ri) {
        const int item = ri < nmain ? gw + NGW * ri : nfull + bid + (ri - nmain) * G;
        const int tile = item >> 3, h = item & 7;
        unsigned tkp[2][4];
        bf16x8 afr[2][4];
        if (tile * 16 < TL) {
#pragma unroll
            for (int pp = 0; pp < 2; ++pp)
#pragma unroll
                for (int ks = 0; ks < 4; ++ks) afr[pp][ks] = *(const bf16x8*)(QP + (size_t)(tile * 16 + fr) * DM + h * 256 + pp * 128 + ks * 32 + fq * 8);
        } else {
#pragma unroll
            for (int pp = 0; pp < 2; ++pp)
#pragma unroll
                for (int ks = 0; ks < 4; ++ks) { const float* qp = QPP + (size_t)(tile * 16 - TL + fr) * DM + h * 256 + pp * 128 + ks * 32 + fq * 8;
                    f32x4 pa[8], pb[8];
#pragma unroll
                    for (int sl = 0; sl < 8; ++sl) { pa[sl] = *(const f32x4*)(qp + (size_t)sl * 512 * DM); pb[sl] = *(const f32x4*)(qp + (size_t)sl * 512 * DM + 4); }
                    const f32x4 s0 = ((pa[0] + pa[1]) + (pa[2] + pa[3])) + ((pa[4] + pa[5]) + (pa[6] + pa[7])), s1 = ((pb[0] + pb[1]) + (pb[2] + pb[3])) + ((pb[4] + pb[5]) + (pb[6] + pb[7]));
                    u32x4 w; w.x = pk2(s0.x, s0.y); w.y = pk2(s0.z, s0.w); w.z = pk2(s1.x, s1.y); w.w = pk2(s1.z, s1.w); afr[pp][ks] = __builtin_bit_cast(bf16x8, w); }
        }
#pragma unroll
        for (int pp = 0; pp < 2; ++pp) {
            asm volatile("" ::: "memory"); __builtin_amdgcn_sched_barrier(0);
            f32x4 acc[8];
#pragma unroll
            for (int kt = 0; kt < 8; ++kt) acc[kt] = (f32x4){0.f, 0.f, 0.f, 0.f};
#pragma unroll
            for (int ks = 0; ks < 4; ++ks) { const bf16x8 a = afr[pp][ks];
#pragma unroll
                for (int kt = 0; kt < 8; ++kt) { const bf16x8 bb = *(const LAS bf16x8*)(SK + (pp * 128 + kt * 16 + fr) * SKP + ks * 32 + fq * 8); acc[kt] = __builtin_amdgcn_mfma_f32_16x16x32_bf16(a, bb, acc[kt], 0, 0, 0); } }
            unsigned kv[4][8];
#pragma unroll
            for (int g = 0; g < 4; ++g)
#pragma unroll
                for (int kt = 0; kt < 8; ++kt) kv[g][kt] = (f2key(acc[kt][g]) & ~127u) | (unsigned)(127 - (kt * 16 + fr));
#define CSWAP(a_, b_) do { const unsigned hi_ = a_ > b_ ? a_ : b_, lo_ = a_ > b_ ? b_ : a_; a_ = hi_; b_ = lo_; } while (0)
#pragma unroll
            for (int g = 0; g < 4; ++g) {
                CSWAP(kv[g][0], kv[g][1]); CSWAP(kv[g][2], kv[g][3]); CSWAP(kv[g][4], kv[g][5]); CSWAP(kv[g][6], kv[g][7]);
                CSWAP(kv[g][0], kv[g][2]); CSWAP(kv[g][1], kv[g][3]); CSWAP(kv[g][4], kv[g][6]); CSWAP(kv[g][5], kv[g][7]);
                CSWAP(kv[g][1], kv[g][2]); CSWAP(kv[g][5], kv[g][6]);
                CSWAP(kv[g][0], kv[g][4]); CSWAP(kv[g][1], kv[g][5]); CSWAP(kv[g][2], kv[g][6]); CSWAP(kv[g][3], kv[g][7]);
                CSWAP(kv[g][2], kv[g][4]); CSWAP(kv[g][3], kv[g][5]);
                CSWAP(kv[g][1], kv[g][2]); CSWAP(kv[g][3], kv[g][4]); CSWAP(kv[g][5], kv[g][6]);
            }
#undef CSWAP
            unsigned tk[4] = {0u, 0u, 0u, 0u};
#pragma unroll 1
            for (int it = 0; it < 16; ++it) {
#pragma unroll
                for (int g = 0; g < 4; ++g) {
                    const unsigned m = row16_max_u32(kv[g][0]);
                    tk[g] = fr == it ? m : tk[g];
                    const bool won = kv[g][0] == m;
#pragma unroll
                    for (int kt = 0; kt < 7; ++kt) kv[g][kt] = won ? kv[g][kt + 1] : kv[g][kt];
                    kv[g][7] = won ? 0u : kv[g][7];
                }
            }
#pragma unroll
            for (int g = 0; g < 4; ++g) tkp[pp][g] = tk[g];
        }
        float av[4], bv[4]; int ptr[4]; unsigned best[4];
#pragma unroll
        for (int g = 0; g < 4; ++g) { av[g] = key2f(tkp[0][g] & ~127u); bv[g] = key2f(tkp[1][g] & ~127u); ptr[g] = 0; best[g] = 0u; }
#pragma unroll 1
        for (int it = 0; it < 16; ++it) {
#pragma unroll
            for (int g = 0; g < 4; ++g) {
                const float bj = __shfl(bv[g], gbase + (ptr[g] & 15));
                const unsigned mine = ptr[g] < 16 ? ((f2key(av[g] + bj) & ~255u) | (unsigned)(255 - (fr * 16 + (ptr[g] & 15)))) : 0u;
                const unsigned m = row16_max_u32(mine);
                best[g] = fr == it ? m : best[g];
                ptr[g] += (m == mine) ? 1 : 0;
            }
        }
#pragma unroll
        for (int g = 0; g < 4; ++g) {
            const int bc = 255 - (int)(best[g] & 255u);
            const float bval = key2f(best[g] & ~255u);
            const int k1 = 127 - (int)(tkp[0][g] & 127u), k2 = 127 - (int)(tkp[1][g] & 127u);
            const int i1 = __shfl(k1, gbase + (bc >> 4)), i2 = __shfl(k2, gbase + (bc & 15));
            const float mx = __shfl(bval, gbase);
            const float ex = __expf(bval - mx);
            const float sm = row16_sum(ex);
            const size_t tok = (size_t)tile * 16 + fq * 4 + g;
            EIDX[tok * 128 + h * 16 + fr] = i1 * 128 + i2; EGATE[tok * 128 + h * 16 + fr] = ex / sm;
        }
    }
}

template <int CTRL> __device__ __forceinline__ float dppf(float x) { return __builtin_bit_cast(float, __builtin_amdgcn_mov_dpp(__builtin_bit_cast(int, x), CTRL, 0xf, 0xf, true)); }
__device__ __forceinline__ float rs_group8(float (&d)[8], bool b8) {
    asm volatile("s_nop 1\n\tv_permlane32_swap_b32 %0, %4\n\tv_permlane32_swap_b32 %1, %5\n\tv_permlane32_swap_b32 %2, %6\n\tv_permlane32_swap_b32 %3, %7"
                 : "+v"(d[0]), "+v"(d[1]), "+v"(d[2]), "+v"(d[3]), "+v"(d[4]), "+v"(d[5]), "+v"(d[6]), "+v"(d[7]));
    float s0 = d[0] + d[4], s1 = d[1] + d[5], s2 = d[2] + d[6], s3 = d[3] + d[7];
    asm volatile("s_nop 1\n\tv_permlane16_swap_b32 %0, %2\n\tv_permlane16_swap_b32 %1, %3" : "+v"(s0), "+v"(s1), "+v"(s2), "+v"(s3));
    const float t0 = s0 + s2, t1 = s1 + s3;
    const float m = b8 ? t1 : t0, o = b8 ? t0 : t1;
    return m + dppf<0x128>(o);
}
template <int CTRL> __device__ __forceinline__ float rs_merge(float a, float b, bool bit) { const float m = bit ? b : a, o = bit ? a : b; return m + dppf<CTRL>(o); }
constexpr int PG = 8;
__device__ __forceinline__ void phase_peer(const Params& p, int l, LAS unsigned char* lds, int tid, int lane, int wave, int bid, int G) {
    const int gw = bid * NWAVES + wave, NGW = G * NWAVES;
    const float* MOD = (const float*)(p.ws + WS_MOD);
    bf16_t* XL = (bf16_t*)(p.ws + WS_XL); bf16_t* HB = (bf16_t*)(p.ws + WS_HB);
    const float* lg = p.in[I_LNG] + (size_t)(l * 2 + 1) * DM; const float* lb = p.in[I_LNB] + (size_t)(l * 2 + 1) * DM;
    const unsigned char* UB = p.ws + WS_UB + (size_t)l * NEXP * ROWB_U; const unsigned char* VB = p.ws + WS_VB + (size_t)l * NEXP * ROWB_V;
    const float* USC = (const float*)(p.ws + WS_USC) + (size_t)l * NEXP; (void)USC; const float* VSC = (const float*)(p.ws + WS_VSC) + (size_t)l * NEXP; (void)VSC;
    const int* EIDX = (const int*)(p.ws + WS_EIDX); const float* EGATE = (const float*)(p.ws + WS_EGATE);
    const bool last = (l == DEPTH - 1);
    const int nrows = last ? TL : TA;
    constexpr int HLW = 64 * 33 * 4 + 128;
    LAS float* HL = (LAS float*)(lds + wave * HLW) + lane * 33;
    LAS int* PI = (LAS int*)((LAS float*)(lds + wave * HLW) + 64 * 33);
    LAS float* VEC = (LAS float*)(lds + 8 * HLW);
    for (int i = tid; i < 11 * DM / 4; i += NTHREADS) { const int vi = i / (DM / 4), c = (i % (DM / 4)) * 4; const int ln = last ? l : l + 1;
        const float* src = vi < 3 ? MOD + (size_t)(l * 3 + vi) * 6 * DM + 5 * DM + c : (vi < 9 ? MOD + (size_t)(ln * 3 + (vi % 3)) * 6 * DM + (vi / 3 - 1) * DM + c : (vi == 9 ? lg : lb) + c);
        *(LAS f32x4*)(VEC + vi * DM + c) = *(const f32x4*)src; }
    __syncthreads();
#if !TBL_U_FP4
    {
        float one = 1.0f; asm volatile("" : "+v"(one));
        f32x16 t0, t1;
#pragma unroll
        for (int c = 0; c < 32; ++c) { const float v = one * (c < 8 ? (float)c * 0.125f : (1.0f + (float)(c & 7) * 0.125f) * (float)(1 << ((c >> 3) - 1))); if (c < 16) t0[c] = v; else t1[c - 16] = v; }
        const u32x6 pw = pack_fp6_2x16(t0, t1);
        const f32x32 un = unpack_fp6_32(pw);
#pragma unroll
        for (int j = 0; j < 32; ++j) { const float y = un[j]; int c;
            if (y < 1.0f) c = (int)(y * 8.0f + 0.5f); else { const int e = y < 2.0f ? 0 : (y < 4.0f ? 1 : 2); c = 8 * (e + 1) + (int)((y / (float)(1 << e) - 1.0f) * 8.0f + 0.5f); }
            if (lane == 0) PI[j] = c & 31; }
        LDS_FENCE();
#if defined(DIAG_PI)
        { unsigned mk = 0u;
#pragma unroll
          for (int j = 0; j < 32; ++j) mk |= 1u << PI[j];
          if (mk != 0xFFFFFFFFu && l == 0 && gw == 0 && lane == 0) ((float*)(p.ws + WS_CTL + 131072))[0] = 1.0f; }
#endif
    }
#endif
    const unsigned ulane = (unsigned)lane & 63u, loff16 = ulane * 16u; (void)ulane; (void)loff16;
    const bool lb8 = (lane & 8) != 0, lb4 = (lane & 4) != 0, lb2 = (lane & 2) != 0, lb1 = (lane & 1) != 0; (void)lb8; (void)lb4; (void)lb2; (void)lb1;
    const int lsrc = ((lane & 6) << 3) | ((lane & 1) << 3) | (((lane >> 3) & 1) << 2) | (((lane >> 4) & 1) << 1) | ((lane >> 5) & 1); (void)lsrc;
    for (int r = row_first(wave, bid, G); r >= 0; r = row_next(r, wave, bid, G, nrows)) {
        const float* mod = MOD + (size_t)(l * 3 + row_stream(r)) * 6 * DM;
        f32x2v hn[16];
#pragma unroll
        for (int c = 0; c < 4; ++c) { float f[8]; unpack8(*(const u32x4*)(HB + (size_t)r * DM + lane * 32 + c * 8), f);
#pragma unroll
            for (int e = 0; e < 4; ++e) hn[c * 4 + e] = (f32x2v){f[2 * e], f[2 * e + 1]}; }
#if !TBL_U_FP4
#pragma unroll
        for (int j = 0; j < 16; ++j) { HL[2 * j] = hn[j].x; HL[2 * j + 1] = hn[j].y; }
        LDS_FENCE();
        f32x2v hf[16];
#pragma unroll
        for (int j = 0; j < 16; ++j) hf[j] = (f32x2v){HL[PI[2 * j]], HL[PI[2 * j + 1]]};
        LDS_FENCE();
#endif
#if TBL_U_I4
        int hlo[4], hhi[4]; unsigned basel;
        { float am = 0.f;
#pragma unroll
          for (int j = 0; j < 16; ++j) am = fmaxf(am, fmaxf(fabsf(hn[j].x), fabsf(hn[j].y)));
          const unsigned ab = __builtin_bit_cast(unsigned, am * (1.0f / 119.0f)); unsigned eb = (ab >> 23) + ((ab & 0x007fffffu) ? 1u : 0u); eb = eb < 1u ? 1u : (eb > 253u ? 253u : eb);
          const float inv = __builtin_bit_cast(float, (254u - eb) << 23);
          basel = U_ROWSCALE ? (eb << 23) : (I4_BASE + ((eb - 127u) << 23));
#pragma unroll
          for (int d = 0; d < 4; ++d) { unsigned tl = 0u, th = 0u;
#pragma unroll
              for (int e = 0; e < 8; ++e) { const f32x2v pr = hn[d * 4 + (e >> 1)]; const float xv = (e & 1) ? pr.y : pr.x;
                  const unsigned qb = __builtin_bit_cast(unsigned, xv * inv + 12582912.0f);
                  tl |= (qb & 15u) << (4 * e); th |= (((qb + 8u) >> 4) & 15u) << (4 * e); }
              hlo[d] = (int)tl; hhi[d] = (int)th; } }
#endif
        const int e0 = EIDX[(size_t)r * 128 + lane], e1 = EIDX[(size_t)r * 128 + 64 + lane];
        const float g0 = EGATE[(size_t)r * 128 + lane], g1 = EGATE[(size_t)r * 128 + 64 + lane];
#if !TBL_U_FP4 || U_ROWSCALE
        const float su0 = USC[e0], su1 = USC[e1];
#else
        const float su0 = 1.0f, su1 = 1.0f;
#endif
        float wgt[2] = {0.f, 0.f};
#define P4_LOAD(dq, ds, TB, eh, j0) do { unsigned lo_ = loff16, ul_ = ulane; asm volatile("" : "+v"(lo_), "+v"(ul_));    \
        _Pragma("unroll") for (int c = 0; c < PG; ++c) { const int e_ = __builtin_amdgcn_readlane(eh, (j0) + c); \
            const unsigned char* rp_ = (TB) + (size_t)e_ * ROWB4; dq[c] = *(const u32x4*)(rp_ + lo_); ds[c] = rp_[1024u + ul_]; } } while (0)
#if V_ROWSCALE
#define P4_LDV P4_LOADU
#else
#define P4_LDV P4_LOAD
#endif
#if U_ROWSCALE
#define P4_LDU P4_LOADU
#else
#define P4_LDU P4_LOAD
#endif
#define P4_LOADU(dq, ds, TB, eh, j0) do { const __amdgpu_buffer_rsrc_t rs_ = __builtin_amdgcn_make_buffer_rsrc((void*)(TB), 0, NEXP * 1024, 0x00020000); \
        _Pragma("unroll") for (int c = 0; c < PG; ++c) { const int e_ = __builtin_amdgcn_readlane(eh, (j0) + c); \
            dq[c] = __builtin_bit_cast(u32x4, __builtin_amdgcn_raw_buffer_load_b128(rs_, (int)loff16, (int)(((unsigned)e_ & 0x3fffu) << 10), 0)); ds[c] = e_; } } while (0)
#define P4_CVT(dq, c, d, b, sc) __builtin_amdgcn_cvt_scalef32_pk_f32_fp4(dq[c][d], sc, b)
#if TBL_U_I4
#define P4_DOT(dq, ds, rr) do { float d_[PG]; _Pragma("unroll") for (int c = 0; c < PG; ++c) { int t_ = 0;        \
            _Pragma("unroll") for (int d = 0; d < 4; ++d) t_ = __builtin_amdgcn_sdot8((int)dq[c][d], hhi[d], t_, false); \
            t_ <<= 4; \
            _Pragma("unroll") for (int d = 0; d < 4; ++d) t_ = __builtin_amdgcn_sdot8((int)dq[c][d], hlo[d], t_, false); \
            d_[c] = (float)t_ * (U_ROWSCALE ? __builtin_bit_cast(float, basel) : __builtin_bit_cast(float, ((unsigned)ds[c] << 20) + basel)); } \
        rr = rs_group8(d_, lb8); } while (0)
#else
#define P4_DOT(dq, ds, rr) do { float d_[PG]; _Pragma("unroll") for (int c = 0; c < PG; ++c) { const float sc_ = __builtin_bit_cast(float, (unsigned)ds[c] << 23); f32x2v a0_ = (f32x2v){0.f, 0.f}, a1_ = (f32x2v){0.f, 0.f}; \
            _Pragma("unroll") for (int d = 0; d < 4; ++d) { a0_ += P4_CVT(dq, c, d, 0, sc_) * hn[d * 4 + 0]; a1_ += P4_CVT(dq, c, d, 1, sc_) * hn[d * 4 + 1]; a0_ += P4_CVT(dq, c, d, 2, sc_) * hn[d * 4 + 2]; a1_ += P4_CVT(dq, c, d, 3, sc_) * hn[d * 4 + 3]; } \
            d_[c] = (a0_.x + a0_.y) + (a1_.x + a1_.y); asm volatile("" : "+v"(d_[c])); } \
        rr = rs_group8(d_, lb8); } while (0)
#endif
#define P4_AXPY(dq, ds, wh, j0) do { _Pragma("unroll") for (int c = 0; c < PG; ++c) { const float wj_ = V_ROWSCALE ? __builtin_bit_cast(float, (unsigned)ds[c] & 0xffff0000u) : __builtin_bit_cast(float, __builtin_amdgcn_readlane(wh, (j0) + c)); const f32x2v w2_ = (f32x2v){wj_, wj_}; \
            const float sc_ = V_ROWSCALE ? 1.0f : __builtin_bit_cast(float, (unsigned)ds[c] << 23); \
            _Pragma("unroll") for (int d = 0; d < 4; ++d) { yv[d * 4 + 0] += P4_CVT(dq, c, d, 0, sc_) * w2_; yv[d * 4 + 1] += P4_CVT(dq, c, d, 1, sc_) * w2_; yv[d * 4 + 2] += P4_CVT(dq, c, d, 2, sc_) * w2_; yv[d * 4 + 3] += P4_CVT(dq, c, d, 3, sc_) * w2_; } \
            asm volatile("" : "+v"(yv[0]), "+v"(yv[1]), "+v"(yv[2]), "+v"(yv[3]), "+v"(yv[4]), "+v"(yv[5]), "+v"(yv[6]), "+v"(yv[7]), "+v"(yv[8]), "+v"(yv[9]), "+v"(yv[10]), "+v"(yv[11]), "+v"(yv[12]), "+v"(yv[13]), "+v"(yv[14]), "+v"(yv[15]));   } } while (0)
#if !TBL_U_FP4
#define PEER_LOAD(dq, dd, TB, eh, j0) do { _Pragma("unroll") for (int c = 0; c < PG; ++c) { const int e_ = __builtin_amdgcn_readlane(eh, (j0) + c); \
            const unsigned char* rp_ = (TB) + (size_t)e_ * ROWB; dq[c] = *(const u32x4*)(rp_ + lane * 16); dd[c] = *(const u32x2*)(rp_ + 1024 + lane * 8); } } while (0)
#define PEER_UNPACK(dq, dd, c) unpack_fp6_32((u32x6){dq[c].x, dq[c].y, dq[c].z, dq[c].w, dd[c].x, dd[c].y})
#define PEER_DOT(dq, dd, j0) do { float d_[PG]; _Pragma("unroll") for (int c = 0; c < PG; ++c) { const f32x32 u_ = PEER_UNPACK(dq, dd, c); f32x2v a0_ = (f32x2v){0.f, 0.f}, a1_ = (f32x2v){0.f, 0.f}; \
            _Pragma("unroll") for (int t = 0; t < 8; ++t) { a0_ += (f32x2v){u_[4 * t], u_[4 * t + 1]} * hf[2 * t]; a1_ += (f32x2v){u_[4 * t + 2], u_[4 * t + 3]} * hf[2 * t + 1]; } \
            d_[c] = (a0_.x + a0_.y) + (a1_.x + a1_.y); __builtin_amdgcn_sched_barrier(0); } \
        _Pragma("unroll") for (int o = 1; o < 64; o <<= 1) { _Pragma("unroll") for (int c = 0; c < PG; ++c) d_[c] += __shfl_xor(d_[c], o); } \
        _Pragma("unroll") for (int c = 0; c < PG; ++c) wacc = (lane == (j0) + c) ? d_[c] : wacc; } while (0)
#endif
#pragma unroll
        for (int hh = 0; hh < 2; ++hh) {
            const int eh = hh ? e1 : e0; float wacc = 0.f;
#if TBL_U_FP4
            u32x4 qa[PG], qb[PG]; int sa[PG], sb[PG];
            P4_LDU(qa, sa, UB, eh, 0);
            float wq = 0.f, wp = 0.f;
#pragma unroll 1
            for (int j0 = 0; j0 < 64; j0 += 2 * PG) {
                float ra, rb;
                P4_LDU(qb, sb, UB, eh, j0 + PG);
                P4_DOT(qa, sa, ra);
                if (j0 + 2 * PG < 64) P4_LDU(qa, sa, UB, eh, j0 + 2 * PG);
                P4_DOT(qb, sb, rb);
                const float q = rs_merge<0x141>(ra, rb, lb4);
                if ((j0 & 16) == 0) wq = q;
                else { const float pm = rs_merge<0x4E>(wq, q, lb2);
                       if (j0 == 16) wp = pm; else wacc = rs_merge<0xB1>(wp, pm, lb1); }
            }
            wacc = __shfl(wacc, lsrc);
#else
            u32x4 qa[PG], qb[PG]; u32x2 da[PG], db[PG];
            PEER_LOAD(qa, da, UB, eh, 0);
#pragma unroll 1
            for (int j0 = 0; j0 < 64; j0 += 2 * PG) {
                PEER_LOAD(qb, db, UB, eh, j0 + PG);
                PEER_DOT(qa, da, j0);
                if (j0 + 2 * PG < 64) PEER_LOAD(qa, da, UB, eh, j0 + 2 * PG);
                PEER_DOT(qb, db, j0 + PG);
            }
#endif
            wgt[hh] = gelu_f(wacc * (hh ? su1 : su0)) * (hh ? g1 : g0) * (V_ROWSCALE ? VSC[eh] : 1.0f);
        }
        f32x2v yv[16];
#pragma unroll
        for (int i = 0; i < 16; ++i) yv[i] = (f32x2v){0.f, 0.f};
#pragma unroll
        for (int hh = 0; hh < 2; ++hh) {
            const int eh = V_ROWSCALE ? ((hh ? e1 : e0) | (int)((__builtin_bit_cast(unsigned, wgt[hh]) + 0x8000u) & 0xffff0000u)) : (hh ? e1 : e0); const int wh = __builtin_bit_cast(int, wgt[hh]); (void)wh;
            u32x4 qa[PG], qb[PG]; int sa[PG], sb[PG];
            P4_LDV(qa, sa, VB, eh, 0);
#pragma unroll 1
            for (int j0 = 0; j0 < 64; j0 += 2 * PG) {
                P4_LDV(qb, sb, VB, eh, j0 + PG);
                P4_AXPY(qa, sa, wh, j0);
                if (j0 + 2 * PG < 64) P4_LDV(qa, sa, VB, eh, j0 + 2 * PG);
                P4_AXPY(qb, sb, wh, j0 + PG);
            }
        }
#undef P4_LOAD
#undef P4_CVT
#undef P4_DOT
#undef P4_AXPY
#if !TBL_U_FP4
#undef PEER_LOAD
#undef PEER_UNPACK
#undef PEER_DOT
#endif
        const int st = row_stream(r);
        const bf16_t* xr = (const bf16_t*)(p.ws + WS_XM) + (size_t)r * DM + lane * 32;
        f32x4 xv[8];
#pragma unroll
        for (int t = 0; t < 4; ++t) { const u32x4 w = *(const u32x4*)(xr + t * 8); xv[2 * t] = (f32x4){bflo(w.x), bfhi(w.x), bflo(w.y), bfhi(w.y)}; xv[2 * t + 1] = (f32x4){bflo(w.z), bfhi(w.z), bflo(w.w), bfhi(w.w)}; }
        float s = 0.f;
#pragma unroll
        for (int t = 0; t < 8; ++t) { const f32x4 ga = *(const LAS f32x4*)(VEC + st * DM + lane * 32 + t * 4);
            f32x2v& ya = yv[t * 2]; f32x2v& yb = yv[t * 2 + 1];
            ya.x = xv[t].x * DN_ALPHA + ga.x * ya.x; ya.y = xv[t].y * DN_ALPHA + ga.y * ya.y; yb.x = xv[t].z * DN_ALPHA + ga.z * yb.x; yb.y = xv[t].w * DN_ALPHA + ga.w * yb.y;
            s += (ya.x + ya.y) + (yb.x + yb.y); }
        const float mean = wave_sum(s) * (1.0f / DM);
        float s2 = 0.f;
#pragma unroll
        for (int i = 0; i < 16; ++i) { yv[i] = yv[i] - mean; s2 += yv[i].x * yv[i].x + yv[i].y * yv[i].y; }
        const float rstd = 1.0f / sqrtf(wave_sum(s2) * (1.0f / DM) + LN_EPS);
        float* dst = p.out + (size_t)r * DM + lane * 32; bf16_t* dstb = XL + (size_t)r * DM + lane * 32;
#pragma unroll
        for (int t = 0; t < 8; t += 2) { const int c = t * 4;
            const f32x4 ga = *(const LAS f32x4*)(VEC + 9 * DM + lane * 32 + c), gb = *(const LAS f32x4*)(VEC + 9 * DM + lane * 32 + c + 4), ba = *(const LAS f32x4*)(VEC + 10 * DM + lane * 32 + c), bb = *(const LAS f32x4*)(VEC + 10 * DM + lane * 32 + c + 4);
            const f32x2v y0 = yv[t * 2], y1 = yv[t * 2 + 1], y2 = yv[t * 2 + 2], y3 = yv[t * 2 + 3];
            f32x4 o0, o1;
            o0.x = y0.x * rstd * ga.x + ba.x; o0.y = y0.y * rstd * ga.y + ba.y; o0.z = y1.x * rstd * ga.z + ba.z; o0.w = y1.y * rstd * ga.w + ba.w;
            o1.x = y2.x * rstd * gb.x + bb.x; o1.y = y2.y * rstd * gb.y + bb.y; o1.z = y3.x * rstd * gb.z + bb.z; o1.w = y3.y * rstd * gb.w + bb.w;
            if (last) { *(f32x4*)(dst + c) = o0; *(f32x4*)(dst + c + 4) = o1; }
            else { u32x4 xw; xw.x = pk2(o0.x, o0.y); xw.y = pk2(o0.z, o0.w); xw.z = pk2(o1.x, o1.y); xw.w = pk2(o1.z, o1.w); *(u32x4*)(dstb + c) = xw; }
            if (!last) {
                const f32x4 sa = *(const LAS f32x4*)(VEC + (3 + st) * DM + lane * 32 + c), sb = *(const LAS f32x4*)(VEC + (3 + st) * DM + lane * 32 + c + 4), ca = *(const LAS f32x4*)(VEC + (6 + st) * DM + lane * 32 + c), cb = *(const LAS f32x4*)(VEC + (6 + st) * DM + lane * 32 + c + 4);
                u32x4 o; o.x = pk2(o0.x * (1.f + ca.x) + sa.x, o0.y * (1.f + ca.y) + sa.y); o.y = pk2(o0.z * (1.f + ca.z) + sa.z, o0.w * (1.f + ca.w) + sa.w);
                o.z = pk2(o1.x * (1.f + cb.x) + sb.x, o1.y * (1.f + cb.y) + sb.y); o.w = pk2(o1.z * (1.f + cb.z) + sb.z, o1.w * (1.f + cb.w) + sb.w);
                *(u32x4*)(HB + (size_t)r * DM + lane * 32 + c) = o; }
        }
#if defined(DIAG_PI)
        if (last && r == 5 && lane == 0 && ((const float*)(p.ws + WS_CTL + 131072))[0] != 0.0f) p.out[(size_t)5 * DM] = __builtin_nanf("");
#endif
    }
}

__device__ __forceinline__ void gemm_rows_bf16(LAS unsigned char* lds, const bf16_t* A, const bf16_t* Bt, bf16_t* C, float* Cpart, bool with_ctx, int G, int bid) {
    { pg8::Gemm g{A, Bt, TL, DM, DM, DM}; pg8::StaticOrder S; S.init(TL, DM, G, bid); pg8::EpiBf16<0> E{C, DM, nullptr, 0, 0, 1.f};
      pg8::gemm_phase<pg8::EpiBf16<0>, pg8::StaticOrder, PG8_ALIGN, PG8_SP2>(lds, g, S, E); }
    if (with_ctx) { int ksl = 256; asm volatile("" : "+s"(ksl));
      pg8::Gemm g{A + (size_t)TL * DM, Bt, TC, DM, ksl, DM}; pg8::SplitKOrder S; S.init(G, bid); pg8::EpiF32Part E{Cpart};
      pg8::gemm_phase<pg8::EpiF32Part, pg8::SplitKOrder, PG8_ALIGN, PG8_SP2>(lds, g, S, E); }
}

constexpr int PH_PER_LAYER = 9, N_PHASES = 2 + DEPTH * PH_PER_LAYER;
__global__ void __launch_bounds__(NTHREADS, 2) fwd_kernel(Params p) {
    extern __shared__ __attribute__((aligned(16))) unsigned char lds_raw[];
    LAS unsigned char* lds = (LAS unsigned char*)lds_raw;
    const int tid = threadIdx.x, lane = tid & 63, wave = __builtin_amdgcn_readfirstlane(tid >> 6), bid = blockIdx.x, G = gridDim.x;
    volatile LAS unsigned* MISC = (volatile LAS unsigned*)(lds + MISC_OFF);
    if (tid < 32) MISC[tid] = 0u;
    __syncthreads();
    if (hipThreadIdx_x == 0) (void)xb_add(&((unsigned*)(p.ws + WS_CTL))[CW_BAR + XB_XCNT(xb_xcc_id())], 1u);
#define IN(k) true
#if defined(PROBE_MASK)
    volatile LAS unsigned long long* PT = (volatile LAS unsigned long long*)(lds + MISC_OFF + 96);
    if (tid == 0) PT[0] = __builtin_amdgcn_s_memrealtime();
#define SEAM(k) do { { XcdBarrier bar_; bar_.bar = (unsigned*)(((const __attribute__((address_space(4))) Params*)__builtin_amdgcn_kernarg_segment_ptr())->ws + WS_CTL) + CW_BAR; bar_.x = xb_xcc_id(); bar_.st = MISC + 8; xcd_barrier(bar_); } if (bid == 0) { const int kind_ = (k) < 2 ? (k) : 2 + ((k) - 2) % PH_PER_LAYER; \
        if (tid == 0) { const unsigned long long now_ = __builtin_amdgcn_s_memrealtime(); if ((PROBE_MASK >> kind_) & 1) { const unsigned long long d_ = (now_ - PT[0]) * PROBE_MULT; \
            while (__builtin_amdgcn_s_memrealtime() - now_ < d_) __builtin_amdgcn_s_sleep(8); } PT[0] = __builtin_amdgcn_s_memrealtime(); } __syncthreads(); } } while (0)
#elif defined(PROBE_DUP_BAR)
#define SEAM(k) do { XcdBarrier bar_; bar_.bar = (unsigned*)(((const __attribute__((address_space(4))) Params*)__builtin_amdgcn_kernarg_segment_ptr())->ws + WS_CTL) + CW_BAR; bar_.x = xb_xcc_id(); bar_.st = MISC + 8; xcd_barrier(bar_); xcd_barrier(bar_); } while (0)
#else
#define SEAM(k) do { XcdBarrier bar_; bar_.bar = (unsigned*)(((const __attribute__((address_space(4))) Params*)__builtin_amdgcn_kernarg_segment_ptr())->ws + WS_CTL) + CW_BAR; bar_.x = xb_xcc_id(); bar_.st = MISC + 8; xcd_barrier(bar_); } while (0)
#endif
    const int NGW = G * NWAVES;
#if defined(__HIP_DEVICE_COMPILE__)
#define KARGS_COPY const Params p_ = *kp_
#else
#define KARGS_COPY const Params p_ = p; (void)kp_
#endif
#define FRESH() int tid_ = threadIdx.x, bid_ = blockIdx.x; asm volatile("" : "+v"(tid_), "+s"(bid_)); const int lane_ = tid_ & 63, wave_ = __builtin_amdgcn_readfirstlane(tid_ >> 6); (void)lane_; (void)wave_; \
    const __attribute__((address_space(4))) Params* kp_ = (const __attribute__((address_space(4))) Params*)__builtin_amdgcn_kernarg_segment_ptr(); asm volatile("" : "+s"(kp_)); KARGS_COPY
    if (IN(0)) { FRESH(); phase_prologue(p_, lds, tid_, lane_, wave_, bid_, G); }
    SEAM(0);
    if (IN(1)) { FRESH(); phase_modulate0(p_, lane_, wave_, bid_, G); }
    SEAM(1);
    for (int l = 0; l < DEPTH; ++l) {
        const int b0 = 2 + l * PH_PER_LAYER;
        if (IN(b0 + 0)) { FRESH();
            pg8::Gemm g{(const bf16_t*)(p_.ws + WS_HB), (const bf16_t*)(p_.ws + WS_WIN) + (size_t)l * INWP * DM, TA, INWP, DM, DM}; pg8::StaticOrder S; S.init(TA, INWP, G, bid_);
            pg8::EpiBf16<0> E{(bf16_t*)(p_.ws + WS_P), INWP, nullptr, 0, 0, 1.f};
            pg8::gemm_phase<pg8::EpiBf16<0>, pg8::StaticOrder, PG8_ALIGN, PG8_SP2>(lds, g, S, E);
#if defined(PROBE_DUP_GEMM)
            __syncthreads(); pg8::gemm_phase<pg8::EpiBf16<0>, pg8::StaticOrder, PG8_ALIGN, PG8_SP2>(lds, g, S, E);
#endif
        }
        SEAM(b0 + 0);
        if (IN(b0 + 1)) { { FRESH(); gla_g1(p_, l, lds, tid_, lane_, wave_, bid_, G); } { FRESH(); phase_post_in(p_, l, lane_, wave_, bid_, G); } }
#if defined(PROBE_DUP_A)
        if (IN(b0 + 1)) { __syncthreads(); { FRESH(); gla_g1(p_, l, lds, tid_, lane_, wave_, bid_, G); } { FRESH(); phase_post_in(p_, l, lane_, wave_, bid_, G); } }
#endif
        SEAM(b0 + 1);
        if (IN(b0 + 2)) {
            unsigned* ctl_ = (unsigned*)(((const __attribute__((address_space(4))) Params*)__builtin_amdgcn_kernarg_segment_ptr())->ws + WS_CTL);
            { FRESH(); gla_g2(p_, tid_, bid_, G);
              if (bid_ < 64) { asm volatile("s_waitcnt vmcnt(0)" ::: "memory"); __syncthreads();
                  if (tid_ == 0) { __builtin_amdgcn_fence(__ATOMIC_RELEASE, "agent"); asm volatile("s_waitcnt vmcnt(0)" ::: "memory"); (void)xb_add(ctl_ + CW_QUEUE + 64 * (12 + l), 1u); } } }
            { FRESH(); phase_mixers(p_, l, lds, tid_, lane_, wave_, bid_, G); }
            { FRESH();
              if (tid_ == 0) { unsigned* bar = ctl_ + CW_BAR; XB_SPIN(xb_ld(ctl_ + CW_QUEUE + 64 * (12 + l)) < (G < 64 ? (unsigned)G : 64u), bar);
                  __builtin_amdgcn_fence(__ATOMIC_ACQUIRE, "agent"); asm volatile("s_waitcnt vmcnt(0)" ::: "memory"); }
              __syncthreads();
              gla_g3(p_, l, lds, tid_, lane_, wave_, bid_, G, ctl_ + CW_QUEUE + 64 * (8 + l)); }
        }
#if defined(PROBE_DUP_B)
        if (IN(b0 + 2)) { __syncthreads(); { FRESH(); gla_g2(p_, tid_, bid_, G); } { FRESH(); phase_mixers(p_, l, lds, tid_, lane_, wave_, bid_, G, 1); } }
#endif
#if defined(PROBE_DUP_C)
        if (IN(b0 + 3)) { __syncthreads(); FRESH(); gla_g3(p_, l, lds, tid_, lane_, wave_, bid_, G); }
#endif
        SEAM(b0 + 3);
        if (IN(b0 + 4)) { FRESH();
            gemm_rows_bf16(lds, (const bf16_t*)(p_.ws + WS_MIX), (const bf16_t*)(p_.ws + WS_WOUT) + (size_t)l * DM * DM, (bf16_t*)(p_.ws + WS_Y), (float*)(p_.ws + WS_YPART), l < DEPTH - 1, G, bid_);
#if defined(PROBE_DUP_GEMM)
            __syncthreads(); gemm_rows_bf16(lds, (const bf16_t*)(p_.ws + WS_MIX), (const bf16_t*)(p_.ws + WS_WOUT) + (size_t)l * DM * DM, (bf16_t*)(p_.ws + WS_Y), (float*)(p_.ws + WS_YPART), l < DEPTH - 1, G, bid_);
#endif
        }
        SEAM(b0 + 4);
        if (IN(b0 + 5)) { FRESH(); phase_ln1(p_, l, lds, tid_, lane_, wave_, bid_, G); }
#if defined(PROBE_DUP_E)
        if (IN(b0 + 5)) { __syncthreads(); FRESH(); phase_ln1(p_, l, lds, tid_, lane_, wave_, bid_, G); }
#endif
        SEAM(b0 + 5);
        if (IN(b0 + 6)) { FRESH();
            gemm_rows_bf16(lds, (const bf16_t*)(p_.ws + WS_HB), (const bf16_t*)(p_.ws + WS_WQ) + (size_t)l * DM * DM, (bf16_t*)(p_.ws + WS_QP), (float*)(p_.ws + WS_QPART), l < DEPTH - 1, G, bid_);
#if defined(PROBE_DUP_GEMM)
            __syncthreads(); gemm_rows_bf16(lds, (const bf16_t*)(p_.ws + WS_HB), (const bf16_t*)(p_.ws + WS_WQ) + (size_t)l * DM * DM, (bf16_t*)(p_.ws + WS_QP), (float*)(p_.ws + WS_QPART), l < DEPTH - 1, G, bid_);
#endif
        }
        SEAM(b0 + 6);
        if (IN(b0 + 7)) { FRESH(); peer_retrieve(p_, l, lds, tid_, lane_, wave_, bid_, G, l < DEPTH - 1 ? TA : TL); }
#if defined(PROBE_DUP_D)
        if (IN(b0 + 7)) { __syncthreads(); FRESH(); peer_retrieve(p_, l, lds, tid_, lane_, wave_, bid_, G, l < DEPTH - 1 ? TA : TL); }
#endif
        SEAM(b0 + 7);
        if (IN(b0 + 8)) { FRESH(); phase_peer(p_, l, lds, tid_, lane_, wave_, bid_, G); }
        if (l < DEPTH - 1) SEAM(b0 + 8);
    }
#undef FRESH
#undef IN
#undef SEAM
}

#ifndef MK_PER_PHASE
#define MK_PER_PHASE 0
#endif
extern "C" void kernel_launch(void* const* d_in, const int* in_sizes, int n_in, void* d_out, int out_size, void* d_ws, size_t ws_size, hipStream_t stream) {
    static int grid = 0;
    if (grid == 0) {
        if (n_in != 19 || out_size != TL * DM || ws_size < WS_END) { fprintf(stderr, "kernel_launch: unexpected shapes (n_in %d out %d ws %zu)\n", n_in, out_size, ws_size); grid = -1; return; }
        int dev = 0, cus = 0;
        if (hipGetDevice(&dev) != hipSuccess || hipDeviceGetAttribute(&cus, hipDeviceAttributeMultiprocessorCount, dev) != hipSuccess) { grid = -1; return; }
        if (hipFuncSetAttribute((const void*)fwd_kernel, hipFuncAttributeMaxDynamicSharedMemorySize, LDS_BYTES) != hipSuccess) { fprintf(stderr, "kernel_launch: hipFuncSetAttribute failed\n"); grid = -1; return; }
        int per_cu = 0;
        (void)hipOccupancyMaxActiveBlocksPerMultiprocessor(&per_cu, (const void*)fwd_kernel, NTHREADS, LDS_BYTES);
        (void)hipGetLastError();
        if (per_cu < 1) fprintf(stderr, "kernel_launch: occupancy query reports %d blocks per CU\n", per_cu);
        grid = cus;
    }
    if (grid < 0) return;
    (void)hipMemsetAsync((char*)d_ws + WS_CTL, 0, CTL_ZERO_BYTES, stream);
    Params p{};
    for (int i = 0; i < 19; ++i) p.in[i] = (const float*)d_in[i];
    p.out = (float*)d_out; p.ws = (unsigned char*)d_ws;
#if MK_PER_PHASE
    for (int ph = 0; ph < N_PHASES; ++ph) { p.ph_lo = ph; p.ph_hi = ph + 1; hipLaunchKernelGGL(fwd_kernel, dim3(grid), dim3(NTHREADS), LDS_BYTES, stream, p); }
#else
    p.ph_lo = 0; p.ph_hi = N_PHASES;
    hipLaunchKernelGGL(fwd_kernel, dim3(grid), dim3(NTHREADS), LDS_BYTES, stream, p);
#endif
}
```

```cpp
#include <hip/hip_runtime.h>
#include <cstdio>
#include <cstdint>

#define LAS __attribute__((address_space(3)))
typedef unsigned short bf16_t;
typedef short bf16x8 __attribute__((ext_vector_type(8)));
typedef float f32x4 __attribute__((ext_vector_type(4)));
typedef unsigned u32x4 __attribute__((ext_vector_type(4)));
typedef unsigned u32x2 __attribute__((ext_vector_type(2)));
typedef unsigned u32x6 __attribute__((ext_vector_type(6)));
typedef float f32x2v __attribute__((ext_vector_type(2)));
typedef float f32x16 __attribute__((ext_vector_type(16)));
typedef float f32x32 __attribute__((ext_vector_type(32)));

constexpr int DM = 2048, NBATCH = 2, SEQ = 8192, DEPTH = 4, CTXL = 256;
constexpr int TL = NBATCH * SEQ, TC = NBATCH * CTXL, TA = TL + TC;
constexpr int INW = 4640, INWP = 4864;
constexpr int C_CX = 0, C_CB = 512, C_CC = 1024, C_GQ = 1536, C_GK = 1792, C_GV = 2048, C_GG = 2560, C_LRF = 3072, C_LRB = 3088,
              C_SQ = 3104, C_SK = 4128, C_SV = 4384;
constexpr int NEXP = 16384;
constexpr int ROWB = 1536;
constexpr int ROWB4 = 1088;
#ifndef TBL_U_FP4
#define TBL_U_FP4 1
#endif
#ifndef TBL_U_I4
#define TBL_U_I4 (TBL_U_FP4)
#endif
constexpr unsigned I4_BASE = 103u << 23;
#ifndef U_ROWSCALE
#define U_ROWSCALE (TBL_U_I4)
#endif
#ifndef V_ROWSCALE
#define V_ROWSCALE 1
#endif
constexpr int ROWB_U = U_ROWSCALE ? 1024 : (TBL_U_FP4 ? ROWB4 : ROWB), ROWB_V = V_ROWSCALE ? 1024 : ROWB4;
constexpr float DN_ALPHA = 1.6817928305074290f;
constexpr float LN_EPS = 1e-6f;
constexpr int NWAVES = 8, NTHREADS = 512;

constexpr size_t MiB = 1u << 20;
constexpr size_t WS_CTL = 0, CTL_ZERO_BYTES = 256 * 1024;
constexpr size_t WS_MOD = 2 * MiB;
constexpr size_t WS_WIN = 4 * MiB;
constexpr size_t WS_WOUT = 80 * MiB;
constexpr size_t WS_WQ = 112 * MiB;
constexpr size_t WS_XL = 144 * MiB;
constexpr size_t WS_HB = 276 * MiB;
constexpr size_t WS_P = 342 * MiB;
constexpr size_t WS_QR = 656 * MiB;
constexpr size_t WS_KR = 720 * MiB;
constexpr size_t WS_ALF = 736 * MiB;
constexpr size_t WS_ALB = 753 * MiB;
constexpr size_t WS_OF = 770 * MiB;
constexpr size_t WS_OB = 803 * MiB;
constexpr size_t WS_MIX = 836 * MiB;
constexpr size_t WS_Y = 902 * MiB;
constexpr size_t WS_QP = 1034 * MiB;
constexpr size_t WS_DELTA = 1166 * MiB;
constexpr size_t WS_DEC = 1233 * MiB;
constexpr size_t WS_SST = 1234 * MiB;
constexpr size_t WS_UB = 1268 * MiB;
constexpr size_t WS_VB = 1524 * MiB;
constexpr size_t WS_EIDX = 1780 * MiB;
constexpr size_t WS_EGATE = 1789 * MiB;
constexpr size_t WS_SUBB = 1798 * MiB;
constexpr size_t WS_USC = 1799 * MiB;
constexpr size_t WS_VSC = 1799 * MiB + 512 * 1024;
constexpr size_t WS_YPART = 1800 * MiB;
constexpr size_t WS_QPART = 1832 * MiB;
constexpr size_t WS_XM = 1864 * MiB;
constexpr size_t WS_END = 1996 * MiB;
constexpr int GLA_ITEMS = (TA / 64) * 4;
static_assert(WS_DELTA + (size_t)GLA_ITEMS * 2 * 8192 * 4 <= WS_DEC && WS_DEC + (size_t)GLA_ITEMS * 2 * 64 * 4 <= WS_SST && WS_SST + (size_t)GLA_ITEMS * 2 * 8192 * 2 <= WS_END, "map");
static_assert(WS_WIN + (size_t)4 * INWP * DM * 2 <= WS_WOUT, "map");
static_assert(WS_P + (size_t)TA * INWP * 2 <= WS_QR, "map");
static_assert(WS_XL + (size_t)TA * DM * 4 <= WS_HB, "map");
constexpr int CW_BAR = 4096;
constexpr int CW_QUEUE = 8192;
constexpr int LDS_BYTES = 163840;
constexpr int MISC_OFF = 163840 - 512;

#define XB_TMO      128
#define XB_XCNT(j)  (256  + 64 * (j))
#define XB_XSUB(j)  (1280 + 64 * (j))
#define XB_XGEN(j)  (2304 + 64 * (j))
#define XB_TOP      3328
#define XB_TOPGEN   3392
#define XCD_BAR_WORDS 3456
#define XB_SPIN_CAP (1u << 18)
__device__ __forceinline__ unsigned xb_ld(unsigned* p)              { return __hip_atomic_load(p, __ATOMIC_RELAXED, __HIP_MEMORY_SCOPE_AGENT); }
__device__ __forceinline__ unsigned xb_add(unsigned* p, unsigned v) { return __hip_atomic_fetch_add(p, v, __ATOMIC_RELAXED, __HIP_MEMORY_SCOPE_AGENT); }
__device__ __forceinline__ unsigned xb_xcc_id() { return (unsigned)__builtin_amdgcn_s_getreg((3 << 11) | 20) & 0xFu; }
#define XB_SPIN(cond, bar) do { unsigned _sp = 0; while (cond) { __builtin_amdgcn_s_sleep(1); \
    if ((++_sp & 255u) == 0u) { if (xb_ld(&(bar)[XB_TMO])) break; if (_sp > XB_SPIN_CAP) { atomicAdd(&(bar)[XB_TMO], 1u); break; } } } } while (0)
struct XcdBarrier { unsigned* bar; unsigned x; volatile LAS unsigned* st; };
__device__ __forceinline__ XcdBarrier xcd_barrier_post(unsigned* bar, volatile LAS unsigned* st) {
    XcdBarrier b; b.bar = bar; b.x = xb_xcc_id(); b.st = st;
    if (threadIdx.x == 0) (void)xb_add(&bar[XB_XCNT(b.x)], 1u);
    return b;
}
__device__ __forceinline__ void xcd_barrier_complete(unsigned* bar, unsigned x, unsigned& nloc, unsigned& nx) {
    const unsigned G = gridDim.x * gridDim.y * gridDim.z;
    unsigned sum, cnt, mine, sp = 0u;
    for (;;) {
        sum = 0u; cnt = 0u; mine = 0u;
#pragma unroll
        for (unsigned j = 0; j < 16; ++j) { const unsigned c = xb_ld(&bar[XB_XCNT(j)]); sum += c; cnt += (c > 0u) ? 1u : 0u; mine = (j == x) ? c : mine; }
        if (sum == G) break;
        __builtin_amdgcn_s_sleep(1);
        if ((++sp & 255u) == 0u) { if (xb_ld(&bar[XB_TMO])) break; if (sp > XB_SPIN_CAP) { atomicAdd(&bar[XB_TMO], 1u); break; } }
    }
    nloc = mine > 0u ? mine : 1u; nx = cnt > 0u ? cnt : 1u;
}
__device__ __forceinline__ void xcd_barrier(const XcdBarrier& b) {
    asm volatile("s_waitcnt vmcnt(0)" ::: "memory");
    __syncthreads();
    if (threadIdx.x == 0) {
        unsigned* bar = b.bar;
        __builtin_amdgcn_s_waitcnt(0);
        unsigned nloc = b.st[0], nx = b.st[1];
        if (nloc == 0u) { xcd_barrier_complete(bar, b.x, nloc, nx); b.st[0] = nloc; b.st[1] = nx; }
        const unsigned old = xb_add(&bar[XB_XSUB(b.x)], 1u);
        const unsigned gen = old / nloc;
        if (old + 1u == (gen + 1u) * nloc) {
            __builtin_amdgcn_fence(__ATOMIC_RELEASE, "agent");
            asm volatile("s_waitcnt vmcnt(0)" ::: "memory");
            const unsigned og = xb_add(&bar[XB_TOP], 1u);
            const unsigned tg = og / nx;
            if (og + 1u == (tg + 1u) * nx) xb_add(&bar[XB_TOPGEN], 1u);
            else XB_SPIN(xb_ld(&bar[XB_TOPGEN]) == tg, bar);
            __builtin_amdgcn_fence(__ATOMIC_ACQUIRE, "agent");
            xb_add(&bar[XB_XGEN(b.x)], 1u);
            asm volatile("s_waitcnt vmcnt(0)" ::: "memory");
        } else {
            XB_SPIN(xb_ld(&bar[XB_XGEN(b.x)]) == gen, bar);
            __builtin_amdgcn_fence(__ATOMIC_ACQUIRE, "agent");
            asm volatile("s_waitcnt vmcnt(0)" ::: "memory");
        }
    }
    __syncthreads();
}

namespace pg8 {
#define PG8_LAS __attribute__((address_space(3)))
typedef unsigned short bf16_t;
typedef short bf16x8 __attribute__((ext_vector_type(8)));
typedef float f32x4 __attribute__((ext_vector_type(4)));
typedef unsigned u32x4 __attribute__((ext_vector_type(4)));
constexpr int BM = 256, BK = 64, HALF = 128, HTB = HALF * BK * 2  , STAGE_BYTES = 8 * HTB, NXCD = 8, WGM = 8;

__host__ __device__ __forceinline__ int lds_byte(int r, int c) { const int st = (r >> 4) * 2 + (c >> 5), rr = r & 15, cc = c & 31, ob = rr * 64 + cc * 2; return st * 1024 + (ob ^ (((ob >> 9) & 1) << 5)); }
__host__ __device__ __forceinline__ void stage_rc(int b, int& R, int& C) { const int st = b / 1024, sb = b % 1024, swz = sb ^ (((sb >> 9) & 1) << 5); R = (st >> 1) * 16 + swz / 64; C = (st & 1) * 32 + (swz % 64) / 2; }
__host__ __device__ __forceinline__ int perm32(int rho) { const int n = rho >> 4, i = rho & 15; return 8 * (i >> 2) + 4 * n + (i & 3); }

struct Unit { int pm, pn, kofs; };
struct Gemm { const bf16_t* A; const bf16_t* Bt; int M, N, K, ld; };

struct StaticOrder {
    int nM, nN, nwg, G, c;
    __host__ __device__ void init(int M, int N, int G_, int c_) { nM = M / BM; nN = N / BM; nwg = nM * nN; G = G_; c = c_; }
    __host__ __device__ bool next(int i, Unit& u) const {
        const long L = (long)i * G + c; if (L >= nwg) return false;
        int wgid = (int)L; { const int q = nwg / NXCD, r = nwg % NXCD, xcd = wgid % NXCD, off = wgid / NXCD; wgid = (xcd < r ? xcd * (q + 1) : r * (q + 1) + (xcd - r) * q) + off; }
        const int nig = WGM * nN, gid = wgid / nig, fm = gid * WGM, gsz = (nM - fm) < WGM ? (nM - fm) : WGM;
        u.pm = fm + ((wgid % nig) % gsz); u.pn = (wgid % nig) / gsz; u.kofs = 0; return true;
    }
    __device__ __forceinline__ void a_ready(const Unit&) const {}
    __device__ __forceinline__ void done(const Unit&) const {}
};

__device__ __forceinline__ unsigned cvt_pk_bf16(float lo, float hi) { unsigned r; asm volatile("v_cvt_pk_bf16_f32 %0, %1, %2" : "=v"(r) : "v"(lo), "v"(hi)); return r; }
typedef float f32x2 __attribute__((ext_vector_type(2)));
__device__ __forceinline__ f32x2 gelu_pk(f32x2 v) {
    const f32x2 av = __builtin_elementwise_abs(v), d = av * 0.2316418882f + 1.0f;
    f32x2 t; t.x = __builtin_amdgcn_rcpf(d.x); t.y = __builtin_amdgcn_rcpf(d.y);
    f32x2 q = t * 0.5307027145f + (-0.7265760135f); q = q * t + 0.7107068705f; q = q * t + (-0.142248368f); q = q * t + 0.127414796f; q = q * t;
    const f32x2 s = (v * v) * (-0.72134752044f);
    f32x2 e; e.x = __builtin_amdgcn_exp2f(s.x); e.y = __builtin_amdgcn_exp2f(s.y);
    const f32x2 m = v * (q * e), r = v - m;
    f32x2 o; o.x = v.x < 0.f ? m.x : r.x; o.y = v.y < 0.f ? m.y : r.y; return o;
}

template <int ACT  > struct EpiBf16 {
    static constexpr bool PERM = true, AFTER_DRAIN = false; static_assert(ACT == 0 || ACT == 1, "EpiBf16: ACT is 0 (none) or 1 (gelu_pk)");
    bf16_t* O; int ldc; const float* bias; int split_cols; size_t split_stride; float scale0;
    __device__ __forceinline__ void operator()(const f32x4 (&acc)[2][2][4][2], const Unit& u, int wr, int wc, int fr, int fq) const {
        const int row0 = u.pm * BM + wr * 64 + fr; int colt = u.pn * BM; bf16_t* base = O;
        float sc = 1.f; if (split_cols) { const int t = colt / split_cols; base += (size_t)t * split_stride; colt -= t * split_cols; if (t == 0) sc = scale0; }
        const int col0 = colt + wc * 32 + 8 * fq, bcol0 = u.pn * BM + wc * 32 + 8 * fq;
        f32x4 bv[2][2];
#pragma unroll
        for (int bj = 0; bj < 2; ++bj)
#pragma unroll
            for (int n = 0; n < 2; ++n) bv[bj][n] = bias ? *(const f32x4*)(bias + bcol0 + bj * HALF + 4 * n) : (f32x4){0.f, 0.f, 0.f, 0.f};
#pragma unroll
        for (int ai = 0; ai < 2; ++ai)
#pragma unroll
            for (int m = 0; m < 4; ++m) { bf16_t* rowp = base + (size_t)(row0 + ai * HALF + m * 16) * ldc + col0;
#pragma unroll
                for (int bj = 0; bj < 2; ++bj) { f32x4 v0 = acc[ai][bj][m][0] + bv[bj][0], v1 = acc[ai][bj][m][1] + bv[bj][1];
                    if (ACT == 1) { f32x2 a = gelu_pk((f32x2){v0[0], v0[1]}), b = gelu_pk((f32x2){v0[2], v0[3]}), c = gelu_pk((f32x2){v1[0], v1[1]}), d = gelu_pk((f32x2){v1[2], v1[3]});
                        v0 = (f32x4){a.x, a.y, b.x, b.y}; v1 = (f32x4){c.x, c.y, d.x, d.y}; }
                    v0 = v0 * sc; v1 = v1 * sc; u32x4 w; w.x = cvt_pk_bf16(v0[0], v0[1]); w.y = cvt_pk_bf16(v0[2], v0[3]); w.z = cvt_pk_bf16(v1[0], v1[1]); w.w = cvt_pk_bf16(v1[2], v1[3]);
                    *(u32x4*)(rowp + bj * HALF) = w; } }
    }
};


struct EpiF32 {
    static constexpr bool PERM = false, AFTER_DRAIN = false;
    float* C; int ldc; const float* bias;
    __device__ __forceinline__ void operator()(const f32x4 (&acc)[2][2][4][2], const Unit& u, int wr, int wc, int fr, int fq) const {
        const int row0 = u.pm * BM + wr * 64 + fr, col0 = u.pn * BM + wc * 32 + 4 * fq;
        f32x4 bv[2][2];
#pragma unroll
        for (int bj = 0; bj < 2; ++bj)
#pragma unroll
            for (int n = 0; n < 2; ++n) bv[bj][n] = bias ? *(const f32x4*)(bias + col0 + bj * HALF + n * 16) : (f32x4){0.f, 0.f, 0.f, 0.f};
#pragma unroll
        for (int ai = 0; ai < 2; ++ai)
#pragma unroll
            for (int m = 0; m < 4; ++m) { float* rowp = C + (size_t)(row0 + ai * HALF + m * 16) * ldc + col0;
#pragma unroll
                for (int bj = 0; bj < 2; ++bj)
#pragma unroll
                    for (int n = 0; n < 2; ++n) *(f32x4*)(rowp + bj * HALF + n * 16) = acc[ai][bj][m][n] + bv[bj][n]; }
    }
};

template <class Epi, class Sched, bool ALIGN_EPI = false, bool SP2 = false>
__device__ __forceinline__ void gemm_phase(PG8_LAS unsigned char* lds, const Gemm g, const Sched& S, const Epi& E) {
    int tid_l = threadIdx.x; asm volatile("" : "+v"(tid_l));
    const int tid = tid_l, wid = __builtin_amdgcn_readfirstlane(tid >> 6), lane = tid & 63, wr = wid >> 2, wc = wid & 3, fr = lane & 15, fq = lane >> 4;
    const int K = g.K, nt = K / BK;
    unsigned voffA[2], voffB[2];
#pragma unroll
    for (int i = 0; i < 2; ++i) { int R, C; stage_rc(tid * 16 + i * 8192, R, C); const int Rb = Epi::PERM ? ((R & ~31) + perm32(R & 31)) : R;
        voffA[i] = (unsigned)(R * g.ld + C) * 2u; voffB[i] = (unsigned)(Rb * g.ld + C) * 2u; }
    const size_t kstep = (size_t)(BK * 2);
    const size_t hstep = (size_t)HALF * g.ld * 2;
    const size_t tstep = 2 * hstep;
    const unsigned ldsw = (unsigned)wid * 1024u;
    const int aoff = lds_byte(wr * 64 + fr, fq * 8), boff = lds_byte(wc * 32 + fr, fq * 8);
#define PG8_SA(b, h) (((b) * 2 + (h)) * HTB)
#define PG8_SB(b, h) ((4 + (b) * 2 + (h)) * HTB)
#define PG8_STAGE(bufoff, gbase, voff) do { _Pragma("unroll") for (int _i = 0; _i < 2; ++_i) \
        __builtin_amdgcn_global_load_lds((const unsigned*)((const char*)(gbase) + (voff)[_i]), (PG8_LAS unsigned*)(lds + (bufoff) + ldsw + _i * 8192), 16, 0, 0); } while (0)
#define PG8_LDA(dst, b, h) do { _Pragma("unroll") for (int m = 0; m < 4; ++m) _Pragma("unroll") for (int k = 0; k < 2; ++k) dst[m][k] = *(const PG8_LAS bf16x8*)(lds + PG8_SA(b, h) + aoff + m * 2048 + k * 1024); } while (0)
#define PG8_LDB(dst, b, h) do { _Pragma("unroll") for (int n = 0; n < 2; ++n) _Pragma("unroll") for (int k = 0; k < 2; ++k) dst[n][k] = *(const PG8_LAS bf16x8*)(lds + PG8_SB(b, h) + boff + n * 2048 + k * 1024); } while (0)
#define PG8_MMA(ai, bj, At, Bt) do { __builtin_amdgcn_s_setprio(1); _Pragma("unroll") for (int m = 0; m < 4; ++m) _Pragma("unroll") for (int n = 0; n < 2; ++n) _Pragma("unroll") for (int k = 0; k < 2; ++k) \
        acc[ai][bj][m][n] = __builtin_amdgcn_mfma_f32_16x16x32_bf16(Bt[n][k], At[m][k], acc[ai][bj][m][n], 0, 0, 0); __builtin_amdgcn_s_setprio(0); } while (0)
#define PG8_WAIT_V(n) asm volatile("s_waitcnt vmcnt(" #n ")" ::: "memory")
#define PG8_WAIT_L(n) asm volatile("s_waitcnt lgkmcnt(" #n ")" ::: "memory")
#define PG8_BAR __builtin_amdgcn_s_barrier()
#define PG8_SCHED __builtin_amdgcn_sched_barrier(0)
    Unit cur, nxt; int ui = 0;
    if (!S.next(0, cur)) return;
    f32x4 acc[2][2][4][2];
#pragma unroll
    for (int a = 0; a < 2; ++a)
#pragma unroll
        for (int b = 0; b < 2; ++b)
#pragma unroll
            for (int m = 0; m < 4; ++m)
#pragma unroll
                for (int n = 0; n < 2; ++n) acc[a][b][m][n] = (f32x4){0.f, 0.f, 0.f, 0.f};
    bf16x8 At[4][2], B0[2][2], B1[2][2];
    const char* cA = (const char*)g.A + (size_t)cur.pm * tstep + (size_t)cur.kofs * 2; const char* cB = (const char*)g.Bt + (size_t)cur.pn * tstep + (size_t)cur.kofs * 2;
    S.a_ready(cur);
    if constexpr (SP2) {
        PG8_STAGE(PG8_SB(0, 0), cB, voffB); PG8_STAGE(PG8_SB(0, 1), cB + hstep, voffB); PG8_STAGE(PG8_SA(0, 0), cA, voffA); PG8_STAGE(PG8_SA(0, 1), cA + hstep, voffA);
        if (wr == 1) PG8_BAR;
        PG8_WAIT_V(2); PG8_BAR;
        PG8_STAGE(PG8_SB(1, 0), cB + kstep, voffB); PG8_STAGE(PG8_SA(1, 0), cA + kstep, voffA); PG8_STAGE(PG8_SB(1, 1), cB + hstep + kstep, voffB);
        PG8_WAIT_V(6); PG8_BAR;
    } else {
        PG8_STAGE(PG8_SB(0, 0), cB, voffB); PG8_STAGE(PG8_SA(0, 0), cA, voffA); PG8_STAGE(PG8_SB(0, 1), cB + hstep, voffB); PG8_STAGE(PG8_SA(0, 1), cA + hstep, voffA);
        if (wr == 1) PG8_BAR;
        PG8_WAIT_V(4); PG8_BAR;
        PG8_STAGE(PG8_SB(1, 0), cB + kstep, voffB); PG8_STAGE(PG8_SA(1, 0), cA + kstep, voffA); PG8_STAGE(PG8_SB(1, 1), cB + hstep + kstep, voffB);
        PG8_WAIT_V(6); PG8_BAR;
    }
    for (;;) {
        const bool has_next = S.next(ui + 1, nxt);
        const char* nA = has_next ? (const char*)g.A + (size_t)nxt.pm * tstep + (size_t)nxt.kofs * 2 : cA; const char* nB = has_next ? (const char*)g.Bt + (size_t)nxt.pn * tstep + (size_t)nxt.kofs * 2 : cB;
        for (int t = 0; t < nt; t += 2) {
            const bool last = (t == nt - 2);
            const char* a1 = cA + (size_t)(t + 1) * kstep;
            const char* a2 = last ? nA : cA + (size_t)(t + 2) * kstep; const char* b2 = last ? nB : cB + (size_t)(t + 2) * kstep;
            const char* a3 = a2 + kstep; const char* b3 = b2 + kstep;
            if (last && has_next) S.a_ready(nxt);
            if constexpr (SP2) {
            PG8_LDB(B0, 0, 0); PG8_LDB(B1, 0, 1); PG8_SCHED; PG8_LDA(At, 0, 0); PG8_STAGE(PG8_SA(1, 1), a1 + hstep, voffA);
            PG8_WAIT_V(8); PG8_WAIT_L(0); PG8_BAR; PG8_MMA(0, 0, At, B0); PG8_MMA(0, 1, At, B1); PG8_BAR; PG8_SCHED;
            PG8_LDA(At, 0, 1); PG8_STAGE(PG8_SB(0, 0), b2, voffB); PG8_STAGE(PG8_SB(0, 1), b2 + hstep, voffB); PG8_STAGE(PG8_SA(0, 0), a2, voffA);
            PG8_WAIT_V(8); PG8_WAIT_L(0); PG8_BAR; PG8_MMA(1, 0, At, B0); PG8_MMA(1, 1, At, B1); PG8_BAR; PG8_SCHED;
            PG8_LDB(B0, 1, 0); PG8_LDB(B1, 1, 1); PG8_SCHED; PG8_LDA(At, 1, 0); PG8_STAGE(PG8_SA(0, 1), a2 + hstep, voffA);
            PG8_WAIT_V(8); PG8_WAIT_L(0); PG8_BAR; PG8_MMA(0, 0, At, B0); PG8_MMA(0, 1, At, B1); PG8_BAR; PG8_SCHED;
            PG8_LDA(At, 1, 1); PG8_STAGE(PG8_SB(1, 0), b3, voffB); PG8_STAGE(PG8_SB(1, 1), b3 + hstep, voffB); PG8_STAGE(PG8_SA(1, 0), a3, voffA);
            PG8_WAIT_V(8); PG8_WAIT_L(0); PG8_BAR; PG8_MMA(1, 0, At, B0); PG8_MMA(1, 1, At, B1); PG8_BAR; PG8_SCHED;
            } else {
            PG8_LDB(B0, 0, 0); PG8_SCHED; PG8_LDA(At, 0, 0); PG8_STAGE(PG8_SA(1, 1), a1 + hstep, voffA);
            PG8_WAIT_L(8); PG8_BAR; PG8_WAIT_L(0); PG8_MMA(0, 0, At, B0); PG8_BAR; PG8_SCHED;
            PG8_LDB(B1, 0, 1); PG8_STAGE(PG8_SB(0, 0), b2, voffB);
            PG8_BAR; PG8_WAIT_L(0); PG8_MMA(0, 1, At, B1); PG8_BAR;
            PG8_LDA(At, 0, 1); PG8_STAGE(PG8_SA(0, 0), a2, voffA);
            PG8_BAR; PG8_WAIT_L(0); PG8_MMA(1, 0, At, B0); PG8_BAR; PG8_SCHED;
            PG8_STAGE(PG8_SB(0, 1), b2 + hstep, voffB);
            PG8_WAIT_V(6); PG8_BAR; PG8_MMA(1, 1, At, B1); PG8_BAR;
            PG8_LDB(B0, 1, 0); PG8_SCHED; PG8_LDA(At, 1, 0); PG8_STAGE(PG8_SA(0, 1), a2 + hstep, voffA);
            PG8_WAIT_L(8); PG8_BAR; PG8_WAIT_L(0); PG8_MMA(0, 0, At, B0); PG8_BAR; PG8_SCHED;
            PG8_LDB(B1, 1, 1); PG8_STAGE(PG8_SB(1, 0), b3, voffB);
            PG8_BAR; PG8_WAIT_L(0); PG8_MMA(0, 1, At, B1); PG8_BAR;
            PG8_LDA(At, 1, 1); PG8_STAGE(PG8_SA(1, 0), a3, voffA);
            PG8_BAR; PG8_WAIT_L(0); PG8_MMA(1, 0, At, B0); PG8_BAR; PG8_SCHED;
            PG8_STAGE(PG8_SB(1, 1), b3 + hstep, voffB);
            PG8_WAIT_V(6); PG8_BAR; PG8_MMA(1, 1, At, B1); PG8_BAR;
            }
        }
        if constexpr (ALIGN_EPI) { if (wr == 0) PG8_BAR; }
        if constexpr (!Epi::AFTER_DRAIN) { E(acc, cur, wr, wc, fr, fq); S.done(cur); }
        if (!has_next) break;
#pragma unroll
        for (int a = 0; a < 2; ++a)
#pragma unroll
            for (int b = 0; b < 2; ++b)
#pragma unroll
                for (int m = 0; m < 4; ++m)
#pragma unroll
                    for (int n = 0; n < 2; ++n) acc[a][b][m][n] = (f32x4){0.f, 0.f, 0.f, 0.f};
        cur = nxt; cA = nA; cB = nB; ++ui;
        if constexpr (ALIGN_EPI) { if (wr == 1) PG8_BAR; }
    }
    PG8_WAIT_V(0);
    if constexpr (!ALIGN_EPI) { if (wr == 0) PG8_BAR; }
    PG8_BAR;
    if constexpr (Epi::AFTER_DRAIN) { E.fused(acc, cur, wr, wc, fr, fq, lds, wid, lane); S.done(cur); }
#undef PG8_SA
#undef PG8_SB
#undef PG8_STAGE
#undef PG8_LDA
#undef PG8_LDB
#undef PG8_MMA
#undef PG8_WAIT_V
#undef PG8_WAIT_L
#undef PG8_BAR
#undef PG8_SCHED
}
}
namespace pg8 {
struct SplitKOrder {
    int G, c;
    __host__ __device__ void init(int G_, int c_) { G = G_; c = c_; }
    __host__ __device__ bool next(int i, Unit& u) const { const long L = (long)i * G + c; if (L >= 128) return false; const int ks = (int)L >> 4, r = (int)L & 15; u.pm = r >> 3; u.pn = r & 7; u.kofs = ks * 256; return true; }
    __device__ __forceinline__ void a_ready(const Unit&) const {}
    __device__ __forceinline__ void done(const Unit&) const {}
};
struct EpiF32Part {
    static constexpr bool PERM = false, AFTER_DRAIN = false;
    float* C;
    __device__ __forceinline__ void operator()(const f32x4 (&acc)[2][2][4][2], const Unit& u, int wr, int wc, int fr, int fq) const {
        const int row0 = u.pm * BM + wr * 64 + fr, col0 = u.pn * BM + wc * 32 + 4 * fq; float* base = C + (size_t)(u.kofs >> 8) * 512 * 2048;
#pragma unroll
        for (int ai = 0; ai < 2; ++ai)
#pragma unroll
            for (int m = 0; m < 4; ++m) { float* rowp = base + (size_t)(row0 + ai * HALF + m * 16) * 2048 + col0;
#pragma unroll
                for (int bj = 0; bj < 2; ++bj)
#pragma unroll
                    for (int n = 0; n < 2; ++n) *(f32x4*)(rowp + bj * HALF + n * 16) = acc[ai][bj][m][n]; }
    }
};
}
#define PG8_SP2 true
#define PG8_ALIGN true

#define LDS_FENCE() asm volatile("s_waitcnt lgkmcnt(0)" ::: "memory")
__device__ __forceinline__ unsigned f2bf(float f) { unsigned u = __builtin_bit_cast(unsigned, f); return (u + 0x7fffu + ((u >> 16) & 1u)) >> 16; }
__device__ __forceinline__ unsigned pk2(float lo, float hi) { return f2bf(lo) | (f2bf(hi) << 16); }
template <int CTRL> __device__ __forceinline__ float dppm(float x) { return __builtin_bit_cast(float, __builtin_amdgcn_mov_dpp(__builtin_bit_cast(int, x), CTRL, 0xf, 0xf, true)); }
__device__ __forceinline__ float row16_sum(float v) { v += dppm<0xB1>(v); v += dppm<0x4E>(v); v += dppm<0x141>(v); v += dppm<0x140>(v); return v; }
__device__ __forceinline__ float row16_maxf(float v) { v = fmaxf(v, dppm<0xB1>(v)); v = fmaxf(v, dppm<0x4E>(v)); v = fmaxf(v, dppm<0x141>(v)); v = fmaxf(v, dppm<0x140>(v)); return v; }
__device__ __forceinline__ float wave_sum(float v) {
    v = row16_sum(v);
    float a = v, b = v; asm volatile("s_nop 1\n\tv_permlane16_swap_b32 %0, %1" : "+v"(a), "+v"(b)); v = a + b;
    a = v; b = v; asm volatile("s_nop 1\n\tv_permlane32_swap_b32 %0, %1" : "+v"(a), "+v"(b)); return a + b;
}
__device__ __forceinline__ float wave_max(float v) {
    v = row16_maxf(v);
    float a = v, b = v; asm volatile("s_nop 1\n\tv_permlane16_swap_b32 %0, %1" : "+v"(a), "+v"(b)); v = fmaxf(a, b);
    a = v; b = v; asm volatile("s_nop 1\n\tv_permlane32_swap_b32 %0, %1" : "+v"(a), "+v"(b)); return fmaxf(a, b);
}
__device__ __forceinline__ float silu_f(float x) { return x / (1.0f + __expf(-x)); }
__device__ __forceinline__ float gelu_f(float v) {
    const float t = __builtin_amdgcn_rcpf(fabsf(v) * 0.2316418882f + 1.0f);
    float q = t * 0.5307027145f + (-0.7265760135f); q = q * t + 0.7107068705f; q = q * t + (-0.142248368f); q = q * t + 0.127414796f; q = q * t;
    const float m = v * (q * __builtin_amdgcn_exp2f(v * v * (-0.72134752044f)));
    return v < 0.f ? m : v - m;
}
__device__ __forceinline__ float log_sigmoid_f(float z) { return fminf(z, 0.0f) - __logf(1.0f + __expf(-fabsf(z))); }


__device__ __forceinline__ float bflo(unsigned w) { return __builtin_bit_cast(float, w << 16); }
__device__ __forceinline__ float bfhi(unsigned w) { return __builtin_bit_cast(float, w & 0xffff0000u); }
__device__ __forceinline__ void unpack8(const u32x4 w, float (&f)[8]) { f[0] = bflo(w.x); f[1] = bfhi(w.x); f[2] = bflo(w.y); f[3] = bfhi(w.y); f[4] = bflo(w.z); f[5] = bfhi(w.z); f[6] = bflo(w.w); f[7] = bfhi(w.w); }
__device__ __forceinline__ u32x4 pack8(const float (&f)[8]) { u32x4 o; o.x = pk2(f[0], f[1]); o.y = pk2(f[2], f[3]); o.z = pk2(f[4], f[5]); o.w = pk2(f[6], f[7]); return o; }


__device__ __forceinline__ u32x6 pack_fp6_2x16(const f32x16 a, const f32x16 b) { u32x6 r; asm("v_cvt_scalef32_2xpk16_fp6_f32 %0, %1, %2, 1.0" : "=&v"(r) : "v"(a), "v"(b)); return r; }
__device__ __forceinline__ f32x32 unpack_fp6_32(const u32x6 w) { f32x32 r; asm volatile("v_cvt_scalef32_pk32_f32_fp6 %0, %1, 1.0" : "=&v"(r) : "v"(w)); return r; }

struct Params {
    const float* in[19];
    float* out;
    unsigned char* ws;
    int ph_lo, ph_hi;
};
enum { I_X = 0, I_C, I_CTX, I_CCTX, I_WADA, I_BADA, I_WIN, I_CONVW, I_GW2, I_GB2, I_GNORM, I_SINK, I_WOUT, I_LNG, I_LNB, I_PWQ, I_PSUB, I_PU, I_PV };

__device__ __forceinline__ int row_stream(int r) { return r < TL ? r / SEQ : 2; }

__device__ __forceinline__ void transpose_item(const float* W, int K, int N, bf16_t* WT, LAS float* scr, int item, int lane) {
    const int nblk = N / 32, kb = item / nblk, nb = item % nblk, k0 = 64 * kb, n0 = 32 * nb;
#pragma unroll 8
    for (int i = 0; i < 32; ++i) { const int kk = 2 * i + (lane >> 5); scr[kk * 33 + (lane & 31)] = W[(size_t)(k0 + kk) * N + n0 + (lane & 31)]; }
    LDS_FENCE();
    const int c = lane & 7;
#pragma unroll
    for (int j = 0; j < 4; ++j) { const int n = (lane >> 3) + 8 * j; const LAS float* s = scr + (8 * c) * 33 + n;
        u32x4 o; o.x = pk2(s[0 * 33], s[1 * 33]); o.y = pk2(s[2 * 33], s[3 * 33]); o.z = pk2(s[4 * 33], s[5 * 33]); o.w = pk2(s[6 * 33], s[7 * 33]);
        *(u32x4*)(WT + (size_t)(n0 + n) * K + k0 + 8 * c) = o; }
    LDS_FENCE();
}

__device__ __forceinline__ void phase_prologue(const Params& p, LAS unsigned char* lds, int tid, int lane, int wave, int bid, int G) {
    const int gw = bid * NWAVES + wave, NGW = G * NWAVES;
    LAS float* scr = (LAS float*)(lds + wave * 16384);
    bf16_t* WIN = (bf16_t*)(p.ws + WS_WIN); bf16_t* WOUT = (bf16_t*)(p.ws + WS_WOUT); bf16_t* WQ = (bf16_t*)(p.ws + WS_WQ);
    constexpr int IT_IN = (DM / 64) * (INW / 32), IT_SQ = (DM / 64) * (DM / 32), IT_L = IT_IN + 2 * IT_SQ;
    for (int it = gw; it < DEPTH * IT_L; it += NGW) {
        const int l = it / IT_L; int r = it % IT_L;
        if (r < IT_IN) { transpose_item(p.in[I_WIN] + (size_t)l * DM * INW, DM, INW, WIN + (size_t)l * INWP * DM, scr, r, lane); continue; } r -= IT_IN;
        if (r < IT_SQ) { transpose_item(p.in[I_WOUT] + (size_t)l * DM * DM, DM, DM, WOUT + (size_t)l * DM * DM, scr, r, lane); continue; } r -= IT_SQ;
        transpose_item(p.in[I_PWQ] + (size_t)l * DM * DM, DM, DM, WQ + (size_t)l * DM * DM, scr, r, lane);
    }
    {
        constexpr int PADV = (INWP - INW) * DM / 8;
        const int gt = bid * NTHREADS + tid, NGT = G * NTHREADS;
        for (int i = gt; i < DEPTH * PADV; i += NGT) { const int l = i / PADV, o = i % PADV;
            *(u32x4*)(WIN + (size_t)l * INWP * DM + (size_t)INW * DM + (size_t)o * 8) = (u32x4){0u, 0u, 0u, 0u}; }
    }
    {
        const float* U = p.in[I_PU]; const float* V = p.in[I_PV];
        unsigned char* UB = p.ws + WS_UB; unsigned char* VB = p.ws + WS_VB; float* USC = (float*)(p.ws + WS_USC); (void)USC; float* VSC = (float*)(p.ws + WS_VSC); (void)VSC;
        for (size_t row = gw; row < (size_t)DEPTH * NEXP; row += NGW) {
            f32x4 xx[2][8];
#pragma unroll
            for (int tb = 0; tb < 2; ++tb)
#pragma unroll
                for (int j = 0; j < 8; ++j) xx[tb][j] = *(const f32x4*)((tb ? V : U) + row * DM + lane * 32 + 4 * j);
#pragma unroll
            for (int tb = 0; tb < 2; ++tb) {
                f32x4 x[8]; float am = 0.f;
#pragma unroll
                for (int j = 0; j < 8; ++j) { x[j] = xx[tb][j]; am = fmaxf(am, fmaxf(fmaxf(fabsf(x[j].x), fabsf(x[j].y)), fmaxf(fabsf(x[j].z), fabsf(x[j].w)))); }
                if (tb == 0 && TBL_U_I4) {
#if U_ROWSCALE
                    unsigned char* dst = UB + row * ROWB_U;
                    float ssq = 0.f;
#pragma unroll
                    for (int j = 0; j < 8; ++j) ssq += (x[j].x * x[j].x + x[j].y * x[j].y) + (x[j].z * x[j].z + x[j].w * x[j].w);
                    const float amr = wave_max(am), rms = sqrtf(wave_sum(ssq) * (1.0f / DM));
                    const float srow = amr > 0.f ? fminf(amr * (1.0f / 7.0f), 0.36f * rms) : 1.0f; const float inv = 1.0f / srow; const int code = 0; (void)code;
                    if (lane == 0) USC[row] = srow;
#else
                    unsigned char* dst = UB + row * ROWB4;
                    const float sb = am * (1.0f / 7.0f); const unsigned ub = (__builtin_bit_cast(unsigned, sb) + 0x000fffffu) & 0xfff00000u;
                    int code = ((int)ub - (int)I4_BASE) >> 20; code = code < 0 ? 0 : (code > 255 ? 255 : code);
                    const float inv = 1.0f / __builtin_bit_cast(float, ((unsigned)code << 20) + I4_BASE);
#endif
                    u32x4 w;
#pragma unroll
                    for (int d = 0; d < 4; ++d) { unsigned t = 0u;
#pragma unroll
                        for (int e = 0; e < 8; ++e) { const float xv = (e < 4 ? x[2 * d] : x[2 * d + 1])[e & 3];
                            int q = (int)__builtin_rintf(xv * inv); q = q < -7 ? -7 : (q > 7 ? 7 : q); t |= ((unsigned)q & 15u) << (4 * e); }
                        w[d] = t; }
                    *(u32x4*)(dst + lane * 16) = w;
#if !U_ROWSCALE
                    dst[1024 + lane] = (unsigned char)code;
#endif
                } else if (tb == 1 && V_ROWSCALE) {
                    unsigned char* dst = VB + row * ROWB_V;
                    float ssq = 0.f;
#pragma unroll
                    for (int j = 0; j < 8; ++j) ssq += (x[j].x * x[j].x + x[j].y * x[j].y) + (x[j].z * x[j].z + x[j].w * x[j].w);
                    const float amr = wave_max(am), rms = sqrtf(wave_sum(ssq) * (1.0f / DM));
                    const float srow = amr > 0.f ? fminf(amr * (1.0f / 6.0f), (2.8f / 6.0f) * rms) : 1.0f; const float inv = 1.0f / srow;
                    if (lane == 0) VSC[row] = srow;
                    u32x4 w;
#pragma unroll
                    for (int d = 0; d < 4; ++d) { unsigned t = 0u;
                        t = __builtin_amdgcn_cvt_scalef32_pk_fp4_f32(t, x[2 * d].x * inv, x[2 * d].y * inv, 1.0f, 0); t = __builtin_amdgcn_cvt_scalef32_pk_fp4_f32(t, x[2 * d].z * inv, x[2 * d].w * inv, 1.0f, 1);
                        t = __builtin_amdgcn_cvt_scalef32_pk_fp4_f32(t, x[2 * d + 1].x * inv, x[2 * d + 1].y * inv, 1.0f, 2); t = __builtin_amdgcn_cvt_scalef32_pk_fp4_f32(t, x[2 * d + 1].z * inv, x[2 * d + 1].w * inv, 1.0f, 3);
                        w[d] = t; }
                    *(u32x4*)(dst + lane * 16) = w;
                } else if (tb == 1 || TBL_U_FP4) {
                    unsigned char* dst = (tb ? VB : UB) + row * ROWB4;
                    const float sb = am * (1.0f / 6.0f); unsigned ub = __builtin_bit_cast(unsigned, sb); ub = (ub & 0x007fffffu) ? ((ub & 0x7f800000u) + 0x00800000u) : (ub & 0x7f800000u);
                    if (!(am > 0.f) || ub < 0x00800000u) ub = 0x00800000u;
                    const float scl = __builtin_bit_cast(float, ub);
                    u32x4 w;
#pragma unroll
                    for (int d = 0; d < 4; ++d) { unsigned t = 0u;
                        t = __builtin_amdgcn_cvt_scalef32_pk_fp4_f32(t, x[2 * d].x, x[2 * d].y, scl, 0); t = __builtin_amdgcn_cvt_scalef32_pk_fp4_f32(t, x[2 * d].z, x[2 * d].w, scl, 1);
                        t = __builtin_amdgcn_cvt_scalef32_pk_fp4_f32(t, x[2 * d + 1].x, x[2 * d + 1].y, scl, 2); t = __builtin_amdgcn_cvt_scalef32_pk_fp4_f32(t, x[2 * d + 1].z, x[2 * d + 1].w, scl, 3);
                        w[d] = t; }
                    *(u32x4*)(dst + lane * 16) = w; dst[1024 + lane] = (unsigned char)(ub >> 23);
                } else {
                    unsigned char* dst = UB + row * ROWB;
                    am = wave_max(am);
                    const float inv = am > 0.f ? 7.0f / am : 0.f;
                    f32x16 x0, x1;
#pragma unroll
                    for (int j = 0; j < 4; ++j) { x0[4 * j + 0] = x[j].x * inv; x0[4 * j + 1] = x[j].y * inv; x0[4 * j + 2] = x[j].z * inv; x0[4 * j + 3] = x[j].w * inv;
                        x1[4 * j + 0] = x[4 + j].x * inv; x1[4 * j + 1] = x[4 + j].y * inv; x1[4 * j + 2] = x[4 + j].z * inv; x1[4 * j + 3] = x[4 + j].w * inv; }
                    const u32x6 w = pack_fp6_2x16(x0, x1);
                    *(u32x4*)(dst + lane * 16) = (u32x4){w[0], w[1], w[2], w[3]}; *(u32x2*)(dst + 1024 + lane * 8) = (u32x2){w[4], w[5]};
                    if (lane == 0) USC[row] = am * (1.0f / 7.0f);
                }
            }
        }
        const size_t gt = (size_t)bid * NTHREADS + tid, NGT = (size_t)G * NTHREADS;
        const float* SUB = p.in[I_PSUB]; bf16_t* SUBB = (bf16_t*)(p.ws + WS_SUBB);
        for (size_t i = gt; i < (size_t)DEPTH * 2 * 128 * 128 / 2; i += NGT) ((unsigned*)SUBB)[i] = pk2(SUB[2 * i], SUB[2 * i + 1]);
    }
    __syncthreads();
    LAS float* sc = (LAS float*)lds;
    LAS float* red = (LAS float*)(lds + 32768);
    for (int i = tid; i < 3 * DM; i += NTHREADS) { const int s = i / DM, k = i % DM; const float v = s < 2 ? p.in[I_C][s * DM + k] : p.in[I_CCTX][k]; sc[i] = silu_f(v); }
    __syncthreads();
    float* MOD = (float*)(p.ws + WS_MOD);
    LAS float* red2 = (LAS float*)(lds + 32768);
    constexpr int NCH = 6 * DM / 256;
    for (int it = bid; it < DEPTH * NCH; it += G) {
        const int l = it / NCH, n0 = (it % NCH) * 256;
        const float* wp = p.in[I_WADA] + (size_t)l * DM * 6 * DM + n0 + lane * 4;
        f32x4 a0 = (f32x4){0.f, 0.f, 0.f, 0.f}, a1 = a0, a2 = a0;
        const int kb = wave * (DM / NWAVES);
#pragma unroll 16
        for (int k = kb; k < kb + DM / NWAVES; ++k) { const f32x4 w = *(const f32x4*)(wp + (size_t)k * 6 * DM); a0 += w * sc[k]; a1 += w * sc[DM + k]; a2 += w * sc[2 * DM + k]; }
        *(LAS f32x4*)(red2 + (wave * 3 + 0) * 256 + lane * 4) = a0; *(LAS f32x4*)(red2 + (wave * 3 + 1) * 256 + lane * 4) = a1; *(LAS f32x4*)(red2 + (wave * 3 + 2) * 256 + lane * 4) = a2;
        __syncthreads();
        for (int i = tid; i < 768; i += NTHREADS) { const int st = i >> 8, c = i & 255; float v = 0.f;
#pragma unroll
            for (int w = 0; w < NWAVES; ++w) v += red2[(w * 3 + st) * 256 + c];
            MOD[((size_t)l * 3 + st) * 6 * DM + n0 + c] = v + p.in[I_BADA][(size_t)l * 6 * DM + n0 + c]; }
        __syncthreads();
    }
}


__device__ __forceinline__ int row_first(int wave, int bid, int G) { const int gw = bid * NWAVES + wave; return gw < TL ? gw : -1; }
__device__ __forceinline__ int row_next(int r, int wave, int bid, int G, int nrows) {
    const int NGW = G * NWAVES;
    if (r < TL) { if (r + NGW < TL) return r + NGW; const int c = TL + wave * G + bid; return c < nrows ? c : -1; }
    return r + NGW < nrows ? r + NGW : -1;
}
__device__ __forceinline__ const float* xsrc(const Params& p, int l, int r) {
    return r < TL ? p.in[I_X] + (size_t)r * DM : p.in[I_CTX] + (size_t)(r - TL) * DM;
}

__device__ __forceinline__ void modulate_row(const float* xr, const float* mod, int sh_off, int sc_off, bf16_t* hb, int lane) {
    f32x4 xx[8];
#pragma unroll
    for (int j = 0; j < 8; ++j) xx[j] = *(const f32x4*)(xr + lane * 4 + 256 * j);
#pragma unroll
    for (int j = 0; j < 8; ++j) { const int c = lane * 4 + 256 * j;
        const f32x4 x = xx[j], sh = *(const f32x4*)(mod + sh_off + c), s = *(const f32x4*)(mod + sc_off + c);
        u32x2 o; o.x = pk2(x.x * (1.f + s.x) + sh.x, x.y * (1.f + s.y) + sh.y); o.y = pk2(x.z * (1.f + s.z) + sh.z, x.w * (1.f + s.w) + sh.w);
        *(u32x2*)(hb + c) = o; }
}
__device__ __forceinline__ void phase_modulate0(const Params& p, int lane, int wave, int bid, int G) {
    const int gw = bid * NWAVES + wave, NGW = G * NWAVES;
    const float* MOD = (const float*)(p.ws + WS_MOD); bf16_t* HB = (bf16_t*)(p.ws + WS_HB);
    for (int r = row_first(wave, bid, G); r >= 0; r = row_next(r, wave, bid, G, TA)) modulate_row(xsrc(p, 0, r), MOD + (size_t)(0 * 3 + row_stream(r)) * 6 * DM, 0, DM, HB + (size_t)r * DM, lane);
}

__device__ __forceinline__ void gemm_direct(const bf16_t* A, const bf16_t* Bt, float* C, int M, int N, int K, int ldc, int gw, int NGW, int lane) {
    const int nTn = N / 64, nItems = (M / 32) * nTn;
    const int fr = lane & 15, fq = lane >> 4;
    for (int it = gw; it < nItems; it += NGW) {
        const int mt = it / nTn, nt = it % nTn;
        const bf16_t* a0 = A + (size_t)(mt * 32 + fr) * K + fq * 8;
        const bf16_t* b0 = Bt + (size_t)(nt * 64 + fr) * K + fq * 8;
        f32x4 acc[2][4];
#pragma unroll
        for (int i = 0; i < 2; ++i)
#pragma unroll
            for (int j = 0; j < 4; ++j) acc[i][j] = (f32x4){0.f, 0.f, 0.f, 0.f};
#pragma unroll 2
        for (int k0 = 0; k0 < K; k0 += 32) {
            bf16x8 af[2], bfr[4];
#pragma unroll
            for (int i = 0; i < 2; ++i) af[i] = *(const bf16x8*)(a0 + (size_t)i * 16 * K + k0);
#pragma unroll
            for (int j = 0; j < 4; ++j) bfr[j] = *(const bf16x8*)(b0 + (size_t)j * 16 * K + k0);
#pragma unroll
            for (int i = 0; i < 2; ++i)
#pragma unroll
                for (int j = 0; j < 4; ++j) acc[i][j] = __builtin_amdgcn_mfma_f32_16x16x32_bf16(af[i], bfr[j], acc[i][j], 0, 0, 0);
        }
#pragma unroll
        for (int i = 0; i < 2; ++i)
#pragma unroll
            for (int j = 0; j < 4; ++j)
#pragma unroll
                for (int g = 0; g < 4; ++g) C[(size_t)(mt * 32 + i * 16 + fq * 4 + g) * ldc + nt * 64 + j * 16 + fr] = acc[i][j][g];
    }
}

__device__ __forceinline__ void phase_post_in(const Params& p, int l, int lane, int wave, int bid, int G) {
    const int gw = bid * NWAVES + wave, NGW = G * NWAVES;
    const bf16_t* P = (const bf16_t*)(p.ws + WS_P);
    bf16_t* QR = (bf16_t*)(p.ws + WS_QR); bf16_t* KR = (bf16_t*)(p.ws + WS_KR); bf16_t* VR = (bf16_t*)(p.ws + WS_ALF);
    bf16_t* MIX = (bf16_t*)(p.ws + WS_MIX);
    const float* cw = p.in[I_CONVW] + (size_t)l * 3 * 512;
    const int c8 = lane * 8, rh = lane >> 3, rf = (lane >> 2) & 1, rg = lane & 3, roff = rh * 128 + rf * 64 + rg * 8;
    float w0[8], w1[8], w2[8], invf[8];
#pragma unroll
    for (int e = 0; e < 8; ++e) { w0[e] = cw[c8 + e]; w1[e] = cw[512 + c8 + e]; w2[e] = cw[1024 + c8 + e]; invf[e] = __builtin_amdgcn_exp2f(-(float)(rg * 8 + e) * 0.4152410118609203f); }
    for (int r = row_first(wave, bid, G); r >= 0; r = row_next(r, wave, bid, G, TA)) {
        const bf16_t* pr = P + (size_t)r * INWP;
        int pos, len;
        if (r < TL) { pos = r % SEQ; len = SEQ; } else { pos = (r - TL) % CTXL; len = CTXL; }
        const bool hp = pos > 0, hn = pos < len - 1;
        const u32x4 z4 = (u32x4){0u, 0u, 0u, 0u};
        const u32x4 xC = *(const u32x4*)(pr + C_CC + c8), xX = *(const u32x4*)(pr + C_CX + c8), xB = *(const u32x4*)(pr + C_CB + c8);
        const u32x4 pC = hp ? *(const u32x4*)(pr - INWP + C_CC + c8) : z4, pX = hp ? *(const u32x4*)(pr - INWP + C_CX + c8) : z4;
        const u32x4 nC = hn ? *(const u32x4*)(pr + INWP + C_CC + c8) : z4, nX = hn ? *(const u32x4*)(pr + INWP + C_CX + c8) : z4;
        const u32x4 q1 = *(const u32x4*)(pr + C_SQ + roff), q2 = *(const u32x4*)(pr + C_SQ + roff + 32);
        u32x4 k1 = z4, k2 = z4, vv = z4;
        if (lane < 16) { k1 = *(const u32x4*)(pr + C_SK + roff); k2 = *(const u32x4*)(pr + C_SK + roff + 32); }
        if (lane < 32) vv = *(const u32x4*)(pr + C_SV + c8);
        { float fC[8], fX[8], fB[8], gC[8], gX[8], hC[8], hX[8], o[8];
          unpack8(xC, fC); unpack8(xX, fX); unpack8(xB, fB); unpack8(pC, gC); unpack8(pX, gX); unpack8(nC, hC); unpack8(nX, hX);
#pragma unroll
          for (int e = 0; e < 8; ++e) o[e] = fB[e] * (w0[e] * gC[e] * gX[e] + w1[e] * fC[e] * fX[e] + w2[e] * hC[e] * hX[e]);
          *(u32x4*)(MIX + (size_t)r * DM + c8) = pack8(o); }
        { float cs[8], sn[8];
#pragma unroll
          for (int e = 0; e < 8; ++e) { cs[e] = 1.f; sn[e] = 0.f; }
          if (r < TL) { const float pv = (float)(rf ? (pos % 64) : (pos / 64));
#pragma unroll
              for (int e = 0; e < 8; ++e) { sn[e] = __sinf(pv * invf[e]); cs[e] = __cosf(pv * invf[e]); } }
          float x1[8], x2[8], o1[8], o2[8];
          unpack8(q1, x1); unpack8(q2, x2);
#pragma unroll
          for (int e = 0; e < 8; ++e) { o1[e] = (x1[e] * cs[e] - x2[e] * sn[e]) * 0.08838834764831845f; o2[e] = (x2[e] * cs[e] + x1[e] * sn[e]) * 0.08838834764831845f; }
          *(u32x4*)(QR + (size_t)r * 1024 + roff) = pack8(o1); *(u32x4*)(QR + (size_t)r * 1024 + roff + 32) = pack8(o2);
          if (lane < 16) { unpack8(k1, x1); unpack8(k2, x2);
#pragma unroll
              for (int e = 0; e < 8; ++e) { o1[e] = x1[e] * cs[e] - x2[e] * sn[e]; o2[e] = x2[e] * cs[e] + x1[e] * sn[e]; }
              *(u32x4*)(KR + (size_t)r * 256 + roff) = pack8(o1); *(u32x4*)(KR + (size_t)r * 256 + roff + 32) = pack8(o2); }
          if (lane < 32) *(u32x4*)(VR + (size_t)r * 256 + c8) = vv; }
    }
}

#ifndef SWA_THR
#define SWA_THR 6.0f
#endif
constexpr int KP = 136, VP = 72;
constexpr int SWA_BUF = 64 * KP * 2 + 128 * VP * 2;
typedef short bf16x4 __attribute__((ext_vector_type(4)));
__device__ __forceinline__ void phase_mixers(const Params& p, int l, LAS unsigned char* lds, int tid, int lane, int wave, int bid, int G, int qsel = 0) {
    const bf16_t* QR = (const bf16_t*)(p.ws + WS_QR); const bf16_t* KR = (const bf16_t*)(p.ws + WS_KR); const bf16_t* VR = (const bf16_t*)(p.ws + WS_ALF);
    bf16_t* MIX = (bf16_t*)(p.ws + WS_MIX);
    const float* sinkp = p.in[I_SINK] + l * 8;
    const int fr = lane & 15, fq = lane >> 4, g = wave & 3, qh = wave >> 2;
    const int nItems = 512 + ((l < DEPTH - 1) ? 16 : 0);
    unsigned* qhead = (unsigned*)(p.ws + WS_CTL) + CW_QUEUE + 64 * (l + 4 * qsel);
    volatile LAS int* itw = (volatile LAS int*)(lds + MISC_OFF + 64);
    for (;;) {
        if (tid == 0) itw[0] = (int)__hip_atomic_fetch_add(qhead, 1u, __ATOMIC_RELAXED, __HIP_MEMORY_SCOPE_AGENT);
        __syncthreads();
        const int it = itw[0];
        __syncthreads();
        if (it >= nItems) break;
        int b, tile, hk, s0; size_t qrow0;
        if (it < 512) { b = it >> 8; tile = (it >> 1) & 127; hk = it & 1; s0 = 0; qrow0 = (size_t)b * SEQ + tile * 64; }
        else { const int c = it - 512; b = c >> 3; tile = (c >> 1) & 3; hk = c & 1; s0 = 5; qrow0 = (size_t)TL + b * CTXL + tile * 64; }
        const int n0 = tile * 64, hq = hk * 4 + g;
        bf16x8 qf[2][4];
#pragma unroll
        for (int qt = 0; qt < 2; ++qt)
#pragma unroll
            for (int ks = 0; ks < 4; ++ks) qf[qt][ks] = *(const bf16x8*)(QR + (qrow0 + qh * 32 + qt * 16 + fr) * 1024 + hq * 128 + ks * 32 + fq * 8);
        f32x4 O[2][8];
#pragma unroll
        for (int qt = 0; qt < 2; ++qt)
#pragma unroll
            for (int dt = 0; dt < 8; ++dt) O[qt][dt] = (f32x4){0.f, 0.f, 0.f, 0.f};
        float m[2], lsum[2];
        m[0] = m[1] = sinkp[hq]; lsum[0] = lsum[1] = (fq == 0) ? 1.f : 0.f;
        u32x4 kreg[2], vreg[2];
#define SWA_ROW(s, kk) ((s) < 5 ? (size_t)b * SEQ + (size_t)min(max(n0 - 128 + (s) * 64 + (kk), 0), SEQ - 1) : (size_t)TL + (size_t)b * CTXL + ((s) - 5) * 64 + (kk))
#define SWA_LOAD(s) do { _Pragma("unroll") for (int j = 0; j < 2; ++j) { const int v = tid + NTHREADS * j; \
            kreg[j] = *(const u32x4*)(KR + SWA_ROW(s, v >> 4) * 256 + hk * 128 + (v & 15) * 8); \
            vreg[j] = *(const u32x4*)(VR + SWA_ROW(s, tid & 63) * 256 + hk * 128 + ((tid >> 6) + 8 * j) * 8); } } while (0)
#define SWA_WRITE(buf) do { LAS bf16_t* Kd = (LAS bf16_t*)(lds + (buf) * SWA_BUF); LAS bf16_t* Vd = Kd + 64 * KP; \
            _Pragma("unroll") for (int j = 0; j < 2; ++j) { const int v = tid + NTHREADS * j; *(LAS u32x4*)(Kd + (v >> 4) * KP + (v & 15) * 8) = kreg[j]; \
                const int d0 = ((tid >> 6) + 8 * j) * 8, key = tid & 63; const u32x4 w = vreg[j]; \
                Vd[(d0 + 0) * VP + key] = (bf16_t)(w.x & 0xffffu); Vd[(d0 + 1) * VP + key] = (bf16_t)(w.x >> 16); Vd[(d0 + 2) * VP + key] = (bf16_t)(w.y & 0xffffu); Vd[(d0 + 3) * VP + key] = (bf16_t)(w.y >> 16); \
                Vd[(d0 + 4) * VP + key] = (bf16_t)(w.z & 0xffffu); Vd[(d0 + 5) * VP + key] = (bf16_t)(w.z >> 16); Vd[(d0 + 6) * VP + key] = (bf16_t)(w.w & 0xffffu); Vd[(d0 + 7) * VP + key] = (bf16_t)(w.w >> 16); } } while (0)
        SWA_LOAD(s0); SWA_WRITE(0);
        __syncthreads();
#pragma unroll 1
        for (int s = s0; s < 9; ++s) {
            const int buf = (s - s0) & 1;
            if (s + 1 < 9) SWA_LOAD(s + 1);
            const LAS bf16_t* Ks = (const LAS bf16_t*)(lds + buf * SWA_BUF); const LAS bf16_t* Vs = Ks + 64 * KP;
#pragma unroll 1
            for (int sc = 0; sc < 2; ++sc) {
                f32x4 sT[2][2];
#pragma unroll
                for (int qt = 0; qt < 2; ++qt) { sT[qt][0] = (f32x4){0.f, 0.f, 0.f, 0.f}; sT[qt][1] = (f32x4){0.f, 0.f, 0.f, 0.f}; }
#pragma unroll
                for (int ks = 0; ks < 4; ++ks)
#pragma unroll
                    for (int kt = 0; kt < 2; ++kt) { const bf16x8 ka = *(const LAS bf16x8*)(Ks + (sc * 32 + kt * 16 + fr) * KP + ks * 32 + fq * 8);
#pragma unroll
                        for (int qt = 0; qt < 2; ++qt) sT[qt][kt] = __builtin_amdgcn_mfma_f32_16x16x32_bf16(ka, qf[qt][ks], sT[qt][kt], 0, 0, 0); }
                bf16x8 pb[2];
                float cm[2];
#pragma unroll
                for (int qt = 0; qt < 2; ++qt) {
                    if (s < 5) {
                        const int qpos = n0 + qh * 32 + qt * 16 + fr;
#pragma unroll
                        for (int kt = 0; kt < 2; ++kt)
#pragma unroll
                            for (int e = 0; e < 4; ++e) { const int kpos = n0 - 128 + s * 64 + sc * 32 + kt * 16 + fq * 4 + e; const int dlt = qpos - kpos;
                                const bool ok = kpos >= 0 && kpos < SEQ && dlt <= 128 && dlt >= -128; sT[qt][kt][e] = ok ? sT[qt][kt][e] : -1e30f; } }
                    cm[qt] = fmaxf(fmaxf(fmaxf(sT[qt][0][0], sT[qt][0][1]), fmaxf(sT[qt][0][2], sT[qt][0][3])), fmaxf(fmaxf(sT[qt][1][0], sT[qt][1][1]), fmaxf(sT[qt][1][2], sT[qt][1][3])));
                }
                if (__any((cm[0] > m[0] + SWA_THR) || (cm[1] > m[1] + SWA_THR))) {
#pragma unroll
                    for (int qt = 0; qt < 2; ++qt) { float c = cm[qt]; c = fmaxf(c, __shfl_xor(c, 16)); c = fmaxf(c, __shfl_xor(c, 32));
                        const float mn = fmaxf(m[qt], c), scl = __expf(m[qt] - mn); m[qt] = mn; lsum[qt] *= scl;
#pragma unroll
                        for (int dt = 0; dt < 8; ++dt) O[qt][dt] = O[qt][dt] * scl; }
                }
#pragma unroll
                for (int qt = 0; qt < 2; ++qt) {
                    float pe[8]; float ps = 0.f;
#pragma unroll
                    for (int kt = 0; kt < 2; ++kt)
#pragma unroll
                        for (int e = 0; e < 4; ++e) { pe[kt * 4 + e] = __expf(sT[qt][kt][e] - m[qt]); ps += pe[kt * 4 + e]; }
                    lsum[qt] += ps;
                    u32x4 pw; pw.x = pk2(pe[0], pe[1]); pw.y = pk2(pe[2], pe[3]); pw.z = pk2(pe[4], pe[5]); pw.w = pk2(pe[6], pe[7]);
                    pb[qt] = __builtin_bit_cast(bf16x8, pw);
                }
#pragma unroll
                for (int dt = 0; dt < 8; ++dt) {
                    const bf16x4 v0 = *(const LAS bf16x4*)(Vs + (dt * 16 + fr) * VP + sc * 32 + 4 * fq), v1 = *(const LAS bf16x4*)(Vs + (dt * 16 + fr) * VP + sc * 32 + 16 + 4 * fq);
                    const bf16x8 va = __builtin_shufflevector(v0, v1, 0, 1, 2, 3, 4, 5, 6, 7);
#pragma unroll
                    for (int qt = 0; qt < 2; ++qt) O[qt][dt] = __builtin_amdgcn_mfma_f32_16x16x32_bf16(va, pb[qt], O[qt][dt], 0, 0, 0);
                }
            }
            if (s + 1 < 9) SWA_WRITE(buf ^ 1);
            __syncthreads();
        }
#undef SWA_ROW
#undef SWA_LOAD
#undef SWA_WRITE
#pragma unroll
        for (int qt = 0; qt < 2; ++qt) {
            float lt = lsum[qt]; lt += __shfl_xor(lt, 16); lt += __shfl_xor(lt, 32);
            const float inv = 1.0f / lt;
            bf16_t* o = MIX + (qrow0 + qh * 32 + qt * 16 + fr) * DM + 1024 + hq * 128 + fq * 4;
#pragma unroll
            for (int dt = 0; dt < 8; ++dt) { u32x2 w; w.x = pk2(O[qt][dt][0] * inv, O[qt][dt][1] * inv); w.y = pk2(O[qt][dt][2] * inv, O[qt][dt][3] * inv); *(u32x2*)(o + dt * 16) = w; }
        }
    }
}

__device__ __forceinline__ int chunk_row0(int cid) { return cid < 256 ? (cid >> 7) * SEQ + (cid & 127) * 64 : TL + ((cid - 256) >> 2) * CTXL + ((cid - 256) & 3) * 64; }
constexpr int GP = 72;

constexpr int LTP = 65;
__device__ __forceinline__ float wave_incl_scan(float x) {
    x += __builtin_bit_cast(float, __builtin_amdgcn_update_dpp(0, __builtin_bit_cast(int, x), 0x111, 0xF, 0xF, true));
    x += __builtin_bit_cast(float, __builtin_amdgcn_update_dpp(0, __builtin_bit_cast(int, x), 0x112, 0xF, 0xF, true));
    x += __builtin_bit_cast(float, __builtin_amdgcn_update_dpp(0, __builtin_bit_cast(int, x), 0x114, 0xF, 0xF, true));
    x += __builtin_bit_cast(float, __builtin_amdgcn_update_dpp(0, __builtin_bit_cast(int, x), 0x118, 0xF, 0xF, true));
    x += __builtin_bit_cast(float, __builtin_amdgcn_update_dpp(0, __builtin_bit_cast(int, x), 0x142, 0xA, 0xF, false));
    x += __builtin_bit_cast(float, __builtin_amdgcn_update_dpp(0, __builtin_bit_cast(int, x), 0x143, 0xC, 0xF, false));
    return x;
}
__device__ __forceinline__ void gla_g1(const Params& p, int l, LAS unsigned char* lds, int tid, int lane, int wave, int bid, int G) {
    LAS float* LTf = (LAS float*)lds; LAS float* LTb = LTf + 64 * LTP;
    LAS bf16_t* KTf = (LAS bf16_t*)(lds + 2 * 64 * LTP * 4); LAS bf16_t* KTb = KTf + 64 * GP;
    LAS bf16_t* VT = KTb + 64 * GP;
    const bf16_t* P = (const bf16_t*)(p.ws + WS_P);
    float* BF = (float*)(p.ws + WS_OF); float* BB = (float*)(p.ws + WS_OB);
    float* DELTA = (float*)(p.ws + WS_DELTA); float* DEC = (float*)(p.ws + WS_DEC);
    const float* w2 = p.in[I_GW2] + (size_t)l * 2 * 16 * 256; const float* b2 = p.in[I_GB2] + (size_t)l * 2 * 256;
    const int fr = lane & 15, fq = lane >> 4, ti = tid >> 3, tk0 = (tid & 7) * 8;
    float wr[2][16], br[2];
    const bool fixed_h = (G & 3) == 0;
#define G1_LOADW(hh_) do { _Pragma("unroll") for (int d = 0; d < 2; ++d) { br[d] = b2[d * 256 + (hh_) * 64 + lane]; \
        _Pragma("unroll") for (int q = 0; q < 16; ++q) wr[d][q] = w2[(d * 16 + q) * 256 + (hh_) * 64 + lane]; } } while (0)
    if (fixed_h) G1_LOADW(bid & 3);
    u32x4 kraw, vraw[2], lrr[2][4];
#define G1_LOADX(item_) do { const int cid_ = (item_) >> 2, h_ = (item_) & 3, row0_ = chunk_row0(cid_); \
        kraw = *(const u32x4*)(P + (size_t)(row0_ + ti) * INWP + C_GK + h_ * 64 + tk0); \
        _Pragma("unroll") for (int j = 0; j < 2; ++j) { const int vi = tid + NTHREADS * j; vraw[j] = *(const u32x4*)(P + (size_t)(row0_ + (vi >> 4)) * INWP + C_GV + h_ * 128 + (vi & 15) * 8); } \
        _Pragma("unroll") for (int jj = 0; jj < 2; ++jj) _Pragma("unroll") for (int c = 0; c < 4; ++c) lrr[jj][c] = *(const u32x4*)(P + (size_t)(row0_ + wave + 8 * jj) * INWP + C_LRF + c * 8); } while (0)
    if (bid < GLA_ITEMS) G1_LOADX(bid);
    for (int item = bid; item < GLA_ITEMS; item += G) {
        const int cid = item >> 2, h = item & 3, row0 = chunk_row0(cid);
        const u32x4 kraw_c = kraw; u32x4 vraw_c[2] = {vraw[0], vraw[1]};
        {
            if (!fixed_h) G1_LOADW(h);
#pragma unroll
            for (int jj = 0; jj < 8; ++jj) { const int i = wave + 8 * jj;
                float lf[4][8];
                if (jj < 2) {
#pragma unroll
                    for (int c = 0; c < 4; ++c) unpack8(lrr[jj][c], lf[c]);
                } else { const bf16_t* lrp = P + (size_t)(row0 + i) * INWP + C_LRF;
#pragma unroll
                    for (int c = 0; c < 4; ++c) unpack8(*(const u32x4*)(lrp + c * 8), lf[c]); }
#pragma unroll
                for (int d = 0; d < 2; ++d) { float z = br[d];
#pragma unroll
                    for (int q = 0; q < 16; ++q) z += lf[d * 2 + (q >> 3)][q & 7] * wr[d][q];
                    (d ? LTb : LTf)[lane * LTP + i] = log_sigmoid_f(z) * (1.0f / 16.0f); } }
        }
        if (item + G < GLA_ITEMS) G1_LOADX(item + G);
        __syncthreads();
#pragma unroll 2
        for (int kk = 0; kk < 8; ++kk) { const int k = wave * 8 + kk;
            float xf = LTf[k * LTP + lane], xb = LTb[k * LTP + lane];
            const float pf = wave_incl_scan(xf), pb = wave_incl_scan(xb);
            const float totb = __builtin_bit_cast(float, __builtin_amdgcn_readlane(__builtin_bit_cast(int, pb), 63));
            LTf[k * LTP + lane] = pf; LTb[k * LTP + lane] = totb - pb + xb; }
        __syncthreads();
        { float kv[8]; unpack8(kraw_c, kv);
          float bfv[8], bbv[8];
#pragma unroll
          for (int e = 0; e < 8; ++e) { const int k = tk0 + e; bfv[e] = LTf[k * LTP + ti]; bbv[e] = LTb[k * LTP + ti];
              KTf[k * GP + ti] = (bf16_t)f2bf(kv[e] * __expf(LTf[k * LTP + 63] - bfv[e]));
              KTb[k * GP + ti] = (bf16_t)f2bf(kv[e] * __expf(LTb[k * LTP] - bbv[e])); }
          float* bg = BF + (size_t)(row0 + ti) * 256 + h * 64 + tk0; *(f32x4*)bg = (f32x4){bfv[0], bfv[1], bfv[2], bfv[3]}; *(f32x4*)(bg + 4) = (f32x4){bfv[4], bfv[5], bfv[6], bfv[7]};
          bg = BB + (size_t)(row0 + ti) * 256 + h * 64 + tk0; *(f32x4*)bg = (f32x4){bbv[0], bbv[1], bbv[2], bbv[3]}; *(f32x4*)(bg + 4) = (f32x4){bbv[4], bbv[5], bbv[6], bbv[7]};
#pragma unroll
          for (int j = 0; j < 2; ++j) { const int vi = tid + NTHREADS * j, i = vi >> 4, v0 = (vi & 15) * 8; const u32x4 w = vraw_c[j];
              VT[(v0 + 0) * GP + i] = (bf16_t)(w.x & 0xffffu); VT[(v0 + 1) * GP + i] = (bf16_t)(w.x >> 16); VT[(v0 + 2) * GP + i] = (bf16_t)(w.y & 0xffffu); VT[(v0 + 3) * GP + i] = (bf16_t)(w.y >> 16);
              VT[(v0 + 4) * GP + i] = (bf16_t)(w.z & 0xffffu); VT[(v0 + 5) * GP + i] = (bf16_t)(w.z >> 16); VT[(v0 + 6) * GP + i] = (bf16_t)(w.w & 0xffffu); VT[(v0 + 7) * GP + i] = (bf16_t)(w.w >> 16); }
          if (tid < 128) { const int dir = tid >> 6, k = tid & 63; DEC[((size_t)item * 2 + dir) * 64 + k] = __expf(dir ? LTb[k * LTP] : LTf[k * LTP + 63]); } }
        __syncthreads();
        { const int dir = wave >> 2, vq = wave & 3; const LAS bf16_t* KT = dir ? KTb : KTf;
            f32x4 acc[2][4];
#pragma unroll
            for (int a = 0; a < 2; ++a)
#pragma unroll
                for (int b = 0; b < 4; ++b) acc[a][b] = (f32x4){0.f, 0.f, 0.f, 0.f};
#pragma unroll
            for (int ks = 0; ks < 2; ++ks) { bf16x8 af[2], bfr[4];
#pragma unroll
                for (int a = 0; a < 2; ++a) af[a] = *(const LAS bf16x8*)(VT + ((vq * 2 + a) * 16 + fr) * GP + ks * 32 + fq * 8);
#pragma unroll
                for (int b = 0; b < 4; ++b) bfr[b] = *(const LAS bf16x8*)(KT + (b * 16 + fr) * GP + ks * 32 + fq * 8);
#pragma unroll
                for (int a = 0; a < 2; ++a)
#pragma unroll
                    for (int b = 0; b < 4; ++b) acc[a][b] = __builtin_amdgcn_mfma_f32_16x16x32_bf16(af[a], bfr[b], acc[a][b], 0, 0, 0); }
            float* dst = DELTA + ((size_t)item * 2 + dir) * 8192;
#pragma unroll
            for (int a = 0; a < 2; ++a)
#pragma unroll
                for (int b = 0; b < 4; ++b)
#pragma unroll
                    for (int g = 0; g < 4; ++g) dst[((vq * 2 + a) * 16 + fq * 4 + g) * 64 + b * 16 + fr] = acc[a][b][g]; }
        __syncthreads();
    }
}

#undef G1_LOADW
#undef G1_LOADX
__device__ __forceinline__ void gla_g2(const Params& p, int tid, int bid, int G) {
    const float* DELTA = (const float*)(p.ws + WS_DELTA); const float* DEC = (const float*)(p.ws + WS_DEC); bf16_t* SST = (bf16_t*)(p.ws + WS_SST);
    for (int u = bid; u < 64; u += G) {
        const int s = u >> 2, dir = s >> 3, b = (s >> 2) & 1, h = s & 3, off = ((u & 3) * NTHREADS + tid) * 4, k0 = off & 63;
        f32x4 S = (f32x4){0.f, 0.f, 0.f, 0.f};
#pragma unroll 1
        for (int st = 0; st < 132; st += 12) {
            f32x4 d[12], dc[12]; size_t base[12];
#pragma unroll
            for (int q = 0; q < 12; ++q) { const int t = st + q;
                const int cid = t < 4 ? 256 + b * 4 + (dir ? 3 - t : t) : b * 128 + (dir ? 127 - (t - 4) : (t - 4));
                const size_t it2 = (size_t)(cid * 4 + h) * 2 + dir; base[q] = it2 * 8192 + off;
                d[q] = *(const f32x4*)(DELTA + base[q]); dc[q] = *(const f32x4*)(DEC + it2 * 64 + k0); }
#pragma unroll
            for (int q = 0; q < 12; ++q) { u32x2 o; o.x = pk2(S.x, S.y); o.y = pk2(S.z, S.w); *(u32x2*)(SST + base[q]) = o; S = dc[q] * S + d[q]; }
        }
    }
}

__device__ __forceinline__ void gla_g3(const Params& p, int l, LAS unsigned char* lds, int tid, int lane, int wave, int bid, int G, unsigned* qhead3 = nullptr) {
    LAS bf16_t* QEf = (LAS bf16_t*)lds; LAS bf16_t* QEb = QEf + 64 * GP; LAS bf16_t* KEf = QEb + 64 * GP; LAS bf16_t* KEb = KEf + 64 * GP;
    LAS bf16_t* VT = KEb + 64 * GP;
    LAS bf16_t* ATT = VT + 128 * GP + wave * (16 * GP);
    LAS float* RS = (LAS float*)(lds + 2 * (4 * 64 * GP + 128 * GP + 8 * 16 * GP));
    const bf16_t* P = (const bf16_t*)(p.ws + WS_P);
    const float* BF = (const float*)(p.ws + WS_OF); const float* BB = (const float*)(p.ws + WS_OB);
    const bf16_t* SST = (const bf16_t*)(p.ws + WS_SST); bf16_t* MIX = (bf16_t*)(p.ws + WS_MIX);
    const float* nw = p.in[I_GNORM] + l * 128;
    const int fr = lane & 15, fq = lane >> 4, it = wave >> 1, vh = wave & 1, ti = tid >> 3, tk0 = (tid & 7) * 8;
    const int n_items = (l < DEPTH - 1) ? GLA_ITEMS : 256 * 4;
    volatile LAS int* itw3 = (volatile LAS int*)(lds + MISC_OFF + 64);
    for (int item = bid;; item += G) {
        if (qhead3) {
            if (tid == 0) itw3[0] = (int)__hip_atomic_fetch_add(qhead3, 1u, __ATOMIC_RELAXED, __HIP_MEMORY_SCOPE_AGENT);
            __syncthreads(); item = itw3[0]; __syncthreads(); }
        if (item >= n_items) break;
        const int cid = item >> 2, h = item & 3, row0 = chunk_row0(cid);
        {
            const size_t r = (size_t)(row0 + ti);
            const u32x4 qraw = *(const u32x4*)(P + r * INWP + C_GQ + h * 64 + tk0), kraw = *(const u32x4*)(P + r * INWP + C_GK + h * 64 + tk0);
            const f32x4 f0 = *(const f32x4*)(BF + r * 256 + h * 64 + tk0), f1 = *(const f32x4*)(BF + r * 256 + h * 64 + tk0 + 4);
            const f32x4 b0 = *(const f32x4*)(BB + r * 256 + h * 64 + tk0), b1 = *(const f32x4*)(BB + r * 256 + h * 64 + tk0 + 4);
            u32x4 vraw[2];
#pragma unroll
            for (int j = 0; j < 2; ++j) { const int vi = tid + NTHREADS * j; vraw[j] = *(const u32x4*)(P + (size_t)(row0 + (vi >> 4)) * INWP + C_GV + h * 128 + (vi & 15) * 8); }
            float q[8], kk[8]; unpack8(qraw, q); unpack8(kraw, kk);
            const float bf[8] = {f0.x, f0.y, f0.z, f0.w, f1.x, f1.y, f1.z, f1.w}, bb[8] = {b0.x, b0.y, b0.z, b0.w, b1.x, b1.y, b1.z, b1.w};
            float o0[8], o1[8], o2[8], o3[8];
#pragma unroll
            for (int e = 0; e < 8; ++e) { const float ef = __expf(bf[e]), eb = __expf(bb[e]); const float qs = q[e] * 0.125f;
                o0[e] = qs * ef; o1[e] = kk[e] / ef; o2[e] = qs * eb; o3[e] = kk[e] / eb; }
            *(LAS u32x4*)(QEf + ti * GP + tk0) = pack8(o0); *(LAS u32x4*)(KEf + ti * GP + tk0) = pack8(o1); *(LAS u32x4*)(QEb + ti * GP + tk0) = pack8(o2); *(LAS u32x4*)(KEb + ti * GP + tk0) = pack8(o3);
#pragma unroll
            for (int j = 0; j < 2; ++j) { const int vi = tid + NTHREADS * j, i = vi >> 4, v0 = (vi & 15) * 8; const u32x4 w = vraw[j];
                VT[(v0 + 0) * GP + i] = (bf16_t)(w.x & 0xffffu); VT[(v0 + 1) * GP + i] = (bf16_t)(w.x >> 16); VT[(v0 + 2) * GP + i] = (bf16_t)(w.y & 0xffffu); VT[(v0 + 3) * GP + i] = (bf16_t)(w.y >> 16);
                VT[(v0 + 4) * GP + i] = (bf16_t)(w.z & 0xffffu); VT[(v0 + 5) * GP + i] = (bf16_t)(w.z >> 16); VT[(v0 + 6) * GP + i] = (bf16_t)(w.w & 0xffffu); VT[(v0 + 7) * GP + i] = (bf16_t)(w.w >> 16); }
        }
        float gt[4][4];
#pragma unroll
        for (int g = 0; g < 4; ++g)
#pragma unroll
            for (int vt = 0; vt < 4; ++vt) gt[g][vt] = bflo((unsigned)P[(size_t)(row0 + it * 16 + fq * 4 + g) * INWP + C_GG + h * 128 + (vh * 4 + vt) * 16 + fr]);
        __syncthreads();
        f32x4 acc[4];
#pragma unroll
        for (int vt = 0; vt < 4; ++vt) acc[vt] = (f32x4){0.f, 0.f, 0.f, 0.f};
#pragma unroll
        for (int dir = 0; dir < 2; ++dir) {
            const LAS bf16_t* QE = dir ? QEb : QEf; const LAS bf16_t* KE = dir ? KEb : KEf;
            bf16x8 qa[2], sbf[2][4];
            const bf16_t* Sg = SST + ((size_t)item * 2 + dir) * 8192;
#pragma unroll
            for (int ks = 0; ks < 2; ++ks)
#pragma unroll
                for (int vt = 0; vt < 4; ++vt) sbf[ks][vt] = *(const bf16x8*)(Sg + ((vh * 4 + vt) * 16 + fr) * 64 + ks * 32 + fq * 8);
#pragma unroll
            for (int ks = 0; ks < 2; ++ks) qa[ks] = *(const LAS bf16x8*)(QE + (it * 16 + fr) * GP + ks * 32 + fq * 8);
#pragma unroll
            for (int jt = 0; jt < 4; ++jt) { f32x4 a = (f32x4){0.f, 0.f, 0.f, 0.f};
#pragma unroll
                for (int ks = 0; ks < 2; ++ks) { const bf16x8 kb = *(const LAS bf16x8*)(KE + (jt * 16 + fr) * GP + ks * 32 + fq * 8); a = __builtin_amdgcn_mfma_f32_16x16x32_bf16(qa[ks], kb, a, 0, 0, 0); }
#pragma unroll
                for (int g = 0; g < 4; ++g) { const int ii = it * 16 + fq * 4 + g, jj = jt * 16 + fr; const bool keep = dir ? (jj >= ii) : (jj <= ii);
                    ATT[(fq * 4 + g) * GP + jt * 16 + fr] = (bf16_t)f2bf(keep ? a[g] : 0.f); } }
            LDS_FENCE();
#pragma unroll
            for (int ks = 0; ks < 2; ++ks) { const bf16x8 aa = *(const LAS bf16x8*)(ATT + fr * GP + ks * 32 + fq * 8);
#pragma unroll
                for (int vt = 0; vt < 4; ++vt) { const int v = (vh * 4 + vt) * 16 + fr;
                    const bf16x8 vb = *(const LAS bf16x8*)(VT + v * GP + ks * 32 + fq * 8);
                    acc[vt] = __builtin_amdgcn_mfma_f32_16x16x32_bf16(aa, vb, acc[vt], 0, 0, 0);
                    acc[vt] = __builtin_amdgcn_mfma_f32_16x16x32_bf16(qa[ks], sbf[ks][vt], acc[vt], 0, 0, 0); } }
            LDS_FENCE();
        }
        float ss[4];
#pragma unroll
        for (int g = 0; g < 4; ++g) { float t = 0.f;
#pragma unroll
            for (int vt = 0; vt < 4; ++vt) t += acc[vt][g] * acc[vt][g];
            ss[g] = row16_sum(t); }
        if (fr == 0) {
#pragma unroll
            for (int g = 0; g < 4; ++g) RS[(it * 16 + fq * 4 + g) * 2 + vh] = ss[g]; }
        __syncthreads();
#pragma unroll
        for (int g = 0; g < 4; ++g) { const int i = it * 16 + fq * 4 + g; const float tot = RS[i * 2] + RS[i * 2 + 1];
            const float rs = 1.0f / sqrtf(tot * (1.0f / 128.0f) + LN_EPS); const size_t r = (size_t)(row0 + i);
#pragma unroll
            for (int vt = 0; vt < 4; ++vt) { const int v = (vh * 4 + vt) * 16 + fr;
                MIX[r * DM + 512 + h * 128 + v] = (bf16_t)f2bf(acc[vt][g] * rs * nw[v] * silu_f(gt[g][vt])); } }
        __syncthreads();
    }
}

__device__ __forceinline__ void ln_row(f32x4 (&v)[8], const float* lg, const float* lb, int lane) {
    float s = 0.f;
#pragma unroll
    for (int j = 0; j < 8; ++j) s += (v[j].x + v[j].y) + (v[j].z + v[j].w);
    const float mean = wave_sum(s) * (1.0f / DM);
    float s2 = 0.f;
#pragma unroll
    for (int j = 0; j < 8; ++j) { v[j] = v[j] - mean; s2 += (v[j].x * v[j].x + v[j].y * v[j].y) + (v[j].z * v[j].z + v[j].w * v[j].w); }
    const float rstd = 1.0f / sqrtf(wave_sum(s2) * (1.0f / DM) + LN_EPS);
#pragma unroll
    for (int j = 0; j < 8; ++j) { const int c = lane * 4 + 256 * j; const f32x4 g = *(const f32x4*)(lg + c), b = *(const f32x4*)(lb + c); v[j] = v[j] * rstd * g + b; }
}

__device__ __forceinline__ void phase_ln1(const Params& p, int l, LAS unsigned char* lds, int tid, int lane, int wave, int bid, int G) {
    const int gw = bid * NWAVES + wave, NGW = G * NWAVES;
    const float* MOD = (const float*)(p.ws + WS_MOD); const bf16_t* Y = (const bf16_t*)(p.ws + WS_Y); const float* YP = (const float*)(p.ws + WS_YPART);
    bf16_t* XM = (bf16_t*)(p.ws + WS_XM); bf16_t* HB = (bf16_t*)(p.ws + WS_HB);
    LAS float* VEC = (LAS float*)lds;
    for (int i = tid; i < 11 * DM / 4; i += NTHREADS) { const int vi = i / (DM / 4), c = (i % (DM / 4)) * 4;
        const float* src = vi < 9 ? MOD + (size_t)(l * 3 + (vi % 3)) * 6 * DM + (2 + vi / 3) * DM + c : (vi == 9 ? p.in[I_LNG] : p.in[I_LNB]) + (size_t)(l * 2 + 0) * DM + c;
        *(LAS f32x4*)(VEC + vi * DM + c) = *(const f32x4*)src; }
    __syncthreads();
    f32x4 xn[8]; u32x2 yn[8];
#define LN1_LOAD(rr) do { if (l == 0) { const float* xr_ = xsrc(p, 0, (rr)); _Pragma("unroll") for (int j = 0; j < 8; ++j) xn[j] = *(const f32x4*)(xr_ + lane * 4 + 256 * j); } \
        else { const bf16_t* xb_ = (const bf16_t*)(p.ws + WS_XL) + (size_t)(rr) * DM; _Pragma("unroll") for (int j = 0; j < 8; ++j) { const u32x2 w_ = *(const u32x2*)(xb_ + lane * 4 + 256 * j); xn[j] = (f32x4){bflo(w_.x), bfhi(w_.x), bflo(w_.y), bfhi(w_.y)}; } } \
        if ((rr) < TL) { _Pragma("unroll") for (int j = 0; j < 8; ++j) yn[j] = *(const u32x2*)(Y + (size_t)(rr) * DM + lane * 4 + 256 * j); } } while (0)
    if (row_first(wave, bid, G) >= 0) LN1_LOAD(row_first(wave, bid, G));
    for (int r = row_first(wave, bid, G); r >= 0; r = row_next(r, wave, bid, G, TA)) {
        const int st = row_stream(r);
        f32x4 v[8], yy[8];
#pragma unroll
        for (int j = 0; j < 8; ++j) v[j] = xn[j];
        if (r < TL) {
#pragma unroll
            for (int j = 0; j < 8; ++j) yy[j] = (f32x4){bflo(yn[j].x), bfhi(yn[j].x), bflo(yn[j].y), bfhi(yn[j].y)};
        } else {
#pragma unroll
            for (int j = 0; j < 8; j += 2) { f32x4 pp[2][8];
#pragma unroll
                for (int jj = 0; jj < 2; ++jj)
#pragma unroll
                    for (int ks = 0; ks < 8; ++ks) pp[jj][ks] = *(const f32x4*)(YP + ((size_t)ks * 512 + (r - TL)) * DM + lane * 4 + 256 * (j + jj));
#pragma unroll
                for (int jj = 0; jj < 2; ++jj) yy[j + jj] = ((pp[jj][0] + pp[jj][1]) + (pp[jj][2] + pp[jj][3])) + ((pp[jj][4] + pp[jj][5]) + (pp[jj][6] + pp[jj][7])); }
        }
        { const int rn = row_next(r, wave, bid, G, TA); if (rn >= 0) LN1_LOAD(rn); }
#pragma unroll
        for (int j = 0; j < 8; ++j) { const f32x4 g = *(const LAS f32x4*)(VEC + st * DM + lane * 4 + 256 * j); v[j] = v[j] * DN_ALPHA + g * yy[j]; }
        float s = 0.f;
#pragma unroll
        for (int j = 0; j < 8; ++j) s += (v[j].x + v[j].y) + (v[j].z + v[j].w);
        const float mean = wave_sum(s) * (1.0f / DM);
        float s2 = 0.f;
#pragma unroll
        for (int j = 0; j < 8; ++j) { v[j] = v[j] - mean; s2 += (v[j].x * v[j].x + v[j].y * v[j].y) + (v[j].z * v[j].z + v[j].w * v[j].w); }
        const float rstd = 1.0f / sqrtf(wave_sum(s2) * (1.0f / DM) + LN_EPS);
#pragma unroll
        for (int j = 0; j < 8; ++j) { const int c = lane * 4 + 256 * j;
            const f32x4 g = *(const LAS f32x4*)(VEC + 9 * DM + c), b = *(const LAS f32x4*)(VEC + 10 * DM + c), sh = *(const LAS f32x4*)(VEC + (3 + st) * DM + c), sc = *(const LAS f32x4*)(VEC + (6 + st) * DM + c);
            const f32x4 o = v[j] * rstd * g + b;
            { u32x2 xw; xw.x = pk2(o.x, o.y); xw.y = pk2(o.z, o.w); *(u32x2*)(XM + (size_t)r * DM + c) = xw; }
            u32x2 w; w.x = pk2(o.x * (1.f + sc.x) + sh.x, o.y * (1.f + sc.y) + sh.y); w.y = pk2(o.z * (1.f + sc.z) + sh.z, o.w * (1.f + sc.w) + sh.w);
            *(u32x2*)(HB + (size_t)r * DM + c) = w; }
    }
#undef LN1_LOAD
}

constexpr int SKP = 136;
__device__ __forceinline__ unsigned f2key(float f) { const unsigned u = __builtin_bit_cast(unsigned, f); return u ^ ((u >> 31) ? 0xFFFFFFFFu : 0x80000000u); }
__device__ __forceinline__ float key2f(unsigned k) { const unsigned u = (k >> 31) ? (k ^ 0x80000000u) : ~k; return __builtin_bit_cast(float, u); }
__device__ __forceinline__ unsigned row16_max_u32(unsigned k) {
    unsigned o;
    o = (unsigned)__builtin_amdgcn_update_dpp(0, (int)k, 0xB1, 0xF, 0xF, false); k = k > o ? k : o;
    o = (unsigned)__builtin_amdgcn_update_dpp(0, (int)k, 0x4E, 0xF, 0xF, false); k = k > o ? k : o;
    o = (unsigned)__builtin_amdgcn_update_dpp(0, (int)k, 0x141, 0xF, 0xF, false); k = k > o ? k : o;
    o = (unsigned)__builtin_amdgcn_update_dpp(0, (int)k, 0x140, 0xF, 0xF, false); k = k > o ? k : o;
    return k;
}
__device__ __forceinline__ void peer_retrieve(const Params& p, int l, LAS unsigned char* lds, int tid, int lane, int wave, int bid, int G, int ntok) {
    LAS bf16_t* SK = (LAS bf16_t*)lds;
    const bf16_t* SUBB = (const bf16_t*)(p.ws + WS_SUBB) + (size_t)l * 2 * 128 * 128;
#pragma unroll 1
    for (int j = 0; j < 8; ++j) { const int vv = tid + NTHREADS * j, row = vv >> 4, c = vv & 15; *(LAS u32x4*)(SK + row * SKP + c * 8) = *(const u32x4*)(SUBB + row * 128 + c * 8); }
    __syncthreads();
    const bf16_t* QP = (const bf16_t*)(p.ws + WS_QP); const float* QPP = (const float*)(p.ws + WS_QPART);
    int* EIDX = (int*)(p.ws + WS_EIDX); float* EGATE = (float*)(p.ws + WS_EGATE);
    const int gw = bid * NWAVES + wave, NGW = G * NWAVES, fr = lane & 15, fq = lane >> 4, gbase = lane & 48;
    const int nitems = (ntok / 16) * 8;
    const int nmain = nitems / NGW, nfull = nmain * NGW, nextra = (wave == 0 && nfull + bid < nitems) ? (nitems - nfull - bid + G - 1) / G : 0;
    for (int ri = 0; ri < nmain + nextra; ++ri) {
        const int item = ri < nmain ? gw + NGW * ri : nfull + bid + (ri - nmain) * G;
        const int tile = item >> 3, h = item & 7;
        unsigned tkp[2][4];
        bf16x8 afr[2][4];
        if (tile * 16 < TL) {
#pragma unroll
            for (int pp = 0; pp < 2; ++pp)
#pragma unroll
                for (int ks = 0; ks < 4; ++ks) afr[pp][ks] = *(const bf16x8*)(QP + (size_t)(tile * 16 + fr) * DM + h * 256 + pp * 128 + ks * 32 + fq * 8);
        } else {
#pragma unroll
            for (int pp = 0; pp < 2; ++pp)
#pragma unroll
                for (int ks = 0; ks < 4; ++ks) { const float* qp = QPP + (size_t)(tile * 16 - TL + fr) * DM + h * 256 + pp * 128 + ks * 32 + fq * 8;
                    f32x4 pa[8], pb[8];
#pragma unroll
                    for (int sl = 0; sl < 8; ++sl) { pa[sl] = *(const f32x4*)(qp + (size_t)sl * 512 * DM); pb[sl] = *(const f32x4*)(qp + (size_t)sl * 512 * DM + 4); }
                    const f32x4 s0 = ((pa[0] + pa[1]) + (pa[2] + pa[3])) + ((pa[4] + pa[5]) + (pa[6] + pa[7])), s1 = ((pb[0] + pb[1]) + (pb[2] + pb[3])) + ((pb[4] + pb[5]) + (pb[6] + pb[7]));
                    u32x4 w; w.x = pk2(s0.x, s0.y); w.y = pk2(s0.z, s0.w); w.z = pk2(s1.x, s1.y); w.w = pk2(s1.z, s1.w); afr[pp][ks] = __builtin_bit_cast(bf16x8, w); }
        }
#pragma unroll
        for (int pp = 0; pp < 2; ++pp) {
            asm volatile("" ::: "memory"); __builtin_amdgcn_sched_barrier(0);
            f32x4 acc[8];
#pragma unroll
            for (int kt = 0; kt < 8; ++kt) acc[kt] = (f32x4){0.f, 0.f, 0.f, 0.f};
#pragma unroll
            for (int ks = 0; ks < 4; ++ks) { const bf16x8 a = afr[pp][ks];
#pragma unroll
                for (int kt = 0; kt < 8; ++kt) { const bf16x8 bb = *(const LAS bf16x8*)(SK + (pp * 128 + kt * 16 + fr) * SKP + ks * 32 + fq * 8); acc[kt] = __builtin_amdgcn_mfma_f32_16x16x32_bf16(a, bb, acc[kt], 0, 0, 0); } }
            unsigned kv[4][8];
#pragma unroll
            for (int g = 0; g < 4; ++g)
#pragma unroll
                for (int kt = 0; kt < 8; ++kt) kv[g][kt] = (f2key(acc[kt][g]) & ~127u) | (unsigned)(127 - (kt * 16 + fr));
#define CSWAP(a_, b_) do { const unsigned hi_ = a_ > b_ ? a_ : b_, lo_ = a_ > b_ ? b_ : a_; a_ = hi_; b_ = lo_; } while (0)
#pragma unroll
            for (int g = 0; g < 4; ++g) {
                CSWAP(kv[g][0], kv[g][1]); CSWAP(kv[g][2], kv[g][3]); CSWAP(kv[g][4], kv[g][5]); CSWAP(kv[g][6], kv[g][7]);
                CSWAP(kv[g][0], kv[g][2]); CSWAP(kv[g][1], kv[g][3]); CSWAP(kv[g][4], kv[g][6]); CSWAP(kv[g][5], kv[g][7]);
                CSWAP(kv[g][1], kv[g][2]); CSWAP(kv[g][5], kv[g][6]);
                CSWAP(kv[g][0], kv[g][4]); CSWAP(kv[g][1], kv[g][5]); CSWAP(kv[g][2], kv[g][6]); CSWAP(kv[g][3], kv[g][7]);
                CSWAP(kv[g][2], kv[g][4]); CSWAP(kv[g][3], kv[g][5]);
                CSWAP(kv[g][1], kv[g][2]); CSWAP(kv[g][3], kv[g][4]); CSWAP(kv[g][5], kv[g][6]);
            }
#undef CSWAP
            unsigned tk[4] = {0u, 0u, 0u, 0u};
#pragma unroll 1
            for (int it = 0; it < 16; ++it) {
#pragma unroll
                for (int g = 0; g < 4; ++g) {
                    const unsigned m = row16_max_u32(kv[g][0]);
                    tk[g] = fr == it ? m : tk[g];
                    const bool won = kv[g][0] == m;
#pragma unroll
                    for (int kt = 0; kt < 7; ++kt) kv[g][kt] = won ? kv[g][kt + 1] : kv[g][kt];
                    kv[g][7] = won ? 0u : kv[g][7];
                }
            }
#pragma unroll
            for (int g = 0; g < 4; ++g) tkp[pp][g] = tk[g];
        }
        float av[4], bv[4]; int ptr[4]; unsigned best[4];
#pragma unroll
        for (int g = 0; g < 4; ++g) { av[g] = key2f(tkp[0][g] & ~127u); bv[g] = key2f(tkp[1][g] & ~127u); ptr[g] = 0; best[g] = 0u; }
#pragma unroll 1
        for (int it = 0; it < 16; ++it) {
#pragma unroll
            for (int g = 0; g < 4; ++g) {
                const float bj = __shfl(bv[g], gbase + (ptr[g] & 15));
                const unsigned mine = ptr[g] < 16 ? ((f2key(av[g] + bj) & ~255u) | (unsigned)(255 - (fr * 16 + (ptr[g] & 15)))) : 0u;
                const unsigned m = row16_max_u32(mine);
                best[g] = fr == it ? m : best[g];
                ptr[g] += (m == mine) ? 1 : 0;
            }
        }
#pragma unroll
        for (int g = 0; g < 4; ++g) {
            const int bc = 255 - (int)(best[g] & 255u);
            const float bval = key2f(best[g] & ~255u);
            const int k1 = 127 - (int)(tkp[0][g] & 127u), k2 = 127 - (int)(tkp[1][g] & 127u);
            const int i1 = __shfl(k1, gbase + (bc >> 4)), i2 = __shfl(k2, gbase + (bc & 15));
            const float mx = __shfl(bval, gbase);
            const float ex = __expf(bval - mx);
            const float sm = row16_sum(ex);
            const size_t tok = (size_t)tile * 16 + fq * 4 + g;
            EIDX[tok * 128 + h * 16 + fr] = i1 * 128 + i2; EGATE[tok * 128 + h * 16 + fr] = ex / sm;
        }
    }
}

template <int CTRL> __device__ __forceinline__ float dppf(float x) { return __builtin_bit_cast(float, __builtin_amdgcn_mov_dpp(__builtin_bit_cast(int, x), CTRL, 0xf, 0xf, true)); }
__device__ __forceinline__ float rs_group8(float (&d)[8], bool b8) {
    asm volatile("s_nop 1\n\tv_permlane32_swap_b32 %0, %4\n\tv_permlane32_swap_b32 %1, %5\n\tv_permlane32_swap_b32 %2, %6\n\tv_permlane32_swap_b32 %3, %7"
                 : "+v"(d[0]), "+v"(d[1]), "+v"(d[2]), "+v"(d[3]), "+v"(d[4]), "+v"(d[5]), "+v"(d[6]), "+v"(d[7]));
    float s0 = d[0] + d[4], s1 = d[1] + d[5], s2 = d[2] + d[6], s3 = d[3] + d[7];
    asm volatile("s_nop 1\n\tv_permlane16_swap_b32 %0, %2\n\tv_permlane16_swap_b32 %1, %3" : "+v"(s0), "+v"(s1), "+v"(s2), "+v"(s3));
    const float t0 = s0 + s2, t1 = s1 + s3;
    const float m = b8 ? t1 : t0, o = b8 ? t0 : t1;
    return m + dppf<0x128>(o);
}
template <int CTRL> __device__ __forceinline__ float rs_merge(float a, float b, bool bit) { const float m = bit ? b : a, o = bit ? a : b; return m + dppf<CTRL>(o); }
constexpr int PG = 8;
__device__ __forceinline__ void phase_peer(const Params& p, int l, LAS unsigned char* lds, int tid, int lane, int wave, int bid, int G) {
    const int gw = bid * NWAVES + wave, NGW = G * NWAVES;
    const float* MOD = (const float*)(p.ws + WS_MOD);
    bf16_t* XL = (bf16_t*)(p.ws + WS_XL); bf16_t* HB = (bf16_t*)(p.ws + WS_HB);
    const float* lg = p.in[I_LNG] + (size_t)(l * 2 + 1) * DM; const float* lb = p.in[I_LNB] + (size_t)(l * 2 + 1) * DM;
    const unsigned char* UB = p.ws + WS_UB + (size_t)l * NEXP * ROWB_U; const unsigned char* VB = p.ws + WS_VB + (size_t)l * NEXP * ROWB_V;
    const float* USC = (const float*)(p.ws + WS_USC) + (size_t)l * NEXP; (void)USC; const float* VSC = (const float*)(p.ws + WS_VSC) + (size_t)l * NEXP; (void)VSC;
    const int* EIDX = (const int*)(p.ws + WS_EIDX); const float* EGATE = (const float*)(p.ws + WS_EGATE);
    const bool last = (l == DEPTH - 1);
    const int nrows = last ? TL : TA;
    constexpr int HLW = 64 * 33 * 4 + 128;
    LAS float* HL = (LAS float*)(lds + wave * HLW) + lane * 33;
    LAS int* PI = (LAS int*)((LAS float*)(lds + wave * HLW) + 64 * 33);
#define VQ(tt_) ((((tt_) * 64) + lane) << 2)
    LAS float* VEC = (LAS float*)(lds + 8 * HLW);
    for (int i = tid; i < 11 * DM / 4; i += NTHREADS) { const int vi = i / (DM / 4), c = (i % (DM / 4)) * 4; const int ln = last ? l : l + 1;
        const float* src = vi < 3 ? MOD + (size_t)(l * 3 + vi) * 6 * DM + 5 * DM + c : (vi < 9 ? MOD + (size_t)(ln * 3 + (vi % 3)) * 6 * DM + (vi / 3 - 1) * DM + c : (vi == 9 ? lg : lb) + c);
        *(LAS f32x4*)(VEC + vi * DM + ((((c >> 2) & 7) * 64 + (c >> 5)) << 2)) = *(const f32x4*)src; }
    __syncthreads();
#if !TBL_U_FP4
    {
        float one = 1.0f; asm volatile("" : "+v"(one));
        f32x16 t0, t1;
#pragma unroll
        for (int c = 0; c < 32; ++c) { const float v = one * (c < 8 ? (float)c * 0.125f : (1.0f + (float)(c & 7) * 0.125f) * (float)(1 << ((c >> 3) - 1))); if (c < 16) t0[c] = v; else t1[c - 16] = v; }
        const u32x6 pw = pack_fp6_2x16(t0, t1);
        const f32x32 un = unpack_fp6_32(pw);
#pragma unroll
        for (int j = 0; j < 32; ++j) { const float y = un[j]; int c;
            if (y < 1.0f) c = (int)(y * 8.0f + 0.5f); else { const int e = y < 2.0f ? 0 : (y < 4.0f ? 1 : 2); c = 8 * (e + 1) + (int)((y / (float)(1 << e) - 1.0f) * 8.0f + 0.5f); }
            if (lane == 0) PI[j] = c & 31; }
        LDS_FENCE();
#if defined(DIAG_PI)
        { unsigned mk = 0u;
#pragma unroll
          for (int j = 0; j < 32; ++j) mk |= 1u << PI[j];
          if (mk != 0xFFFFFFFFu && l == 0 && gw == 0 && lane == 0) ((float*)(p.ws + WS_CTL + 131072))[0] = 1.0f; }
#endif
    }
#endif
    const unsigned ulane = (unsigned)lane & 63u, loff16 = ulane * 16u; (void)ulane; (void)loff16;
    const bool lb8 = (lane & 8) != 0, lb4 = (lane & 4) != 0, lb2 = (lane & 2) != 0, lb1 = (lane & 1) != 0; (void)lb8; (void)lb4; (void)lb2; (void)lb1;
    const int lsrc = ((lane & 6) << 3) | ((lane & 1) << 3) | (((lane >> 3) & 1) << 2) | (((lane >> 4) & 1) << 1) | ((lane >> 5) & 1); (void)lsrc;
    for (int r = row_first(wave, bid, G); r >= 0; r = row_next(r, wave, bid, G, nrows)) {
        const float* mod = MOD + (size_t)(l * 3 + row_stream(r)) * 6 * DM;
        f32x2v hn[16];
#pragma unroll
        for (int c = 0; c < 4; ++c) { float f[8]; unpack8(*(const u32x4*)(HB + (size_t)r * DM + lane * 32 + c * 8), f);
#pragma unroll
            for (int e = 0; e < 4; ++e) hn[c * 4 + e] = (f32x2v){f[2 * e], f[2 * e + 1]}; }
#if !TBL_U_FP4
#pragma unroll
        for (int j = 0; j < 16; ++j) { HL[2 * j] = hn[j].x; HL[2 * j + 1] = hn[j].y; }
        LDS_FENCE();
        f32x2v hf[16];
#pragma unroll
        for (int j = 0; j < 16; ++j) hf[j] = (f32x2v){HL[PI[2 * j]], HL[PI[2 * j + 1]]};
        LDS_FENCE();
#endif
#if TBL_U_I4
        int hlo[4], hhi[4]; unsigned basel;
        { float am = 0.f;
#pragma unroll
          for (int j = 0; j < 16; ++j) am = fmaxf(am, fmaxf(fabsf(hn[j].x), fabsf(hn[j].y)));
          const unsigned ab = __builtin_bit_cast(unsigned, am * (1.0f / 119.0f)); unsigned eb = (ab >> 23) + ((ab & 0x007fffffu) ? 1u : 0u); eb = eb < 1u ? 1u : (eb > 253u ? 253u : eb);
          const float inv = __builtin_bit_cast(float, (254u - eb) << 23);
          basel = U_ROWSCALE ? (eb << 23) : (I4_BASE + ((eb - 127u) << 23));
#pragma unroll
          for (int d = 0; d < 4; ++d) { unsigned tl = 0u, th = 0u;
#pragma unroll
              for (int e = 0; e < 8; ++e) { const f32x2v pr = hn[d * 4 + (e >> 1)]; const float xv = (e & 1) ? pr.y : pr.x;
                  const unsigned qb = __builtin_bit_cast(unsigned, xv * inv + 12582912.0f);
                  tl |= (qb & 15u) << (4 * e); th |= (((qb + 8u) >> 4) & 15u) << (4 * e); }
              hlo[d] = (int)tl; hhi[d] = (int)th; } }
#endif
        const int e0 = EIDX[(size_t)r * 128 + lane], e1 = EIDX[(size_t)r * 128 + 64 + lane];
        const float g0 = EGATE[(size_t)r * 128 + lane], g1 = EGATE[(size_t)r * 128 + 64 + lane];
#if !TBL_U_FP4 || U_ROWSCALE
        const float su0 = USC[e0], su1 = USC[e1];
#else
        const float su0 = 1.0f, su1 = 1.0f;
#endif
        float wgt[2] = {0.f, 0.f};
#define P4_LOAD(dq, ds, TB, eh, j0) do { unsigned lo_ = loff16, ul_ = ulane; asm volatile("" : "+v"(lo_), "+v"(ul_));    \
        _Pragma("unroll") for (int c = 0; c < PG; ++c) { const int e_ = __builtin_amdgcn_readlane(eh, (j0) + c); \
            const unsigned char* rp_ = (TB) + (size_t)e_ * ROWB4; dq[c] = *(const u32x4*)(rp_ + lo_); ds[c] = rp_[1024u + ul_]; } } while (0)
#if V_ROWSCALE
#define P4_LDV P4_LOADU
#else
#define P4_LDV P4_LOAD
#endif
#if U_ROWSCALE
#define P4_LDU P4_LOADU
#else
#define P4_LDU P4_LOAD
#endif
#define P4_LOADU(dq, ds, TB, eh, j0) do { const __amdgpu_buffer_rsrc_t rs_ = __builtin_amdgcn_make_buffer_rsrc((void*)(TB), 0, NEXP * 1024, 0x00020000); \
        _Pragma("unroll") for (int c = 0; c < PG; ++c) { const int e_ = __builtin_amdgcn_readlane(eh, (j0) + c); \
            dq[c] = __builtin_bit_cast(u32x4, __builtin_amdgcn_raw_buffer_load_b128(rs_, (int)loff16, (int)(((unsigned)e_ & 0x3fffu) << 10), 0)); ds[c] = e_; } } while (0)
#define P4_CVT(dq, c, d, b, sc) __builtin_amdgcn_cvt_scalef32_pk_f32_fp4(dq[c][d], sc, b)
#if TBL_U_I4
#define P4_DOT(dq, ds, rr) do { float d_[PG]; _Pragma("unroll") for (int c = 0; c < PG; ++c) { int t_ = 0;        \
            _Pragma("unroll") for (int d = 0; d < 4; ++d) t_ = __builtin_amdgcn_sdot8((int)dq[c][d], hhi[d], t_, false); \
            t_ <<= 4; \
            _Pragma("unroll") for (int d = 0; d < 4; ++d) t_ = __builtin_amdgcn_sdot8((int)dq[c][d], hlo[d], t_, false); \
            d_[c] = (float)t_ * (U_ROWSCALE ? __builtin_bit_cast(float, basel) : __builtin_bit_cast(float, ((unsigned)ds[c] << 20) + basel)); } \
        rr = rs_group8(d_, lb8); } while (0)
#else
#define P4_DOT(dq, ds, rr) do { float d_[PG]; _Pragma("unroll") for (int c = 0; c < PG; ++c) { const float sc_ = __builtin_bit_cast(float, (unsigned)ds[c] << 23); f32x2v a0_ = (f32x2v){0.f, 0.f}, a1_ = (f32x2v){0.f, 0.f}; \
            _Pragma("unroll") for (int d = 0; d < 4; ++d) { a0_ += P4_CVT(dq, c, d, 0, sc_) * hn[d * 4 + 0]; a1_ += P4_CVT(dq, c, d, 1, sc_) * hn[d * 4 + 1]; a0_ += P4_CVT(dq, c, d, 2, sc_) * hn[d * 4 + 2]; a1_ += P4_CVT(dq, c, d, 3, sc_) * hn[d * 4 + 3]; } \
            d_[c] = (a0_.x + a0_.y) + (a1_.x + a1_.y); asm volatile("" : "+v"(d_[c])); } \
        rr = rs_group8(d_, lb8); } while (0)
#endif
#define P4_AXPY(dq, ds, wh, j0) do { _Pragma("unroll") for (int c = 0; c < PG; ++c) { const float wj_ = V_ROWSCALE ? __builtin_bit_cast(float, (unsigned)ds[c] & 0xffff0000u) : __builtin_bit_cast(float, __builtin_amdgcn_readlane(wh, (j0) + c)); const f32x2v w2_ = (f32x2v){wj_, wj_}; \
            const float sc_ = V_ROWSCALE ? 1.0f : __builtin_bit_cast(float, (unsigned)ds[c] << 23); \
            _Pragma("unroll") for (int d = 0; d < 4; ++d) { yv[d * 4 + 0] += P4_CVT(dq, c, d, 0, sc_) * w2_; yv[d * 4 + 1] += P4_CVT(dq, c, d, 1, sc_) * w2_; yv[d * 4 + 2] += P4_CVT(dq, c, d, 2, sc_) * w2_; yv[d * 4 + 3] += P4_CVT(dq, c, d, 3, sc_) * w2_; } \
            asm volatile("" : "+v"(yv[0]), "+v"(yv[1]), "+v"(yv[2]), "+v"(yv[3]), "+v"(yv[4]), "+v"(yv[5]), "+v"(yv[6]), "+v"(yv[7]), "+v"(yv[8]), "+v"(yv[9]), "+v"(yv[10]), "+v"(yv[11]), "+v"(yv[12]), "+v"(yv[13]), "+v"(yv[14]), "+v"(yv[15]));   } } while (0)
#if !TBL_U_FP4
#define PEER_LOAD(dq, dd, TB, eh, j0) do { _Pragma("unroll") for (int c = 0; c < PG; ++c) { const int e_ = __builtin_amdgcn_readlane(eh, (j0) + c); \
            const unsigned char* rp_ = (TB) + (size_t)e_ * ROWB; dq[c] = *(const u32x4*)(rp_ + lane * 16); dd[c] = *(const u32x2*)(rp_ + 1024 + lane * 8); } } while (0)
#define PEER_UNPACK(dq, dd, c) unpack_fp6_32((u32x6){dq[c].x, dq[c].y, dq[c].z, dq[c].w, dd[c].x, dd[c].y})
#define PEER_DOT(dq, dd, j0) do { float d_[PG]; _Pragma("unroll") for (int c = 0; c < PG; ++c) { const f32x32 u_ = PEER_UNPACK(dq, dd, c); f32x2v a0_ = (f32x2v){0.f, 0.f}, a1_ = (f32x2v){0.f, 0.f}; \
            _Pragma("unroll") for (int t = 0; t < 8; ++t) { a0_ += (f32x2v){u_[4 * t], u_[4 * t + 1]} * hf[2 * t]; a1_ += (f32x2v){u_[4 * t + 2], u_[4 * t + 3]} * hf[2 * t + 1]; } \
            d_[c] = (a0_.x + a0_.y) + (a1_.x + a1_.y); __builtin_amdgcn_sched_barrier(0); } \
        _Pragma("unroll") for (int o = 1; o < 64; o <<= 1) { _Pragma("unroll") for (int c = 0; c < PG; ++c) d_[c] += __shfl_xor(d_[c], o); } \
        _Pragma("unroll") for (int c = 0; c < PG; ++c) wacc = (lane == (j0) + c) ? d_[c] : wacc; } while (0)
#endif
#pragma unroll
        for (int hh = 0; hh < 2; ++hh) {
            const int eh = hh ? e1 : e0; float wacc = 0.f;
#if TBL_U_FP4
            u32x4 qa[PG], qb[PG]; int sa[PG], sb[PG];
            P4_LDU(qa, sa, UB, eh, 0);
            float wq = 0.f, wp = 0.f;
#pragma unroll 1
            for (int j0 = 0; j0 < 64; j0 += 2 * PG) {
                float ra, rb;
                P4_LDU(qb, sb, UB, eh, j0 + PG);
                P4_DOT(qa, sa, ra);
                if (j0 + 2 * PG < 64) P4_LDU(qa, sa, UB, eh, j0 + 2 * PG);
                P4_DOT(qb, sb, rb);
                const float q = rs_merge<0x141>(ra, rb, lb4);
                if ((j0 & 16) == 0) wq = q;
                else { const float pm = rs_merge<0x4E>(wq, q, lb2);
                       if (j0 == 16) wp = pm; else wacc = rs_merge<0xB1>(wp, pm, lb1); }
            }
            wacc = __shfl(wacc, lsrc);
#else
            u32x4 qa[PG], qb[PG]; u32x2 da[PG], db[PG];
            PEER_LOAD(qa, da, UB, eh, 0);
#pragma unroll 1
            for (int j0 = 0; j0 < 64; j0 += 2 * PG) {
                PEER_LOAD(qb, db, UB, eh, j0 + PG);
                PEER_DOT(qa, da, j0);
                if (j0 + 2 * PG < 64) PEER_LOAD(qa, da, UB, eh, j0 + 2 * PG);
                PEER_DOT(qb, db, j0 + PG);
            }
#endif
            wgt[hh] = gelu_f(wacc * (hh ? su1 : su0)) * (hh ? g1 : g0) * (V_ROWSCALE ? VSC[eh] : 1.0f);
        }
        f32x2v yv[16];
#pragma unroll
        for (int i = 0; i < 16; ++i) yv[i] = (f32x2v){0.f, 0.f};
#pragma unroll
        for (int hh = 0; hh < 2; ++hh) {
            const int eh = V_ROWSCALE ? ((hh ? e1 : e0) | (int)((__builtin_bit_cast(unsigned, wgt[hh]) + 0x8000u) & 0xffff0000u)) : (hh ? e1 : e0); const int wh = __builtin_bit_cast(int, wgt[hh]); (void)wh;
            u32x4 qa[PG], qb[PG]; int sa[PG], sb[PG];
            P4_LDV(qa, sa, VB, eh, 0);
#pragma unroll 1
            for (int j0 = 0; j0 < 64; j0 += 2 * PG) {
                P4_LDV(qb, sb, VB, eh, j0 + PG);
                P4_AXPY(qa, sa, wh, j0);
                if (j0 + 2 * PG < 64) P4_LDV(qa, sa, VB, eh, j0 + 2 * PG);
                P4_AXPY(qb, sb, wh, j0 + PG);
            }
        }
#undef P4_LOAD
#undef P4_CVT
#undef P4_DOT
#undef P4_AXPY
#if !TBL_U_FP4
#undef PEER_LOAD
#undef PEER_UNPACK
#undef PEER_DOT
#endif
        const int st = row_stream(r);
        const bf16_t* xr = (const bf16_t*)(p.ws + WS_XM) + (size_t)r * DM + lane * 32;
        f32x4 xv[8];
#pragma unroll
        for (int t = 0; t < 4; ++t) { const u32x4 w = *(const u32x4*)(xr + t * 8); xv[2 * t] = (f32x4){bflo(w.x), bfhi(w.x), bflo(w.y), bfhi(w.y)}; xv[2 * t + 1] = (f32x4){bflo(w.z), bfhi(w.z), bflo(w.w), bfhi(w.w)}; }
        float s = 0.f;
#pragma unroll
        for (int t = 0; t < 8; ++t) { const f32x4 ga = *(const LAS f32x4*)(VEC + st * DM + VQ(t));
            f32x2v& ya = yv[t * 2]; f32x2v& yb = yv[t * 2 + 1];
            ya.x = xv[t].x * DN_ALPHA + ga.x * ya.x; ya.y = xv[t].y * DN_ALPHA + ga.y * ya.y; yb.x = xv[t].z * DN_ALPHA + ga.z * yb.x; yb.y = xv[t].w * DN_ALPHA + ga.w * yb.y;
            s += (ya.x + ya.y) + (yb.x + yb.y); }
        const float mean = wave_sum(s) * (1.0f / DM);
        float s2 = 0.f;
#pragma unroll
        for (int i = 0; i < 16; ++i) { yv[i] = yv[i] - mean; s2 += yv[i].x * yv[i].x + yv[i].y * yv[i].y; }
        const float rstd = 1.0f / sqrtf(wave_sum(s2) * (1.0f / DM) + LN_EPS);
        float* dst = p.out + (size_t)r * DM + lane * 32; bf16_t* dstb = XL + (size_t)r * DM + lane * 32;
#pragma unroll
        for (int t = 0; t < 8; t += 2) { const int c = t * 4;
            const f32x4 ga = *(const LAS f32x4*)(VEC + 9 * DM + VQ(t)), gb = *(const LAS f32x4*)(VEC + 9 * DM + VQ(t + 1)), ba = *(const LAS f32x4*)(VEC + 10 * DM + VQ(t)), bb = *(const LAS f32x4*)(VEC + 10 * DM + VQ(t + 1));
            const f32x2v y0 = yv[t * 2], y1 = yv[t * 2 + 1], y2 = yv[t * 2 + 2], y3 = yv[t * 2 + 3];
            f32x4 o0, o1;
            o0.x = y0.x * rstd * ga.x + ba.x; o0.y = y0.y * rstd * ga.y + ba.y; o0.z = y1.x * rstd * ga.z + ba.z; o0.w = y1.y * rstd * ga.w + ba.w;
            o1.x = y2.x * rstd * gb.x + bb.x; o1.y = y2.y * rstd * gb.y + bb.y; o1.z = y3.x * rstd * gb.z + bb.z; o1.w = y3.y * rstd * gb.w + bb.w;
            if (last) { *(f32x4*)(dst + c) = o0; *(f32x4*)(dst + c + 4) = o1; }
            else { u32x4 xw; xw.x = pk2(o0.x, o0.y); xw.y = pk2(o0.z, o0.w); xw.z = pk2(o1.x, o1.y); xw.w = pk2(o1.z, o1.w); *(u32x4*)(dstb + c) = xw; }
            if (!last) {
                const f32x4 sa = *(const LAS f32x4*)(VEC + (3 + st) * DM + VQ(t)), sb = *(const LAS f32x4*)(VEC + (3 + st) * DM + VQ(t + 1)), ca = *(const LAS f32x4*)(VEC + (6 + st) * DM + VQ(t)), cb = *(const LAS f32x4*)(VEC + (6 + st) * DM + VQ(t + 1));
                u32x4 o; o.x = pk2(o0.x * (1.f + ca.x) + sa.x, o0.y * (1.f + ca.y) + sa.y); o.y = pk2(o0.z * (1.f + ca.z) + sa.z, o0.w * (1.f + ca.w) + sa.w);
                o.z = pk2(o1.x * (1.f + cb.x) + sb.x, o1.y * (1.f + cb.y) + sb.y); o.w = pk2(o1.z * (1.f + cb.z) + sb.z, o1.w * (1.f + cb.w) + sb.w);
                *(u32x4*)(HB + (size_t)r * DM + lane * 32 + c) = o; }
        }
#if defined(DIAG_PI)
        if (last && r == 5 && lane == 0 && ((const float*)(p.ws + WS_CTL + 131072))[0] != 0.0f) p.out[(size_t)5 * DM] = __builtin_nanf("");
#endif
    }
}

#undef VQ
__device__ __forceinline__ void gemm_rows_bf16(LAS unsigned char* lds, const bf16_t* A, const bf16_t* Bt, bf16_t* C, float* Cpart, bool with_ctx, int G, int bid) {
    { pg8::Gemm g{A, Bt, TL, DM, DM, DM}; pg8::StaticOrder S; S.init(TL, DM, G, bid); pg8::EpiBf16<0> E{C, DM, nullptr, 0, 0, 1.f};
      pg8::gemm_phase<pg8::EpiBf16<0>, pg8::StaticOrder, PG8_ALIGN, PG8_SP2>(lds, g, S, E); }
    if (with_ctx) { int ksl = 256; asm volatile("" : "+s"(ksl));
      pg8::Gemm g{A + (size_t)TL * DM, Bt, TC, DM, ksl, DM}; pg8::SplitKOrder S; S.init(G, bid); pg8::EpiF32Part E{Cpart};
      pg8::gemm_phase<pg8::EpiF32Part, pg8::SplitKOrder, PG8_ALIGN, PG8_SP2>(lds, g, S, E); }
}

constexpr int PH_PER_LAYER = 9, N_PHASES = 2 + DEPTH * PH_PER_LAYER;
__global__ void __launch_bounds__(NTHREADS, 2) fwd_kernel(Params p) {
    extern __shared__ __attribute__((aligned(16))) unsigned char lds_raw[];
    LAS unsigned char* lds = (LAS unsigned char*)lds_raw;
    const int tid = threadIdx.x, lane = tid & 63, wave = __builtin_amdgcn_readfirstlane(tid >> 6), bid = blockIdx.x, G = gridDim.x;
    volatile LAS unsigned* MISC = (volatile LAS unsigned*)(lds + MISC_OFF);
    if (tid < 32) MISC[tid] = 0u;
    __syncthreads();
    if (hipThreadIdx_x == 0) (void)xb_add(&((unsigned*)(p.ws + WS_CTL))[CW_BAR + XB_XCNT(xb_xcc_id())], 1u);
#define IN(k) true
#if defined(PROBE_MASK)
    volatile LAS unsigned long long* PT = (volatile LAS unsigned long long*)(lds + MISC_OFF + 96);
    if (tid == 0) PT[0] = __builtin_amdgcn_s_memrealtime();
#define SEAM(k) do { { XcdBarrier bar_; bar_.bar = (unsigned*)(((const __attribute__((address_space(4))) Params*)__builtin_amdgcn_kernarg_segment_ptr())->ws + WS_CTL) + CW_BAR; bar_.x = xb_xcc_id(); bar_.st = MISC + 8; xcd_barrier(bar_); } if (bid == 0) { const int kind_ = (k) < 2 ? (k) : 2 + ((k) - 2) % PH_PER_LAYER; \
        if (tid == 0) { const unsigned long long now_ = __builtin_amdgcn_s_memrealtime(); if ((PROBE_MASK >> kind_) & 1) { const unsigned long long d_ = (now_ - PT[0]) * PROBE_MULT; \
            while (__builtin_amdgcn_s_memrealtime() - now_ < d_) __builtin_amdgcn_s_sleep(8); } PT[0] = __builtin_amdgcn_s_memrealtime(); } __syncthreads(); } } while (0)
#elif defined(PROBE_DUP_BAR)
#define SEAM(k) do { XcdBarrier bar_; bar_.bar = (unsigned*)(((const __attribute__((address_space(4))) Params*)__builtin_amdgcn_kernarg_segment_ptr())->ws + WS_CTL) + CW_BAR; bar_.x = xb_xcc_id(); bar_.st = MISC + 8; xcd_barrier(bar_); xcd_barrier(bar_); } while (0)
#else
#define SEAM(k) do { XcdBarrier bar_; bar_.bar = (unsigned*)(((const __attribute__((address_space(4))) Params*)__builtin_amdgcn_kernarg_segment_ptr())->ws + WS_CTL) + CW_BAR; bar_.x = xb_xcc_id(); bar_.st = MISC + 8; xcd_barrier(bar_); } while (0)
#endif
    const int NGW = G * NWAVES;
#if defined(__HIP_DEVICE_COMPILE__)
#define KARGS_COPY const Params p_ = *kp_
#else
#define KARGS_COPY const Params p_ = p; (void)kp_
#endif
#define FRESH() int tid_ = threadIdx.x, bid_ = blockIdx.x; asm volatile("" : "+v"(tid_), "+s"(bid_)); const int lane_ = tid_ & 63, wave_ = __builtin_amdgcn_readfirstlane(tid_ >> 6); (void)lane_; (void)wave_; \
    const __attribute__((address_space(4))) Params* kp_ = (const __attribute__((address_space(4))) Params*)__builtin_amdgcn_kernarg_segment_ptr(); asm volatile("" : "+s"(kp_)); KARGS_COPY
    if (IN(0)) { FRESH(); phase_prologue(p_, lds, tid_, lane_, wave_, bid_, G); }
    SEAM(0);
    if (IN(1)) { FRESH(); phase_modulate0(p_, lane_, wave_, bid_, G); }
    SEAM(1);
    for (int l = 0; l < DEPTH; ++l) {
        const int b0 = 2 + l * PH_PER_LAYER;
        if (IN(b0 + 0)) { FRESH();
            pg8::Gemm g{(const bf16_t*)(p_.ws + WS_HB), (const bf16_t*)(p_.ws + WS_WIN) + (size_t)l * INWP * DM, TA, INWP, DM, DM}; pg8::StaticOrder S; S.init(TA, INWP, G, bid_);
            pg8::EpiBf16<0> E{(bf16_t*)(p_.ws + WS_P), INWP, nullptr, 0, 0, 1.f};
            pg8::gemm_phase<pg8::EpiBf16<0>, pg8::StaticOrder, PG8_ALIGN, PG8_SP2>(lds, g, S, E);
#if defined(PROBE_DUP_GEMM)
            __syncthreads(); pg8::gemm_phase<pg8::EpiBf16<0>, pg8::StaticOrder, PG8_ALIGN, PG8_SP2>(lds, g, S, E);
#endif
        }
        SEAM(b0 + 0);
        if (IN(b0 + 1)) { { FRESH(); gla_g1(p_, l, lds, tid_, lane_, wave_, bid_, G); } { FRESH(); phase_post_in(p_, l, lane_, wave_, bid_, G); } }
#if defined(PROBE_DUP_A)
        if (IN(b0 + 1)) { __syncthreads(); { FRESH(); gla_g1(p_, l, lds, tid_, lane_, wave_, bid_, G); } { FRESH(); phase_post_in(p_, l, lane_, wave_, bid_, G); } }
#endif
        SEAM(b0 + 1);
        if (IN(b0 + 2)) {
            unsigned* ctl_ = (unsigned*)(((const __attribute__((address_space(4))) Params*)__builtin_amdgcn_kernarg_segment_ptr())->ws + WS_CTL);
            { FRESH(); gla_g2(p_, tid_, bid_, G);
              if (bid_ < 64) { asm volatile("s_waitcnt vmcnt(0)" ::: "memory"); __syncthreads();
                  if (tid_ == 0) { __builtin_amdgcn_fence(__ATOMIC_RELEASE, "agent"); asm volatile("s_waitcnt vmcnt(0)" ::: "memory"); (void)xb_add(ctl_ + CW_QUEUE + 64 * (12 + l), 1u); } } }
            { FRESH(); phase_mixers(p_, l, lds, tid_, lane_, wave_, bid_, G); }
            { FRESH();
              if (tid_ == 0) { unsigned* bar = ctl_ + CW_BAR; XB_SPIN(xb_ld(ctl_ + CW_QUEUE + 64 * (12 + l)) < (G < 64 ? (unsigned)G : 64u), bar);
                  __builtin_amdgcn_fence(__ATOMIC_ACQUIRE, "agent"); asm volatile("s_waitcnt vmcnt(0)" ::: "memory"); }
              __syncthreads();
              gla_g3(p_, l, lds, tid_, lane_, wave_, bid_, G, ctl_ + CW_QUEUE + 64 * (8 + l)); }
        }
#if defined(PROBE_DUP_B)
        if (IN(b0 + 2)) { __syncthreads(); { FRESH(); gla_g2(p_, tid_, bid_, G); } { FRESH(); phase_mixers(p_, l, lds, tid_, lane_, wave_, bid_, G, 1); } }
#endif
#if defined(PROBE_DUP_C)
        if (IN(b0 + 3)) { __syncthreads(); FRESH(); gla_g3(p_, l, lds, tid_, lane_, wave_, bid_, G); }
#endif
        SEAM(b0 + 3);
        if (IN(b0 + 4)) { FRESH();
            gemm_rows_bf16(lds, (const bf16_t*)(p_.ws + WS_MIX), (const bf16_t*)(p_.ws + WS_WOUT) + (size_t)l * DM * DM, (bf16_t*)(p_.ws + WS_Y), (float*)(p_.ws + WS_YPART), l < DEPTH - 1, G, bid_);
#if defined(PROBE_DUP_GEMM)
            __syncthreads(); gemm_rows_bf16(lds, (const bf16_t*)(p_.ws + WS_MIX), (const bf16_t*)(p_.ws + WS_WOUT) + (size_t)l * DM * DM, (bf16_t*)(p_.ws + WS_Y), (float*)(p_.ws + WS_YPART), l < DEPTH - 1, G, bid_);
#endif
        }
        SEAM(b0 + 4);
        if (IN(b0 + 5)) { FRESH(); phase_ln1(p_, l, lds, tid_, lane_, wave_, bid_, G); }
#if defined(PROBE_DUP_E)
        if (IN(b0 + 5)) { __syncthreads(); FRESH(); phase_ln1(p_, l, lds, tid_, lane_, wave_, bid_, G); }
#endif
        SEAM(b0 + 5);
        if (IN(b0 + 6)) { FRESH();
            gemm_rows_bf16(lds, (const bf16_t*)(p_.ws + WS_HB), (const bf16_t*)(p_.ws + WS_WQ) + (size_t)l * DM * DM, (bf16_t*)(p_.ws + WS_QP), (float*)(p_.ws + WS_QPART), l < DEPTH - 1, G, bid_);
#if defined(PROBE_DUP_GEMM)
            __syncthreads(); gemm_rows_bf16(lds, (const bf16_t*)(p_.ws + WS_HB), (const bf16_t*)(p_.ws + WS_WQ) + (size_t)l * DM * DM, (bf16_t*)(p_.ws + WS_QP), (float*)(p_.ws + WS_QPART), l < DEPTH - 1, G, bid_);
#endif
        }
        SEAM(b0 + 6);
        if (IN(b0 + 7)) { FRESH(); peer_retrieve(p_, l, lds, tid_, lane_, wave_, bid_, G, l < DEPTH - 1 ? TA : TL); }
#if defined(PROBE_DUP_D)
        if (IN(b0 + 7)) { __syncthreads(); FRESH(); peer_retrieve(p_, l, lds, tid_, lane_, wave_, bid_, G, l < DEPTH - 1 ? TA : TL); }
#endif
        SEAM(b0 + 7);
        if (IN(b0 + 8)) { FRESH(); phase_peer(p_, l, lds, tid_, lane_, wave_, bid_, G); }
        if (l < DEPTH - 1) SEAM(b0 + 8);
    }
#undef FRESH
#undef IN
#undef SEAM
}

#ifndef MK_PER_PHASE
#define MK_PER_PHASE 0
#endif
extern "C" void kernel_launch(void* const* d_in, const int* in_sizes, int n_in, void* d_out, int out_size, void* d_ws, size_t ws_size, hipStream_t stream) {
    static int grid = 0;
    if (grid == 0) {
        if (n_in != 19 || out_size != TL * DM || ws_size < WS_END) { fprintf(stderr, "kernel_launch: unexpected shapes (n_in %d out %d ws %zu)\n", n_in, out_size, ws_size); grid = -1; return; }
        int dev = 0, cus = 0;
        if (hipGetDevice(&dev) != hipSuccess || hipDeviceGetAttribute(&cus, hipDeviceAttributeMultiprocessorCount, dev) != hipSuccess) { grid = -1; return; }
        if (hipFuncSetAttribute((const void*)fwd_kernel, hipFuncAttributeMaxDynamicSharedMemorySize, LDS_BYTES) != hipSuccess) { fprintf(stderr, "kernel_launch: hipFuncSetAttribute failed\n"); grid = -1; return; }
        int per_cu = 0;
        (void)hipOccupancyMaxActiveBlocksPerMultiprocessor(&per_cu, (const void*)fwd_kernel, NTHREADS, LDS_BYTES);
        (void)hipGetLastError();
        if (per_cu < 1) fprintf(stderr, "kernel_launch: occupancy query reports %d blocks per CU\n", per_cu);
        grid = cus;
    }
    if (grid < 0) return;
    (void)hipMemsetAsync((char*)d_ws + WS_CTL, 0, CTL_ZERO_BYTES, stream);
    Params p{};
    for (int i = 0; i < 19; ++i) p.in[i] = (const float*)d_in[i];
    p.out = (float*)d_out; p.ws = (unsigned char*)d_ws;
#if MK_PER_PHASE
    for (int ph = 0; ph < N_PHASES; ++ph) { p.ph_lo = ph; p.ph_hi = ph + 1; hipLaunchKernelGGL(fwd_kernel, dim3(grid), dim3(NTHREADS), LDS_BYTES, stream, p); }
#else
    p.ph_lo = 0; p.ph_hi = N_PHASES;
    hipLaunchKernelGGL(fwd_kernel, dim3(grid), dim3(NTHREADS), LDS_BYTES, stream, p);
#endif
}
```

```cpp
#include <hip/hip_runtime.h>
#include <cstdio>
#include <cstdint>

#define LAS __attribute__((address_space(3)))
typedef unsigned short bf16_t;
typedef short bf16x8 __attribute__((ext_vector_type(8)));
typedef float f32x4 __attribute__((ext_vector_type(4)));
typedef unsigned u32x4 __attribute__((ext_vector_type(4)));
typedef unsigned u32x2 __attribute__((ext_vector_type(2)));
typedef unsigned u32x6 __attribute__((ext_vector_type(6)));
typedef float f32x2v __attribute__((ext_vector_type(2)));
typedef float f32x16 __attribute__((ext_vector_type(16)));
typedef float f32x32 __attribute__((ext_vector_type(32)));

constexpr int DM = 2048, NBATCH = 2, SEQ = 8192, DEPTH = 4, CTXL = 256;
constexpr int TL = NBATCH * SEQ, TC = NBATCH * CTXL, TA = TL + TC;
constexpr int INW = 4640, INWP = 4864;
constexpr int C_CX = 0, C_CB = 512, C_CC = 1024, C_GQ = 1536, C_GK = 1792, C_GV = 2048, C_GG = 2560, C_LRF = 3072, C_LRB = 3088,
              C_SQ = 3104, C_SK = 4128, C_SV = 4384;
constexpr int NEXP = 16384;
constexpr int ROWB = 1536;
constexpr int ROWB4 = 1088;
#ifndef TBL_U_FP4
#define TBL_U_FP4 1
#endif
#ifndef TBL_U_I4
#define TBL_U_I4 (TBL_U_FP4)
#endif
constexpr unsigned I4_BASE = 103u << 23;
#ifndef U_ROWSCALE
#define U_ROWSCALE (TBL_U_I4)
#endif
#ifndef V_ROWSCALE
#define V_ROWSCALE 1
#endif
constexpr int ROWB_U = U_ROWSCALE ? 1024 : (TBL_U_FP4 ? ROWB4 : ROWB), ROWB_V = V_ROWSCALE ? 1024 : ROWB4;
constexpr float DN_ALPHA = 1.6817928305074290f;
constexpr float LN_EPS = 1e-6f;
constexpr int NWAVES = 8, NTHREADS = 512;

constexpr size_t MiB = 1u << 20;
constexpr size_t WS_CTL = 0, CTL_ZERO_BYTES = 256 * 1024;
constexpr size_t WS_MOD = 2 * MiB;
constexpr size_t WS_WIN = 4 * MiB;
constexpr size_t WS_WOUT = 80 * MiB;
constexpr size_t WS_WQ = 112 * MiB;
constexpr size_t WS_XL = 144 * MiB;
constexpr size_t WS_HB = 276 * MiB;
constexpr size_t WS_P = 342 * MiB;
constexpr size_t WS_QR = 656 * MiB;
constexpr size_t WS_KR = 720 * MiB;
constexpr size_t WS_ALF = 736 * MiB;
constexpr size_t WS_ALB = 753 * MiB;
constexpr size_t WS_OF = 770 * MiB;
constexpr size_t WS_OB = 803 * MiB;
constexpr size_t WS_MIX = 836 * MiB;
constexpr size_t WS_Y = 902 * MiB;
constexpr size_t WS_QP = 1034 * MiB;
constexpr size_t WS_DELTA = 1166 * MiB;
constexpr size_t WS_DEC = 1233 * MiB;
constexpr size_t WS_SST = 1234 * MiB;
constexpr size_t WS_UB = 1268 * MiB;
constexpr size_t WS_VB = 1524 * MiB;
constexpr size_t WS_EIDX = 1780 * MiB;
constexpr size_t WS_EGATE = 1789 * MiB;
constexpr size_t WS_SUBB = 1798 * MiB;
constexpr size_t WS_USC = 1799 * MiB;
constexpr size_t WS_VSC = 1799 * MiB + 512 * 1024;
constexpr size_t WS_YPART = 1800 * MiB;
constexpr size_t WS_QPART = 1832 * MiB;
constexpr size_t WS_XM = 1864 * MiB;
constexpr size_t WS_END = 1996 * MiB;
constexpr int GLA_ITEMS = (TA / 64) * 4;
static_assert(WS_DELTA + (size_t)GLA_ITEMS * 2 * 8192 * 4 <= WS_DEC && WS_DEC + (size_t)GLA_ITEMS * 2 * 64 * 4 <= WS_SST && WS_SST + (size_t)GLA_ITEMS * 2 * 8192 * 2 <= WS_END, "map");
static_assert(WS_WIN + (size_t)4 * INWP * DM * 2 <= WS_WOUT, "map");
static_assert(WS_P + (size_t)TA * INWP * 2 <= WS_QR, "map");
static_assert(WS_XL + (size_t)TA * DM * 4 <= WS_HB, "map");
constexpr int CW_BAR = 4096;
constexpr int CW_QUEUE = 8192;
constexpr int LDS_BYTES = 163840;
constexpr int MISC_OFF = 163840 - 512;

#define XB_TMO      128
#define XB_XCNT(j)  (256  + 64 * (j))
#define XB_XSUB(j)  (1280 + 64 * (j))
#define XB_XGEN(j)  (2304 + 64 * (j))
#define XB_TOP      3328
#define XB_TOPGEN   3392
#define XCD_BAR_WORDS 3456
#define XB_SPIN_CAP (1u << 18)
__device__ __forceinline__ unsigned xb_ld(unsigned* p)              { return __hip_atomic_load(p, __ATOMIC_RELAXED, __HIP_MEMORY_SCOPE_AGENT); }
__device__ __forceinline__ unsigned xb_add(unsigned* p, unsigned v) { return __hip_atomic_fetch_add(p, v, __ATOMIC_RELAXED, __HIP_MEMORY_SCOPE_AGENT); }
__device__ __forceinline__ unsigned xb_xcc_id() { return (unsigned)__builtin_amdgcn_s_getreg((3 << 11) | 20) & 0xFu; }
#define XB_SPIN(cond, bar) do { unsigned _sp = 0; while (cond) { __builtin_amdgcn_s_sleep(1); \
    if ((++_sp & 255u) == 0u) { if (xb_ld(&(bar)[XB_TMO])) break; if (_sp > XB_SPIN_CAP) { atomicAdd(&(bar)[XB_TMO], 1u); break; } } } } while (0)
struct XcdBarrier { unsigned* bar; unsigned x; volatile LAS unsigned* st; };
__device__ __forceinline__ XcdBarrier xcd_barrier_post(unsigned* bar, volatile LAS unsigned* st) {
    XcdBarrier b; b.bar = bar; b.x = xb_xcc_id(); b.st = st;
    if (threadIdx.x == 0) (void)xb_add(&bar[XB_XCNT(b.x)], 1u);
    return b;
}
__device__ __forceinline__ void xcd_barrier_complete(unsigned* bar, unsigned x, unsigned& nloc, unsigned& nx) {
    const unsigned G = gridDim.x * gridDim.y * gridDim.z;
    unsigned sum, cnt, mine, sp = 0u;
    for (;;) {
        sum = 0u; cnt = 0u; mine = 0u;
#pragma unroll
        for (unsigned j = 0; j < 16; ++j) { const unsigned c = xb_ld(&bar[XB_XCNT(j)]); sum += c; cnt += (c > 0u) ? 1u : 0u; mine = (j == x) ? c : mine; }
        if (sum == G) break;
        __builtin_amdgcn_s_sleep(1);
        if ((++sp & 255u) == 0u) { if (xb_ld(&bar[XB_TMO])) break; if (sp > XB_SPIN_CAP) { atomicAdd(&bar[XB_TMO], 1u); break; } }
    }
    nloc = mine > 0u ? mine : 1u; nx = cnt > 0u ? cnt : 1u;
}
__device__ __forceinline__ void xcd_barrier(const XcdBarrier& b) {
    asm volatile("s_waitcnt vmcnt(0)" ::: "memory");
    __syncthreads();
    if (threadIdx.x == 0) {
        unsigned* bar = b.bar;
        __builtin_amdgcn_s_waitcnt(0);
        unsigned nloc = b.st[0], nx = b.st[1];
        if (nloc == 0u) { xcd_barrier_complete(bar, b.x, nloc, nx); b.st[0] = nloc; b.st[1] = nx; }
        const unsigned old = xb_add(&bar[XB_XSUB(b.x)], 1u);
        const unsigned gen = old / nloc;
        if (old + 1u == (gen + 1u) * nloc) {
            __builtin_amdgcn_fence(__ATOMIC_RELEASE, "agent");
            asm volatile("s_waitcnt vmcnt(0)" ::: "memory");
            const unsigned og = xb_add(&bar[XB_TOP], 1u);
            const unsigned tg = og / nx;
            if (og + 1u == (tg + 1u) * nx) xb_add(&bar[XB_TOPGEN], 1u);
            else XB_SPIN(xb_ld(&bar[XB_TOPGEN]) == tg, bar);
            __builtin_amdgcn_fence(__ATOMIC_ACQUIRE, "agent");
            xb_add(&bar[XB_XGEN(b.x)], 1u);
            asm volatile("s_waitcnt vmcnt(0)" ::: "memory");
        } else {
            XB_SPIN(xb_ld(&bar[XB_XGEN(b.x)]) == gen, bar);
            __builtin_amdgcn_fence(__ATOMIC_ACQUIRE, "agent");
            asm volatile("s_waitcnt vmcnt(0)" ::: "memory");
        }
    }
    __syncthreads();
}

namespace pg8 {
#define PG8_LAS __attribute__((address_space(3)))
typedef unsigned short bf16_t;
typedef short bf16x8 __attribute__((ext_vector_type(8)));
typedef float f32x4 __attribute__((ext_vector_type(4)));
typedef unsigned u32x4 __attribute__((ext_vector_type(4)));
constexpr int BM = 256, BK = 64, HALF = 128, HTB = HALF * BK * 2  , STAGE_BYTES = 8 * HTB, NXCD = 8, WGM = 8;

__host__ __device__ __forceinline__ int lds_byte(int r, int c) { const int st = (r >> 4) * 2 + (c >> 5), rr = r & 15, cc = c & 31, ob = rr * 64 + cc * 2; return st * 1024 + (ob ^ (((ob >> 9) & 1) << 5)); }
__host__ __device__ __forceinline__ void stage_rc(int b, int& R, int& C) { const int st = b / 1024, sb = b % 1024, swz = sb ^ (((sb >> 9) & 1) << 5); R = (st >> 1) * 16 + swz / 64; C = (st & 1) * 32 + (swz % 64) / 2; }
__host__ __device__ __forceinline__ int perm32(int rho) { const int n = rho >> 4, i = rho & 15; return 8 * (i >> 2) + 4 * n + (i & 3); }

struct Unit { int pm, pn, kofs; };
struct Gemm { const bf16_t* A; const bf16_t* Bt; int M, N, K, ld; };

struct StaticOrder {
    int nM, nN, nwg, G, c;
    __host__ __device__ void init(int M, int N, int G_, int c_) { nM = M / BM; nN = N / BM; nwg = nM * nN; G = G_; c = c_; }
    __host__ __device__ bool next(int i, Unit& u) const {
        const long L = (long)i * G + c; if (L >= nwg) return false;
        int wgid = (int)L; { const int q = nwg / NXCD, r = nwg % NXCD, xcd = wgid % NXCD, off = wgid / NXCD; wgid = (xcd < r ? xcd * (q + 1) : r * (q + 1) + (xcd - r) * q) + off; }
        const int nig = WGM * nN, gid = wgid / nig, fm = gid * WGM, gsz = (nM - fm) < WGM ? (nM - fm) : WGM;
        u.pm = fm + ((wgid % nig) % gsz); u.pn = (wgid % nig) / gsz; u.kofs = 0; return true;
    }
    __device__ __forceinline__ void a_ready(const Unit&) const {}
    __device__ __forceinline__ void done(const Unit&) const {}
};

__device__ __forceinline__ unsigned cvt_pk_bf16(float lo, float hi) { unsigned r; asm volatile("v_cvt_pk_bf16_f32 %0, %1, %2" : "=v"(r) : "v"(lo), "v"(hi)); return r; }
typedef float f32x2 __attribute__((ext_vector_type(2)));
__device__ __forceinline__ f32x2 gelu_pk(f32x2 v) {
    const f32x2 av = __builtin_elementwise_abs(v), d = av * 0.2316418882f + 1.0f;
    f32x2 t; t.x = __builtin_amdgcn_rcpf(d.x); t.y = __builtin_amdgcn_rcpf(d.y);
    f32x2 q = t * 0.5307027145f + (-0.7265760135f); q = q * t + 0.7107068705f; q = q * t + (-0.142248368f); q = q * t + 0.127414796f; q = q * t;
    const f32x2 s = (v * v) * (-0.72134752044f);
    f32x2 e; e.x = __builtin_amdgcn_exp2f(s.x); e.y = __builtin_amdgcn_exp2f(s.y);
    const f32x2 m = v * (q * e), r = v - m;
    f32x2 o; o.x = v.x < 0.f ? m.x : r.x; o.y = v.y < 0.f ? m.y : r.y; return o;
}

template <int ACT  > struct EpiBf16 {
    static constexpr bool PERM = true, AFTER_DRAIN = false; static_assert(ACT == 0 || ACT == 1, "EpiBf16: ACT is 0 (none) or 1 (gelu_pk)");
    bf16_t* O; int ldc; const float* bias; int split_cols; size_t split_stride; float scale0;
    __device__ __forceinline__ void operator()(const f32x4 (&acc)[2][2][4][2], const Unit& u, int wr, int wc, int fr, int fq) const {
        const int row0 = u.pm * BM + wr * 64 + fr; int colt = u.pn * BM; bf16_t* base = O;
        float sc = 1.f; if (split_cols) { const int t = colt / split_cols; base += (size_t)t * split_stride; colt -= t * split_cols; if (t == 0) sc = scale0; }
        const int col0 = colt + wc * 32 + 8 * fq, bcol0 = u.pn * BM + wc * 32 + 8 * fq;
        f32x4 bv[2][2];
#pragma unroll
        for (int bj = 0; bj < 2; ++bj)
#pragma unroll
            for (int n = 0; n < 2; ++n) bv[bj][n] = bias ? *(const f32x4*)(bias + bcol0 + bj * HALF + 4 * n) : (f32x4){0.f, 0.f, 0.f, 0.f};
#pragma unroll
        for (int ai = 0; ai < 2; ++ai)
#pragma unroll
            for (int m = 0; m < 4; ++m) { bf16_t* rowp = base + (size_t)(row0 + ai * HALF + m * 16) * ldc + col0;
#pragma unroll
                for (int bj = 0; bj < 2; ++bj) { f32x4 v0 = acc[ai][bj][m][0] + bv[bj][0], v1 = acc[ai][bj][m][1] + bv[bj][1];
                    if (ACT == 1) { f32x2 a = gelu_pk((f32x2){v0[0], v0[1]}), b = gelu_pk((f32x2){v0[2], v0[3]}), c = gelu_pk((f32x2){v1[0], v1[1]}), d = gelu_pk((f32x2){v1[2], v1[3]});
                        v0 = (f32x4){a.x, a.y, b.x, b.y}; v1 = (f32x4){c.x, c.y, d.x, d.y}; }
                    v0 = v0 * sc; v1 = v1 * sc; u32x4 w; w.x = cvt_pk_bf16(v0[0], v0[1]); w.y = cvt_pk_bf16(v0[2], v0[3]); w.z = cvt_pk_bf16(v1[0], v1[1]); w.w = cvt_pk_bf16(v1[2], v1[3]);
                    *(u32x4*)(rowp + bj * HALF) = w; } }
    }
};


struct EpiF32 {
    static constexpr bool PERM = false, AFTER_DRAIN = false;
    float* C; int ldc; const float* bias;
    __device__ __forceinline__ void operator()(const f32x4 (&acc)[2][2][4][2], const Unit& u, int wr, int wc, int fr, int fq) const {
        const int row0 = u.pm * BM + wr * 64 + fr, col0 = u.pn * BM + wc * 32 + 4 * fq;
        f32x4 bv[2][2];
#pragma unroll
        for (int bj = 0; bj < 2; ++bj)
#pragma unroll
            for (int n = 0; n < 2; ++n) bv[bj][n] = bias ? *(const f32x4*)(bias + col0 + bj * HALF + n * 16) : (f32x4){0.f, 0.f, 0.f, 0.f};
#pragma unroll
        for (int ai = 0; ai < 2; ++ai)
#pragma unroll
            for (int m = 0; m < 4; ++m) { float* rowp = C + (size_t)(row0 + ai * HALF + m * 16) * ldc + col0;
#pragma unroll
                for (int bj = 0; bj < 2; ++bj)
#pragma unroll
                    for (int n = 0; n < 2; ++n) *(f32x4*)(rowp + bj * HALF + n * 16) = acc[ai][bj][m][n] + bv[bj][n]; }
    }
};

template <class Epi, class Sched, bool ALIGN_EPI = false, bool SP2 = false>
__device__ __forceinline__ void gemm_phase(PG8_LAS unsigned char* lds, const Gemm g, const Sched& S, const Epi& E) {
    int tid_l = threadIdx.x; asm volatile("" : "+v"(tid_l));
    const int tid = tid_l, wid = __builtin_amdgcn_readfirstlane(tid >> 6), lane = tid & 63, wr = wid >> 2, wc = wid & 3, fr = lane & 15, fq = lane >> 4;
    const int K = g.K, nt = K / BK;
    unsigned voffA[2], voffB[2];
#pragma unroll
    for (int i = 0; i < 2; ++i) { int R, C; stage_rc(tid * 16 + i * 8192, R, C); const int Rb = Epi::PERM ? ((R & ~31) + perm32(R & 31)) : R;
        voffA[i] = (unsigned)(R * g.ld + C) * 2u; voffB[i] = (unsigned)(Rb * g.ld + C) * 2u; }
    const size_t kstep = (size_t)(BK * 2);
    const size_t hstep = (size_t)HALF * g.ld * 2;
    const size_t tstep = 2 * hstep;
    const unsigned ldsw = (unsigned)wid * 1024u;
    const int aoff = lds_byte(wr * 64 + fr, fq * 8), boff = lds_byte(wc * 32 + fr, fq * 8);
#define PG8_SA(b, h) (((b) * 2 + (h)) * HTB)
#define PG8_SB(b, h) ((4 + (b) * 2 + (h)) * HTB)
#define PG8_STAGE(bufoff, gbase, voff) do { _Pragma("unroll") for (int _i = 0; _i < 2; ++_i) \
        __builtin_amdgcn_global_load_lds((const unsigned*)((const char*)(gbase) + (voff)[_i]), (PG8_LAS unsigned*)(lds + (bufoff) + ldsw + _i * 8192), 16, 0, 0); } while (0)
#define PG8_LDA(dst, b, h) do { _Pragma("unroll") for (int m = 0; m < 4; ++m) _Pragma("unroll") for (int k = 0; k < 2; ++k) dst[m][k] = *(const PG8_LAS bf16x8*)(lds + PG8_SA(b, h) + aoff + m * 2048 + k * 1024); } while (0)
#define PG8_LDB(dst, b, h) do { _Pragma("unroll") for (int n = 0; n < 2; ++n) _Pragma("unroll") for (int k = 0; k < 2; ++k) dst[n][k] = *(const PG8_LAS bf16x8*)(lds + PG8_SB(b, h) + boff + n * 2048 + k * 1024); } while (0)
#define PG8_MMA(ai, bj, At, Bt) do { __builtin_amdgcn_s_setprio(1); _Pragma("unroll") for (int m = 0; m < 4; ++m) _Pragma("unroll") for (int n = 0; n < 2; ++n) _Pragma("unroll") for (int k = 0; k < 2; ++k) \
        acc[ai][bj][m][n] = __builtin_amdgcn_mfma_f32_16x16x32_bf16(Bt[n][k], At[m][k], acc[ai][bj][m][n], 0, 0, 0); __builtin_amdgcn_s_setprio(0); } while (0)
#define PG8_WAIT_V(n) asm volatile("s_waitcnt vmcnt(" #n ")" ::: "memory")
#define PG8_WAIT_L(n) asm volatile("s_waitcnt lgkmcnt(" #n ")" ::: "memory")
#define PG8_BAR __builtin_amdgcn_s_barrier()
#define PG8_SCHED __builtin_amdgcn_sched_barrier(0)
    Unit cur, nxt; int ui = 0;
    if (!S.next(0, cur)) return;
    f32x4 acc[2][2][4][2];
#pragma unroll
    for (int a = 0; a < 2; ++a)
#pragma unroll
        for (int b = 0; b < 2; ++b)
#pragma unroll
            for (int m = 0; m < 4; ++m)
#pragma unroll
                for (int n = 0; n < 2; ++n) acc[a][b][m][n] = (f32x4){0.f, 0.f, 0.f, 0.f};
    bf16x8 At[4][2], B0[2][2], B1[2][2];
    const char* cA = (const char*)g.A + (size_t)cur.pm * tstep + (size_t)cur.kofs * 2; const char* cB = (const char*)g.Bt + (size_t)cur.pn * tstep + (size_t)cur.kofs * 2;
    S.a_ready(cur);
    if constexpr (SP2) {
        PG8_STAGE(PG8_SB(0, 0), cB, voffB); PG8_STAGE(PG8_SB(0, 1), cB + hstep, voffB); PG8_STAGE(PG8_SA(0, 0), cA, voffA); PG8_STAGE(PG8_SA(0, 1), cA + hstep, voffA);
        if (wr == 1) PG8_BAR;
        PG8_WAIT_V(2); PG8_BAR;
        PG8_STAGE(PG8_SB(1, 0), cB + kstep, voffB); PG8_STAGE(PG8_SA(1, 0), cA + kstep, voffA); PG8_STAGE(PG8_SB(1, 1), cB + hstep + kstep, voffB);
        PG8_WAIT_V(6); PG8_BAR;
    } else {
        PG8_STAGE(PG8_SB(0, 0), cB, voffB); PG8_STAGE(PG8_SA(0, 0), cA, voffA); PG8_STAGE(PG8_SB(0, 1), cB + hstep, voffB); PG8_STAGE(PG8_SA(0, 1), cA + hstep, voffA);
        if (wr == 1) PG8_BAR;
        PG8_WAIT_V(4); PG8_BAR;
        PG8_STAGE(PG8_SB(1, 0), cB + kstep, voffB); PG8_STAGE(PG8_SA(1, 0), cA + kstep, voffA); PG8_STAGE(PG8_SB(1, 1), cB + hstep + kstep, voffB);
        PG8_WAIT_V(6); PG8_BAR;
    }
    for (;;) {
        const bool has_next = S.next(ui + 1, nxt);
        const char* nA = has_next ? (const char*)g.A + (size_t)nxt.pm * tstep + (size_t)nxt.kofs * 2 : cA; const char* nB = has_next ? (const char*)g.Bt + (size_t)nxt.pn * tstep + (size_t)nxt.kofs * 2 : cB;
        for (int t = 0; t < nt; t += 2) {
            const bool last = (t == nt - 2);
            const char* a1 = cA + (size_t)(t + 1) * kstep;
            const char* a2 = last ? nA : cA + (size_t)(t + 2) * kstep; const char* b2 = last ? nB : cB + (size_t)(t + 2) * kstep;
            const char* a3 = a2 + kstep; const char* b3 = b2 + kstep;
            if (last && has_next) S.a_ready(nxt);
            if constexpr (SP2) {
            PG8_LDB(B0, 0, 0); PG8_LDB(B1, 0, 1); PG8_SCHED; PG8_LDA(At, 0, 0); PG8_STAGE(PG8_SA(1, 1), a1 + hstep, voffA);
            PG8_WAIT_V(8); PG8_WAIT_L(0); PG8_BAR; PG8_MMA(0, 0, At, B0); PG8_MMA(0, 1, At, B1); PG8_BAR; PG8_SCHED;
            PG8_LDA(At, 0, 1); PG8_STAGE(PG8_SB(0, 0), b2, voffB); PG8_STAGE(PG8_SB(0, 1), b2 + hstep, voffB); PG8_STAGE(PG8_SA(0, 0), a2, voffA);
            PG8_WAIT_V(8); PG8_WAIT_L(0); PG8_BAR; PG8_MMA(1, 0, At, B0); PG8_MMA(1, 1, At, B1); PG8_BAR; PG8_SCHED;
            PG8_LDB(B0, 1, 0); PG8_LDB(B1, 1, 1); PG8_SCHED; PG8_LDA(At, 1, 0); PG8_STAGE(PG8_SA(0, 1), a2 + hstep, voffA);
            PG8_WAIT_V(8); PG8_WAIT_L(0); PG8_BAR; PG8_MMA(0, 0, At, B0); PG8_MMA(0, 1, At, B1); PG8_BAR; PG8_SCHED;
            PG8_LDA(At, 1, 1); PG8_STAGE(PG8_SB(1, 0), b3, voffB); PG8_STAGE(PG8_SB(1, 1), b3 + hstep, voffB); PG8_STAGE(PG8_SA(1, 0), a3, voffA);
            PG8_WAIT_V(8); PG8_WAIT_L(0); PG8_BAR; PG8_MMA(1, 0, At, B0); PG8_MMA(1, 1, At, B1); PG8_BAR; PG8_SCHED;
            } else {
            PG8_LDB(B0, 0, 0); PG8_SCHED; PG8_LDA(At, 0, 0); PG8_STAGE(PG8_SA(1, 1), a1 + hstep, voffA);
            PG8_WAIT_L(8); PG8_BAR; PG8_WAIT_L(0); PG8_MMA(0, 0, At, B0); PG8_BAR; PG8_SCHED;
            PG8_LDB(B1, 0, 1); PG8_STAGE(PG8_SB(0, 0), b2, voffB);
            PG8_BAR; PG8_WAIT_L(0); PG8_MMA(0, 1, At, B1); PG8_BAR;
            PG8_LDA(At, 0, 1); PG8_STAGE(PG8_SA(0, 0), a2, voffA);
            PG8_BAR; PG8_WAIT_L(0); PG8_MMA(1, 0, At, B0); PG8_BAR; PG8_SCHED;
            PG8_STAGE(PG8_SB(0, 1), b2 + hstep, voffB);
            PG8_WAIT_V(6); PG8_BAR; PG8_MMA(1, 1, At, B1); PG8_BAR;
            PG8_LDB(B0, 1, 0); PG8_SCHED; PG8_LDA(At, 1, 0); PG8_STAGE(PG8_SA(0, 1), a2 + hstep, voffA);
            PG8_WAIT_L(8); PG8_BAR; PG8_WAIT_L(0); PG8_MMA(0, 0, At, B0); PG8_BAR; PG8_SCHED;
            PG8_LDB(B1, 1, 1); PG8_STAGE(PG8_SB(1, 0), b3, voffB);
            PG8_BAR; PG8_WAIT_L(0); PG8_MMA(0, 1, At, B1); PG8_BAR;
            PG8_LDA(At, 1, 1); PG8_STAGE(PG8_SA(1, 0), a3, voffA);
            PG8_BAR; PG8_WAIT_L(0); PG8_MMA(1, 0, At, B0); PG8_BAR; PG8_SCHED;
            PG8_STAGE(PG8_SB(1, 1), b3 + hstep, voffB);
            PG8_WAIT_V(6); PG8_BAR; PG8_MMA(1, 1, At, B1); PG8_BAR;
            }
        }
        if constexpr (ALIGN_EPI) { if (wr == 0) PG8_BAR; }
        if constexpr (!Epi::AFTER_DRAIN) { E(acc, cur, wr, wc, fr, fq); S.done(cur); }
        if (!has_next) break;
#pragma unroll
        for (int a = 0; a < 2; ++a)
#pragma unroll
            for (int b = 0; b < 2; ++b)
#pragma unroll
                for (int m = 0; m < 4; ++m)
#pragma unroll
                    for (int n = 0; n < 2; ++n) acc[a][b][m][n] = (f32x4){0.f, 0.f, 0.f, 0.f};
        cur = nxt; cA = nA; cB = nB; ++ui;
        if constexpr (ALIGN_EPI) { if (wr == 1) PG8_BAR; }
    }
    PG8_WAIT_V(0);
    if constexpr (!ALIGN_EPI) { if (wr == 0) PG8_BAR; }
    PG8_BAR;
    if constexpr (Epi::AFTER_DRAIN) { E.fused(acc, cur, wr, wc, fr, fq, lds, wid, lane); S.done(cur); }
#undef PG8_SA
#undef PG8_SB
#undef PG8_STAGE
#undef PG8_LDA
#undef PG8_LDB
#undef PG8_MMA
#undef PG8_WAIT_V
#undef PG8_WAIT_L
#undef PG8_BAR
#undef PG8_SCHED
}
}
namespace pg8 {
struct SplitKOrder {
    int G, c;
    __host__ __device__ void init(int G_, int c_) { G = G_; c = c_; }
    __host__ __device__ bool next(int i, Unit& u) const { const long L = (long)i * G + c; if (L >= 128) return false; const int ks = (int)L >> 4, r = (int)L & 15; u.pm = r >> 3; u.pn = r & 7; u.kofs = ks * 256; return true; }
    __device__ __forceinline__ void a_ready(const Unit&) const {}
    __device__ __forceinline__ void done(const Unit&) const {}
};
struct EpiF32Part {
    static constexpr bool PERM = false, AFTER_DRAIN = false;
    float* C;
    __device__ __forceinline__ void operator()(const f32x4 (&acc)[2][2][4][2], const Unit& u, int wr, int wc, int fr, int fq) const {
        const int row0 = u.pm * BM + wr * 64 + fr, col0 = u.pn * BM + wc * 32 + 4 * fq; float* base = C + (size_t)(u.kofs >> 8) * 512 * 2048;
#pragma unroll
        for (int ai = 0; ai < 2; ++ai)
#pragma unroll
            for (int m = 0; m < 4; ++m) { float* rowp = base + (size_t)(row0 + ai * HALF + m * 16) * 2048 + col0;
#pragma unroll
                for (int bj = 0; bj < 2; ++bj)
#pragma unroll
                    for (int n = 0; n < 2; ++n) *(f32x4*)(rowp + bj * HALF + n * 16) = acc[ai][bj][m][n]; }
    }
};
}
#define PG8_SP2 true
#define PG8_ALIGN true

#define LDS_FENCE() asm volatile("s_waitcnt lgkmcnt(0)" ::: "memory")
__device__ __forceinline__ unsigned f2bf(float f) { unsigned u = __builtin_bit_cast(unsigned, f); return (u + 0x7fffu + ((u >> 16) & 1u)) >> 16; }
__device__ __forceinline__ unsigned pk2(float lo, float hi) { return f2bf(lo) | (f2bf(hi) << 16); }
template <int CTRL> __device__ __forceinline__ float dppm(float x) { return __builtin_bit_cast(float, __builtin_amdgcn_mov_dpp(__builtin_bit_cast(int, x), CTRL, 0xf, 0xf, true)); }
__device__ __forceinline__ float row16_sum(float v) { v += dppm<0xB1>(v); v += dppm<0x4E>(v); v += dppm<0x141>(v); v += dppm<0x140>(v); return v; }
__device__ __forceinline__ float row16_maxf(float v) { v = fmaxf(v, dppm<0xB1>(v)); v = fmaxf(v, dppm<0x4E>(v)); v = fmaxf(v, dppm<0x141>(v)); v = fmaxf(v, dppm<0x140>(v)); return v; }
__device__ __forceinline__ float wave_sum(float v) {
    v = row16_sum(v);
    float a = v, b = v; asm volatile("s_nop 1\n\tv_permlane16_swap_b32 %0, %1" : "+v"(a), "+v"(b)); v = a + b;
    a = v; b = v; asm volatile("s_nop 1\n\tv_permlane32_swap_b32 %0, %1" : "+v"(a), "+v"(b)); return a + b;
}
__device__ __forceinline__ float wave_max(float v) {
    v = row16_maxf(v);
    float a = v, b = v; asm volatile("s_nop 1\n\tv_permlane16_swap_b32 %0, %1" : "+v"(a), "+v"(b)); v = fmaxf(a, b);
    a = v; b = v; asm volatile("s_nop 1\n\tv_permlane32_swap_b32 %0, %1" : "+v"(a), "+v"(b)); return fmaxf(a, b);
}
__device__ __forceinline__ float silu_f(float x) { return x / (1.0f + __expf(-x)); }
__device__ __forceinline__ float gelu_f(float v) {
    const float t = __builtin_amdgcn_rcpf(fabsf(v) * 0.2316418882f + 1.0f);
    float q = t * 0.5307027145f + (-0.7265760135f); q = q * t + 0.7107068705f; q = q * t + (-0.142248368f); q = q * t + 0.127414796f; q = q * t;
    const float m = v * (q * __builtin_amdgcn_exp2f(v * v * (-0.72134752044f)));
    return v < 0.f ? m : v - m;
}
__device__ __forceinline__ float log_sigmoid_f(float z) { return fminf(z, 0.0f) - __logf(1.0f + __expf(-fabsf(z))); }


__device__ __forceinline__ float bflo(unsigned w) { return __builtin_bit_cast(float, w << 16); }
__device__ __forceinline__ float bfhi(unsigned w) { return __builtin_bit_cast(float, w & 0xffff0000u); }
__device__ __forceinline__ void unpack8(const u32x4 w, float (&f)[8]) { f[0] = bflo(w.x); f[1] = bfhi(w.x); f[2] = bflo(w.y); f[3] = bfhi(w.y); f[4] = bflo(w.z); f[5] = bfhi(w.z); f[6] = bflo(w.w); f[7] = bfhi(w.w); }
__device__ __forceinline__ u32x4 pack8(const float (&f)[8]) { u32x4 o; o.x = pk2(f[0], f[1]); o.y = pk2(f[2], f[3]); o.z = pk2(f[4], f[5]); o.w = pk2(f[6], f[7]); return o; }


__device__ __forceinline__ u32x6 pack_fp6_2x16(const f32x16 a, const f32x16 b) { u32x6 r; asm("v_cvt_scalef32_2xpk16_fp6_f32 %0, %1, %2, 1.0" : "=&v"(r) : "v"(a), "v"(b)); return r; }
__device__ __forceinline__ f32x32 unpack_fp6_32(const u32x6 w) { f32x32 r; asm volatile("v_cvt_scalef32_pk32_f32_fp6 %0, %1, 1.0" : "=&v"(r) : "v"(w)); return r; }

struct Params {
    const float* in[19];
    float* out;
    unsigned char* ws;
    int ph_lo, ph_hi;
};
enum { I_X = 0, I_C, I_CTX, I_CCTX, I_WADA, I_BADA, I_WIN, I_CONVW, I_GW2, I_GB2, I_GNORM, I_SINK, I_WOUT, I_LNG, I_LNB, I_PWQ, I_PSUB, I_PU, I_PV };

__device__ __forceinline__ int row_stream(int r) { return r < TL ? r / SEQ : 2; }

__device__ __forceinline__ void transpose_item(const float* W, int K, int N, bf16_t* WT, LAS float* scr, int item, int lane) {
    const int nblk = N / 32, kb = item / nblk, nb = item % nblk, k0 = 64 * kb, n0 = 32 * nb;
#pragma unroll 8
    for (int i = 0; i < 32; ++i) { const int kk = 2 * i + (lane >> 5); scr[kk * 33 + (lane & 31)] = W[(size_t)(k0 + kk) * N + n0 + (lane & 31)]; }
    LDS_FENCE();
    const int c = lane & 7;
#pragma unroll
    for (int j = 0; j < 4; ++j) { const int n = (lane >> 3) + 8 * j; const LAS float* s = scr + (8 * c) * 33 + n;
        u32x4 o; o.x = pk2(s[0 * 33], s[1 * 33]); o.y = pk2(s[2 * 33], s[3 * 33]); o.z = pk2(s[4 * 33], s[5 * 33]); o.w = pk2(s[6 * 33], s[7 * 33]);
        *(u32x4*)(WT + (size_t)(n0 + n) * K + k0 + 8 * c) = o; }
    LDS_FENCE();
}

__device__ __forceinline__ void phase_prologue(const Params& p, LAS unsigned char* lds, int tid, int lane, int wave, int bid, int G) {
    const int gw = bid * NWAVES + wave, NGW = G * NWAVES;
    LAS float* scr = (LAS float*)(lds + wave * 16384);
    bf16_t* WIN = (bf16_t*)(p.ws + WS_WIN); bf16_t* WOUT = (bf16_t*)(p.ws + WS_WOUT); bf16_t* WQ = (bf16_t*)(p.ws + WS_WQ);
    constexpr int IT_IN = (DM / 64) * (INW / 32), IT_SQ = (DM / 64) * (DM / 32), IT_L = IT_IN + 2 * IT_SQ;
    for (int it = gw; it < DEPTH * IT_L; it += NGW) {
        const int l = it / IT_L; int r = it % IT_L;
        if (r < IT_IN) { transpose_item(p.in[I_WIN] + (size_t)l * DM * INW, DM, INW, WIN + (size_t)l * INWP * DM, scr, r, lane); continue; } r -= IT_IN;
        if (r < IT_SQ) { transpose_item(p.in[I_WOUT] + (size_t)l * DM * DM, DM, DM, WOUT + (size_t)l * DM * DM, scr, r, lane); continue; } r -= IT_SQ;
        transpose_item(p.in[I_PWQ] + (size_t)l * DM * DM, DM, DM, WQ + (size_t)l * DM * DM, scr, r, lane);
    }
    {
        constexpr int PADV = (INWP - INW) * DM / 8;
        const int gt = bid * NTHREADS + tid, NGT = G * NTHREADS;
        for (int i = gt; i < DEPTH * PADV; i += NGT) { const int l = i / PADV, o = i % PADV;
            *(u32x4*)(WIN + (size_t)l * INWP * DM + (size_t)INW * DM + (size_t)o * 8) = (u32x4){0u, 0u, 0u, 0u}; }
    }
    {
        const float* U = p.in[I_PU]; const float* V = p.in[I_PV];
        unsigned char* UB = p.ws + WS_UB; unsigned char* VB = p.ws + WS_VB; float* USC = (float*)(p.ws + WS_USC); (void)USC; float* VSC = (float*)(p.ws + WS_VSC); (void)VSC;
        for (size_t row = gw; row < (size_t)DEPTH * NEXP; row += NGW) {
            f32x4 xx[2][8];
#pragma unroll
            for (int tb = 0; tb < 2; ++tb)
#pragma unroll
                for (int j = 0; j < 8; ++j) xx[tb][j] = *(const f32x4*)((tb ? V : U) + row * DM + lane * 32 + 4 * j);
#pragma unroll
            for (int tb = 0; tb < 2; ++tb) {
                f32x4 x[8]; float am = 0.f;
#pragma unroll
                for (int j = 0; j < 8; ++j) { x[j] = xx[tb][j]; am = fmaxf(am, fmaxf(fmaxf(fabsf(x[j].x), fabsf(x[j].y)), fmaxf(fabsf(x[j].z), fabsf(x[j].w)))); }
                if (tb == 0 && TBL_U_I4) {
#if U_ROWSCALE
                    unsigned char* dst = UB + row * ROWB_U;
                    float ssq = 0.f;
#pragma unroll
                    for (int j = 0; j < 8; ++j) ssq += (x[j].x * x[j].x + x[j].y * x[j].y) + (x[j].z * x[j].z + x[j].w * x[j].w);
                    const float amr = wave_max(am), rms = sqrtf(wave_sum(ssq) * (1.0f / DM));
                    const float srow = amr > 0.f ? fminf(amr * (1.0f / 7.0f), 0.36f * rms) : 1.0f; const float inv = 1.0f / srow; const int code = 0; (void)code;
                    if (lane == 0) USC[row] = srow;
#else
                    unsigned char* dst = UB + row * ROWB4;
                    const float sb = am * (1.0f / 7.0f); const unsigned ub = (__builtin_bit_cast(unsigned, sb) + 0x000fffffu) & 0xfff00000u;
                    int code = ((int)ub - (int)I4_BASE) >> 20; code = code < 0 ? 0 : (code > 255 ? 255 : code);
                    const float inv = 1.0f / __builtin_bit_cast(float, ((unsigned)code << 20) + I4_BASE);
#endif
                    u32x4 w;
#pragma unroll
                    for (int d = 0; d < 4; ++d) { unsigned t = 0u;
#pragma unroll
                        for (int e = 0; e < 8; ++e) { const float xv = (e < 4 ? x[2 * d] : x[2 * d + 1])[e & 3];
                            int q = (int)__builtin_rintf(xv * inv); q = q < -7 ? -7 : (q > 7 ? 7 : q); t |= ((unsigned)q & 15u) << (4 * e); }
                        w[d] = t; }
                    *(u32x4*)(dst + lane * 16) = w;
#if !U_ROWSCALE
                    dst[1024 + lane] = (unsigned char)code;
#endif
                } else if (tb == 1 && V_ROWSCALE) {
                    unsigned char* dst = VB + row * ROWB_V;
                    float ssq = 0.f;
#pragma unroll
                    for (int j = 0; j < 8; ++j) ssq += (x[j].x * x[j].x + x[j].y * x[j].y) + (x[j].z * x[j].z + x[j].w * x[j].w);
                    const float amr = wave_max(am), rms = sqrtf(wave_sum(ssq) * (1.0f / DM));
                    const float srow = amr > 0.f ? fminf(amr * (1.0f / 6.0f), (2.8f / 6.0f) * rms) : 1.0f; const float inv = 1.0f / srow;
                    if (lane == 0) VSC[row] = srow;
                    u32x4 w;
#pragma unroll
                    for (int d = 0; d < 4; ++d) { unsigned t = 0u;
                        t = __builtin_amdgcn_cvt_scalef32_pk_fp4_f32(t, x[2 * d].x * inv, x[2 * d].y * inv, 1.0f, 0); t = __builtin_amdgcn_cvt_scalef32_pk_fp4_f32(t, x[2 * d].z * inv, x[2 * d].w * inv, 1.0f, 1);
                        t = __builtin_amdgcn_cvt_scalef32_pk_fp4_f32(t, x[2 * d + 1].x * inv, x[2 * d + 1].y * inv, 1.0f, 2); t = __builtin_amdgcn_cvt_scalef32_pk_fp4_f32(t, x[2 * d + 1].z * inv, x[2 * d + 1].w * inv, 1.0f, 3);
                        w[d] = t; }
                    *(u32x4*)(dst + lane * 16) = w;
                } else if (tb == 1 || TBL_U_FP4) {
                    unsigned char* dst = (tb ? VB : UB) + row * ROWB4;
                    const float sb = am * (1.0f / 6.0f); unsigned ub = __builtin_bit_cast(unsigned, sb); ub = (ub & 0x007fffffu) ? ((ub & 0x7f800000u) + 0x00800000u) : (ub & 0x7f800000u);
                    if (!(am > 0.f) || ub < 0x00800000u) ub = 0x00800000u;
                    const float scl = __builtin_bit_cast(float, ub);
                    u32x4 w;
#pragma unroll
                    for (int d = 0; d < 4; ++d) { unsigned t = 0u;
                        t = __builtin_amdgcn_cvt_scalef32_pk_fp4_f32(t, x[2 * d].x, x[2 * d].y, scl, 0); t = __builtin_amdgcn_cvt_scalef32_pk_fp4_f32(t, x[2 * d].z, x[2 * d].w, scl, 1);
                        t = __builtin_amdgcn_cvt_scalef32_pk_fp4_f32(t, x[2 * d + 1].x, x[2 * d + 1].y, scl, 2); t = __builtin_amdgcn_cvt_scalef32_pk_fp4_f32(t, x[2 * d + 1].z, x[2 * d + 1].w, scl, 3);
                        w[d] = t; }
                    *(u32x4*)(dst + lane * 16) = w; dst[1024 + lane] = (unsigned char)(ub >> 23);
                } else {
                    unsigned char* dst = UB + row * ROWB;
                    am = wave_max(am);
                    const float inv = am > 0.f ? 7.0f / am : 0.f;
                    f32x16 x0, x1;
#pragma unroll
                    for (int j = 0; j < 4; ++j) { x0[4 * j + 0] = x[j].x * inv; x0[4 * j + 1] = x[j].y * inv; x0[4 * j + 2] = x[j].z * inv; x0[4 * j + 3] = x[j].w * inv;
                        x1[4 * j + 0] = x[4 + j].x * inv; x1[4 * j + 1] = x[4 + j].y * inv; x1[4 * j + 2] = x[4 + j].z * inv; x1[4 * j + 3] = x[4 + j].w * inv; }
                    const u32x6 w = pack_fp6_2x16(x0, x1);
                    *(u32x4*)(dst + lane * 16) = (u32x4){w[0], w[1], w[2], w[3]}; *(u32x2*)(dst + 1024 + lane * 8) = (u32x2){w[4], w[5]};
                    if (lane == 0) USC[row] = am * (1.0f / 7.0f);
                }
            }
        }
        const size_t gt = (size_t)bid * NTHREADS + tid, NGT = (size_t)G * NTHREADS;
        const float* SUB = p.in[I_PSUB]; bf16_t* SUBB = (bf16_t*)(p.ws + WS_SUBB);
        for (size_t i = gt; i < (size_t)DEPTH * 2 * 128 * 128 / 2; i += NGT) ((unsigned*)SUBB)[i] = pk2(SUB[2 * i], SUB[2 * i + 1]);
    }
    __syncthreads();
    LAS float* sc = (LAS float*)lds;
    LAS float* red = (LAS float*)(lds + 32768);
    for (int i = tid; i < 3 * DM; i += NTHREADS) { const int s = i / DM, k = i % DM; const float v = s < 2 ? p.in[I_C][s * DM + k] : p.in[I_CCTX][k]; sc[i] = silu_f(v); }
    __syncthreads();
    float* MOD = (float*)(p.ws + WS_MOD);
    LAS float* red2 = (LAS float*)(lds + 32768);
    constexpr int NCH = 6 * DM / 256;
    for (int it = bid; it < DEPTH * NCH; it += G) {
        const int l = it / NCH, n0 = (it % NCH) * 256;
        const float* wp = p.in[I_WADA] + (size_t)l * DM * 6 * DM + n0 + lane * 4;
        f32x4 a0 = (f32x4){0.f, 0.f, 0.f, 0.f}, a1 = a0, a2 = a0;
        const int kb = wave * (DM / NWAVES);
#pragma unroll 16
        for (int k = kb; k < kb + DM / NWAVES; ++k) { const f32x4 w = *(const f32x4*)(wp + (size_t)k * 6 * DM); a0 += w * sc[k]; a1 += w * sc[DM + k]; a2 += w * sc[2 * DM + k]; }
        *(LAS f32x4*)(red2 + (wave * 3 + 0) * 256 + lane * 4) = a0; *(LAS f32x4*)(red2 + (wave * 3 + 1) * 256 + lane * 4) = a1; *(LAS f32x4*)(red2 + (wave * 3 + 2) * 256 + lane * 4) = a2;
        __syncthreads();
        for (int i = tid; i < 768; i += NTHREADS) { const int st = i >> 8, c = i & 255; float v = 0.f;
#pragma unroll
            for (int w = 0; w < NWAVES; ++w) v += red2[(w * 3 + st) * 256 + c];
            MOD[((size_t)l * 3 + st) * 6 * DM + n0 + c] = v + p.in[I_BADA][(size_t)l * 6 * DM + n0 + c]; }
        __syncthreads();
    }
}


__device__ __forceinline__ int row_first(int wave, int bid, int G) { const int gw = bid * NWAVES + wave; return gw < TL ? gw : -1; }
__device__ __forceinline__ int row_next(int r, int wave, int bid, int G, int nrows) {
    const int NGW = G * NWAVES;
    if (r < TL) { if (r + NGW < TL) return r + NGW; const int c = TL + wave * G + bid; return c < nrows ? c : -1; }
    return r + NGW < nrows ? r + NGW : -1;
}
__device__ __forceinline__ const float* xsrc(const Params& p, int l, int r) {
    return r < TL ? p.in[I_X] + (size_t)r * DM : p.in[I_CTX] + (size_t)(r - TL) * DM;
}

__device__ __forceinline__ void modulate_row(const float* xr, const float* mod, int sh_off, int sc_off, bf16_t* hb, int lane) {
    f32x4 xx[8];
#pragma unroll
    for (int j = 0; j < 8; ++j) xx[j] = *(const f32x4*)(xr + lane * 4 + 256 * j);
#pragma unroll
    for (int j = 0; j < 8; ++j) { const int c = lane * 4 + 256 * j;
        const f32x4 x = xx[j], sh = *(const f32x4*)(mod + sh_off + c), s = *(const f32x4*)(mod + sc_off + c);
        u32x2 o; o.x = pk2(x.x * (1.f + s.x) + sh.x, x.y * (1.f + s.y) + sh.y); o.y = pk2(x.z * (1.f + s.z) + sh.z, x.w * (1.f + s.w) + sh.w);
        *(u32x2*)(hb + c) = o; }
}
__device__ __forceinline__ void phase_modulate0(const Params& p, int lane, int wave, int bid, int G) {
    const int gw = bid * NWAVES + wave, NGW = G * NWAVES;
    const float* MOD = (const float*)(p.ws + WS_MOD); bf16_t* HB = (bf16_t*)(p.ws + WS_HB);
    for (int r = row_first(wave, bid, G); r >= 0; r = row_next(r, wave, bid, G, TA)) modulate_row(xsrc(p, 0, r), MOD + (size_t)(0 * 3 + row_stream(r)) * 6 * DM, 0, DM, HB + (size_t)r * DM, lane);
}

__device__ __forceinline__ void gemm_direct(const bf16_t* A, const bf16_t* Bt, float* C, int M, int N, int K, int ldc, int gw, int NGW, int lane) {
    const int nTn = N / 64, nItems = (M / 32) * nTn;
    const int fr = lane & 15, fq = lane >> 4;
    for (int it = gw; it < nItems; it += NGW) {
        const int mt = it / nTn, nt = it % nTn;
        const bf16_t* a0 = A + (size_t)(mt * 32 + fr) * K + fq * 8;
        const bf16_t* b0 = Bt + (size_t)(nt * 64 + fr) * K + fq * 8;
        f32x4 acc[2][4];
#pragma unroll
        for (int i = 0; i < 2; ++i)
#pragma unroll
            for (int j = 0; j < 4; ++j) acc[i][j] = (f32x4){0.f, 0.f, 0.f, 0.f};
#pragma unroll 2
        for (int k0 = 0; k0 < K; k0 += 32) {
            bf16x8 af[2], bfr[4];
#pragma unroll
            for (int i = 0; i < 2; ++i) af[i] = *(const bf16x8*)(a0 + (size_t)i * 16 * K + k0);
#pragma unroll
            for (int j = 0; j < 4; ++j) bfr[j] = *(const bf16x8*)(b0 + (size_t)j * 16 * K + k0);
#pragma unroll
            for (int i = 0; i < 2; ++i)
#pragma unroll
                for (int j = 0; j < 4; ++j) acc[i][j] = __builtin_amdgcn_mfma_f32_16x16x32_bf16(af[i], bfr[j], acc[i][j], 0, 0, 0);
        }
#pragma unroll
        for (int i = 0; i < 2; ++i)
#pragma unroll
            for (int j = 0; j < 4; ++j)
#pragma unroll
                for (int g = 0; g < 4; ++g) C[(size_t)(mt * 32 + i * 16 + fq * 4 + g) * ldc + nt * 64 + j * 16 + fr] = acc[i][j][g];
    }
}

__device__ __forceinline__ void phase_post_in(const Params& p, int l, int lane, int wave, int bid, int G) {
    const int gw = bid * NWAVES + wave, NGW = G * NWAVES;
    const bf16_t* P = (const bf16_t*)(p.ws + WS_P);
    bf16_t* QR = (bf16_t*)(p.ws + WS_QR); bf16_t* KR = (bf16_t*)(p.ws + WS_KR); bf16_t* VR = (bf16_t*)(p.ws + WS_ALF);
    bf16_t* MIX = (bf16_t*)(p.ws + WS_MIX);
    const float* cw = p.in[I_CONVW] + (size_t)l * 3 * 512;
    const int c8 = lane * 8, rh = lane >> 3, rf = (lane >> 2) & 1, rg = lane & 3, roff = rh * 128 + rf * 64 + rg * 8;
    float w0[8], w1[8], w2[8], invf[8];
#pragma unroll
    for (int e = 0; e < 8; ++e) { w0[e] = cw[c8 + e]; w1[e] = cw[512 + c8 + e]; w2[e] = cw[1024 + c8 + e]; invf[e] = __builtin_amdgcn_exp2f(-(float)(rg * 8 + e) * 0.4152410118609203f); }
    for (int r = row_first(wave, bid, G); r >= 0; r = row_next(r, wave, bid, G, TA)) {
        const bf16_t* pr = P + (size_t)r * INWP;
        int pos, len;
        if (r < TL) { pos = r % SEQ; len = SEQ; } else { pos = (r - TL) % CTXL; len = CTXL; }
        const bool hp = pos > 0, hn = pos < len - 1;
        const u32x4 z4 = (u32x4){0u, 0u, 0u, 0u};
        const u32x4 xC = *(const u32x4*)(pr + C_CC + c8), xX = *(const u32x4*)(pr + C_CX + c8), xB = *(const u32x4*)(pr + C_CB + c8);
        const u32x4 pC = hp ? *(const u32x4*)(pr - INWP + C_CC + c8) : z4, pX = hp ? *(const u32x4*)(pr - INWP + C_CX + c8) : z4;
        const u32x4 nC = hn ? *(const u32x4*)(pr + INWP + C_CC + c8) : z4, nX = hn ? *(const u32x4*)(pr + INWP + C_CX + c8) : z4;
        const u32x4 q1 = *(const u32x4*)(pr + C_SQ + roff), q2 = *(const u32x4*)(pr + C_SQ + roff + 32);
        u32x4 k1 = z4, k2 = z4, vv = z4;
        if (lane < 16) { k1 = *(const u32x4*)(pr + C_SK + roff); k2 = *(const u32x4*)(pr + C_SK + roff + 32); }
        if (lane < 32) vv = *(const u32x4*)(pr + C_SV + c8);
        { float fC[8], fX[8], fB[8], gC[8], gX[8], hC[8], hX[8], o[8];
          unpack8(xC, fC); unpack8(xX, fX); unpack8(xB, fB); unpack8(pC, gC); unpack8(pX, gX); unpack8(nC, hC); unpack8(nX, hX);
#pragma unroll
          for (int e = 0; e < 8; ++e) o[e] = fB[e] * (w0[e] * gC[e] * gX[e] + w1[e] * fC[e] * fX[e] + w2[e] * hC[e] * hX[e]);
          *(u32x4*)(MIX + (size_t)r * DM + c8) = pack8(o); }
        { float cs[8], sn[8];
#pragma unroll
          for (int e = 0; e < 8; ++e) { cs[e] = 1.f; sn[e] = 0.f; }
          if (r < TL) { const float pv = (float)(rf ? (pos % 64) : (pos / 64));
#pragma unroll
              for (int e = 0; e < 8; ++e) { sn[e] = __sinf(pv * invf[e]); cs[e] = __cosf(pv * invf[e]); } }
          float x1[8], x2[8], o1[8], o2[8];
          unpack8(q1, x1); unpack8(q2, x2);
#pragma unroll
          for (int e = 0; e < 8; ++e) { o1[e] = (x1[e] * cs[e] - x2[e] * sn[e]) * 0.08838834764831845f; o2[e] = (x2[e] * cs[e] + x1[e] * sn[e]) * 0.08838834764831845f; }
          *(u32x4*)(QR + (size_t)r * 1024 + roff) = pack8(o1); *(u32x4*)(QR + (size_t)r * 1024 + roff + 32) = pack8(o2);
          if (lane < 16) { unpack8(k1, x1); unpack8(k2, x2);
#pragma unroll
              for (int e = 0; e < 8; ++e) { o1[e] = x1[e] * cs[e] - x2[e] * sn[e]; o2[e] = x2[e] * cs[e] + x1[e] * sn[e]; }
              *(u32x4*)(KR + (size_t)r * 256 + roff) = pack8(o1); *(u32x4*)(KR + (size_t)r * 256 + roff + 32) = pack8(o2); }
          if (lane < 32) *(u32x4*)(VR + (size_t)r * 256 + c8) = vv; }
    }
}

#ifndef SWA_THR
#define SWA_THR 6.0f
#endif
constexpr int KP = 136, VP = 72;
constexpr int SWA_BUF = 64 * KP * 2 + 128 * VP * 2;
typedef short bf16x4 __attribute__((ext_vector_type(4)));
__device__ __forceinline__ void phase_mixers(const Params& p, int l, LAS unsigned char* lds, int tid, int lane, int wave, int bid, int G, int qsel = 0) {
    const bf16_t* QR = (const bf16_t*)(p.ws + WS_QR); const bf16_t* KR = (const bf16_t*)(p.ws + WS_KR); const bf16_t* VR = (const bf16_t*)(p.ws + WS_ALF);
    bf16_t* MIX = (bf16_t*)(p.ws + WS_MIX);
    const float* sinkp = p.in[I_SINK] + l * 8;
    const int fr = lane & 15, fq = lane >> 4, g = wave & 3, qh = wave >> 2;
    const int nItems = 512 + ((l < DEPTH - 1) ? 16 : 0);
    unsigned* qhead = (unsigned*)(p.ws + WS_CTL) + CW_QUEUE + 64 * (l + 4 * qsel);
    volatile LAS int* itw = (volatile LAS int*)(lds + MISC_OFF + 64);
    for (;;) {
        if (tid == 0) itw[0] = (int)__hip_atomic_fetch_add(qhead, 1u, __ATOMIC_RELAXED, __HIP_MEMORY_SCOPE_AGENT);
        __syncthreads();
        const int it = itw[0];
        __syncthreads();
        if (it >= nItems) break;
        int b, tile, hk, s0; size_t qrow0;
        if (it < 512) { b = it >> 8; tile = (it >> 1) & 127; hk = it & 1; s0 = 0; qrow0 = (size_t)b * SEQ + tile * 64; }
        else { const int c = it - 512; b = c >> 3; tile = (c >> 1) & 3; hk = c & 1; s0 = 5; qrow0 = (size_t)TL + b * CTXL + tile * 64; }
        const int n0 = tile * 64, hq = hk * 4 + g;
        bf16x8 qf[2][4];
#pragma unroll
        for (int qt = 0; qt < 2; ++qt)
#pragma unroll
            for (int ks = 0; ks < 4; ++ks) qf[qt][ks] = *(const bf16x8*)(QR + (qrow0 + qh * 32 + qt * 16 + fr) * 1024 + hq * 128 + ks * 32 + fq * 8);
        f32x4 O[2][8];
#pragma unroll
        for (int qt = 0; qt < 2; ++qt)
#pragma unroll
            for (int dt = 0; dt < 8; ++dt) O[qt][dt] = (f32x4){0.f, 0.f, 0.f, 0.f};
        float m[2], lsum[2];
        m[0] = m[1] = sinkp[hq]; lsum[0] = lsum[1] = (fq == 0) ? 1.f : 0.f;
        u32x4 kreg[2], vreg[2];
#define SWA_ROW(s, kk) ((s) < 5 ? (size_t)b * SEQ + (size_t)min(max(n0 - 128 + (s) * 64 + (kk), 0), SEQ - 1) : (size_t)TL + (size_t)b * CTXL + ((s) - 5) * 64 + (kk))
#define SWA_LOAD(s) do { _Pragma("unroll") for (int j = 0; j < 2; ++j) { const int v = tid + NTHREADS * j; \
            kreg[j] = *(const u32x4*)(KR + SWA_ROW(s, v >> 4) * 256 + hk * 128 + (v & 15) * 8); \
            vreg[j] = *(const u32x4*)(VR + SWA_ROW(s, tid & 63) * 256 + hk * 128 + ((tid >> 6) + 8 * j) * 8); } } while (0)
#define SWA_WRITE(buf) do { LAS bf16_t* Kd = (LAS bf16_t*)(lds + (buf) * SWA_BUF); LAS bf16_t* Vd = Kd + 64 * KP; \
            _Pragma("unroll") for (int j = 0; j < 2; ++j) { const int v = tid + NTHREADS * j; *(LAS u32x4*)(Kd + (v >> 4) * KP + (v & 15) * 8) = kreg[j]; \
                const int d0 = ((tid >> 6) + 8 * j) * 8, key = tid & 63; const u32x4 w = vreg[j]; \
                Vd[(d0 + 0) * VP + key] = (bf16_t)(w.x & 0xffffu); Vd[(d0 + 1) * VP + key] = (bf16_t)(w.x >> 16); Vd[(d0 + 2) * VP + key] = (bf16_t)(w.y & 0xffffu); Vd[(d0 + 3) * VP + key] = (bf16_t)(w.y >> 16); \
                Vd[(d0 + 4) * VP + key] = (bf16_t)(w.z & 0xffffu); Vd[(d0 + 5) * VP + key] = (bf16_t)(w.z >> 16); Vd[(d0 + 6) * VP + key] = (bf16_t)(w.w & 0xffffu); Vd[(d0 + 7) * VP + key] = (bf16_t)(w.w >> 16); } } while (0)
        SWA_LOAD(s0); SWA_WRITE(0);
        __syncthreads();
#pragma unroll 1
        for (int s = s0; s < 9; ++s) {
            const int buf = (s - s0) & 1;
            if (s + 1 < 9) SWA_LOAD(s + 1);
            const LAS bf16_t* Ks = (const LAS bf16_t*)(lds + buf * SWA_BUF); const LAS bf16_t* Vs = Ks + 64 * KP;
#pragma unroll 1
            for (int sc = 0; sc < 2; ++sc) {
                f32x4 sT[2][2];
#pragma unroll
                for (int qt = 0; qt < 2; ++qt) { sT[qt][0] = (f32x4){0.f, 0.f, 0.f, 0.f}; sT[qt][1] = (f32x4){0.f, 0.f, 0.f, 0.f}; }
#pragma unroll
                for (int ks = 0; ks < 4; ++ks)
#pragma unroll
                    for (int kt = 0; kt < 2; ++kt) { const bf16x8 ka = *(const LAS bf16x8*)(Ks + (sc * 32 + kt * 16 + fr) * KP + ks * 32 + fq * 8);
#pragma unroll
                        for (int qt = 0; qt < 2; ++qt) sT[qt][kt] = __builtin_amdgcn_mfma_f32_16x16x32_bf16(ka, qf[qt][ks], sT[qt][kt], 0, 0, 0); }
                bf16x8 pb[2];
                float cm[2];
#pragma unroll
                for (int qt = 0; qt < 2; ++qt) {
                    if (s < 5) {
                        const int qpos = n0 + qh * 32 + qt * 16 + fr;
#pragma unroll
                        for (int kt = 0; kt < 2; ++kt)
#pragma unroll
                            for (int e = 0; e < 4; ++e) { const int kpos = n0 - 128 + s * 64 + sc * 32 + kt * 16 + fq * 4 + e; const int dlt = qpos - kpos;
                                const bool ok = kpos >= 0 && kpos < SEQ && dlt <= 128 && dlt >= -128; sT[qt][kt][e] = ok ? sT[qt][kt][e] : -1e30f; } }
                    cm[qt] = fmaxf(fmaxf(fmaxf(sT[qt][0][0], sT[qt][0][1]), fmaxf(sT[qt][0][2], sT[qt][0][3])), fmaxf(fmaxf(sT[qt][1][0], sT[qt][1][1]), fmaxf(sT[qt][1][2], sT[qt][1][3])));
                }
                if (__any((cm[0] > m[0] + SWA_THR) || (cm[1] > m[1] + SWA_THR))) {
#pragma unroll
                    for (int qt = 0; qt < 2; ++qt) { float c = cm[qt]; c = fmaxf(c, __shfl_xor(c, 16)); c = fmaxf(c, __shfl_xor(c, 32));
                        const float mn = fmaxf(m[qt], c), scl = __expf(m[qt] - mn); m[qt] = mn; lsum[qt] *= scl;
#pragma unroll
                        for (int dt = 0; dt < 8; ++dt) O[qt][dt] = O[qt][dt] * scl; }
                }
#pragma unroll
                for (int qt = 0; qt < 2; ++qt) {
                    float pe[8]; float ps = 0.f;
#pragma unroll
                    for (int kt = 0; kt < 2; ++kt)
#pragma unroll
                        for (int e = 0; e < 4; ++e) { pe[kt * 4 + e] = __expf(sT[qt][kt][e] - m[qt]); ps += pe[kt * 4 + e]; }
                    lsum[qt] += ps;
                    u32x4 pw; pw.x = pk2(pe[0], pe[1]); pw.y = pk2(pe[2], pe[3]); pw.z = pk2(pe[4], pe[5]); pw.w = pk2(pe[6], pe[7]);
                    pb[qt] = __builtin_bit_cast(bf16x8, pw);
                }
#pragma unroll
                for (int dt = 0; dt < 8; ++dt) {
                    const bf16x4 v0 = *(const LAS bf16x4*)(Vs + (dt * 16 + fr) * VP + sc * 32 + 4 * fq), v1 = *(const LAS bf16x4*)(Vs + (dt * 16 + fr) * VP + sc * 32 + 16 + 4 * fq);
                    const bf16x8 va = __builtin_shufflevector(v0, v1, 0, 1, 2, 3, 4, 5, 6, 7);
#pragma unroll
                    for (int qt = 0; qt < 2; ++qt) O[qt][dt] = __builtin_amdgcn_mfma_f32_16x16x32_bf16(va, pb[qt], O[qt][dt], 0, 0, 0);
                }
            }
            if (s + 1 < 9) SWA_WRITE(buf ^ 1);
            __syncthreads();
        }
#undef SWA_ROW
#undef SWA_LOAD
#undef SWA_WRITE
#pragma unroll
        for (int qt = 0; qt < 2; ++qt) {
            float lt = lsum[qt]; lt += __shfl_xor(lt, 16); lt += __shfl_xor(lt, 32);
            const float inv = 1.0f / lt;
            bf16_t* o = MIX + (qrow0 + qh * 32 + qt * 16 + fr) * DM + 1024 + hq * 128 + fq * 4;
#pragma unroll
            for (int dt = 0; dt < 8; ++dt) { u32x2 w; w.x = pk2(O[qt][dt][0] * inv, O[qt][dt][1] * inv); w.y = pk2(O[qt][dt][2] * inv, O[qt][dt][3] * inv); *(u32x2*)(o + dt * 16) = w; }
        }
    }
}

__device__ __forceinline__ int chunk_row0(int cid) { return cid < 256 ? (cid >> 7) * SEQ + (cid & 127) * 64 : TL + ((cid - 256) >> 2) * CTXL + ((cid - 256) & 3) * 64; }
constexpr int GP = 72;

constexpr int LTP = 65;
__device__ __forceinline__ float wave_incl_scan(float x) {
    x += __builtin_bit_cast(float, __builtin_amdgcn_update_dpp(0, __builtin_bit_cast(int, x), 0x111, 0xF, 0xF, true));
    x += __builtin_bit_cast(float, __builtin_amdgcn_update_dpp(0, __builtin_bit_cast(int, x), 0x112, 0xF, 0xF, true));
    x += __builtin_bit_cast(float, __builtin_amdgcn_update_dpp(0, __builtin_bit_cast(int, x), 0x114, 0xF, 0xF, true));
    x += __builtin_bit_cast(float, __builtin_amdgcn_update_dpp(0, __builtin_bit_cast(int, x), 0x118, 0xF, 0xF, true));
    x += __builtin_bit_cast(float, __builtin_amdgcn_update_dpp(0, __builtin_bit_cast(int, x), 0x142, 0xA, 0xF, false));
    x += __builtin_bit_cast(float, __builtin_amdgcn_update_dpp(0, __builtin_bit_cast(int, x), 0x143, 0xC, 0xF, false));
    return x;
}
__device__ __forceinline__ void gla_g1(const Params& p, int l, LAS unsigned char* lds, int tid, int lane, int wave, int bid, int G) {
    LAS float* LTf = (LAS float*)lds; LAS float* LTb = LTf + 64 * LTP;
    LAS bf16_t* KTf = (LAS bf16_t*)(lds + 2 * 64 * LTP * 4); LAS bf16_t* KTb = KTf + 64 * GP;
    LAS bf16_t* VT = KTb + 64 * GP;
    const bf16_t* P = (const bf16_t*)(p.ws + WS_P);
    float* BF = (float*)(p.ws + WS_OF); float* BB = (float*)(p.ws + WS_OB);
    float* DELTA = (float*)(p.ws + WS_DELTA); float* DEC = (float*)(p.ws + WS_DEC);
    const float* w2 = p.in[I_GW2] + (size_t)l * 2 * 16 * 256; const float* b2 = p.in[I_GB2] + (size_t)l * 2 * 256;
    const int fr = lane & 15, fq = lane >> 4, ti = tid >> 3, tk0 = (tid & 7) * 8;
    float wr[2][16], br[2];
    const bool fixed_h = (G & 3) == 0;
#define G1_LOADW(hh_) do { _Pragma("unroll") for (int d = 0; d < 2; ++d) { br[d] = b2[d * 256 + (hh_) * 64 + lane]; \
        _Pragma("unroll") for (int q = 0; q < 16; ++q) wr[d][q] = w2[(d * 16 + q) * 256 + (hh_) * 64 + lane]; } } while (0)
    if (fixed_h) G1_LOADW(bid & 3);
    u32x4 kraw, vraw[2], lrr[2][4];
#define G1_LOADX(item_) do { const int cid_ = (item_) >> 2, h_ = (item_) & 3, row0_ = chunk_row0(cid_); \
        kraw = *(const u32x4*)(P + (size_t)(row0_ + ti) * INWP + C_GK + h_ * 64 + tk0); \
        _Pragma("unroll") for (int j = 0; j < 2; ++j) vraw[j] = *(const u32x4*)(P + (size_t)(row0_ + 2 * (tid >> 4) + j) * INWP + C_GV + h_ * 128 + (tid & 15) * 8);        \
        _Pragma("unroll") for (int jj = 0; jj < 2; ++jj) _Pragma("unroll") for (int c = 0; c < 4; ++c) lrr[jj][c] = *(const u32x4*)(P + (size_t)(row0_ + wave + 8 * jj) * INWP + C_LRF + c * 8); } while (0)
    if (bid < GLA_ITEMS) G1_LOADX(bid);
    for (int item = bid; item < GLA_ITEMS; item += G) {
        const int cid = item >> 2, h = item & 3, row0 = chunk_row0(cid);
        const u32x4 kraw_c = kraw; u32x4 vraw_c[2] = {vraw[0], vraw[1]};
        {
            if (!fixed_h) G1_LOADW(h);
#pragma unroll
            for (int jj = 0; jj < 8; ++jj) { const int i = wave + 8 * jj;
                float lf[4][8];
                if (jj < 2) {
#pragma unroll
                    for (int c = 0; c < 4; ++c) unpack8(lrr[jj][c], lf[c]);
                } else { const bf16_t* lrp = P + (size_t)(row0 + i) * INWP + C_LRF;
#pragma unroll
                    for (int c = 0; c < 4; ++c) unpack8(*(const u32x4*)(lrp + c * 8), lf[c]); }
#pragma unroll
                for (int d = 0; d < 2; ++d) { float z = br[d];
#pragma unroll
                    for (int q = 0; q < 16; ++q) z += lf[d * 2 + (q >> 3)][q & 7] * wr[d][q];
                    (d ? LTb : LTf)[lane * LTP + i] = log_sigmoid_f(z) * (1.0f / 16.0f); } }
        }
        if (item + G < GLA_ITEMS) G1_LOADX(item + G);
        __syncthreads();
#pragma unroll 2
        for (int kk = 0; kk < 8; ++kk) { const int k = wave * 8 + kk;
            float xf = LTf[k * LTP + lane], xb = LTb[k * LTP + lane];
            const float pf = wave_incl_scan(xf), pb = wave_incl_scan(xb);
            const float totb = __builtin_bit_cast(float, __builtin_amdgcn_readlane(__builtin_bit_cast(int, pb), 63));
            LTf[k * LTP + lane] = pf; LTb[k * LTP + lane] = totb - pb + xb; }
        __syncthreads();
        { float kv[8]; unpack8(kraw_c, kv);
          float bfv[8], bbv[8];
#pragma unroll
          for (int e = 0; e < 8; ++e) { const int k = tk0 + e; bfv[e] = LTf[k * LTP + ti]; bbv[e] = LTb[k * LTP + ti];
              KTf[k * GP + ti] = (bf16_t)f2bf(kv[e] * __expf(LTf[k * LTP + 63] - bfv[e]));
              KTb[k * GP + ti] = (bf16_t)f2bf(kv[e] * __expf(LTb[k * LTP] - bbv[e])); }
          float* bg = BF + (size_t)(row0 + ti) * 256 + h * 64 + tk0; *(f32x4*)bg = (f32x4){bfv[0], bfv[1], bfv[2], bfv[3]}; *(f32x4*)(bg + 4) = (f32x4){bfv[4], bfv[5], bfv[6], bfv[7]};
          bg = BB + (size_t)(row0 + ti) * 256 + h * 64 + tk0; *(f32x4*)bg = (f32x4){bbv[0], bbv[1], bbv[2], bbv[3]}; *(f32x4*)(bg + 4) = (f32x4){bbv[4], bbv[5], bbv[6], bbv[7]};
#pragma unroll
          for (int d = 0; d < 4; ++d) { const int i2 = 2 * (tid >> 4), v0 = (tid & 15) * 8; const unsigned a = vraw_c[0][d], b = vraw_c[1][d];
              *(LAS unsigned*)(VT + (v0 + 2 * d) * GP + i2) = (a & 0xffffu) | (b << 16); *(LAS unsigned*)(VT + (v0 + 2 * d + 1) * GP + i2) = (a >> 16) | (b & 0xffff0000u); }
          if (tid < 128) { const int dir = tid >> 6, k = tid & 63; DEC[((size_t)item * 2 + dir) * 64 + k] = __expf(dir ? LTb[k * LTP] : LTf[k * LTP + 63]); } }
        __syncthreads();
        { const int dir = wave >> 2, vq = wave & 3; const LAS bf16_t* KT = dir ? KTb : KTf;
            f32x4 acc[2][4];
#pragma unroll
            for (int a = 0; a < 2; ++a)
#pragma unroll
                for (int b = 0; b < 4; ++b) acc[a][b] = (f32x4){0.f, 0.f, 0.f, 0.f};
#pragma unroll
            for (int ks = 0; ks < 2; ++ks) { bf16x8 af[2], bfr[4];
#pragma unroll
                for (int a = 0; a < 2; ++a) af[a] = *(const LAS bf16x8*)(VT + ((vq * 2 + a) * 16 + fr) * GP + ks * 32 + fq * 8);
#pragma unroll
                for (int b = 0; b < 4; ++b) bfr[b] = *(const LAS bf16x8*)(KT + (b * 16 + fr) * GP + ks * 32 + fq * 8);
#pragma unroll
                for (int a = 0; a < 2; ++a)
#pragma unroll
                    for (int b = 0; b < 4; ++b) acc[a][b] = __builtin_amdgcn_mfma_f32_16x16x32_bf16(af[a], bfr[b], acc[a][b], 0, 0, 0); }
            float* dst = DELTA + ((size_t)item * 2 + dir) * 8192;
#pragma unroll
            for (int a = 0; a < 2; ++a)
#pragma unroll
                for (int b = 0; b < 4; ++b)
#pragma unroll
                    for (int g = 0; g < 4; ++g) dst[((vq * 2 + a) * 16 + fq * 4 + g) * 64 + b * 16 + fr] = acc[a][b][g]; }
        __syncthreads();
    }
}

#undef G1_LOADW
#undef G1_LOADX
__device__ __forceinline__ void gla_g2(const Params& p, int tid, int bid, int G) {
    const float* DELTA = (const float*)(p.ws + WS_DELTA); const float* DEC = (const float*)(p.ws + WS_DEC); bf16_t* SST = (bf16_t*)(p.ws + WS_SST);
    for (int u = bid; u < 64; u += G) {
        const int s = u >> 2, dir = s >> 3, b = (s >> 2) & 1, h = s & 3, off = ((u & 3) * NTHREADS + tid) * 4, k0 = off & 63;
        f32x4 S = (f32x4){0.f, 0.f, 0.f, 0.f};
#pragma unroll 1
        for (int st = 0; st < 132; st += 12) {
            f32x4 d[12], dc[12]; size_t base[12];
#pragma unroll
            for (int q = 0; q < 12; ++q) { const int t = st + q;
                const int cid = t < 4 ? 256 + b * 4 + (dir ? 3 - t : t) : b * 128 + (dir ? 127 - (t - 4) : (t - 4));
                const size_t it2 = (size_t)(cid * 4 + h) * 2 + dir; base[q] = it2 * 8192 + off;
                d[q] = *(const f32x4*)(DELTA + base[q]); dc[q] = *(const f32x4*)(DEC + it2 * 64 + k0); }
#pragma unroll
            for (int q = 0; q < 12; ++q) { u32x2 o; o.x = pk2(S.x, S.y); o.y = pk2(S.z, S.w); *(u32x2*)(SST + base[q]) = o; S = dc[q] * S + d[q]; }
        }
    }
}

__device__ __forceinline__ void gla_g3(const Params& p, int l, LAS unsigned char* lds, int tid, int lane, int wave, int bid, int G, unsigned* qhead3 = nullptr) {
    LAS bf16_t* QEf = (LAS bf16_t*)lds; LAS bf16_t* QEb = QEf + 64 * GP; LAS bf16_t* KEf = QEb + 64 * GP; LAS bf16_t* KEb = KEf + 64 * GP;
    LAS bf16_t* VT = KEb + 64 * GP;
    LAS bf16_t* ATT = VT + 128 * GP + wave * (16 * GP);
    LAS float* RS = (LAS float*)(lds + 2 * (4 * 64 * GP + 128 * GP + 8 * 16 * GP));
    const bf16_t* P = (const bf16_t*)(p.ws + WS_P);
    const float* BF = (const float*)(p.ws + WS_OF); const float* BB = (const float*)(p.ws + WS_OB);
    const bf16_t* SST = (const bf16_t*)(p.ws + WS_SST); bf16_t* MIX = (bf16_t*)(p.ws + WS_MIX);
    const float* nw = p.in[I_GNORM] + l * 128;
    const int fr = lane & 15, fq = lane >> 4, it = wave >> 1, vh = wave & 1, ti = tid >> 3, tk0 = (tid & 7) * 8;
    const int n_items = (l < DEPTH - 1) ? GLA_ITEMS : 256 * 4;
    volatile LAS int* itw3 = (volatile LAS int*)(lds + MISC_OFF + 64);
    for (int item = bid;; item += G) {
        if (qhead3) {
            if (tid == 0) itw3[0] = (int)__hip_atomic_fetch_add(qhead3, 1u, __ATOMIC_RELAXED, __HIP_MEMORY_SCOPE_AGENT);
            __syncthreads(); item = itw3[0]; __syncthreads(); }
        if (item >= n_items) break;
        const int cid = item >> 2, h = item & 3, row0 = chunk_row0(cid);
        {
            const size_t r = (size_t)(row0 + ti);
            const u32x4 qraw = *(const u32x4*)(P + r * INWP + C_GQ + h * 64 + tk0), kraw = *(const u32x4*)(P + r * INWP + C_GK + h * 64 + tk0);
            const f32x4 f0 = *(const f32x4*)(BF + r * 256 + h * 64 + tk0), f1 = *(const f32x4*)(BF + r * 256 + h * 64 + tk0 + 4);
            const f32x4 b0 = *(const f32x4*)(BB + r * 256 + h * 64 + tk0), b1 = *(const f32x4*)(BB + r * 256 + h * 64 + tk0 + 4);
            u32x4 vraw[2];
#pragma unroll
            for (int j = 0; j < 2; ++j) vraw[j] = *(const u32x4*)(P + (size_t)(row0 + 2 * (tid >> 4) + j) * INWP + C_GV + h * 128 + (tid & 15) * 8);
            float q[8], kk[8]; unpack8(qraw, q); unpack8(kraw, kk);
            const float bf[8] = {f0.x, f0.y, f0.z, f0.w, f1.x, f1.y, f1.z, f1.w}, bb[8] = {b0.x, b0.y, b0.z, b0.w, b1.x, b1.y, b1.z, b1.w};
            float o0[8], o1[8], o2[8], o3[8];
#pragma unroll
            for (int e = 0; e < 8; ++e) { const float ef = __expf(bf[e]), eb = __expf(bb[e]); const float qs = q[e] * 0.125f;
                o0[e] = qs * ef; o1[e] = kk[e] / ef; o2[e] = qs * eb; o3[e] = kk[e] / eb; }
            *(LAS u32x4*)(QEf + ti * GP + tk0) = pack8(o0); *(LAS u32x4*)(KEf + ti * GP + tk0) = pack8(o1); *(LAS u32x4*)(QEb + ti * GP + tk0) = pack8(o2); *(LAS u32x4*)(KEb + ti * GP + tk0) = pack8(o3);
#pragma unroll
            for (int d = 0; d < 4; ++d) { const int i2 = 2 * (tid >> 4), v0 = (tid & 15) * 8; const unsigned a = vraw[0][d], b = vraw[1][d];
                *(LAS unsigned*)(VT + (v0 + 2 * d) * GP + i2) = (a & 0xffffu) | (b << 16); *(LAS unsigned*)(VT + (v0 + 2 * d + 1) * GP + i2) = (a >> 16) | (b & 0xffff0000u); }
        }
        float gt[4][4];
#pragma unroll
        for (int g = 0; g < 4; ++g)
#pragma unroll
            for (int vt = 0; vt < 4; ++vt) gt[g][vt] = bflo((unsigned)P[(size_t)(row0 + it * 16 + fq * 4 + g) * INWP + C_GG + h * 128 + (vh * 4 + vt) * 16 + fr]);
        __syncthreads();
        f32x4 acc[4];
#pragma unroll
        for (int vt = 0; vt < 4; ++vt) acc[vt] = (f32x4){0.f, 0.f, 0.f, 0.f};
#pragma unroll
        for (int dir = 0; dir < 2; ++dir) {
            const LAS bf16_t* QE = dir ? QEb : QEf; const LAS bf16_t* KE = dir ? KEb : KEf;
            bf16x8 qa[2], sbf[2][4];
            const bf16_t* Sg = SST + ((size_t)item * 2 + dir) * 8192;
#pragma unroll
            for (int ks = 0; ks < 2; ++ks)
#pragma unroll
                for (int vt = 0; vt < 4; ++vt) sbf[ks][vt] = *(const bf16x8*)(Sg + ((vh * 4 + vt) * 16 + fr) * 64 + ks * 32 + fq * 8);
#pragma unroll
            for (int ks = 0; ks < 2; ++ks) qa[ks] = *(const LAS bf16x8*)(QE + (it * 16 + fr) * GP + ks * 32 + fq * 8);
#pragma unroll
            for (int jt = 0; jt < 4; ++jt) { f32x4 a = (f32x4){0.f, 0.f, 0.f, 0.f};
#pragma unroll
                for (int ks = 0; ks < 2; ++ks) { const bf16x8 kb = *(const LAS bf16x8*)(KE + (jt * 16 + fr) * GP + ks * 32 + fq * 8); a = __builtin_amdgcn_mfma_f32_16x16x32_bf16(qa[ks], kb, a, 0, 0, 0); }
#pragma unroll
                for (int g = 0; g < 4; ++g) { const int ii = it * 16 + fq * 4 + g, jj = jt * 16 + fr; const bool keep = dir ? (jj >= ii) : (jj <= ii);
                    ATT[(fq * 4 + g) * GP + jt * 16 + fr] = (bf16_t)f2bf(keep ? a[g] : 0.f); } }
            LDS_FENCE();
#pragma unroll
            for (int ks = 0; ks < 2; ++ks) { const bf16x8 aa = *(const LAS bf16x8*)(ATT + fr * GP + ks * 32 + fq * 8);
#pragma unroll
                for (int vt = 0; vt < 4; ++vt) { const int v = (vh * 4 + vt) * 16 + fr;
                    const bf16x8 vb = *(const LAS bf16x8*)(VT + v * GP + ks * 32 + fq * 8);
                    acc[vt] = __builtin_amdgcn_mfma_f32_16x16x32_bf16(aa, vb, acc[vt], 0, 0, 0);
                    acc[vt] = __builtin_amdgcn_mfma_f32_16x16x32_bf16(qa[ks], sbf[ks][vt], acc[vt], 0, 0, 0); } }
            LDS_FENCE();
        }
        float ss[4];
#pragma unroll
        for (int g = 0; g < 4; ++g) { float t = 0.f;
#pragma unroll
            for (int vt = 0; vt < 4; ++vt) t += acc[vt][g] * acc[vt][g];
            ss[g] = row16_sum(t); }
        if (fr == 0) {
#pragma unroll
            for (int g = 0; g < 4; ++g) RS[(it * 16 + fq * 4 + g) * 2 + vh] = ss[g]; }
        __syncthreads();
#pragma unroll
        for (int g = 0; g < 4; ++g) { const int i = it * 16 + fq * 4 + g; const float tot = RS[i * 2] + RS[i * 2 + 1];
            const float rs = 1.0f / sqrtf(tot * (1.0f / 128.0f) + LN_EPS); const size_t r = (size_t)(row0 + i);
#pragma unroll
            for (int vt = 0; vt < 4; ++vt) { const int v = (vh * 4 + vt) * 16 + fr;
                MIX[r * DM + 512 + h * 128 + v] = (bf16_t)f2bf(acc[vt][g] * rs * nw[v] * silu_f(gt[g][vt])); } }
        __syncthreads();
    }
}

__device__ __forceinline__ void ln_row(f32x4 (&v)[8], const float* lg, const float* lb, int lane) {
    float s = 0.f;
#pragma unroll
    for (int j = 0; j < 8; ++j) s += (v[j].x + v[j].y) + (v[j].z + v[j].w);
    const float mean = wave_sum(s) * (1.0f / DM);
    float s2 = 0.f;
#pragma unroll
    for (int j = 0; j < 8; ++j) { v[j] = v[j] - mean; s2 += (v[j].x * v[j].x + v[j].y * v[j].y) + (v[j].z * v[j].z + v[j].w * v[j].w); }
    const float rstd = 1.0f / sqrtf(wave_sum(s2) * (1.0f / DM) + LN_EPS);
#pragma unroll
    for (int j = 0; j < 8; ++j) { const int c = lane * 4 + 256 * j; const f32x4 g = *(const f32x4*)(lg + c), b = *(const f32x4*)(lb + c); v[j] = v[j] * rstd * g + b; }
}

__device__ __forceinline__ void phase_ln1(const Params& p, int l, LAS unsigned char* lds, int tid, int lane, int wave, int bid, int G) {
    const int gw = bid * NWAVES + wave, NGW = G * NWAVES;
    const float* MOD = (const float*)(p.ws + WS_MOD); const bf16_t* Y = (const bf16_t*)(p.ws + WS_Y); const float* YP = (const float*)(p.ws + WS_YPART);
    bf16_t* XM = (bf16_t*)(p.ws + WS_XM); bf16_t* HB = (bf16_t*)(p.ws + WS_HB);
    LAS float* VEC = (LAS float*)lds;
    for (int i = tid; i < 11 * DM / 4; i += NTHREADS) { const int vi = i / (DM / 4), c = (i % (DM / 4)) * 4;
        const float* src = vi < 9 ? MOD + (size_t)(l * 3 + (vi % 3)) * 6 * DM + (2 + vi / 3) * DM + c : (vi == 9 ? p.in[I_LNG] : p.in[I_LNB]) + (size_t)(l * 2 + 0) * DM + c;
        *(LAS f32x4*)(VEC + vi * DM + c) = *(const f32x4*)src; }
    __syncthreads();
    f32x4 xn[8]; u32x2 yn[8];
#define LN1_LOAD(rr) do { if (l == 0) { const float* xr_ = xsrc(p, 0, (rr)); _Pragma("unroll") for (int j = 0; j < 8; ++j) xn[j] = *(const f32x4*)(xr_ + lane * 4 + 256 * j); } \
        else { const bf16_t* xb_ = (const bf16_t*)(p.ws + WS_XL) + (size_t)(rr) * DM; _Pragma("unroll") for (int j = 0; j < 8; ++j) { const u32x2 w_ = *(const u32x2*)(xb_ + lane * 4 + 256 * j); xn[j] = (f32x4){bflo(w_.x), bfhi(w_.x), bflo(w_.y), bfhi(w_.y)}; } } \
        if ((rr) < TL) { _Pragma("unroll") for (int j = 0; j < 8; ++j) yn[j] = *(const u32x2*)(Y + (size_t)(rr) * DM + lane * 4 + 256 * j); } } while (0)
    if (row_first(wave, bid, G) >= 0) LN1_LOAD(row_first(wave, bid, G));
    for (int r = row_first(wave, bid, G); r >= 0; r = row_next(r, wave, bid, G, TA)) {
        const int st = row_stream(r);
        f32x4 v[8], yy[8];
#pragma unroll
        for (int j = 0; j < 8; ++j) v[j] = xn[j];
        if (r < TL) {
#pragma unroll
            for (int j = 0; j < 8; ++j) yy[j] = (f32x4){bflo(yn[j].x), bfhi(yn[j].x), bflo(yn[j].y), bfhi(yn[j].y)};
        } else {
#pragma unroll
            for (int j = 0; j < 8; j += 2) { f32x4 pp[2][8];
#pragma unroll
                for (int jj = 0; jj < 2; ++jj)
#pragma unroll
                    for (int ks = 0; ks < 8; ++ks) pp[jj][ks] = *(const f32x4*)(YP + ((size_t)ks * 512 + (r - TL)) * DM + lane * 4 + 256 * (j + jj));
#pragma unroll
                for (int jj = 0; jj < 2; ++jj) yy[j + jj] = ((pp[jj][0] + pp[jj][1]) + (pp[jj][2] + pp[jj][3])) + ((pp[jj][4] + pp[jj][5]) + (pp[jj][6] + pp[jj][7])); }
        }
        { const int rn = row_next(r, wave, bid, G, TA); if (rn >= 0) LN1_LOAD(rn); }
#pragma unroll
        for (int j = 0; j < 8; ++j) { const f32x4 g = *(const LAS f32x4*)(VEC + st * DM + lane * 4 + 256 * j); v[j] = v[j] * DN_ALPHA + g * yy[j]; }
        float s = 0.f;
#pragma unroll
        for (int j = 0; j < 8; ++j) s += (v[j].x + v[j].y) + (v[j].z + v[j].w);
        const float mean = wave_sum(s) * (1.0f / DM);
        float s2 = 0.f;
#pragma unroll
        for (int j = 0; j < 8; ++j) { v[j] = v[j] - mean; s2 += (v[j].x * v[j].x + v[j].y * v[j].y) + (v[j].z * v[j].z + v[j].w * v[j].w); }
        const float rstd = 1.0f / sqrtf(wave_sum(s2) * (1.0f / DM) + LN_EPS);
#pragma unroll
        for (int j = 0; j < 8; ++j) { const int c = lane * 4 + 256 * j;
            const f32x4 g = *(const LAS f32x4*)(VEC + 9 * DM + c), b = *(const LAS f32x4*)(VEC + 10 * DM + c), sh = *(const LAS f32x4*)(VEC + (3 + st) * DM + c), sc = *(const LAS f32x4*)(VEC + (6 + st) * DM + c);
            const f32x4 o = v[j] * rstd * g + b;
            { u32x2 xw; xw.x = pk2(o.x, o.y); xw.y = pk2(o.z, o.w); *(u32x2*)(XM + (size_t)r * DM + c) = xw; }
            u32x2 w; w.x = pk2(o.x * (1.f + sc.x) + sh.x, o.y * (1.f + sc.y) + sh.y); w.y = pk2(o.z * (1.f + sc.z) + sh.z, o.w * (1.f + sc.w) + sh.w);
            *(u32x2*)(HB + (size_t)r * DM + c) = w; }
    }
#undef LN1_LOAD
}

constexpr int SKP = 136;
__device__ __forceinline__ unsigned f2key(float f) { const unsigned u = __builtin_bit_cast(unsigned, f); return u ^ ((u >> 31) ? 0xFFFFFFFFu : 0x80000000u); }
__device__ __forceinline__ float key2f(unsigned k) { const unsigned u = (k >> 31) ? (k ^ 0x80000000u) : ~k; return __builtin_bit_cast(float, u); }
__device__ __forceinline__ unsigned row16_max_u32(unsigned k) {
    unsigned o;
    o = (unsigned)__builtin_amdgcn_update_dpp(0, (int)k, 0xB1, 0xF, 0xF, false); k = k > o ? k : o;
    o = (unsigned)__builtin_amdgcn_update_dpp(0, (int)k, 0x4E, 0xF, 0xF, false); k = k > o ? k : o;
    o = (unsigned)__builtin_amdgcn_update_dpp(0, (int)k, 0x141, 0xF, 0xF, false); k = k > o ? k : o;
    o = (unsigned)__builtin_amdgcn_update_dpp(0, (int)k, 0x140, 0xF, 0xF, false); k = k > o ? k : o;
    return k;
}
__device__ __forceinline__ void peer_retrieve(const Params& p, int l, LAS unsigned char* lds, int tid, int lane, int wave, int bid, int G, int ntok) {
    LAS bf16_t* SK = (LAS bf16_t*)lds;
    const bf16_t* SUBB = (const bf16_t*)(p.ws + WS_SUBB) + (size_t)l * 2 * 128 * 128;
#pragma unroll 1
    for (int j = 0; j < 8; ++j) { const int vv = tid + NTHREADS * j, row = vv >> 4, c = vv & 15; *(LAS u32x4*)(SK + row * SKP + c * 8) = *(const u32x4*)(SUBB + row * 128 + c * 8); }
    __syncthreads();
    const bf16_t* QP = (const bf16_t*)(p.ws + WS_QP); const float* QPP = (const float*)(p.ws + WS_QPART);
    int* EIDX = (int*)(p.ws + WS_EIDX); float* EGATE = (float*)(p.ws + WS_EGATE);
    const int gw = bid * NWAVES + wave, NGW = G * NWAVES, fr = lane & 15, fq = lane >> 4, gbase = lane & 48;
    const int nitems = (ntok / 16) * 8;
    const int nmain = nitems / NGW, nfull = nmain * NGW, nextra = (wave == 0 && nfull + bid < nitems) ? (nitems - nfull - bid + G - 1) / G : 0;
    for (int ri = 0; ri < nmain + nextra; ++ri) {
        const int item = ri < nmain ? gw + NGW * ri : nfull + bid + (ri - nmain) * G;
        const int tile = item >> 3, h = item & 7;
        unsigned tkp[2][4];
        bf16x8 afr[2][4];
        if (tile * 16 < TL) {
#pragma unroll
            for (int pp = 0; pp < 2; ++pp)
#pragma unroll
                for (int ks = 0; ks < 4; ++ks) afr[pp][ks] = *(const bf16x8*)(QP + (size_t)(tile * 16 + fr) * DM + h * 256 + pp * 128 + ks * 32 + fq * 8);
        } else {
#pragma unroll
            for (int pp = 0; pp < 2; ++pp)
#pragma unroll
                for (int ks = 0; ks < 4; ++ks) { const float* qp = QPP + (size_t)(tile * 16 - TL + fr) * DM + h * 256 + pp * 128 + ks * 32 + fq * 8;
                    f32x4 pa[8], pb[8];
#pragma unroll
                    for (int sl = 0; sl < 8; ++sl) { pa[sl] = *(const f32x4*)(qp + (size_t)sl * 512 * DM); pb[sl] = *(const f32x4*)(qp + (size_t)sl * 512 * DM + 4); }
                    const f32x4 s0 = ((pa[0] + pa[1]) + (pa[2] + pa[3])) + ((pa[4] + pa[5]) + (pa[6] + pa[7])), s1 = ((pb[0] + pb[1]) + (pb[2] + pb[3])) + ((pb[4] + pb[5]) + (pb[6] + pb[7]));
                    u32x4 w; w.x = pk2(s0.x, s0.y); w.y = pk2(s0.z, s0.w); w.z = pk2(s1.x, s1.y); w.w = pk2(s1.z, s1.w); afr[pp][ks] = __builtin_bit_cast(bf16x8, w); }
        }
#pragma unroll
        for (int pp = 0; pp < 2; ++pp) {
            asm volatile("" ::: "memory"); __builtin_amdgcn_sched_barrier(0);
            f32x4 acc[8];
#pragma unroll
            for (int kt = 0; kt < 8; ++kt) acc[kt] = (f32x4){0.f, 0.f, 0.f, 0.f};
#pragma unroll
            for (int ks = 0; ks < 4; ++ks) { const bf16x8 a = afr[pp][ks];
#pragma unroll
                for (int kt = 0; kt < 8; ++kt) { const bf16x8 bb = *(const LAS bf16x8*)(SK + (pp * 128 + kt * 16 + fr) * SKP + ks * 32 + fq * 8); acc[kt] = __builtin_amdgcn_mfma_f32_16x16x32_bf16(a, bb, acc[kt], 0, 0, 0); } }
            unsigned kv[4][8];
#pragma unroll
            for (int g = 0; g < 4; ++g)
#pragma unroll
                for (int kt = 0; kt < 8; ++kt) kv[g][kt] = (f2key(acc[kt][g]) & ~127u) | (unsigned)(127 - (kt * 16 + fr));
#define CSWAP(a_, b_) do { const unsigned hi_ = a_ > b_ ? a_ : b_, lo_ = a_ > b_ ? b_ : a_; a_ = hi_; b_ = lo_; } while (0)
#pragma unroll
            for (int g = 0; g < 4; ++g) {
                CSWAP(kv[g][0], kv[g][1]); CSWAP(kv[g][2], kv[g][3]); CSWAP(kv[g][4], kv[g][5]); CSWAP(kv[g][6], kv[g][7]);
                CSWAP(kv[g][0], kv[g][2]); CSWAP(kv[g][1], kv[g][3]); CSWAP(kv[g][4], kv[g][6]); CSWAP(kv[g][5], kv[g][7]);
                CSWAP(kv[g][1], kv[g][2]); CSWAP(kv[g][5], kv[g][6]);
                CSWAP(kv[g][0], kv[g][4]); CSWAP(kv[g][1], kv[g][5]); CSWAP(kv[g][2], kv[g][6]); CSWAP(kv[g][3], kv[g][7]);
                CSWAP(kv[g][2], kv[g][4]); CSWAP(kv[g][3], kv[g][5]);
                CSWAP(kv[g][1], kv[g][2]); CSWAP(kv[g][3], kv[g][4]); CSWAP(kv[g][5], kv[g][6]);
            }
#undef CSWAP
            unsigned tk[4] = {0u, 0u, 0u, 0u};
#pragma unroll 1
            for (int it = 0; it < 16; ++it) {
#pragma unroll
                for (int g = 0; g < 4; ++g) {
                    const unsigned m = row16_max_u32(kv[g][0]);
                    tk[g] = fr == it ? m : tk[g];
                    const bool won = kv[g][0] == m;
#pragma unroll
                    for (int kt = 0; kt < 7; ++kt) kv[g][kt] = won ? kv[g][kt + 1] : kv[g][kt];
                    kv[g][7] = won ? 0u : kv[g][7];
                }
            }
#pragma unroll
            for (int g = 0; g < 4; ++g) tkp[pp][g] = tk[g];
        }
        float av[4], bv[4]; int ptr[4]; unsigned best[4];
#pragma unroll
        for (int g = 0; g < 4; ++g) { av[g] = key2f(tkp[0][g] & ~127u); bv[g] = key2f(tkp[1][g] & ~127u); ptr[g] = 0; best[g] = 0u; }
#pragma unroll 1
        for (int it = 0; it < 16; ++it) {
#pragma unroll
            for (int g = 0; g < 4; ++g) {
                const float bj = __shfl(bv[g], gbase + (ptr[g] & 15));
                const unsigned mine = ptr[g] < 16 ? ((f2key(av[g] + bj) & ~255u) | (unsigned)(255 - (fr * 16 + (ptr[g] & 15)))) : 0u;
                const unsigned m = row16_max_u32(mine);
                best[g] = fr == it ? m : best[g];
                ptr[g] += (m == mine) ? 1 : 0;
            }
        }
#pragma unroll
        for (int g = 0; g < 4; ++g) {
            const int bc = 255 - (int)(best[g] & 255u);
            const float bval = key2f(best[g] & ~255u);
            const int k1 = 127 - (int)(tkp[0][g] & 127u), k2 = 127 - (int)(tkp[1][g] & 127u);
            const int i1 = __shfl(k1, gbase + (bc >> 4)), i2 = __shfl(k2, gbase + (bc & 15));
            const float mx = __shfl(bval, gbase);
            const float ex = __expf(bval - mx);
            const float sm = row16_sum(ex);
            const size_t tok = (size_t)tile * 16 + fq * 4 + g;
            EIDX[tok * 128 + h * 16 + fr] = i1 * 128 + i2; EGATE[tok * 128 + h * 16 + fr] = ex / sm;
        }
    }
}

template <int CTRL> __device__ __forceinline__ float dppf(float x) { return __builtin_bit_cast(float, __builtin_amdgcn_mov_dpp(__builtin_bit_cast(int, x), CTRL, 0xf, 0xf, true)); }
__device__ __forceinline__ float rs_group8(float (&d)[8], bool b8) {
    asm volatile("s_nop 1\n\tv_permlane32_swap_b32 %0, %4\n\tv_permlane32_swap_b32 %1, %5\n\tv_permlane32_swap_b32 %2, %6\n\tv_permlane32_swap_b32 %3, %7"
                 : "+v"(d[0]), "+v"(d[1]), "+v"(d[2]), "+v"(d[3]), "+v"(d[4]), "+v"(d[5]), "+v"(d[6]), "+v"(d[7]));
    float s0 = d[0] + d[4], s1 = d[1] + d[5], s2 = d[2] + d[6], s3 = d[3] + d[7];
    asm volatile("s_nop 1\n\tv_permlane16_swap_b32 %0, %2\n\tv_permlane16_swap_b32 %1, %3" : "+v"(s0), "+v"(s1), "+v"(s2), "+v"(s3));
    const float t0 = s0 + s2, t1 = s1 + s3;
    const float m = b8 ? t1 : t0, o = b8 ? t0 : t1;
    return m + dppf<0x128>(o);
}
template <int CTRL> __device__ __forceinline__ float rs_merge(float a, float b, bool bit) { const float m = bit ? b : a, o = bit ? a : b; return m + dppf<CTRL>(o); }
constexpr int PG = 8;
__device__ __forceinline__ void phase_peer(const Params& p, int l, LAS unsigned char* lds, int tid, int lane, int wave, int bid, int G) {
    const int gw = bid * NWAVES + wave, NGW = G * NWAVES;
    const float* MOD = (const float*)(p.ws + WS_MOD);
    bf16_t* XL = (bf16_t*)(p.ws + WS_XL); bf16_t* HB = (bf16_t*)(p.ws + WS_HB);
    const float* lg = p.in[I_LNG] + (size_t)(l * 2 + 1) * DM; const float* lb = p.in[I_LNB] + (size_t)(l * 2 + 1) * DM;
    const unsigned char* UB = p.ws + WS_UB + (size_t)l * NEXP * ROWB_U; const unsigned char* VB = p.ws + WS_VB + (size_t)l * NEXP * ROWB_V;
    const float* USC = (const float*)(p.ws + WS_USC) + (size_t)l * NEXP; (void)USC; const float* VSC = (const float*)(p.ws + WS_VSC) + (size_t)l * NEXP; (void)VSC;
    const int* EIDX = (const int*)(p.ws + WS_EIDX); const float* EGATE = (const float*)(p.ws + WS_EGATE);
    const bool last = (l == DEPTH - 1);
    const int nrows = last ? TL : TA;
    constexpr int HLW = 64 * 33 * 4 + 128;
    LAS float* HL = (LAS float*)(lds + wave * HLW) + lane * 33;
    LAS int* PI = (LAS int*)((LAS float*)(lds + wave * HLW) + 64 * 33);
#define VQ(tt_) ((((tt_) * 64) + lane) << 2)
    LAS float* VEC = (LAS float*)(lds + 8 * HLW);
    for (int i = tid; i < 11 * DM / 4; i += NTHREADS) { const int vi = i / (DM / 4), c = (i % (DM / 4)) * 4; const int ln = last ? l : l + 1;
        const float* src = vi < 3 ? MOD + (size_t)(l * 3 + vi) * 6 * DM + 5 * DM + c : (vi < 9 ? MOD + (size_t)(ln * 3 + (vi % 3)) * 6 * DM + (vi / 3 - 1) * DM + c : (vi == 9 ? lg : lb) + c);
        *(LAS f32x4*)(VEC + vi * DM + ((((c >> 2) & 7) * 64 + (c >> 5)) << 2)) = *(const f32x4*)src; }
    __syncthreads();
#if !TBL_U_FP4
    {
        float one = 1.0f; asm volatile("" : "+v"(one));
        f32x16 t0, t1;
#pragma unroll
        for (int c = 0; c < 32; ++c) { const float v = one * (c < 8 ? (float)c * 0.125f : (1.0f + (float)(c & 7) * 0.125f) * (float)(1 << ((c >> 3) - 1))); if (c < 16) t0[c] = v; else t1[c - 16] = v; }
        const u32x6 pw = pack_fp6_2x16(t0, t1);
        const f32x32 un = unpack_fp6_32(pw);
#pragma unroll
        for (int j = 0; j < 32; ++j) { const float y = un[j]; int c;
            if (y < 1.0f) c = (int)(y * 8.0f + 0.5f); else { const int e = y < 2.0f ? 0 : (y < 4.0f ? 1 : 2); c = 8 * (e + 1) + (int)((y / (float)(1 << e) - 1.0f) * 8.0f + 0.5f); }
            if (lane == 0) PI[j] = c & 31; }
        LDS_FENCE();
#if defined(DIAG_PI)
        { unsigned mk = 0u;
#pragma unroll
          for (int j = 0; j < 32; ++j) mk |= 1u << PI[j];
          if (mk != 0xFFFFFFFFu && l == 0 && gw == 0 && lane == 0) ((float*)(p.ws + WS_CTL + 131072))[0] = 1.0f; }
#endif
    }
#endif
    const unsigned ulane = (unsigned)lane & 63u, loff16 = ulane * 16u; (void)ulane; (void)loff16;
    const bool lb8 = (lane & 8) != 0, lb4 = (lane & 4) != 0, lb2 = (lane & 2) != 0, lb1 = (lane & 1) != 0; (void)lb8; (void)lb4; (void)lb2; (void)lb1;
    const int lsrc = ((lane & 6) << 3) | ((lane & 1) << 3) | (((lane >> 3) & 1) << 2) | (((lane >> 4) & 1) << 1) | ((lane >> 5) & 1); (void)lsrc;
    for (int r = row_first(wave, bid, G); r >= 0; r = row_next(r, wave, bid, G, nrows)) {
        const float* mod = MOD + (size_t)(l * 3 + row_stream(r)) * 6 * DM;
        f32x2v hn[16];
#pragma unroll
        for (int c = 0; c < 4; ++c) { float f[8]; unpack8(*(const u32x4*)(HB + (size_t)r * DM + lane * 32 + c * 8), f);
#pragma unroll
            for (int e = 0; e < 4; ++e) hn[c * 4 + e] = (f32x2v){f[2 * e], f[2 * e + 1]}; }
#if !TBL_U_FP4
#pragma unroll
        for (int j = 0; j < 16; ++j) { HL[2 * j] = hn[j].x; HL[2 * j + 1] = hn[j].y; }
        LDS_FENCE();
        f32x2v hf[16];
#pragma unroll
        for (int j = 0; j < 16; ++j) hf[j] = (f32x2v){HL[PI[2 * j]], HL[PI[2 * j + 1]]};
        LDS_FENCE();
#endif
#if TBL_U_I4
        int hlo[4], hhi[4]; unsigned basel;
        { float am = 0.f;
#pragma unroll
          for (int j = 0; j < 16; ++j) am = fmaxf(am, fmaxf(fabsf(hn[j].x), fabsf(hn[j].y)));
          const unsigned ab = __builtin_bit_cast(unsigned, am * (1.0f / 119.0f)); unsigned eb = (ab >> 23) + ((ab & 0x007fffffu) ? 1u : 0u); eb = eb < 1u ? 1u : (eb > 253u ? 253u : eb);
          const float inv = __builtin_bit_cast(float, (254u - eb) << 23);
          basel = U_ROWSCALE ? (eb << 23) : (I4_BASE + ((eb - 127u) << 23));
#pragma unroll
          for (int d = 0; d < 4; ++d) { unsigned tl = 0u, th = 0u;
#pragma unroll
              for (int e = 0; e < 8; ++e) { const f32x2v pr = hn[d * 4 + (e >> 1)]; const float xv = (e & 1) ? pr.y : pr.x;
                  const unsigned qb = __builtin_bit_cast(unsigned, xv * inv + 12582912.0f);
                  tl |= (qb & 15u) << (4 * e); th |= (((qb + 8u) >> 4) & 15u) << (4 * e); }
              hlo[d] = (int)tl; hhi[d] = (int)th; } }
#endif
        const int e0 = EIDX[(size_t)r * 128 + lane], e1 = EIDX[(size_t)r * 128 + 64 + lane];
        const float g0 = EGATE[(size_t)r * 128 + lane], g1 = EGATE[(size_t)r * 128 + 64 + lane];
#if !TBL_U_FP4 || U_ROWSCALE
        const float su0 = USC[e0], su1 = USC[e1];
#else
        const float su0 = 1.0f, su1 = 1.0f;
#endif
        float wgt[2] = {0.f, 0.f};
#define P4_LOAD(dq, ds, TB, eh, j0) do { unsigned lo_ = loff16, ul_ = ulane; asm volatile("" : "+v"(lo_), "+v"(ul_));    \
        _Pragma("unroll") for (int c = 0; c < PG; ++c) { const int e_ = __builtin_amdgcn_readlane(eh, (j0) + c); \
            const unsigned char* rp_ = (TB) + (size_t)e_ * ROWB4; dq[c] = *(const u32x4*)(rp_ + lo_); ds[c] = rp_[1024u + ul_]; } } while (0)
#if V_ROWSCALE
#define P4_LDV P4_LOADU
#else
#define P4_LDV P4_LOAD
#endif
#if U_ROWSCALE
#define P4_LDU P4_LOADU
#else
#define P4_LDU P4_LOAD
#endif
#define P4_LOADU(dq, ds, TB, eh, j0) do { const __amdgpu_buffer_rsrc_t rs_ = __builtin_amdgcn_make_buffer_rsrc((void*)(TB), 0, NEXP * 1024, 0x00020000); \
        _Pragma("unroll") for (int c = 0; c < PG; ++c) { const int e_ = __builtin_amdgcn_readlane(eh, (j0) + c); \
            dq[c] = __builtin_bit_cast(u32x4, __builtin_amdgcn_raw_buffer_load_b128(rs_, (int)loff16, (int)(((unsigned)e_ & 0x3fffu) << 10), 0)); ds[c] = e_; } } while (0)
#define P4_CVT(dq, c, d, b, sc) __builtin_amdgcn_cvt_scalef32_pk_f32_fp4(dq[c][d], sc, b)
#if TBL_U_I4
#define P4_DOT(dq, ds, rr) do { float d_[PG]; _Pragma("unroll") for (int c = 0; c < PG; ++c) { int t_ = 0;        \
            _Pragma("unroll") for (int d = 0; d < 4; ++d) t_ = __builtin_amdgcn_sdot8((int)dq[c][d], hhi[d], t_, false); \
            t_ <<= 4; \
            _Pragma("unroll") for (int d = 0; d < 4; ++d) t_ = __builtin_amdgcn_sdot8((int)dq[c][d], hlo[d], t_, false); \
            d_[c] = (float)t_ * (U_ROWSCALE ? __builtin_bit_cast(float, basel) : __builtin_bit_cast(float, ((unsigned)ds[c] << 20) + basel)); } \
        rr = rs_group8(d_, lb8); } while (0)
#else
#define P4_DOT(dq, ds, rr) do { float d_[PG]; _Pragma("unroll") for (int c = 0; c < PG; ++c) { const float sc_ = __builtin_bit_cast(float, (unsigned)ds[c] << 23); f32x2v a0_ = (f32x2v){0.f, 0.f}, a1_ = (f32x2v){0.f, 0.f}; \
            _Pragma("unroll") for (int d = 0; d < 4; ++d) { a0_ += P4_CVT(dq, c, d, 0, sc_) * hn[d * 4 + 0]; a1_ += P4_CVT(dq, c, d, 1, sc_) * hn[d * 4 + 1]; a0_ += P4_CVT(dq, c, d, 2, sc_) * hn[d * 4 + 2]; a1_ += P4_CVT(dq, c, d, 3, sc_) * hn[d * 4 + 3]; } \
            d_[c] = (a0_.x + a0_.y) + (a1_.x + a1_.y); asm volatile("" : "+v"(d_[c])); } \
        rr = rs_group8(d_, lb8); } while (0)
#endif
#define P4_AXPY(dq, ds, wh, j0) do { _Pragma("unroll") for (int c = 0; c < PG; ++c) { const float wj_ = V_ROWSCALE ? __builtin_bit_cast(float, (unsigned)ds[c] & 0xffff0000u) : __builtin_bit_cast(float, __builtin_amdgcn_readlane(wh, (j0) + c)); const f32x2v w2_ = (f32x2v){wj_, wj_}; \
            const float sc_ = V_ROWSCALE ? 1.0f : __builtin_bit_cast(float, (unsigned)ds[c] << 23); \
            _Pragma("unroll") for (int d = 0; d < 4; ++d) { yv[d * 4 + 0] += P4_CVT(dq, c, d, 0, sc_) * w2_; yv[d * 4 + 1] += P4_CVT(dq, c, d, 1, sc_) * w2_; yv[d * 4 + 2] += P4_CVT(dq, c, d, 2, sc_) * w2_; yv[d * 4 + 3] += P4_CVT(dq, c, d, 3, sc_) * w2_; } \
            asm volatile("" : "+v"(yv[0]), "+v"(yv[1]), "+v"(yv[2]), "+v"(yv[3]), "+v"(yv[4]), "+v"(yv[5]), "+v"(yv[6]), "+v"(yv[7]), "+v"(yv[8]), "+v"(yv[9]), "+v"(yv[10]), "+v"(yv[11]), "+v"(yv[12]), "+v"(yv[13]), "+v"(yv[14]), "+v"(yv[15]));   } } while (0)
#if !TBL_U_FP4
#define PEER_LOAD(dq, dd, TB, eh, j0) do { _Pragma("unroll") for (int c = 0; c < PG; ++c) { const int e_ = __builtin_amdgcn_readlane(eh, (j0) + c); \
            const unsigned char* rp_ = (TB) + (size_t)e_ * ROWB; dq[c] = *(const u32x4*)(rp_ + lane * 16); dd[c] = *(const u32x2*)(rp_ + 1024 + lane * 8); } } while (0)
#define PEER_UNPACK(dq, dd, c) unpack_fp6_32((u32x6){dq[c].x, dq[c].y, dq[c].z, dq[c].w, dd[c].x, dd[c].y})
#define PEER_DOT(dq, dd, j0) do { float d_[PG]; _Pragma("unroll") for (int c = 0; c < PG; ++c) { const f32x32 u_ = PEER_UNPACK(dq, dd, c); f32x2v a0_ = (f32x2v){0.f, 0.f}, a1_ = (f32x2v){0.f, 0.f}; \
            _Pragma("unroll") for (int t = 0; t < 8; ++t) { a0_ += (f32x2v){u_[4 * t], u_[4 * t + 1]} * hf[2 * t]; a1_ += (f32x2v){u_[4 * t + 2], u_[4 * t + 3]} * hf[2 * t + 1]; } \
            d_[c] = (a0_.x + a0_.y) + (a1_.x + a1_.y); __builtin_amdgcn_sched_barrier(0); } \
        _Pragma("unroll") for (int o = 1; o < 64; o <<= 1) { _Pragma("unroll") for (int c = 0; c < PG; ++c) d_[c] += __shfl_xor(d_[c], o); } \
        _Pragma("unroll") for (int c = 0; c < PG; ++c) wacc = (lane == (j0) + c) ? d_[c] : wacc; } while (0)
#endif
#pragma unroll
        for (int hh = 0; hh < 2; ++hh) {
            const int eh = hh ? e1 : e0; float wacc = 0.f;
#if TBL_U_FP4
            u32x4 qa[PG], qb[PG]; int sa[PG], sb[PG];
            P4_LDU(qa, sa, UB, eh, 0);
            float wq = 0.f, wp = 0.f;
#pragma unroll 1
            for (int j0 = 0; j0 < 64; j0 += 2 * PG) {
                float ra, rb;
                P4_LDU(qb, sb, UB, eh, j0 + PG);
                P4_DOT(qa, sa, ra);
                if (j0 + 2 * PG < 64) P4_LDU(qa, sa, UB, eh, j0 + 2 * PG);
                P4_DOT(qb, sb, rb);
                const float q = rs_merge<0x141>(ra, rb, lb4);
                if ((j0 & 16) == 0) wq = q;
                else { const float pm = rs_merge<0x4E>(wq, q, lb2);
                       if (j0 == 16) wp = pm; else wacc = rs_merge<0xB1>(wp, pm, lb1); }
            }
            wacc = __shfl(wacc, lsrc);
#else
            u32x4 qa[PG], qb[PG]; u32x2 da[PG], db[PG];
            PEER_LOAD(qa, da, UB, eh, 0);
#pragma unroll 1
            for (int j0 = 0; j0 < 64; j0 += 2 * PG) {
                PEER_LOAD(qb, db, UB, eh, j0 + PG);
                PEER_DOT(qa, da, j0);
                if (j0 + 2 * PG < 64) PEER_LOAD(qa, da, UB, eh, j0 + 2 * PG);
                PEER_DOT(qb, db, j0 + PG);
            }
#endif
            wgt[hh] = gelu_f(wacc * (hh ? su1 : su0)) * (hh ? g1 : g0) * (V_ROWSCALE ? VSC[eh] : 1.0f);
        }
        f32x2v yv[16];
#pragma unroll
        for (int i = 0; i < 16; ++i) yv[i] = (f32x2v){0.f, 0.f};
#pragma unroll
        for (int hh = 0; hh < 2; ++hh) {
            const int eh = V_ROWSCALE ? ((hh ? e1 : e0) | (int)((__builtin_bit_cast(unsigned, wgt[hh]) + 0x8000u) & 0xffff0000u)) : (hh ? e1 : e0); const int wh = __builtin_bit_cast(int, wgt[hh]); (void)wh;
            u32x4 qa[PG], qb[PG]; int sa[PG], sb[PG];
            P4_LDV(qa, sa, VB, eh, 0);
#pragma unroll 1
            for (int j0 = 0; j0 < 64; j0 += 2 * PG) {
                P4_LDV(qb, sb, VB, eh, j0 + PG);
                P4_AXPY(qa, sa, wh, j0);
                if (j0 + 2 * PG < 64) P4_LDV(qa, sa, VB, eh, j0 + 2 * PG);
                P4_AXPY(qb, sb, wh, j0 + PG);
            }
        }
#undef P4_LOAD
#undef P4_CVT
#undef P4_DOT
#undef P4_AXPY
#if !TBL_U_FP4
#undef PEER_LOAD
#undef PEER_UNPACK
#undef PEER_DOT
#endif
        const int st = row_stream(r);
        const bf16_t* xr = (const bf16_t*)(p.ws + WS_XM) + (size_t)r * DM + lane * 32;
        f32x4 xv[8];
#pragma unroll
        for (int t = 0; t < 4; ++t) { const u32x4 w = *(const u32x4*)(xr + t * 8); xv[2 * t] = (f32x4){bflo(w.x), bfhi(w.x), bflo(w.y), bfhi(w.y)}; xv[2 * t + 1] = (f32x4){bflo(w.z), bfhi(w.z), bflo(w.w), bfhi(w.w)}; }
        float s = 0.f;
#pragma unroll
        for (int t = 0; t < 8; ++t) { const f32x4 ga = *(const LAS f32x4*)(VEC + st * DM + VQ(t));
            f32x2v& ya = yv[t * 2]; f32x2v& yb = yv[t * 2 + 1];
            ya.x = xv[t].x * DN_ALPHA + ga.x * ya.x; ya.y = xv[t].y * DN_ALPHA + ga.y * ya.y; yb.x = xv[t].z * DN_ALPHA + ga.z * yb.x; yb.y = xv[t].w * DN_ALPHA + ga.w * yb.y;
            s += (ya.x + ya.y) + (yb.x + yb.y); }
        const float mean = wave_sum(s) * (1.0f / DM);
        float s2 = 0.f;
#pragma unroll
        for (int i = 0; i < 16; ++i) { yv[i] = yv[i] - mean; s2 += yv[i].x * yv[i].x + yv[i].y * yv[i].y; }
        const float rstd = 1.0f / sqrtf(wave_sum(s2) * (1.0f / DM) + LN_EPS);
        float* dst = p.out + (size_t)r * DM + lane * 32; bf16_t* dstb = XL + (size_t)r * DM + lane * 32;
#pragma unroll
        for (int t = 0; t < 8; t += 2) { const int c = t * 4;
            const f32x4 ga = *(const LAS f32x4*)(VEC + 9 * DM + VQ(t)), gb = *(const LAS f32x4*)(VEC + 9 * DM + VQ(t + 1)), ba = *(const LAS f32x4*)(VEC + 10 * DM + VQ(t)), bb = *(const LAS f32x4*)(VEC + 10 * DM + VQ(t + 1));
            const f32x2v y0 = yv[t * 2], y1 = yv[t * 2 + 1], y2 = yv[t * 2 + 2], y3 = yv[t * 2 + 3];
            f32x4 o0, o1;
            o0.x = y0.x * rstd * ga.x + ba.x; o0.y = y0.y * rstd * ga.y + ba.y; o0.z = y1.x * rstd * ga.z + ba.z; o0.w = y1.y * rstd * ga.w + ba.w;
            o1.x = y2.x * rstd * gb.x + bb.x; o1.y = y2.y * rstd * gb.y + bb.y; o1.z = y3.x * rstd * gb.z + bb.z; o1.w = y3.y * rstd * gb.w + bb.w;
            if (last) { *(f32x4*)(dst + c) = o0; *(f32x4*)(dst + c + 4) = o1; }
            else { u32x4 xw; xw.x = pk2(o0.x, o0.y); xw.y = pk2(o0.z, o0.w); xw.z = pk2(o1.x, o1.y); xw.w = pk2(o1.z, o1.w); *(u32x4*)(dstb + c) = xw; }
            if (!last) {
                const f32x4 sa = *(const LAS f32x4*)(VEC + (3 + st) * DM + VQ(t)), sb = *(const LAS f32x4*)(VEC + (3 + st) * DM + VQ(t + 1)), ca = *(const LAS f32x4*)(VEC + (6 + st) * DM + VQ(t)), cb = *(const LAS f32x4*)(VEC + (6 + st) * DM + VQ(t + 1));
                u32x4 o; o.x = pk2(o0.x * (1.f + ca.x) + sa.x, o0.y * (1.f + ca.y) + sa.y); o.y = pk2(o0.z * (1.f + ca.z) + sa.z, o0.w * (1.f + ca.w) + sa.w);
                o.z = pk2(o1.x * (1.f + cb.x) + sb.x, o1.y * (1.f + cb.y) + sb.y); o.w = pk2(o1.z * (1.f + cb.z) + sb.z, o1.w * (1.f + cb.w) + sb.w);
                *(u32x4*)(HB + (size_t)r * DM + lane * 32 + c) = o; }
        }
#if defined(DIAG_PI)
        if (last && r == 5 && lane == 0 && ((const float*)(p.ws + WS_CTL + 131072))[0] != 0.0f) p.out[(size_t)5 * DM] = __builtin_nanf("");
#endif
    }
}

#undef VQ
__device__ __forceinline__ void gemm_rows_bf16(LAS unsigned char* lds, const bf16_t* A, const bf16_t* Bt, bf16_t* C, float* Cpart, bool with_ctx, int G, int bid) {
    { pg8::Gemm g{A, Bt, TL, DM, DM, DM}; pg8::StaticOrder S; S.init(TL, DM, G, bid); pg8::EpiBf16<0> E{C, DM, nullptr, 0, 0, 1.f};
      pg8::gemm_phase<pg8::EpiBf16<0>, pg8::StaticOrder, PG8_ALIGN, PG8_SP2>(lds, g, S, E); }
    if (with_ctx) { int ksl = 256; asm volatile("" : "+s"(ksl));
      pg8::Gemm g{A + (size_t)TL * DM, Bt, TC, DM, ksl, DM}; pg8::SplitKOrder S; S.init(G, bid); pg8::EpiF32Part E{Cpart};
      pg8::gemm_phase<pg8::EpiF32Part, pg8::SplitKOrder, PG8_ALIGN, PG8_SP2>(lds, g, S, E); }
}

constexpr int PH_PER_LAYER = 9, N_PHASES = 2 + DEPTH * PH_PER_LAYER;
__global__ void __launch_bounds__(NTHREADS, 2) fwd_kernel(Params p) {
    extern __shared__ __attribute__((aligned(16))) unsigned char lds_raw[];
    LAS unsigned char* lds = (LAS unsigned char*)lds_raw;
    const int tid = threadIdx.x, lane = tid & 63, wave = __builtin_amdgcn_readfirstlane(tid >> 6), bid = blockIdx.x, G = gridDim.x;
    volatile LAS unsigned* MISC = (volatile LAS unsigned*)(lds + MISC_OFF);
    if (tid < 32) MISC[tid] = 0u;
    __syncthreads();
    if (hipThreadIdx_x == 0) (void)xb_add(&((unsigned*)(p.ws + WS_CTL))[CW_BAR + XB_XCNT(xb_xcc_id())], 1u);
#define IN(k) true
#if defined(PROBE_MASK)
    volatile LAS unsigned long long* PT = (volatile LAS unsigned long long*)(lds + MISC_OFF + 96);
    if (tid == 0) PT[0] = __builtin_amdgcn_s_memrealtime();
#define SEAM(k) do { { XcdBarrier bar_; bar_.bar = (unsigned*)(((const __attribute__((address_space(4))) Params*)__builtin_amdgcn_kernarg_segment_ptr())->ws + WS_CTL) + CW_BAR; bar_.x = xb_xcc_id(); bar_.st = MISC + 8; xcd_barrier(bar_); } if (bid == 0) { const int kind_ = (k) < 2 ? (k) : 2 + ((k) - 2) % PH_PER_LAYER; \
        if (tid == 0) { const unsigned long long now_ = __builtin_amdgcn_s_memrealtime(); if ((PROBE_MASK >> kind_) & 1) { const unsigned long long d_ = (now_ - PT[0]) * PROBE_MULT; \
            while (__builtin_amdgcn_s_memrealtime() - now_ < d_) __builtin_amdgcn_s_sleep(8); } PT[0] = __builtin_amdgcn_s_memrealtime(); } __syncthreads(); } } while (0)
#elif defined(PROBE_DUP_BAR)
#define SEAM(k) do { XcdBarrier bar_; bar_.bar = (unsigned*)(((const __attribute__((address_space(4))) Params*)__builtin_amdgcn_kernarg_segment_ptr())->ws + WS_CTL) + CW_BAR; bar_.x = xb_xcc_id(); bar_.st = MISC + 8; xcd_barrier(bar_); xcd_barrier(bar_); } while (0)
#else
#define SEAM(k) do { XcdBarrier bar_; bar_.bar = (unsigned*)(((const __attribute__((address_space(4))) Params*)__builtin_amdgcn_kernarg_segment_ptr())->ws + WS_CTL) + CW_BAR; bar_.x = xb_xcc_id(); bar_.st = MISC + 8; xcd_barrier(bar_); } while (0)
#endif
    const int NGW = G * NWAVES;
#if defined(__HIP_DEVICE_COMPILE__)
#define KARGS_COPY const Params p_ = *kp_
#else
#define KARGS_COPY const Params p_ = p; (void)kp_
#endif
#define FRESH() int tid_ = threadIdx.x, bid_ = blockIdx.x; asm volatile("" : "+v"(tid_), "+s"(bid_)); const int lane_ = tid_ & 63, wave_ = __builtin_amdgcn_readfirstlane(tid_ >> 6); (void)lane_; (void)wave_; \
    const __attribute__((address_space(4))) Params* kp_ = (const __attribute__((address_space(4))) Params*)__builtin_amdgcn_kernarg_segment_ptr(); asm volatile("" : "+s"(kp_)); KARGS_COPY
    if (IN(0)) { FRESH(); phase_prologue(p_, lds, tid_, lane_, wave_, bid_, G); }
    SEAM(0);
    if (IN(1)) { FRESH(); phase_modulate0(p_, lane_, wave_, bid_, G); }
    SEAM(1);
    for (int l = 0; l < DEPTH; ++l) {
        const int b0 = 2 + l * PH_PER_LAYER;
        if (IN(b0 + 0)) { FRESH();
            pg8::Gemm g{(const bf16_t*)(p_.ws + WS_HB), (const bf16_t*)(p_.ws + WS_WIN) + (size_t)l * INWP * DM, TA, INWP, DM, DM}; pg8::StaticOrder S; S.init(TA, INWP, G, bid_);
            pg8::EpiBf16<0> E{(bf16_t*)(p_.ws + WS_P), INWP, nullptr, 0, 0, 1.f};
            pg8::gemm_phase<pg8::EpiBf16<0>, pg8::StaticOrder, PG8_ALIGN, PG8_SP2>(lds, g, S, E);
#if defined(PROBE_DUP_GEMM)
            __syncthreads(); pg8::gemm_phase<pg8::EpiBf16<0>, pg8::StaticOrder, PG8_ALIGN, PG8_SP2>(lds, g, S, E);
#endif
        }
        SEAM(b0 + 0);
        if (IN(b0 + 1)) { { FRESH(); gla_g1(p_, l, lds, tid_, lane_, wave_, bid_, G); } { FRESH(); phase_post_in(p_, l, lane_, wave_, bid_, G); } }
#if defined(PROBE_DUP_A)
        if (IN(b0 + 1)) { __syncthreads(); { FRESH(); gla_g1(p_, l, lds, tid_, lane_, wave_, bid_, G); } { FRESH(); phase_post_in(p_, l, lane_, wave_, bid_, G); } }
#endif
        SEAM(b0 + 1);
        if (IN(b0 + 2)) {
            unsigned* ctl_ = (unsigned*)(((const __attribute__((address_space(4))) Params*)__builtin_amdgcn_kernarg_segment_ptr())->ws + WS_CTL);
            { FRESH(); gla_g2(p_, tid_, bid_, G);
              if (bid_ < 64) { asm volatile("s_waitcnt vmcnt(0)" ::: "memory"); __syncthreads();
                  if (tid_ == 0) { __builtin_amdgcn_fence(__ATOMIC_RELEASE, "agent"); asm volatile("s_waitcnt vmcnt(0)" ::: "memory"); (void)xb_add(ctl_ + CW_QUEUE + 64 * (12 + l), 1u); } } }
            { FRESH(); phase_mixers(p_, l, lds, tid_, lane_, wave_, bid_, G); }
            { FRESH();
              if (tid_ == 0) { unsigned* bar = ctl_ + CW_BAR; XB_SPIN(xb_ld(ctl_ + CW_QUEUE + 64 * (12 + l)) < (G < 64 ? (unsigned)G : 64u), bar);
                  __builtin_amdgcn_fence(__ATOMIC_ACQUIRE, "agent"); asm volatile("s_waitcnt vmcnt(0)" ::: "memory"); }
              __syncthreads();
              gla_g3(p_, l, lds, tid_, lane_, wave_, bid_, G, ctl_ + CW_QUEUE + 64 * (8 + l)); }
        }
#if defined(PROBE_DUP_B)
        if (IN(b0 + 2)) { __syncthreads(); { FRESH(); gla_g2(p_, tid_, bid_, G); } { FRESH(); phase_mixers(p_, l, lds, tid_, lane_, wave_, bid_, G, 1); } }
#endif
#if defined(PROBE_DUP_C)
        if (IN(b0 + 3)) { __syncthreads(); FRESH(); gla_g3(p_, l, lds, tid_, lane_, wave_, bid_, G); }
#endif
        SEAM(b0 + 3);
        if (IN(b0 + 4)) { FRESH();
            gemm_rows_bf16(lds, (const bf16_t*)(p_.ws + WS_MIX), (const bf16_t*)(p_.ws + WS_WOUT) + (size_t)l * DM * DM, (bf16_t*)(p_.ws + WS_Y), (float*)(p_.ws + WS_YPART), l < DEPTH - 1, G, bid_);
#if defined(PROBE_DUP_GEMM)
            __syncthreads(); gemm_rows_bf16(lds, (const bf16_t*)(p_.ws + WS_MIX), (const bf16_t*)(p_.ws + WS_WOUT) + (size_t)l * DM * DM, (bf16_t*)(p_.ws + WS_Y), (float*)(p_.ws + WS_YPART), l < DEPTH - 1, G, bid_);
#endif
        }
        SEAM(b0 + 4);
        if (IN(b0 + 5)) { FRESH(); phase_ln1(p_, l, lds, tid_, lane_, wave_, bid_, G); }
#if defined(PROBE_DUP_E)
        if (IN(b0 + 5)) { __syncthreads(); FRESH(); phase_ln1(p_, l, lds, tid_, lane_, wave_, bid_, G); }
#endif
        SEAM(b0 + 5);
        if (IN(b0 + 6)) { FRESH();
            gemm_rows_bf16(lds, (const bf16_t*)(p_.ws + WS_HB), (const bf16_t*)(p_.ws + WS_WQ) + (size_t)l * DM * DM, (bf16_t*)(p_.ws + WS_QP), (float*)(p_.ws + WS_QPART), l < DEPTH - 1, G, bid_);
#if defined(PROBE_DUP_GEMM)
            __syncthreads(); gemm_rows_bf16(lds, (const bf16_t*)(p_.ws + WS_HB), (const bf16_t*)(p_.ws + WS_WQ) + (size_t)l * DM * DM, (bf16_t*)(p_.ws + WS_QP), (float*)(p_.ws + WS_QPART), l < DEPTH - 1, G, bid_);
#endif
        }
        SEAM(b0 + 6);
        if (IN(b0 + 7)) { FRESH(); peer_retrieve(p_, l, lds, tid_, lane_, wave_, bid_, G, l < DEPTH - 1 ? TA : TL); }
#if defined(PROBE_DUP_D)
        if (IN(b0 + 7)) { __syncthreads(); FRESH(); peer_retrieve(p_, l, lds, tid_, lane_, wave_, bid_, G, l < DEPTH - 1 ? TA : TL); }
#endif
        SEAM(b0 + 7);
        if (IN(b0 + 8)) { FRESH(); phase_peer(p_, l, lds, tid_, lane_, wave_, bid_, G); }
        if (l < DEPTH - 1) SEAM(b0 + 8);
    }
#undef FRESH
#undef IN
#undef SEAM
}

#ifndef MK_PER_PHASE
#define MK_PER_PHASE 0
#endif
extern "C" void kernel_launch(void* const* d_in, const int* in_sizes, int n_in, void* d_out, int out_size, void* d_ws, size_t ws_size, hipStream_t stream) {
    static int grid = 0;
    if (grid == 0) {
        if (n_in != 19 || out_size != TL * DM || ws_size < WS_END) { fprintf(stderr, "kernel_launch: unexpected shapes (n_in %d out %d ws %zu)\n", n_in, out_size, ws_size); grid = -1; return; }
        int dev = 0, cus = 0;
        if (hipGetDevice(&dev) != hipSuccess || hipDeviceGetAttribute(&cus, hipDeviceAttributeMultiprocessorCount, dev) != hipSuccess) { grid = -1; return; }
        if (hipFuncSetAttribute((const void*)fwd_kernel, hipFuncAttributeMaxDynamicSharedMemorySize, LDS_BYTES) != hipSuccess) { fprintf(stderr, "kernel_launch: hipFuncSetAttribute failed\n"); grid = -1; return; }
        int per_cu = 0;
        (void)hipOccupancyMaxActiveBlocksPerMultiprocessor(&per_cu, (const void*)fwd_kernel, NTHREADS, LDS_BYTES);
        (void)hipGetLastError();
        if (per_cu < 1) fprintf(stderr, "kernel_launch: occupancy query reports %d blocks per CU\n", per_cu);
        grid = cus;
    }
    if (grid < 0) return;
    (void)hipMemsetAsync((char*)d_ws + WS_CTL, 0, CTL_ZERO_BYTES, stream);
    Params p{};
    for (int i = 0; i < 19; ++i) p.in[i] = (const float*)d_in[i];
    p.out = (float*)d_out; p.ws = (unsigned char*)d_ws;
#if MK_PER_PHASE
    for (int ph = 0; ph < N_PHASES; ++ph) { p.ph_lo = ph; p.ph_hi = ph + 1; hipLaunchKernelGGL(fwd_kernel, dim3(grid), dim3(NTHREADS), LDS_BYTES, stream, p); }
#else
    p.ph_lo = 0; p.ph_hi = N_PHASES;
    hipLaunchKernelGGL(fwd_kernel, dim3(grid), dim3(NTHREADS), LDS_BYTES, stream, p);
#endif
}
```
